# Optimizing an MI355X kernel written in HIP

```python
import math
import jax, jax.numpy as jnp
from jax import lax
import numpy as np

D_MODEL = 1024
BATCH = 8
SEQ = 2048
DEPTH = 2
DEC_BATCH = 128
DEC_SEQ = 4
PAST_LEN = 16384
PAGE_SIZE = 128

N_META = 16
S5_WIDTH = 768
S5_GROUP = 16
S5_GROUPS = S5_WIDTH // S5_GROUP
S5_STATE = 64
LRU_WIDTH = 768
LRU_BLOCK = 64
LRU_BLOCKS = LRU_WIDTH // LRU_BLOCK
LRU_CONV = 4
LRU_C = 8.0
RET_HEADS = 8
RET_DK = 64
RET_DV = 128
RET_QK = RET_HEADS * RET_DK
RET_V = RET_HEADS * RET_DV
RET_CHUNK = 128
ROPE_BASE = 10000.0
N_BRANCH = 3
D_FF = 2816
FFN_CONV = 3
EPS = 1e-6
IN_SPLITS = (S5_WIDTH, LRU_WIDTH, LRU_WIDTH, RET_QK, RET_QK, RET_V, RET_V, N_BRANCH * D_MODEL)
D_IN = S5_WIDTH + 2 * LRU_WIDTH + 2 * RET_QK + 2 * RET_V + N_BRANCH * D_MODEL

kernel_name = 'hybrid_s5_rglru_retention_step'

F32 = jnp.float32


def rmsnorm(x, g):
    xf = x.astype(F32)
    y = xf * lax.rsqrt(jnp.mean(xf * xf, axis=-1, keepdims=True) + EPS)
    return (y * g.astype(F32)).astype(x.dtype)


def causal_dwconv(x, buf, w, b):
    width = w.shape[0]
    L = x.shape[1]
    xp = jnp.concatenate([buf.astype(x.dtype), x], axis=1)
    y = b + sum(xp[:, j:j + L] * w[j] for j in range(width))
    return y, xp[:, L:]


def _lin_combine(c1, c2):
    a1, b1 = c1
    a2, b2 = c2
    return a2 * a1, a2 * b1 + b2


def _cplx_combine(c1, c2):
    ar1, ai1, br1, bi1 = c1
    ar2, ai2, br2, bi2 = c2
    return (ar2 * ar1 - ai2 * ai1, ar2 * ai1 + ai2 * ar1,
            ar2 * br1 - ai2 * bi1 + br2, ar2 * bi1 + ai2 * br1 + bi2)


def s5_mixer(u, h0_re, h0_im, a_re, a_im, log_step, b_re, b_im, c_re, c_im, d_skip, w_glu, b_glu):
    Bsz, L, _ = u.shape
    uf = u.astype(F32)
    ug = uf.reshape(Bsz, L, S5_GROUPS, S5_GROUP)
    dt = jnp.exp(log_step.astype(F32))[:, None]
    lr = a_re.astype(F32)
    li = a_im.astype(F32)
    mag = jnp.exp(lr * dt)
    abar_re = mag * jnp.cos(li * dt)
    abar_im = mag * jnp.sin(li * dt)
    den = lr * lr + li * li
    nr = abar_re - 1.0
    cr = (nr * lr + abar_im * li) / den
    ci = (abar_im * lr - nr * li) / den
    bre = b_re.astype(F32)
    bim = b_im.astype(F32)
    bbar_re = cr[..., None] * bre - ci[..., None] * bim
    bbar_im = cr[..., None] * bim + ci[..., None] * bre
    bu_re = jnp.einsum('blgi,gpi->blgp', ug, bbar_re)
    bu_im = jnp.einsum('blgi,gpi->blgp', ug, bbar_im)
    h0r = h0_re.astype(F32)
    h0i = h0_im.astype(F32)
    bu_re = bu_re.at[:, 0].add(abar_re * h0r - abar_im * h0i)
    bu_im = bu_im.at[:, 0].add(abar_re * h0i + abar_im * h0r)
    ar = jnp.broadcast_to(abar_re[None, None], (1, L) + abar_re.shape)
    ai = jnp.broadcast_to(abar_im[None, None], (1, L) + abar_im.shape)
    _, _, hr, hi = lax.associative_scan(_cplx_combine, (ar, ai, bu_re, bu_im), axis=1)
    y = (jnp.einsum('blgp,gip->blgi', hr, c_re.astype(F32))
         - jnp.einsum('blgp,gip->blgi', hi, c_im.astype(F32)))
    y = y.reshape(Bsz, L, S5_WIDTH) + d_skip.astype(F32) * uf
    z = jax.nn.gelu(y)
    out = z * jax.nn.sigmoid(z @ w_glu.astype(F32) + b_glu.astype(F32))
    return out.astype(u.dtype), hr[:, -1], hi[:, -1]


def rglru_mixer(xb, gate, h0, conv_buf, conv_w, conv_b, w_a, b_a, w_x, b_x, lam):
    Bsz, L, _ = xb.shape
    xc, new_buf = causal_dwconv(xb, conv_buf, conv_w, conv_b)
    xcf = xc.astype(F32)
    xh = xcf.reshape(Bsz, L, LRU_BLOCKS, LRU_BLOCK)
    r = jax.nn.sigmoid(jnp.einsum('blhi,hij->blhj', xh, w_a.astype(F32)).reshape(Bsz, L, LRU_WIDTH) + b_a.astype(F32))
    i = jax.nn.sigmoid(jnp.einsum('blhi,hij->blhj', xh, w_x.astype(F32)).reshape(Bsz, L, LRU_WIDTH) + b_x.astype(F32))
    log_a = -LRU_C * r * jax.nn.softplus(-lam.astype(F32))
    a = jnp.exp(log_a)
    mult = jnp.sqrt(-jnp.expm1(2.0 * log_a))
    bvals = mult * (i * xcf)
    bvals = bvals.at[:, 0].add(a[:, 0] * h0.astype(F32))
    _, h = lax.associative_scan(_lin_combine, (a, bvals), axis=1)
    y = h * jax.nn.gelu(gate.astype(F32))
    return y.astype(xb.dtype), h[:, -1], new_buf


def rope(x, pos):
    half = x.shape[-1] // 2
    inv = jnp.power(ROPE_BASE, -jnp.arange(half, dtype=F32) / half)
    ang = pos.astype(F32)[:, None] * inv
    cos = jnp.cos(ang)[None, :, None, :]
    sin = jnp.sin(ang)[None, :, None, :]
    x1 = x[..., :half]
    x2 = x[..., half:]
    return jnp.concatenate([x1 * cos - x2 * sin, x2 * cos + x1 * sin], axis=-1)


def retention_chunk(s, qkv, log_gamma):
    q, k, v = qkv
    C = q.shape[2]
    n = jnp.arange(C, dtype=F32)
    diff = n[:, None] - n[None, :]
    decay = jnp.where(diff >= 0, jnp.exp(log_gamma[:, None, None] * jnp.maximum(diff, 0.0)), 0.0)
    scores = jnp.einsum('bhnd,bhmd->bhnm', q, k) * decay
    o = jnp.einsum('bhnm,bhme->bhne', scores, v)
    o = o + jnp.einsum('bhnd,bhde->bhne', q, s) * jnp.exp(log_gamma[:, None] * (n + 1.0))[..., None]
    k_dec = k * jnp.exp(log_gamma[:, None] * (C - 1.0 - n))[..., None]
    s_new = jnp.exp(log_gamma * C)[:, None, None] * s + jnp.einsum('bhmd,bhme->bhde', k_dec, v)
    return s_new, o


def retention_mixer(q, k, v, g, s0, norm_g, pos, lead, chunk):
    Bsz, L, _ = q.shape
    log_gamma = jnp.log1p(-jnp.exp2(-5.0 - jnp.arange(RET_HEADS, dtype=F32)))
    qh = rope(q.astype(F32).reshape(Bsz, L, RET_HEADS, RET_DK), pos).transpose(0, 2, 1, 3)
    kh = (rope(k.astype(F32).reshape(Bsz, L, RET_HEADS, RET_DK), pos) * RET_DK ** -0.5).transpose(0, 2, 1, 3)
    vh = v.astype(F32).reshape(Bsz, L, RET_HEADS, RET_DV).transpose(0, 2, 1, 3)
    step = lambda st, qkv: retention_chunk(st, qkv, log_gamma)
    s = s0.astype(F32)
    outs = []
    if lead > 0:
        s, o_lead = step(s, (qh[:, :, :lead], kh[:, :, :lead], vh[:, :, :lead]))
        outs.append(o_lead)
    n_chunks = (L - lead) // chunk

    def to_chunks(t):
        return t[:, :, lead:].reshape(Bsz, RET_HEADS, n_chunks, chunk, t.shape[-1]).transpose(2, 0, 1, 3, 4)

    s, o = lax.scan(step, s, (to_chunks(qh), to_chunks(kh), to_chunks(vh)))
    outs.append(o.transpose(1, 2, 0, 3, 4).reshape(Bsz, RET_HEADS, L - lead, RET_DV))
    o = jnp.concatenate(outs, axis=2).transpose(0, 2, 1, 3)
    mu = jnp.mean(o, axis=-1, keepdims=True)
    var = jnp.mean(jnp.square(o - mu), axis=-1, keepdims=True)
    o = (o - mu) * lax.rsqrt(var + EPS) * norm_g.astype(F32).reshape(RET_HEADS, RET_DV)
    y = jax.nn.silu(g.astype(F32)) * o.reshape(Bsz, L, RET_V)
    return y.astype(q.dtype), s


def layer(x, st, p, pos, lead, chunk):
    s5_re0, s5_im0, lru_h0, lru_buf0, ret_s0, ffn_buf0 = st
    Bsz, L, _ = x.shape
    h = rmsnorm(x, p['g_pre_mix'])
    z = h @ p['w_in']
    offs = np.cumsum(IN_SPLITS)[:-1].tolist()
    u_a, x_b, g_b, q, k, v, g_c, gates = jnp.split(z, offs, axis=-1)
    y_a, s5_re, s5_im = s5_mixer(u_a, s5_re0, s5_im0, p['s5_a_re'], p['s5_a_im'], p['s5_log_step'],
                                 p['s5_b_re'], p['s5_b_im'], p['s5_c_re'], p['s5_c_im'], p['s5_d'],
                                 p['s5_w_glu'], p['s5_b_glu'])
    y_b, lru_h, lru_buf = rglru_mixer(x_b, g_b, lru_h0, lru_buf0, p['lru_conv_w'], p['lru_conv_b'],
                                      p['lru_w_a'], p['lru_b_a'], p['lru_w_x'], p['lru_b_x'], p['lru_lam'])
    y_c, ret_s = retention_mixer(q, k, v, g_c, ret_s0, p['ret_norm_g'], pos, lead, chunk)
    gt = jax.nn.sigmoid(gates.reshape(Bsz, L, N_BRANCH, D_MODEL))
    m = (gt[:, :, 0] * (y_a @ p['w_branch_a'])
         + gt[:, :, 1] * (y_b @ p['w_branch_b'])
         + gt[:, :, 2] * (y_c @ p['w_branch_c']))
    x = x + rmsnorm(m @ p['w_out'], p['g_post_mix'])
    h = rmsnorm(x, p['g_pre_ffn'])
    up = h @ p['ffn_w_up']
    gf, uf = jnp.split(up, 2, axis=-1)
    gc, ffn_buf = causal_dwconv(gf, ffn_buf0, p['ffn_conv_w'], p['ffn_conv_b'])
    f = (jax.nn.gelu(gc) * uf) @ p['ffn_w_down']
    x = x + rmsnorm(f, p['g_post_ffn'])
    return x, (s5_re, s5_im, lru_h, lru_buf, ret_s, ffn_buf)


def run_group(x, states, params, pos, lead, chunk):
    new = []
    for l in range(DEPTH):
        p = {name: arr[l] for name, arr in params.items()}
        st = tuple(s[l] for s in states)
        x, st_new = layer(x, st, p, pos, lead, chunk)
        new.append(st_new)
    stacked = tuple(jnp.stack([n[i] for n in new]) for i in range(len(states)))
    return x, stacked


def setup_inputs(seed: int = 0):
    key = jax.random.key(seed)
    ks = iter(jax.random.split(key, 48))
    nrm = lambda shape, scale: scale * jax.random.normal(next(ks), shape, F32)
    x_prompt = nrm((BATCH, SEQ, D_MODEL), 1.0)
    x_sample = nrm((DEC_BATCH, DEC_SEQ, D_MODEL), 1.0)
    state_s5_re = nrm((DEPTH, DEC_BATCH, S5_GROUPS, S5_STATE), 0.5)
    state_s5_im = nrm((DEPTH, DEC_BATCH, S5_GROUPS, S5_STATE), 0.5)
    state_lru = nrm((DEPTH, DEC_BATCH, LRU_WIDTH), 0.5)
    cache_lru_conv = nrm((DEPTH, DEC_BATCH, LRU_CONV - 1, LRU_WIDTH), 1.0)
    state_ret = nrm((DEPTH, DEC_BATCH, RET_HEADS, RET_DK, RET_DV), 0.5)
    cache_ffn_conv = nrm((DEPTH, DEC_BATCH, FFN_CONV - 1, D_FF), 1.0)
    meta_tokens = nrm((N_META, D_MODEL), 1.0)
    g_pre_mix = 1.0 + nrm((DEPTH, D_MODEL), 0.02)
    g_post_mix = 1.0 + nrm((DEPTH, D_MODEL), 0.02)
    g_pre_ffn = 1.0 + nrm((DEPTH, D_MODEL), 0.02)
    g_post_ffn = 1.0 + nrm((DEPTH, D_MODEL), 0.02)
    w_in = nrm((DEPTH, D_MODEL, D_IN), D_MODEL ** -0.5)
    s5_a_re = -0.5 + nrm((DEPTH, S5_GROUPS, S5_STATE), 0.02)
    s5_a_im = jnp.pi * jnp.arange(S5_STATE, dtype=F32) + nrm((DEPTH, S5_GROUPS, S5_STATE), 0.02)
    s5_log_step = jax.random.uniform(next(ks), (DEPTH, S5_GROUPS), F32, math.log(1e-3), math.log(1e-1))
    s5_b_re = nrm((DEPTH, S5_GROUPS, S5_STATE, S5_GROUP), (2 * S5_GROUP) ** -0.5)
    s5_b_im = nrm((DEPTH, S5_GROUPS, S5_STATE, S5_GROUP), (2 * S5_GROUP) ** -0.5)
    s5_c_re = nrm((DEPTH, S5_GROUPS, S5_GROUP, S5_STATE), S5_STATE ** -0.5)
    s5_c_im = nrm((DEPTH, S5_GROUPS, S5_GROUP, S5_STATE), S5_STATE ** -0.5)
    s5_d = nrm((DEPTH, S5_WIDTH), 1.0)
    s5_w_glu = nrm((DEPTH, S5_WIDTH, S5_WIDTH), S5_WIDTH ** -0.5)
    s5_b_glu = nrm((DEPTH, S5_WIDTH), 0.01)
    lru_conv_w = nrm((DEPTH, LRU_CONV, LRU_WIDTH), LRU_CONV ** -0.5)
    lru_conv_b = nrm((DEPTH, LRU_WIDTH), 0.01)
    lru_w_a = nrm((DEPTH, LRU_BLOCKS, LRU_BLOCK, LRU_BLOCK), LRU_BLOCK ** -0.5)
    lru_b_a = nrm((DEPTH, LRU_WIDTH), 0.01)
    lru_w_x = nrm((DEPTH, LRU_BLOCKS, LRU_BLOCK, LRU_BLOCK), LRU_BLOCK ** -0.5)
    lru_b_x = nrm((DEPTH, LRU_WIDTH), 0.01)
    a_c = jax.random.uniform(next(ks), (DEPTH, LRU_WIDTH), F32, 0.9, 0.999) ** (1.0 / LRU_C)
    lru_lam = jnp.log(a_c) - jnp.log1p(-a_c)
    ret_norm_g = 1.0 + nrm((DEPTH, RET_V), 0.02)
    w_branch_a = nrm((DEPTH, S5_WIDTH, D_MODEL), S5_WIDTH ** -0.5)
    w_branch_b = nrm((DEPTH, LRU_WIDTH, D_MODEL), LRU_WIDTH ** -0.5)
    w_branch_c = nrm((DEPTH, RET_V, D_MODEL), RET_V ** -0.5)
    w_out = nrm((DEPTH, D_MODEL, D_MODEL), D_MODEL ** -0.5)
    ffn_w_up = nrm((DEPTH, D_MODEL, 2 * D_FF), D_MODEL ** -0.5)
    ffn_conv_w = nrm((DEPTH, FFN_CONV, D_FF), FFN_CONV ** -0.5)
    ffn_conv_b = nrm((DEPTH, D_FF), 0.01)
    ffn_w_down = nrm((DEPTH, D_FF, D_MODEL), D_FF ** -0.5)
    return {'x_prompt': x_prompt, 'x_sample': x_sample,
            'state_s5_re': state_s5_re, 'state_s5_im': state_s5_im, 'state_lru': state_lru,
            'cache_lru_conv': cache_lru_conv, 'state_ret': state_ret, 'cache_ffn_conv': cache_ffn_conv,
            'meta_tokens': meta_tokens,
            'g_pre_mix': g_pre_mix, 'g_post_mix': g_post_mix, 'g_pre_ffn': g_pre_ffn, 'g_post_ffn': g_post_ffn,
            'w_in': w_in, 's5_a_re': s5_a_re, 's5_a_im': s5_a_im, 's5_log_step': s5_log_step,
            's5_b_re': s5_b_re, 's5_b_im': s5_b_im, 's5_c_re': s5_c_re, 's5_c_im': s5_c_im,
            's5_d': s5_d, 's5_w_glu': s5_w_glu, 's5_b_glu': s5_b_glu,
            'lru_conv_w': lru_conv_w, 'lru_conv_b': lru_conv_b, 'lru_w_a': lru_w_a, 'lru_b_a': lru_b_a,
            'lru_w_x': lru_w_x, 'lru_b_x': lru_b_x, 'lru_lam': lru_lam, 'ret_norm_g': ret_norm_g,
            'w_branch_a': w_branch_a, 'w_branch_b': w_branch_b, 'w_branch_c': w_branch_c, 'w_out': w_out,
            'ffn_w_up': ffn_w_up, 'ffn_conv_w': ffn_conv_w, 'ffn_conv_b': ffn_conv_b, 'ffn_w_down': ffn_w_down}


def reference(x_prompt, x_sample, state_s5_re, state_s5_im, state_lru, cache_lru_conv, state_ret,
              cache_ffn_conv, meta_tokens, g_pre_mix, g_post_mix, g_pre_ffn, g_post_ffn, w_in,
              s5_a_re, s5_a_im, s5_log_step, s5_b_re, s5_b_im, s5_c_re, s5_c_im, s5_d, s5_w_glu, s5_b_glu,
              lru_conv_w, lru_conv_b, lru_w_a, lru_b_a, lru_w_x, lru_b_x, lru_lam, ret_norm_g,
              w_branch_a, w_branch_b, w_branch_c, w_out, ffn_w_up, ffn_conv_w, ffn_conv_b, ffn_w_down):
    params = {'g_pre_mix': g_pre_mix, 'g_post_mix': g_post_mix, 'g_pre_ffn': g_pre_ffn, 'g_post_ffn': g_post_ffn,
              'w_in': w_in, 's5_a_re': s5_a_re, 's5_a_im': s5_a_im, 's5_log_step': s5_log_step,
              's5_b_re': s5_b_re, 's5_b_im': s5_b_im, 's5_c_re': s5_c_re, 's5_c_im': s5_c_im,
              's5_d': s5_d, 's5_w_glu': s5_w_glu, 's5_b_glu': s5_b_glu,
              'lru_conv_w': lru_conv_w, 'lru_conv_b': lru_conv_b, 'lru_w_a': lru_w_a, 'lru_b_a': lru_b_a,
              'lru_w_x': lru_w_x, 'lru_b_x': lru_b_x, 'lru_lam': lru_lam, 'ret_norm_g': ret_norm_g,
              'w_branch_a': w_branch_a, 'w_branch_b': w_branch_b, 'w_branch_c': w_branch_c, 'w_out': w_out,
              'ffn_w_up': ffn_w_up, 'ffn_conv_w': ffn_conv_w, 'ffn_conv_b': ffn_conv_b, 'ffn_w_down': ffn_w_down}
    bp, sp, _ = x_prompt.shape
    meta = jnp.broadcast_to(meta_tokens.astype(x_prompt.dtype)[None], (bp, N_META, D_MODEL))
    xp = jnp.concatenate([meta, x_prompt], axis=1)
    zero_states = (jnp.zeros((DEPTH, bp, S5_GROUPS, S5_STATE), F32),
                   jnp.zeros((DEPTH, bp, S5_GROUPS, S5_STATE), F32),
                   jnp.zeros((DEPTH, bp, LRU_WIDTH), F32),
                   jnp.zeros((DEPTH, bp, LRU_CONV - 1, LRU_WIDTH), x_prompt.dtype),
                   jnp.zeros((DEPTH, bp, RET_HEADS, RET_DK, RET_DV), F32),
                   jnp.zeros((DEPTH, bp, FFN_CONV - 1, D_FF), x_prompt.dtype))
    pos_p = jnp.arange(N_META + sp)
    yp, (p_s5_re, p_s5_im, p_lru_h, p_lru_conv, p_ret, p_ffn_conv) = run_group(
        xp, zero_states, params, pos_p, N_META, RET_CHUNK)
    y_prompt = yp[:, N_META:]
    ds = x_sample.shape[1]
    pos_s = PAST_LEN + jnp.arange(ds)
    y_sample, (s_s5_re, s_s5_im, s_lru_h, s_lru_conv, s_ret, s_ffn_conv) = run_group(
        x_sample, (state_s5_re, state_s5_im, state_lru, cache_lru_conv, state_ret, cache_ffn_conv),
        params, pos_s, 0, ds)
    return (y_prompt, y_sample, p_s5_re, p_s5_im, p_lru_h, p_lru_conv, p_ret, p_ffn_conv,
            s_s5_re, s_s5_im, s_lru_h, s_lru_conv, s_ret, s_ffn_conv)
```

```cpp
#include <hip/hip_runtime.h>
#include <hip/hip_cooperative_groups.h>
#include <cstdio>
namespace cg = cooperative_groups;

#ifndef COOP
#define COOP 1
#endif
#ifndef OUTMASK
#define OUTMASK 0x3FFF
#endif
#ifndef OUT_BMAX
#define OUT_BMAX 1000
#endif
#ifndef OUT_L
#define OUT_L 3
#endif
#define OUT_ON(k) (((OUTMASK >> (k)) & 1) && ((OUT_L >> l) & 1))
#ifndef DMA_AUX
#define DMA_AUX 17
#endif

#define LAS __attribute__((address_space(3)))
typedef unsigned short bf16_t;
typedef short bf16x8 __attribute__((ext_vector_type(8)));
typedef float f32x4 __attribute__((ext_vector_type(4)));
typedef unsigned u32x4 __attribute__((ext_vector_type(4)));
typedef unsigned u32x2 __attribute__((ext_vector_type(2)));

constexpr int DM = 1024, NB = 8, SEQ = 2048, LP = 2064, DEC_B = 128, DEC_S = 4;
constexpr int TPR = NB * LP;
constexpr int TT = TPR + DEC_B * DEC_S;
constexpr int TPAD = 17152;
constexpr int DIN = 8448, DFF = 2816;
constexpr int ZO_UA = 0, ZO_XB = 768, ZO_GB = 1536, ZO_Q = 2304, ZO_K = 2816, ZO_V = 3328, ZO_GC = 4352, ZO_GATE = 5376;
constexpr int LDY = 2560;
constexpr float EPS = 1e-6f;
constexpr int LDS_BYTES = 143360;

enum { I_XP = 0, I_XS, I_S5RE, I_S5IM, I_LRUH, I_LRUC, I_RET, I_FFNC, I_META, I_GPREMIX, I_GPOSTMIX, I_GPREFFN, I_GPOSTFFN, I_WIN,
       I_AR, I_AI, I_LS, I_BR, I_BI, I_CR, I_CI, I_D, I_WGLU, I_BGLU, I_LCW, I_LCB, I_LWA, I_LBA, I_LWX, I_LBX, I_LAM, I_RNG,
       I_WBA, I_WBB, I_WBC, I_WOUT, I_WUP, I_FCW, I_FCB, I_WDOWN, N_IN };

constexpr size_t O_YP = 0;
constexpr size_t O_YS = O_YP + (size_t)NB * SEQ * DM;
constexpr size_t O_P_S5RE = O_YS + (size_t)DEC_B * DEC_S * DM;
constexpr size_t O_P_S5IM = O_P_S5RE + 2 * NB * 48 * 64;
constexpr size_t O_P_LRUH = O_P_S5IM + 2 * NB * 48 * 64;
constexpr size_t O_P_LRUC = O_P_LRUH + 2 * NB * 768;
constexpr size_t O_P_RET = O_P_LRUC + 2 * NB * 3 * 768;
constexpr size_t O_P_FFNC = O_P_RET + (size_t)2 * NB * 8 * 64 * 128;
constexpr size_t O_S_S5RE = O_P_FFNC + 2 * NB * 2 * DFF;
constexpr size_t O_S_S5IM = O_S_S5RE + 2 * DEC_B * 48 * 64;
constexpr size_t O_S_LRUH = O_S_S5IM + 2 * DEC_B * 48 * 64;
constexpr size_t O_S_LRUC = O_S_LRUH + 2 * DEC_B * 768;
constexpr size_t O_S_RET = O_S_LRUC + 2 * DEC_B * 3 * 768;
constexpr size_t O_S_FFNC = O_S_RET + (size_t)2 * DEC_B * 8 * 64 * 128;

constexpr size_t al256(size_t x) { return (x + 255) & ~(size_t)255; }
constexpr size_t W_IN = 0;
constexpr size_t W_GLU = W_IN + (size_t)2 * DIN * DM * 2;
constexpr size_t W_BR = W_GLU + (size_t)2 * 768 * 768 * 2;
constexpr size_t W_OUT = W_BR + (size_t)2 * DM * LDY * 2;
constexpr size_t W_UP = W_OUT + (size_t)2 * DM * DM * 2;
constexpr size_t W_DOWN = W_UP + (size_t)2 * 2 * DFF * DM * 2;
constexpr size_t A_X = W_DOWN + (size_t)2 * DM * DFF * 2;
constexpr int GR = 6400;
constexpr size_t R_Z = A_X + (size_t)TPAD * DM * 4;
constexpr size_t R_ZS5 = R_Z + (size_t)GR * DIN * 2;
constexpr size_t R_Y = R_ZS5 + (size_t)GR * 768 * 2;
constexpr size_t R_M = R_Y + (size_t)GR * LDY * 2;
constexpr size_t R_END = R_M + (size_t)GR * DM * 2;
constexpr size_t R_H = R_M;
constexpr size_t R_F = R_Z;
constexpr size_t R_UP = R_Z + (size_t)GR * DM * 4;
constexpr size_t R_FIN = R_ZS5;
static_assert(R_UP + (size_t)GR * 2 * DFF * 2 <= R_ZS5, "UP inside Z");
static_assert(R_FIN + (size_t)GR * DFF * 2 <= R_M, "FIN inside ZS5|Y");
constexpr size_t A_ROPE = R_END;
constexpr size_t A_CTR = al256(A_ROPE + (size_t)2068 * 64 * 4);
constexpr size_t WS_TOTAL = A_CTR + 4096;
constexpr int NGRP = 3;
constexpr int NPHASE = 1 + 2 * NGRP * 10;

struct Grp { int g0, nrows, npan, pb0, npb, hasS; };
__device__ __forceinline__ Grp get_grp(int g) {
    Grp r; r.g0 = g * 6192; r.nrows = g < 2 ? 6192 : 4640; r.npan = g < 2 ? 25 : 19; r.pb0 = g * 3; r.npb = g < 2 ? 3 : 2; r.hasS = g == 2; return r;
}

struct Params {
    const float* in[N_IN];
    float* out;
    unsigned char* ws;
};


constexpr int PTAB_OFF = 142336;
__device__ __forceinline__ const float* ldin(const unsigned char* smem, int i) {
    const unsigned long long v = ((const unsigned long long*)(smem + PTAB_OFF))[i];
    const unsigned lo = __builtin_amdgcn_readfirstlane((unsigned)v), hi = __builtin_amdgcn_readfirstlane((unsigned)(v >> 32));
    return (const float*)(((unsigned long long)hi << 32) | lo);
}
#define INP(i) ldin(smem, (i))
__device__ __forceinline__ int otid() { int t = threadIdx.x; asm volatile("" : "+v"(t)); return t; }

__device__ __forceinline__ float bf2f(bf16_t b) { return __uint_as_float(((unsigned)b) << 16); }
__device__ __forceinline__ bf16_t f2bf(float f) { unsigned u = __float_as_uint(f); u += 0x7FFFu + ((u >> 16) & 1u); return (bf16_t)(u >> 16); }
__device__ __forceinline__ unsigned pk2(float lo, float hi) { return (unsigned)f2bf(lo) | ((unsigned)f2bf(hi) << 16); }
__device__ __forceinline__ float sigm(float x) { return __frcp_rn(1.0f + __expf(-x)); }
__device__ __forceinline__ float gelu_t(float x) { const float v = 1.5957691216f * (x + 0.044715f * x * x * x); return x * __frcp_rn(1.0f + __expf(-v)); }
__device__ __forceinline__ void lds_wait() { asm volatile("s_waitcnt lgkmcnt(0)" ::: "memory"); __builtin_amdgcn_wave_barrier(); }
__device__ __forceinline__ f32x4 mfma16(bf16x8 a, bf16x8 b, f32x4 c) { return __builtin_amdgcn_mfma_f32_16x16x32_bf16(a, b, c, 0, 0, 0); }

namespace pg8 {
constexpr int BM = 256, BK = 64, HALF = 128, HTB = HALF * BK * 2, STAGE_BYTES = 8 * HTB, NXCD = 8, WGM = 8;
__device__ __forceinline__ int lds_byte(int r, int c) { const int st = (r >> 4) * 2 + (c >> 5), rr = r & 15, cc = c & 31, ob = rr * 64 + cc * 2; return st * 1024 + (ob ^ (((ob >> 9) & 1) << 5)); }
__device__ __forceinline__ void stage_rc(int b, int& R, int& C) { const int st = b / 1024, sb = b % 1024, swz = sb ^ (((sb >> 9) & 1) << 5); R = (st >> 1) * 16 + swz / 64; C = (st & 1) * 32 + (swz % 64) / 2; }

struct Unit { int pm, pn, br; };
struct Gemm { const bf16_t* A; const bf16_t* Bt; int lda, ldb, nM, nN, nt; };

template <int NBR> struct Sched {
    int nM, nN, nwg, G, c, nt0;
    __device__ void init(int nM_, int nN_, int G_, int c_, int nt_) { nM = nM_; nN = nN_; nwg = nM * nN; G = G_; c = c_; nt0 = nt_; }
    __device__ bool next(int i, Unit& u) const {
        const int ti = i / NBR; u.br = i - ti * NBR;
        const long L = (long)ti * G + c; if (L >= nwg) return false;
        int wgid = (int)L; { const int q = nwg / NXCD, r = nwg % NXCD, xcd = wgid % NXCD, off = wgid / NXCD; wgid = (xcd < r ? xcd * (q + 1) : r * (q + 1) + (xcd - r) * q) + off; }
        const int nig = WGM * nN, gid = wgid / nig, fm = gid * WGM, gsz = (nM - fm) < WGM ? (nM - fm) : WGM;
        u.pm = fm + ((wgid % nig) % gsz); u.pn = (wgid % nig) / gsz; return true;
    }
    __device__ __forceinline__ void kr(const Unit& u, size_t& koffB, int& nt) const {
        if (NBR == 1) { koffB = 0; nt = nt0; }
        else { koffB = (size_t)u.br * 1536; nt = (u.br == 2) ? 16 : 12; }
    }
};

__device__ __forceinline__ unsigned cvt_pk_bf16(float lo, float hi) { unsigned r; asm volatile("v_cvt_pk_bf16_f32 %0, %1, %2" : "=v"(r) : "v"(lo), "v"(hi)); return r; }

template <class Epi, class SchedT>
__device__ __forceinline__ void gemm_phase(LAS unsigned char* lds, const Gemm g, const SchedT& S, const Epi& E) {
    const int tid = otid(), wid = __builtin_amdgcn_readfirstlane(tid >> 6), lane = tid & 63, wr = wid >> 2, wc = wid & 3, fr = lane & 15, fq = lane >> 4;
    unsigned voffA[2], voffB[2];
#pragma unroll
    for (int i = 0; i < 2; ++i) { int R, C; stage_rc(tid * 16 + i * 8192, R, C);
        voffA[i] = (unsigned)(R * g.lda + C) * 2u; voffB[i] = (unsigned)(R * g.ldb + C) * 2u; }
    const size_t kstep = (size_t)(BK * 2);
    const size_t hstepA = (size_t)HALF * g.lda * 2, hstepB = (size_t)HALF * g.ldb * 2;
    const size_t tstepA = 2 * hstepA, tstepB = 2 * hstepB;
    const unsigned ldsw = (unsigned)wid * 1024u;
    const int aoff = lds_byte(wr * 64 + fr, fq * 8), boff = lds_byte(wc * 32 + fr, fq * 8);
#define PG8_SA(b, h) (((b) * 2 + (h)) * HTB)
#define PG8_SB(b, h) ((4 + (b) * 2 + (h)) * HTB)
#define PG8_STAGE(bufoff, gbase, voff) do { _Pragma("unroll") for (int _i = 0; _i < 2; ++_i) \
        __builtin_amdgcn_global_load_lds((const unsigned*)((const char*)(gbase) + (voff)[_i]), (LAS unsigned*)(lds + (bufoff) + ldsw + _i * 8192), 16, 0, DMA_AUX); } while (0)
#define PG8_LDA(dst, b, h) do { _Pragma("unroll") for (int m = 0; m < 4; ++m) _Pragma("unroll") for (int k = 0; k < 2; ++k) dst[m][k] = *(const LAS bf16x8*)(lds + PG8_SA(b, h) + aoff + m * 2048 + k * 1024); } while (0)
#define PG8_LDB(dst, b, h) do { _Pragma("unroll") for (int n = 0; n < 2; ++n) _Pragma("unroll") for (int k = 0; k < 2; ++k) dst[n][k] = *(const LAS bf16x8*)(lds + PG8_SB(b, h) + boff + n * 2048 + k * 1024); } while (0)
#define PG8_MMA(ai, bj, At, Bt) do { __builtin_amdgcn_s_setprio(1); _Pragma("unroll") for (int m = 0; m < 4; ++m) _Pragma("unroll") for (int n = 0; n < 2; ++n) _Pragma("unroll") for (int k = 0; k < 2; ++k) \
        acc[ai][bj][m][n] = __builtin_amdgcn_mfma_f32_16x16x32_bf16(Bt[n][k], At[m][k], acc[ai][bj][m][n], 0, 0, 0); __builtin_amdgcn_s_setprio(0); } while (0)
#define PG8_WAIT_V(n) asm volatile("s_waitcnt vmcnt(" #n ")" ::: "memory")
#define PG8_WAIT_L(n) asm volatile("s_waitcnt lgkmcnt(" #n ")" ::: "memory")
#define PG8_BAR __builtin_amdgcn_s_barrier()
#define PG8_SCHED __builtin_amdgcn_sched_barrier(0)
    Unit cur, nxt; int ui = 0;
    if (!S.next(0, cur)) return;
    f32x4 acc[2][2][4][2];
#pragma unroll
    for (int a = 0; a < 2; ++a)
#pragma unroll
        for (int b = 0; b < 2; ++b)
#pragma unroll
            for (int m = 0; m < 4; ++m)
#pragma unroll
                for (int n = 0; n < 2; ++n) acc[a][b][m][n] = (f32x4){0.f, 0.f, 0.f, 0.f};
    bf16x8 At[4][2], B0[2][2], B1[2][2];
    size_t koc; int ntc; S.kr(cur, koc, ntc);
    const char* cA = (const char*)g.A + (size_t)cur.pm * tstepA + koc; const char* cB = (const char*)g.Bt + (size_t)cur.pn * tstepB + koc;
    PG8_STAGE(PG8_SB(0, 0), cB, voffB); PG8_STAGE(PG8_SA(0, 0), cA, voffA); PG8_STAGE(PG8_SB(0, 1), cB + hstepB, voffB); PG8_STAGE(PG8_SA(0, 1), cA + hstepA, voffA);
    if (wr == 1) PG8_BAR;
    PG8_WAIT_V(4); PG8_BAR;
    PG8_STAGE(PG8_SB(1, 0), cB + kstep, voffB); PG8_STAGE(PG8_SA(1, 0), cA + kstep, voffA); PG8_STAGE(PG8_SB(1, 1), cB + hstepB + kstep, voffB);
    PG8_WAIT_V(6); PG8_BAR;
    for (;;) {
        const bool has_next = S.next(ui + 1, nxt);
        size_t kon = 0; int ntn = ntc; if (has_next) S.kr(nxt, kon, ntn);
        const char* nA = has_next ? (const char*)g.A + (size_t)nxt.pm * tstepA + kon : cA; const char* nB = has_next ? (const char*)g.Bt + (size_t)nxt.pn * tstepB + kon : cB;
        for (int t = 0; t < ntc; t += 2) {
            const bool last = (t == ntc - 2);
            const char* a1 = cA + (size_t)(t + 1) * kstep;
            const char* a2 = last ? nA : cA + (size_t)(t + 2) * kstep; const char* b2 = last ? nB : cB + (size_t)(t + 2) * kstep;
            const char* a3 = a2 + kstep; const char* b3 = b2 + kstep;
            PG8_LDB(B0, 0, 0); PG8_SCHED; PG8_LDA(At, 0, 0); PG8_STAGE(PG8_SA(1, 1), a1 + hstepA, voffA);
            PG8_WAIT_L(8); PG8_BAR; PG8_WAIT_L(0); PG8_MMA(0, 0, At, B0); PG8_BAR; PG8_SCHED;
            PG8_LDB(B1, 0, 1); PG8_STAGE(PG8_SB(0, 0), b2, voffB);
            PG8_BAR; PG8_WAIT_L(0); PG8_MMA(0, 1, At, B1); PG8_BAR;
            PG8_LDA(At, 0, 1); PG8_STAGE(PG8_SA(0, 0), a2, voffA);
            PG8_BAR; PG8_WAIT_L(0); PG8_MMA(1, 0, At, B0); PG8_BAR; PG8_SCHED;
            PG8_STAGE(PG8_SB(0, 1), b2 + hstepB, voffB);
            PG8_WAIT_V(6); PG8_BAR; PG8_MMA(1, 1, At, B1); PG8_BAR;
            PG8_LDB(B0, 1, 0); PG8_SCHED; PG8_LDA(At, 1, 0); PG8_STAGE(PG8_SA(0, 1), a2 + hstepA, voffA);
            PG8_WAIT_L(8); PG8_BAR; PG8_WAIT_L(0); PG8_MMA(0, 0, At, B0); PG8_BAR; PG8_SCHED;
            PG8_LDB(B1, 1, 1); PG8_STAGE(PG8_SB(1, 0), b3, voffB);
            PG8_BAR; PG8_WAIT_L(0); PG8_MMA(0, 1, At, B1); PG8_BAR;
            PG8_LDA(At, 1, 1); PG8_STAGE(PG8_SA(1, 0), a3, voffA);
            PG8_BAR; PG8_WAIT_L(0); PG8_MMA(1, 0, At, B0); PG8_BAR; PG8_SCHED;
            PG8_STAGE(PG8_SB(1, 1), b3 + hstepB, voffB);
            PG8_WAIT_V(6); PG8_BAR; PG8_MMA(1, 1, At, B1); PG8_BAR;
        }
        E(acc, cur, wr, wc, fr, fq);
        if (!has_next) break;
#pragma unroll
        for (int a = 0; a < 2; ++a)
#pragma unroll
            for (int b = 0; b < 2; ++b)
#pragma unroll
                for (int m = 0; m < 4; ++m)
#pragma unroll
                    for (int n = 0; n < 2; ++n) acc[a][b][m][n] = (f32x4){0.f, 0.f, 0.f, 0.f};
        cur = nxt; cA = nA; cB = nB; ntc = ntn; ++ui;
    }
    PG8_WAIT_V(0);
    if (wr == 0) PG8_BAR;
    PG8_BAR;
#undef PG8_SA
#undef PG8_SB
#undef PG8_STAGE
#undef PG8_LDA
#undef PG8_LDB
#undef PG8_MMA
#undef PG8_WAIT_V
#undef PG8_WAIT_L
#undef PG8_BAR
#undef PG8_SCHED
}

struct EpiBf {
    bf16_t* O; int ldc;
    __device__ __forceinline__ void operator()(const f32x4 (&acc)[2][2][4][2], const Unit& u, int wr, int wc, int fr, int fq) const {
        const int row0 = u.pm * BM + wr * 64 + fr, col0 = u.pn * BM + wc * 32 + 4 * fq;
#pragma unroll
        for (int ai = 0; ai < 2; ++ai)
#pragma unroll
            for (int m = 0; m < 4; ++m) { bf16_t* rowp = O + (size_t)(row0 + ai * HALF + m * 16) * ldc + col0;
#pragma unroll
                for (int bj = 0; bj < 2; ++bj)
#pragma unroll
                    for (int n = 0; n < 2; ++n) { const f32x4 v = acc[ai][bj][m][n]; u32x2 o; o.x = cvt_pk_bf16(v[0], v[1]); o.y = cvt_pk_bf16(v[2], v[3]); *(u32x2*)(rowp + bj * HALF + n * 16) = o; } }
    }
};
struct EpiF32 {
    float* C; int ldc;
    __device__ __forceinline__ void operator()(const f32x4 (&acc)[2][2][4][2], const Unit& u, int wr, int wc, int fr, int fq) const {
        const int row0 = u.pm * BM + wr * 64 + fr, col0 = u.pn * BM + wc * 32 + 4 * fq;
#pragma unroll
        for (int ai = 0; ai < 2; ++ai)
#pragma unroll
            for (int m = 0; m < 4; ++m) { float* rowp = C + (size_t)(row0 + ai * HALF + m * 16) * ldc + col0;
#pragma unroll
                for (int bj = 0; bj < 2; ++bj)
#pragma unroll
                    for (int n = 0; n < 2; ++n) *(f32x4*)(rowp + bj * HALF + n * 16) = acc[ai][bj][m][n]; }
    }
};
struct EpiGlu {
    bf16_t* Y; const bf16_t* Z; const float* bias;
    __device__ __forceinline__ void operator()(const f32x4 (&acc)[2][2][4][2], const Unit& u, int wr, int wc, int fr, int fq) const {
        const int row0 = u.pm * BM + wr * 64 + fr, col0 = u.pn * BM + wc * 32 + 4 * fq;
#pragma unroll
        for (int ai = 0; ai < 2; ++ai)
#pragma unroll
            for (int m = 0; m < 4; ++m) { const size_t r = (size_t)(row0 + ai * HALF + m * 16);
#pragma unroll
                for (int bj = 0; bj < 2; ++bj)
#pragma unroll
                    for (int n = 0; n < 2; ++n) { const int c = col0 + bj * HALF + n * 16; const f32x4 v = acc[ai][bj][m][n];
                        const u32x2 zz = *(const u32x2*)(Z + r * 768 + c); const f32x4 bb = *(const f32x4*)(bias + c);
                        const float z0 = __uint_as_float(zz.x << 16), z1 = __uint_as_float(zz.x & 0xffff0000u), z2 = __uint_as_float(zz.y << 16), z3 = __uint_as_float(zz.y & 0xffff0000u);
                        u32x2 o; o.x = cvt_pk_bf16(z0 * sigm(v[0] + bb[0]), z1 * sigm(v[1] + bb[1])); o.y = cvt_pk_bf16(z2 * sigm(v[2] + bb[2]), z3 * sigm(v[3] + bb[3]));
                        *(u32x2*)(Y + r * LDY + c) = o; } }
    }
};
struct EpiBranch {
    const bf16_t* Zg; bf16_t* Mo;
    __device__ __forceinline__ void operator()(const f32x4 (&acc)[2][2][4][2], const Unit& u, int wr, int wc, int fr, int fq) const {
        const int row0 = u.pm * BM + wr * 64 + fr, col0 = u.pn * BM + wc * 32 + 4 * fq; const int br = u.br;
#pragma unroll
        for (int ai = 0; ai < 2; ++ai)
#pragma unroll
            for (int m = 0; m < 4; ++m) { const size_t r = (size_t)(row0 + ai * HALF + m * 16);
#pragma unroll
                for (int bj = 0; bj < 2; ++bj)
#pragma unroll
                    for (int n = 0; n < 2; ++n) { const int c = col0 + bj * HALF + n * 16; const f32x4 v = acc[ai][bj][m][n];
                        const u32x2 gg = *(const u32x2*)(Zg + r * DIN + br * 1024 + c);
                        f32x4 t; t[0] = v[0] * sigm(__uint_as_float(gg.x << 16)); t[1] = v[1] * sigm(__uint_as_float(gg.x & 0xffff0000u));
                        t[2] = v[2] * sigm(__uint_as_float(gg.y << 16)); t[3] = v[3] * sigm(__uint_as_float(gg.y & 0xffff0000u));
                        bf16_t* mp = Mo + r * DM + c;
                        if (br != 0) { u32x2 p; p.x = __hip_atomic_load((const unsigned*)mp, __ATOMIC_RELAXED, __HIP_MEMORY_SCOPE_AGENT); p.y = __hip_atomic_load((const unsigned*)mp + 1, __ATOMIC_RELAXED, __HIP_MEMORY_SCOPE_AGENT); t[0] += __uint_as_float(p.x << 16); t[1] += __uint_as_float(p.x & 0xffff0000u); t[2] += __uint_as_float(p.y << 16); t[3] += __uint_as_float(p.y & 0xffff0000u); }
                        u32x2 o; o.x = cvt_pk_bf16(t[0], t[1]); o.y = cvt_pk_bf16(t[2], t[3]); *(u32x2*)mp = o; } }
    }
};

#ifndef GEMM_SIMPLE
#define GEMM_SIMPLE 0
#endif
template <class Epi, class SchedT>
__device__ __forceinline__ void gemm_simple(LAS unsigned char* lds, const Gemm g, const SchedT& S, const Epi& E) {
    const int tid = otid(), wid = __builtin_amdgcn_readfirstlane(tid >> 6), lane = tid & 63, wr = wid >> 2, wc = wid & 3, fr = lane & 15, fq = lane >> 4;
    unsigned voffA[2], voffB[2];
#pragma unroll
    for (int i = 0; i < 2; ++i) { int R, C; stage_rc(tid * 16 + i * 8192, R, C);
        voffA[i] = (unsigned)(R * g.lda + C) * 2u; voffB[i] = (unsigned)(R * g.ldb + C) * 2u; }
    const size_t hstepA = (size_t)HALF * g.lda * 2, hstepB = (size_t)HALF * g.ldb * 2;
    const int aoff = lds_byte(wr * 64 + fr, fq * 8), boff = lds_byte(wc * 32 + fr, fq * 8);
    Unit cur;
    for (int ui = 0; S.next(ui, cur); ++ui) {
        size_t koc; int ntc; S.kr(cur, koc, ntc);
        const char* cA = (const char*)g.A + (size_t)cur.pm * 2 * hstepA + koc; const char* cB = (const char*)g.Bt + (size_t)cur.pn * 2 * hstepB + koc;
        f32x4 acc[2][2][4][2];
#pragma unroll
        for (int a = 0; a < 2; ++a)
#pragma unroll
            for (int b = 0; b < 2; ++b)
#pragma unroll
                for (int m = 0; m < 4; ++m)
#pragma unroll
                    for (int n = 0; n < 2; ++n) acc[a][b][m][n] = (f32x4){0.f, 0.f, 0.f, 0.f};
        for (int t = 0; t < ntc; ++t) {
            u32x4 ra[2][2], rb[2][2];
#pragma unroll
            for (int h = 0; h < 2; ++h)
#pragma unroll
                for (int i = 0; i < 2; ++i) { ra[h][i] = *(const u32x4*)(cA + (size_t)t * 128 + h * hstepA + voffA[i]); rb[h][i] = *(const u32x4*)(cB + (size_t)t * 128 + h * hstepB + voffB[i]); }
            __syncthreads();
#pragma unroll
            for (int h = 0; h < 2; ++h)
#pragma unroll
                for (int i = 0; i < 2; ++i) { *(LAS u32x4*)(lds + h * HTB + tid * 16 + i * 8192) = ra[h][i]; *(LAS u32x4*)(lds + (4 + h) * HTB + tid * 16 + i * 8192) = rb[h][i]; }
            __syncthreads();
#pragma unroll
            for (int ai = 0; ai < 2; ++ai) {
                bf16x8 At[4][2];
#pragma unroll
                for (int m = 0; m < 4; ++m)
#pragma unroll
                    for (int k = 0; k < 2; ++k) At[m][k] = *(const LAS bf16x8*)(lds + ai * HTB + aoff + m * 2048 + k * 1024);
#pragma unroll
                for (int bj = 0; bj < 2; ++bj) {
                    bf16x8 Bf[2][2];
#pragma unroll
                    for (int n = 0; n < 2; ++n)
#pragma unroll
                        for (int k = 0; k < 2; ++k) Bf[n][k] = *(const LAS bf16x8*)(lds + (4 + bj) * HTB + boff + n * 2048 + k * 1024);
#pragma unroll
                    for (int m = 0; m < 4; ++m)
#pragma unroll
                        for (int n = 0; n < 2; ++n)
#pragma unroll
                            for (int k = 0; k < 2; ++k) acc[ai][bj][m][n] = __builtin_amdgcn_mfma_f32_16x16x32_bf16(Bf[n][k], At[m][k], acc[ai][bj][m][n], 0, 0, 0);
                }
            }
        }
        E(acc, cur, wr, wc, fr, fq);
    }
    __syncthreads();
}
template <class Epi, class SchedT>
__device__ __forceinline__ void gemm_run(LAS unsigned char* lds, const Gemm g, const SchedT& S, const Epi& E) {
#if GEMM_SIMPLE
    gemm_simple(lds, g, S, E);
#else
    gemm_phase(lds, g, S, E);
#endif
}
}

__device__ __forceinline__ void transpose_tile(const float* __restrict__ W, int N, bf16_t* __restrict__ dst, int ldd, int koff, int tk, int tn, float* tile) {
    const int tid = otid(), a = tid >> 6, bq = tid & 63;
    __syncthreads();
#pragma unroll
    for (int i = 0; i < 8; ++i) { const int k = a + 8 * i; tile[k * 65 + bq] = W[(size_t)(tk * 64 + k) * N + tn * 64 + bq]; }
    __syncthreads();
#pragma unroll
    for (int i = 0; i < 8; ++i) { const int n = a + 8 * i; dst[(size_t)(tn * 64 + n) * ldd + koff + tk * 64 + bq] = f2bf(tile[bq * 65 + n]); }
}

__device__ __forceinline__ void rms_store(const f32x4 (&xv)[4], const float* g, bf16_t* dst, int lane) {
    float ss = 0.f;
#pragma unroll
    for (int i = 0; i < 4; ++i) ss += xv[i][0] * xv[i][0] + xv[i][1] * xv[i][1] + xv[i][2] * xv[i][2] + xv[i][3] * xv[i][3];
#pragma unroll
    for (int o = 32; o > 0; o >>= 1) ss += __shfl_xor(ss, o);
    const float rs = rsqrtf(ss * (1.0f / DM) + EPS);
#pragma unroll
    for (int i = 0; i < 4; ++i) { const int c = lane * 4 + 256 * i; const f32x4 gn = *(const f32x4*)(g + c); const f32x4 hv = xv[i] * gn * rs;
        u32x2 o; o.x = pk2(hv[0], hv[1]); o.y = pk2(hv[2], hv[3]); *(u32x2*)(dst + c) = o; }
}
__device__ __forceinline__ void norm_rows(const Params& P, int mode, int l, int grp, const unsigned char* smem) {
    const int tid_ = otid(); const int wid = tid_ >> 6, lane = tid_ & 63;
    float* X = (float*)(P.ws + A_X);
    const int gw = blockIdx.x * 8 + wid, nw = gridDim.x * 8;
    if (mode == 0) {
        const float* g0p = INP(I_GPREMIX); bf16_t* H = (bf16_t*)(P.ws + R_H);
        for (int row = gw; row < TPAD; row += nw) {
            f32x4 xv[4];
            if (row >= TT) {
#pragma unroll
                for (int i = 0; i < 4; ++i) xv[i] = (f32x4){0.f, 0.f, 0.f, 0.f};
            } else {
                const bool isP = row < TPR; int b = 0, t = 0; if (isP) { b = row / LP; t = row - b * LP; }
                const float* src = isP ? (t < 16 ? INP(I_META) + (size_t)t * DM : INP(I_XP) + ((size_t)b * SEQ + (t - 16)) * DM) : INP(I_XS) + (size_t)(row - TPR) * DM;
#pragma unroll
                for (int i = 0; i < 4; ++i) xv[i] = *(const f32x4*)(src + lane * 4 + 256 * i);
            }
#pragma unroll
            for (int i = 0; i < 4; ++i) *(f32x4*)(X + (size_t)row * DM + lane * 4 + 256 * i) = xv[i];
            if (row < 6192) rms_store(xv, g0p, H + (size_t)row * DM, lane);
        }
        return;
    }
    const Grp G = get_grp(grp);
    const float* F = (const float*)(P.ws + R_F) - (size_t)G.g0 * DM;
    bf16_t* H = (bf16_t*)(P.ws + R_H) - (size_t)G.g0 * DM;
    const bool fin = (mode == 2 && l == 1);
    const float* gpost = (mode == 1 ? INP(I_GPOSTMIX) : INP(I_GPOSTFFN)) + l * DM;
    const float* gffn = INP(I_GPREFFN) + l * DM;
    for (int row = G.g0 + gw; row < G.g0 + G.nrows; row += nw) {
        f32x4 xv[4], fv[4]; float ss = 0.f;
#pragma unroll
        for (int i = 0; i < 4; ++i) { const int c = lane * 4 + 256 * i; xv[i] = *(const f32x4*)(X + (size_t)row * DM + c); fv[i] = *(const f32x4*)(F + (size_t)row * DM + c);
            ss += fv[i][0] * fv[i][0] + fv[i][1] * fv[i][1] + fv[i][2] * fv[i][2] + fv[i][3] * fv[i][3]; }
#pragma unroll
        for (int o = 32; o > 0; o >>= 1) ss += __shfl_xor(ss, o);
        const float rs = rsqrtf(ss * (1.0f / DM) + EPS);
#pragma unroll
        for (int i = 0; i < 4; ++i) { const f32x4 gp = *(const f32x4*)(gpost + lane * 4 + 256 * i); xv[i] = xv[i] + fv[i] * gp * rs; }
        if (fin) {
            float* dst = nullptr;
            if (row < TPR) { const int b = row / LP, t = row - b * LP; if (t >= 16 && ((OUTMASK >> 0) & 1)) dst = P.out + O_YP + ((size_t)b * SEQ + (t - 16)) * DM; }
            else if ((OUTMASK >> 1) & 1) dst = P.out + O_YS + (size_t)(row - TPR) * DM;
            if (dst) {
#pragma unroll
                for (int i = 0; i < 4; ++i) *(f32x4*)(dst + lane * 4 + 256 * i) = xv[i];
            }
        } else {
#pragma unroll
            for (int i = 0; i < 4; ++i) *(f32x4*)(X + (size_t)row * DM + lane * 4 + 256 * i) = xv[i];
        }
        if (mode == 1) rms_store(xv, gffn, H + (size_t)row * DM, lane);
    }
    if (mode == 2) {
        int nl = l, ng = grp + 1; if (ng == NGRP) { ng = 0; nl = l + 1; }
        if (nl < 2) {
            const Grp N = get_grp(ng); const float* gn = INP(I_GPREMIX) + nl * DM; bf16_t* Hn = (bf16_t*)(P.ws + R_H) - (size_t)N.g0 * DM;
            for (int row = N.g0 + gw; row < N.g0 + N.nrows; row += nw) {
                f32x4 xv[4];
#pragma unroll
                for (int i = 0; i < 4; ++i) xv[i] = *(const f32x4*)(X + (size_t)row * DM + lane * 4 + 256 * i);
                rms_store(xv, gn, Hn + (size_t)row * DM, lane);
            }
        }
    }
}

__device__ __forceinline__ void phase0(const Params& P, unsigned char* smem) {
    float* tile = (float*)smem;
    constexpr int C0 = 2112, C1 = C0 + 144, C2 = C1 + 192, C3 = C2 + 192, C4 = C3 + 256, C5 = C4 + 256, C6 = C5 + 1408, C7 = C6 + 704;
    for (int id = blockIdx.x; id < 2 * C7; id += gridDim.x) {
        const int l = id / C7; int j = id - l * C7;
        const float* W; int N, ldd, koff = 0; bf16_t* dst;
        if (j < C0) { W = INP(I_WIN) + (size_t)l * DM * DIN; N = DIN; dst = (bf16_t*)(P.ws + W_IN) + (size_t)l * DIN * DM; ldd = DM; }
        else if (j < C1) { j -= C0; W = INP(I_WGLU) + (size_t)l * 768 * 768; N = 768; dst = (bf16_t*)(P.ws + W_GLU) + (size_t)l * 768 * 768; ldd = 768; }
        else if (j < C2) { j -= C1; W = INP(I_WBA) + (size_t)l * 768 * DM; N = DM; dst = (bf16_t*)(P.ws + W_BR) + (size_t)l * DM * LDY; ldd = LDY; }
        else if (j < C3) { j -= C2; W = INP(I_WBB) + (size_t)l * 768 * DM; N = DM; dst = (bf16_t*)(P.ws + W_BR) + (size_t)l * DM * LDY; ldd = LDY; koff = 768; }
        else if (j < C4) { j -= C3; W = INP(I_WBC) + (size_t)l * DM * DM; N = DM; dst = (bf16_t*)(P.ws + W_BR) + (size_t)l * DM * LDY; ldd = LDY; koff = 1536; }
        else if (j < C5) { j -= C4; W = INP(I_WOUT) + (size_t)l * DM * DM; N = DM; dst = (bf16_t*)(P.ws + W_OUT) + (size_t)l * DM * DM; ldd = DM; }
        else if (j < C6) { j -= C5; W = INP(I_WUP) + (size_t)l * DM * 2 * DFF; N = 2 * DFF; dst = (bf16_t*)(P.ws + W_UP) + (size_t)l * 2 * DFF * DM; ldd = DM; }
        else { j -= C6; W = INP(I_WDOWN) + (size_t)l * DFF * DM; N = DM; dst = (bf16_t*)(P.ws + W_DOWN) + (size_t)l * DM * DFF; ldd = DFF; }
        const int ntn = N / 64; const int tk = j / ntn, tn = j - tk * ntn;
        transpose_tile(W, N, dst, ldd, koff, tk, tn, tile);
    }
    norm_rows(P, 0, 0, 0, smem);
    float* rt = (float*)(P.ws + A_ROPE);
    for (int i = blockIdx.x * 512 + threadIdx.x; i < 2068 * 32; i += gridDim.x * 512) {
        const int pi = i >> 5, fi = i & 31; const double pos = pi < LP ? (double)pi : (double)(16384 + pi - LP);
        const double inv = exp(-(double)fi * (9.210340371976184 / 32.0));
        double ang = pos * inv; const double k = rint(ang * 0.15915494309189535); ang = ang - k * 6.283185307179586;
        const float af = (float)ang; rt[2 * i] = cosf(af); rt[2 * i + 1] = sinf(af);
    }
    if (blockIdx.x == 0 && threadIdx.x < 64) ((unsigned*)(P.ws + A_CTR))[threadIdx.x] = 0u;
}

__device__ __forceinline__ void ffn_conv_phase(const Params& P, int l, int grp, const unsigned char* smem) {
    const Grp G = get_grp(grp);
    const bf16_t* UP = (const bf16_t*)(P.ws + R_UP) - (size_t)G.g0 * (2 * DFF); bf16_t* FIN = (bf16_t*)(P.ws + R_FIN) - (size_t)G.g0 * DFF;
    const float* cw = INP(I_FCW) + (size_t)l * 3 * DFF; const float* cb = INP(I_FCB) + (size_t)l * DFF;
    const float* cache = INP(I_FFNC) + (size_t)l * DEC_B * 2 * DFF;
    constexpr int NCG = DFF / 8;
    for (int it = blockIdx.x * 512 + threadIdx.x; it < G.nrows * NCG; it += gridDim.x * 512) {
        const int rr = it / NCG, c = (it - rr * NCG) * 8, row = G.g0 + rr;
        int b, t, L; const bool isP = row < TPR;
        if (isP) { b = row / LP; t = row - b * LP; L = LP; } else { b = (row - TPR) >> 2; t = (row - TPR) & 3; L = 4; }
        float g0[8], g1[8], g2[8], uf[8];
        { const u32x4 v = *(const u32x4*)(UP + (size_t)row * (2 * DFF) + c);
#pragma unroll
          for (int i = 0; i < 4; ++i) { g0[2 * i] = __uint_as_float(v[i] << 16); g0[2 * i + 1] = __uint_as_float(v[i] & 0xffff0000u); } }
        { const u32x4 v = *(const u32x4*)(UP + (size_t)row * (2 * DFF) + DFF + c);
#pragma unroll
          for (int i = 0; i < 4; ++i) { uf[2 * i] = __uint_as_float(v[i] << 16); uf[2 * i + 1] = __uint_as_float(v[i] & 0xffff0000u); } }
        if (t >= 1) { const u32x4 v = *(const u32x4*)(UP + (size_t)(row - 1) * (2 * DFF) + c);
#pragma unroll
            for (int i = 0; i < 4; ++i) { g1[2 * i] = __uint_as_float(v[i] << 16); g1[2 * i + 1] = __uint_as_float(v[i] & 0xffff0000u); } }
        else {
#pragma unroll
            for (int i = 0; i < 8; ++i) g1[i] = isP ? 0.f : cache[((size_t)b * 2 + 1) * DFF + c + i]; }
        if (t >= 2) { const u32x4 v = *(const u32x4*)(UP + (size_t)(row - 2) * (2 * DFF) + c);
#pragma unroll
            for (int i = 0; i < 4; ++i) { g2[2 * i] = __uint_as_float(v[i] << 16); g2[2 * i + 1] = __uint_as_float(v[i] & 0xffff0000u); } }
        else {
#pragma unroll
            for (int i = 0; i < 8; ++i) g2[i] = isP ? 0.f : cache[((size_t)b * 2 + t) * DFF + c + i]; }
        float o[8];
#pragma unroll
        for (int i = 0; i < 8; ++i) { const float gc = cb[c + i] + cw[c + i] * g2[i] + cw[DFF + c + i] * g1[i] + cw[2 * DFF + c + i] * g0[i]; o[i] = gelu_t(gc) * uf[i]; }
        u32x4 ov; ov[0] = pk2(o[0], o[1]); ov[1] = pk2(o[2], o[3]); ov[2] = pk2(o[4], o[5]); ov[3] = pk2(o[6], o[7]);
        *(u32x4*)(FIN + (size_t)row * DFF + c) = ov;
        if (t >= L - 2 && (isP ? OUT_ON(7) : OUT_ON(13))) {
            float* dst = isP ? P.out + O_P_FFNC + (((size_t)l * NB + b) * 2 + (t - (L - 2))) * DFF + c : P.out + O_S_FFNC + (((size_t)l * DEC_B + b) * 2 + (t - (L - 2))) * DFF + c;
#pragma unroll
            for (int i = 0; i < 8; ++i) dst[i] = g0[i];
        }
    }
}

__device__ __forceinline__ void ret_job(const Params& P, int l, int grp, int b, int h, int g0, unsigned char* smem) {
    const int tid = otid(), w = __builtin_amdgcn_readfirstlane(tid >> 6), lane = tid & 63, fr = lane & 15, fq = lane >> 4;
    bf16_t* sQ = (bf16_t*)smem;
    bf16_t* sK = sQ + 128 * 72;
    bf16_t* sKdT = sK + 128 * 72;
    bf16_t* sVT = sKdT + 64 * 136;
    bf16_t* sST = sVT + 128 * 136;
    bf16_t* sP = sST + 128 * 72 + w * 16 * 136;
    const bf16_t* Z = (const bf16_t*)(P.ws + R_Z) - (size_t)g0 * DIN; bf16_t* Y = (bf16_t*)(P.ws + R_Y) - (size_t)g0 * LDY;
    const float* rope = (const float*)(P.ws + A_ROPE);
    const int L = grp ? 4 : LP, rowb = grp ? TPR + b * 4 : b * LP, tabb = grp ? LP : 0;
    const float lg = log1pf(-exp2f(-5.0f - (float)h));
    const float* ng = INP(I_RNG) + (size_t)l * 1024 + h * 128;
    f32x4 accS[4];
    float* Sout = P.out + (grp ? O_S_RET + (((size_t)l * DEC_B + b) * 8 + h) * 8192 : O_P_RET + (((size_t)l * NB + b) * 8 + h) * 8192);
    if (grp) { const float* S0 = INP(I_RET) + (((size_t)l * DEC_B + b) * 8 + h) * 8192;
#pragma unroll
        for (int dt = 0; dt < 4; ++dt)
#pragma unroll
            for (int j = 0; j < 4; ++j) accS[dt][j] = S0[(16 * dt + 4 * fq + j) * 128 + 16 * w + fr];
    } else {
#pragma unroll
        for (int dt = 0; dt < 4; ++dt) accS[dt] = (f32x4){0.f, 0.f, 0.f, 0.f};
    }
    __syncthreads();
#pragma unroll
    for (int dt = 0; dt < 4; ++dt) { u32x2 o; o.x = pk2(accS[dt][0], accS[dt][1]); o.y = pk2(accS[dt][2], accS[dt][3]); *(u32x2*)(sST + (16 * w + fr) * 72 + 16 * dt + 4 * fq) = o; }
    const int nch = grp ? 1 : 17;
    for (int ck = 0; ck < nch; ++ck) {
        const int t0 = grp ? 0 : (ck == 0 ? 0 : 16 + (ck - 1) * 128), C = grp ? 4 : (ck == 0 ? 16 : 128);
        {
            const int m = tid >> 2, i0 = (tid & 3) * 8;
            u32x4 q1w = {0u, 0u, 0u, 0u}, q2w = q1w, k1w = q1w, k2w = q1w;
            float kd1[8], kd2[8];
#pragma unroll
            for (int e = 0; e < 8; ++e) { kd1[e] = 0.f; kd2[e] = 0.f; }
            if (m < C) {
                const size_t zr = (size_t)(rowb + t0 + m) * DIN;
                const u32x4 q1 = *(const u32x4*)(Z + zr + ZO_Q + h * 64 + i0), q2 = *(const u32x4*)(Z + zr + ZO_Q + h * 64 + 32 + i0);
                const u32x4 k1 = *(const u32x4*)(Z + zr + ZO_K + h * 64 + i0), k2 = *(const u32x4*)(Z + zr + ZO_K + h * 64 + 32 + i0);
                const float* rp = rope + ((size_t)(tabb + t0 + m) * 32 + i0) * 2;
                const float kdec = __expf(lg * (float)(C - 1 - m));
                float qo1[8], qo2[8], ko1[8], ko2[8];
#pragma unroll
                for (int e = 0; e < 8; ++e) {
                    const float cs = rp[2 * e], sn = rp[2 * e + 1];
                    const unsigned qa = q1[e >> 1], qb = q2[e >> 1], ka = k1[e >> 1], kb = k2[e >> 1];
                    const float x1 = (e & 1) ? __uint_as_float(qa & 0xffff0000u) : __uint_as_float(qa << 16);
                    const float x2 = (e & 1) ? __uint_as_float(qb & 0xffff0000u) : __uint_as_float(qb << 16);
                    const float y1 = ((e & 1) ? __uint_as_float(ka & 0xffff0000u) : __uint_as_float(ka << 16)) * 0.125f;
                    const float y2 = ((e & 1) ? __uint_as_float(kb & 0xffff0000u) : __uint_as_float(kb << 16)) * 0.125f;
                    qo1[e] = x1 * cs - x2 * sn; qo2[e] = x2 * cs + x1 * sn;
                    ko1[e] = y1 * cs - y2 * sn; ko2[e] = y2 * cs + y1 * sn;
                    kd1[e] = ko1[e] * kdec; kd2[e] = ko2[e] * kdec;
                }
#pragma unroll
                for (int e = 0; e < 4; ++e) { q1w[e] = pk2(qo1[2 * e], qo1[2 * e + 1]); q2w[e] = pk2(qo2[2 * e], qo2[2 * e + 1]); k1w[e] = pk2(ko1[2 * e], ko1[2 * e + 1]); k2w[e] = pk2(ko2[2 * e], ko2[2 * e + 1]); }
            }
            *(u32x4*)(sQ + m * 72 + i0) = q1w; *(u32x4*)(sQ + m * 72 + 32 + i0) = q2w;
            *(u32x4*)(sK + m * 72 + i0) = k1w; *(u32x4*)(sK + m * 72 + 32 + i0) = k2w;
#pragma unroll
            for (int e = 0; e < 8; ++e) { sKdT[(i0 + e) * 136 + m] = f2bf(kd1[e]); sKdT[(32 + i0 + e) * 136 + m] = f2bf(kd2[e]); }
            const int m2 = tid & 127, e0 = (tid >> 7) * 32;
            u32x4 vv[4];
#pragma unroll
            for (int i = 0; i < 4; ++i) vv[i] = (u32x4){0u, 0u, 0u, 0u};
            if (m2 < C) { const bf16_t* vp = Z + (size_t)(rowb + t0 + m2) * DIN + ZO_V + h * 128 + e0;
#pragma unroll
                for (int i = 0; i < 4; ++i) vv[i] = *(const u32x4*)(vp + 8 * i); }
#pragma unroll
            for (int i = 0; i < 4; ++i)
#pragma unroll
                for (int e = 0; e < 4; ++e) { sVT[(e0 + 8 * i + 2 * e) * 136 + m2] = (bf16_t)(vv[i][e] & 0xffffu); sVT[(e0 + 8 * i + 2 * e + 1) * 136 + m2] = (bf16_t)(vv[i][e] >> 16); }
        }
        __syncthreads();
        f32x4 o[8];
        const bool act = (16 * w < C);
        if (act) {
            bf16x8 qf[2];
#pragma unroll
            for (int ks = 0; ks < 2; ++ks) qf[ks] = *(const bf16x8*)(sQ + (16 * w + fr) * 72 + 32 * ks + 8 * fq);
            const int mtN = (w | 1) + 1;
            for (int mt = 0; mt < mtN; ++mt) {
                f32x4 a = {0.f, 0.f, 0.f, 0.f};
#pragma unroll
                for (int ks = 0; ks < 2; ++ks) { const bf16x8 kf = *(const bf16x8*)(sK + (16 * mt + fr) * 72 + 32 * ks + 8 * fq); a = mfma16(qf[ks], kf, a); }
#pragma unroll
                for (int j = 0; j < 4; ++j) { const int d = (16 * w + 4 * fq + j) - (16 * mt + fr); const float v = d >= 0 ? a[j] * __expf(lg * (float)d) : 0.f; sP[(4 * fq + j) * 136 + 16 * mt + fr] = f2bf(v); }
            }
            lds_wait();
#pragma unroll
            for (int et = 0; et < 8; ++et) o[et] = (f32x4){0.f, 0.f, 0.f, 0.f};
            const int ksN = mtN >> 1;
            for (int ks = 0; ks < ksN; ++ks) {
                const bf16x8 pf = *(const bf16x8*)(sP + fr * 136 + 32 * ks + 8 * fq);
#pragma unroll
                for (int et = 0; et < 8; ++et) { const bf16x8 vf = *(const bf16x8*)(sVT + (16 * et + fr) * 136 + 32 * ks + 8 * fq); o[et] = mfma16(pf, vf, o[et]); }
            }
            f32x4 o2[8];
#pragma unroll
            for (int et = 0; et < 8; ++et) o2[et] = (f32x4){0.f, 0.f, 0.f, 0.f};
#pragma unroll
            for (int ks = 0; ks < 2; ++ks)
#pragma unroll
                for (int et = 0; et < 8; ++et) { const bf16x8 sf = *(const bf16x8*)(sST + (16 * et + fr) * 72 + 32 * ks + 8 * fq); o2[et] = mfma16(qf[ks], sf, o2[et]); }
#pragma unroll
            for (int j = 0; j < 4; ++j) { const float sc = __expf(lg * (float)(16 * w + 4 * fq + j + 1));
#pragma unroll
                for (int et = 0; et < 8; ++et) o[et][j] += o2[et][j] * sc; }
        }
        {
            const float gC = __expf(lg * (float)C);
#pragma unroll
            for (int dt = 0; dt < 4; ++dt) accS[dt] = accS[dt] * gC;
            const int ksN = (C + 31) >> 5;
            for (int ks = 0; ks < ksN; ++ks) {
                const bf16x8 vf = *(const bf16x8*)(sVT + (16 * w + fr) * 136 + 32 * ks + 8 * fq);
#pragma unroll
                for (int dt = 0; dt < 4; ++dt) { const bf16x8 kf = *(const bf16x8*)(sKdT + (16 * dt + fr) * 136 + 32 * ks + 8 * fq); accS[dt] = mfma16(kf, vf, accS[dt]); }
            }
        }
        __syncthreads();
#pragma unroll
        for (int dt = 0; dt < 4; ++dt) { u32x2 ow; ow.x = pk2(accS[dt][0], accS[dt][1]); ow.y = pk2(accS[dt][2], accS[dt][3]); *(u32x2*)(sST + (16 * w + fr) * 72 + 16 * dt + 4 * fq) = ow; }
        if (act) {
#pragma unroll
            for (int j = 0; j < 4; ++j) {
                float s = 0.f;
#pragma unroll
                for (int et = 0; et < 8; ++et) s += o[et][j];
                s += __shfl_xor(s, 1); s += __shfl_xor(s, 2); s += __shfl_xor(s, 4); s += __shfl_xor(s, 8);
                const float mu = s * (1.0f / 128.0f);
                float s2 = 0.f;
#pragma unroll
                for (int et = 0; et < 8; ++et) { const float d = o[et][j] - mu; s2 += d * d; }
                s2 += __shfl_xor(s2, 1); s2 += __shfl_xor(s2, 2); s2 += __shfl_xor(s2, 4); s2 += __shfl_xor(s2, 8);
                const float rstd = rsqrtf(s2 * (1.0f / 128.0f) + EPS);
                const int n = 16 * w + 4 * fq + j;
                if (n < C) {
                    const size_t row = (size_t)(rowb + t0 + n);
#pragma unroll
                    for (int et = 0; et < 8; ++et) { const int e = 16 * et + fr; const float gcv = bf2f(Z[row * DIN + ZO_GC + h * 128 + e]);
                        const float yv = gcv * sigm(gcv) * (o[et][j] - mu) * rstd * ng[e]; Y[row * LDY + 1536 + h * 128 + e] = f2bf(yv); }
                }
            }
        }
    }
    if (grp ? OUT_ON(12) : OUT_ON(6)) {
#pragma unroll
    for (int dt = 0; dt < 4; ++dt)
#pragma unroll
        for (int j = 0; j < 4; ++j) Sout[(16 * dt + 4 * fq + j) * 128 + 16 * w + fr] = accS[dt][j];
    }
}

__device__ __forceinline__ void lru_job(const Params& P, int l, int grp, int jid, int g0, int pb0, unsigned char* smem) {
    const int tid = otid(), w = __builtin_amdgcn_readfirstlane(tid >> 6), lane = tid & 63, fr = lane & 15, fq = lane >> 4;
    bf16_t* sA = (bf16_t*)(smem + w * 10752);
    float* sRI = (float*)(smem + w * 10752 + 2304);
    float* sComb = (float*)(smem + 8 * 10752);
    const bf16_t* Z = (const bf16_t*)(P.ws + R_Z) - (size_t)g0 * DIN; bf16_t* Y = (bf16_t*)(P.ws + R_Y) - (size_t)g0 * LDY;
    const int unit = grp ? jid * 8 + w : jid;
    const int bl = unit / 12, hb = unit - bl * 12, ch = hb * 64 + lane; const int b = grp ? bl : pb0 + bl;
    const int L = grp ? 4 : LP, rowb = grp ? TPR + b * 4 : b * LP;
    float cw[4];
#pragma unroll
    for (int j = 0; j < 4; ++j) cw[j] = INP(I_LCW)[((size_t)l * 4 + j) * 768 + ch];
    const float cb = INP(I_LCB)[l * 768 + ch], ba = INP(I_LBA)[l * 768 + ch], bx = INP(I_LBX)[l * 768 + ch];
    const float lam = INP(I_LAM)[l * 768 + ch];
    const float sp8 = 8.0f * (fmaxf(-lam, 0.f) + log1pf(__expf(-fabsf(lam))));
    bf16x8 Wa[4][2], Wx[4][2];
    { const float* wa = INP(I_LWA) + ((size_t)l * 12 + hb) * 4096; const float* wx = INP(I_LWX) + ((size_t)l * 12 + hb) * 4096;
#pragma unroll
      for (int nt = 0; nt < 4; ++nt)
#pragma unroll
          for (int ks = 0; ks < 2; ++ks)
#pragma unroll
              for (int j = 0; j < 8; ++j) { const int k = 32 * ks + 8 * fq + j, n = 16 * nt + fr; Wa[nt][ks][j] = (short)f2bf(wa[k * 64 + n]); Wx[nt][ks][j] = (short)f2bf(wx[k * 64 + n]); } }
    float carry = grp ? INP(I_LRUH)[((size_t)l * DEC_B + b) * 768 + ch] : 0.f;
    const float* cache = INP(I_LRUC) + ((size_t)l * DEC_B + b) * 3 * 768;
    const int nIter = grp ? 1 : 17;
    __syncthreads();
    for (int it = 0; it < nIter; ++it) {
        const int tw = grp ? 0 : it * 128 + 16 * w;
        float xv[19];
#pragma unroll
        for (int i = 0; i < 19; ++i) { const int t = tw - 3 + i; float v = 0.f;
            if (t < 0) { if (grp) v = cache[(t + 3) * 768 + ch]; }
            else if (t < L) v = bf2f(Z[(size_t)(rowb + t) * DIN + ZO_XB + ch]);
            xv[i] = v; }
        float xc[16];
#pragma unroll
        for (int i = 0; i < 16; ++i) { xc[i] = cb + cw[0] * xv[i] + cw[1] * xv[i + 1] + cw[2] * xv[i + 2] + cw[3] * xv[i + 3]; sA[i * 72 + lane] = f2bf(xc[i]); }
        lds_wait();
        bf16x8 af[2];
#pragma unroll
        for (int ks = 0; ks < 2; ++ks) af[ks] = *(const bf16x8*)(sA + fr * 72 + 32 * ks + 8 * fq);
#pragma unroll
        for (int nt = 0; nt < 4; ++nt) {
            f32x4 ra = {0.f, 0.f, 0.f, 0.f}, rx = ra;
            ra = mfma16(af[0], Wa[nt][0], ra); ra = mfma16(af[1], Wa[nt][1], ra);
            rx = mfma16(af[0], Wx[nt][0], rx); rx = mfma16(af[1], Wx[nt][1], rx);
#pragma unroll
            for (int j = 0; j < 4; ++j) { sRI[(4 * fq + j) * 132 + 16 * nt + fr] = ra[j]; sRI[(4 * fq + j) * 132 + 64 + 16 * nt + fr] = rx[j]; }
        }
        lds_wait();
        float hloc[16], ca[16]; float hl = 0.f, cacc = 1.f;
#pragma unroll
        for (int i = 0; i < 16; ++i) {
            const float rp = sRI[i * 132 + lane], ip = sRI[i * 132 + 64 + lane];
            const float r = sigm(rp + ba), ii = sigm(ip + bx);
            const float la = -sp8 * r; float a = __expf(la); float bv = sqrtf(-expm1f(2.0f * la)) * ii * xc[i];
            if (tw + i >= L) { a = 1.f; bv = 0.f; }
            hl = a * hl + bv; cacc *= a; hloc[i] = hl; ca[i] = cacc;
        }
        float hin = carry;
        if (!grp) {
            sComb[(w * 64 + lane) * 2] = cacc; sComb[(w * 64 + lane) * 2 + 1] = hl;
            __syncthreads();
            float run = carry;
#pragma unroll
            for (int ww = 0; ww < 8; ++ww) { if (ww == w) hin = run; run = sComb[(ww * 64 + lane) * 2] * run + sComb[(ww * 64 + lane) * 2 + 1]; }
            carry = run;
            __syncthreads();
        } else carry = hloc[15] + ca[15] * hin;
#pragma unroll
        for (int i = 0; i < 16; ++i) { const int t = tw + i;
            if (t < L) { const size_t row = (size_t)(rowb + t); const float hh = hloc[i] + ca[i] * hin; const float gt = bf2f(Z[row * DIN + ZO_GB + ch]); Y[row * LDY + 768 + ch] = f2bf(hh * gelu_t(gt)); } }
    }
    if (grp || w == 0) {
        float* ho = grp ? P.out + O_S_LRUH + ((size_t)l * DEC_B + b) * 768 + ch : P.out + O_P_LRUH + ((size_t)l * NB + b) * 768 + ch;
        if (grp ? OUT_ON(10) : OUT_ON(4)) *ho = carry;
        float* co = grp ? P.out + O_S_LRUC + ((size_t)l * DEC_B + b) * 3 * 768 + ch : P.out + O_P_LRUC + ((size_t)l * NB + b) * 3 * 768 + ch;
#pragma unroll
        for (int j = 0; j < 3; ++j) if (grp ? OUT_ON(11) : OUT_ON(5)) co[j * 768] = bf2f(Z[(size_t)(rowb + L - 3 + j) * DIN + ZO_XB + ch]);
    }
}

__device__ __forceinline__ void s5_job(const Params& P, int l, int grp, int jid, int g0, int pb0, unsigned char* smem) {
    const int tid = otid(), w = __builtin_amdgcn_readfirstlane(tid >> 6), lane = tid & 63, fr = lane & 15, fq = lane >> 4;
    float* sBU = (float*)(smem + w * 12800);
    bf16_t* sH = (bf16_t*)(smem + w * 12800 + 8448);
    const bf16_t* Z = (const bf16_t*)(P.ws + R_Z) - (size_t)g0 * DIN; bf16_t* ZS = (bf16_t*)(P.ws + R_ZS5) - (size_t)g0 * 768;
    const int unit = jid * 8 + w;
    int g, b0, nseq;
    if (grp) { g = unit % 48; b0 = (unit / 48) * 16; nseq = 16; } else { b0 = unit / 48; g = unit - b0 * 48; b0 += pb0; nseq = 1; }
    const int L = grp ? 4 : LP, nIter = grp ? 1 : 129;
    const float dt = __expf(INP(I_LS)[l * 48 + g]);
    float abr = 0.f, abi = 0.f;
    bf16x8 Bf[8];
#pragma unroll
    for (int k = 0; k < 4; ++k) {
        const int p = 16 * k + fr;
        const float lr = INP(I_AR)[((size_t)l * 48 + g) * 64 + p], li = INP(I_AI)[((size_t)l * 48 + g) * 64 + p];
        const float mag = expf(lr * dt), ar_ = mag * cosf(li * dt), ai_ = mag * sinf(li * dt);
        if (k == fq) { abr = ar_; abi = ai_; }
        const float den = lr * lr + li * li, nr = ar_ - 1.0f;
        const float cr = (nr * lr + ai_ * li) / den, ci = (ai_ * lr - nr * li) / den;
        bf16x8 fre, fim;
#pragma unroll
        for (int j = 0; j < 8; ++j) { fre[j] = 0; fim[j] = 0; }
        if (fq < 2) {
            const float* bre = INP(I_BR) + (((size_t)l * 48 + g) * 64 + p) * 16 + 8 * fq; const float* bim = INP(I_BI) + (((size_t)l * 48 + g) * 64 + p) * 16 + 8 * fq;
#pragma unroll
            for (int j = 0; j < 8; ++j) { const float br_ = bre[j], bi_ = bim[j]; fre[j] = (short)f2bf(cr * br_ - ci * bi_); fim[j] = (short)f2bf(cr * bi_ + ci * br_); }
        }
        Bf[k] = fre; Bf[4 + k] = fim;
    }
    bf16x8 Cf[4];
#pragma unroll
    for (int ks = 0; ks < 4; ++ks) {
        const float* cp = (ks < 2 ? INP(I_CR) : INP(I_CI)) + (((size_t)l * 48 + g) * 16 + fr) * 64 + 32 * (ks & 1) + 8 * fq;
        const float sg = ks < 2 ? 1.0f : -1.0f;
#pragma unroll
        for (int j = 0; j < 8; ++j) Cf[ks][j] = (short)f2bf(sg * cp[j]);
    }
    const float dsk = INP(I_D)[l * 768 + g * 16 + fr];
    __syncthreads();
    for (int s = 0; s < nseq; ++s) {
        const int b = b0 + s;
        const int rowb = grp ? TPR + b * 4 : b * LP;
        float hr = 0.f, hi = 0.f;
        if (grp) { hr = INP(I_S5RE)[(((size_t)l * DEC_B + b) * 48 + g) * 64 + lane]; hi = INP(I_S5IM)[(((size_t)l * DEC_B + b) * 48 + g) * 64 + lane]; }
        for (int it = 0; it < nIter; ++it) {
            const int t0 = it * 16; const int valid = (L - t0) < 16 ? (L - t0) : 16;
            bf16x8 uf;
            { u32x4 v = {0u, 0u, 0u, 0u};
              if (fq < 2 && fr < valid) v = *(const u32x4*)(Z + (size_t)(rowb + t0 + fr) * DIN + ZO_UA + g * 16 + 8 * fq);
              uf = __builtin_bit_cast(bf16x8, v); }
#pragma unroll
            for (int nt = 0; nt < 8; ++nt) { f32x4 a = {0.f, 0.f, 0.f, 0.f}; a = mfma16(uf, Bf[nt], a);
#pragma unroll
                for (int j = 0; j < 4; ++j) sBU[(4 * fq + j) * 132 + 16 * nt + fr] = a[j]; }
            lds_wait();
#pragma unroll
            for (int i = 0; i < 16; ++i) {
                float bur = sBU[i * 132 + lane], bui = sBU[i * 132 + 64 + lane];
                asm volatile("" : "+v"(bur), "+v"(bui));
                const float msk = (i < valid) ? 1.0f : 0.0f;
                float nr = __builtin_fmaf(abr, hr, bur); asm volatile("" : "+v"(nr));
                nr = __builtin_fmaf(-abi, hi, nr); asm volatile("" : "+v"(nr));
                float ni = __builtin_fmaf(abr, hi, bui); asm volatile("" : "+v"(ni));
                ni = __builtin_fmaf(abi, hr, ni); asm volatile("" : "+v"(ni));
                hr = __builtin_fmaf(msk, nr - hr, hr); hi = __builtin_fmaf(msk, ni - hi, hi);
                asm volatile("" : "+v"(hr), "+v"(hi));
                sH[i * 136 + lane] = f2bf(hr); sH[i * 136 + 64 + lane] = f2bf(hi);
            }
            lds_wait();
            f32x4 y = {0.f, 0.f, 0.f, 0.f};
#pragma unroll
            for (int ks = 0; ks < 4; ++ks) { const bf16x8 hf = *(const bf16x8*)(sH + fr * 136 + 32 * ks + 8 * fq); y = mfma16(hf, Cf[ks], y); }
#pragma unroll
            for (int j = 0; j < 4; ++j) { const int t = 4 * fq + j;
                if (t < valid) { const size_t row = (size_t)(rowb + t0 + t); const float u = bf2f(Z[row * DIN + ZO_UA + g * 16 + fr]); ZS[row * 768 + g * 16 + fr] = f2bf(gelu_t(y[j] + dsk * u)); } }
            lds_wait();
        }
        float* ore = grp ? P.out + O_S_S5RE + (((size_t)l * DEC_B + b) * 48 + g) * 64 + lane : P.out + O_P_S5RE + (((size_t)l * NB + b) * 48 + g) * 64 + lane;
        float* oim = grp ? P.out + O_S_S5IM + (((size_t)l * DEC_B + b) * 48 + g) * 64 + lane : P.out + O_P_S5IM + (((size_t)l * NB + b) * 48 + g) * 64 + lane;
        if ((grp ? OUT_ON(8) : OUT_ON(2)) && b < OUT_BMAX) *ore = hr;
        if ((grp ? OUT_ON(9) : OUT_ON(3)) && b < OUT_BMAX) *oim = hi;
    }
}

__device__ __forceinline__ void mixers_phase(const Params& P, int l, int rg, unsigned char* smem) {
    const Grp G = get_grp(rg);
    const int j1 = G.npb * 8, j2 = j1 + G.npb * 12, j3 = j2 + G.npb * 6, j4 = j3 + (G.hasS ? 1024 : 0), j5 = j4 + (G.hasS ? 48 : 0), NJ = j5 + (G.hasS ? 192 : 0);
    unsigned* ctr = (unsigned*)(P.ws + A_CTR) + (l * NGRP + rg);
    int* slot = (int*)(smem + LDS_BYTES - 16);
#ifndef STATIC_JOBS
#define STATIC_JOBS 1
#endif
    for (int jj = blockIdx.x;; jj += gridDim.x) {
        __syncthreads();
#if STATIC_JOBS
        const int j = jj; (void)ctr; (void)slot;
#else
        if (threadIdx.x == 0) *slot = (int)atomicAdd(ctr, 1u);
        __syncthreads();
        const int j = *slot;
#endif
        if (j >= NJ) break;
        int type, sg, idx;
        if (j < j1) { type = 0; sg = 0; idx = j; }
        else if (j < j2) { type = 1; sg = 0; idx = j - j1; }
        else if (j < j3) { type = 2; sg = 0; idx = j - j2; }
        else if (j < j4) { type = 0; sg = 1; idx = j - j3; }
        else if (j < j5) { type = 2; sg = 1; idx = j - j4; }
        else { type = 1; sg = 1; idx = j - j5; }
        if (type == 0) ret_job(P, l, sg, (idx >> 3) + (sg ? 0 : G.pb0), idx & 7, G.g0, smem);
        else if (type == 1) lru_job(P, l, sg, idx, G.g0, G.pb0, smem);
        else s5_job(P, l, sg, idx, G.g0, G.pb0, smem);
    }
}

__device__ __forceinline__ void run_phase(const Params& P, int ph, unsigned char* smem) {
#ifndef PHSEL
#define PHSEL -1
#endif
#define PSEL(x) (PHSEL < 0 || PHSEL == (x))
    if (ph == 0) { if (PSEL(10)) phase0(P, smem); return; }
    const int l = (ph - 1) / (10 * NGRP), rg = ((ph - 1) / 10) % NGRP, s = (ph - 1) % 10;
    LAS unsigned char* lds = (LAS unsigned char*)smem;
    unsigned char* ws = P.ws;
    using namespace pg8;
    const int G = gridDim.x, c = blockIdx.x;
    const int npan = rg < 2 ? 25 : 19;
    switch (s) {
    case 0: if (PSEL(0)) { Gemm g{(const bf16_t*)(ws + R_H), (const bf16_t*)(ws + W_IN) + (size_t)l * DIN * DM, DM, DM, npan, DIN / 256, DM / 64};
              Sched<1> S; S.init(g.nM, g.nN, G, c, g.nt); EpiBf E{(bf16_t*)(ws + R_Z), DIN}; gemm_run(lds, g, S, E); } break;
    case 1: if (PSEL(1)) mixers_phase(P, l, rg, smem); break;
    case 2: if (PSEL(2)) { Gemm g{(const bf16_t*)(ws + R_ZS5), (const bf16_t*)(ws + W_GLU) + (size_t)l * 768 * 768, 768, 768, npan, 3, 12};
              Sched<1> S; S.init(g.nM, g.nN, G, c, g.nt); EpiGlu E{(bf16_t*)(ws + R_Y), (const bf16_t*)(ws + R_ZS5), INP(I_BGLU) + l * 768}; gemm_run(lds, g, S, E); } break;
    case 3: if (PSEL(3)) { Gemm g{(const bf16_t*)(ws + R_Y), (const bf16_t*)(ws + W_BR) + (size_t)l * DM * LDY, LDY, LDY, npan, 4, 0};
              Sched<3> S; S.init(g.nM, g.nN, G, c, 0); EpiBranch E{(const bf16_t*)(ws + R_Z) + ZO_GATE, (bf16_t*)(ws + R_M)}; gemm_run(lds, g, S, E); } break;
    case 4: if (PSEL(4)) { Gemm g{(const bf16_t*)(ws + R_M), (const bf16_t*)(ws + W_OUT) + (size_t)l * DM * DM, DM, DM, npan, 4, 16};
              Sched<1> S; S.init(g.nM, g.nN, G, c, g.nt); EpiF32 E{(float*)(ws + R_F), DM}; gemm_run(lds, g, S, E); } break;
    case 5: if (PSEL(5)) norm_rows(P, 1, l, rg, smem); break;
    case 6: if (PSEL(6)) { Gemm g{(const bf16_t*)(ws + R_H), (const bf16_t*)(ws + W_UP) + (size_t)l * 2 * DFF * DM, DM, DM, npan, 22, 16};
              Sched<1> S; S.init(g.nM, g.nN, G, c, g.nt); EpiBf E{(bf16_t*)(ws + R_UP), 2 * DFF}; gemm_run(lds, g, S, E); } break;
    case 7: if (PSEL(7)) ffn_conv_phase(P, l, rg, smem); break;
    case 8: if (PSEL(8)) { Gemm g{(const bf16_t*)(ws + R_FIN), (const bf16_t*)(ws + W_DOWN) + (size_t)l * DM * DFF, DFF, DFF, npan, 4, 44};
              Sched<1> S; S.init(g.nM, g.nN, G, c, g.nt); EpiF32 E{(float*)(ws + R_F), DM}; gemm_run(lds, g, S, E); } break;
    default: if (PSEL(9)) norm_rows(P, 2, l, rg, smem); break;
    }
}

__global__ void __launch_bounds__(512, 2) mega(Params P, int ph_lo, int ph_hi) {
    extern __shared__ __attribute__((aligned(16))) unsigned char smem[];
    if (threadIdx.x == 0) {
        const float** tab = (const float**)(smem + PTAB_OFF);
#pragma unroll
        for (int i = 0; i < N_IN; ++i) tab[i] = P.in[i];
    }
    __syncthreads();
    for (int ph = ph_lo; ph < ph_hi; ++ph) {
        run_phase(P, ph, smem);
        if (ph + 1 < ph_hi) cg::this_grid().sync();
    }
}


#ifndef DBG_STOP
#define DBG_STOP 0
#endif
#ifndef DBG_OFF
#define DBG_OFF R_Z
#endif
__global__ void dbg_dump(const unsigned char* ws, float* out, size_t n) {
    const bf16_t* src = (const bf16_t*)(ws + DBG_OFF);
    for (size_t i = (size_t)blockIdx.x * blockDim.x + threadIdx.x; i < n; i += (size_t)gridDim.x * blockDim.x) out[i] = bf2f(src[i]);
}

extern "C" void kernel_launch(void* const* d_in, const int* in_sizes, int n_in, void* d_out, int out_size, void* d_ws, size_t ws_size, hipStream_t stream) {
    (void)in_sizes; (void)n_in; (void)out_size;
    if (ws_size < WS_TOTAL) { fprintf(stderr, "workspace too small: %zu < %zu\n", ws_size, (size_t)WS_TOTAL); return; }
    Params p{};
    for (int i = 0; i < N_IN; ++i) p.in[i] = (const float*)d_in[i];
    p.out = (float*)d_out; p.ws = (unsigned char*)d_ws;
    hipFuncSetAttribute((const void*)mega, hipFuncAttributeMaxDynamicSharedMemorySize, LDS_BYTES);
    int dev = 0, cus = 256, per_cu = 1;
    hipGetDevice(&dev);
    hipDeviceGetAttribute(&cus, hipDeviceAttributeMultiprocessorCount, dev);
    hipOccupancyMaxActiveBlocksPerMultiprocessor(&per_cu, mega, 512, LDS_BYTES);
    if (per_cu < 1) per_cu = 1;
    const int grid = cus * 1;
#if COOP
#ifndef PH_HI
#define PH_HI NPHASE
#endif
    int lo = 0, hi = PH_HI;
    void* args[] = {&p, &lo, &hi};
    hipError_t e = hipLaunchCooperativeKernel((void*)mega, dim3(grid), dim3(512), args, LDS_BYTES, stream);
    if (e != hipSuccess) fprintf(stderr, "cooperative launch failed: %s (grid %d)\n", hipGetErrorString(e), grid);
#else
#if DBG_STOP
    for (int ph = 0; ph < DBG_STOP; ++ph) hipLaunchKernelGGL(mega, dim3(grid), dim3(512), LDS_BYTES, stream, p, ph, ph + 1);
#ifdef DBG_EXTRA
    hipLaunchKernelGGL(mega, dim3(grid), dim3(512), LDS_BYTES, stream, p, DBG_EXTRA, DBG_EXTRA + 1);
#endif
    hipLaunchKernelGGL(dbg_dump, dim3(2048), dim3(256), 0, stream, (const unsigned char*)d_ws, (float*)d_out, (size_t)34873344);
#else
    for (int ph = 0; ph < NPHASE; ++ph) hipLaunchKernelGGL(mega, dim3(grid), dim3(512), LDS_BYTES, stream, p, ph, ph + 1);
#endif
#endif
}
```

```cpp
#include <hip/hip_runtime.h>
#include <hip/hip_cooperative_groups.h>
#include <cstdio>
namespace cg = cooperative_groups;

#define DUP_MASK 0
#ifndef COOP
#define COOP 1
#endif
#ifndef OUTMASK
#define OUTMASK 0x3FFF
#endif
#ifndef OUT_BMAX
#define OUT_BMAX 1000
#endif
#ifndef OUT_L
#define OUT_L 3
#endif
#define OUT_ON(k) (((OUTMASK >> (k)) & 1) && ((OUT_L >> l) & 1))
#ifndef DMA_AUX
#define DMA_AUX 17
#endif

#define LAS __attribute__((address_space(3)))
typedef unsigned short bf16_t;
typedef short bf16x8 __attribute__((ext_vector_type(8)));
typedef float f32x4 __attribute__((ext_vector_type(4)));
typedef unsigned u32x4 __attribute__((ext_vector_type(4)));
typedef unsigned u32x2 __attribute__((ext_vector_type(2)));

constexpr int DM = 1024, NB = 8, SEQ = 2048, LP = 2064, DEC_B = 128, DEC_S = 4;
constexpr int TPR = NB * LP;
constexpr int TT = TPR + DEC_B * DEC_S;
constexpr int TPAD = 17152;
constexpr int DIN = 8448, DFF = 2816;
constexpr int ZO_UA = 0, ZO_XB = 768, ZO_GB = 1536, ZO_Q = 2304, ZO_K = 2816, ZO_V = 3328, ZO_GC = 4352, ZO_GATE = 5376;
constexpr int LDY = 2560;
constexpr float EPS = 1e-6f;
constexpr int LDS_BYTES = 143360;

enum { I_XP = 0, I_XS, I_S5RE, I_S5IM, I_LRUH, I_LRUC, I_RET, I_FFNC, I_META, I_GPREMIX, I_GPOSTMIX, I_GPREFFN, I_GPOSTFFN, I_WIN,
       I_AR, I_AI, I_LS, I_BR, I_BI, I_CR, I_CI, I_D, I_WGLU, I_BGLU, I_LCW, I_LCB, I_LWA, I_LBA, I_LWX, I_LBX, I_LAM, I_RNG,
       I_WBA, I_WBB, I_WBC, I_WOUT, I_WUP, I_FCW, I_FCB, I_WDOWN, N_IN };

constexpr size_t O_YP = 0;
constexpr size_t O_YS = O_YP + (size_t)NB * SEQ * DM;
constexpr size_t O_P_S5RE = O_YS + (size_t)DEC_B * DEC_S * DM;
constexpr size_t O_P_S5IM = O_P_S5RE + 2 * NB * 48 * 64;
constexpr size_t O_P_LRUH = O_P_S5IM + 2 * NB * 48 * 64;
constexpr size_t O_P_LRUC = O_P_LRUH + 2 * NB * 768;
constexpr size_t O_P_RET = O_P_LRUC + 2 * NB * 3 * 768;
constexpr size_t O_P_FFNC = O_P_RET + (size_t)2 * NB * 8 * 64 * 128;
constexpr size_t O_S_S5RE = O_P_FFNC + 2 * NB * 2 * DFF;
constexpr size_t O_S_S5IM = O_S_S5RE + 2 * DEC_B * 48 * 64;
constexpr size_t O_S_LRUH = O_S_S5IM + 2 * DEC_B * 48 * 64;
constexpr size_t O_S_LRUC = O_S_LRUH + 2 * DEC_B * 768;
constexpr size_t O_S_RET = O_S_LRUC + 2 * DEC_B * 3 * 768;
constexpr size_t O_S_FFNC = O_S_RET + (size_t)2 * DEC_B * 8 * 64 * 128;

constexpr size_t al256(size_t x) { return (x + 255) & ~(size_t)255; }
constexpr size_t W_IN = 0;
constexpr size_t W_GLU = W_IN + (size_t)2 * DIN * DM * 2;
constexpr size_t W_BR = W_GLU + (size_t)2 * 768 * 768 * 2;
constexpr size_t W_OUT = W_BR + (size_t)2 * DM * LDY * 2;
constexpr size_t W_UP = W_OUT + (size_t)2 * DM * DM * 2;
constexpr size_t W_DOWN = W_UP + (size_t)2 * 2 * DFF * DM * 2;
constexpr size_t A_X = W_DOWN + (size_t)2 * DM * DFF * 2;
constexpr int GR = 6400;
constexpr size_t R_Z = A_X + (size_t)TPAD * DM * 4;
constexpr size_t R_ZS5 = R_Z + (size_t)GR * DIN * 2;
constexpr size_t R_Y = R_ZS5 + (size_t)GR * 768 * 2;
constexpr size_t R_M = R_Y + (size_t)GR * LDY * 2;
constexpr size_t R_END = R_M + (size_t)GR * DM * 2;
constexpr size_t R_H = R_M;
constexpr size_t R_F = R_Z;
constexpr size_t R_UP = R_Z + (size_t)GR * DM * 4;
constexpr size_t R_FIN = R_ZS5;
static_assert(R_UP + (size_t)GR * 2 * DFF * 2 <= R_ZS5, "UP inside Z");
static_assert(R_FIN + (size_t)GR * DFF * 2 <= R_M, "FIN inside ZS5|Y");
constexpr size_t A_ROPE = R_END;
constexpr size_t A_CTR = al256(A_ROPE + (size_t)2068 * 64 * 4);
constexpr size_t A_BAR = A_CTR + 4096;
constexpr size_t WS_TOTAL = A_BAR + 16384;
constexpr int NGRP = 3;
constexpr int NPHASE = 1 + 2 * NGRP * 10;

struct Grp { int g0, nrows, npan, pb0, npb, hasS; };
__device__ __forceinline__ Grp get_grp(int g) {
    Grp r; r.g0 = g * 6192; r.nrows = g < 2 ? 6192 : 4640; r.npan = g < 2 ? 25 : 19; r.pb0 = g * 3; r.npb = g < 2 ? 3 : 2; r.hasS = g == 2; return r;
}

struct Params {
    const float* in[N_IN];
    float* out;
    unsigned char* ws;
};


constexpr int PTAB_OFF = 142336;
__device__ __forceinline__ const float* ldin(const unsigned char* smem, int i) {
    const unsigned long long v = ((const unsigned long long*)(smem + PTAB_OFF))[i];
    const unsigned lo = __builtin_amdgcn_readfirstlane((unsigned)v), hi = __builtin_amdgcn_readfirstlane((unsigned)(v >> 32));
    return (const float*)(((unsigned long long)hi << 32) | lo);
}
#define INP(i) ldin(smem, (i))
__device__ __forceinline__ int otid() { int t = threadIdx.x; asm volatile("" : "+v"(t)); return t; }

__device__ __forceinline__ float bf2f(bf16_t b) { return __uint_as_float(((unsigned)b) << 16); }
__device__ __forceinline__ bf16_t f2bf(float f) { unsigned u = __float_as_uint(f); u += 0x7FFFu + ((u >> 16) & 1u); return (bf16_t)(u >> 16); }
__device__ __forceinline__ unsigned pk2(float lo, float hi) { return (unsigned)f2bf(lo) | ((unsigned)f2bf(hi) << 16); }
__device__ __forceinline__ float sigm(float x) { return __frcp_rn(1.0f + __expf(-x)); }
__device__ __forceinline__ float gelu_t(float x) { const float v = 1.5957691216f * (x + 0.044715f * x * x * x); return x * __frcp_rn(1.0f + __expf(-v)); }
__device__ __forceinline__ void lds_wait() { asm volatile("s_waitcnt lgkmcnt(0)" ::: "memory"); __builtin_amdgcn_wave_barrier(); }
__device__ __forceinline__ f32x4 mfma16(bf16x8 a, bf16x8 b, f32x4 c) { return __builtin_amdgcn_mfma_f32_16x16x32_bf16(a, b, c, 0, 0, 0); }

namespace pg8 {
constexpr int BM = 256, BK = 64, HALF = 128, HTB = HALF * BK * 2, STAGE_BYTES = 8 * HTB, NXCD = 8, WGM = 8;
__device__ __forceinline__ int lds_byte(int r, int c) { const int st = (r >> 4) * 2 + (c >> 5), rr = r & 15, cc = c & 31, ob = rr * 64 + cc * 2; return st * 1024 + (ob ^ (((ob >> 9) & 1) << 5)); }
__device__ __forceinline__ void stage_rc(int b, int& R, int& C) { const int st = b / 1024, sb = b % 1024, swz = sb ^ (((sb >> 9) & 1) << 5); R = (st >> 1) * 16 + swz / 64; C = (st & 1) * 32 + (swz % 64) / 2; }

struct Unit { int pm, pn, br; };
struct Gemm { const bf16_t* A; const bf16_t* Bt; int lda, ldb, nM, nN, nt; };

template <int NBR> struct Sched {
    int nM, nN, nwg, G, c, nt0;
    __device__ void init(int nM_, int nN_, int G_, int c_, int nt_) { nM = nM_; nN = nN_; nwg = nM * nN; G = G_; c = c_; nt0 = nt_; }
    __device__ bool next(int i, Unit& u) const {
        const int ti = i / NBR; u.br = i - ti * NBR;
        const long L = (long)ti * G + c; if (L >= nwg) return false;
        int wgid = (int)L; { const int q = nwg / NXCD, r = nwg % NXCD, xcd = wgid % NXCD, off = wgid / NXCD; wgid = (xcd < r ? xcd * (q + 1) : r * (q + 1) + (xcd - r) * q) + off; }
        const int nig = WGM * nN, gid = wgid / nig, fm = gid * WGM, gsz = (nM - fm) < WGM ? (nM - fm) : WGM;
        u.pm = fm + ((wgid % nig) % gsz); u.pn = (wgid % nig) / gsz; return true;
    }
    __device__ __forceinline__ void kr(const Unit& u, size_t& koffB, int& nt) const {
        if (NBR == 1) { koffB = 0; nt = nt0; }
        else { koffB = (size_t)u.br * 1536; nt = (u.br == 2) ? 16 : 12; }
    }
};

__device__ __forceinline__ unsigned cvt_pk_bf16(float lo, float hi) { unsigned r; asm volatile("v_cvt_pk_bf16_f32 %0, %1, %2" : "=v"(r) : "v"(lo), "v"(hi)); return r; }

template <class Epi, class SchedT>
__device__ __forceinline__ void gemm_phase(LAS unsigned char* lds, const Gemm g, const SchedT& S, const Epi& E) {
    const int tid = otid(), wid = __builtin_amdgcn_readfirstlane(tid >> 6), lane = tid & 63, wr = wid >> 2, wc = wid & 3, fr = lane & 15, fq = lane >> 4;
    unsigned voffA[2], voffB[2];
#pragma unroll
    for (int i = 0; i < 2; ++i) { int R, C; stage_rc(tid * 16 + i * 8192, R, C);
        voffA[i] = (unsigned)(R * g.lda + C) * 2u; voffB[i] = (unsigned)(R * g.ldb + C) * 2u; }
    const size_t kstep = (size_t)(BK * 2);
    const size_t hstepA = (size_t)HALF * g.lda * 2, hstepB = (size_t)HALF * g.ldb * 2;
    const size_t tstepA = 2 * hstepA, tstepB = 2 * hstepB;
    const unsigned ldsw = (unsigned)wid * 1024u;
    const int aoff = lds_byte(wr * 64 + fr, fq * 8), boff = lds_byte(wc * 32 + fr, fq * 8);
#define PG8_SA(b, h) (((b) * 2 + (h)) * HTB)
#define PG8_SB(b, h) ((4 + (b) * 2 + (h)) * HTB)
#define PG8_STAGE(bufoff, gbase, voff) do { _Pragma("unroll") for (int _i = 0; _i < 2; ++_i) \
        __builtin_amdgcn_global_load_lds((const unsigned*)((const char*)(gbase) + (voff)[_i]), (LAS unsigned*)(lds + (bufoff) + ldsw + _i * 8192), 16, 0, DMA_AUX); } while (0)
#define PG8_LDA(dst, b, h) do { _Pragma("unroll") for (int m = 0; m < 4; ++m) _Pragma("unroll") for (int k = 0; k < 2; ++k) dst[m][k] = *(const LAS bf16x8*)(lds + PG8_SA(b, h) + aoff + m * 2048 + k * 1024); } while (0)
#define PG8_LDB(dst, b, h) do { _Pragma("unroll") for (int n = 0; n < 2; ++n) _Pragma("unroll") for (int k = 0; k < 2; ++k) dst[n][k] = *(const LAS bf16x8*)(lds + PG8_SB(b, h) + boff + n * 2048 + k * 1024); } while (0)
#define PG8_MMA(ai, bj, At, Bt) do { __builtin_amdgcn_s_setprio(1); _Pragma("unroll") for (int m = 0; m < 4; ++m) _Pragma("unroll") for (int n = 0; n < 2; ++n) _Pragma("unroll") for (int k = 0; k < 2; ++k) \
        acc[ai][bj][m][n] = __builtin_amdgcn_mfma_f32_16x16x32_bf16(Bt[n][k], At[m][k], acc[ai][bj][m][n], 0, 0, 0); __builtin_amdgcn_s_setprio(0); } while (0)
#define PG8_WAIT_V(n) asm volatile("s_waitcnt vmcnt(" #n ")" ::: "memory")
#define PG8_WAIT_L(n) asm volatile("s_waitcnt lgkmcnt(" #n ")" ::: "memory")
#define PG8_BAR __builtin_amdgcn_s_barrier()
#define PG8_SCHED __builtin_amdgcn_sched_barrier(0)
    Unit cur, nxt; int ui = 0;
    if (!S.next(0, cur)) return;
    f32x4 acc[2][2][4][2];
#pragma unroll
    for (int a = 0; a < 2; ++a)
#pragma unroll
        for (int b = 0; b < 2; ++b)
#pragma unroll
            for (int m = 0; m < 4; ++m)
#pragma unroll
                for (int n = 0; n < 2; ++n) acc[a][b][m][n] = (f32x4){0.f, 0.f, 0.f, 0.f};
    bf16x8 At[4][2], B0[2][2], B1[2][2];
    size_t koc; int ntc; S.kr(cur, koc, ntc);
    const char* cA = (const char*)g.A + (size_t)cur.pm * tstepA + koc; const char* cB = (const char*)g.Bt + (size_t)cur.pn * tstepB + koc;
    PG8_STAGE(PG8_SB(0, 0), cB, voffB); PG8_STAGE(PG8_SA(0, 0), cA, voffA); PG8_STAGE(PG8_SB(0, 1), cB + hstepB, voffB); PG8_STAGE(PG8_SA(0, 1), cA + hstepA, voffA);
    if (wr == 1) PG8_BAR;
    PG8_WAIT_V(4); PG8_BAR;
    PG8_STAGE(PG8_SB(1, 0), cB + kstep, voffB); PG8_STAGE(PG8_SA(1, 0), cA + kstep, voffA); PG8_STAGE(PG8_SB(1, 1), cB + hstepB + kstep, voffB);
    PG8_WAIT_V(6); PG8_BAR;
    for (;;) {
        const bool has_next = S.next(ui + 1, nxt);
        size_t kon = 0; int ntn = ntc; if (has_next) S.kr(nxt, kon, ntn);
        const char* nA = has_next ? (const char*)g.A + (size_t)nxt.pm * tstepA + kon : cA; const char* nB = has_next ? (const char*)g.Bt + (size_t)nxt.pn * tstepB + kon : cB;
        for (int t = 0; t < ntc; t += 2) {
            const bool last = (t == ntc - 2);
            const char* a1 = cA + (size_t)(t + 1) * kstep;
            const char* a2 = last ? nA : cA + (size_t)(t + 2) * kstep; const char* b2 = last ? nB : cB + (size_t)(t + 2) * kstep;
            const char* a3 = a2 + kstep; const char* b3 = b2 + kstep;
            PG8_LDB(B0, 0, 0); PG8_SCHED; PG8_LDA(At, 0, 0); PG8_STAGE(PG8_SA(1, 1), a1 + hstepA, voffA);
            PG8_WAIT_L(8); PG8_BAR; PG8_WAIT_L(0); PG8_MMA(0, 0, At, B0); PG8_BAR; PG8_SCHED;
            PG8_LDB(B1, 0, 1); PG8_STAGE(PG8_SB(0, 0), b2, voffB);
            PG8_BAR; PG8_WAIT_L(0); PG8_MMA(0, 1, At, B1); PG8_BAR;
            PG8_LDA(At, 0, 1); PG8_STAGE(PG8_SA(0, 0), a2, voffA);
            PG8_BAR; PG8_WAIT_L(0); PG8_MMA(1, 0, At, B0); PG8_BAR; PG8_SCHED;
            PG8_STAGE(PG8_SB(0, 1), b2 + hstepB, voffB);
            PG8_WAIT_V(6); PG8_BAR; PG8_MMA(1, 1, At, B1); PG8_BAR;
            PG8_LDB(B0, 1, 0); PG8_SCHED; PG8_LDA(At, 1, 0); PG8_STAGE(PG8_SA(0, 1), a2 + hstepA, voffA);
            PG8_WAIT_L(8); PG8_BAR; PG8_WAIT_L(0); PG8_MMA(0, 0, At, B0); PG8_BAR; PG8_SCHED;
            PG8_LDB(B1, 1, 1); PG8_STAGE(PG8_SB(1, 0), b3, voffB);
            PG8_BAR; PG8_WAIT_L(0); PG8_MMA(0, 1, At, B1); PG8_BAR;
            PG8_LDA(At, 1, 1); PG8_STAGE(PG8_SA(1, 0), a3, voffA);
            PG8_BAR; PG8_WAIT_L(0); PG8_MMA(1, 0, At, B0); PG8_BAR; PG8_SCHED;
            PG8_STAGE(PG8_SB(1, 1), b3 + hstepB, voffB);
            PG8_WAIT_V(6); PG8_BAR; PG8_MMA(1, 1, At, B1); PG8_BAR;
        }
        E(acc, cur, wr, wc, fr, fq);
        if (!has_next) break;
#pragma unroll
        for (int a = 0; a < 2; ++a)
#pragma unroll
            for (int b = 0; b < 2; ++b)
#pragma unroll
                for (int m = 0; m < 4; ++m)
#pragma unroll
                    for (int n = 0; n < 2; ++n) acc[a][b][m][n] = (f32x4){0.f, 0.f, 0.f, 0.f};
        cur = nxt; cA = nA; cB = nB; ntc = ntn; ++ui;
    }
    PG8_WAIT_V(0);
    if (wr == 0) PG8_BAR;
    PG8_BAR;
#undef PG8_SA
#undef PG8_SB
#undef PG8_STAGE
#undef PG8_LDA
#undef PG8_LDB
#undef PG8_MMA
#undef PG8_WAIT_V
#undef PG8_WAIT_L
#undef PG8_BAR
#undef PG8_SCHED
}

struct EpiBf {
    bf16_t* O; int ldc;
    __device__ __forceinline__ void operator()(const f32x4 (&acc)[2][2][4][2], const Unit& u, int wr, int wc, int fr, int fq) const {
        const int row0 = u.pm * BM + wr * 64 + fr, col0 = u.pn * BM + wc * 32 + 4 * fq;
#pragma unroll
        for (int ai = 0; ai < 2; ++ai)
#pragma unroll
            for (int m = 0; m < 4; ++m) { bf16_t* rowp = O + (size_t)(row0 + ai * HALF + m * 16) * ldc + col0;
#pragma unroll
                for (int bj = 0; bj < 2; ++bj)
#pragma unroll
                    for (int n = 0; n < 2; ++n) { const f32x4 v = acc[ai][bj][m][n]; u32x2 o; o.x = cvt_pk_bf16(v[0], v[1]); o.y = cvt_pk_bf16(v[2], v[3]); *(u32x2*)(rowp + bj * HALF + n * 16) = o; } }
    }
};
struct EpiF32 {
    float* C; int ldc;
    __device__ __forceinline__ void operator()(const f32x4 (&acc)[2][2][4][2], const Unit& u, int wr, int wc, int fr, int fq) const {
        const int row0 = u.pm * BM + wr * 64 + fr, col0 = u.pn * BM + wc * 32 + 4 * fq;
#pragma unroll
        for (int ai = 0; ai < 2; ++ai)
#pragma unroll
            for (int m = 0; m < 4; ++m) { float* rowp = C + (size_t)(row0 + ai * HALF + m * 16) * ldc + col0;
#pragma unroll
                for (int bj = 0; bj < 2; ++bj)
#pragma unroll
                    for (int n = 0; n < 2; ++n) *(f32x4*)(rowp + bj * HALF + n * 16) = acc[ai][bj][m][n]; }
    }
};
struct EpiGlu {
    bf16_t* Y; const bf16_t* Z; const float* bias;
    __device__ __forceinline__ void operator()(const f32x4 (&acc)[2][2][4][2], const Unit& u, int wr, int wc, int fr, int fq) const {
        const int row0 = u.pm * BM + wr * 64 + fr, col0 = u.pn * BM + wc * 32 + 4 * fq;
#pragma unroll
        for (int ai = 0; ai < 2; ++ai)
#pragma unroll
            for (int m = 0; m < 4; ++m) { const size_t r = (size_t)(row0 + ai * HALF + m * 16);
#pragma unroll
                for (int bj = 0; bj < 2; ++bj)
#pragma unroll
                    for (int n = 0; n < 2; ++n) { const int c = col0 + bj * HALF + n * 16; const f32x4 v = acc[ai][bj][m][n];
                        const u32x2 zz = *(const u32x2*)(Z + r * 768 + c); const f32x4 bb = *(const f32x4*)(bias + c);
                        const float z0 = __uint_as_float(zz.x << 16), z1 = __uint_as_float(zz.x & 0xffff0000u), z2 = __uint_as_float(zz.y << 16), z3 = __uint_as_float(zz.y & 0xffff0000u);
                        u32x2 o; o.x = cvt_pk_bf16(z0 * sigm(v[0] + bb[0]), z1 * sigm(v[1] + bb[1])); o.y = cvt_pk_bf16(z2 * sigm(v[2] + bb[2]), z3 * sigm(v[3] + bb[3]));
                        *(u32x2*)(Y + r * LDY + c) = o; } }
    }
};
struct EpiBranch {
    const bf16_t* Zg; bf16_t* Mo;
    __device__ __forceinline__ void operator()(const f32x4 (&acc)[2][2][4][2], const Unit& u, int wr, int wc, int fr, int fq) const {
        const int row0 = u.pm * BM + wr * 64 + fr, col0 = u.pn * BM + wc * 32 + 4 * fq; const int br = u.br;
#pragma unroll
        for (int ai = 0; ai < 2; ++ai)
#pragma unroll
            for (int m = 0; m < 4; ++m) { const size_t r = (size_t)(row0 + ai * HALF + m * 16);
#pragma unroll
                for (int bj = 0; bj < 2; ++bj)
#pragma unroll
                    for (int n = 0; n < 2; ++n) { const int c = col0 + bj * HALF + n * 16; const f32x4 v = acc[ai][bj][m][n];
                        const u32x2 gg = *(const u32x2*)(Zg + r * DIN + br * 1024 + c);
                        f32x4 t; t[0] = v[0] * sigm(__uint_as_float(gg.x << 16)); t[1] = v[1] * sigm(__uint_as_float(gg.x & 0xffff0000u));
                        t[2] = v[2] * sigm(__uint_as_float(gg.y << 16)); t[3] = v[3] * sigm(__uint_as_float(gg.y & 0xffff0000u));
                        bf16_t* mp = Mo + r * DM + c;
                        if (br != 0) { u32x2 p; p.x = __hip_atomic_load((const unsigned*)mp, __ATOMIC_RELAXED, __HIP_MEMORY_SCOPE_AGENT); p.y = __hip_atomic_load((const unsigned*)mp + 1, __ATOMIC_RELAXED, __HIP_MEMORY_SCOPE_AGENT); t[0] += __uint_as_float(p.x << 16); t[1] += __uint_as_float(p.x & 0xffff0000u); t[2] += __uint_as_float(p.y << 16); t[3] += __uint_as_float(p.y & 0xffff0000u); }
                        u32x2 o; o.x = cvt_pk_bf16(t[0], t[1]); o.y = cvt_pk_bf16(t[2], t[3]); *(u32x2*)mp = o; } }
    }
};

#ifndef GEMM_SIMPLE
#define GEMM_SIMPLE 0
#endif
template <class Epi, class SchedT>
__device__ __forceinline__ void gemm_simple(LAS unsigned char* lds, const Gemm g, const SchedT& S, const Epi& E) {
    const int tid = otid(), wid = __builtin_amdgcn_readfirstlane(tid >> 6), lane = tid & 63, wr = wid >> 2, wc = wid & 3, fr = lane & 15, fq = lane >> 4;
    unsigned voffA[2], voffB[2];
#pragma unroll
    for (int i = 0; i < 2; ++i) { int R, C; stage_rc(tid * 16 + i * 8192, R, C);
        voffA[i] = (unsigned)(R * g.lda + C) * 2u; voffB[i] = (unsigned)(R * g.ldb + C) * 2u; }
    const size_t hstepA = (size_t)HALF * g.lda * 2, hstepB = (size_t)HALF * g.ldb * 2;
    const int aoff = lds_byte(wr * 64 + fr, fq * 8), boff = lds_byte(wc * 32 + fr, fq * 8);
    Unit cur;
    for (int ui = 0; S.next(ui, cur); ++ui) {
        size_t koc; int ntc; S.kr(cur, koc, ntc);
        const char* cA = (const char*)g.A + (size_t)cur.pm * 2 * hstepA + koc; const char* cB = (const char*)g.Bt + (size_t)cur.pn * 2 * hstepB + koc;
        f32x4 acc[2][2][4][2];
#pragma unroll
        for (int a = 0; a < 2; ++a)
#pragma unroll
            for (int b = 0; b < 2; ++b)
#pragma unroll
                for (int m = 0; m < 4; ++m)
#pragma unroll
                    for (int n = 0; n < 2; ++n) acc[a][b][m][n] = (f32x4){0.f, 0.f, 0.f, 0.f};
        for (int t = 0; t < ntc; ++t) {
            u32x4 ra[2][2], rb[2][2];
#pragma unroll
            for (int h = 0; h < 2; ++h)
#pragma unroll
                for (int i = 0; i < 2; ++i) { ra[h][i] = *(const u32x4*)(cA + (size_t)t * 128 + h * hstepA + voffA[i]); rb[h][i] = *(const u32x4*)(cB + (size_t)t * 128 + h * hstepB + voffB[i]); }
            __syncthreads();
#pragma unroll
            for (int h = 0; h < 2; ++h)
#pragma unroll
                for (int i = 0; i < 2; ++i) { *(LAS u32x4*)(lds + h * HTB + tid * 16 + i * 8192) = ra[h][i]; *(LAS u32x4*)(lds + (4 + h) * HTB + tid * 16 + i * 8192) = rb[h][i]; }
            __syncthreads();
#pragma unroll
            for (int ai = 0; ai < 2; ++ai) {
                bf16x8 At[4][2];
#pragma unroll
                for (int m = 0; m < 4; ++m)
#pragma unroll
                    for (int k = 0; k < 2; ++k) At[m][k] = *(const LAS bf16x8*)(lds + ai * HTB + aoff + m * 2048 + k * 1024);
#pragma unroll
                for (int bj = 0; bj < 2; ++bj) {
                    bf16x8 Bf[2][2];
#pragma unroll
                    for (int n = 0; n < 2; ++n)
#pragma unroll
                        for (int k = 0; k < 2; ++k) Bf[n][k] = *(const LAS bf16x8*)(lds + (4 + bj) * HTB + boff + n * 2048 + k * 1024);
#pragma unroll
                    for (int m = 0; m < 4; ++m)
#pragma unroll
                        for (int n = 0; n < 2; ++n)
#pragma unroll
                            for (int k = 0; k < 2; ++k) acc[ai][bj][m][n] = __builtin_amdgcn_mfma_f32_16x16x32_bf16(Bf[n][k], At[m][k], acc[ai][bj][m][n], 0, 0, 0);
                }
            }
        }
        E(acc, cur, wr, wc, fr, fq);
    }
    __syncthreads();
}
template <class Epi, class SchedT>
__device__ __forceinline__ void gemm_run(LAS unsigned char* lds, const Gemm g, const SchedT& S, const Epi& E) {
#if GEMM_SIMPLE
    gemm_simple(lds, g, S, E);
#else
    gemm_phase(lds, g, S, E);
#endif
}
}

__device__ __forceinline__ void transpose_tile(const float* __restrict__ W, int N, bf16_t* __restrict__ dst, int ldd, int koff, int tk, int tn, float* tile) {
    const int tid = otid(), a = tid >> 6, bq = tid & 63;
    __syncthreads();
#pragma unroll
    for (int i = 0; i < 8; ++i) { const int k = a + 8 * i; tile[k * 65 + bq] = W[(size_t)(tk * 64 + k) * N + tn * 64 + bq]; }
    __syncthreads();
#pragma unroll
    for (int i = 0; i < 8; ++i) { const int n = a + 8 * i; dst[(size_t)(tn * 64 + n) * ldd + koff + tk * 64 + bq] = f2bf(tile[bq * 65 + n]); }
}

__device__ __forceinline__ void rms_store(const f32x4 (&xv)[4], const float* g, bf16_t* dst, int lane) {
    float ss = 0.f;
#pragma unroll
    for (int i = 0; i < 4; ++i) ss += xv[i][0] * xv[i][0] + xv[i][1] * xv[i][1] + xv[i][2] * xv[i][2] + xv[i][3] * xv[i][3];
#pragma unroll
    for (int o = 32; o > 0; o >>= 1) ss += __shfl_xor(ss, o);
    const float rs = rsqrtf(ss * (1.0f / DM) + EPS);
#pragma unroll
    for (int i = 0; i < 4; ++i) { const int c = lane * 4 + 256 * i; const f32x4 gn = *(const f32x4*)(g + c); const f32x4 hv = xv[i] * gn * rs;
        u32x2 o; o.x = pk2(hv[0], hv[1]); o.y = pk2(hv[2], hv[3]); *(u32x2*)(dst + c) = o; }
}
__device__ __forceinline__ void norm_rows(const Params& P, int mode, int l, int grp, const unsigned char* smem) {
    const int tid_ = otid(); const int wid = tid_ >> 6, lane = tid_ & 63;
    float* X = (float*)(P.ws + A_X);
    const int gw = blockIdx.x * 8 + wid, nw = gridDim.x * 8;
    if (mode == 0) {
        const float* g0p = INP(I_GPREMIX); bf16_t* H = (bf16_t*)(P.ws + R_H);
        for (int row = gw; row < TPAD; row += nw) {
            f32x4 xv[4];
            if (row >= TT) {
#pragma unroll
                for (int i = 0; i < 4; ++i) xv[i] = (f32x4){0.f, 0.f, 0.f, 0.f};
            } else {
                const bool isP = row < TPR; int b = 0, t = 0; if (isP) { b = row / LP; t = row - b * LP; }
                const float* src = isP ? (t < 16 ? INP(I_META) + (size_t)t * DM : INP(I_XP) + ((size_t)b * SEQ + (t - 16)) * DM) : INP(I_XS) + (size_t)(row - TPR) * DM;
#pragma unroll
                for (int i = 0; i < 4; ++i) xv[i] = *(const f32x4*)(src + lane * 4 + 256 * i);
            }
#pragma unroll
            for (int i = 0; i < 4; ++i) *(f32x4*)(X + (size_t)row * DM + lane * 4 + 256 * i) = xv[i];
            if (row < 6192) rms_store(xv, g0p, H + (size_t)row * DM, lane);
        }
        return;
    }
    const Grp G = get_grp(grp);
    const float* F = (const float*)(P.ws + R_F) - (size_t)G.g0 * DM;
    bf16_t* H = (bf16_t*)(P.ws + R_H) - (size_t)G.g0 * DM;
    const bool fin = (mode == 2 && l == 1);
    const float* gpost = (mode == 1 ? INP(I_GPOSTMIX) : INP(I_GPOSTFFN)) + l * DM;
    const float* gffn = INP(I_GPREFFN) + l * DM;
    for (int row = G.g0 + gw; row < G.g0 + G.nrows; row += nw) {
        f32x4 xv[4], fv[4]; float ss = 0.f;
#pragma unroll
        for (int i = 0; i < 4; ++i) { const int c = lane * 4 + 256 * i; xv[i] = *(const f32x4*)(X + (size_t)row * DM + c); fv[i] = *(const f32x4*)(F + (size_t)row * DM + c);
            ss += fv[i][0] * fv[i][0] + fv[i][1] * fv[i][1] + fv[i][2] * fv[i][2] + fv[i][3] * fv[i][3]; }
#pragma unroll
        for (int o = 32; o > 0; o >>= 1) ss += __shfl_xor(ss, o);
        const float rs = rsqrtf(ss * (1.0f / DM) + EPS);
#pragma unroll
        for (int i = 0; i < 4; ++i) { const f32x4 gp = *(const f32x4*)(gpost + lane * 4 + 256 * i); xv[i] = xv[i] + fv[i] * gp * rs; }
        if (fin) {
            float* dst = nullptr;
            if (row < TPR) { const int b = row / LP, t = row - b * LP; if (t >= 16 && ((OUTMASK >> 0) & 1)) dst = P.out + O_YP + ((size_t)b * SEQ + (t - 16)) * DM; }
            else if ((OUTMASK >> 1) & 1) dst = P.out + O_YS + (size_t)(row - TPR) * DM;
            if (dst) {
#pragma unroll
                for (int i = 0; i < 4; ++i) *(f32x4*)(dst + lane * 4 + 256 * i) = xv[i];
            }
        } else {
#pragma unroll
            for (int i = 0; i < 4; ++i) *(f32x4*)(X + (size_t)row * DM + lane * 4 + 256 * i) = xv[i];
        }
        if (mode == 1) rms_store(xv, gffn, H + (size_t)row * DM, lane);
    }
    if (mode == 2) {
        int nl = l, ng = grp + 1; if (ng == NGRP) { ng = 0; nl = l + 1; }
        if (nl < 2) {
            const Grp N = get_grp(ng); const float* gn = INP(I_GPREMIX) + nl * DM; bf16_t* Hn = (bf16_t*)(P.ws + R_H) - (size_t)N.g0 * DM;
            for (int row = N.g0 + gw; row < N.g0 + N.nrows; row += nw) {
                f32x4 xv[4];
#pragma unroll
                for (int i = 0; i < 4; ++i) xv[i] = *(const f32x4*)(X + (size_t)row * DM + lane * 4 + 256 * i);
                rms_store(xv, gn, Hn + (size_t)row * DM, lane);
            }
        }
    }
}

__device__ __forceinline__ void phase0(const Params& P, unsigned char* smem) {
    float* tile = (float*)smem;
    constexpr int C0 = 2112, C1 = C0 + 144, C2 = C1 + 192, C3 = C2 + 192, C4 = C3 + 256, C5 = C4 + 256, C6 = C5 + 1408, C7 = C6 + 704;
    for (int id = blockIdx.x; id < 2 * C7; id += gridDim.x) {
        const int l = id / C7; int j = id - l * C7;
        const float* W; int N, ldd, koff = 0; bf16_t* dst;
        if (j < C0) { W = INP(I_WIN) + (size_t)l * DM * DIN; N = DIN; dst = (bf16_t*)(P.ws + W_IN) + (size_t)l * DIN * DM; ldd = DM; }
        else if (j < C1) { j -= C0; W = INP(I_WGLU) + (size_t)l * 768 * 768; N = 768; dst = (bf16_t*)(P.ws + W_GLU) + (size_t)l * 768 * 768; ldd = 768; }
        else if (j < C2) { j -= C1; W = INP(I_WBA) + (size_t)l * 768 * DM; N = DM; dst = (bf16_t*)(P.ws + W_BR) + (size_t)l * DM * LDY; ldd = LDY; }
        else if (j < C3) { j -= C2; W = INP(I_WBB) + (size_t)l * 768 * DM; N = DM; dst = (bf16_t*)(P.ws + W_BR) + (size_t)l * DM * LDY; ldd = LDY; koff = 768; }
        else if (j < C4) { j -= C3; W = INP(I_WBC) + (size_t)l * DM * DM; N = DM; dst = (bf16_t*)(P.ws + W_BR) + (size_t)l * DM * LDY; ldd = LDY; koff = 1536; }
        else if (j < C5) { j -= C4; W = INP(I_WOUT) + (size_t)l * DM * DM; N = DM; dst = (bf16_t*)(P.ws + W_OUT) + (size_t)l * DM * DM; ldd = DM; }
        else if (j < C6) { j -= C5; W = INP(I_WUP) + (size_t)l * DM * 2 * DFF; N = 2 * DFF; dst = (bf16_t*)(P.ws + W_UP) + (size_t)l * 2 * DFF * DM; ldd = DM; }
        else { j -= C6; W = INP(I_WDOWN) + (size_t)l * DFF * DM; N = DM; dst = (bf16_t*)(P.ws + W_DOWN) + (size_t)l * DM * DFF; ldd = DFF; }
        const int ntn = N / 64; const int tk = j / ntn, tn = j - tk * ntn;
        transpose_tile(W, N, dst, ldd, koff, tk, tn, tile);
    }
    norm_rows(P, 0, 0, 0, smem);
    float* rt = (float*)(P.ws + A_ROPE);
    for (int i = blockIdx.x * 512 + threadIdx.x; i < 2068 * 32; i += gridDim.x * 512) {
        const int pi = i >> 5, fi = i & 31; const double pos = pi < LP ? (double)pi : (double)(16384 + pi - LP);
        const double inv = exp(-(double)fi * (9.210340371976184 / 32.0));
        double ang = pos * inv; const double k = rint(ang * 0.15915494309189535); ang = ang - k * 6.283185307179586;
        const float af = (float)ang; rt[2 * i] = cosf(af); rt[2 * i + 1] = sinf(af);
    }
    if (blockIdx.x == 0 && threadIdx.x < 64) ((unsigned*)(P.ws + A_CTR))[threadIdx.x] = 0u;
}

__device__ __forceinline__ void ffn_conv_phase(const Params& P, int l, int grp, const unsigned char* smem) {
    const Grp G = get_grp(grp);
    const bf16_t* UP = (const bf16_t*)(P.ws + R_UP) - (size_t)G.g0 * (2 * DFF); bf16_t* FIN = (bf16_t*)(P.ws + R_FIN) - (size_t)G.g0 * DFF;
    const float* cw = INP(I_FCW) + (size_t)l * 3 * DFF; const float* cb = INP(I_FCB) + (size_t)l * DFF;
    const float* cache = INP(I_FFNC) + (size_t)l * DEC_B * 2 * DFF;
    constexpr int NCG = DFF / 8;
    for (int it = blockIdx.x * 512 + threadIdx.x; it < G.nrows * NCG; it += gridDim.x * 512) {
        const int rr = it / NCG, c = (it - rr * NCG) * 8, row = G.g0 + rr;
        int b, t, L; const bool isP = row < TPR;
        if (isP) { b = row / LP; t = row - b * LP; L = LP; } else { b = (row - TPR) >> 2; t = (row - TPR) & 3; L = 4; }
        float g0[8], g1[8], g2[8], uf[8];
        { const u32x4 v = *(const u32x4*)(UP + (size_t)row * (2 * DFF) + c);
#pragma unroll
          for (int i = 0; i < 4; ++i) { g0[2 * i] = __uint_as_float(v[i] << 16); g0[2 * i + 1] = __uint_as_float(v[i] & 0xffff0000u); } }
        { const u32x4 v = *(const u32x4*)(UP + (size_t)row * (2 * DFF) + DFF + c);
#pragma unroll
          for (int i = 0; i < 4; ++i) { uf[2 * i] = __uint_as_float(v[i] << 16); uf[2 * i + 1] = __uint_as_float(v[i] & 0xffff0000u); } }
        if (t >= 1) { const u32x4 v = *(const u32x4*)(UP + (size_t)(row - 1) * (2 * DFF) + c);
#pragma unroll
            for (int i = 0; i < 4; ++i) { g1[2 * i] = __uint_as_float(v[i] << 16); g1[2 * i + 1] = __uint_as_float(v[i] & 0xffff0000u); } }
        else {
#pragma unroll
            for (int i = 0; i < 8; ++i) g1[i] = isP ? 0.f : cache[((size_t)b * 2 + 1) * DFF + c + i]; }
        if (t >= 2) { const u32x4 v = *(const u32x4*)(UP + (size_t)(row - 2) * (2 * DFF) + c);
#pragma unroll
            for (int i = 0; i < 4; ++i) { g2[2 * i] = __uint_as_float(v[i] << 16); g2[2 * i + 1] = __uint_as_float(v[i] & 0xffff0000u); } }
        else {
#pragma unroll
            for (int i = 0; i < 8; ++i) g2[i] = isP ? 0.f : cache[((size_t)b * 2 + t) * DFF + c + i]; }
        float o[8];
#pragma unroll
        for (int i = 0; i < 8; ++i) { const float gc = cb[c + i] + cw[c + i] * g2[i] + cw[DFF + c + i] * g1[i] + cw[2 * DFF + c + i] * g0[i]; o[i] = gelu_t(gc) * uf[i]; }
        u32x4 ov; ov[0] = pk2(o[0], o[1]); ov[1] = pk2(o[2], o[3]); ov[2] = pk2(o[4], o[5]); ov[3] = pk2(o[6], o[7]);
        *(u32x4*)(FIN + (size_t)row * DFF + c) = ov;
        if (t >= L - 2 && (isP ? OUT_ON(7) : OUT_ON(13))) {
            float* dst = isP ? P.out + O_P_FFNC + (((size_t)l * NB + b) * 2 + (t - (L - 2))) * DFF + c : P.out + O_S_FFNC + (((size_t)l * DEC_B + b) * 2 + (t - (L - 2))) * DFF + c;
#pragma unroll
            for (int i = 0; i < 8; ++i) dst[i] = g0[i];
        }
    }
}

__device__ __forceinline__ void ret_job(const Params& P, int l, int grp, int b, int h, int g0, unsigned char* smem) {
    const int tid = otid(), w = __builtin_amdgcn_readfirstlane(tid >> 6), lane = tid & 63, fr = lane & 15, fq = lane >> 4;
    bf16_t* sQ = (bf16_t*)smem;
    bf16_t* sK = sQ + 128 * 72;
    bf16_t* sKdT = sK + 128 * 72;
    bf16_t* sVT = sKdT + 64 * 136;
    bf16_t* sST = sVT + 128 * 136;
    bf16_t* sP = sST + 128 * 72 + w * 16 * 136;
    const bf16_t* Z = (const bf16_t*)(P.ws + R_Z) - (size_t)g0 * DIN; bf16_t* Y = (bf16_t*)(P.ws + R_Y) - (size_t)g0 * LDY;
    const float* rope = (const float*)(P.ws + A_ROPE);
    const int L = grp ? 4 : LP, rowb = grp ? TPR + b * 4 : b * LP, tabb = grp ? LP : 0;
    const float lg = log1pf(-exp2f(-5.0f - (float)h));
    const float* ng = INP(I_RNG) + (size_t)l * 1024 + h * 128;
    f32x4 accS[4];
    float* Sout = P.out + (grp ? O_S_RET + (((size_t)l * DEC_B + b) * 8 + h) * 8192 : O_P_RET + (((size_t)l * NB + b) * 8 + h) * 8192);
    if (grp) { const float* S0 = INP(I_RET) + (((size_t)l * DEC_B + b) * 8 + h) * 8192;
#pragma unroll
        for (int dt = 0; dt < 4; ++dt)
#pragma unroll
            for (int j = 0; j < 4; ++j) accS[dt][j] = S0[(16 * dt + 4 * fq + j) * 128 + 16 * w + fr];
    } else {
#pragma unroll
        for (int dt = 0; dt < 4; ++dt) accS[dt] = (f32x4){0.f, 0.f, 0.f, 0.f};
    }
    __syncthreads();
#pragma unroll
    for (int dt = 0; dt < 4; ++dt) { u32x2 o; o.x = pk2(accS[dt][0], accS[dt][1]); o.y = pk2(accS[dt][2], accS[dt][3]); *(u32x2*)(sST + (16 * w + fr) * 72 + 16 * dt + 4 * fq) = o; }
    const int nch = grp ? 1 : 17;
    u32x4 q1 = {0u, 0u, 0u, 0u}, q2 = q1, k1 = q1, k2 = q1, vv[4];
#define RET_LOAD(ckx) do { const int _t0 = grp ? 0 : ((ckx) == 0 ? 0 : 16 + ((ckx) - 1) * 128), _C = grp ? 4 : ((ckx) == 0 ? 16 : 128); \
        const int _m = tid >> 2, _i0 = (tid & 3) * 8, _m2 = tid & 127, _e0 = (tid >> 7) * 32; \
        q1 = (u32x4){0u, 0u, 0u, 0u}; q2 = q1; k1 = q1; k2 = q1; \
        if (_m < _C) { const size_t _zr = (size_t)(rowb + _t0 + _m) * DIN; \
            q1 = *(const u32x4*)(Z + _zr + ZO_Q + h * 64 + _i0); q2 = *(const u32x4*)(Z + _zr + ZO_Q + h * 64 + 32 + _i0); \
            k1 = *(const u32x4*)(Z + _zr + ZO_K + h * 64 + _i0); k2 = *(const u32x4*)(Z + _zr + ZO_K + h * 64 + 32 + _i0); } \
        _Pragma("unroll") for (int _i = 0; _i < 4; ++_i) vv[_i] = (u32x4){0u, 0u, 0u, 0u}; \
        if (_m2 < _C) { const bf16_t* _vp = Z + (size_t)(rowb + _t0 + _m2) * DIN + ZO_V + h * 128 + _e0; \
            _Pragma("unroll") for (int _i = 0; _i < 4; ++_i) vv[_i] = *(const u32x4*)(_vp + 8 * _i); } } while (0)
    RET_LOAD(0);
    for (int ck = 0; ck < nch; ++ck) {
        const int t0 = grp ? 0 : (ck == 0 ? 0 : 16 + (ck - 1) * 128), C = grp ? 4 : (ck == 0 ? 16 : 128);
        {
            const int m = tid >> 2, i0 = (tid & 3) * 8;
            u32x4 q1w = {0u, 0u, 0u, 0u}, q2w = q1w, k1w = q1w, k2w = q1w;
            float kd1[8], kd2[8];
#pragma unroll
            for (int e = 0; e < 8; ++e) { kd1[e] = 0.f; kd2[e] = 0.f; }
            if (m < C) {
                const float* rp = rope + ((size_t)(tabb + t0 + m) * 32 + i0) * 2;
                const float kdec = __expf(lg * (float)(C - 1 - m));
                float qo1[8], qo2[8], ko1[8], ko2[8];
#pragma unroll
                for (int e = 0; e < 8; ++e) {
                    const float cs = rp[2 * e], sn = rp[2 * e + 1];
                    const unsigned qa = q1[e >> 1], qb = q2[e >> 1], ka = k1[e >> 1], kb = k2[e >> 1];
                    const float x1 = (e & 1) ? __uint_as_float(qa & 0xffff0000u) : __uint_as_float(qa << 16);
                    const float x2 = (e & 1) ? __uint_as_float(qb & 0xffff0000u) : __uint_as_float(qb << 16);
                    const float y1 = ((e & 1) ? __uint_as_float(ka & 0xffff0000u) : __uint_as_float(ka << 16)) * 0.125f;
                    const float y2 = ((e & 1) ? __uint_as_float(kb & 0xffff0000u) : __uint_as_float(kb << 16)) * 0.125f;
                    qo1[e] = x1 * cs - x2 * sn; qo2[e] = x2 * cs + x1 * sn;
                    ko1[e] = y1 * cs - y2 * sn; ko2[e] = y2 * cs + y1 * sn;
                    kd1[e] = ko1[e] * kdec; kd2[e] = ko2[e] * kdec;
                }
#pragma unroll
                for (int e = 0; e < 4; ++e) { q1w[e] = pk2(qo1[2 * e], qo1[2 * e + 1]); q2w[e] = pk2(qo2[2 * e], qo2[2 * e + 1]); k1w[e] = pk2(ko1[2 * e], ko1[2 * e + 1]); k2w[e] = pk2(ko2[2 * e], ko2[2 * e + 1]); }
            }
            *(u32x4*)(sQ + m * 72 + i0) = q1w; *(u32x4*)(sQ + m * 72 + 32 + i0) = q2w;
            *(u32x4*)(sK + m * 72 + i0) = k1w; *(u32x4*)(sK + m * 72 + 32 + i0) = k2w;
#pragma unroll
            for (int e = 0; e < 8; ++e) { sKdT[(i0 + e) * 136 + m] = f2bf(kd1[e]); sKdT[(32 + i0 + e) * 136 + m] = f2bf(kd2[e]); }
            const int m2 = tid & 127, e0 = (tid >> 7) * 32;
#pragma unroll
            for (int i = 0; i < 4; ++i)
#pragma unroll
                for (int e = 0; e < 4; ++e) { sVT[(e0 + 8 * i + 2 * e) * 136 + m2] = (bf16_t)(vv[i][e] & 0xffffu); sVT[(e0 + 8 * i + 2 * e + 1) * 136 + m2] = (bf16_t)(vv[i][e] >> 16); }
        }
        __syncthreads();
        if (ck + 1 < nch) RET_LOAD(ck + 1);
        f32x4 o[8];
        const bool act = (16 * w < C);
        unsigned gcp[4][4];
        if (act) {
#pragma unroll
            for (int j = 0; j < 4; ++j) { const int n = 16 * w + 4 * fq + j; const size_t row = (size_t)(rowb + t0 + (n < C ? n : 0));
#pragma unroll
                for (int e2 = 0; e2 < 4; ++e2) { const bf16_t lo = Z[row * DIN + ZO_GC + h * 128 + 32 * e2 + fr], hi = Z[row * DIN + ZO_GC + h * 128 + 32 * e2 + 16 + fr]; gcp[e2][j] = (unsigned)lo | ((unsigned)hi << 16); } }
        }
        if (act) {
            bf16x8 qf[2];
#pragma unroll
            for (int ks = 0; ks < 2; ++ks) qf[ks] = *(const bf16x8*)(sQ + (16 * w + fr) * 72 + 32 * ks + 8 * fq);
            const int mtN = (w | 1) + 1;
            for (int mt = 0; mt < mtN; ++mt) {
                f32x4 a = {0.f, 0.f, 0.f, 0.f};
#pragma unroll
                for (int ks = 0; ks < 2; ++ks) { const bf16x8 kf = *(const bf16x8*)(sK + (16 * mt + fr) * 72 + 32 * ks + 8 * fq); a = mfma16(qf[ks], kf, a); }
#pragma unroll
                for (int j = 0; j < 4; ++j) { const int d = (16 * w + 4 * fq + j) - (16 * mt + fr); const float v = d >= 0 ? a[j] * __expf(lg * (float)d) : 0.f; sP[(4 * fq + j) * 136 + 16 * mt + fr] = f2bf(v); }
            }
            lds_wait();
#pragma unroll
            for (int et = 0; et < 8; ++et) o[et] = (f32x4){0.f, 0.f, 0.f, 0.f};
            const int ksN = mtN >> 1;
            for (int ks = 0; ks < ksN; ++ks) {
                const bf16x8 pf = *(const bf16x8*)(sP + fr * 136 + 32 * ks + 8 * fq);
#pragma unroll
                for (int et = 0; et < 8; ++et) { const bf16x8 vf = *(const bf16x8*)(sVT + (16 * et + fr) * 136 + 32 * ks + 8 * fq); o[et] = mfma16(pf, vf, o[et]); }
            }
            f32x4 o2[8];
#pragma unroll
            for (int et = 0; et < 8; ++et) o2[et] = (f32x4){0.f, 0.f, 0.f, 0.f};
#pragma unroll
            for (int ks = 0; ks < 2; ++ks)
#pragma unroll
                for (int et = 0; et < 8; ++et) { const bf16x8 sf = *(const bf16x8*)(sST + (16 * et + fr) * 72 + 32 * ks + 8 * fq); o2[et] = mfma16(qf[ks], sf, o2[et]); }
#pragma unroll
            for (int j = 0; j < 4; ++j) { const float sc = __expf(lg * (float)(16 * w + 4 * fq + j + 1));
#pragma unroll
                for (int et = 0; et < 8; ++et) o[et][j] += o2[et][j] * sc; }
        }
        {
            const float gC = __expf(lg * (float)C);
#pragma unroll
            for (int dt = 0; dt < 4; ++dt) accS[dt] = accS[dt] * gC;
            const int ksN = (C + 31) >> 5;
            for (int ks = 0; ks < ksN; ++ks) {
                const bf16x8 vf = *(const bf16x8*)(sVT + (16 * w + fr) * 136 + 32 * ks + 8 * fq);
#pragma unroll
                for (int dt = 0; dt < 4; ++dt) { const bf16x8 kf = *(const bf16x8*)(sKdT + (16 * dt + fr) * 136 + 32 * ks + 8 * fq); accS[dt] = mfma16(kf, vf, accS[dt]); }
            }
        }
        __syncthreads();
#pragma unroll
        for (int dt = 0; dt < 4; ++dt) { u32x2 ow; ow.x = pk2(accS[dt][0], accS[dt][1]); ow.y = pk2(accS[dt][2], accS[dt][3]); *(u32x2*)(sST + (16 * w + fr) * 72 + 16 * dt + 4 * fq) = ow; }
        if (act) {
#pragma unroll
            for (int j = 0; j < 4; ++j) {
                float s = 0.f;
#pragma unroll
                for (int et = 0; et < 8; ++et) s += o[et][j];
                s += __shfl_xor(s, 1); s += __shfl_xor(s, 2); s += __shfl_xor(s, 4); s += __shfl_xor(s, 8);
                const float mu = s * (1.0f / 128.0f);
                float s2 = 0.f;
#pragma unroll
                for (int et = 0; et < 8; ++et) { const float d = o[et][j] - mu; s2 += d * d; }
                s2 += __shfl_xor(s2, 1); s2 += __shfl_xor(s2, 2); s2 += __shfl_xor(s2, 4); s2 += __shfl_xor(s2, 8);
                const float rstd = rsqrtf(s2 * (1.0f / 128.0f) + EPS);
                const int n = 16 * w + 4 * fq + j;
                if (n < C) {
                    const size_t row = (size_t)(rowb + t0 + n);
#pragma unroll
                    for (int et = 0; et < 8; ++et) { const int e = 16 * et + fr; const unsigned gw_ = gcp[et >> 1][j]; const float gcv = (et & 1) ? __uint_as_float(gw_ & 0xffff0000u) : __uint_as_float(gw_ << 16);
                        const float yv = gcv * sigm(gcv) * (o[et][j] - mu) * rstd * ng[e]; Y[row * LDY + 1536 + h * 128 + e] = f2bf(yv); }
                }
            }
        }
    }
    if (grp ? OUT_ON(12) : OUT_ON(6)) {
#pragma unroll
    for (int dt = 0; dt < 4; ++dt)
#pragma unroll
        for (int j = 0; j < 4; ++j) Sout[(16 * dt + 4 * fq + j) * 128 + 16 * w + fr] = accS[dt][j];
    }
}

__device__ __forceinline__ void lru_job(const Params& P, int l, int grp, int jid, int g0, int pb0, unsigned char* smem) {
    const int tid = otid(), w = __builtin_amdgcn_readfirstlane(tid >> 6), lane = tid & 63, fr = lane & 15, fq = lane >> 4;
    bf16_t* sA = (bf16_t*)(smem + w * 10752);
    float* sRI = (float*)(smem + w * 10752 + 2304);
    float* sComb = (float*)(smem + 8 * 10752);
    const bf16_t* Z = (const bf16_t*)(P.ws + R_Z) - (size_t)g0 * DIN; bf16_t* Y = (bf16_t*)(P.ws + R_Y) - (size_t)g0 * LDY;
    const int unit = grp ? jid * 8 + w : jid;
    const int bl = unit / 12, hb = unit - bl * 12, ch = hb * 64 + lane; const int b = grp ? bl : pb0 + bl;
    const int L = grp ? 4 : LP, rowb = grp ? TPR + b * 4 : b * LP;
    float cw[4];
#pragma unroll
    for (int j = 0; j < 4; ++j) cw[j] = INP(I_LCW)[((size_t)l * 4 + j) * 768 + ch];
    const float cb = INP(I_LCB)[l * 768 + ch], ba = INP(I_LBA)[l * 768 + ch], bx = INP(I_LBX)[l * 768 + ch];
    const float lam = INP(I_LAM)[l * 768 + ch];
    const float sp8 = 8.0f * (fmaxf(-lam, 0.f) + log1pf(__expf(-fabsf(lam))));
    bf16x8 Wa[4][2], Wx[4][2];
    { const float* wa = INP(I_LWA) + ((size_t)l * 12 + hb) * 4096; const float* wx = INP(I_LWX) + ((size_t)l * 12 + hb) * 4096;
#pragma unroll
      for (int nt = 0; nt < 4; ++nt)
#pragma unroll
          for (int ks = 0; ks < 2; ++ks)
#pragma unroll
              for (int j = 0; j < 8; ++j) { const int k = 32 * ks + 8 * fq + j, n = 16 * nt + fr; Wa[nt][ks][j] = (short)f2bf(wa[k * 64 + n]); Wx[nt][ks][j] = (short)f2bf(wx[k * 64 + n]); } }
    float carry = grp ? INP(I_LRUH)[((size_t)l * DEC_B + b) * 768 + ch] : 0.f;
    const float* cache = INP(I_LRUC) + ((size_t)l * DEC_B + b) * 3 * 768;
    const int nIter = grp ? 1 : 17;
    __syncthreads();
    for (int it = 0; it < nIter; ++it) {
        const int tw = grp ? 0 : it * 128 + 16 * w;
        float xv[19];
#pragma unroll
        for (int i = 0; i < 19; ++i) { const int t = tw - 3 + i; float v = 0.f;
            if (t < 0) { if (grp) v = cache[(t + 3) * 768 + ch]; }
            else if (t < L) v = bf2f(Z[(size_t)(rowb + t) * DIN + ZO_XB + ch]);
            xv[i] = v; }
        float xc[16];
#pragma unroll
        for (int i = 0; i < 16; ++i) { xc[i] = cb + cw[0] * xv[i] + cw[1] * xv[i + 1] + cw[2] * xv[i + 2] + cw[3] * xv[i + 3]; sA[i * 72 + lane] = f2bf(xc[i]); }
        lds_wait();
        bf16x8 af[2];
#pragma unroll
        for (int ks = 0; ks < 2; ++ks) af[ks] = *(const bf16x8*)(sA + fr * 72 + 32 * ks + 8 * fq);
#pragma unroll
        for (int nt = 0; nt < 4; ++nt) {
            f32x4 ra = {0.f, 0.f, 0.f, 0.f}, rx = ra;
            ra = mfma16(af[0], Wa[nt][0], ra); ra = mfma16(af[1], Wa[nt][1], ra);
            rx = mfma16(af[0], Wx[nt][0], rx); rx = mfma16(af[1], Wx[nt][1], rx);
#pragma unroll
            for (int j = 0; j < 4; ++j) { sRI[(4 * fq + j) * 132 + 16 * nt + fr] = ra[j]; sRI[(4 * fq + j) * 132 + 64 + 16 * nt + fr] = rx[j]; }
        }
        lds_wait();
        float hloc[16], ca[16]; float hl = 0.f, cacc = 1.f;
#pragma unroll
        for (int i = 0; i < 16; ++i) {
            const float rp = sRI[i * 132 + lane], ip = sRI[i * 132 + 64 + lane];
            const float r = sigm(rp + ba), ii = sigm(ip + bx);
            const float la = -sp8 * r; float a = __expf(la); float bv = sqrtf(-expm1f(2.0f * la)) * ii * xc[i];
            if (tw + i >= L) { a = 1.f; bv = 0.f; }
            hl = a * hl + bv; cacc *= a; hloc[i] = hl; ca[i] = cacc;
        }
        float hin = carry;
        if (!grp) {
            sComb[(w * 64 + lane) * 2] = cacc; sComb[(w * 64 + lane) * 2 + 1] = hl;
            __syncthreads();
            float run = carry;
#pragma unroll
            for (int ww = 0; ww < 8; ++ww) { if (ww == w) hin = run; run = sComb[(ww * 64 + lane) * 2] * run + sComb[(ww * 64 + lane) * 2 + 1]; }
            carry = run;
            __syncthreads();
        } else carry = hloc[15] + ca[15] * hin;
#pragma unroll
        for (int i = 0; i < 16; ++i) { const int t = tw + i;
            if (t < L) { const size_t row = (size_t)(rowb + t); const float hh = hloc[i] + ca[i] * hin; const float gt = bf2f(Z[row * DIN + ZO_GB + ch]); Y[row * LDY + 768 + ch] = f2bf(hh * gelu_t(gt)); } }
    }
    if (grp || w == 0) {
        float* ho = grp ? P.out + O_S_LRUH + ((size_t)l * DEC_B + b) * 768 + ch : P.out + O_P_LRUH + ((size_t)l * NB + b) * 768 + ch;
        if (grp ? OUT_ON(10) : OUT_ON(4)) *ho = carry;
        float* co = grp ? P.out + O_S_LRUC + ((size_t)l * DEC_B + b) * 3 * 768 + ch : P.out + O_P_LRUC + ((size_t)l * NB + b) * 3 * 768 + ch;
#pragma unroll
        for (int j = 0; j < 3; ++j) if (grp ? OUT_ON(11) : OUT_ON(5)) co[j * 768] = bf2f(Z[(size_t)(rowb + L - 3 + j) * DIN + ZO_XB + ch]);
    }
}

template <bool FULL>
__device__ __forceinline__ void s5_run(const bf16_t* Z, bf16_t* ZS, float* sBU, bf16_t* sH, const bf16x8 (&Bf)[8], const bf16x8 (&Cf)[4], float abr, float abi, float dsk,
                                       int rowb, int g, int L, int it0, int it1, float& hr, float& hi, int lane, int fr, int fq) {
    u32x4 ufn = {0u, 0u, 0u, 0u}; bf16_t udn[4] = {0, 0, 0, 0};
    { const int t1 = it0 * 16; const int v1 = (L - t1) < 16 ? (L - t1) : 16;
      if (fq < 2 && fr < v1) ufn = *(const u32x4*)(Z + (size_t)(rowb + t1 + fr) * DIN + ZO_UA + g * 16 + 8 * fq);
      if (FULL) {
#pragma unroll
          for (int j = 0; j < 4; ++j) if (4 * fq + j < v1) udn[j] = Z[(size_t)(rowb + t1 + 4 * fq + j) * DIN + ZO_UA + g * 16 + fr]; } }
    for (int it = it0; it < it1; ++it) {
        const int t0 = it * 16; const int valid = (L - t0) < 16 ? (L - t0) : 16;
        const bf16x8 uf = __builtin_bit_cast(bf16x8, ufn);
        bf16_t ud[4];
#pragma unroll
        for (int j = 0; j < 4; ++j) ud[j] = udn[j];
        if (it + 1 < it1) { const int t1 = t0 + 16; const int v1 = (L - t1) < 16 ? (L - t1) : 16;
            ufn = (u32x4){0u, 0u, 0u, 0u};
            if (fq < 2 && fr < v1) ufn = *(const u32x4*)(Z + (size_t)(rowb + t1 + fr) * DIN + ZO_UA + g * 16 + 8 * fq);
            if (FULL) {
#pragma unroll
                for (int j = 0; j < 4; ++j) { udn[j] = 0; if (4 * fq + j < v1) udn[j] = Z[(size_t)(rowb + t1 + 4 * fq + j) * DIN + ZO_UA + g * 16 + fr]; } } }
#pragma unroll
        for (int nt = 0; nt < 8; ++nt) { f32x4 a = {0.f, 0.f, 0.f, 0.f}; a = mfma16(uf, Bf[nt], a);
#pragma unroll
            for (int j = 0; j < 4; ++j) sBU[(4 * fq + j) * 132 + 16 * nt + fr] = a[j]; }
        lds_wait();
#pragma unroll
        for (int i = 0; i < 16; ++i) {
            float bur = sBU[i * 132 + lane], bui = sBU[i * 132 + 64 + lane];
            asm volatile("" : "+v"(bur), "+v"(bui));
            const float msk = (i < valid) ? 1.0f : 0.0f;
            float nr = __builtin_fmaf(abr, hr, bur); asm volatile("" : "+v"(nr));
            nr = __builtin_fmaf(-abi, hi, nr); asm volatile("" : "+v"(nr));
            float ni = __builtin_fmaf(abr, hi, bui); asm volatile("" : "+v"(ni));
            ni = __builtin_fmaf(abi, hr, ni); asm volatile("" : "+v"(ni));
            hr = __builtin_fmaf(msk, nr - hr, hr); hi = __builtin_fmaf(msk, ni - hi, hi);
            asm volatile("" : "+v"(hr), "+v"(hi));
            if (FULL) { sH[i * 136 + lane] = f2bf(hr); sH[i * 136 + 64 + lane] = f2bf(hi); }
        }
        lds_wait();
        if (FULL) {
            f32x4 y = {0.f, 0.f, 0.f, 0.f};
#pragma unroll
            for (int ks = 0; ks < 4; ++ks) { const bf16x8 hf = *(const bf16x8*)(sH + fr * 136 + 32 * ks + 8 * fq); y = mfma16(hf, Cf[ks], y); }
#pragma unroll
            for (int j = 0; j < 4; ++j) { const int t = 4 * fq + j;
                if (t < valid) { const size_t row = (size_t)(rowb + t0 + t); const float u = bf2f(ud[j]); ZS[row * 768 + g * 16 + fr] = f2bf(gelu_t(y[j] + dsk * u)); } }
            lds_wait();
        }
    }
}
__device__ __forceinline__ void cmul(float& ar, float& ai, float br, float bi) { const float r = ar * br - ai * bi, i = ar * bi + ai * br; ar = r; ai = i; }

__device__ __forceinline__ void s5_job(const Params& P, int l, int grp, int jid, int g0, int pb0, unsigned char* smem) {
    const int tid = otid(), w = __builtin_amdgcn_readfirstlane(tid >> 6), lane = tid & 63, fr = lane & 15, fq = lane >> 4;
    float* sBU = (float*)(smem + w * 12800);
    bf16_t* sH = (bf16_t*)(smem + w * 12800 + 8448);
    float* sC = (float*)(smem + 8 * 12800);
    const bf16_t* Z = (const bf16_t*)(P.ws + R_Z) - (size_t)g0 * DIN; bf16_t* ZS = (bf16_t*)(P.ws + R_ZS5) - (size_t)g0 * 768;
    int g, b0;
    if (grp) { const int unit = jid * 8 + w; g = unit % 48; b0 = (unit / 48) * 16; } else { b0 = jid / 48; g = jid - b0 * 48; b0 += pb0; }
    const float dt = __expf(INP(I_LS)[l * 48 + g]);
    float abr = 0.f, abi = 0.f;
    bf16x8 Bf[8];
#pragma unroll
    for (int k = 0; k < 4; ++k) {
        const int p = 16 * k + fr;
        const float lr = INP(I_AR)[((size_t)l * 48 + g) * 64 + p], li = INP(I_AI)[((size_t)l * 48 + g) * 64 + p];
        const float mag = expf(lr * dt), ar_ = mag * cosf(li * dt), ai_ = mag * sinf(li * dt);
        if (k == fq) { abr = ar_; abi = ai_; }
        const float den = lr * lr + li * li, nr = ar_ - 1.0f;
        const float cr = (nr * lr + ai_ * li) / den, ci = (ai_ * lr - nr * li) / den;
        bf16x8 fre, fim;
#pragma unroll
        for (int j = 0; j < 8; ++j) { fre[j] = 0; fim[j] = 0; }
        if (fq < 2) {
            const float* bre = INP(I_BR) + (((size_t)l * 48 + g) * 64 + p) * 16 + 8 * fq; const float* bim = INP(I_BI) + (((size_t)l * 48 + g) * 64 + p) * 16 + 8 * fq;
#pragma unroll
            for (int j = 0; j < 8; ++j) { const float br_ = bre[j], bi_ = bim[j]; fre[j] = (short)f2bf(cr * br_ - ci * bi_); fim[j] = (short)f2bf(cr * bi_ + ci * br_); }
        }
        Bf[k] = fre; Bf[4 + k] = fim;
    }
    bf16x8 Cf[4];
#pragma unroll
    for (int ks = 0; ks < 4; ++ks) {
        const float* cp = (ks < 2 ? INP(I_CR) : INP(I_CI)) + (((size_t)l * 48 + g) * 16 + fr) * 64 + 32 * (ks & 1) + 8 * fq;
        const float sg = ks < 2 ? 1.0f : -1.0f;
#pragma unroll
        for (int j = 0; j < 8; ++j) Cf[ks][j] = (short)f2bf(sg * cp[j]);
    }
    const float dsk = INP(I_D)[l * 768 + g * 16 + fr];
    __syncthreads();
    if (grp) {
        for (int s = 0; s < 16; ++s) {
            const int b = b0 + s; const int rowb = TPR + b * 4;
            float hr = INP(I_S5RE)[(((size_t)l * DEC_B + b) * 48 + g) * 64 + lane], hi = INP(I_S5IM)[(((size_t)l * DEC_B + b) * 48 + g) * 64 + lane];
            s5_run<true>(Z, ZS, sBU, sH, Bf, Cf, abr, abi, dsk, rowb, g, 4, 0, 1, hr, hi, lane, fr, fq);
            P.out[O_S_S5RE + (((size_t)l * DEC_B + b) * 48 + g) * 64 + lane] = hr;
            P.out[O_S_S5IM + (((size_t)l * DEC_B + b) * 48 + g) * 64 + lane] = hi;
        }
    } else {
        const int b = b0, rowb = b * LP;
        const int it0 = w == 0 ? 0 : 17 + 16 * (w - 1), it1 = 17 + 16 * w;
        float hr = 0.f, hi = 0.f;
        s5_run<false>(Z, ZS, sBU, sH, Bf, Cf, abr, abi, dsk, rowb, g, LP, it0, it1, hr, hi, lane, fr, fq);
        sC[(w * 64 + lane) * 2] = hr; sC[(w * 64 + lane) * 2 + 1] = hi;
        float pr = abr, pi = abi, p16r = 0.f, p16i = 0.f;
#pragma unroll
        for (int q = 0; q < 8; ++q) { cmul(pr, pi, pr, pi); if (q == 3) { p16r = pr; p16i = pi; } }
        float qr = pr, qi = pi; cmul(qr, qi, p16r, p16i);
        __syncthreads();
        float cr_ = 0.f, ci_ = 0.f;
        for (int ww = 0; ww < w; ++ww) {
            const float ar2 = ww == 0 ? qr : pr, ai2 = ww == 0 ? qi : pi;
            cmul(cr_, ci_, ar2, ai2);
            cr_ += sC[(ww * 64 + lane) * 2]; ci_ += sC[(ww * 64 + lane) * 2 + 1];
        }
        hr = cr_; hi = ci_;
        s5_run<true>(Z, ZS, sBU, sH, Bf, Cf, abr, abi, dsk, rowb, g, LP, it0, it1, hr, hi, lane, fr, fq);
        if (w == 7) {
            P.out[O_P_S5RE + (((size_t)l * NB + b) * 48 + g) * 64 + lane] = hr;
            P.out[O_P_S5IM + (((size_t)l * NB + b) * 48 + g) * 64 + lane] = hi;
        }
    }
}

__device__ __forceinline__ void mixers_phase(const Params& P, int l, int rg, unsigned char* smem, int rep) {
    const Grp G = get_grp(rg);
    const int j1 = G.npb * 8, j2 = j1 + G.npb * 12, j3 = j2 + G.npb * 48, j4 = j3 + (G.hasS ? 1024 : 0), j5 = j4 + (G.hasS ? 48 : 0), NJ = j5 + (G.hasS ? 192 : 0);
    unsigned* ctr = (unsigned*)(P.ws + A_CTR) + (l * NGRP + rg) + rep * 16;
    int* slot = (int*)(smem + LDS_BYTES - 16);
#ifndef STATIC_JOBS
#define STATIC_JOBS 0
#endif
    for (int jj = blockIdx.x;; jj += gridDim.x) {
        __syncthreads();
#if STATIC_JOBS
        const int j = jj; (void)ctr; (void)slot;
#else
        if (threadIdx.x == 0) *slot = (int)atomicAdd(ctr, 1u);
        __syncthreads();
        const int j = *slot;
#endif
        if (j >= NJ) break;
        int type, sg, idx;
        if (j < j1) { type = 0; sg = 0; idx = j; }
        else if (j < j2) { type = 1; sg = 0; idx = j - j1; }
        else if (j < j3) { type = 2; sg = 0; idx = j - j2; }
        else if (j < j4) { type = 0; sg = 1; idx = j - j3; }
        else if (j < j5) { type = 2; sg = 1; idx = j - j4; }
        else { type = 1; sg = 1; idx = j - j5; }
        if (type == 0) ret_job(P, l, sg, (idx >> 3) + (sg ? 0 : G.pb0), idx & 7, G.g0, smem);
        else if (type == 1) lru_job(P, l, sg, idx, G.g0, G.pb0, smem);
        else s5_job(P, l, sg, idx, G.g0, G.pb0, smem);
    }
}

__device__ __forceinline__ void run_phase(const Params& P, int ph, unsigned char* smem, int rep) {
#ifndef PHSEL
#define PHSEL -1
#endif
#define PSEL(x) (PHSEL < 0 || PHSEL == (x))
    if (ph == 0) { if (PSEL(10)) phase0(P, smem); return; }
    const int l = (ph - 1) / (10 * NGRP), rg = ((ph - 1) / 10) % NGRP, s = (ph - 1) % 10;
    LAS unsigned char* lds = (LAS unsigned char*)smem;
    unsigned char* ws = P.ws;
    using namespace pg8;
    const int G = gridDim.x, c = blockIdx.x;
    const int npan = rg < 2 ? 25 : 19;
    switch (s) {
    case 0: if (PSEL(0)) { Gemm g{(const bf16_t*)(ws + R_H), (const bf16_t*)(ws + W_IN) + (size_t)l * DIN * DM, DM, DM, npan, DIN / 256, DM / 64};
              Sched<1> S; S.init(g.nM, g.nN, G, c, g.nt); EpiBf E{(bf16_t*)(ws + R_Z), DIN}; gemm_run(lds, g, S, E); } break;
    case 1: if (PSEL(1)) mixers_phase(P, l, rg, smem, rep); break;
    case 2: if (PSEL(2)) { Gemm g{(const bf16_t*)(ws + R_ZS5), (const bf16_t*)(ws + W_GLU) + (size_t)l * 768 * 768, 768, 768, npan, 3, 12};
              Sched<1> S; S.init(g.nM, g.nN, G, c, g.nt); EpiGlu E{(bf16_t*)(ws + R_Y), (const bf16_t*)(ws + R_ZS5), INP(I_BGLU) + l * 768}; gemm_run(lds, g, S, E); } break;
    case 3: if (PSEL(3)) { Gemm g{(const bf16_t*)(ws + R_Y), (const bf16_t*)(ws + W_BR) + (size_t)l * DM * LDY, LDY, LDY, npan, 4, 0};
              Sched<3> S; S.init(g.nM, g.nN, G, c, 0); EpiBranch E{(const bf16_t*)(ws + R_Z) + ZO_GATE, (bf16_t*)(ws + R_M)}; gemm_run(lds, g, S, E); } break;
    case 4: if (PSEL(4)) { Gemm g{(const bf16_t*)(ws + R_M), (const bf16_t*)(ws + W_OUT) + (size_t)l * DM * DM, DM, DM, npan, 4, 16};
              Sched<1> S; S.init(g.nM, g.nN, G, c, g.nt); EpiF32 E{(float*)(ws + R_F), DM}; gemm_run(lds, g, S, E); } break;
    case 5: if (PSEL(5) && rep == 0) norm_rows(P, 1, l, rg, smem); break;
    case 6: if (PSEL(6)) { Gemm g{(const bf16_t*)(ws + R_H), (const bf16_t*)(ws + W_UP) + (size_t)l * 2 * DFF * DM, DM, DM, npan, 22, 16};
              Sched<1> S; S.init(g.nM, g.nN, G, c, g.nt); EpiBf E{(bf16_t*)(ws + R_UP), 2 * DFF}; gemm_run(lds, g, S, E); } break;
    case 7: if (PSEL(7)) ffn_conv_phase(P, l, rg, smem); break;
    case 8: if (PSEL(8)) { Gemm g{(const bf16_t*)(ws + R_FIN), (const bf16_t*)(ws + W_DOWN) + (size_t)l * DM * DFF, DFF, DFF, npan, 4, 44};
              Sched<1> S; S.init(g.nM, g.nN, G, c, g.nt); EpiF32 E{(float*)(ws + R_F), DM}; gemm_run(lds, g, S, E); } break;
    default: if (PSEL(9) && rep == 0) norm_rows(P, 2, l, rg, smem); break;
    }
}

#define XB_TMO      128
#define XB_XCNT(j)  (256  + 64 * (j))
#define XB_XSUB(j)  (1280 + 64 * (j))
#define XB_XGEN(j)  (2304 + 64 * (j))
#define XB_TOP      3328
#define XB_TOPGEN   3392
#define XCD_BAR_WORDS 3456
#define XB_SPIN_CAP (1u << 18)

__device__ __forceinline__ unsigned xb_ld(unsigned* p)              { return __hip_atomic_load(p, __ATOMIC_RELAXED, __HIP_MEMORY_SCOPE_AGENT); }
__device__ __forceinline__ unsigned xb_add(unsigned* p, unsigned v) { return __hip_atomic_fetch_add(p, v, __ATOMIC_RELAXED, __HIP_MEMORY_SCOPE_AGENT); }
__device__ __forceinline__ unsigned xb_xcc_id() { return (unsigned)__builtin_amdgcn_s_getreg((3 << 11) | 20) & 0xFu; }
#define XB_SPIN(cond, bar) do { unsigned _sp = 0; while (cond) { __builtin_amdgcn_s_sleep(1); \
    if ((++_sp & 255u) == 0u) { if (xb_ld(&(bar)[XB_TMO])) break; if (_sp > XB_SPIN_CAP) { atomicAdd(&(bar)[XB_TMO], 1u); break; } } } } while (0)

struct XcdBarrier {
    unsigned* bar; unsigned x;
    volatile LAS unsigned* st;
};

__device__ __forceinline__ XcdBarrier xcd_barrier_post(unsigned* bar, volatile LAS unsigned* st) {
    XcdBarrier b; b.bar = bar; b.x = xb_xcc_id(); b.st = st;
    if (threadIdx.x == 0) (void)xb_add(&bar[XB_XCNT(b.x)], 1u);
    return b;
}
__device__ __forceinline__ void xcd_barrier_complete(unsigned* bar, unsigned x, unsigned& nloc, unsigned& nx) {
    const unsigned G = gridDim.x * gridDim.y * gridDim.z;
    unsigned sum, cnt, mine, sp = 0u;
    for (;;) {
        sum = 0u; cnt = 0u; mine = 0u;
#pragma unroll
        for (unsigned j = 0; j < 16; ++j) { const unsigned c = xb_ld(&bar[XB_XCNT(j)]); sum += c; cnt += (c > 0u) ? 1u : 0u; mine = (j == x) ? c : mine; }
        if (sum == G) break;
        __builtin_amdgcn_s_sleep(1);
        if ((++sp & 255u) == 0u) { if (xb_ld(&bar[XB_TMO])) break; if (sp > XB_SPIN_CAP) { atomicAdd(&bar[XB_TMO], 1u); break; } }
    }
    nloc = mine > 0u ? mine : 1u; nx = cnt > 0u ? cnt : 1u;
}

__device__ __forceinline__ void xcd_barrier(const XcdBarrier& b) {
    asm volatile("s_waitcnt vmcnt(0)" ::: "memory");
    __syncthreads();
    if (threadIdx.x == 0) {
        unsigned* bar = b.bar;
        __builtin_amdgcn_s_waitcnt(0);
        unsigned nloc = b.st[0], nx = b.st[1];
        if (nloc == 0u) { xcd_barrier_complete(bar, b.x, nloc, nx); b.st[0] = nloc; b.st[1] = nx; }
        const unsigned old = xb_add(&bar[XB_XSUB(b.x)], 1u);
        const unsigned gen = old / nloc;
        if (old + 1u == (gen + 1u) * nloc) {
            __builtin_amdgcn_fence(__ATOMIC_RELEASE, "agent");
            asm volatile("s_waitcnt vmcnt(0)" ::: "memory");
            const unsigned og = xb_add(&bar[XB_TOP], 1u);
            const unsigned tg = og / nx;
            if (og + 1u == (tg + 1u) * nx) xb_add(&bar[XB_TOPGEN], 1u);
            else XB_SPIN(xb_ld(&bar[XB_TOPGEN]) == tg, bar);
            __builtin_amdgcn_fence(__ATOMIC_ACQUIRE, "agent");
            xb_add(&bar[XB_XGEN(b.x)], 1u);
            asm volatile("s_waitcnt vmcnt(0)" ::: "memory");
        } else {
            XB_SPIN(xb_ld(&bar[XB_XGEN(b.x)]) == gen, bar);
            __builtin_amdgcn_fence(__ATOMIC_ACQUIRE, "agent");
            asm volatile("s_waitcnt vmcnt(0)" ::: "memory");
        }
    }
    __syncthreads();
}


__global__ void __launch_bounds__(512, 2) mega(Params P, int ph_lo, int ph_hi) {
    extern __shared__ __attribute__((aligned(16))) unsigned char smem[];
    unsigned* xst = (unsigned*)(smem + LDS_BYTES - 32);
    if (threadIdx.x == 0) {
        const float** tab = (const float**)(smem + PTAB_OFF);
#pragma unroll
        for (int i = 0; i < N_IN; ++i) tab[i] = P.in[i];
        xst[0] = 0u; xst[1] = 0u;
    }
    __syncthreads();
    XcdBarrier xb = xcd_barrier_post((unsigned*)(P.ws + A_BAR), (volatile LAS unsigned*)xst);
#ifndef DUP_MASK
#define DUP_MASK 0x400
#endif
    for (int ph = ph_lo; ph < ph_hi; ++ph) {
        int nrep = 1;
        if (DUP_MASK) { const int sidx = ph == 0 ? 10 : (ph - 1) % 10; if ((DUP_MASK >> sidx) & 1) nrep = 2; }
        for (int rep = 0; rep < nrep; ++rep) {
            run_phase(P, ph, smem, rep);
            if (ph + 1 < ph_hi || rep + 1 < nrep) xcd_barrier(xb);
        }
    }
}


#ifndef DBG_STOP
#define DBG_STOP 0
#endif
#ifndef DBG_OFF
#define DBG_OFF R_Z
#endif
__global__ void dbg_dump(const unsigned char* ws, float* out, size_t n) {
    const bf16_t* src = (const bf16_t*)(ws + DBG_OFF);
    for (size_t i = (size_t)blockIdx.x * blockDim.x + threadIdx.x; i < n; i += (size_t)gridDim.x * blockDim.x) out[i] = bf2f(src[i]);
}

extern "C" void kernel_launch(void* const* d_in, const int* in_sizes, int n_in, void* d_out, int out_size, void* d_ws, size_t ws_size, hipStream_t stream) {
    (void)in_sizes; (void)n_in; (void)out_size;
    if (ws_size < WS_TOTAL) { fprintf(stderr, "workspace too small: %zu < %zu\n", ws_size, (size_t)WS_TOTAL); return; }
    Params p{};
    for (int i = 0; i < N_IN; ++i) p.in[i] = (const float*)d_in[i];
    p.out = (float*)d_out; p.ws = (unsigned char*)d_ws;
    hipFuncSetAttribute((const void*)mega, hipFuncAttributeMaxDynamicSharedMemorySize, LDS_BYTES);
    int dev = 0, cus = 256, per_cu = 1;
    hipGetDevice(&dev);
    hipDeviceGetAttribute(&cus, hipDeviceAttributeMultiprocessorCount, dev);
    hipOccupancyMaxActiveBlocksPerMultiprocessor(&per_cu, mega, 512, LDS_BYTES);
    if (per_cu < 1) per_cu = 1;
    const int grid = cus * 1;
#if COOP
#ifndef PH_HI
#define PH_HI NPHASE
#endif
    hipMemsetAsync((unsigned char*)d_ws + A_BAR, 0, 16384, stream);
    int lo = 0, hi = PH_HI;
    void* args[] = {&p, &lo, &hi};
    hipError_t e = hipLaunchCooperativeKernel((void*)mega, dim3(grid), dim3(512), args, LDS_BYTES, stream);
    if (e != hipSuccess) fprintf(stderr, "cooperative launch failed: %s (grid %d)\n", hipGetErrorString(e), grid);
#else
#if DBG_STOP
    for (int ph = 0; ph < DBG_STOP; ++ph) hipLaunchKernelGGL(mega, dim3(grid), dim3(512), LDS_BYTES, stream, p, ph, ph + 1);
#ifdef DBG_EXTRA
    hipLaunchKernelGGL(mega, dim3(grid), dim3(512), LDS_BYTES, stream, p, DBG_EXTRA, DBG_EXTRA + 1);
#endif
    hipLaunchKernelGGL(dbg_dump, dim3(2048), dim3(256), 0, stream, (const unsigned char*)d_ws, (float*)d_out, (size_t)34873344);
#else
    for (int ph = 0; ph < NPHASE; ++ph) hipLaunchKernelGGL(mega, dim3(grid), dim3(512), LDS_BYTES, stream, p, ph, ph + 1);
#endif
#endif
}
```

```cpp
#include <hip/hip_runtime.h>
#include <hip/hip_cooperative_groups.h>
#include <cstdio>
namespace cg = cooperative_groups;

#define DUP_MASK 0
#ifndef COOP
#define COOP 1
#endif
#ifndef OUTMASK
#define OUTMASK 0x3FFF
#endif
#ifndef OUT_BMAX
#define OUT_BMAX 1000
#endif
#ifndef OUT_L
#define OUT_L 3
#endif
#define OUT_ON(k) (((OUTMASK >> (k)) & 1) && ((OUT_L >> l) & 1))
#ifndef DMA_AUX
#define DMA_AUX 17
#endif

#define LAS __attribute__((address_space(3)))
typedef unsigned short bf16_t;
typedef short bf16x8 __attribute__((ext_vector_type(8)));
typedef float f32x4 __attribute__((ext_vector_type(4)));
typedef unsigned u32x4 __attribute__((ext_vector_type(4)));
typedef unsigned u32x2 __attribute__((ext_vector_type(2)));

constexpr int DM = 1024, NB = 8, SEQ = 2048, LP = 2064, DEC_B = 128, DEC_S = 4;
constexpr int TPR = NB * LP;
constexpr int TT = TPR + DEC_B * DEC_S;
constexpr int TPAD = 17152;
constexpr int DIN = 8448, DFF = 2816;
constexpr int ZO_UA = 0, ZO_XB = 768, ZO_GB = 1536, ZO_Q = 2304, ZO_K = 2816, ZO_V = 3328, ZO_GC = 4352, ZO_GATE = 5376;
constexpr int LDY = 2560;
constexpr float EPS = 1e-6f;
constexpr int LDS_BYTES = 143360;

enum { I_XP = 0, I_XS, I_S5RE, I_S5IM, I_LRUH, I_LRUC, I_RET, I_FFNC, I_META, I_GPREMIX, I_GPOSTMIX, I_GPREFFN, I_GPOSTFFN, I_WIN,
       I_AR, I_AI, I_LS, I_BR, I_BI, I_CR, I_CI, I_D, I_WGLU, I_BGLU, I_LCW, I_LCB, I_LWA, I_LBA, I_LWX, I_LBX, I_LAM, I_RNG,
       I_WBA, I_WBB, I_WBC, I_WOUT, I_WUP, I_FCW, I_FCB, I_WDOWN, N_IN };

constexpr size_t O_YP = 0;
constexpr size_t O_YS = O_YP + (size_t)NB * SEQ * DM;
constexpr size_t O_P_S5RE = O_YS + (size_t)DEC_B * DEC_S * DM;
constexpr size_t O_P_S5IM = O_P_S5RE + 2 * NB * 48 * 64;
constexpr size_t O_P_LRUH = O_P_S5IM + 2 * NB * 48 * 64;
constexpr size_t O_P_LRUC = O_P_LRUH + 2 * NB * 768;
constexpr size_t O_P_RET = O_P_LRUC + 2 * NB * 3 * 768;
constexpr size_t O_P_FFNC = O_P_RET + (size_t)2 * NB * 8 * 64 * 128;
constexpr size_t O_S_S5RE = O_P_FFNC + 2 * NB * 2 * DFF;
constexpr size_t O_S_S5IM = O_S_S5RE + 2 * DEC_B * 48 * 64;
constexpr size_t O_S_LRUH = O_S_S5IM + 2 * DEC_B * 48 * 64;
constexpr size_t O_S_LRUC = O_S_LRUH + 2 * DEC_B * 768;
constexpr size_t O_S_RET = O_S_LRUC + 2 * DEC_B * 3 * 768;
constexpr size_t O_S_FFNC = O_S_RET + (size_t)2 * DEC_B * 8 * 64 * 128;

constexpr size_t al256(size_t x) { return (x + 255) & ~(size_t)255; }
constexpr size_t W_IN = 0;
constexpr size_t W_GLU = W_IN + (size_t)2 * DIN * DM * 2;
constexpr size_t W_BR = W_GLU + (size_t)2 * 768 * 768 * 2;
constexpr size_t W_OUT = W_BR + (size_t)2 * DM * LDY * 2;
constexpr size_t W_UP = W_OUT + (size_t)2 * DM * DM * 2;
constexpr size_t W_DOWN = W_UP + (size_t)2 * 2 * DFF * DM * 2;
constexpr size_t A_X = W_DOWN + (size_t)2 * DM * DFF * 2;
constexpr int GR = 6400;
constexpr size_t R_Z = A_X + (size_t)TPAD * DM * 4;
constexpr size_t R_ZS5 = R_Z + (size_t)GR * DIN * 2;
constexpr size_t R_Y = R_ZS5 + (size_t)GR * 768 * 2;
constexpr size_t R_M = R_Y + (size_t)GR * LDY * 2;
constexpr size_t R_END = R_M + (size_t)GR * DM * 2;
constexpr size_t R_H = R_M;
constexpr size_t R_F = R_Z;
constexpr size_t R_UP = R_Z + (size_t)GR * DM * 4;
constexpr size_t R_FIN = R_ZS5;
static_assert(R_UP + (size_t)GR * 2 * DFF * 2 <= R_ZS5, "UP inside Z");
static_assert(R_FIN + (size_t)GR * DFF * 2 <= R_M, "FIN inside ZS5|Y");
constexpr size_t A_ROPE = R_END;
constexpr size_t A_CTR = al256(A_ROPE + (size_t)2068 * 64 * 4);
constexpr size_t A_BAR = A_CTR + 4096;
constexpr size_t WS_TOTAL = A_BAR + 16384;
constexpr int NGRP = 3;
constexpr int NPHASE = 1 + 2 * NGRP * 10;

struct Grp { int g0, nrows, npan, pb0, npb, hasS; };
__device__ __forceinline__ Grp get_grp(int g) {
    Grp r; r.g0 = g * 6192; r.nrows = g < 2 ? 6192 : 4640; r.npan = g < 2 ? 25 : 19; r.pb0 = g * 3; r.npb = g < 2 ? 3 : 2; r.hasS = g == 2; return r;
}

struct Params {
    const float* in[N_IN];
    float* out;
    unsigned char* ws;
};


constexpr int PTAB_OFF = 142336;
__device__ __forceinline__ const float* ldin(const unsigned char* smem, int i) {
    const unsigned long long v = ((const unsigned long long*)(smem + PTAB_OFF))[i];
    const unsigned lo = __builtin_amdgcn_readfirstlane((unsigned)v), hi = __builtin_amdgcn_readfirstlane((unsigned)(v >> 32));
    return (const float*)(((unsigned long long)hi << 32) | lo);
}
#define INP(i) ldin(smem, (i))
__device__ __forceinline__ int otid() { int t = threadIdx.x; asm volatile("" : "+v"(t)); return t; }

__device__ __forceinline__ float bf2f(bf16_t b) { return __uint_as_float(((unsigned)b) << 16); }
__device__ __forceinline__ bf16_t f2bf(float f) { unsigned u = __float_as_uint(f); u += 0x7FFFu + ((u >> 16) & 1u); return (bf16_t)(u >> 16); }
__device__ __forceinline__ unsigned pk2(float lo, float hi) { return (unsigned)f2bf(lo) | ((unsigned)f2bf(hi) << 16); }
__device__ __forceinline__ float sigm(float x) { return __builtin_amdgcn_rcpf(1.0f + __expf(-x)); }
__device__ __forceinline__ float gelu_t(float x) { const float v = 1.5957691216f * (x + 0.044715f * x * x * x); return x * __builtin_amdgcn_rcpf(1.0f + __expf(-v)); }
__device__ __forceinline__ void lds_wait() { asm volatile("s_waitcnt lgkmcnt(0)" ::: "memory"); __builtin_amdgcn_wave_barrier(); }
__device__ __forceinline__ f32x4 mfma16(bf16x8 a, bf16x8 b, f32x4 c) { return __builtin_amdgcn_mfma_f32_16x16x32_bf16(a, b, c, 0, 0, 0); }

namespace pg8 {
constexpr int BM = 256, BK = 64, HALF = 128, HTB = HALF * BK * 2, STAGE_BYTES = 8 * HTB, NXCD = 8, WGM = 8;
__device__ __forceinline__ int lds_byte(int r, int c) { const int st = (r >> 4) * 2 + (c >> 5), rr = r & 15, cc = c & 31, ob = rr * 64 + cc * 2; return st * 1024 + (ob ^ (((ob >> 9) & 1) << 5)); }
__device__ __forceinline__ void stage_rc(int b, int& R, int& C) { const int st = b / 1024, sb = b % 1024, swz = sb ^ (((sb >> 9) & 1) << 5); R = (st >> 1) * 16 + swz / 64; C = (st & 1) * 32 + (swz % 64) / 2; }

struct Unit { int pm, pn, br; };
struct Gemm { const bf16_t* A; const bf16_t* Bt; int lda, ldb, nM, nN, nt; };

struct SchedOne {
    int pm, pn, nt0;
    __device__ bool next(int i, Unit& u) const { if (i != 0) return false; u.pm = pm; u.pn = pn; u.br = 0; return true; }
    __device__ __forceinline__ void kr(const Unit&, size_t& koffB, int& nt) const { koffB = 0; nt = nt0; }
};
template <int NBR> struct Sched {
    int nM, nN, nwg, G, c, nt0;
    __device__ void init(int nM_, int nN_, int G_, int c_, int nt_) { nM = nM_; nN = nN_; nwg = nM * nN; G = G_; c = c_; nt0 = nt_; }
    __device__ bool next(int i, Unit& u) const {
        int wgid;
        if (NBR == 2) {
            const long L = (long)i * G + c; if (L >= 2 * (long)nwg) return false;
            u.br = (int)(L / nwg); wgid = (int)(L - (long)u.br * nwg);
        } else {
            const int ti = i / NBR; u.br = i - ti * NBR;
            const long L = (long)ti * G + c; if (L >= nwg) return false;
            wgid = (int)L;
        } { const int q = nwg / NXCD, r = nwg % NXCD, xcd = wgid % NXCD, off = wgid / NXCD; wgid = (xcd < r ? xcd * (q + 1) : r * (q + 1) + (xcd - r) * q) + off; }
        const int nig = WGM * nN, gid = wgid / nig, fm = gid * WGM, gsz = (nM - fm) < WGM ? (nM - fm) : WGM;
        u.pm = fm + ((wgid % nig) % gsz); u.pn = (wgid % nig) / gsz; return true;
    }
    __device__ __forceinline__ void kr(const Unit& u, size_t& koffB, int& nt) const {
        if (NBR == 1) { koffB = 0; nt = nt0; }
        else if (NBR == 2) { nt = nt0 >> 1; koffB = (size_t)u.br * (size_t)nt * 128; }
        else { koffB = (size_t)u.br * 1536; nt = (u.br == 2) ? 16 : 12; }
    }
};

__device__ __forceinline__ unsigned cvt_pk_bf16(float lo, float hi) { unsigned r; asm volatile("v_cvt_pk_bf16_f32 %0, %1, %2" : "=v"(r) : "v"(lo), "v"(hi)); return r; }

template <class Epi, class SchedT>
__device__ __forceinline__ void gemm_phase(LAS unsigned char* lds, const Gemm g, const SchedT& S, const Epi& E) {
    const int tid = otid(), wid = __builtin_amdgcn_readfirstlane(tid >> 6), lane = tid & 63, wr = wid >> 2, wc = wid & 3, fr = lane & 15, fq = lane >> 4;
    unsigned voffA[2], voffB[2];
#pragma unroll
    for (int i = 0; i < 2; ++i) { int R, C; stage_rc(tid * 16 + i * 8192, R, C);
        voffA[i] = (unsigned)(R * g.lda + C) * 2u; voffB[i] = (unsigned)(R * g.ldb + C) * 2u; }
    const size_t kstep = (size_t)(BK * 2);
    const size_t hstepA = (size_t)HALF * g.lda * 2, hstepB = (size_t)HALF * g.ldb * 2;
    const size_t tstepA = 2 * hstepA, tstepB = 2 * hstepB;
    const unsigned ldsw = (unsigned)wid * 1024u;
    const int aoff = lds_byte(wr * 64 + fr, fq * 8), boff = lds_byte(wc * 32 + fr, fq * 8);
#define PG8_SA(b, h) (((b) * 2 + (h)) * HTB)
#define PG8_SB(b, h) ((4 + (b) * 2 + (h)) * HTB)
#define PG8_STAGE(bufoff, gbase, voff) do { _Pragma("unroll") for (int _i = 0; _i < 2; ++_i) \
        __builtin_amdgcn_global_load_lds((const unsigned*)((const char*)(gbase) + (voff)[_i]), (LAS unsigned*)(lds + (bufoff) + ldsw + _i * 8192), 16, 0, DMA_AUX); } while (0)
#define PG8_LDA(dst, b, h) do { _Pragma("unroll") for (int m = 0; m < 4; ++m) _Pragma("unroll") for (int k = 0; k < 2; ++k) dst[m][k] = *(const LAS bf16x8*)(lds + PG8_SA(b, h) + aoff + m * 2048 + k * 1024); } while (0)
#define PG8_LDB(dst, b, h) do { _Pragma("unroll") for (int n = 0; n < 2; ++n) _Pragma("unroll") for (int k = 0; k < 2; ++k) dst[n][k] = *(const LAS bf16x8*)(lds + PG8_SB(b, h) + boff + n * 2048 + k * 1024); } while (0)
#define PG8_MMA(ai, bj, At, Bt) do { __builtin_amdgcn_s_setprio(1); _Pragma("unroll") for (int m = 0; m < 4; ++m) _Pragma("unroll") for (int n = 0; n < 2; ++n) _Pragma("unroll") for (int k = 0; k < 2; ++k) \
        acc[ai][bj][m][n] = __builtin_amdgcn_mfma_f32_16x16x32_bf16(Bt[n][k], At[m][k], acc[ai][bj][m][n], 0, 0, 0); __builtin_amdgcn_s_setprio(0); } while (0)
#define PG8_WAIT_V(n) asm volatile("s_waitcnt vmcnt(" #n ")" ::: "memory")
#define PG8_WAIT_L(n) asm volatile("s_waitcnt lgkmcnt(" #n ")" ::: "memory")
#define PG8_BAR __builtin_amdgcn_s_barrier()
#define PG8_SCHED __builtin_amdgcn_sched_barrier(0)
    Unit cur, nxt; int ui = 0;
    if (!S.next(0, cur)) return;
    f32x4 acc[2][2][4][2];
#pragma unroll
    for (int a = 0; a < 2; ++a)
#pragma unroll
        for (int b = 0; b < 2; ++b)
#pragma unroll
            for (int m = 0; m < 4; ++m)
#pragma unroll
                for (int n = 0; n < 2; ++n) acc[a][b][m][n] = (f32x4){0.f, 0.f, 0.f, 0.f};
    bf16x8 At[4][2], B0[2][2], B1[2][2];
    size_t koc; int ntc; S.kr(cur, koc, ntc);
    const char* cA = (const char*)g.A + (size_t)cur.pm * tstepA + koc; const char* cB = (const char*)g.Bt + (size_t)cur.pn * tstepB + koc;
    PG8_STAGE(PG8_SB(0, 0), cB, voffB); PG8_STAGE(PG8_SA(0, 0), cA, voffA); PG8_STAGE(PG8_SB(0, 1), cB + hstepB, voffB); PG8_STAGE(PG8_SA(0, 1), cA + hstepA, voffA);
    if (wr == 1) PG8_BAR;
    PG8_WAIT_V(4); PG8_BAR;
    PG8_STAGE(PG8_SB(1, 0), cB + kstep, voffB); PG8_STAGE(PG8_SA(1, 0), cA + kstep, voffA); PG8_STAGE(PG8_SB(1, 1), cB + hstepB + kstep, voffB);
    PG8_WAIT_V(6); PG8_BAR;
    for (;;) {
        const bool has_next = S.next(ui + 1, nxt);
        size_t kon = 0; int ntn = ntc; if (has_next) S.kr(nxt, kon, ntn);
        const char* nA = has_next ? (const char*)g.A + (size_t)nxt.pm * tstepA + kon : cA; const char* nB = has_next ? (const char*)g.Bt + (size_t)nxt.pn * tstepB + kon : cB;
        for (int t = 0; t < ntc; t += 2) {
            const bool last = (t == ntc - 2);
            const char* a1 = cA + (size_t)(t + 1) * kstep;
            const char* a2 = last ? nA : cA + (size_t)(t + 2) * kstep; const char* b2 = last ? nB : cB + (size_t)(t + 2) * kstep;
            const char* a3 = a2 + kstep; const char* b3 = b2 + kstep;
            PG8_LDB(B0, 0, 0); PG8_SCHED; PG8_LDA(At, 0, 0); PG8_STAGE(PG8_SA(1, 1), a1 + hstepA, voffA);
            PG8_WAIT_L(8); PG8_BAR; PG8_WAIT_L(0); PG8_MMA(0, 0, At, B0); PG8_BAR; PG8_SCHED;
            PG8_LDB(B1, 0, 1); PG8_STAGE(PG8_SB(0, 0), b2, voffB);
            PG8_BAR; PG8_WAIT_L(0); PG8_MMA(0, 1, At, B1); PG8_BAR;
            PG8_LDA(At, 0, 1); PG8_STAGE(PG8_SA(0, 0), a2, voffA);
            PG8_BAR; PG8_WAIT_L(0); PG8_MMA(1, 0, At, B0); PG8_BAR; PG8_SCHED;
            PG8_STAGE(PG8_SB(0, 1), b2 + hstepB, voffB);
            PG8_WAIT_V(6); PG8_BAR; PG8_MMA(1, 1, At, B1); PG8_BAR;
            PG8_LDB(B0, 1, 0); PG8_SCHED; PG8_LDA(At, 1, 0); PG8_STAGE(PG8_SA(0, 1), a2 + hstepA, voffA);
            PG8_WAIT_L(8); PG8_BAR; PG8_WAIT_L(0); PG8_MMA(0, 0, At, B0); PG8_BAR; PG8_SCHED;
            PG8_LDB(B1, 1, 1); PG8_STAGE(PG8_SB(1, 0), b3, voffB);
            PG8_BAR; PG8_WAIT_L(0); PG8_MMA(0, 1, At, B1); PG8_BAR;
            PG8_LDA(At, 1, 1); PG8_STAGE(PG8_SA(1, 0), a3, voffA);
            PG8_BAR; PG8_WAIT_L(0); PG8_MMA(1, 0, At, B0); PG8_BAR; PG8_SCHED;
            PG8_STAGE(PG8_SB(1, 1), b3 + hstepB, voffB);
            PG8_WAIT_V(6); PG8_BAR; PG8_MMA(1, 1, At, B1); PG8_BAR;
        }
        E(acc, cur, wr, wc, fr, fq);
        if (!has_next) break;
#pragma unroll
        for (int a = 0; a < 2; ++a)
#pragma unroll
            for (int b = 0; b < 2; ++b)
#pragma unroll
                for (int m = 0; m < 4; ++m)
#pragma unroll
                    for (int n = 0; n < 2; ++n) acc[a][b][m][n] = (f32x4){0.f, 0.f, 0.f, 0.f};
        cur = nxt; cA = nA; cB = nB; ntc = ntn; ++ui;
    }
    PG8_WAIT_V(0);
    if (wr == 0) PG8_BAR;
    PG8_BAR;
#undef PG8_SA
#undef PG8_SB
#undef PG8_STAGE
#undef PG8_LDA
#undef PG8_LDB
#undef PG8_MMA
#undef PG8_WAIT_V
#undef PG8_WAIT_L
#undef PG8_BAR
#undef PG8_SCHED
}

struct EpiBf {
    bf16_t* O; int ldc;
    __device__ __forceinline__ void operator()(const f32x4 (&acc)[2][2][4][2], const Unit& u, int wr, int wc, int fr, int fq) const {
        const int row0 = u.pm * BM + wr * 64 + fr, col0 = u.pn * BM + wc * 32 + 4 * fq;
#pragma unroll
        for (int ai = 0; ai < 2; ++ai)
#pragma unroll
            for (int m = 0; m < 4; ++m) { bf16_t* rowp = O + (size_t)(row0 + ai * HALF + m * 16) * ldc + col0;
#pragma unroll
                for (int bj = 0; bj < 2; ++bj)
#pragma unroll
                    for (int n = 0; n < 2; ++n) { const f32x4 v = acc[ai][bj][m][n]; u32x2 o; o.x = cvt_pk_bf16(v[0], v[1]); o.y = cvt_pk_bf16(v[2], v[3]); *(u32x2*)(rowp + bj * HALF + n * 16) = o; } }
    }
};
struct EpiF32 {
    float* C; int ldc; float* C2;
    __device__ __forceinline__ void operator()(const f32x4 (&acc)[2][2][4][2], const Unit& u, int wr, int wc, int fr, int fq) const {
        const int row0 = u.pm * BM + wr * 64 + fr, col0 = u.pn * BM + wc * 32 + 4 * fq;
        float* C = u.br ? this->C2 : this->C;
#pragma unroll
        for (int ai = 0; ai < 2; ++ai)
#pragma unroll
            for (int m = 0; m < 4; ++m) { float* rowp = C + (size_t)(row0 + ai * HALF + m * 16) * ldc + col0;
#pragma unroll
                for (int bj = 0; bj < 2; ++bj)
#pragma unroll
                    for (int n = 0; n < 2; ++n) *(f32x4*)(rowp + bj * HALF + n * 16) = acc[ai][bj][m][n]; }
    }
};
struct EpiGlu {
    bf16_t* Y; const bf16_t* Z; const float* bias;
    __device__ __forceinline__ void operator()(const f32x4 (&acc)[2][2][4][2], const Unit& u, int wr, int wc, int fr, int fq) const {
        const int row0 = u.pm * BM + wr * 64 + fr, col0 = u.pn * BM + wc * 32 + 4 * fq;
#pragma unroll
        for (int ai = 0; ai < 2; ++ai)
#pragma unroll
            for (int m = 0; m < 4; ++m) { const size_t r = (size_t)(row0 + ai * HALF + m * 16);
#pragma unroll
                for (int bj = 0; bj < 2; ++bj)
#pragma unroll
                    for (int n = 0; n < 2; ++n) { const int c = col0 + bj * HALF + n * 16; const f32x4 v = acc[ai][bj][m][n];
                        const u32x2 zz = *(const u32x2*)(Z + r * 768 + c); const f32x4 bb = *(const f32x4*)(bias + c);
                        const float z0 = __uint_as_float(zz.x << 16), z1 = __uint_as_float(zz.x & 0xffff0000u), z2 = __uint_as_float(zz.y << 16), z3 = __uint_as_float(zz.y & 0xffff0000u);
                        u32x2 o; o.x = cvt_pk_bf16(z0 * sigm(v[0] + bb[0]), z1 * sigm(v[1] + bb[1])); o.y = cvt_pk_bf16(z2 * sigm(v[2] + bb[2]), z3 * sigm(v[3] + bb[3]));
                        *(u32x2*)(Y + r * LDY + c) = o; } }
    }
};
struct EpiBranch {
    const bf16_t* Zg; bf16_t* Mo;
    __device__ __forceinline__ void operator()(const f32x4 (&acc)[2][2][4][2], const Unit& u, int wr, int wc, int fr, int fq) const {
        const int row0 = u.pm * BM + wr * 64 + fr, col0 = u.pn * BM + wc * 32 + 4 * fq; const int br = u.br;
#pragma unroll
        for (int ai = 0; ai < 2; ++ai)
#pragma unroll
            for (int m = 0; m < 4; ++m) { const size_t r = (size_t)(row0 + ai * HALF + m * 16);
#pragma unroll
                for (int bj = 0; bj < 2; ++bj)
#pragma unroll
                    for (int n = 0; n < 2; ++n) { const int c = col0 + bj * HALF + n * 16; const f32x4 v = acc[ai][bj][m][n];
                        const u32x2 gg = *(const u32x2*)(Zg + r * DIN + br * 1024 + c);
                        f32x4 t; t[0] = v[0] * sigm(__uint_as_float(gg.x << 16)); t[1] = v[1] * sigm(__uint_as_float(gg.x & 0xffff0000u));
                        t[2] = v[2] * sigm(__uint_as_float(gg.y << 16)); t[3] = v[3] * sigm(__uint_as_float(gg.y & 0xffff0000u));
                        bf16_t* mp = Mo + r * DM + c;
                        if (br != 0) { u32x2 p; p.x = __hip_atomic_load((const unsigned*)mp, __ATOMIC_RELAXED, __HIP_MEMORY_SCOPE_AGENT); p.y = __hip_atomic_load((const unsigned*)mp + 1, __ATOMIC_RELAXED, __HIP_MEMORY_SCOPE_AGENT); t[0] += __uint_as_float(p.x << 16); t[1] += __uint_as_float(p.x & 0xffff0000u); t[2] += __uint_as_float(p.y << 16); t[3] += __uint_as_float(p.y & 0xffff0000u); }
                        u32x2 o; o.x = cvt_pk_bf16(t[0], t[1]); o.y = cvt_pk_bf16(t[2], t[3]); *(u32x2*)mp = o; } }
    }
};

#ifndef GEMM_SIMPLE
#define GEMM_SIMPLE 0
#endif
template <class Epi, class SchedT>
__device__ __forceinline__ void gemm_simple(LAS unsigned char* lds, const Gemm g, const SchedT& S, const Epi& E) {
    const int tid = otid(), wid = __builtin_amdgcn_readfirstlane(tid >> 6), lane = tid & 63, wr = wid >> 2, wc = wid & 3, fr = lane & 15, fq = lane >> 4;
    unsigned voffA[2], voffB[2];
#pragma unroll
    for (int i = 0; i < 2; ++i) { int R, C; stage_rc(tid * 16 + i * 8192, R, C);
        voffA[i] = (unsigned)(R * g.lda + C) * 2u; voffB[i] = (unsigned)(R * g.ldb + C) * 2u; }
    const size_t hstepA = (size_t)HALF * g.lda * 2, hstepB = (size_t)HALF * g.ldb * 2;
    const int aoff = lds_byte(wr * 64 + fr, fq * 8), boff = lds_byte(wc * 32 + fr, fq * 8);
    Unit cur;
    for (int ui = 0; S.next(ui, cur); ++ui) {
        size_t koc; int ntc; S.kr(cur, koc, ntc);
        const char* cA = (const char*)g.A + (size_t)cur.pm * 2 * hstepA + koc; const char* cB = (const char*)g.Bt + (size_t)cur.pn * 2 * hstepB + koc;
        f32x4 acc[2][2][4][2];
#pragma unroll
        for (int a = 0; a < 2; ++a)
#pragma unroll
            for (int b = 0; b < 2; ++b)
#pragma unroll
                for (int m = 0; m < 4; ++m)
#pragma unroll
                    for (int n = 0; n < 2; ++n) acc[a][b][m][n] = (f32x4){0.f, 0.f, 0.f, 0.f};
        for (int t = 0; t < ntc; ++t) {
            u32x4 ra[2][2], rb[2][2];
#pragma unroll
            for (int h = 0; h < 2; ++h)
#pragma unroll
                for (int i = 0; i < 2; ++i) { ra[h][i] = *(const u32x4*)(cA + (size_t)t * 128 + h * hstepA + voffA[i]); rb[h][i] = *(const u32x4*)(cB + (size_t)t * 128 + h * hstepB + voffB[i]); }
            __syncthreads();
#pragma unroll
            for (int h = 0; h < 2; ++h)
#pragma unroll
                for (int i = 0; i < 2; ++i) { *(LAS u32x4*)(lds + h * HTB + tid * 16 + i * 8192) = ra[h][i]; *(LAS u32x4*)(lds + (4 + h) * HTB + tid * 16 + i * 8192) = rb[h][i]; }
            __syncthreads();
#pragma unroll
            for (int ai = 0; ai < 2; ++ai) {
                bf16x8 At[4][2];
#pragma unroll
                for (int m = 0; m < 4; ++m)
#pragma unroll
                    for (int k = 0; k < 2; ++k) At[m][k] = *(const LAS bf16x8*)(lds + ai * HTB + aoff + m * 2048 + k * 1024);
#pragma unroll
                for (int bj = 0; bj < 2; ++bj) {
                    bf16x8 Bf[2][2];
#pragma unroll
                    for (int n = 0; n < 2; ++n)
#pragma unroll
                        for (int k = 0; k < 2; ++k) Bf[n][k] = *(const LAS bf16x8*)(lds + (4 + bj) * HTB + boff + n * 2048 + k * 1024);
#pragma unroll
                    for (int m = 0; m < 4; ++m)
#pragma unroll
                        for (int n = 0; n < 2; ++n)
#pragma unroll
                            for (int k = 0; k < 2; ++k) acc[ai][bj][m][n] = __builtin_amdgcn_mfma_f32_16x16x32_bf16(Bf[n][k], At[m][k], acc[ai][bj][m][n], 0, 0, 0);
                }
            }
        }
        E(acc, cur, wr, wc, fr, fq);
    }
    __syncthreads();
}
template <class Epi, class SchedT>
__device__ __forceinline__ void gemm_run(LAS unsigned char* lds, const Gemm g, const SchedT& S, const Epi& E) {
#if GEMM_SIMPLE
    gemm_simple(lds, g, S, E);
#else
    gemm_phase(lds, g, S, E);
#endif
}
}

__device__ __forceinline__ void transpose_tile(const float* __restrict__ W, int N, bf16_t* __restrict__ dst, int ldd, int koff, int tk, int tn, float* tile) {
    const int tid = otid(), a = tid >> 6, bq = tid & 63;
    __syncthreads();
#pragma unroll
    for (int i = 0; i < 8; ++i) { const int k = a + 8 * i; tile[k * 65 + bq] = W[(size_t)(tk * 64 + k) * N + tn * 64 + bq]; }
    __syncthreads();
#pragma unroll
    for (int i = 0; i < 8; ++i) { const int n = a + 8 * i; dst[(size_t)(tn * 64 + n) * ldd + koff + tk * 64 + bq] = f2bf(tile[bq * 65 + n]); }
}

__device__ __forceinline__ void rms_store(const f32x4 (&xv)[4], const float* g, bf16_t* dst, int lane) {
    float ss = 0.f;
#pragma unroll
    for (int i = 0; i < 4; ++i) ss += xv[i][0] * xv[i][0] + xv[i][1] * xv[i][1] + xv[i][2] * xv[i][2] + xv[i][3] * xv[i][3];
#pragma unroll
    for (int o = 32; o > 0; o >>= 1) ss += __shfl_xor(ss, o);
    const float rs = rsqrtf(ss * (1.0f / DM) + EPS);
#pragma unroll
    for (int i = 0; i < 4; ++i) { const int c = lane * 4 + 256 * i; const f32x4 gn = *(const f32x4*)(g + c); const f32x4 hv = xv[i] * gn * rs;
        u32x2 o; o.x = pk2(hv[0], hv[1]); o.y = pk2(hv[2], hv[3]); *(u32x2*)(dst + c) = o; }
}
__device__ __forceinline__ void norm_rows(const Params& P, int mode, int l, int grp, const unsigned char* smem) {
    const int tid_ = otid(); const int wid = tid_ >> 6, lane = tid_ & 63;
    float* X = (float*)(P.ws + A_X);
    const int gw = blockIdx.x * 8 + wid, nw = gridDim.x * 8;
    if (mode == 0) {
        const float* g0p = INP(I_GPREMIX); bf16_t* H = (bf16_t*)(P.ws + R_H);
        for (int row = gw; row < TPAD; row += nw) {
            f32x4 xv[4];
            if (row >= TT) {
#pragma unroll
                for (int i = 0; i < 4; ++i) xv[i] = (f32x4){0.f, 0.f, 0.f, 0.f};
            } else {
                const bool isP = row < TPR; int b = 0, t = 0; if (isP) { b = row / LP; t = row - b * LP; }
                const float* src = isP ? (t < 16 ? INP(I_META) + (size_t)t * DM : INP(I_XP) + ((size_t)b * SEQ + (t - 16)) * DM) : INP(I_XS) + (size_t)(row - TPR) * DM;
#pragma unroll
                for (int i = 0; i < 4; ++i) xv[i] = *(const f32x4*)(src + lane * 4 + 256 * i);
            }
#pragma unroll
            for (int i = 0; i < 4; ++i) *(f32x4*)(X + (size_t)row * DM + lane * 4 + 256 * i) = xv[i];
            if (row < 6192) rms_store(xv, g0p, H + (size_t)row * DM, lane);
        }
        return;
    }
    const Grp G = get_grp(grp);
    const float* F = (const float*)(P.ws + R_F) - (size_t)G.g0 * DM;
    const float* F2 = (const float*)(P.ws + R_UP) - (size_t)G.g0 * DM;
    bf16_t* H = (bf16_t*)(P.ws + R_H) - (size_t)G.g0 * DM;
    const bool fin = (mode == 2 && l == 1);
    const float* gpost = (mode == 1 ? INP(I_GPOSTMIX) : INP(I_GPOSTFFN)) + l * DM;
    const float* gffn = INP(I_GPREFFN) + l * DM;
    for (int row = G.g0 + gw; row < G.g0 + G.nrows; row += nw) {
        f32x4 xv[4], fv[4]; float ss = 0.f;
#pragma unroll
        for (int i = 0; i < 4; ++i) { const int c = lane * 4 + 256 * i; xv[i] = *(const f32x4*)(X + (size_t)row * DM + c); fv[i] = *(const f32x4*)(F + (size_t)row * DM + c); fv[i] = fv[i] + *(const f32x4*)(F2 + (size_t)row * DM + c);
            ss += fv[i][0] * fv[i][0] + fv[i][1] * fv[i][1] + fv[i][2] * fv[i][2] + fv[i][3] * fv[i][3]; }
#pragma unroll
        for (int o = 32; o > 0; o >>= 1) ss += __shfl_xor(ss, o);
        const float rs = rsqrtf(ss * (1.0f / DM) + EPS);
#pragma unroll
        for (int i = 0; i < 4; ++i) { const f32x4 gp = *(const f32x4*)(gpost + lane * 4 + 256 * i); xv[i] = xv[i] + fv[i] * gp * rs; }
        if (fin) {
            float* dst = nullptr;
            if (row < TPR) { const int b = row / LP, t = row - b * LP; if (t >= 16 && ((OUTMASK >> 0) & 1)) dst = P.out + O_YP + ((size_t)b * SEQ + (t - 16)) * DM; }
            else if ((OUTMASK >> 1) & 1) dst = P.out + O_YS + (size_t)(row - TPR) * DM;
            if (dst) {
#pragma unroll
                for (int i = 0; i < 4; ++i) *(f32x4*)(dst + lane * 4 + 256 * i) = xv[i];
            }
        } else {
#pragma unroll
            for (int i = 0; i < 4; ++i) *(f32x4*)(X + (size_t)row * DM + lane * 4 + 256 * i) = xv[i];
        }
        if (mode == 1) rms_store(xv, gffn, H + (size_t)row * DM, lane);
    }
    if (mode == 2) {
        int nl = l, ng = grp + 1; if (ng == NGRP) { ng = 0; nl = l + 1; }
        if (nl < 2) {
            const Grp N = get_grp(ng); const float* gn = INP(I_GPREMIX) + nl * DM; bf16_t* Hn = (bf16_t*)(P.ws + R_H) - (size_t)N.g0 * DM;
            for (int row = N.g0 + gw; row < N.g0 + N.nrows; row += nw) {
                f32x4 xv[4];
#pragma unroll
                for (int i = 0; i < 4; ++i) xv[i] = *(const f32x4*)(X + (size_t)row * DM + lane * 4 + 256 * i);
                rms_store(xv, gn, Hn + (size_t)row * DM, lane);
            }
        }
    }
}

__device__ __forceinline__ void phase0(const Params& P, unsigned char* smem) {
    float* tile = (float*)smem;
    constexpr int C0 = 2112, C1 = C0 + 144, C2 = C1 + 192, C3 = C2 + 192, C4 = C3 + 256, C5 = C4 + 256, C6 = C5 + 1408, C7 = C6 + 704;
    for (int id = blockIdx.x; id < 2 * C7; id += gridDim.x) {
        const int l = id / C7; int j = id - l * C7;
        const float* W; int N, ldd, koff = 0; bf16_t* dst;
        if (j < C0) { W = INP(I_WIN) + (size_t)l * DM * DIN; N = DIN; dst = (bf16_t*)(P.ws + W_IN) + (size_t)l * DIN * DM; ldd = DM; }
        else if (j < C1) { j -= C0; W = INP(I_WGLU) + (size_t)l * 768 * 768; N = 768; dst = (bf16_t*)(P.ws + W_GLU) + (size_t)l * 768 * 768; ldd = 768; }
        else if (j < C2) { j -= C1; W = INP(I_WBA) + (size_t)l * 768 * DM; N = DM; dst = (bf16_t*)(P.ws + W_BR) + (size_t)l * DM * LDY; ldd = LDY; }
        else if (j < C3) { j -= C2; W = INP(I_WBB) + (size_t)l * 768 * DM; N = DM; dst = (bf16_t*)(P.ws + W_BR) + (size_t)l * DM * LDY; ldd = LDY; koff = 768; }
        else if (j < C4) { j -= C3; W = INP(I_WBC) + (size_t)l * DM * DM; N = DM; dst = (bf16_t*)(P.ws + W_BR) + (size_t)l * DM * LDY; ldd = LDY; koff = 1536; }
        else if (j < C5) { j -= C4; W = INP(I_WOUT) + (size_t)l * DM * DM; N = DM; dst = (bf16_t*)(P.ws + W_OUT) + (size_t)l * DM * DM; ldd = DM; }
        else if (j < C6) { j -= C5; W = INP(I_WUP) + (size_t)l * DM * 2 * DFF; N = 2 * DFF; dst = (bf16_t*)(P.ws + W_UP) + (size_t)l * 2 * DFF * DM; ldd = DM; }
        else { j -= C6; W = INP(I_WDOWN) + (size_t)l * DFF * DM; N = DM; dst = (bf16_t*)(P.ws + W_DOWN) + (size_t)l * DM * DFF; ldd = DFF; }
        const int ntn = N / 64; const int tk = j / ntn, tn = j - tk * ntn;
        transpose_tile(W, N, dst, ldd, koff, tk, tn, tile);
    }
    norm_rows(P, 0, 0, 0, smem);
    float* rt = (float*)(P.ws + A_ROPE);
    for (int i = blockIdx.x * 512 + threadIdx.x; i < 2068 * 32; i += gridDim.x * 512) {
        const int pi = i >> 5, fi = i & 31; const double pos = pi < LP ? (double)pi : (double)(16384 + pi - LP);
        const double inv = exp(-(double)fi * (9.210340371976184 / 32.0));
        double ang = pos * inv; const double k = rint(ang * 0.15915494309189535); ang = ang - k * 6.283185307179586;
        const float af = (float)ang; rt[2 * i] = cosf(af); rt[2 * i + 1] = sinf(af);
    }
    if (blockIdx.x == 0 && threadIdx.x < 64) ((unsigned*)(P.ws + A_CTR))[threadIdx.x] = 0u;
}

__device__ __forceinline__ void ffn_conv_phase(const Params& P, int l, int grp, const unsigned char* smem) {
    const Grp G = get_grp(grp);
    const bf16_t* UP = (const bf16_t*)(P.ws + R_UP) - (size_t)G.g0 * (2 * DFF); bf16_t* FIN = (bf16_t*)(P.ws + R_FIN) - (size_t)G.g0 * DFF;
    const float* cw = INP(I_FCW) + (size_t)l * 3 * DFF; const float* cb = INP(I_FCB) + (size_t)l * DFF;
    const float* cache = INP(I_FFNC) + (size_t)l * DEC_B * 2 * DFF;
    constexpr int NCG = DFF / 8;
    for (int it = blockIdx.x * 512 + threadIdx.x; it < G.nrows * NCG; it += gridDim.x * 512) {
        const int rr = it / NCG, c = (it - rr * NCG) * 8, row = G.g0 + rr;
        int b, t, L; const bool isP = row < TPR;
        if (isP) { b = row / LP; t = row - b * LP; L = LP; } else { b = (row - TPR) >> 2; t = (row - TPR) & 3; L = 4; }
        float g0[8], g1[8], g2[8], uf[8];
        { const u32x4 v = *(const u32x4*)(UP + (size_t)row * (2 * DFF) + c);
#pragma unroll
          for (int i = 0; i < 4; ++i) { g0[2 * i] = __uint_as_float(v[i] << 16); g0[2 * i + 1] = __uint_as_float(v[i] & 0xffff0000u); } }
        { const u32x4 v = *(const u32x4*)(UP + (size_t)row * (2 * DFF) + DFF + c);
#pragma unroll
          for (int i = 0; i < 4; ++i) { uf[2 * i] = __uint_as_float(v[i] << 16); uf[2 * i + 1] = __uint_as_float(v[i] & 0xffff0000u); } }
        if (t >= 1) { const u32x4 v = *(const u32x4*)(UP + (size_t)(row - 1) * (2 * DFF) + c);
#pragma unroll
            for (int i = 0; i < 4; ++i) { g1[2 * i] = __uint_as_float(v[i] << 16); g1[2 * i + 1] = __uint_as_float(v[i] & 0xffff0000u); } }
        else {
#pragma unroll
            for (int i = 0; i < 8; ++i) g1[i] = isP ? 0.f : cache[((size_t)b * 2 + 1) * DFF + c + i]; }
        if (t >= 2) { const u32x4 v = *(const u32x4*)(UP + (size_t)(row - 2) * (2 * DFF) + c);
#pragma unroll
            for (int i = 0; i < 4; ++i) { g2[2 * i] = __uint_as_float(v[i] << 16); g2[2 * i + 1] = __uint_as_float(v[i] & 0xffff0000u); } }
        else {
#pragma unroll
            for (int i = 0; i < 8; ++i) g2[i] = isP ? 0.f : cache[((size_t)b * 2 + t) * DFF + c + i]; }
        float o[8];
#pragma unroll
        for (int i = 0; i < 8; ++i) { const float gc = cb[c + i] + cw[c + i] * g2[i] + cw[DFF + c + i] * g1[i] + cw[2 * DFF + c + i] * g0[i]; o[i] = gelu_t(gc) * uf[i]; }
        u32x4 ov; ov[0] = pk2(o[0], o[1]); ov[1] = pk2(o[2], o[3]); ov[2] = pk2(o[4], o[5]); ov[3] = pk2(o[6], o[7]);
        *(u32x4*)(FIN + (size_t)row * DFF + c) = ov;
        if (t >= L - 2 && (isP ? OUT_ON(7) : OUT_ON(13))) {
            float* dst = isP ? P.out + O_P_FFNC + (((size_t)l * NB + b) * 2 + (t - (L - 2))) * DFF + c : P.out + O_S_FFNC + (((size_t)l * DEC_B + b) * 2 + (t - (L - 2))) * DFF + c;
#pragma unroll
            for (int i = 0; i < 8; ++i) dst[i] = g0[i];
        }
    }
}

__device__ __forceinline__ void ret_job(const Params& P, int l, int grp, int b, int h, int g0, unsigned char* smem) {
    const int tid = otid(), w = __builtin_amdgcn_readfirstlane(tid >> 6), lane = tid & 63, fr = lane & 15, fq = lane >> 4;
    bf16_t* sQ = (bf16_t*)smem;
    bf16_t* sK = sQ + 128 * 72;
    bf16_t* sKdT = sK + 128 * 72;
    bf16_t* sVT = sKdT + 64 * 136;
    bf16_t* sST = sVT + 128 * 136;
    bf16_t* sP = sST + 128 * 72 + w * 16 * 136;
    const bf16_t* Z = (const bf16_t*)(P.ws + R_Z) - (size_t)g0 * DIN; bf16_t* Y = (bf16_t*)(P.ws + R_Y) - (size_t)g0 * LDY;
    const float* rope = (const float*)(P.ws + A_ROPE);
    const int L = grp ? 4 : LP, rowb = grp ? TPR + b * 4 : b * LP, tabb = grp ? LP : 0;
    const float lg = log1pf(-exp2f(-5.0f - (float)h));
    const float* ng = INP(I_RNG) + (size_t)l * 1024 + h * 128;
    f32x4 accS[4];
    float* Sout = P.out + (grp ? O_S_RET + (((size_t)l * DEC_B + b) * 8 + h) * 8192 : O_P_RET + (((size_t)l * NB + b) * 8 + h) * 8192);
    if (grp) { const float* S0 = INP(I_RET) + (((size_t)l * DEC_B + b) * 8 + h) * 8192;
#pragma unroll
        for (int dt = 0; dt < 4; ++dt)
#pragma unroll
            for (int j = 0; j < 4; ++j) accS[dt][j] = S0[(16 * dt + 4 * fq + j) * 128 + 16 * w + fr];
    } else {
#pragma unroll
        for (int dt = 0; dt < 4; ++dt) accS[dt] = (f32x4){0.f, 0.f, 0.f, 0.f};
    }
    __syncthreads();
#pragma unroll
    for (int dt = 0; dt < 4; ++dt) { u32x2 o; o.x = pk2(accS[dt][0], accS[dt][1]); o.y = pk2(accS[dt][2], accS[dt][3]); *(u32x2*)(sST + (16 * w + fr) * 72 + 16 * dt + 4 * fq) = o; }
    const int nch = grp ? 1 : 17;
    u32x4 q1 = {0u, 0u, 0u, 0u}, q2 = q1, k1 = q1, k2 = q1, vv[4];
#define RET_LOAD(ckx) do { const int _t0 = grp ? 0 : ((ckx) == 0 ? 0 : 16 + ((ckx) - 1) * 128), _C = grp ? 4 : ((ckx) == 0 ? 16 : 128); \
        const int _m = tid >> 2, _i0 = (tid & 3) * 8, _m2 = tid & 127, _e0 = (tid >> 7) * 32; \
        q1 = (u32x4){0u, 0u, 0u, 0u}; q2 = q1; k1 = q1; k2 = q1; \
        if (_m < _C) { const size_t _zr = (size_t)(rowb + _t0 + _m) * DIN; \
            q1 = *(const u32x4*)(Z + _zr + ZO_Q + h * 64 + _i0); q2 = *(const u32x4*)(Z + _zr + ZO_Q + h * 64 + 32 + _i0); \
            k1 = *(const u32x4*)(Z + _zr + ZO_K + h * 64 + _i0); k2 = *(const u32x4*)(Z + _zr + ZO_K + h * 64 + 32 + _i0); } \
        _Pragma("unroll") for (int _i = 0; _i < 4; ++_i) vv[_i] = (u32x4){0u, 0u, 0u, 0u}; \
        if (_m2 < _C) { const bf16_t* _vp = Z + (size_t)(rowb + _t0 + _m2) * DIN + ZO_V + h * 128 + _e0; \
            _Pragma("unroll") for (int _i = 0; _i < 4; ++_i) vv[_i] = *(const u32x4*)(_vp + 8 * _i); } } while (0)
    RET_LOAD(0);
    for (int ck = 0; ck < nch; ++ck) {
        const int t0 = grp ? 0 : (ck == 0 ? 0 : 16 + (ck - 1) * 128), C = grp ? 4 : (ck == 0 ? 16 : 128);
        {
            const int m = tid >> 2, i0 = (tid & 3) * 8;
            u32x4 q1w = {0u, 0u, 0u, 0u}, q2w = q1w, k1w = q1w, k2w = q1w;
            float kd1[8], kd2[8];
#pragma unroll
            for (int e = 0; e < 8; ++e) { kd1[e] = 0.f; kd2[e] = 0.f; }
            if (m < C) {
                const float* rp = rope + ((size_t)(tabb + t0 + m) * 32 + i0) * 2;
                const float kdec = __expf(lg * (float)(C - 1 - m));
                float qo1[8], qo2[8], ko1[8], ko2[8];
#pragma unroll
                for (int e = 0; e < 8; ++e) {
                    const float cs = rp[2 * e], sn = rp[2 * e + 1];
                    const unsigned qa = q1[e >> 1], qb = q2[e >> 1], ka = k1[e >> 1], kb = k2[e >> 1];
                    const float x1 = (e & 1) ? __uint_as_float(qa & 0xffff0000u) : __uint_as_float(qa << 16);
                    const float x2 = (e & 1) ? __uint_as_float(qb & 0xffff0000u) : __uint_as_float(qb << 16);
                    const float y1 = ((e & 1) ? __uint_as_float(ka & 0xffff0000u) : __uint_as_float(ka << 16)) * 0.125f;
                    const float y2 = ((e & 1) ? __uint_as_float(kb & 0xffff0000u) : __uint_as_float(kb << 16)) * 0.125f;
                    qo1[e] = x1 * cs - x2 * sn; qo2[e] = x2 * cs + x1 * sn;
                    ko1[e] = y1 * cs - y2 * sn; ko2[e] = y2 * cs + y1 * sn;
                    kd1[e] = ko1[e] * kdec; kd2[e] = ko2[e] * kdec;
                }
#pragma unroll
                for (int e = 0; e < 4; ++e) { q1w[e] = pk2(qo1[2 * e], qo1[2 * e + 1]); q2w[e] = pk2(qo2[2 * e], qo2[2 * e + 1]); k1w[e] = pk2(ko1[2 * e], ko1[2 * e + 1]); k2w[e] = pk2(ko2[2 * e], ko2[2 * e + 1]); }
            }
            *(u32x4*)(sQ + m * 72 + i0) = q1w; *(u32x4*)(sQ + m * 72 + 32 + i0) = q2w;
            *(u32x4*)(sK + m * 72 + i0) = k1w; *(u32x4*)(sK + m * 72 + 32 + i0) = k2w;
#pragma unroll
            for (int e = 0; e < 8; ++e) { sKdT[(i0 + e) * 136 + m] = f2bf(kd1[e]); sKdT[(32 + i0 + e) * 136 + m] = f2bf(kd2[e]); }
            const int m2 = tid & 127, e0 = (tid >> 7) * 32;
#pragma unroll
            for (int i = 0; i < 4; ++i)
#pragma unroll
                for (int e = 0; e < 4; ++e) { sVT[(e0 + 8 * i + 2 * e) * 136 + m2] = (bf16_t)(vv[i][e] & 0xffffu); sVT[(e0 + 8 * i + 2 * e + 1) * 136 + m2] = (bf16_t)(vv[i][e] >> 16); }
        }
        __syncthreads();
        if (ck + 1 < nch) RET_LOAD(ck + 1);
        f32x4 o[8];
        const bool act = (16 * w < C);
        unsigned gcp[4][4];
        if (act) {
#pragma unroll
            for (int j = 0; j < 4; ++j) { const int n = 16 * w + 4 * fq + j; const size_t row = (size_t)(rowb + t0 + (n < C ? n : 0));
#pragma unroll
                for (int e2 = 0; e2 < 4; ++e2) { const bf16_t lo = Z[row * DIN + ZO_GC + h * 128 + 32 * e2 + fr], hi = Z[row * DIN + ZO_GC + h * 128 + 32 * e2 + 16 + fr]; gcp[e2][j] = (unsigned)lo | ((unsigned)hi << 16); } }
        }
        if (act) {
            bf16x8 qf[2];
#pragma unroll
            for (int ks = 0; ks < 2; ++ks) qf[ks] = *(const bf16x8*)(sQ + (16 * w + fr) * 72 + 32 * ks + 8 * fq);
            const int mtN = (w | 1) + 1;
            for (int mt = 0; mt < mtN; ++mt) {
                f32x4 a = {0.f, 0.f, 0.f, 0.f};
#pragma unroll
                for (int ks = 0; ks < 2; ++ks) { const bf16x8 kf = *(const bf16x8*)(sK + (16 * mt + fr) * 72 + 32 * ks + 8 * fq); a = mfma16(qf[ks], kf, a); }
#pragma unroll
                for (int j = 0; j < 4; ++j) { const int d = (16 * w + 4 * fq + j) - (16 * mt + fr); const float v = d >= 0 ? a[j] * __expf(lg * (float)d) : 0.f; sP[(4 * fq + j) * 136 + 16 * mt + fr] = f2bf(v); }
            }
            lds_wait();
#pragma unroll
            for (int et = 0; et < 8; ++et) o[et] = (f32x4){0.f, 0.f, 0.f, 0.f};
            const int ksN = mtN >> 1;
            for (int ks = 0; ks < ksN; ++ks) {
                const bf16x8 pf = *(const bf16x8*)(sP + fr * 136 + 32 * ks + 8 * fq);
#pragma unroll
                for (int et = 0; et < 8; ++et) { const bf16x8 vf = *(const bf16x8*)(sVT + (16 * et + fr) * 136 + 32 * ks + 8 * fq); o[et] = mfma16(pf, vf, o[et]); }
            }
            f32x4 o2[8];
#pragma unroll
            for (int et = 0; et < 8; ++et) o2[et] = (f32x4){0.f, 0.f, 0.f, 0.f};
#pragma unroll
            for (int ks = 0; ks < 2; ++ks)
#pragma unroll
                for (int et = 0; et < 8; ++et) { const bf16x8 sf = *(const bf16x8*)(sST + (16 * et + fr) * 72 + 32 * ks + 8 * fq); o2[et] = mfma16(qf[ks], sf, o2[et]); }
#pragma unroll
            for (int j = 0; j < 4; ++j) { const float sc = __expf(lg * (float)(16 * w + 4 * fq + j + 1));
#pragma unroll
                for (int et = 0; et < 8; ++et) o[et][j] += o2[et][j] * sc; }
        }
        {
            const float gC = __expf(lg * (float)C);
#pragma unroll
            for (int dt = 0; dt < 4; ++dt) accS[dt] = accS[dt] * gC;
            const int ksN = (C + 31) >> 5;
            for (int ks = 0; ks < ksN; ++ks) {
                const bf16x8 vf = *(const bf16x8*)(sVT + (16 * w + fr) * 136 + 32 * ks + 8 * fq);
#pragma unroll
                for (int dt = 0; dt < 4; ++dt) { const bf16x8 kf = *(const bf16x8*)(sKdT + (16 * dt + fr) * 136 + 32 * ks + 8 * fq); accS[dt] = mfma16(kf, vf, accS[dt]); }
            }
        }
        __syncthreads();
#pragma unroll
        for (int dt = 0; dt < 4; ++dt) { u32x2 ow; ow.x = pk2(accS[dt][0], accS[dt][1]); ow.y = pk2(accS[dt][2], accS[dt][3]); *(u32x2*)(sST + (16 * w + fr) * 72 + 16 * dt + 4 * fq) = ow; }
        if (act) {
#pragma unroll
            for (int j = 0; j < 4; ++j) {
                float s = 0.f;
#pragma unroll
                for (int et = 0; et < 8; ++et) s += o[et][j];
                s += __shfl_xor(s, 1); s += __shfl_xor(s, 2); s += __shfl_xor(s, 4); s += __shfl_xor(s, 8);
                const float mu = s * (1.0f / 128.0f);
                float s2 = 0.f;
#pragma unroll
                for (int et = 0; et < 8; ++et) { const float d = o[et][j] - mu; s2 += d * d; }
                s2 += __shfl_xor(s2, 1); s2 += __shfl_xor(s2, 2); s2 += __shfl_xor(s2, 4); s2 += __shfl_xor(s2, 8);
                const float rstd = rsqrtf(s2 * (1.0f / 128.0f) + EPS);
                const int n = 16 * w + 4 * fq + j;
                if (n < C) {
                    const size_t row = (size_t)(rowb + t0 + n);
#pragma unroll
                    for (int et = 0; et < 8; ++et) { const int e = 16 * et + fr; const unsigned gw_ = gcp[et >> 1][j]; const float gcv = (et & 1) ? __uint_as_float(gw_ & 0xffff0000u) : __uint_as_float(gw_ << 16);
                        const float yv = gcv * sigm(gcv) * (o[et][j] - mu) * rstd * ng[e]; Y[row * LDY + 1536 + h * 128 + e] = f2bf(yv); }
                }
            }
        }
    }
    if (grp ? OUT_ON(12) : OUT_ON(6)) {
#pragma unroll
    for (int dt = 0; dt < 4; ++dt)
#pragma unroll
        for (int j = 0; j < 4; ++j) Sout[(16 * dt + 4 * fq + j) * 128 + 16 * w + fr] = accS[dt][j];
    }
}

__device__ __forceinline__ void lru_job(const Params& P, int l, int grp, int jid, int g0, int pb0, unsigned char* smem) {
    const int tid = otid(), w = __builtin_amdgcn_readfirstlane(tid >> 6), lane = tid & 63, fr = lane & 15, fq = lane >> 4;
    bf16_t* sA = (bf16_t*)(smem + w * 10752);
    float* sRI = (float*)(smem + w * 10752 + 2304);
    float* sComb = (float*)(smem + 8 * 10752);
    const bf16_t* Z = (const bf16_t*)(P.ws + R_Z) - (size_t)g0 * DIN; bf16_t* Y = (bf16_t*)(P.ws + R_Y) - (size_t)g0 * LDY;
    const int unit = grp ? jid * 8 + w : jid;
    const int bl = unit / 12, hb = unit - bl * 12, ch = hb * 64 + lane; const int b = grp ? bl : pb0 + bl;
    const int L = grp ? 4 : LP, rowb = grp ? TPR + b * 4 : b * LP;
    float cw[4];
#pragma unroll
    for (int j = 0; j < 4; ++j) cw[j] = INP(I_LCW)[((size_t)l * 4 + j) * 768 + ch];
    const float cb = INP(I_LCB)[l * 768 + ch], ba = INP(I_LBA)[l * 768 + ch], bx = INP(I_LBX)[l * 768 + ch];
    const float lam = INP(I_LAM)[l * 768 + ch];
    const float sp8 = 8.0f * (fmaxf(-lam, 0.f) + log1pf(__expf(-fabsf(lam))));
    bf16x8 Wa[4][2], Wx[4][2];
    { const float* wa = INP(I_LWA) + ((size_t)l * 12 + hb) * 4096; const float* wx = INP(I_LWX) + ((size_t)l * 12 + hb) * 4096;
#pragma unroll
      for (int nt = 0; nt < 4; ++nt)
#pragma unroll
          for (int ks = 0; ks < 2; ++ks)
#pragma unroll
              for (int j = 0; j < 8; ++j) { const int k = 32 * ks + 8 * fq + j, n = 16 * nt + fr; Wa[nt][ks][j] = (short)f2bf(wa[k * 64 + n]); Wx[nt][ks][j] = (short)f2bf(wx[k * 64 + n]); } }
    float carry = grp ? INP(I_LRUH)[((size_t)l * DEC_B + b) * 768 + ch] : 0.f;
    const float* cache = INP(I_LRUC) + ((size_t)l * DEC_B + b) * 3 * 768;
    const int nIter = grp ? 1 : 17;
    __syncthreads();
#ifndef LRU_REP
#define LRU_REP 1
#endif
    bf16_t xn[19];
    { const int tw0 = grp ? 0 : 16 * w;
#pragma unroll
      for (int i = 0; i < 19; ++i) { int t = tw0 - 3 + i; t = t < 0 ? 0 : (t > L - 1 ? L - 1 : t); xn[i] = Z[(size_t)(rowb + t) * DIN + ZO_XB + ch]; } }
    for (int it_ = 0; it_ < nIter * (grp ? 1 : LRU_REP); ++it_) {
        const int it = it_ % nIter; if (LRU_REP > 1 && it_ == nIter) carry = 0.f;
        const int tw = grp ? 0 : it * 128 + 16 * w;
        float xv[19];
#pragma unroll
        for (int i = 0; i < 19; ++i) { const int t = tw - 3 + i; xv[i] = (t >= 0 && t < L) ? bf2f(xn[i]) : 0.f; }
        if (grp) {
#pragma unroll
            for (int i = 0; i < 3; ++i) xv[i] = cache[i * 768 + ch];
        }
        if (it_ + 1 < nIter * (grp ? 1 : LRU_REP)) {
            const int twn = tw + 128;
#pragma unroll
            for (int i = 0; i < 19; ++i) { int t = twn - 3 + i; t = t < 0 ? 0 : (t > L - 1 ? L - 1 : t); xn[i] = Z[(size_t)(rowb + t) * DIN + ZO_XB + ch]; }
        }
        unsigned gtp[8];
#pragma unroll
        for (int i = 0; i < 8; ++i) { const int ta = tw + 2 * i, tb = ta + 1;
            const bf16_t lo = Z[(size_t)(rowb + (ta < L ? ta : L - 1)) * DIN + ZO_GB + ch], hi = Z[(size_t)(rowb + (tb < L ? tb : L - 1)) * DIN + ZO_GB + ch];
            gtp[i] = (unsigned)lo | ((unsigned)hi << 16); }
        float xc[16];
#pragma unroll
        for (int i = 0; i < 16; ++i) { xc[i] = cb + cw[0] * xv[i] + cw[1] * xv[i + 1] + cw[2] * xv[i + 2] + cw[3] * xv[i + 3]; sA[i * 72 + lane] = f2bf(xc[i]); }
        lds_wait();
        bf16x8 af[2];
#pragma unroll
        for (int ks = 0; ks < 2; ++ks) af[ks] = *(const bf16x8*)(sA + fr * 72 + 32 * ks + 8 * fq);
#pragma unroll
        for (int nt = 0; nt < 4; ++nt) {
            f32x4 ra = {0.f, 0.f, 0.f, 0.f}, rx = ra;
            ra = mfma16(af[0], Wa[nt][0], ra); ra = mfma16(af[1], Wa[nt][1], ra);
            rx = mfma16(af[0], Wx[nt][0], rx); rx = mfma16(af[1], Wx[nt][1], rx);
#pragma unroll
            for (int j = 0; j < 4; ++j) { sRI[(4 * fq + j) * 132 + 16 * nt + fr] = ra[j]; sRI[(4 * fq + j) * 132 + 64 + 16 * nt + fr] = rx[j]; }
        }
        lds_wait();
        float hloc[16], ca[16]; float hl = 0.f, cacc = 1.f;
#pragma unroll
        for (int i = 0; i < 16; ++i) {
            const float rp = sRI[i * 132 + lane], ip = sRI[i * 132 + 64 + lane];
            const float r = sigm(rp + ba), ii = sigm(ip + bx);
            const float la = -sp8 * r; float a = __expf(la);
            const float x2 = 2.0f * la;
            const float ser = -x2 * (1.0f + x2 * (0.5f + x2 * (0.16666667f + x2 * (0.041666668f + x2 * 0.0083333338f))));
            const float om = x2 > -0.25f ? ser : 1.0f - __expf(x2);
            float bv = __builtin_amdgcn_sqrtf(om) * ii * xc[i];
            if (tw + i >= L) { a = 1.f; bv = 0.f; }
            hl = a * hl + bv; cacc *= a; hloc[i] = hl; ca[i] = cacc;
        }
        float hin = carry;
        if (!grp) {
            sComb[(w * 64 + lane) * 2] = cacc; sComb[(w * 64 + lane) * 2 + 1] = hl;
            __syncthreads();
            float run = carry;
#pragma unroll
            for (int ww = 0; ww < 8; ++ww) { if (ww == w) hin = run; run = sComb[(ww * 64 + lane) * 2] * run + sComb[(ww * 64 + lane) * 2 + 1]; }
            carry = run;
            __syncthreads();
        } else carry = hloc[15] + ca[15] * hin;
#pragma unroll
        for (int i = 0; i < 16; ++i) { const int t = tw + i;
            if (t < L) { const size_t row = (size_t)(rowb + t); const float hh = hloc[i] + ca[i] * hin; const unsigned gw_ = gtp[i >> 1]; const float gt = (i & 1) ? __uint_as_float(gw_ & 0xffff0000u) : __uint_as_float(gw_ << 16); Y[row * LDY + 768 + ch] = f2bf(hh * gelu_t(gt)); } }
    }
    if (grp || w == 0) {
        float* ho = grp ? P.out + O_S_LRUH + ((size_t)l * DEC_B + b) * 768 + ch : P.out + O_P_LRUH + ((size_t)l * NB + b) * 768 + ch;
        if (grp ? OUT_ON(10) : OUT_ON(4)) *ho = carry;
        float* co = grp ? P.out + O_S_LRUC + ((size_t)l * DEC_B + b) * 3 * 768 + ch : P.out + O_P_LRUC + ((size_t)l * NB + b) * 3 * 768 + ch;
#pragma unroll
        for (int j = 0; j < 3; ++j) if (grp ? OUT_ON(11) : OUT_ON(5)) co[j * 768] = bf2f(Z[(size_t)(rowb + L - 3 + j) * DIN + ZO_XB + ch]);
    }
}

template <bool FULL>
__device__ __forceinline__ void s5_run(const bf16_t* Z, bf16_t* ZS, float* sBU, bf16_t* sH, const bf16x8 (&Bf)[8], const bf16x8 (&Cf)[4], float abr, float abi, float dsk,
                                       int rowb, int g, int L, int it0, int it1, float& hr, float& hi, int lane, int fr, int fq) {
    u32x4 ufn = {0u, 0u, 0u, 0u}; bf16_t udn[4] = {0, 0, 0, 0};
    { const int t1 = it0 * 16; const int v1 = (L - t1) < 16 ? (L - t1) : 16;
      if (fq < 2 && fr < v1) ufn = *(const u32x4*)(Z + (size_t)(rowb + t1 + fr) * DIN + ZO_UA + g * 16 + 8 * fq);
      if (FULL) {
#pragma unroll
          for (int j = 0; j < 4; ++j) if (4 * fq + j < v1) udn[j] = Z[(size_t)(rowb + t1 + 4 * fq + j) * DIN + ZO_UA + g * 16 + fr]; } }
    for (int it = it0; it < it1; ++it) {
        const int t0 = it * 16; const int valid = (L - t0) < 16 ? (L - t0) : 16;
        const bf16x8 uf = __builtin_bit_cast(bf16x8, ufn);
        bf16_t ud[4];
#pragma unroll
        for (int j = 0; j < 4; ++j) ud[j] = udn[j];
        if (it + 1 < it1) { const int t1 = t0 + 16; const int v1 = (L - t1) < 16 ? (L - t1) : 16;
            ufn = (u32x4){0u, 0u, 0u, 0u};
            if (fq < 2 && fr < v1) ufn = *(const u32x4*)(Z + (size_t)(rowb + t1 + fr) * DIN + ZO_UA + g * 16 + 8 * fq);
            if (FULL) {
#pragma unroll
                for (int j = 0; j < 4; ++j) { udn[j] = 0; if (4 * fq + j < v1) udn[j] = Z[(size_t)(rowb + t1 + 4 * fq + j) * DIN + ZO_UA + g * 16 + fr]; } } }
#pragma unroll
        for (int nt = 0; nt < 8; ++nt) { f32x4 a = {0.f, 0.f, 0.f, 0.f}; a = mfma16(uf, Bf[nt], a);
#pragma unroll
            for (int j = 0; j < 4; ++j) sBU[(4 * fq + j) * 132 + 16 * nt + fr] = a[j]; }
        lds_wait();
#pragma unroll
        for (int i = 0; i < 16; ++i) {
            float bur = sBU[i * 132 + lane], bui = sBU[i * 132 + 64 + lane];
            asm volatile("" : "+v"(bur), "+v"(bui));
            const float msk = (i < valid) ? 1.0f : 0.0f;
            float nr = __builtin_fmaf(abr, hr, bur); asm volatile("" : "+v"(nr));
            nr = __builtin_fmaf(-abi, hi, nr); asm volatile("" : "+v"(nr));
            float ni = __builtin_fmaf(abr, hi, bui); asm volatile("" : "+v"(ni));
            ni = __builtin_fmaf(abi, hr, ni); asm volatile("" : "+v"(ni));
            hr = __builtin_fmaf(msk, nr - hr, hr); hi = __builtin_fmaf(msk, ni - hi, hi);
            asm volatile("" : "+v"(hr), "+v"(hi));
            if (FULL) { sH[i * 136 + lane] = f2bf(hr); sH[i * 136 + 64 + lane] = f2bf(hi); }
        }
        lds_wait();
        if (FULL) {
            f32x4 y = {0.f, 0.f, 0.f, 0.f};
#pragma unroll
            for (int ks = 0; ks < 4; ++ks) { const bf16x8 hf = *(const bf16x8*)(sH + fr * 136 + 32 * ks + 8 * fq); y = mfma16(hf, Cf[ks], y); }
#pragma unroll
            for (int j = 0; j < 4; ++j) { const int t = 4 * fq + j;
                if (t < valid) { const size_t row = (size_t)(rowb + t0 + t); const float u = bf2f(ud[j]); ZS[row * 768 + g * 16 + fr] = f2bf(gelu_t(y[j] + dsk * u)); } }
            lds_wait();
        }
    }
}
__device__ __forceinline__ void cmul(float& ar, float& ai, float br, float bi) { const float r = ar * br - ai * bi, i = ar * bi + ai * br; ar = r; ai = i; }

__device__ __forceinline__ void s5_job(const Params& P, int l, int grp, int jid, int g0, int pb0, unsigned* s5done, unsigned char* smem) {
    const int tid = otid(), w = __builtin_amdgcn_readfirstlane(tid >> 6), lane = tid & 63, fr = lane & 15, fq = lane >> 4;
    float* sBU = (float*)(smem + w * 12800);
    bf16_t* sH = (bf16_t*)(smem + w * 12800 + 8448);
    float* sC = (float*)(smem + 8 * 12800);
    const bf16_t* Z = (const bf16_t*)(P.ws + R_Z) - (size_t)g0 * DIN; bf16_t* ZS = (bf16_t*)(P.ws + R_ZS5) - (size_t)g0 * 768;
    int g, b0;
    if (grp) { const int unit = jid * 8 + w; g = unit % 48; b0 = (unit / 48) * 16; } else { b0 = jid / 48; g = jid - b0 * 48; b0 += pb0; }
    const float dt = __expf(INP(I_LS)[l * 48 + g]);
    float abr = 0.f, abi = 0.f;
    bf16x8 Bf[8];
#pragma unroll
    for (int k = 0; k < 4; ++k) {
        const int p = 16 * k + fr;
        const float lr = INP(I_AR)[((size_t)l * 48 + g) * 64 + p], li = INP(I_AI)[((size_t)l * 48 + g) * 64 + p];
        const float mag = expf(lr * dt), ar_ = mag * cosf(li * dt), ai_ = mag * sinf(li * dt);
        if (k == fq) { abr = ar_; abi = ai_; }
        const float den = lr * lr + li * li, nr = ar_ - 1.0f;
        const float cr = (nr * lr + ai_ * li) / den, ci = (ai_ * lr - nr * li) / den;
        bf16x8 fre, fim;
#pragma unroll
        for (int j = 0; j < 8; ++j) { fre[j] = 0; fim[j] = 0; }
        if (fq < 2) {
            const float* bre = INP(I_BR) + (((size_t)l * 48 + g) * 64 + p) * 16 + 8 * fq; const float* bim = INP(I_BI) + (((size_t)l * 48 + g) * 64 + p) * 16 + 8 * fq;
#pragma unroll
            for (int j = 0; j < 8; ++j) { const float br_ = bre[j], bi_ = bim[j]; fre[j] = (short)f2bf(cr * br_ - ci * bi_); fim[j] = (short)f2bf(cr * bi_ + ci * br_); }
        }
        Bf[k] = fre; Bf[4 + k] = fim;
    }
    bf16x8 Cf[4];
#pragma unroll
    for (int ks = 0; ks < 4; ++ks) {
        const float* cp = (ks < 2 ? INP(I_CR) : INP(I_CI)) + (((size_t)l * 48 + g) * 16 + fr) * 64 + 32 * (ks & 1) + 8 * fq;
        const float sg = ks < 2 ? 1.0f : -1.0f;
#pragma unroll
        for (int j = 0; j < 8; ++j) Cf[ks][j] = (short)f2bf(sg * cp[j]);
    }
    const float dsk = INP(I_D)[l * 768 + g * 16 + fr];
    __syncthreads();
    if (grp) {
        for (int s = 0; s < 16; ++s) {
            const int b = b0 + s; const int rowb = TPR + b * 4;
            float hr = INP(I_S5RE)[(((size_t)l * DEC_B + b) * 48 + g) * 64 + lane], hi = INP(I_S5IM)[(((size_t)l * DEC_B + b) * 48 + g) * 64 + lane];
            s5_run<true>(Z, ZS, sBU, sH, Bf, Cf, abr, abi, dsk, rowb, g, 4, 0, 1, hr, hi, lane, fr, fq);
            P.out[O_S_S5RE + (((size_t)l * DEC_B + b) * 48 + g) * 64 + lane] = hr;
            P.out[O_S_S5IM + (((size_t)l * DEC_B + b) * 48 + g) * 64 + lane] = hi;
        }
    } else {
        const int b = b0, rowb = b * LP;
        const int it0 = w == 0 ? 0 : 17 + 16 * (w - 1), it1 = 17 + 16 * w;
        float hr = 0.f, hi = 0.f;
        s5_run<false>(Z, ZS, sBU, sH, Bf, Cf, abr, abi, dsk, rowb, g, LP, it0, it1, hr, hi, lane, fr, fq);
        sC[(w * 64 + lane) * 2] = hr; sC[(w * 64 + lane) * 2 + 1] = hi;
        float pr = abr, pi = abi, p16r = 0.f, p16i = 0.f;
#pragma unroll
        for (int q = 0; q < 8; ++q) { cmul(pr, pi, pr, pi); if (q == 3) { p16r = pr; p16i = pi; } }
        float qr = pr, qi = pi; cmul(qr, qi, p16r, p16i);
        __syncthreads();
        float cr_ = 0.f, ci_ = 0.f;
        for (int ww = 0; ww < w; ++ww) {
            const float ar2 = ww == 0 ? qr : pr, ai2 = ww == 0 ? qi : pi;
            cmul(cr_, ci_, ar2, ai2);
            cr_ += sC[(ww * 64 + lane) * 2]; ci_ += sC[(ww * 64 + lane) * 2 + 1];
        }
        hr = cr_; hi = ci_;
        s5_run<true>(Z, ZS, sBU, sH, Bf, Cf, abr, abi, dsk, rowb, g, LP, it0, it1, hr, hi, lane, fr, fq);
        if (w == 7) {
            P.out[O_P_S5RE + (((size_t)l * NB + b) * 48 + g) * 64 + lane] = hr;
            P.out[O_P_S5IM + (((size_t)l * NB + b) * 48 + g) * 64 + lane] = hi;
        }
    }
    asm volatile("s_waitcnt vmcnt(0)" ::: "memory");
    __syncthreads();
    if (threadIdx.x == 0) { __threadfence(); atomicAdd(s5done, 1u); }
}

__device__ __forceinline__ void mixers_phase(const Params& P, int l, int rg, unsigned char* smem, int rep) {
    const Grp G = get_grp(rg);
    const int j1 = G.npb * 8, j2 = j1 + G.npb * 12, j3 = j2 + G.npb * 48, j4 = j3 + (G.hasS ? 1024 : 0), j5 = j4 + (G.hasS ? 48 : 0), j6 = j5 + (G.hasS ? 192 : 0), NJ = j6 + G.npan * 3;
    unsigned* s5done = (unsigned*)(P.ws + A_CTR) + 32 + (l * NGRP + rg) + rep * 16;
    const unsigned s5total = (unsigned)(G.npb * 48 + (G.hasS ? 48 : 0));
    unsigned* ctr = (unsigned*)(P.ws + A_CTR) + (l * NGRP + rg) + rep * 16;
    int* slot = (int*)(smem + LDS_BYTES - 16);
#ifndef STATIC_JOBS
#define STATIC_JOBS 0
#endif
    for (int jj = blockIdx.x;; jj += gridDim.x) {
        __syncthreads();
#if STATIC_JOBS
        const int j = jj; (void)ctr; (void)slot;
#else
        if (threadIdx.x == 0) *slot = (int)atomicAdd(ctr, 1u);
        __syncthreads();
        const int j = *slot;
#endif
        if (j >= NJ) break;
        int type, sg, idx;
        if (j < j1) { type = 0; sg = 0; idx = j; }
        else if (j < j2) { type = 1; sg = 0; idx = j - j1; }
        else if (j < j3) { type = 2; sg = 0; idx = j - j2; }
        else if (j < j4) { type = 0; sg = 1; idx = j - j3; }
        else if (j < j5) { type = 2; sg = 1; idx = j - j4; }
        else if (j < j6) { type = 1; sg = 1; idx = j - j5; }
        else { type = 3; sg = 0; idx = j - j6; }
        if (type == 3) {
            if (threadIdx.x == 0) {
                unsigned sp = 0;
                while (__hip_atomic_load(s5done, __ATOMIC_RELAXED, __HIP_MEMORY_SCOPE_AGENT) < s5total) { __builtin_amdgcn_s_sleep(8); if (++sp > (1u << 22)) break; }
                __threadfence();
                asm volatile("s_waitcnt vmcnt(0)" ::: "memory");
            }
            __syncthreads();
            using namespace pg8;
            Gemm gg{(const bf16_t*)(P.ws + R_ZS5), (const bf16_t*)(P.ws + W_GLU) + (size_t)l * 768 * 768, 768, 768, G.npan, 3, 12};
            SchedOne S1{idx / 3, idx % 3, 12};
            EpiGlu E{(bf16_t*)(P.ws + R_Y), (const bf16_t*)(P.ws + R_ZS5), INP(I_BGLU) + l * 768};
            gemm_run((LAS unsigned char*)smem, gg, S1, E);
            continue;
        }
        if (type == 0) ret_job(P, l, sg, (idx >> 3) + (sg ? 0 : G.pb0), idx & 7, G.g0, smem);
        else if (type == 1) lru_job(P, l, sg, idx, G.g0, G.pb0, smem);
        else s5_job(P, l, sg, idx, G.g0, G.pb0, s5done, smem);
    }
}

__device__ __forceinline__ void run_phase(const Params& P, int ph, unsigned char* smem, int rep) {
#ifndef PHSEL
#define PHSEL -1
#endif
#define PSEL(x) (PHSEL < 0 || PHSEL == (x))
    if (ph == 0) { if (PSEL(10)) phase0(P, smem); return; }
    const int l = (ph - 1) / (10 * NGRP), rg = ((ph - 1) / 10) % NGRP, s = (ph - 1) % 10;
    LAS unsigned char* lds = (LAS unsigned char*)smem;
    unsigned char* ws = P.ws;
    using namespace pg8;
    const int G = gridDim.x, c = blockIdx.x;
    const int npan = rg < 2 ? 25 : 19;
    switch (s) {
    case 0: if (PSEL(0)) { Gemm g{(const bf16_t*)(ws + R_H), (const bf16_t*)(ws + W_IN) + (size_t)l * DIN * DM, DM, DM, npan, DIN / 256, DM / 64};
              Sched<1> S; S.init(g.nM, g.nN, G, c, g.nt); EpiBf E{(bf16_t*)(ws + R_Z), DIN}; gemm_run(lds, g, S, E); } break;
    case 1: if (PSEL(1)) mixers_phase(P, l, rg, smem, rep); break;
    case 2: if (PSEL(2)) { Gemm g{(const bf16_t*)(ws + R_ZS5), (const bf16_t*)(ws + W_GLU) + (size_t)l * 768 * 768, 768, 768, npan, 3, 12};
              Sched<1> S; S.init(g.nM, g.nN, G, c, g.nt); EpiGlu E{(bf16_t*)(ws + R_Y), (const bf16_t*)(ws + R_ZS5), INP(I_BGLU) + l * 768}; gemm_run(lds, g, S, E); } break;
    case 3: if (PSEL(3)) { Gemm g{(const bf16_t*)(ws + R_Y), (const bf16_t*)(ws + W_BR) + (size_t)l * DM * LDY, LDY, LDY, npan, 4, 0};
              Sched<3> S; S.init(g.nM, g.nN, G, c, 0); EpiBranch E{(const bf16_t*)(ws + R_Z) + ZO_GATE, (bf16_t*)(ws + R_M)}; gemm_run(lds, g, S, E); } break;
    case 4: if (PSEL(4)) { Gemm g{(const bf16_t*)(ws + R_M), (const bf16_t*)(ws + W_OUT) + (size_t)l * DM * DM, DM, DM, npan, 4, 16};
              Sched<2> S; S.init(g.nM, g.nN, G, c, g.nt); EpiF32 E{(float*)(ws + R_F), DM, (float*)(ws + R_UP)}; gemm_run(lds, g, S, E); } break;
    case 5: if (PSEL(5) && rep == 0) norm_rows(P, 1, l, rg, smem); break;
    case 6: if (PSEL(6)) { Gemm g{(const bf16_t*)(ws + R_H), (const bf16_t*)(ws + W_UP) + (size_t)l * 2 * DFF * DM, DM, DM, npan, 22, 16};
              Sched<1> S; S.init(g.nM, g.nN, G, c, g.nt); EpiBf E{(bf16_t*)(ws + R_UP), 2 * DFF}; gemm_run(lds, g, S, E); } break;
    case 7: if (PSEL(7)) ffn_conv_phase(P, l, rg, smem); break;
    case 8: if (PSEL(8)) { Gemm g{(const bf16_t*)(ws + R_FIN), (const bf16_t*)(ws + W_DOWN) + (size_t)l * DM * DFF, DFF, DFF, npan, 4, 44};
              Sched<2> S; S.init(g.nM, g.nN, G, c, g.nt); EpiF32 E{(float*)(ws + R_F), DM, (float*)(ws + R_UP)}; gemm_run(lds, g, S, E); } break;
    default: if (PSEL(9) && rep == 0) norm_rows(P, 2, l, rg, smem); break;
    }
}

#define XB_TMO      128
#define XB_XCNT(j)  (256  + 64 * (j))
#define XB_XSUB(j)  (1280 + 64 * (j))
#define XB_XGEN(j)  (2304 + 64 * (j))
#define XB_TOP      3328
#define XB_TOPGEN   3392
#define XCD_BAR_WORDS 3456
#define XB_SPIN_CAP (1u << 18)

__device__ __forceinline__ unsigned xb_ld(unsigned* p)              { return __hip_atomic_load(p, __ATOMIC_RELAXED, __HIP_MEMORY_SCOPE_AGENT); }
__device__ __forceinline__ unsigned xb_add(unsigned* p, unsigned v) { return __hip_atomic_fetch_add(p, v, __ATOMIC_RELAXED, __HIP_MEMORY_SCOPE_AGENT); }
__device__ __forceinline__ unsigned xb_xcc_id() { return (unsigned)__builtin_amdgcn_s_getreg((3 << 11) | 20) & 0xFu; }
#define XB_SPIN(cond, bar) do { unsigned _sp = 0; while (cond) { __builtin_amdgcn_s_sleep(1); \
    if ((++_sp & 255u) == 0u) { if (xb_ld(&(bar)[XB_TMO])) break; if (_sp > XB_SPIN_CAP) { atomicAdd(&(bar)[XB_TMO], 1u); break; } } } } while (0)

struct XcdBarrier {
    unsigned* bar; unsigned x;
    volatile LAS unsigned* st;
};

__device__ __forceinline__ XcdBarrier xcd_barrier_post(unsigned* bar, volatile LAS unsigned* st) {
    XcdBarrier b; b.bar = bar; b.x = xb_xcc_id(); b.st = st;
    if (threadIdx.x == 0) (void)xb_add(&bar[XB_XCNT(b.x)], 1u);
    return b;
}
__device__ __forceinline__ void xcd_barrier_complete(unsigned* bar, unsigned x, unsigned& nloc, unsigned& nx) {
    const unsigned G = gridDim.x * gridDim.y * gridDim.z;
    unsigned sum, cnt, mine, sp = 0u;
    for (;;) {
        sum = 0u; cnt = 0u; mine = 0u;
#pragma unroll
        for (unsigned j = 0; j < 16; ++j) { const unsigned c = xb_ld(&bar[XB_XCNT(j)]); sum += c; cnt += (c > 0u) ? 1u : 0u; mine = (j == x) ? c : mine; }
        if (sum == G) break;
        __builtin_amdgcn_s_sleep(1);
        if ((++sp & 255u) == 0u) { if (xb_ld(&bar[XB_TMO])) break; if (sp > XB_SPIN_CAP) { atomicAdd(&bar[XB_TMO], 1u); break; } }
    }
    nloc = mine > 0u ? mine : 1u; nx = cnt > 0u ? cnt : 1u;
}

__device__ __forceinline__ void xcd_barrier(const XcdBarrier& b) {
    asm volatile("s_waitcnt vmcnt(0)" ::: "memory");
    __syncthreads();
    if (threadIdx.x == 0) {
        unsigned* bar = b.bar;
        __builtin_amdgcn_s_waitcnt(0);
        unsigned nloc = b.st[0], nx = b.st[1];
        if (nloc == 0u) { xcd_barrier_complete(bar, b.x, nloc, nx); b.st[0] = nloc; b.st[1] = nx; }
        const unsigned old = xb_add(&bar[XB_XSUB(b.x)], 1u);
        const unsigned gen = old / nloc;
        if (old + 1u == (gen + 1u) * nloc) {
            __builtin_amdgcn_fence(__ATOMIC_RELEASE, "agent");
            asm volatile("s_waitcnt vmcnt(0)" ::: "memory");
            const unsigned og = xb_add(&bar[XB_TOP], 1u);
            const unsigned tg = og / nx;
            if (og + 1u == (tg + 1u) * nx) xb_add(&bar[XB_TOPGEN], 1u);
            else XB_SPIN(xb_ld(&bar[XB_TOPGEN]) == tg, bar);
            __builtin_amdgcn_fence(__ATOMIC_ACQUIRE, "agent");
            xb_add(&bar[XB_XGEN(b.x)], 1u);
            asm volatile("s_waitcnt vmcnt(0)" ::: "memory");
        } else {
            XB_SPIN(xb_ld(&bar[XB_XGEN(b.x)]) == gen, bar);
            __builtin_amdgcn_fence(__ATOMIC_ACQUIRE, "agent");
            asm volatile("s_waitcnt vmcnt(0)" ::: "memory");
        }
    }
    __syncthreads();
}


__global__ void __launch_bounds__(512, 2) mega(Params P, int ph_lo, int ph_hi) {
    extern __shared__ __attribute__((aligned(16))) unsigned char smem[];
    unsigned* xst = (unsigned*)(smem + LDS_BYTES - 32);
    if (threadIdx.x == 0) {
        const float** tab = (const float**)(smem + PTAB_OFF);
#pragma unroll
        for (int i = 0; i < N_IN; ++i) tab[i] = P.in[i];
        xst[0] = 0u; xst[1] = 0u;
    }
    __syncthreads();
    XcdBarrier xb = xcd_barrier_post((unsigned*)(P.ws + A_BAR), (volatile LAS unsigned*)xst);
#ifndef DUP_MASK
#define DUP_MASK 0x400
#endif
    for (int ph = ph_lo; ph < ph_hi; ++ph) {
        if (ph > 0 && (ph - 1) % 10 == 2) continue;
        int nrep = 1;
        if (DUP_MASK) { const int sidx = ph == 0 ? 10 : (ph - 1) % 10; if ((DUP_MASK >> sidx) & 1) nrep = 2; }
        for (int rep = 0; rep < nrep; ++rep) {
            run_phase(P, ph, smem, rep);
            if (ph + 1 < ph_hi || rep + 1 < nrep) xcd_barrier(xb);
        }
    }
}


#ifndef DBG_STOP
#define DBG_STOP 0
#endif
#ifndef DBG_OFF
#define DBG_OFF R_Z
#endif
__global__ void dbg_dump(const unsigned char* ws, float* out, size_t n) {
    const bf16_t* src = (const bf16_t*)(ws + DBG_OFF);
    for (size_t i = (size_t)blockIdx.x * blockDim.x + threadIdx.x; i < n; i += (size_t)gridDim.x * blockDim.x) out[i] = bf2f(src[i]);
}

extern "C" void kernel_launch(void* const* d_in, const int* in_sizes, int n_in, void* d_out, int out_size, void* d_ws, size_t ws_size, hipStream_t stream) {
    (void)in_sizes; (void)n_in; (void)out_size;
    if (ws_size < WS_TOTAL) { fprintf(stderr, "workspace too small: %zu < %zu\n", ws_size, (size_t)WS_TOTAL); return; }
    Params p{};
    for (int i = 0; i < N_IN; ++i) p.in[i] = (const float*)d_in[i];
    p.out = (float*)d_out; p.ws = (unsigned char*)d_ws;
    hipFuncSetAttribute((const void*)mega, hipFuncAttributeMaxDynamicSharedMemorySize, LDS_BYTES);
    int dev = 0, cus = 256, per_cu = 1;
    hipGetDevice(&dev);
    hipDeviceGetAttribute(&cus, hipDeviceAttributeMultiprocessorCount, dev);
    hipOccupancyMaxActiveBlocksPerMultiprocessor(&per_cu, mega, 512, LDS_BYTES);
    if (per_cu < 1) per_cu = 1;
    const int grid = cus * 1;
#if COOP
#ifndef PH_HI
#define PH_HI NPHASE
#endif
    hipMemsetAsync((unsigned char*)d_ws + A_BAR, 0, 16384, stream);
    int lo = 0, hi = PH_HI;
    void* args[] = {&p, &lo, &hi};
    hipError_t e = hipLaunchCooperativeKernel((void*)mega, dim3(grid), dim3(512), args, LDS_BYTES, stream);
    if (e != hipSuccess) fprintf(stderr, "cooperative launch failed: %s (grid %d)\n", hipGetErrorString(e), grid);
#else
#if DBG_STOP
    for (int ph = 0; ph < DBG_STOP; ++ph) hipLaunchKernelGGL(mega, dim3(grid), dim3(512), LDS_BYTES, stream, p, ph, ph + 1);
#ifdef DBG_EXTRA
    hipLaunchKernelGGL(mega, dim3(grid), dim3(512), LDS_BYTES, stream, p, DBG_EXTRA, DBG_EXTRA + 1);
#endif
    hipLaunchKernelGGL(dbg_dump, dim3(2048), dim3(256), 0, stream, (const unsigned char*)d_ws, (float*)d_out, (size_t)34873344);
#else
    for (int ph = 0; ph < NPHASE; ++ph) hipLaunchKernelGGL(mega, dim3(grid), dim3(512), LDS_BYTES, stream, p, ph, ph + 1);
#endif
#endif
}
```

```cpp
#include <hip/hip_runtime.h>
#include <hip/hip_cooperative_groups.h>
#include <cstdio>
namespace cg = cooperative_groups;

#define DUP_MASK 0
#ifndef COOP
#define COOP 1
#endif
#ifndef OUTMASK
#define OUTMASK 0x3FFF
#endif
#ifndef OUT_BMAX
#define OUT_BMAX 1000
#endif
#ifndef OUT_L
#define OUT_L 3
#endif
#define OUT_ON(k) (((OUTMASK >> (k)) & 1) && ((OUT_L >> l) & 1))
#ifndef DMA_AUX
#define DMA_AUX 17
#endif

#define LAS __attribute__((address_space(3)))
typedef unsigned short bf16_t;
typedef short bf16x8 __attribute__((ext_vector_type(8)));
typedef float f32x4 __attribute__((ext_vector_type(4)));
typedef unsigned u32x4 __attribute__((ext_vector_type(4)));
typedef unsigned u32x2 __attribute__((ext_vector_type(2)));

constexpr int DM = 1024, NB = 8, SEQ = 2048, LP = 2064, DEC_B = 128, DEC_S = 4;
constexpr int TPR = NB * LP;
constexpr int TT = TPR + DEC_B * DEC_S;
constexpr int TPAD = 17152;
constexpr int DIN = 8448, DFF = 2816;
constexpr int ZO_UA = 0, ZO_XB = 768, ZO_GB = 1536, ZO_Q = 2304, ZO_K = 2816, ZO_V = 3328, ZO_GC = 4352, ZO_GATE = 5376;
constexpr int LDY = 2560;
constexpr float EPS = 1e-6f;
constexpr int LDS_BYTES = 143360;

enum { I_XP = 0, I_XS, I_S5RE, I_S5IM, I_LRUH, I_LRUC, I_RET, I_FFNC, I_META, I_GPREMIX, I_GPOSTMIX, I_GPREFFN, I_GPOSTFFN, I_WIN,
       I_AR, I_AI, I_LS, I_BR, I_BI, I_CR, I_CI, I_D, I_WGLU, I_BGLU, I_LCW, I_LCB, I_LWA, I_LBA, I_LWX, I_LBX, I_LAM, I_RNG,
       I_WBA, I_WBB, I_WBC, I_WOUT, I_WUP, I_FCW, I_FCB, I_WDOWN, N_IN };

constexpr size_t O_YP = 0;
constexpr size_t O_YS = O_YP + (size_t)NB * SEQ * DM;
constexpr size_t O_P_S5RE = O_YS + (size_t)DEC_B * DEC_S * DM;
constexpr size_t O_P_S5IM = O_P_S5RE + 2 * NB * 48 * 64;
constexpr size_t O_P_LRUH = O_P_S5IM + 2 * NB * 48 * 64;
constexpr size_t O_P_LRUC = O_P_LRUH + 2 * NB * 768;
constexpr size_t O_P_RET = O_P_LRUC + 2 * NB * 3 * 768;
constexpr size_t O_P_FFNC = O_P_RET + (size_t)2 * NB * 8 * 64 * 128;
constexpr size_t O_S_S5RE = O_P_FFNC + 2 * NB * 2 * DFF;
constexpr size_t O_S_S5IM = O_S_S5RE + 2 * DEC_B * 48 * 64;
constexpr size_t O_S_LRUH = O_S_S5IM + 2 * DEC_B * 48 * 64;
constexpr size_t O_S_LRUC = O_S_LRUH + 2 * DEC_B * 768;
constexpr size_t O_S_RET = O_S_LRUC + 2 * DEC_B * 3 * 768;
constexpr size_t O_S_FFNC = O_S_RET + (size_t)2 * DEC_B * 8 * 64 * 128;

constexpr size_t al256(size_t x) { return (x + 255) & ~(size_t)255; }
constexpr size_t W_IN = 0;
constexpr size_t W_GLU = W_IN + (size_t)2 * DIN * DM * 2;
constexpr size_t W_BR = W_GLU + (size_t)2 * 768 * 768 * 2;
constexpr size_t W_OUT = W_BR + (size_t)2 * DM * LDY * 2;
constexpr size_t W_UP = W_OUT + (size_t)2 * DM * DM * 2;
constexpr size_t W_DOWN = W_UP + (size_t)2 * 2 * DFF * DM * 2;
constexpr size_t A_X = W_DOWN + (size_t)2 * DM * DFF * 2;
constexpr int GR = 6400;
constexpr size_t R_Z = A_X + (size_t)TPAD * DM * 4;
constexpr size_t R_ZS5 = R_Z + (size_t)GR * DIN * 2;
constexpr size_t R_Y = R_ZS5 + (size_t)GR * 768 * 2;
constexpr size_t R_M = R_Y + (size_t)GR * LDY * 2;
constexpr size_t R_END = R_M + (size_t)GR * DM * 2;
constexpr size_t R_H = R_M;
constexpr size_t R_F = R_Z;
constexpr size_t R_UP = R_Z + (size_t)GR * DM * 4;
constexpr size_t R_FIN = R_ZS5;
static_assert(R_UP + (size_t)GR * 2 * DFF * 2 <= R_ZS5, "UP inside Z");
static_assert(R_FIN + (size_t)GR * DFF * 2 <= R_M, "FIN inside ZS5|Y");
constexpr size_t A_ROPE = R_END;
constexpr size_t A_CTR = al256(A_ROPE + (size_t)2068 * 64 * 4);
constexpr size_t A_BAR = A_CTR + 4096;
constexpr size_t WS_TOTAL = A_BAR + 16384;
constexpr int NGRP = 3;
constexpr int NPHASE = 1 + 2 * NGRP * 10;

struct Grp { int g0, nrows, npan, pb0, npb, hasS; };
__device__ __forceinline__ Grp get_grp(int g) {
    Grp r; r.g0 = g * 6192; r.nrows = g < 2 ? 6192 : 4640; r.npan = g < 2 ? 25 : 19; r.pb0 = g * 3; r.npb = g < 2 ? 3 : 2; r.hasS = g == 2; return r;
}

struct Params {
    const float* in[N_IN];
    float* out;
    unsigned char* ws;
};


constexpr int PTAB_OFF = 142336;
__device__ __forceinline__ const float* ldin(const unsigned char* smem, int i) {
    const unsigned long long v = ((const unsigned long long*)(smem + PTAB_OFF))[i];
    const unsigned lo = __builtin_amdgcn_readfirstlane((unsigned)v), hi = __builtin_amdgcn_readfirstlane((unsigned)(v >> 32));
    return (const float*)(((unsigned long long)hi << 32) | lo);
}
#define INP(i) ldin(smem, (i))
__device__ __forceinline__ int otid() { int t = threadIdx.x; asm volatile("" : "+v"(t)); return t; }

__device__ __forceinline__ float bf2f(bf16_t b) { return __uint_as_float(((unsigned)b) << 16); }
__device__ __forceinline__ bf16_t f2bf(float f) { unsigned u = __float_as_uint(f); u += 0x7FFFu + ((u >> 16) & 1u); return (bf16_t)(u >> 16); }
__device__ __forceinline__ unsigned pk2(float lo, float hi) { return (unsigned)f2bf(lo) | ((unsigned)f2bf(hi) << 16); }
__device__ __forceinline__ float sigm(float x) { return __builtin_amdgcn_rcpf(1.0f + __expf(-x)); }
__device__ __forceinline__ float gelu_t(float x) { const float v = 1.5957691216f * (x + 0.044715f * x * x * x); return x * __builtin_amdgcn_rcpf(1.0f + __expf(-v)); }
__device__ __forceinline__ void lds_wait() { asm volatile("s_waitcnt lgkmcnt(0)" ::: "memory"); __builtin_amdgcn_wave_barrier(); }
__device__ __forceinline__ f32x4 mfma16(bf16x8 a, bf16x8 b, f32x4 c) { return __builtin_amdgcn_mfma_f32_16x16x32_bf16(a, b, c, 0, 0, 0); }

namespace pg8 {
constexpr int BM = 256, BK = 64, HALF = 128, HTB = HALF * BK * 2, STAGE_BYTES = 8 * HTB, NXCD = 8, WGM = 8;
__device__ __forceinline__ int lds_byte(int r, int c) { const int st = (r >> 4) * 2 + (c >> 5), rr = r & 15, cc = c & 31, ob = rr * 64 + cc * 2; return st * 1024 + (ob ^ (((ob >> 9) & 1) << 5)); }
__device__ __forceinline__ void stage_rc(int b, int& R, int& C) { const int st = b / 1024, sb = b % 1024, swz = sb ^ (((sb >> 9) & 1) << 5); R = (st >> 1) * 16 + swz / 64; C = (st & 1) * 32 + (swz % 64) / 2; }

struct Unit { int pm, pn, br; };
struct Gemm { const bf16_t* A; const bf16_t* Bt; int lda, ldb, nM, nN, nt; };

struct SchedOne {
    int pm, pn, nt0;
    __device__ bool next(int i, Unit& u) const { if (i != 0) return false; u.pm = pm; u.pn = pn; u.br = 0; return true; }
    __device__ __forceinline__ void kr(const Unit&, size_t& koffB, int& nt) const { koffB = 0; nt = nt0; }
};
template <int NBR> struct Sched {
    int nM, nN, nwg, G, c, nt0;
    __device__ void init(int nM_, int nN_, int G_, int c_, int nt_) { nM = nM_; nN = nN_; nwg = nM * nN; G = G_; c = c_; nt0 = nt_; }
    __device__ bool next(int i, Unit& u) const {
        int wgid;
        if (NBR == 2) {
            const long L = (long)i * G + c; if (L >= 2 * (long)nwg) return false;
            u.br = (int)(L / nwg); wgid = (int)(L - (long)u.br * nwg);
        } else {
            const int ti = i / NBR; u.br = i - ti * NBR;
            const long L = (long)ti * G + c; if (L >= nwg) return false;
            wgid = (int)L;
        } { const int q = nwg / NXCD, r = nwg % NXCD, xcd = wgid % NXCD, off = wgid / NXCD; wgid = (xcd < r ? xcd * (q + 1) : r * (q + 1) + (xcd - r) * q) + off; }
        const int nig = WGM * nN, gid = wgid / nig, fm = gid * WGM, gsz = (nM - fm) < WGM ? (nM - fm) : WGM;
        u.pm = fm + ((wgid % nig) % gsz); u.pn = (wgid % nig) / gsz; return true;
    }
    __device__ __forceinline__ void kr(const Unit& u, size_t& koffB, int& nt) const {
        if (NBR == 1) { koffB = 0; nt = nt0; }
        else if (NBR == 2) { nt = nt0 >> 1; koffB = (size_t)u.br * (size_t)nt * 128; }
        else { koffB = (size_t)u.br * 1536; nt = (u.br == 2) ? 16 : 12; }
    }
};

__device__ __forceinline__ unsigned cvt_pk_bf16(float lo, float hi) { unsigned r; asm volatile("v_cvt_pk_bf16_f32 %0, %1, %2" : "=v"(r) : "v"(lo), "v"(hi)); return r; }

template <class Epi, class SchedT>
__device__ __forceinline__ void gemm_phase(LAS unsigned char* lds, const Gemm g, const SchedT& S, const Epi& E) {
    const int tid = otid(), wid = __builtin_amdgcn_readfirstlane(tid >> 6), lane = tid & 63, wr = wid >> 2, wc = wid & 3, fr = lane & 15, fq = lane >> 4;
    unsigned voffA[2], voffB[2];
#pragma unroll
    for (int i = 0; i < 2; ++i) { int R, C; stage_rc(tid * 16 + i * 8192, R, C);
        voffA[i] = (unsigned)(R * g.lda + C) * 2u; voffB[i] = (unsigned)(R * g.ldb + C) * 2u; }
    const size_t kstep = (size_t)(BK * 2);
    const size_t hstepA = (size_t)HALF * g.lda * 2, hstepB = (size_t)HALF * g.ldb * 2;
    const size_t tstepA = 2 * hstepA, tstepB = 2 * hstepB;
    const unsigned ldsw = (unsigned)wid * 1024u;
    const int aoff = lds_byte(wr * 64 + fr, fq * 8), boff = lds_byte(wc * 32 + fr, fq * 8);
#define PG8_SA(b, h) (((b) * 2 + (h)) * HTB)
#define PG8_SB(b, h) ((4 + (b) * 2 + (h)) * HTB)
#define PG8_STAGE(bufoff, gbase, voff) do { _Pragma("unroll") for (int _i = 0; _i < 2; ++_i) \
        __builtin_amdgcn_global_load_lds((const unsigned*)((const char*)(gbase) + (voff)[_i]), (LAS unsigned*)(lds + (bufoff) + ldsw + _i * 8192), 16, 0, DMA_AUX); } while (0)
#define PG8_LDA(dst, b, h) do { _Pragma("unroll") for (int m = 0; m < 4; ++m) _Pragma("unroll") for (int k = 0; k < 2; ++k) dst[m][k] = *(const LAS bf16x8*)(lds + PG8_SA(b, h) + aoff + m * 2048 + k * 1024); } while (0)
#define PG8_LDB(dst, b, h) do { _Pragma("unroll") for (int n = 0; n < 2; ++n) _Pragma("unroll") for (int k = 0; k < 2; ++k) dst[n][k] = *(const LAS bf16x8*)(lds + PG8_SB(b, h) + boff + n * 2048 + k * 1024); } while (0)
#define PG8_MMA(ai, bj, At, Bt) do { __builtin_amdgcn_s_setprio(1); _Pragma("unroll") for (int m = 0; m < 4; ++m) _Pragma("unroll") for (int n = 0; n < 2; ++n) _Pragma("unroll") for (int k = 0; k < 2; ++k) \
        acc[ai][bj][m][n] = __builtin_amdgcn_mfma_f32_16x16x32_bf16(Bt[n][k], At[m][k], acc[ai][bj][m][n], 0, 0, 0); __builtin_amdgcn_s_setprio(0); } while (0)
#define PG8_WAIT_V(n) asm volatile("s_waitcnt vmcnt(" #n ")" ::: "memory")
#define PG8_WAIT_L(n) asm volatile("s_waitcnt lgkmcnt(" #n ")" ::: "memory")
#define PG8_BAR __builtin_amdgcn_s_barrier()
#define PG8_SCHED __builtin_amdgcn_sched_barrier(0)
    Unit cur, nxt; int ui = 0;
    if (!S.next(0, cur)) return;
    f32x4 acc[2][2][4][2];
#pragma unroll
    for (int a = 0; a < 2; ++a)
#pragma unroll
        for (int b = 0; b < 2; ++b)
#pragma unroll
            for (int m = 0; m < 4; ++m)
#pragma unroll
                for (int n = 0; n < 2; ++n) acc[a][b][m][n] = (f32x4){0.f, 0.f, 0.f, 0.f};
    bf16x8 At[4][2], B0[2][2], B1[2][2];
    size_t koc; int ntc; S.kr(cur, koc, ntc);
    const char* cA = (const char*)g.A + (size_t)cur.pm * tstepA + koc; const char* cB = (const char*)g.Bt + (size_t)cur.pn * tstepB + koc;
    PG8_STAGE(PG8_SB(0, 0), cB, voffB); PG8_STAGE(PG8_SA(0, 0), cA, voffA); PG8_STAGE(PG8_SB(0, 1), cB + hstepB, voffB); PG8_STAGE(PG8_SA(0, 1), cA + hstepA, voffA);
    if (wr == 1) PG8_BAR;
    PG8_WAIT_V(4); PG8_BAR;
    PG8_STAGE(PG8_SB(1, 0), cB + kstep, voffB); PG8_STAGE(PG8_SA(1, 0), cA + kstep, voffA); PG8_STAGE(PG8_SB(1, 1), cB + hstepB + kstep, voffB);
    PG8_WAIT_V(6); PG8_BAR;
    for (;;) {
        const bool has_next = S.next(ui + 1, nxt);
        size_t kon = 0; int ntn = ntc; if (has_next) S.kr(nxt, kon, ntn);
        const char* nA = has_next ? (const char*)g.A + (size_t)nxt.pm * tstepA + kon : cA; const char* nB = has_next ? (const char*)g.Bt + (size_t)nxt.pn * tstepB + kon : cB;
        for (int t = 0; t < ntc; t += 2) {
            const bool last = (t == ntc - 2);
            const char* a1 = cA + (size_t)(t + 1) * kstep;
            const char* a2 = last ? nA : cA + (size_t)(t + 2) * kstep; const char* b2 = last ? nB : cB + (size_t)(t + 2) * kstep;
            const char* a3 = a2 + kstep; const char* b3 = b2 + kstep;
            PG8_LDB(B0, 0, 0); PG8_SCHED; PG8_LDA(At, 0, 0); PG8_STAGE(PG8_SA(1, 1), a1 + hstepA, voffA);
            PG8_WAIT_L(8); PG8_BAR; PG8_WAIT_L(0); PG8_MMA(0, 0, At, B0); PG8_BAR; PG8_SCHED;
            PG8_LDB(B1, 0, 1); PG8_STAGE(PG8_SB(0, 0), b2, voffB);
            PG8_BAR; PG8_WAIT_L(0); PG8_MMA(0, 1, At, B1); PG8_BAR;
            PG8_LDA(At, 0, 1); PG8_STAGE(PG8_SA(0, 0), a2, voffA);
            PG8_BAR; PG8_WAIT_L(0); PG8_MMA(1, 0, At, B0); PG8_BAR; PG8_SCHED;
            PG8_STAGE(PG8_SB(0, 1), b2 + hstepB, voffB);
            PG8_WAIT_V(6); PG8_BAR; PG8_MMA(1, 1, At, B1); PG8_BAR;
            PG8_LDB(B0, 1, 0); PG8_SCHED; PG8_LDA(At, 1, 0); PG8_STAGE(PG8_SA(0, 1), a2 + hstepA, voffA);
            PG8_WAIT_L(8); PG8_BAR; PG8_WAIT_L(0); PG8_MMA(0, 0, At, B0); PG8_BAR; PG8_SCHED;
            PG8_LDB(B1, 1, 1); PG8_STAGE(PG8_SB(1, 0), b3, voffB);
            PG8_BAR; PG8_WAIT_L(0); PG8_MMA(0, 1, At, B1); PG8_BAR;
            PG8_LDA(At, 1, 1); PG8_STAGE(PG8_SA(1, 0), a3, voffA);
            PG8_BAR; PG8_WAIT_L(0); PG8_MMA(1, 0, At, B0); PG8_BAR; PG8_SCHED;
            PG8_STAGE(PG8_SB(1, 1), b3 + hstepB, voffB);
            PG8_WAIT_V(6); PG8_BAR; PG8_MMA(1, 1, At, B1); PG8_BAR;
        }
        E(acc, cur, wr, wc, fr, fq);
        if (!has_next) break;
#pragma unroll
        for (int a = 0; a < 2; ++a)
#pragma unroll
            for (int b = 0; b < 2; ++b)
#pragma unroll
                for (int m = 0; m < 4; ++m)
#pragma unroll
                    for (int n = 0; n < 2; ++n) acc[a][b][m][n] = (f32x4){0.f, 0.f, 0.f, 0.f};
        cur = nxt; cA = nA; cB = nB; ntc = ntn; ++ui;
    }
    PG8_WAIT_V(0);
    if (wr == 0) PG8_BAR;
    PG8_BAR;
#undef PG8_SA
#undef PG8_SB
#undef PG8_STAGE
#undef PG8_LDA
#undef PG8_LDB
#undef PG8_MMA
#undef PG8_WAIT_V
#undef PG8_WAIT_L
#undef PG8_BAR
#undef PG8_SCHED
}

struct EpiBf {
    bf16_t* O; int ldc; bf16_t* O2;
    __device__ __forceinline__ void operator()(const f32x4 (&acc)[2][2][4][2], const Unit& u, int wr, int wc, int fr, int fq) const {
        const int row0 = u.pm * BM + wr * 64 + fr, col0 = u.pn * BM + wc * 32 + 4 * fq;
        bf16_t* O = u.br ? this->O2 : this->O;
#pragma unroll
        for (int ai = 0; ai < 2; ++ai)
#pragma unroll
            for (int m = 0; m < 4; ++m) { bf16_t* rowp = O + (size_t)(row0 + ai * HALF + m * 16) * ldc + col0;
#pragma unroll
                for (int bj = 0; bj < 2; ++bj)
#pragma unroll
                    for (int n = 0; n < 2; ++n) { const f32x4 v = acc[ai][bj][m][n]; u32x2 o; o.x = cvt_pk_bf16(v[0], v[1]); o.y = cvt_pk_bf16(v[2], v[3]); *(u32x2*)(rowp + bj * HALF + n * 16) = o; } }
    }
};
struct EpiF32 {
    float* C; int ldc; float* C2;
    __device__ __forceinline__ void operator()(const f32x4 (&acc)[2][2][4][2], const Unit& u, int wr, int wc, int fr, int fq) const {
        const int row0 = u.pm * BM + wr * 64 + fr, col0 = u.pn * BM + wc * 32 + 4 * fq;
        float* C = u.br ? this->C2 : this->C;
#pragma unroll
        for (int ai = 0; ai < 2; ++ai)
#pragma unroll
            for (int m = 0; m < 4; ++m) { float* rowp = C + (size_t)(row0 + ai * HALF + m * 16) * ldc + col0;
#pragma unroll
                for (int bj = 0; bj < 2; ++bj)
#pragma unroll
                    for (int n = 0; n < 2; ++n) *(f32x4*)(rowp + bj * HALF + n * 16) = acc[ai][bj][m][n]; }
    }
};
struct EpiGlu {
    bf16_t* Y; const bf16_t* Z; const float* bias;
    __device__ __forceinline__ void operator()(const f32x4 (&acc)[2][2][4][2], const Unit& u, int wr, int wc, int fr, int fq) const {
        const int row0 = u.pm * BM + wr * 64 + fr, col0 = u.pn * BM + wc * 32 + 4 * fq;
#pragma unroll
        for (int ai = 0; ai < 2; ++ai)
#pragma unroll
            for (int m = 0; m < 4; ++m) { const size_t r = (size_t)(row0 + ai * HALF + m * 16);
#pragma unroll
                for (int bj = 0; bj < 2; ++bj)
#pragma unroll
                    for (int n = 0; n < 2; ++n) { const int c = col0 + bj * HALF + n * 16; const f32x4 v = acc[ai][bj][m][n];
                        const u32x2 zz = *(const u32x2*)(Z + r * 768 + c); const f32x4 bb = *(const f32x4*)(bias + c);
                        const float z0 = __uint_as_float(zz.x << 16), z1 = __uint_as_float(zz.x & 0xffff0000u), z2 = __uint_as_float(zz.y << 16), z3 = __uint_as_float(zz.y & 0xffff0000u);
                        u32x2 o; o.x = cvt_pk_bf16(z0 * sigm(v[0] + bb[0]), z1 * sigm(v[1] + bb[1])); o.y = cvt_pk_bf16(z2 * sigm(v[2] + bb[2]), z3 * sigm(v[3] + bb[3]));
                        *(u32x2*)(Y + r * LDY + c) = o; } }
    }
};
struct EpiBranch {
    const bf16_t* Zg; bf16_t* Mo;
    __device__ __forceinline__ void operator()(const f32x4 (&acc)[2][2][4][2], const Unit& u, int wr, int wc, int fr, int fq) const {
        const int row0 = u.pm * BM + wr * 64 + fr, col0 = u.pn * BM + wc * 32 + 4 * fq; const int br = u.br;
#pragma unroll
        for (int ai = 0; ai < 2; ++ai)
#pragma unroll
            for (int m = 0; m < 4; ++m) { const size_t r = (size_t)(row0 + ai * HALF + m * 16);
#pragma unroll
                for (int bj = 0; bj < 2; ++bj)
#pragma unroll
                    for (int n = 0; n < 2; ++n) { const int c = col0 + bj * HALF + n * 16; const f32x4 v = acc[ai][bj][m][n];
                        const u32x2 gg = *(const u32x2*)(Zg + r * DIN + br * 1024 + c);
                        f32x4 t; t[0] = v[0] * sigm(__uint_as_float(gg.x << 16)); t[1] = v[1] * sigm(__uint_as_float(gg.x & 0xffff0000u));
                        t[2] = v[2] * sigm(__uint_as_float(gg.y << 16)); t[3] = v[3] * sigm(__uint_as_float(gg.y & 0xffff0000u));
                        bf16_t* mp = Mo + r * DM + c;
                        if (br != 0) { u32x2 p; p.x = __hip_atomic_load((const unsigned*)mp, __ATOMIC_RELAXED, __HIP_MEMORY_SCOPE_AGENT); p.y = __hip_atomic_load((const unsigned*)mp + 1, __ATOMIC_RELAXED, __HIP_MEMORY_SCOPE_AGENT); t[0] += __uint_as_float(p.x << 16); t[1] += __uint_as_float(p.x & 0xffff0000u); t[2] += __uint_as_float(p.y << 16); t[3] += __uint_as_float(p.y & 0xffff0000u); }
                        u32x2 o; o.x = cvt_pk_bf16(t[0], t[1]); o.y = cvt_pk_bf16(t[2], t[3]); *(u32x2*)mp = o; } }
    }
};

#ifndef GEMM_SIMPLE
#define GEMM_SIMPLE 0
#endif
template <class Epi, class SchedT>
__device__ __forceinline__ void gemm_simple(LAS unsigned char* lds, const Gemm g, const SchedT& S, const Epi& E) {
    const int tid = otid(), wid = __builtin_amdgcn_readfirstlane(tid >> 6), lane = tid & 63, wr = wid >> 2, wc = wid & 3, fr = lane & 15, fq = lane >> 4;
    unsigned voffA[2], voffB[2];
#pragma unroll
    for (int i = 0; i < 2; ++i) { int R, C; stage_rc(tid * 16 + i * 8192, R, C);
        voffA[i] = (unsigned)(R * g.lda + C) * 2u; voffB[i] = (unsigned)(R * g.ldb + C) * 2u; }
    const size_t hstepA = (size_t)HALF * g.lda * 2, hstepB = (size_t)HALF * g.ldb * 2;
    const int aoff = lds_byte(wr * 64 + fr, fq * 8), boff = lds_byte(wc * 32 + fr, fq * 8);
    Unit cur;
    for (int ui = 0; S.next(ui, cur); ++ui) {
        size_t koc; int ntc; S.kr(cur, koc, ntc);
        const char* cA = (const char*)g.A + (size_t)cur.pm * 2 * hstepA + koc; const char* cB = (const char*)g.Bt + (size_t)cur.pn * 2 * hstepB + koc;
        f32x4 acc[2][2][4][2];
#pragma unroll
        for (int a = 0; a < 2; ++a)
#pragma unroll
            for (int b = 0; b < 2; ++b)
#pragma unroll
                for (int m = 0; m < 4; ++m)
#pragma unroll
                    for (int n = 0; n < 2; ++n) acc[a][b][m][n] = (f32x4){0.f, 0.f, 0.f, 0.f};
        for (int t = 0; t < ntc; ++t) {
            u32x4 ra[2][2], rb[2][2];
#pragma unroll
            for (int h = 0; h < 2; ++h)
#pragma unroll
                for (int i = 0; i < 2; ++i) { ra[h][i] = *(const u32x4*)(cA + (size_t)t * 128 + h * hstepA + voffA[i]); rb[h][i] = *(const u32x4*)(cB + (size_t)t * 128 + h * hstepB + voffB[i]); }
            __syncthreads();
#pragma unroll
            for (int h = 0; h < 2; ++h)
#pragma unroll
                for (int i = 0; i < 2; ++i) { *(LAS u32x4*)(lds + h * HTB + tid * 16 + i * 8192) = ra[h][i]; *(LAS u32x4*)(lds + (4 + h) * HTB + tid * 16 + i * 8192) = rb[h][i]; }
            __syncthreads();
#pragma unroll
            for (int ai = 0; ai < 2; ++ai) {
                bf16x8 At[4][2];
#pragma unroll
                for (int m = 0; m < 4; ++m)
#pragma unroll
                    for (int k = 0; k < 2; ++k) At[m][k] = *(const LAS bf16x8*)(lds + ai * HTB + aoff + m * 2048 + k * 1024);
#pragma unroll
                for (int bj = 0; bj < 2; ++bj) {
                    bf16x8 Bf[2][2];
#pragma unroll
                    for (int n = 0; n < 2; ++n)
#pragma unroll
                        for (int k = 0; k < 2; ++k) Bf[n][k] = *(const LAS bf16x8*)(lds + (4 + bj) * HTB + boff + n * 2048 + k * 1024);
#pragma unroll
                    for (int m = 0; m < 4; ++m)
#pragma unroll
                        for (int n = 0; n < 2; ++n)
#pragma unroll
                            for (int k = 0; k < 2; ++k) acc[ai][bj][m][n] = __builtin_amdgcn_mfma_f32_16x16x32_bf16(Bf[n][k], At[m][k], acc[ai][bj][m][n], 0, 0, 0);
                }
            }
        }
        E(acc, cur, wr, wc, fr, fq);
    }
    __syncthreads();
}
template <class Epi, class SchedT>
__device__ __forceinline__ void gemm_run(LAS unsigned char* lds, const Gemm g, const SchedT& S, const Epi& E) {
#if GEMM_SIMPLE
    gemm_simple(lds, g, S, E);
#else
    gemm_phase(lds, g, S, E);
#endif
}
}

__device__ __forceinline__ void transpose_tile(const float* __restrict__ W, int N, bf16_t* __restrict__ dst, int ldd, int koff, int tk, int tn, float* tile) {
    const int tid = otid(), a = tid >> 6, bq = tid & 63;
    __syncthreads();
#pragma unroll
    for (int i = 0; i < 8; ++i) { const int k = a + 8 * i; tile[k * 65 + bq] = W[(size_t)(tk * 64 + k) * N + tn * 64 + bq]; }
    __syncthreads();
#pragma unroll
    for (int i = 0; i < 8; ++i) { const int n = a + 8 * i; dst[(size_t)(tn * 64 + n) * ldd + koff + tk * 64 + bq] = f2bf(tile[bq * 65 + n]); }
}

__device__ __forceinline__ f32x4 ldx4(const bf16_t* p) { const u32x2 v = *(const u32x2*)p; f32x4 r; r[0] = __uint_as_float(v.x << 16); r[1] = __uint_as_float(v.x & 0xffff0000u); r[2] = __uint_as_float(v.y << 16); r[3] = __uint_as_float(v.y & 0xffff0000u); return r; }
__device__ __forceinline__ void stx4(bf16_t* p, const f32x4 v) { u32x2 o; o.x = pk2(v[0], v[1]); o.y = pk2(v[2], v[3]); *(u32x2*)p = o; }
__device__ __forceinline__ void rms_store(const f32x4 (&xv)[4], const float* g, bf16_t* dst, int lane) {
    float ss = 0.f;
#pragma unroll
    for (int i = 0; i < 4; ++i) ss += xv[i][0] * xv[i][0] + xv[i][1] * xv[i][1] + xv[i][2] * xv[i][2] + xv[i][3] * xv[i][3];
#pragma unroll
    for (int o = 32; o > 0; o >>= 1) ss += __shfl_xor(ss, o);
    const float rs = rsqrtf(ss * (1.0f / DM) + EPS);
#pragma unroll
    for (int i = 0; i < 4; ++i) { const int c = lane * 4 + 256 * i; const f32x4 gn = *(const f32x4*)(g + c); const f32x4 hv = xv[i] * gn * rs;
        u32x2 o; o.x = pk2(hv[0], hv[1]); o.y = pk2(hv[2], hv[3]); *(u32x2*)(dst + c) = o; }
}
__device__ __forceinline__ void norm_rows(const Params& P, int mode, int l, int grp, const unsigned char* smem) {
    const int tid_ = otid(); const int wid = tid_ >> 6, lane = tid_ & 63;
    bf16_t* __restrict__ X = (bf16_t*)(P.ws + A_X);
    const int gw = blockIdx.x * 8 + wid, nw = gridDim.x * 8;
    if (mode == 0) {
        const float* g0p = INP(I_GPREMIX); bf16_t* H = (bf16_t*)(P.ws + R_H);
        for (int row = gw; row < TPAD; row += nw) {
            f32x4 xv[4];
            if (row >= TT) {
#pragma unroll
                for (int i = 0; i < 4; ++i) xv[i] = (f32x4){0.f, 0.f, 0.f, 0.f};
            } else {
                const bool isP = row < TPR; int b = 0, t = 0; if (isP) { b = row / LP; t = row - b * LP; }
                const float* src = isP ? (t < 16 ? INP(I_META) + (size_t)t * DM : INP(I_XP) + ((size_t)b * SEQ + (t - 16)) * DM) : INP(I_XS) + (size_t)(row - TPR) * DM;
#pragma unroll
                for (int i = 0; i < 4; ++i) xv[i] = *(const f32x4*)(src + lane * 4 + 256 * i);
            }
#pragma unroll
            for (int i = 0; i < 4; ++i) stx4(X + (size_t)row * DM + lane * 4 + 256 * i, xv[i]);
            if (row < 6192) rms_store(xv, g0p, H + (size_t)row * DM, lane);
        }
        return;
    }
    const Grp G = get_grp(grp);
    const bf16_t* __restrict__ F = (const bf16_t*)(P.ws + R_F) - (size_t)G.g0 * DM;
    const bf16_t* __restrict__ F2 = (const bf16_t*)(P.ws + R_UP) - (size_t)G.g0 * DM;
    bf16_t* __restrict__ H = (bf16_t*)(P.ws + R_H) - (size_t)G.g0 * DM;
    const bool fin = (mode == 2 && l == 1);
    const float* gpost = (mode == 1 ? INP(I_GPOSTMIX) : INP(I_GPOSTFFN)) + l * DM;
    const float* gffn = INP(I_GPREFFN) + l * DM;
#pragma unroll 2
    for (int row = G.g0 + gw; row < G.g0 + G.nrows; row += nw) {
        f32x4 xv[4], fv[4]; float ss = 0.f;
#pragma unroll
        for (int i = 0; i < 4; ++i) { const int c = lane * 4 + 256 * i; xv[i] = ldx4(X + (size_t)row * DM + c);
            { const u32x2 fa = *(const u32x2*)(F + (size_t)row * DM + c), fb = *(const u32x2*)(F2 + (size_t)row * DM + c);
              fv[i][0] = __uint_as_float(fa.x << 16) + __uint_as_float(fb.x << 16); fv[i][1] = __uint_as_float(fa.x & 0xffff0000u) + __uint_as_float(fb.x & 0xffff0000u);
              fv[i][2] = __uint_as_float(fa.y << 16) + __uint_as_float(fb.y << 16); fv[i][3] = __uint_as_float(fa.y & 0xffff0000u) + __uint_as_float(fb.y & 0xffff0000u); }
            ss += fv[i][0] * fv[i][0] + fv[i][1] * fv[i][1] + fv[i][2] * fv[i][2] + fv[i][3] * fv[i][3]; }
#pragma unroll
        for (int o = 32; o > 0; o >>= 1) ss += __shfl_xor(ss, o);
        const float rs = rsqrtf(ss * (1.0f / DM) + EPS);
#pragma unroll
        for (int i = 0; i < 4; ++i) { const f32x4 gp = *(const f32x4*)(gpost + lane * 4 + 256 * i); xv[i] = xv[i] + fv[i] * gp * rs; }
        if (fin) {
            float* dst = nullptr;
            if (row < TPR) { const int b = row / LP, t = row - b * LP; if (t >= 16 && ((OUTMASK >> 0) & 1)) dst = P.out + O_YP + ((size_t)b * SEQ + (t - 16)) * DM; }
            else if ((OUTMASK >> 1) & 1) dst = P.out + O_YS + (size_t)(row - TPR) * DM;
            if (dst) {
#pragma unroll
                for (int i = 0; i < 4; ++i) *(f32x4*)(dst + lane * 4 + 256 * i) = xv[i];
            }
        } else {
#pragma unroll
            for (int i = 0; i < 4; ++i) stx4(X + (size_t)row * DM + lane * 4 + 256 * i, xv[i]);
        }
        if (mode == 1) rms_store(xv, gffn, H + (size_t)row * DM, lane);
    }
    if (mode == 2) {
        int nl = l, ng = grp + 1; if (ng == NGRP) { ng = 0; nl = l + 1; }
        if (nl < 2) {
            const Grp N = get_grp(ng); const float* gn = INP(I_GPREMIX) + nl * DM; bf16_t* Hn = (bf16_t*)(P.ws + R_H) - (size_t)N.g0 * DM;
            for (int row = N.g0 + gw; row < N.g0 + N.nrows; row += nw) {
                f32x4 xv[4];
#pragma unroll
                for (int i = 0; i < 4; ++i) xv[i] = ldx4(X + (size_t)row * DM + lane * 4 + 256 * i);
                rms_store(xv, gn, Hn + (size_t)row * DM, lane);
            }
        }
    }
}

__device__ __forceinline__ void phase0(const Params& P, unsigned char* smem) {
    float* tile = (float*)smem;
    constexpr int C0 = 2112, C1 = C0 + 144, C2 = C1 + 192, C3 = C2 + 192, C4 = C3 + 256, C5 = C4 + 256, C6 = C5 + 1408, C7 = C6 + 704;
    for (int id = blockIdx.x; id < 2 * C7; id += gridDim.x) {
        const int l = id / C7; int j = id - l * C7;
        const float* W; int N, ldd, koff = 0; bf16_t* dst;
        if (j < C0) { W = INP(I_WIN) + (size_t)l * DM * DIN; N = DIN; dst = (bf16_t*)(P.ws + W_IN) + (size_t)l * DIN * DM; ldd = DM; }
        else if (j < C1) { j -= C0; W = INP(I_WGLU) + (size_t)l * 768 * 768; N = 768; dst = (bf16_t*)(P.ws + W_GLU) + (size_t)l * 768 * 768; ldd = 768; }
        else if (j < C2) { j -= C1; W = INP(I_WBA) + (size_t)l * 768 * DM; N = DM; dst = (bf16_t*)(P.ws + W_BR) + (size_t)l * DM * LDY; ldd = LDY; }
        else if (j < C3) { j -= C2; W = INP(I_WBB) + (size_t)l * 768 * DM; N = DM; dst = (bf16_t*)(P.ws + W_BR) + (size_t)l * DM * LDY; ldd = LDY; koff = 768; }
        else if (j < C4) { j -= C3; W = INP(I_WBC) + (size_t)l * DM * DM; N = DM; dst = (bf16_t*)(P.ws + W_BR) + (size_t)l * DM * LDY; ldd = LDY; koff = 1536; }
        else if (j < C5) { j -= C4; W = INP(I_WOUT) + (size_t)l * DM * DM; N = DM; dst = (bf16_t*)(P.ws + W_OUT) + (size_t)l * DM * DM; ldd = DM; }
        else if (j < C6) { j -= C5; W = INP(I_WUP) + (size_t)l * DM * 2 * DFF; N = 2 * DFF; dst = (bf16_t*)(P.ws + W_UP) + (size_t)l * 2 * DFF * DM; ldd = DM; }
        else { j -= C6; W = INP(I_WDOWN) + (size_t)l * DFF * DM; N = DM; dst = (bf16_t*)(P.ws + W_DOWN) + (size_t)l * DM * DFF; ldd = DFF; }
        const int ntn = N / 64; const int tk = j / ntn, tn = j - tk * ntn;
        transpose_tile(W, N, dst, ldd, koff, tk, tn, tile);
    }
    norm_rows(P, 0, 0, 0, smem);
    float* rt = (float*)(P.ws + A_ROPE);
    for (int i = blockIdx.x * 512 + threadIdx.x; i < 2068 * 32; i += gridDim.x * 512) {
        const int pi = i >> 5, fi = i & 31; const double pos = pi < LP ? (double)pi : (double)(16384 + pi - LP);
        const double inv = exp(-(double)fi * (9.210340371976184 / 32.0));
        double ang = pos * inv; const double k = rint(ang * 0.15915494309189535); ang = ang - k * 6.283185307179586;
        const float af = (float)ang; rt[2 * i] = cosf(af); rt[2 * i + 1] = sinf(af);
    }
    if (blockIdx.x == 0 && threadIdx.x < 64) ((unsigned*)(P.ws + A_CTR))[threadIdx.x] = 0u;
}

__device__ __forceinline__ void ffn_conv_phase(const Params& P, int l, int grp, const unsigned char* smem) {
    const Grp G = get_grp(grp);
    const bf16_t* __restrict__ UP = (const bf16_t*)(P.ws + R_UP) - (size_t)G.g0 * (2 * DFF); bf16_t* __restrict__ FIN = (bf16_t*)(P.ws + R_FIN) - (size_t)G.g0 * DFF;
    const float* cw = INP(I_FCW) + (size_t)l * 3 * DFF; const float* cb = INP(I_FCB) + (size_t)l * DFF;
    const float* cache = INP(I_FFNC) + (size_t)l * DEC_B * 2 * DFF;
    constexpr int NCG = DFF / 8;
#pragma unroll 2
    for (int it = blockIdx.x * 512 + threadIdx.x; it < G.nrows * NCG; it += gridDim.x * 512) {
        const int rr = it / NCG, c = (it - rr * NCG) * 8, row = G.g0 + rr;
        int b, t, L; const bool isP = row < TPR;
        if (isP) { b = row / LP; t = row - b * LP; L = LP; } else { b = (row - TPR) >> 2; t = (row - TPR) & 3; L = 4; }
        float g0[8], g1[8], g2[8], uf[8];
        { const u32x4 v = *(const u32x4*)(UP + (size_t)row * (2 * DFF) + c);
#pragma unroll
          for (int i = 0; i < 4; ++i) { g0[2 * i] = __uint_as_float(v[i] << 16); g0[2 * i + 1] = __uint_as_float(v[i] & 0xffff0000u); } }
        { const u32x4 v = *(const u32x4*)(UP + (size_t)row * (2 * DFF) + DFF + c);
#pragma unroll
          for (int i = 0; i < 4; ++i) { uf[2 * i] = __uint_as_float(v[i] << 16); uf[2 * i + 1] = __uint_as_float(v[i] & 0xffff0000u); } }
        if (t >= 1) { const u32x4 v = *(const u32x4*)(UP + (size_t)(row - 1) * (2 * DFF) + c);
#pragma unroll
            for (int i = 0; i < 4; ++i) { g1[2 * i] = __uint_as_float(v[i] << 16); g1[2 * i + 1] = __uint_as_float(v[i] & 0xffff0000u); } }
        else {
#pragma unroll
            for (int i = 0; i < 8; ++i) g1[i] = isP ? 0.f : cache[((size_t)b * 2 + 1) * DFF + c + i]; }
        if (t >= 2) { const u32x4 v = *(const u32x4*)(UP + (size_t)(row - 2) * (2 * DFF) + c);
#pragma unroll
            for (int i = 0; i < 4; ++i) { g2[2 * i] = __uint_as_float(v[i] << 16); g2[2 * i + 1] = __uint_as_float(v[i] & 0xffff0000u); } }
        else {
#pragma unroll
            for (int i = 0; i < 8; ++i) g2[i] = isP ? 0.f : cache[((size_t)b * 2 + t) * DFF + c + i]; }
        float o[8];
#pragma unroll
        for (int i = 0; i < 8; ++i) { const float gc = cb[c + i] + cw[c + i] * g2[i] + cw[DFF + c + i] * g1[i] + cw[2 * DFF + c + i] * g0[i]; o[i] = gelu_t(gc) * uf[i]; }
        u32x4 ov; ov[0] = pk2(o[0], o[1]); ov[1] = pk2(o[2], o[3]); ov[2] = pk2(o[4], o[5]); ov[3] = pk2(o[6], o[7]);
        *(u32x4*)(FIN + (size_t)row * DFF + c) = ov;
        if (t >= L - 2 && (isP ? OUT_ON(7) : OUT_ON(13))) {
            float* dst = isP ? P.out + O_P_FFNC + (((size_t)l * NB + b) * 2 + (t - (L - 2))) * DFF + c : P.out + O_S_FFNC + (((size_t)l * DEC_B + b) * 2 + (t - (L - 2))) * DFF + c;
#pragma unroll
            for (int i = 0; i < 8; ++i) dst[i] = g0[i];
        }
    }
}

__device__ __forceinline__ void ret_job(const Params& P, int l, int grp, int b, int h, int g0, unsigned char* smem) {
    const int tid = otid(), w = __builtin_amdgcn_readfirstlane(tid >> 6), lane = tid & 63, fr = lane & 15, fq = lane >> 4;
    bf16_t* sQ = (bf16_t*)smem;
    bf16_t* sK = sQ + 128 * 72;
    bf16_t* sKdT = sK + 128 * 72;
    bf16_t* sVT = sKdT + 64 * 136;
    bf16_t* sST = sVT + 128 * 136;
    bf16_t* sP = sST + 128 * 72 + w * 16 * 136;
    const bf16_t* Z = (const bf16_t*)(P.ws + R_Z) - (size_t)g0 * DIN; bf16_t* Y = (bf16_t*)(P.ws + R_Y) - (size_t)g0 * LDY;
    const float* rope = (const float*)(P.ws + A_ROPE);
    const int L = grp ? 4 : LP, rowb = grp ? TPR + b * 4 : b * LP, tabb = grp ? LP : 0;
    const float lg = log1pf(-exp2f(-5.0f - (float)h));
    const float* ng = INP(I_RNG) + (size_t)l * 1024 + h * 128;
    f32x4 accS[4];
    float* Sout = P.out + (grp ? O_S_RET + (((size_t)l * DEC_B + b) * 8 + h) * 8192 : O_P_RET + (((size_t)l * NB + b) * 8 + h) * 8192);
    if (grp) { const float* S0 = INP(I_RET) + (((size_t)l * DEC_B + b) * 8 + h) * 8192;
#pragma unroll
        for (int dt = 0; dt < 4; ++dt)
#pragma unroll
            for (int j = 0; j < 4; ++j) accS[dt][j] = S0[(16 * dt + 4 * fq + j) * 128 + 16 * w + fr];
    } else {
#pragma unroll
        for (int dt = 0; dt < 4; ++dt) accS[dt] = (f32x4){0.f, 0.f, 0.f, 0.f};
    }
    __syncthreads();
#pragma unroll
    for (int dt = 0; dt < 4; ++dt) { u32x2 o; o.x = pk2(accS[dt][0], accS[dt][1]); o.y = pk2(accS[dt][2], accS[dt][3]); *(u32x2*)(sST + (16 * w + fr) * 72 + 16 * dt + 4 * fq) = o; }
    const int nch = grp ? 1 : 17;
    u32x4 q1 = {0u, 0u, 0u, 0u}, q2 = q1, k1 = q1, k2 = q1, vv[4];
#define RET_LOAD(ckx) do { const int _t0 = grp ? 0 : ((ckx) == 0 ? 0 : 16 + ((ckx) - 1) * 128), _C = grp ? 4 : ((ckx) == 0 ? 16 : 128); \
        const int _m = tid >> 2, _i0 = (tid & 3) * 8, _m2 = tid & 127, _e0 = (tid >> 7) * 32; \
        q1 = (u32x4){0u, 0u, 0u, 0u}; q2 = q1; k1 = q1; k2 = q1; \
        if (_m < _C) { const size_t _zr = (size_t)(rowb + _t0 + _m) * DIN; \
            q1 = *(const u32x4*)(Z + _zr + ZO_Q + h * 64 + _i0); q2 = *(const u32x4*)(Z + _zr + ZO_Q + h * 64 + 32 + _i0); \
            k1 = *(const u32x4*)(Z + _zr + ZO_K + h * 64 + _i0); k2 = *(const u32x4*)(Z + _zr + ZO_K + h * 64 + 32 + _i0); } \
        _Pragma("unroll") for (int _i = 0; _i < 4; ++_i) vv[_i] = (u32x4){0u, 0u, 0u, 0u}; \
        if (_m2 < _C) { const bf16_t* _vp = Z + (size_t)(rowb + _t0 + _m2) * DIN + ZO_V + h * 128 + _e0; \
            _Pragma("unroll") for (int _i = 0; _i < 4; ++_i) vv[_i] = *(const u32x4*)(_vp + 8 * _i); } } while (0)
    RET_LOAD(0);
    for (int ck = 0; ck < nch; ++ck) {
        const int t0 = grp ? 0 : (ck == 0 ? 0 : 16 + (ck - 1) * 128), C = grp ? 4 : (ck == 0 ? 16 : 128);
        {
            const int m = tid >> 2, i0 = (tid & 3) * 8;
            u32x4 q1w = {0u, 0u, 0u, 0u}, q2w = q1w, k1w = q1w, k2w = q1w;
            float kd1[8], kd2[8];
#pragma unroll
            for (int e = 0; e < 8; ++e) { kd1[e] = 0.f; kd2[e] = 0.f; }
            if (m < C) {
                const float* rp = rope + ((size_t)(tabb + t0 + m) * 32 + i0) * 2;
                const float kdec = __expf(lg * (float)(C - 1 - m));
                float qo1[8], qo2[8], ko1[8], ko2[8];
#pragma unroll
                for (int e = 0; e < 8; ++e) {
                    const float cs = rp[2 * e], sn = rp[2 * e + 1];
                    const unsigned qa = q1[e >> 1], qb = q2[e >> 1], ka = k1[e >> 1], kb = k2[e >> 1];
                    const float x1 = (e & 1) ? __uint_as_float(qa & 0xffff0000u) : __uint_as_float(qa << 16);
                    const float x2 = (e & 1) ? __uint_as_float(qb & 0xffff0000u) : __uint_as_float(qb << 16);
                    const float y1 = ((e & 1) ? __uint_as_float(ka & 0xffff0000u) : __uint_as_float(ka << 16)) * 0.125f;
                    const float y2 = ((e & 1) ? __uint_as_float(kb & 0xffff0000u) : __uint_as_float(kb << 16)) * 0.125f;
                    qo1[e] = x1 * cs - x2 * sn; qo2[e] = x2 * cs + x1 * sn;
                    ko1[e] = y1 * cs - y2 * sn; ko2[e] = y2 * cs + y1 * sn;
                    kd1[e] = ko1[e] * kdec; kd2[e] = ko2[e] * kdec;
                }
#pragma unroll
                for (int e = 0; e < 4; ++e) { q1w[e] = pk2(qo1[2 * e], qo1[2 * e + 1]); q2w[e] = pk2(qo2[2 * e], qo2[2 * e + 1]); k1w[e] = pk2(ko1[2 * e], ko1[2 * e + 1]); k2w[e] = pk2(ko2[2 * e], ko2[2 * e + 1]); }
            }
            *(u32x4*)(sQ + m * 72 + i0) = q1w; *(u32x4*)(sQ + m * 72 + 32 + i0) = q2w;
            *(u32x4*)(sK + m * 72 + i0) = k1w; *(u32x4*)(sK + m * 72 + 32 + i0) = k2w;
#pragma unroll
            for (int e = 0; e < 8; ++e) { sKdT[(i0 + e) * 136 + m] = f2bf(kd1[e]); sKdT[(32 + i0 + e) * 136 + m] = f2bf(kd2[e]); }
            const int m2 = tid & 127, e0 = (tid >> 7) * 32;
#pragma unroll
            for (int i = 0; i < 4; ++i)
#pragma unroll
                for (int e = 0; e < 4; ++e) { sVT[(e0 + 8 * i + 2 * e) * 136 + m2] = (bf16_t)(vv[i][e] & 0xffffu); sVT[(e0 + 8 * i + 2 * e + 1) * 136 + m2] = (bf16_t)(vv[i][e] >> 16); }
        }
        __syncthreads();
        if (ck + 1 < nch) RET_LOAD(ck + 1);
        f32x4 o[8];
        const bool act = (16 * w < C);
        unsigned gcp[4][4];
        if (act) {
#pragma unroll
            for (int j = 0; j < 4; ++j) { const int n = 16 * w + 4 * fq + j; const size_t row = (size_t)(rowb + t0 + (n < C ? n : 0));
#pragma unroll
                for (int e2 = 0; e2 < 4; ++e2) { const bf16_t lo = Z[row * DIN + ZO_GC + h * 128 + 32 * e2 + fr], hi = Z[row * DIN + ZO_GC + h * 128 + 32 * e2 + 16 + fr]; gcp[e2][j] = (unsigned)lo | ((unsigned)hi << 16); } }
        }
        if (act) {
            bf16x8 qf[2];
#pragma unroll
            for (int ks = 0; ks < 2; ++ks) qf[ks] = *(const bf16x8*)(sQ + (16 * w + fr) * 72 + 32 * ks + 8 * fq);
            const int mtN = (w | 1) + 1;
            for (int mt = 0; mt < mtN; ++mt) {
                f32x4 a = {0.f, 0.f, 0.f, 0.f};
#pragma unroll
                for (int ks = 0; ks < 2; ++ks) { const bf16x8 kf = *(const bf16x8*)(sK + (16 * mt + fr) * 72 + 32 * ks + 8 * fq); a = mfma16(qf[ks], kf, a); }
#pragma unroll
                for (int j = 0; j < 4; ++j) { const int d = (16 * w + 4 * fq + j) - (16 * mt + fr); const float v = d >= 0 ? a[j] * __expf(lg * (float)d) : 0.f; sP[(4 * fq + j) * 136 + 16 * mt + fr] = f2bf(v); }
            }
            lds_wait();
#pragma unroll
            for (int et = 0; et < 8; ++et) o[et] = (f32x4){0.f, 0.f, 0.f, 0.f};
            const int ksN = mtN >> 1;
            for (int ks = 0; ks < ksN; ++ks) {
                const bf16x8 pf = *(const bf16x8*)(sP + fr * 136 + 32 * ks + 8 * fq);
#pragma unroll
                for (int et = 0; et < 8; ++et) { const bf16x8 vf = *(const bf16x8*)(sVT + (16 * et + fr) * 136 + 32 * ks + 8 * fq); o[et] = mfma16(pf, vf, o[et]); }
            }
            f32x4 o2[8];
#pragma unroll
            for (int et = 0; et < 8; ++et) o2[et] = (f32x4){0.f, 0.f, 0.f, 0.f};
#pragma unroll
            for (int ks = 0; ks < 2; ++ks)
#pragma unroll
                for (int et = 0; et < 8; ++et) { const bf16x8 sf = *(const bf16x8*)(sST + (16 * et + fr) * 72 + 32 * ks + 8 * fq); o2[et] = mfma16(qf[ks], sf, o2[et]); }
#pragma unroll
            for (int j = 0; j < 4; ++j) { const float sc = __expf(lg * (float)(16 * w + 4 * fq + j + 1));
#pragma unroll
                for (int et = 0; et < 8; ++et) o[et][j] += o2[et][j] * sc; }
        }
        {
            const float gC = __expf(lg * (float)C);
#pragma unroll
            for (int dt = 0; dt < 4; ++dt) accS[dt] = accS[dt] * gC;
            const int ksN = (C + 31) >> 5;
            for (int ks = 0; ks < ksN; ++ks) {
                const bf16x8 vf = *(const bf16x8*)(sVT + (16 * w + fr) * 136 + 32 * ks + 8 * fq);
#pragma unroll
                for (int dt = 0; dt < 4; ++dt) { const bf16x8 kf = *(const bf16x8*)(sKdT + (16 * dt + fr) * 136 + 32 * ks + 8 * fq); accS[dt] = mfma16(kf, vf, accS[dt]); }
            }
        }
        __syncthreads();
#pragma unroll
        for (int dt = 0; dt < 4; ++dt) { u32x2 ow; ow.x = pk2(accS[dt][0], accS[dt][1]); ow.y = pk2(accS[dt][2], accS[dt][3]); *(u32x2*)(sST + (16 * w + fr) * 72 + 16 * dt + 4 * fq) = ow; }
        if (act) {
#pragma unroll
            for (int j = 0; j < 4; ++j) {
                float s = 0.f;
#pragma unroll
                for (int et = 0; et < 8; ++et) s += o[et][j];
                s += __shfl_xor(s, 1); s += __shfl_xor(s, 2); s += __shfl_xor(s, 4); s += __shfl_xor(s, 8);
                const float mu = s * (1.0f / 128.0f);
                float s2 = 0.f;
#pragma unroll
                for (int et = 0; et < 8; ++et) { const float d = o[et][j] - mu; s2 += d * d; }
                s2 += __shfl_xor(s2, 1); s2 += __shfl_xor(s2, 2); s2 += __shfl_xor(s2, 4); s2 += __shfl_xor(s2, 8);
                const float rstd = rsqrtf(s2 * (1.0f / 128.0f) + EPS);
                const int n = 16 * w + 4 * fq + j;
                if (n < C) {
                    const size_t row = (size_t)(rowb + t0 + n);
#pragma unroll
                    for (int et = 0; et < 8; ++et) { const int e = 16 * et + fr; const unsigned gw_ = gcp[et >> 1][j]; const float gcv = (et & 1) ? __uint_as_float(gw_ & 0xffff0000u) : __uint_as_float(gw_ << 16);
                        const float yv = gcv * sigm(gcv) * (o[et][j] - mu) * rstd * ng[e]; Y[row * LDY + 1536 + h * 128 + e] = f2bf(yv); }
                }
            }
        }
    }
    if (grp ? OUT_ON(12) : OUT_ON(6)) {
#pragma unroll
    for (int dt = 0; dt < 4; ++dt)
#pragma unroll
        for (int j = 0; j < 4; ++j) Sout[(16 * dt + 4 * fq + j) * 128 + 16 * w + fr] = accS[dt][j];
    }
}

__device__ __forceinline__ void lru_job(const Params& P, int l, int grp, int jid, int g0, int pb0, unsigned char* smem) {
    const int tid = otid(), w = __builtin_amdgcn_readfirstlane(tid >> 6), lane = tid & 63, fr = lane & 15, fq = lane >> 4;
    bf16_t* sA = (bf16_t*)(smem + w * 10752);
    float* sRI = (float*)(smem + w * 10752 + 2304);
    float* sComb = (float*)(smem + 8 * 10752);
    const bf16_t* Z = (const bf16_t*)(P.ws + R_Z) - (size_t)g0 * DIN; bf16_t* Y = (bf16_t*)(P.ws + R_Y) - (size_t)g0 * LDY;
    const int unit = grp ? jid * 8 + w : jid;
    const int bl = unit / 12, hb = unit - bl * 12, ch = hb * 64 + lane; const int b = grp ? bl : pb0 + bl;
    const int L = grp ? 4 : LP, rowb = grp ? TPR + b * 4 : b * LP;
    float cw[4];
#pragma unroll
    for (int j = 0; j < 4; ++j) cw[j] = INP(I_LCW)[((size_t)l * 4 + j) * 768 + ch];
    const float cb = INP(I_LCB)[l * 768 + ch], ba = INP(I_LBA)[l * 768 + ch], bx = INP(I_LBX)[l * 768 + ch];
    const float lam = INP(I_LAM)[l * 768 + ch];
    const float sp8 = 8.0f * (fmaxf(-lam, 0.f) + log1pf(__expf(-fabsf(lam))));
    bf16x8 Wa[4][2], Wx[4][2];
    { const float* wa = INP(I_LWA) + ((size_t)l * 12 + hb) * 4096; const float* wx = INP(I_LWX) + ((size_t)l * 12 + hb) * 4096;
#pragma unroll
      for (int nt = 0; nt < 4; ++nt)
#pragma unroll
          for (int ks = 0; ks < 2; ++ks)
#pragma unroll
              for (int j = 0; j < 8; ++j) { const int k = 32 * ks + 8 * fq + j, n = 16 * nt + fr; Wa[nt][ks][j] = (short)f2bf(wa[k * 64 + n]); Wx[nt][ks][j] = (short)f2bf(wx[k * 64 + n]); } }
    float carry = grp ? INP(I_LRUH)[((size_t)l * DEC_B + b) * 768 + ch] : 0.f;
    const float* cache = INP(I_LRUC) + ((size_t)l * DEC_B + b) * 3 * 768;
    const int nIter = grp ? 1 : 17;
    __syncthreads();
#ifndef LRU_REP
#define LRU_REP 1
#endif
    bf16_t xn[19];
    { const int tw0 = grp ? 0 : 16 * w;
#pragma unroll
      for (int i = 0; i < 19; ++i) { int t = tw0 - 3 + i; t = t < 0 ? 0 : (t > L - 1 ? L - 1 : t); xn[i] = Z[(size_t)(rowb + t) * DIN + ZO_XB + ch]; } }
    for (int it_ = 0; it_ < nIter * (grp ? 1 : LRU_REP); ++it_) {
        const int it = it_ % nIter; if (LRU_REP > 1 && it_ == nIter) carry = 0.f;
        const int tw = grp ? 0 : it * 128 + 16 * w;
        float xv[19];
#pragma unroll
        for (int i = 0; i < 19; ++i) { const int t = tw - 3 + i; xv[i] = (t >= 0 && t < L) ? bf2f(xn[i]) : 0.f; }
        if (grp) {
#pragma unroll
            for (int i = 0; i < 3; ++i) xv[i] = cache[i * 768 + ch];
        }
        if (it_ + 1 < nIter * (grp ? 1 : LRU_REP)) {
            const int twn = tw + 128;
#pragma unroll
            for (int i = 0; i < 19; ++i) { int t = twn - 3 + i; t = t < 0 ? 0 : (t > L - 1 ? L - 1 : t); xn[i] = Z[(size_t)(rowb + t) * DIN + ZO_XB + ch]; }
        }
        unsigned gtp[8];
#pragma unroll
        for (int i = 0; i < 8; ++i) { const int ta = tw + 2 * i, tb = ta + 1;
            const bf16_t lo = Z[(size_t)(rowb + (ta < L ? ta : L - 1)) * DIN + ZO_GB + ch], hi = Z[(size_t)(rowb + (tb < L ? tb : L - 1)) * DIN + ZO_GB + ch];
            gtp[i] = (unsigned)lo | ((unsigned)hi << 16); }
        float xc[16];
#pragma unroll
        for (int i = 0; i < 16; ++i) { xc[i] = cb + cw[0] * xv[i] + cw[1] * xv[i + 1] + cw[2] * xv[i + 2] + cw[3] * xv[i + 3]; sA[i * 72 + lane] = f2bf(xc[i]); }
        lds_wait();
        bf16x8 af[2];
#pragma unroll
        for (int ks = 0; ks < 2; ++ks) af[ks] = *(const bf16x8*)(sA + fr * 72 + 32 * ks + 8 * fq);
#pragma unroll
        for (int nt = 0; nt < 4; ++nt) {
            f32x4 ra = {0.f, 0.f, 0.f, 0.f}, rx = ra;
            ra = mfma16(af[0], Wa[nt][0], ra); ra = mfma16(af[1], Wa[nt][1], ra);
            rx = mfma16(af[0], Wx[nt][0], rx); rx = mfma16(af[1], Wx[nt][1], rx);
#pragma unroll
            for (int j = 0; j < 4; ++j) { sRI[(4 * fq + j) * 132 + 16 * nt + fr] = ra[j]; sRI[(4 * fq + j) * 132 + 64 + 16 * nt + fr] = rx[j]; }
        }
        lds_wait();
        float hloc[16], ca[16]; float hl = 0.f, cacc = 1.f;
#pragma unroll
        for (int i = 0; i < 16; ++i) {
            const float rp = sRI[i * 132 + lane], ip = sRI[i * 132 + 64 + lane];
            const float r = sigm(rp + ba), ii = sigm(ip + bx);
            const float la = -sp8 * r; float a = __expf(la);
            const float x2 = 2.0f * la;
            const float ser = -x2 * (1.0f + x2 * (0.5f + x2 * (0.16666667f + x2 * (0.041666668f + x2 * 0.0083333338f))));
            const float om = x2 > -0.25f ? ser : 1.0f - __expf(x2);
            float bv = __builtin_amdgcn_sqrtf(om) * ii * xc[i];
            if (tw + i >= L) { a = 1.f; bv = 0.f; }
            hl = a * hl + bv; cacc *= a; hloc[i] = hl; ca[i] = cacc;
        }
        float hin = carry;
        if (!grp) {
            float* sCb = sComb + (it_ & 1) * 1024;
            sCb[(w * 64 + lane) * 2] = cacc; sCb[(w * 64 + lane) * 2 + 1] = hl;
            __syncthreads();
            float run = carry;
#pragma unroll
            for (int ww = 0; ww < 8; ++ww) { if (ww == w) hin = run; run = sCb[(ww * 64 + lane) * 2] * run + sCb[(ww * 64 + lane) * 2 + 1]; }
            carry = run;
        } else carry = hloc[15] + ca[15] * hin;
#pragma unroll
        for (int i = 0; i < 16; ++i) { const int t = tw + i;
            if (t < L) { const size_t row = (size_t)(rowb + t); const float hh = hloc[i] + ca[i] * hin; const unsigned gw_ = gtp[i >> 1]; const float gt = (i & 1) ? __uint_as_float(gw_ & 0xffff0000u) : __uint_as_float(gw_ << 16); Y[row * LDY + 768 + ch] = f2bf(hh * gelu_t(gt)); } }
    }
    if (grp || w == 0) {
        float* ho = grp ? P.out + O_S_LRUH + ((size_t)l * DEC_B + b) * 768 + ch : P.out + O_P_LRUH + ((size_t)l * NB + b) * 768 + ch;
        if (grp ? OUT_ON(10) : OUT_ON(4)) *ho = carry;
        float* co = grp ? P.out + O_S_LRUC + ((size_t)l * DEC_B + b) * 3 * 768 + ch : P.out + O_P_LRUC + ((size_t)l * NB + b) * 3 * 768 + ch;
#pragma unroll
        for (int j = 0; j < 3; ++j) if (grp ? OUT_ON(11) : OUT_ON(5)) co[j * 768] = bf2f(Z[(size_t)(rowb + L - 3 + j) * DIN + ZO_XB + ch]);
    }
}

template <bool FULL>
__device__ __forceinline__ void s5_run(const bf16_t* Z, bf16_t* ZS, float* sBU, bf16_t* sH, const bf16x8 (&Bf)[8], const bf16x8 (&Cf)[4], float abr, float abi, float dsk,
                                       int rowb, int g, int L, int it0, int it1, float& hr, float& hi, int lane, int fr, int fq) {
    u32x4 ufn = {0u, 0u, 0u, 0u}; bf16_t udn[4] = {0, 0, 0, 0};
    { const int t1 = it0 * 16; const int v1 = (L - t1) < 16 ? (L - t1) : 16;
      if (fq < 2 && fr < v1) ufn = *(const u32x4*)(Z + (size_t)(rowb + t1 + fr) * DIN + ZO_UA + g * 16 + 8 * fq);
      if (FULL) {
#pragma unroll
          for (int j = 0; j < 4; ++j) if (4 * fq + j < v1) udn[j] = Z[(size_t)(rowb + t1 + 4 * fq + j) * DIN + ZO_UA + g * 16 + fr]; } }
    for (int it = it0; it < it1; ++it) {
        const int t0 = it * 16; const int valid = (L - t0) < 16 ? (L - t0) : 16;
        const bf16x8 uf = __builtin_bit_cast(bf16x8, ufn);
        bf16_t ud[4];
#pragma unroll
        for (int j = 0; j < 4; ++j) ud[j] = udn[j];
        if (it + 1 < it1) { const int t1 = t0 + 16; const int v1 = (L - t1) < 16 ? (L - t1) : 16;
            ufn = (u32x4){0u, 0u, 0u, 0u};
            if (fq < 2 && fr < v1) ufn = *(const u32x4*)(Z + (size_t)(rowb + t1 + fr) * DIN + ZO_UA + g * 16 + 8 * fq);
            if (FULL) {
#pragma unroll
                for (int j = 0; j < 4; ++j) { udn[j] = 0; if (4 * fq + j < v1) udn[j] = Z[(size_t)(rowb + t1 + 4 * fq + j) * DIN + ZO_UA + g * 16 + fr]; } } }
#pragma unroll
        for (int nt = 0; nt < 8; ++nt) { f32x4 a = {0.f, 0.f, 0.f, 0.f}; a = mfma16(uf, Bf[nt], a);
#pragma unroll
            for (int j = 0; j < 4; ++j) sBU[(4 * fq + j) * 132 + 16 * nt + fr] = a[j]; }
        lds_wait();
#pragma unroll
        for (int i = 0; i < 16; ++i) {
            float bur = sBU[i * 132 + lane], bui = sBU[i * 132 + 64 + lane];
            asm volatile("" : "+v"(bur), "+v"(bui));
            const float msk = (i < valid) ? 1.0f : 0.0f;
            float nr = __builtin_fmaf(abr, hr, bur); asm volatile("" : "+v"(nr));
            nr = __builtin_fmaf(-abi, hi, nr); asm volatile("" : "+v"(nr));
            float ni = __builtin_fmaf(abr, hi, bui); asm volatile("" : "+v"(ni));
            ni = __builtin_fmaf(abi, hr, ni); asm volatile("" : "+v"(ni));
            hr = __builtin_fmaf(msk, nr - hr, hr); hi = __builtin_fmaf(msk, ni - hi, hi);
            asm volatile("" : "+v"(hr), "+v"(hi));
            if (FULL) { sH[i * 136 + lane] = f2bf(hr); sH[i * 136 + 64 + lane] = f2bf(hi); }
        }
        lds_wait();
        if (FULL) {
            f32x4 y = {0.f, 0.f, 0.f, 0.f};
#pragma unroll
            for (int ks = 0; ks < 4; ++ks) { const bf16x8 hf = *(const bf16x8*)(sH + fr * 136 + 32 * ks + 8 * fq); y = mfma16(hf, Cf[ks], y); }
#pragma unroll
            for (int j = 0; j < 4; ++j) { const int t = 4 * fq + j;
                if (t < valid) { const size_t row = (size_t)(rowb + t0 + t); const float u = bf2f(ud[j]); ZS[row * 768 + g * 16 + fr] = f2bf(gelu_t(y[j] + dsk * u)); } }
            lds_wait();
        }
    }
}
__device__ __forceinline__ void cmul(float& ar, float& ai, float br, float bi) { const float r = ar * br - ai * bi, i = ar * bi + ai * br; ar = r; ai = i; }

__device__ __forceinline__ void s5_job(const Params& P, int l, int grp, int jid, int g0, int pb0, unsigned* s5done, unsigned char* smem) {
    const int tid = otid(), w = __builtin_amdgcn_readfirstlane(tid >> 6), lane = tid & 63, fr = lane & 15, fq = lane >> 4;
    float* sBU = (float*)(smem + w * 12800);
    bf16_t* sH = (bf16_t*)(smem + w * 12800 + 8448);
    float* sC = (float*)(smem + 8 * 12800);
    const bf16_t* Z = (const bf16_t*)(P.ws + R_Z) - (size_t)g0 * DIN; bf16_t* ZS = (bf16_t*)(P.ws + R_ZS5) - (size_t)g0 * 768;
    int g, b0;
    if (grp) { const int unit = jid * 8 + w; g = unit % 48; b0 = (unit / 48) * 16; } else { b0 = jid / 48; g = jid - b0 * 48; b0 += pb0; }
    const float dt = __expf(INP(I_LS)[l * 48 + g]);
    float abr = 0.f, abi = 0.f;
    bf16x8 Bf[8];
#pragma unroll
    for (int k = 0; k < 4; ++k) {
        const int p = 16 * k + fr;
        const float lr = INP(I_AR)[((size_t)l * 48 + g) * 64 + p], li = INP(I_AI)[((size_t)l * 48 + g) * 64 + p];
        const float mag = expf(lr * dt), ar_ = mag * cosf(li * dt), ai_ = mag * sinf(li * dt);
        if (k == fq) { abr = ar_; abi = ai_; }
        const float den = lr * lr + li * li, nr = ar_ - 1.0f;
        const float cr = (nr * lr + ai_ * li) / den, ci = (ai_ * lr - nr * li) / den;
        bf16x8 fre, fim;
#pragma unroll
        for (int j = 0; j < 8; ++j) { fre[j] = 0; fim[j] = 0; }
        if (fq < 2) {
            const float* bre = INP(I_BR) + (((size_t)l * 48 + g) * 64 + p) * 16 + 8 * fq; const float* bim = INP(I_BI) + (((size_t)l * 48 + g) * 64 + p) * 16 + 8 * fq;
#pragma unroll
            for (int j = 0; j < 8; ++j) { const float br_ = bre[j], bi_ = bim[j]; fre[j] = (short)f2bf(cr * br_ - ci * bi_); fim[j] = (short)f2bf(cr * bi_ + ci * br_); }
        }
        Bf[k] = fre; Bf[4 + k] = fim;
    }
    bf16x8 Cf[4];
#pragma unroll
    for (int ks = 0; ks < 4; ++ks) {
        const float* cp = (ks < 2 ? INP(I_CR) : INP(I_CI)) + (((size_t)l * 48 + g) * 16 + fr) * 64 + 32 * (ks & 1) + 8 * fq;
        const float sg = ks < 2 ? 1.0f : -1.0f;
#pragma unroll
        for (int j = 0; j < 8; ++j) Cf[ks][j] = (short)f2bf(sg * cp[j]);
    }
    const float dsk = INP(I_D)[l * 768 + g * 16 + fr];
    __syncthreads();
    if (grp) {
        for (int s = 0; s < 16; ++s) {
            const int b = b0 + s; const int rowb = TPR + b * 4;
            float hr = INP(I_S5RE)[(((size_t)l * DEC_B + b) * 48 + g) * 64 + lane], hi = INP(I_S5IM)[(((size_t)l * DEC_B + b) * 48 + g) * 64 + lane];
            s5_run<true>(Z, ZS, sBU, sH, Bf, Cf, abr, abi, dsk, rowb, g, 4, 0, 1, hr, hi, lane, fr, fq);
            P.out[O_S_S5RE + (((size_t)l * DEC_B + b) * 48 + g) * 64 + lane] = hr;
            P.out[O_S_S5IM + (((size_t)l * DEC_B + b) * 48 + g) * 64 + lane] = hi;
        }
    } else {
        const int b = b0, rowb = b * LP;
        const int it0 = w == 0 ? 0 : 17 + 16 * (w - 1), it1 = 17 + 16 * w;
        float hr = 0.f, hi = 0.f;
        s5_run<false>(Z, ZS, sBU, sH, Bf, Cf, abr, abi, dsk, rowb, g, LP, it0, it1, hr, hi, lane, fr, fq);
        sC[(w * 64 + lane) * 2] = hr; sC[(w * 64 + lane) * 2 + 1] = hi;
        float pr = abr, pi = abi, p16r = 0.f, p16i = 0.f;
#pragma unroll
        for (int q = 0; q < 8; ++q) { cmul(pr, pi, pr, pi); if (q == 3) { p16r = pr; p16i = pi; } }
        float qr = pr, qi = pi; cmul(qr, qi, p16r, p16i);
        __syncthreads();
        float cr_ = 0.f, ci_ = 0.f;
        for (int ww = 0; ww < w; ++ww) {
            const float ar2 = ww == 0 ? qr : pr, ai2 = ww == 0 ? qi : pi;
            cmul(cr_, ci_, ar2, ai2);
            cr_ += sC[(ww * 64 + lane) * 2]; ci_ += sC[(ww * 64 + lane) * 2 + 1];
        }
        hr = cr_; hi = ci_;
        s5_run<true>(Z, ZS, sBU, sH, Bf, Cf, abr, abi, dsk, rowb, g, LP, it0, it1, hr, hi, lane, fr, fq);
        if (w == 7) {
            P.out[O_P_S5RE + (((size_t)l * NB + b) * 48 + g) * 64 + lane] = hr;
            P.out[O_P_S5IM + (((size_t)l * NB + b) * 48 + g) * 64 + lane] = hi;
        }
    }
    asm volatile("s_waitcnt vmcnt(0)" ::: "memory");
    __syncthreads();
    if (threadIdx.x == 0) { __threadfence(); atomicAdd(s5done, 1u); }
}

__device__ __forceinline__ void mixers_phase(const Params& P, int l, int rg, unsigned char* smem, int rep) {
    const Grp G = get_grp(rg);
    const int j1 = G.npb * 8, j2 = j1 + G.npb * 12, j3 = j2 + G.npb * 48, j4 = j3 + (G.hasS ? 1024 : 0), j5 = j4 + (G.hasS ? 48 : 0), j6 = j5 + (G.hasS ? 192 : 0), j7 = j6 + G.npan * 12, NJ = j7 + G.npan * 3;
    unsigned* s5done = (unsigned*)(P.ws + A_CTR) + 32 + (l * NGRP + rg) + rep * 16;
    const unsigned s5total = (unsigned)(G.npb * 48 + (G.hasS ? 48 : 0));
    unsigned* ctr = (unsigned*)(P.ws + A_CTR) + (l * NGRP + rg) + rep * 16;
    int* slot = (int*)(smem + LDS_BYTES - 16);
#ifndef STATIC_JOBS
#define STATIC_JOBS 0
#endif
    for (int jj = blockIdx.x;; jj += gridDim.x) {
        __syncthreads();
#if STATIC_JOBS
        const int j = jj; (void)ctr; (void)slot;
#else
        if (threadIdx.x == 0) *slot = (int)atomicAdd(ctr, 1u);
        __syncthreads();
        const int j = *slot;
#endif
        if (j >= NJ) break;
        int type, sg, idx;
        if (j < j1) { type = 0; sg = 0; idx = j; }
        else if (j < j2) { type = 1; sg = 0; idx = j - j1; }
        else if (j < j3) { type = 2; sg = 0; idx = j - j2; }
        else if (j < j4) { type = 0; sg = 1; idx = j - j3; }
        else if (j < j5) { type = 2; sg = 1; idx = j - j4; }
        else if (j < j6) { type = 1; sg = 1; idx = j - j5; }
        else if (j < j7) { type = 4; sg = 0; idx = j - j6; }
        else { type = 3; sg = 0; idx = j - j7; }
        if (type == 4) {
            using namespace pg8;
            Gemm gg{(const bf16_t*)(P.ws + R_H), (const bf16_t*)(P.ws + W_IN) + (size_t)l * DIN * DM, DM, DM, G.npan, DIN / 256, DM / 64};
            SchedOne S1{idx / 12, 21 + idx % 12, DM / 64};
            EpiBf E{(bf16_t*)(P.ws + R_Z), DIN, (bf16_t*)(P.ws + R_Z)};
            gemm_run((LAS unsigned char*)smem, gg, S1, E);
            continue;
        }
        if (type == 3) {
            if (threadIdx.x == 0) {
                unsigned sp = 0;
                while (__hip_atomic_load(s5done, __ATOMIC_RELAXED, __HIP_MEMORY_SCOPE_AGENT) < s5total) { __builtin_amdgcn_s_sleep(8); if (++sp > (1u << 22)) break; }
                __threadfence();
                asm volatile("s_waitcnt vmcnt(0)" ::: "memory");
            }
            __syncthreads();
            using namespace pg8;
            Gemm gg{(const bf16_t*)(P.ws + R_ZS5), (const bf16_t*)(P.ws + W_GLU) + (size_t)l * 768 * 768, 768, 768, G.npan, 3, 12};
            SchedOne S1{idx / 3, idx % 3, 12};
            EpiGlu E{(bf16_t*)(P.ws + R_Y), (const bf16_t*)(P.ws + R_ZS5), INP(I_BGLU) + l * 768};
            gemm_run((LAS unsigned char*)smem, gg, S1, E);
            continue;
        }
        if (type == 0) ret_job(P, l, sg, (idx >> 3) + (sg ? 0 : G.pb0), idx & 7, G.g0, smem);
        else if (type == 1) lru_job(P, l, sg, idx, G.g0, G.pb0, smem);
        else s5_job(P, l, sg, idx, G.g0, G.pb0, s5done, smem);
    }
}

__device__ __forceinline__ void run_phase(const Params& P, int ph, unsigned char* smem, int rep) {
#ifndef PHSEL
#define PHSEL -1
#endif
#define PSEL(x) (PHSEL < 0 || PHSEL == (x))
    if (ph == 0) { if (PSEL(10)) phase0(P, smem); return; }
    const int l = (ph - 1) / (10 * NGRP), rg = ((ph - 1) / 10) % NGRP, s = (ph - 1) % 10;
    LAS unsigned char* lds = (LAS unsigned char*)smem;
    unsigned char* ws = P.ws;
    using namespace pg8;
    const int G = gridDim.x, c = blockIdx.x;
    const int npan = rg < 2 ? 25 : 19;
    switch (s) {
    case 0: if (PSEL(0)) { Gemm g{(const bf16_t*)(ws + R_H), (const bf16_t*)(ws + W_IN) + (size_t)l * DIN * DM, DM, DM, npan, 21, DM / 64};
              Sched<1> S; S.init(g.nM, g.nN, G, c, g.nt); EpiBf E{(bf16_t*)(ws + R_Z), DIN, (bf16_t*)(ws + R_Z)}; gemm_run(lds, g, S, E); } break;
    case 1: if (PSEL(1)) mixers_phase(P, l, rg, smem, rep); break;
    case 2: if (PSEL(2)) { Gemm g{(const bf16_t*)(ws + R_ZS5), (const bf16_t*)(ws + W_GLU) + (size_t)l * 768 * 768, 768, 768, npan, 3, 12};
              Sched<1> S; S.init(g.nM, g.nN, G, c, g.nt); EpiGlu E{(bf16_t*)(ws + R_Y), (const bf16_t*)(ws + R_ZS5), INP(I_BGLU) + l * 768}; gemm_run(lds, g, S, E); } break;
    case 3: if (PSEL(3)) { Gemm g{(const bf16_t*)(ws + R_Y), (const bf16_t*)(ws + W_BR) + (size_t)l * DM * LDY, LDY, LDY, npan, 4, 0};
              Sched<3> S; S.init(g.nM, g.nN, G, c, 0); EpiBranch E{(const bf16_t*)(ws + R_Z) + ZO_GATE, (bf16_t*)(ws + R_M)}; gemm_run(lds, g, S, E); } break;
    case 4: if (PSEL(4)) { Gemm g{(const bf16_t*)(ws + R_M), (const bf16_t*)(ws + W_OUT) + (size_t)l * DM * DM, DM, DM, npan, 4, 16};
              Sched<2> S; S.init(g.nM, g.nN, G, c, g.nt); EpiBf E{(bf16_t*)(ws + R_F), DM, (bf16_t*)(ws + R_UP)}; gemm_run(lds, g, S, E); } break;
    case 5: if (PSEL(5) && rep == 0) norm_rows(P, 1, l, rg, smem); break;
    case 6: if (PSEL(6)) { Gemm g{(const bf16_t*)(ws + R_H), (const bf16_t*)(ws + W_UP) + (size_t)l * 2 * DFF * DM, DM, DM, npan, 22, 16};
              Sched<1> S; S.init(g.nM, g.nN, G, c, g.nt); EpiBf E{(bf16_t*)(ws + R_UP), 2 * DFF, (bf16_t*)(ws + R_UP)}; gemm_run(lds, g, S, E); } break;
    case 7: if (PSEL(7)) ffn_conv_phase(P, l, rg, smem); break;
    case 8: if (PSEL(8)) { Gemm g{(const bf16_t*)(ws + R_FIN), (const bf16_t*)(ws + W_DOWN) + (size_t)l * DM * DFF, DFF, DFF, npan, 4, 44};
              Sched<2> S; S.init(g.nM, g.nN, G, c, g.nt); EpiBf E{(bf16_t*)(ws + R_F), DM, (bf16_t*)(ws + R_UP)}; gemm_run(lds, g, S, E); } break;
    default: if (PSEL(9) && rep == 0) norm_rows(P, 2, l, rg, smem); break;
    }
}

#define XB_TMO      128
#define XB_XCNT(j)  (256  + 64 * (j))
#define XB_XSUB(j)  (1280 + 64 * (j))
#define XB_XGEN(j)  (2304 + 64 * (j))
#define XB_TOP      3328
#define XB_TOPGEN   3392
#define XCD_BAR_WORDS 3456
#define XB_SPIN_CAP (1u << 18)

__device__ __forceinline__ unsigned xb_ld(unsigned* p)              { return __hip_atomic_load(p, __ATOMIC_RELAXED, __HIP_MEMORY_SCOPE_AGENT); }
__device__ __forceinline__ unsigned xb_add(unsigned* p, unsigned v) { return __hip_atomic_fetch_add(p, v, __ATOMIC_RELAXED, __HIP_MEMORY_SCOPE_AGENT); }
__device__ __forceinline__ unsigned xb_xcc_id() { return (unsigned)__builtin_amdgcn_s_getreg((3 << 11) | 20) & 0xFu; }
#define XB_SPIN(cond, bar) do { unsigned _sp = 0; while (cond) { __builtin_amdgcn_s_sleep(1); \
    if ((++_sp & 255u) == 0u) { if (xb_ld(&(bar)[XB_TMO])) break; if (_sp > XB_SPIN_CAP) { atomicAdd(&(bar)[XB_TMO], 1u); break; } } } } while (0)

struct XcdBarrier {
    unsigned* bar; unsigned x;
    volatile LAS unsigned* st;
};

__device__ __forceinline__ XcdBarrier xcd_barrier_post(unsigned* bar, volatile LAS unsigned* st) {
    XcdBarrier b; b.bar = bar; b.x = xb_xcc_id(); b.st = st;
    if (threadIdx.x == 0) (void)xb_add(&bar[XB_XCNT(b.x)], 1u);
    return b;
}
__device__ __forceinline__ void xcd_barrier_complete(unsigned* bar, unsigned x, unsigned& nloc, unsigned& nx) {
    const unsigned G = gridDim.x * gridDim.y * gridDim.z;
    unsigned sum, cnt, mine, sp = 0u;
    for (;;) {
        sum = 0u; cnt = 0u; mine = 0u;
#pragma unroll
        for (unsigned j = 0; j < 16; ++j) { const unsigned c = xb_ld(&bar[XB_XCNT(j)]); sum += c; cnt += (c > 0u) ? 1u : 0u; mine = (j == x) ? c : mine; }
        if (sum == G) break;
        __builtin_amdgcn_s_sleep(1);
        if ((++sp & 255u) == 0u) { if (xb_ld(&bar[XB_TMO])) break; if (sp > XB_SPIN_CAP) { atomicAdd(&bar[XB_TMO], 1u); break; } }
    }
    nloc = mine > 0u ? mine : 1u; nx = cnt > 0u ? cnt : 1u;
}

__device__ __forceinline__ void xcd_barrier(const XcdBarrier& b) {
    asm volatile("s_waitcnt vmcnt(0)" ::: "memory");
    __syncthreads();
    if (threadIdx.x == 0) {
        unsigned* bar = b.bar;
        __builtin_amdgcn_s_waitcnt(0);
        unsigned nloc = b.st[0], nx = b.st[1];
        if (nloc == 0u) { xcd_barrier_complete(bar, b.x, nloc, nx); b.st[0] = nloc; b.st[1] = nx; }
        const unsigned old = xb_add(&bar[XB_XSUB(b.x)], 1u);
        const unsigned gen = old / nloc;
        if (old + 1u == (gen + 1u) * nloc) {
            __builtin_amdgcn_fence(__ATOMIC_RELEASE, "agent");
            asm volatile("s_waitcnt vmcnt(0)" ::: "memory");
            const unsigned og = xb_add(&bar[XB_TOP], 1u);
            const unsigned tg = og / nx;
            if (og + 1u == (tg + 1u) * nx) xb_add(&bar[XB_TOPGEN], 1u);
            else XB_SPIN(xb_ld(&bar[XB_TOPGEN]) == tg, bar);
            __builtin_amdgcn_fence(__ATOMIC_ACQUIRE, "agent");
            xb_add(&bar[XB_XGEN(b.x)], 1u);
            asm volatile("s_waitcnt vmcnt(0)" ::: "memory");
        } else {
            XB_SPIN(xb_ld(&bar[XB_XGEN(b.x)]) == gen, bar);
            __builtin_amdgcn_fence(__ATOMIC_ACQUIRE, "agent");
            asm volatile("s_waitcnt vmcnt(0)" ::: "memory");
        }
    }
    __syncthreads();
}


__global__ void __launch_bounds__(512, 2) mega(Params P, int ph_lo, int ph_hi) {
    extern __shared__ __attribute__((aligned(16))) unsigned char smem[];
    unsigned* xst = (unsigned*)(smem + LDS_BYTES - 32);
    if (threadIdx.x == 0) {
        const float** tab = (const float**)(smem + PTAB_OFF);
#pragma unroll
        for (int i = 0; i < N_IN; ++i) tab[i] = P.in[i];
        xst[0] = 0u; xst[1] = 0u;
    }
    __syncthreads();
    XcdBarrier xb = xcd_barrier_post((unsigned*)(P.ws + A_BAR), (volatile LAS unsigned*)xst);
#ifndef DUP_MASK
#define DUP_MASK 0x400
#endif
    for (int ph = ph_lo; ph < ph_hi; ++ph) {
        if (ph > 0 && (ph - 1) % 10 == 2) continue;
        int nrep = 1;
        if (DUP_MASK) { const int sidx = ph == 0 ? 10 : (ph - 1) % 10; if ((DUP_MASK >> sidx) & 1) nrep = 2; }
        for (int rep = 0; rep < nrep; ++rep) {
            run_phase(P, ph, smem, rep);
            if (ph + 1 < ph_hi || rep + 1 < nrep) xcd_barrier(xb);
        }
    }
}


#ifndef DBG_STOP
#define DBG_STOP 0
#endif
#ifndef DBG_OFF
#define DBG_OFF R_Z
#endif
__global__ void dbg_dump(const unsigned char* ws, float* out, size_t n) {
    const bf16_t* src = (const bf16_t*)(ws + DBG_OFF);
    for (size_t i = (size_t)blockIdx.x * blockDim.x + threadIdx.x; i < n; i += (size_t)gridDim.x * blockDim.x) out[i] = bf2f(src[i]);
}

extern "C" void kernel_launch(void* const* d_in, const int* in_sizes, int n_in, void* d_out, int out_size, void* d_ws, size_t ws_size, hipStream_t stream) {
    (void)in_sizes; (void)n_in; (void)out_size;
    if (ws_size < WS_TOTAL) { fprintf(stderr, "workspace too small: %zu < %zu\n", ws_size, (size_t)WS_TOTAL); return; }
    Params p{};
    for (int i = 0; i < N_IN; ++i) p.in[i] = (const float*)d_in[i];
    p.out = (float*)d_out; p.ws = (unsigned char*)d_ws;
    hipFuncSetAttribute((const void*)mega, hipFuncAttributeMaxDynamicSharedMemorySize, LDS_BYTES);
    int dev = 0, cus = 256, per_cu = 1;
    hipGetDevice(&dev);
    hipDeviceGetAttribute(&cus, hipDeviceAttributeMultiprocessorCount, dev);
    hipOccupancyMaxActiveBlocksPerMultiprocessor(&per_cu, mega, 512, LDS_BYTES);
    if (per_cu < 1) per_cu = 1;
    const int grid = cus * 1;
#if COOP
#ifndef PH_HI
#define PH_HI NPHASE
#endif
    hipMemsetAsync((unsigned char*)d_ws + A_BAR, 0, 16384, stream);
    int lo = 0, hi = PH_HI;
    void* args[] = {&p, &lo, &hi};
    hipError_t e = hipLaunchCooperativeKernel((void*)mega, dim3(grid), dim3(512), args, LDS_BYTES, stream);
    if (e != hipSuccess) fprintf(stderr, "cooperative launch failed: %s (grid %d)\n", hipGetErrorString(e), grid);
#else
#if DBG_STOP
    for (int ph = 0; ph < DBG_STOP; ++ph) hipLaunchKernelGGL(mega, dim3(grid), dim3(512), LDS_BYTES, stream, p, ph, ph + 1);
#ifdef DBG_EXTRA
    hipLaunchKernelGGL(mega, dim3(grid), dim3(512), LDS_BYTES, stream, p, DBG_EXTRA, DBG_EXTRA + 1);
#endif
    hipLaunchKernelGGL(dbg_dump, dim3(2048), dim3(256), 0, stream, (const unsigned char*)d_ws, (float*)d_out, (size_t)34873344);
#else
    for (int ph = 0; ph < NPHASE; ++ph) hipLaunchKernelGGL(mega, dim3(grid), dim3(512), LDS_BYTES, stream, p, ph, ph + 1);
#endif
#endif
}
```

```cpp
#include <hip/hip_runtime.h>
#include <hip/hip_cooperative_groups.h>
#include <cstdio>
namespace cg = cooperative_groups;

#define DUP_MASK 0
#ifndef COOP
#define COOP 1
#endif
#ifndef OUTMASK
#define OUTMASK 0x3FFF
#endif
#ifndef OUT_BMAX
#define OUT_BMAX 1000
#endif
#ifndef OUT_L
#define OUT_L 3
#endif
#define OUT_ON(k) (((OUTMASK >> (k)) & 1) && ((OUT_L >> l) & 1))
#ifndef DMA_AUX
#define DMA_AUX 17
#endif

#define LAS __attribute__((address_space(3)))
typedef unsigned short bf16_t;
typedef short bf16x8 __attribute__((ext_vector_type(8)));
typedef float f32x4 __attribute__((ext_vector_type(4)));
typedef unsigned u32x4 __attribute__((ext_vector_type(4)));
typedef unsigned u32x2 __attribute__((ext_vector_type(2)));

constexpr int DM = 1024, NB = 8, SEQ = 2048, LP = 2064, DEC_B = 128, DEC_S = 4;
constexpr int TPR = NB * LP;
constexpr int TT = TPR + DEC_B * DEC_S;
constexpr int TPAD = 17152;
constexpr int DIN = 8448, DFF = 2816;
constexpr int ZO_UA = 0, ZO_XB = 768, ZO_GB = 1536, ZO_Q = 2304, ZO_K = 2816, ZO_V = 3328, ZO_GC = 4352, ZO_GATE = 5376;
constexpr int LDY = 2560;
constexpr float EPS = 1e-6f;
constexpr int LDS_BYTES = 143360;

enum { I_XP = 0, I_XS, I_S5RE, I_S5IM, I_LRUH, I_LRUC, I_RET, I_FFNC, I_META, I_GPREMIX, I_GPOSTMIX, I_GPREFFN, I_GPOSTFFN, I_WIN,
       I_AR, I_AI, I_LS, I_BR, I_BI, I_CR, I_CI, I_D, I_WGLU, I_BGLU, I_LCW, I_LCB, I_LWA, I_LBA, I_LWX, I_LBX, I_LAM, I_RNG,
       I_WBA, I_WBB, I_WBC, I_WOUT, I_WUP, I_FCW, I_FCB, I_WDOWN, N_IN };

constexpr size_t O_YP = 0;
constexpr size_t O_YS = O_YP + (size_t)NB * SEQ * DM;
constexpr size_t O_P_S5RE = O_YS + (size_t)DEC_B * DEC_S * DM;
constexpr size_t O_P_S5IM = O_P_S5RE + 2 * NB * 48 * 64;
constexpr size_t O_P_LRUH = O_P_S5IM + 2 * NB * 48 * 64;
constexpr size_t O_P_LRUC = O_P_LRUH + 2 * NB * 768;
constexpr size_t O_P_RET = O_P_LRUC + 2 * NB * 3 * 768;
constexpr size_t O_P_FFNC = O_P_RET + (size_t)2 * NB * 8 * 64 * 128;
constexpr size_t O_S_S5RE = O_P_FFNC + 2 * NB * 2 * DFF;
constexpr size_t O_S_S5IM = O_S_S5RE + 2 * DEC_B * 48 * 64;
constexpr size_t O_S_LRUH = O_S_S5IM + 2 * DEC_B * 48 * 64;
constexpr size_t O_S_LRUC = O_S_LRUH + 2 * DEC_B * 768;
constexpr size_t O_S_RET = O_S_LRUC + 2 * DEC_B * 3 * 768;
constexpr size_t O_S_FFNC = O_S_RET + (size_t)2 * DEC_B * 8 * 64 * 128;

constexpr size_t al256(size_t x) { return (x + 255) & ~(size_t)255; }
constexpr size_t W_IN = 0;
constexpr size_t W_GLU = W_IN + (size_t)2 * DIN * DM * 2;
constexpr size_t W_BR = W_GLU + (size_t)2 * 768 * 768 * 2;
constexpr size_t W_OUT = W_BR + (size_t)2 * DM * LDY * 2;
constexpr size_t W_UP = W_OUT + (size_t)2 * DM * DM * 2;
constexpr size_t W_DOWN = W_UP + (size_t)2 * 2 * DFF * DM * 2;
constexpr size_t A_X = W_DOWN + (size_t)2 * DM * DFF * 2;
constexpr int GR = 6400;
constexpr size_t R_Z = A_X + (size_t)TPAD * DM * 4;
constexpr size_t R_ZS5 = R_Z + (size_t)GR * DIN * 2;
constexpr size_t R_Y = R_ZS5 + (size_t)GR * 768 * 2;
constexpr size_t R_M = R_Y + (size_t)GR * LDY * 2;
constexpr size_t R_END = R_M + (size_t)GR * DM * 2;
constexpr size_t R_H = R_M;
constexpr size_t R_F = R_Z;
constexpr size_t R_UP = R_Z + (size_t)GR * DM * 4;
constexpr size_t R_FIN = R_ZS5;
static_assert(R_UP + (size_t)GR * 2 * DFF * 2 <= R_ZS5, "UP inside Z");
static_assert(R_FIN + (size_t)GR * DFF * 2 <= R_M, "FIN inside ZS5|Y");
constexpr size_t A_ROPE = R_END;
constexpr size_t A_CTR = al256(A_ROPE + (size_t)2068 * 64 * 4);
constexpr size_t A_BAR = A_CTR + 4096;
constexpr size_t WS_TOTAL = A_BAR + 16384;
constexpr size_t R_M2 = A_X + (size_t)40 * 1024 * 1024;
static_assert(A_X + (size_t)TPAD * DM * 2 <= R_M2 && R_M2 + (size_t)GR * DM * 2 <= R_Z, "M2 inside the freed half of the X reservation");
constexpr int NGRP = 3;
constexpr int NPHASE = 1 + 2 * NGRP * 10;

struct Grp { int g0, nrows, npan, pb0, npb, hasS; };
__device__ __forceinline__ Grp get_grp(int g) {
    Grp r; r.g0 = g * 6192; r.nrows = g < 2 ? 6192 : 4640; r.npan = g < 2 ? 25 : 19; r.pb0 = g * 3; r.npb = g < 2 ? 3 : 2; r.hasS = g == 2; return r;
}

struct Params {
    const float* in[N_IN];
    float* out;
    unsigned char* ws;
};


constexpr int PTAB_OFF = 142336;
__device__ __forceinline__ const float* ldin(const unsigned char* smem, int i) {
    const unsigned long long v = ((const unsigned long long*)(smem + PTAB_OFF))[i];
    const unsigned lo = __builtin_amdgcn_readfirstlane((unsigned)v), hi = __builtin_amdgcn_readfirstlane((unsigned)(v >> 32));
    return (const float*)(((unsigned long long)hi << 32) | lo);
}
#define INP(i) ldin(smem, (i))
__device__ __forceinline__ int otid() { int t = threadIdx.x; asm volatile("" : "+v"(t)); return t; }

__device__ __forceinline__ float bf2f(bf16_t b) { return __uint_as_float(((unsigned)b) << 16); }
__device__ __forceinline__ bf16_t f2bf(float f) { unsigned u = __float_as_uint(f); u += 0x7FFFu + ((u >> 16) & 1u); return (bf16_t)(u >> 16); }
__device__ __forceinline__ unsigned pk2(float lo, float hi) { return (unsigned)f2bf(lo) | ((unsigned)f2bf(hi) << 16); }
__device__ __forceinline__ float sigm(float x) { return __builtin_amdgcn_rcpf(1.0f + __expf(-x)); }
__device__ __forceinline__ float gelu_t(float x) { const float v = 1.5957691216f * (x + 0.044715f * x * x * x); return x * __builtin_amdgcn_rcpf(1.0f + __expf(-v)); }
__device__ __forceinline__ void lds_wait() { asm volatile("s_waitcnt lgkmcnt(0)" ::: "memory"); __builtin_amdgcn_wave_barrier(); }
__device__ __forceinline__ f32x4 mfma16(bf16x8 a, bf16x8 b, f32x4 c) { return __builtin_amdgcn_mfma_f32_16x16x32_bf16(a, b, c, 0, 0, 0); }

namespace pg8 {
constexpr int BM = 256, BK = 64, HALF = 128, HTB = HALF * BK * 2, STAGE_BYTES = 8 * HTB, NXCD = 8, WGM = 8;
__device__ __forceinline__ int lds_byte(int r, int c) { const int st = (r >> 4) * 2 + (c >> 5), rr = r & 15, cc = c & 31, ob = rr * 64 + cc * 2; return st * 1024 + (ob ^ (((ob >> 9) & 1) << 5)); }
__device__ __forceinline__ void stage_rc(int b, int& R, int& C) { const int st = b / 1024, sb = b % 1024, swz = sb ^ (((sb >> 9) & 1) << 5); R = (st >> 1) * 16 + swz / 64; C = (st & 1) * 32 + (swz % 64) / 2; }

struct Unit { int pm, pn, br; };
struct Gemm { const bf16_t* A; const bf16_t* Bt; int lda, ldb, nM, nN, nt; const bf16_t* A2; };

struct SchedOne {
    int pm, pn, nt0;
    __device__ bool next(int i, Unit& u) const { if (i != 0) return false; u.pm = pm; u.pn = pn; u.br = 0; return true; }
    __device__ __forceinline__ void kr(const Unit&, size_t& koffB, int& nt) const { koffB = 0; nt = nt0; }
};
template <int NBR> struct Sched {
    int nM, nN, nwg, G, c, nt0, fullk;
    __device__ void init(int nM_, int nN_, int G_, int c_, int nt_) { nM = nM_; nN = nN_; nwg = nM * nN; G = G_; c = c_; nt0 = nt_; fullk = 0; }
    __device__ bool next(int i, Unit& u) const {
        int wgid;
        if (NBR == 2) {
            const long L = (long)i * G + c; if (L >= 2 * (long)nwg) return false;
            u.br = (int)(L / nwg); wgid = (int)(L - (long)u.br * nwg);
        } else {
            const int ti = i / NBR; u.br = i - ti * NBR;
            const long L = (long)ti * G + c; if (L >= nwg) return false;
            wgid = (int)L;
        } { const int q = nwg / NXCD, r = nwg % NXCD, xcd = wgid % NXCD, off = wgid / NXCD; wgid = (xcd < r ? xcd * (q + 1) : r * (q + 1) + (xcd - r) * q) + off; }
        const int nig = WGM * nN, gid = wgid / nig, fm = gid * WGM, gsz = (nM - fm) < WGM ? (nM - fm) : WGM;
        u.pm = fm + ((wgid % nig) % gsz); u.pn = (wgid % nig) / gsz; return true;
    }
    __device__ __forceinline__ void kr(const Unit& u, size_t& koffB, int& nt) const {
        if (NBR == 1) { koffB = 0; nt = nt0; }
        else if (NBR == 2) { if (fullk) { nt = nt0; koffB = 0; } else { nt = nt0 >> 1; koffB = (size_t)u.br * (size_t)nt * 128; } }
        else { koffB = (size_t)u.br * 1536; nt = (u.br == 2) ? 16 : 12; }
    }
};

struct SchedBr2 {
    int nM, nN, nwg, G, c;
    __device__ void init(int nM_, int nN_, int G_, int c_) { nM = nM_; nN = nN_; nwg = nM * nN; G = G_; c = c_; }
    __device__ bool next(int i, Unit& u) const {
        const int ti = i / 3, b = i - ti * 3;
        const long L = (long)ti * G + c; if (L >= 2 * (long)nwg) return false;
        const int half = (int)(L / nwg); int wgid = (int)(L - (long)half * nwg);
        { const int q = nwg / NXCD, r = nwg % NXCD, xcd = wgid % NXCD, off = wgid / NXCD; wgid = (xcd < r ? xcd * (q + 1) : r * (q + 1) + (xcd - r) * q) + off; }
        const int nig = WGM * nN, gid = wgid / nig, fm = gid * WGM, gsz = (nM - fm) < WGM ? (nM - fm) : WGM;
        u.pm = fm + ((wgid % nig) % gsz); u.pn = (wgid % nig) / gsz; u.br = b + 4 * half; return true;
    }
    __device__ __forceinline__ void kr(const Unit& u, size_t& koffB, int& nt) const {
        const int b = u.br & 3, half = u.br >> 2; nt = (b == 2) ? 8 : 6; koffB = (size_t)b * 1536 + (size_t)half * nt * 128;
    }
};
__device__ __forceinline__ unsigned cvt_pk_bf16(float lo, float hi) { unsigned r; asm volatile("v_cvt_pk_bf16_f32 %0, %1, %2" : "=v"(r) : "v"(lo), "v"(hi)); return r; }

template <class Epi, class SchedT>
__device__ __forceinline__ void gemm_phase(LAS unsigned char* lds, const Gemm g, const SchedT& S, const Epi& E) {
    const int tid = otid(), wid = __builtin_amdgcn_readfirstlane(tid >> 6), lane = tid & 63, wr = wid >> 2, wc = wid & 3, fr = lane & 15, fq = lane >> 4;
    unsigned voffA[2], voffB[2];
#pragma unroll
    for (int i = 0; i < 2; ++i) { int R, C; stage_rc(tid * 16 + i * 8192, R, C);
        voffA[i] = (unsigned)(R * g.lda + C) * 2u; voffB[i] = (unsigned)(R * g.ldb + C) * 2u; }
    const size_t kstep = (size_t)(BK * 2);
    const size_t hstepA = (size_t)HALF * g.lda * 2, hstepB = (size_t)HALF * g.ldb * 2;
    const size_t tstepA = 2 * hstepA, tstepB = 2 * hstepB;
    const unsigned ldsw = (unsigned)wid * 1024u;
    const int aoff = lds_byte(wr * 64 + fr, fq * 8), boff = lds_byte(wc * 32 + fr, fq * 8);
#define PG8_SA(b, h) (((b) * 2 + (h)) * HTB)
#define PG8_SB(b, h) ((4 + (b) * 2 + (h)) * HTB)
#define PG8_STAGE(bufoff, gbase, voff) do { _Pragma("unroll") for (int _i = 0; _i < 2; ++_i) \
        __builtin_amdgcn_global_load_lds((const unsigned*)((const char*)(gbase) + (voff)[_i]), (LAS unsigned*)(lds + (bufoff) + ldsw + _i * 8192), 16, 0, DMA_AUX); } while (0)
#define PG8_LDA(dst, b, h) do { _Pragma("unroll") for (int m = 0; m < 4; ++m) _Pragma("unroll") for (int k = 0; k < 2; ++k) dst[m][k] = *(const LAS bf16x8*)(lds + PG8_SA(b, h) + aoff + m * 2048 + k * 1024); } while (0)
#define PG8_LDB(dst, b, h) do { _Pragma("unroll") for (int n = 0; n < 2; ++n) _Pragma("unroll") for (int k = 0; k < 2; ++k) dst[n][k] = *(const LAS bf16x8*)(lds + PG8_SB(b, h) + boff + n * 2048 + k * 1024); } while (0)
#define PG8_MMA(ai, bj, At, Bt) do { __builtin_amdgcn_s_setprio(1); _Pragma("unroll") for (int m = 0; m < 4; ++m) _Pragma("unroll") for (int n = 0; n < 2; ++n) _Pragma("unroll") for (int k = 0; k < 2; ++k) \
        acc[ai][bj][m][n] = __builtin_amdgcn_mfma_f32_16x16x32_bf16(Bt[n][k], At[m][k], acc[ai][bj][m][n], 0, 0, 0); __builtin_amdgcn_s_setprio(0); } while (0)
#define PG8_WAIT_V(n) asm volatile("s_waitcnt vmcnt(" #n ")" ::: "memory")
#define PG8_WAIT_L(n) asm volatile("s_waitcnt lgkmcnt(" #n ")" ::: "memory")
#define PG8_BAR __builtin_amdgcn_s_barrier()
#define PG8_SCHED __builtin_amdgcn_sched_barrier(0)
    Unit cur, nxt; int ui = 0;
    if (!S.next(0, cur)) return;
    f32x4 acc[2][2][4][2];
#pragma unroll
    for (int a = 0; a < 2; ++a)
#pragma unroll
        for (int b = 0; b < 2; ++b)
#pragma unroll
            for (int m = 0; m < 4; ++m)
#pragma unroll
                for (int n = 0; n < 2; ++n) acc[a][b][m][n] = (f32x4){0.f, 0.f, 0.f, 0.f};
    bf16x8 At[4][2], B0[2][2], B1[2][2];
    size_t koc; int ntc; S.kr(cur, koc, ntc);
    const char* cA = (const char*)((g.A2 && cur.br) ? g.A2 : g.A) + (size_t)cur.pm * tstepA + koc; const char* cB = (const char*)g.Bt + (size_t)cur.pn * tstepB + koc;
    PG8_STAGE(PG8_SB(0, 0), cB, voffB); PG8_STAGE(PG8_SA(0, 0), cA, voffA); PG8_STAGE(PG8_SB(0, 1), cB + hstepB, voffB); PG8_STAGE(PG8_SA(0, 1), cA + hstepA, voffA);
    if (wr == 1) PG8_BAR;
    PG8_WAIT_V(4); PG8_BAR;
    PG8_STAGE(PG8_SB(1, 0), cB + kstep, voffB); PG8_STAGE(PG8_SA(1, 0), cA + kstep, voffA); PG8_STAGE(PG8_SB(1, 1), cB + hstepB + kstep, voffB);
    PG8_WAIT_V(6); PG8_BAR;
    for (;;) {
        const bool has_next = S.next(ui + 1, nxt);
        size_t kon = 0; int ntn = ntc; if (has_next) S.kr(nxt, kon, ntn);
        const char* nA = has_next ? (const char*)((g.A2 && nxt.br) ? g.A2 : g.A) + (size_t)nxt.pm * tstepA + kon : cA; const char* nB = has_next ? (const char*)g.Bt + (size_t)nxt.pn * tstepB + kon : cB;
        for (int t = 0; t < ntc; t += 2) {
            const bool last = (t == ntc - 2);
            const char* a1 = cA + (size_t)(t + 1) * kstep;
            const char* a2 = last ? nA : cA + (size_t)(t + 2) * kstep; const char* b2 = last ? nB : cB + (size_t)(t + 2) * kstep;
            const char* a3 = a2 + kstep; const char* b3 = b2 + kstep;
            PG8_LDB(B0, 0, 0); PG8_SCHED; PG8_LDA(At, 0, 0); PG8_STAGE(PG8_SA(1, 1), a1 + hstepA, voffA);
            PG8_WAIT_L(8); PG8_BAR; PG8_WAIT_L(0); PG8_MMA(0, 0, At, B0); PG8_BAR; PG8_SCHED;
            PG8_LDB(B1, 0, 1); PG8_STAGE(PG8_SB(0, 0), b2, voffB);
            PG8_BAR; PG8_WAIT_L(0); PG8_MMA(0, 1, At, B1); PG8_BAR;
            PG8_LDA(At, 0, 1); PG8_STAGE(PG8_SA(0, 0), a2, voffA);
            PG8_BAR; PG8_WAIT_L(0); PG8_MMA(1, 0, At, B0); PG8_BAR; PG8_SCHED;
            PG8_STAGE(PG8_SB(0, 1), b2 + hstepB, voffB);
            PG8_WAIT_V(6); PG8_BAR; PG8_MMA(1, 1, At, B1); PG8_BAR;
            PG8_LDB(B0, 1, 0); PG8_SCHED; PG8_LDA(At, 1, 0); PG8_STAGE(PG8_SA(0, 1), a2 + hstepA, voffA);
            PG8_WAIT_L(8); PG8_BAR; PG8_WAIT_L(0); PG8_MMA(0, 0, At, B0); PG8_BAR; PG8_SCHED;
            PG8_LDB(B1, 1, 1); PG8_STAGE(PG8_SB(1, 0), b3, voffB);
            PG8_BAR; PG8_WAIT_L(0); PG8_MMA(0, 1, At, B1); PG8_BAR;
            PG8_LDA(At, 1, 1); PG8_STAGE(PG8_SA(1, 0), a3, voffA);
            PG8_BAR; PG8_WAIT_L(0); PG8_MMA(1, 0, At, B0); PG8_BAR; PG8_SCHED;
            PG8_STAGE(PG8_SB(1, 1), b3 + hstepB, voffB);
            PG8_WAIT_V(6); PG8_BAR; PG8_MMA(1, 1, At, B1); PG8_BAR;
        }
        E(acc, cur, wr, wc, fr, fq);
        if (!has_next) break;
#pragma unroll
        for (int a = 0; a < 2; ++a)
#pragma unroll
            for (int b = 0; b < 2; ++b)
#pragma unroll
                for (int m = 0; m < 4; ++m)
#pragma unroll
                    for (int n = 0; n < 2; ++n) acc[a][b][m][n] = (f32x4){0.f, 0.f, 0.f, 0.f};
        cur = nxt; cA = nA; cB = nB; ntc = ntn; ++ui;
    }
    PG8_WAIT_V(0);
    if (wr == 0) PG8_BAR;
    PG8_BAR;
#undef PG8_SA
#undef PG8_SB
#undef PG8_STAGE
#undef PG8_LDA
#undef PG8_LDB
#undef PG8_MMA
#undef PG8_WAIT_V
#undef PG8_WAIT_L
#undef PG8_BAR
#undef PG8_SCHED
}

struct EpiBf {
    bf16_t* O; int ldc; bf16_t* O2;
    __device__ __forceinline__ void operator()(const f32x4 (&acc)[2][2][4][2], const Unit& u, int wr, int wc, int fr, int fq) const {
        const int row0 = u.pm * BM + wr * 64 + fr, col0 = u.pn * BM + wc * 32 + 4 * fq;
        bf16_t* O = u.br ? this->O2 : this->O;
#pragma unroll
        for (int ai = 0; ai < 2; ++ai)
#pragma unroll
            for (int m = 0; m < 4; ++m) { bf16_t* rowp = O + (size_t)(row0 + ai * HALF + m * 16) * ldc + col0;
#pragma unroll
                for (int bj = 0; bj < 2; ++bj)
#pragma unroll
                    for (int n = 0; n < 2; ++n) { const f32x4 v = acc[ai][bj][m][n]; u32x2 o; o.x = cvt_pk_bf16(v[0], v[1]); o.y = cvt_pk_bf16(v[2], v[3]); *(u32x2*)(rowp + bj * HALF + n * 16) = o; } }
    }
};
struct EpiF32 {
    float* C; int ldc; float* C2;
    __device__ __forceinline__ void operator()(const f32x4 (&acc)[2][2][4][2], const Unit& u, int wr, int wc, int fr, int fq) const {
        const int row0 = u.pm * BM + wr * 64 + fr, col0 = u.pn * BM + wc * 32 + 4 * fq;
        float* C = u.br ? this->C2 : this->C;
#pragma unroll
        for (int ai = 0; ai < 2; ++ai)
#pragma unroll
            for (int m = 0; m < 4; ++m) { float* rowp = C + (size_t)(row0 + ai * HALF + m * 16) * ldc + col0;
#pragma unroll
                for (int bj = 0; bj < 2; ++bj)
#pragma unroll
                    for (int n = 0; n < 2; ++n) *(f32x4*)(rowp + bj * HALF + n * 16) = acc[ai][bj][m][n]; }
    }
};
struct EpiGlu {
    bf16_t* Y; const bf16_t* Z; const float* bias;
    __device__ __forceinline__ void operator()(const f32x4 (&acc)[2][2][4][2], const Unit& u, int wr, int wc, int fr, int fq) const {
        const int row0 = u.pm * BM + wr * 64 + fr, col0 = u.pn * BM + wc * 32 + 4 * fq;
#pragma unroll
        for (int ai = 0; ai < 2; ++ai)
#pragma unroll
            for (int m = 0; m < 4; ++m) { const size_t r = (size_t)(row0 + ai * HALF + m * 16);
#pragma unroll
                for (int bj = 0; bj < 2; ++bj)
#pragma unroll
                    for (int n = 0; n < 2; ++n) { const int c = col0 + bj * HALF + n * 16; const f32x4 v = acc[ai][bj][m][n];
                        const u32x2 zz = *(const u32x2*)(Z + r * 768 + c); const f32x4 bb = *(const f32x4*)(bias + c);
                        const float z0 = __uint_as_float(zz.x << 16), z1 = __uint_as_float(zz.x & 0xffff0000u), z2 = __uint_as_float(zz.y << 16), z3 = __uint_as_float(zz.y & 0xffff0000u);
                        u32x2 o; o.x = cvt_pk_bf16(z0 * sigm(v[0] + bb[0]), z1 * sigm(v[1] + bb[1])); o.y = cvt_pk_bf16(z2 * sigm(v[2] + bb[2]), z3 * sigm(v[3] + bb[3]));
                        *(u32x2*)(Y + r * LDY + c) = o; } }
    }
};
struct EpiBranch {
    const bf16_t* Zg; bf16_t* Mo; bf16_t* Mo2;
    __device__ __forceinline__ void operator()(const f32x4 (&acc)[2][2][4][2], const Unit& u, int wr, int wc, int fr, int fq) const {
        const int row0 = u.pm * BM + wr * 64 + fr, col0 = u.pn * BM + wc * 32 + 4 * fq; const int br = u.br & 3; bf16_t* Mo = (u.br >> 2) ? this->Mo2 : this->Mo;
#pragma unroll
        for (int ai = 0; ai < 2; ++ai)
#pragma unroll
            for (int m = 0; m < 4; ++m) { const size_t r = (size_t)(row0 + ai * HALF + m * 16);
#pragma unroll
                for (int bj = 0; bj < 2; ++bj)
#pragma unroll
                    for (int n = 0; n < 2; ++n) { const int c = col0 + bj * HALF + n * 16; const f32x4 v = acc[ai][bj][m][n];
                        const u32x2 gg = *(const u32x2*)(Zg + r * DIN + br * 1024 + c);
                        f32x4 t; t[0] = v[0] * sigm(__uint_as_float(gg.x << 16)); t[1] = v[1] * sigm(__uint_as_float(gg.x & 0xffff0000u));
                        t[2] = v[2] * sigm(__uint_as_float(gg.y << 16)); t[3] = v[3] * sigm(__uint_as_float(gg.y & 0xffff0000u));
                        bf16_t* mp = Mo + r * DM + c;
                        if (br != 0) { u32x2 p; p.x = __hip_atomic_load((const unsigned*)mp, __ATOMIC_RELAXED, __HIP_MEMORY_SCOPE_AGENT); p.y = __hip_atomic_load((const unsigned*)mp + 1, __ATOMIC_RELAXED, __HIP_MEMORY_SCOPE_AGENT); t[0] += __uint_as_float(p.x << 16); t[1] += __uint_as_float(p.x & 0xffff0000u); t[2] += __uint_as_float(p.y << 16); t[3] += __uint_as_float(p.y & 0xffff0000u); }
                        u32x2 o; o.x = cvt_pk_bf16(t[0], t[1]); o.y = cvt_pk_bf16(t[2], t[3]); *(u32x2*)mp = o; } }
    }
};

#ifndef GEMM_SIMPLE
#define GEMM_SIMPLE 0
#endif
template <class Epi, class SchedT>
__device__ __forceinline__ void gemm_simple(LAS unsigned char* lds, const Gemm g, const SchedT& S, const Epi& E) {
    const int tid = otid(), wid = __builtin_amdgcn_readfirstlane(tid >> 6), lane = tid & 63, wr = wid >> 2, wc = wid & 3, fr = lane & 15, fq = lane >> 4;
    unsigned voffA[2], voffB[2];
#pragma unroll
    for (int i = 0; i < 2; ++i) { int R, C; stage_rc(tid * 16 + i * 8192, R, C);
        voffA[i] = (unsigned)(R * g.lda + C) * 2u; voffB[i] = (unsigned)(R * g.ldb + C) * 2u; }
    const size_t hstepA = (size_t)HALF * g.lda * 2, hstepB = (size_t)HALF * g.ldb * 2;
    const int aoff = lds_byte(wr * 64 + fr, fq * 8), boff = lds_byte(wc * 32 + fr, fq * 8);
    Unit cur;
    for (int ui = 0; S.next(ui, cur); ++ui) {
        size_t koc; int ntc; S.kr(cur, koc, ntc);
        const char* cA = (const char*)((g.A2 && cur.br) ? g.A2 : g.A) + (size_t)cur.pm * 2 * hstepA + koc; const char* cB = (const char*)g.Bt + (size_t)cur.pn * 2 * hstepB + koc;
        f32x4 acc[2][2][4][2];
#pragma unroll
        for (int a = 0; a < 2; ++a)
#pragma unroll
            for (int b = 0; b < 2; ++b)
#pragma unroll
                for (int m = 0; m < 4; ++m)
#pragma unroll
                    for (int n = 0; n < 2; ++n) acc[a][b][m][n] = (f32x4){0.f, 0.f, 0.f, 0.f};
        for (int t = 0; t < ntc; ++t) {
            u32x4 ra[2][2], rb[2][2];
#pragma unroll
            for (int h = 0; h < 2; ++h)
#pragma unroll
                for (int i = 0; i < 2; ++i) { ra[h][i] = *(const u32x4*)(cA + (size_t)t * 128 + h * hstepA + voffA[i]); rb[h][i] = *(const u32x4*)(cB + (size_t)t * 128 + h * hstepB + voffB[i]); }
            __syncthreads();
#pragma unroll
            for (int h = 0; h < 2; ++h)
#pragma unroll
                for (int i = 0; i < 2; ++i) { *(LAS u32x4*)(lds + h * HTB + tid * 16 + i * 8192) = ra[h][i]; *(LAS u32x4*)(lds + (4 + h) * HTB + tid * 16 + i * 8192) = rb[h][i]; }
            __syncthreads();
#pragma unroll
            for (int ai = 0; ai < 2; ++ai) {
                bf16x8 At[4][2];
#pragma unroll
                for (int m = 0; m < 4; ++m)
#pragma unroll
                    for (int k = 0; k < 2; ++k) At[m][k] = *(const LAS bf16x8*)(lds + ai * HTB + aoff + m * 2048 + k * 1024);
#pragma unroll
                for (int bj = 0; bj < 2; ++bj) {
                    bf16x8 Bf[2][2];
#pragma unroll
                    for (int n = 0; n < 2; ++n)
#pragma unroll
                        for (int k = 0; k < 2; ++k) Bf[n][k] = *(const LAS bf16x8*)(lds + (4 + bj) * HTB + boff + n * 2048 + k * 1024);
#pragma unroll
                    for (int m = 0; m < 4; ++m)
#pragma unroll
                        for (int n = 0; n < 2; ++n)
#pragma unroll
                            for (int k = 0; k < 2; ++k) acc[ai][bj][m][n] = __builtin_amdgcn_mfma_f32_16x16x32_bf16(Bf[n][k], At[m][k], acc[ai][bj][m][n], 0, 0, 0);
                }
            }
        }
        E(acc, cur, wr, wc, fr, fq);
    }
    __syncthreads();
}
template <class Epi, class SchedT>
__device__ __forceinline__ void gemm_run(LAS unsigned char* lds, const Gemm g, const SchedT& S, const Epi& E) {
#if GEMM_SIMPLE
    gemm_simple(lds, g, S, E);
#else
    gemm_phase(lds, g, S, E);
#endif
}
}

__device__ __forceinline__ void transpose_tile(const float* __restrict__ W, int N, bf16_t* __restrict__ dst, int ldd, int koff, int tk, int tn, float* tile) {
    const int tid = otid(), a = tid >> 6, bq = tid & 63;
    __syncthreads();
#pragma unroll
    for (int i = 0; i < 8; ++i) { const int k = a + 8 * i; tile[k * 65 + bq] = W[(size_t)(tk * 64 + k) * N + tn * 64 + bq]; }
    __syncthreads();
#pragma unroll
    for (int i = 0; i < 8; ++i) { const int n = a + 8 * i; dst[(size_t)(tn * 64 + n) * ldd + koff + tk * 64 + bq] = f2bf(tile[bq * 65 + n]); }
}

__device__ __forceinline__ f32x4 ldx4(const bf16_t* p) { const u32x2 v = *(const u32x2*)p; f32x4 r; r[0] = __uint_as_float(v.x << 16); r[1] = __uint_as_float(v.x & 0xffff0000u); r[2] = __uint_as_float(v.y << 16); r[3] = __uint_as_float(v.y & 0xffff0000u); return r; }
__device__ __forceinline__ void stx4(bf16_t* p, const f32x4 v) { u32x2 o; o.x = pk2(v[0], v[1]); o.y = pk2(v[2], v[3]); *(u32x2*)p = o; }
__device__ __forceinline__ void rms_store(const f32x4 (&xv)[4], const float* g, bf16_t* dst, int lane) {
    float ss = 0.f;
#pragma unroll
    for (int i = 0; i < 4; ++i) ss += xv[i][0] * xv[i][0] + xv[i][1] * xv[i][1] + xv[i][2] * xv[i][2] + xv[i][3] * xv[i][3];
#pragma unroll
    for (int o = 32; o > 0; o >>= 1) ss += __shfl_xor(ss, o);
    const float rs = rsqrtf(ss * (1.0f / DM) + EPS);
#pragma unroll
    for (int i = 0; i < 4; ++i) { const int c = lane * 4 + 256 * i; const f32x4 gn = *(const f32x4*)(g + c); const f32x4 hv = xv[i] * gn * rs;
        u32x2 o; o.x = pk2(hv[0], hv[1]); o.y = pk2(hv[2], hv[3]); *(u32x2*)(dst + c) = o; }
}
__device__ __forceinline__ void norm_rows(const Params& P, int mode, int l, int grp, const unsigned char* smem) {
    const int tid_ = otid(); const int wid = tid_ >> 6, lane = tid_ & 63;
    bf16_t* __restrict__ X = (bf16_t*)(P.ws + A_X);
    const int gw = blockIdx.x * 8 + wid, nw = gridDim.x * 8;
    if (mode == 0) {
        const float* g0p = INP(I_GPREMIX); bf16_t* H = (bf16_t*)(P.ws + R_H);
        for (int row = gw; row < TPAD; row += nw) {
            f32x4 xv[4];
            if (row >= TT) {
#pragma unroll
                for (int i = 0; i < 4; ++i) xv[i] = (f32x4){0.f, 0.f, 0.f, 0.f};
            } else {
                const bool isP = row < TPR; int b = 0, t = 0; if (isP) { b = row / LP; t = row - b * LP; }
                const float* src = isP ? (t < 16 ? INP(I_META) + (size_t)t * DM : INP(I_XP) + ((size_t)b * SEQ + (t - 16)) * DM) : INP(I_XS) + (size_t)(row - TPR) * DM;
#pragma unroll
                for (int i = 0; i < 4; ++i) xv[i] = *(const f32x4*)(src + lane * 4 + 256 * i);
            }
#pragma unroll
            for (int i = 0; i < 4; ++i) stx4(X + (size_t)row * DM + lane * 4 + 256 * i, xv[i]);
            if (row < 6192) rms_store(xv, g0p, H + (size_t)row * DM, lane);
        }
        return;
    }
    const Grp G = get_grp(grp);
    const bf16_t* __restrict__ F = (const bf16_t*)(P.ws + R_F) - (size_t)G.g0 * DM;
    const bf16_t* __restrict__ F2 = (const bf16_t*)(P.ws + R_UP) - (size_t)G.g0 * DM;
    bf16_t* __restrict__ H = (bf16_t*)(P.ws + R_H) - (size_t)G.g0 * DM;
    const bool fin = (mode == 2 && l == 1);
    const float* gpost = (mode == 1 ? INP(I_GPOSTMIX) : INP(I_GPOSTFFN)) + l * DM;
    const float* gffn = INP(I_GPREFFN) + l * DM;
#pragma unroll 2
    for (int row = G.g0 + gw; row < G.g0 + G.nrows; row += nw) {
        f32x4 xv[4], fv[4]; float ss = 0.f;
#pragma unroll
        for (int i = 0; i < 4; ++i) { const int c = lane * 4 + 256 * i; xv[i] = ldx4(X + (size_t)row * DM + c);
            { const u32x2 fa = *(const u32x2*)(F + (size_t)row * DM + c), fb = *(const u32x2*)(F2 + (size_t)row * DM + c);
              fv[i][0] = __uint_as_float(fa.x << 16) + __uint_as_float(fb.x << 16); fv[i][1] = __uint_as_float(fa.x & 0xffff0000u) + __uint_as_float(fb.x & 0xffff0000u);
              fv[i][2] = __uint_as_float(fa.y << 16) + __uint_as_float(fb.y << 16); fv[i][3] = __uint_as_float(fa.y & 0xffff0000u) + __uint_as_float(fb.y & 0xffff0000u); }
            ss += fv[i][0] * fv[i][0] + fv[i][1] * fv[i][1] + fv[i][2] * fv[i][2] + fv[i][3] * fv[i][3]; }
#pragma unroll
        for (int o = 32; o > 0; o >>= 1) ss += __shfl_xor(ss, o);
        const float rs = rsqrtf(ss * (1.0f / DM) + EPS);
#pragma unroll
        for (int i = 0; i < 4; ++i) { const f32x4 gp = *(const f32x4*)(gpost + lane * 4 + 256 * i); xv[i] = xv[i] + fv[i] * gp * rs; }
        if (fin) {
            float* dst = nullptr;
            if (row < TPR) { const int b = row / LP, t = row - b * LP; if (t >= 16 && ((OUTMASK >> 0) & 1)) dst = P.out + O_YP + ((size_t)b * SEQ + (t - 16)) * DM; }
            else if ((OUTMASK >> 1) & 1) dst = P.out + O_YS + (size_t)(row - TPR) * DM;
            if (dst) {
#pragma unroll
                for (int i = 0; i < 4; ++i) *(f32x4*)(dst + lane * 4 + 256 * i) = xv[i];
            }
        } else {
#pragma unroll
            for (int i = 0; i < 4; ++i) stx4(X + (size_t)row * DM + lane * 4 + 256 * i, xv[i]);
        }
        if (mode == 1) rms_store(xv, gffn, H + (size_t)row * DM, lane);
    }
    if (mode == 2) {
        int nl = l, ng = grp + 1; if (ng == NGRP) { ng = 0; nl = l + 1; }
        if (nl < 2) {
            const Grp N = get_grp(ng); const float* gn = INP(I_GPREMIX) + nl * DM; bf16_t* Hn = (bf16_t*)(P.ws + R_H) - (size_t)N.g0 * DM;
            for (int row = N.g0 + gw; row < N.g0 + N.nrows; row += nw) {
                f32x4 xv[4];
#pragma unroll
                for (int i = 0; i < 4; ++i) xv[i] = ldx4(X + (size_t)row * DM + lane * 4 + 256 * i);
                rms_store(xv, gn, Hn + (size_t)row * DM, lane);
            }
        }
    }
}

__device__ __forceinline__ void phase0(const Params& P, unsigned char* smem) {
    float* tile = (float*)smem;
    constexpr int C0 = 2112, C1 = C0 + 144, C2 = C1 + 192, C3 = C2 + 192, C4 = C3 + 256, C5 = C4 + 256, C6 = C5 + 1408, C7 = C6 + 704;
    for (int id = blockIdx.x; id < 2 * C7; id += gridDim.x) {
        const int l = id / C7; int j = id - l * C7;
        const float* W; int N, ldd, koff = 0; bf16_t* dst;
        if (j < C0) { W = INP(I_WIN) + (size_t)l * DM * DIN; N = DIN; dst = (bf16_t*)(P.ws + W_IN) + (size_t)l * DIN * DM; ldd = DM; }
        else if (j < C1) { j -= C0; W = INP(I_WGLU) + (size_t)l * 768 * 768; N = 768; dst = (bf16_t*)(P.ws + W_GLU) + (size_t)l * 768 * 768; ldd = 768; }
        else if (j < C2) { j -= C1; W = INP(I_WBA) + (size_t)l * 768 * DM; N = DM; dst = (bf16_t*)(P.ws + W_BR) + (size_t)l * DM * LDY; ldd = LDY; }
        else if (j < C3) { j -= C2; W = INP(I_WBB) + (size_t)l * 768 * DM; N = DM; dst = (bf16_t*)(P.ws + W_BR) + (size_t)l * DM * LDY; ldd = LDY; koff = 768; }
        else if (j < C4) { j -= C3; W = INP(I_WBC) + (size_t)l * DM * DM; N = DM; dst = (bf16_t*)(P.ws + W_BR) + (size_t)l * DM * LDY; ldd = LDY; koff = 1536; }
        else if (j < C5) { j -= C4; W = INP(I_WOUT) + (size_t)l * DM * DM; N = DM; dst = (bf16_t*)(P.ws + W_OUT) + (size_t)l * DM * DM; ldd = DM; }
        else if (j < C6) { j -= C5; W = INP(I_WUP) + (size_t)l * DM * 2 * DFF; N = 2 * DFF; dst = (bf16_t*)(P.ws + W_UP) + (size_t)l * 2 * DFF * DM; ldd = DM; }
        else { j -= C6; W = INP(I_WDOWN) + (size_t)l * DFF * DM; N = DM; dst = (bf16_t*)(P.ws + W_DOWN) + (size_t)l * DM * DFF; ldd = DFF; }
        const int ntn = N / 64; const int tk = j / ntn, tn = j - tk * ntn;
        transpose_tile(W, N, dst, ldd, koff, tk, tn, tile);
    }
    norm_rows(P, 0, 0, 0, smem);
    float* rt = (float*)(P.ws + A_ROPE);
    for (int i = blockIdx.x * 512 + threadIdx.x; i < 2068 * 32; i += gridDim.x * 512) {
        const int pi = i >> 5, fi = i & 31; const double pos = pi < LP ? (double)pi : (double)(16384 + pi - LP);
        const double inv = exp(-(double)fi * (9.210340371976184 / 32.0));
        double ang = pos * inv; const double k = rint(ang * 0.15915494309189535); ang = ang - k * 6.283185307179586;
        const float af = (float)ang; rt[2 * i] = cosf(af); rt[2 * i + 1] = sinf(af);
    }
    if (blockIdx.x == 0 && threadIdx.x < 64) ((unsigned*)(P.ws + A_CTR))[threadIdx.x] = 0u;
}

__device__ __forceinline__ void ffn_conv_phase(const Params& P, int l, int grp, const unsigned char* smem) {
    const Grp G = get_grp(grp);
    const bf16_t* __restrict__ UP = (const bf16_t*)(P.ws + R_UP) - (size_t)G.g0 * (2 * DFF); bf16_t* __restrict__ FIN = (bf16_t*)(P.ws + R_FIN) - (size_t)G.g0 * DFF;
    const float* cw = INP(I_FCW) + (size_t)l * 3 * DFF; const float* cb = INP(I_FCB) + (size_t)l * DFF;
    const float* cache = INP(I_FFNC) + (size_t)l * DEC_B * 2 * DFF;
    constexpr int NCG = DFF / 8;
#pragma unroll 2
    for (int it = blockIdx.x * 512 + threadIdx.x; it < G.nrows * NCG; it += gridDim.x * 512) {
        const int rr = it / NCG, c = (it - rr * NCG) * 8, row = G.g0 + rr;
        int b, t, L; const bool isP = row < TPR;
        if (isP) { b = row / LP; t = row - b * LP; L = LP; } else { b = (row - TPR) >> 2; t = (row - TPR) & 3; L = 4; }
        float g0[8], g1[8], g2[8], uf[8];
        { const u32x4 v = *(const u32x4*)(UP + (size_t)row * (2 * DFF) + c);
#pragma unroll
          for (int i = 0; i < 4; ++i) { g0[2 * i] = __uint_as_float(v[i] << 16); g0[2 * i + 1] = __uint_as_float(v[i] & 0xffff0000u); } }
        { const u32x4 v = *(const u32x4*)(UP + (size_t)row * (2 * DFF) + DFF + c);
#pragma unroll
          for (int i = 0; i < 4; ++i) { uf[2 * i] = __uint_as_float(v[i] << 16); uf[2 * i + 1] = __uint_as_float(v[i] & 0xffff0000u); } }
        if (t >= 1) { const u32x4 v = *(const u32x4*)(UP + (size_t)(row - 1) * (2 * DFF) + c);
#pragma unroll
            for (int i = 0; i < 4; ++i) { g1[2 * i] = __uint_as_float(v[i] << 16); g1[2 * i + 1] = __uint_as_float(v[i] & 0xffff0000u); } }
        else {
#pragma unroll
            for (int i = 0; i < 8; ++i) g1[i] = isP ? 0.f : cache[((size_t)b * 2 + 1) * DFF + c + i]; }
        if (t >= 2) { const u32x4 v = *(const u32x4*)(UP + (size_t)(row - 2) * (2 * DFF) + c);
#pragma unroll
            for (int i = 0; i < 4; ++i) { g2[2 * i] = __uint_as_float(v[i] << 16); g2[2 * i + 1] = __uint_as_float(v[i] & 0xffff0000u); } }
        else {
#pragma unroll
            for (int i = 0; i < 8; ++i) g2[i] = isP ? 0.f : cache[((size_t)b * 2 + t) * DFF + c + i]; }
        float o[8];
#pragma unroll
        for (int i = 0; i < 8; ++i) { const float gc = cb[c + i] + cw[c + i] * g2[i] + cw[DFF + c + i] * g1[i] + cw[2 * DFF + c + i] * g0[i]; o[i] = gelu_t(gc) * uf[i]; }
        u32x4 ov; ov[0] = pk2(o[0], o[1]); ov[1] = pk2(o[2], o[3]); ov[2] = pk2(o[4], o[5]); ov[3] = pk2(o[6], o[7]);
        *(u32x4*)(FIN + (size_t)row * DFF + c) = ov;
        if (t >= L - 2 && (isP ? OUT_ON(7) : OUT_ON(13))) {
            float* dst = isP ? P.out + O_P_FFNC + (((size_t)l * NB + b) * 2 + (t - (L - 2))) * DFF + c : P.out + O_S_FFNC + (((size_t)l * DEC_B + b) * 2 + (t - (L - 2))) * DFF + c;
#pragma unroll
            for (int i = 0; i < 8; ++i) dst[i] = g0[i];
        }
    }
}

__device__ __forceinline__ float row16_sum(float v) {
    v += __builtin_bit_cast(float, __builtin_amdgcn_update_dpp(0, __builtin_bit_cast(int, v), 0xB1, 0xF, 0xF, true));
    v += __builtin_bit_cast(float, __builtin_amdgcn_update_dpp(0, __builtin_bit_cast(int, v), 0x4E, 0xF, 0xF, true));
    v += __builtin_bit_cast(float, __builtin_amdgcn_update_dpp(0, __builtin_bit_cast(int, v), 0x141, 0xF, 0xF, true));
    v += __builtin_bit_cast(float, __builtin_amdgcn_update_dpp(0, __builtin_bit_cast(int, v), 0x140, 0xF, 0xF, true));
    return v;
}
__device__ __forceinline__ void ret_job(const Params& P, int l, int grp, int b, int h, int g0, unsigned char* smem) {
    const int tid = otid(), w = __builtin_amdgcn_readfirstlane(tid >> 6), lane = tid & 63, fr = lane & 15, fq = lane >> 4;
    bf16_t* sQ = (bf16_t*)smem;
    bf16_t* sK = sQ + 128 * 72;
    bf16_t* sKdT = sK + 128 * 72;
    bf16_t* sVT = sKdT + 64 * 136;
    bf16_t* sST = sVT + 128 * 136;
    bf16_t* sP = sST + 128 * 72 + w * 16 * 136;
    const bf16_t* Z = (const bf16_t*)(P.ws + R_Z) - (size_t)g0 * DIN; bf16_t* Y = (bf16_t*)(P.ws + R_Y) - (size_t)g0 * LDY;
    const float* rope = (const float*)(P.ws + A_ROPE);
    const int L = grp ? 4 : LP, rowb = grp ? TPR + b * 4 : b * LP, tabb = grp ? LP : 0;
    const float lg = log1pf(-exp2f(-5.0f - (float)h));
    const float* ng = INP(I_RNG) + (size_t)l * 1024 + h * 128;
    float ngv[8];
#pragma unroll
    for (int et = 0; et < 8; ++et) ngv[et] = ng[16 * et + fr];
    f32x4 accS[4];
    float* Sout = P.out + (grp ? O_S_RET + (((size_t)l * DEC_B + b) * 8 + h) * 8192 : O_P_RET + (((size_t)l * NB + b) * 8 + h) * 8192);
    if (grp) { const float* S0 = INP(I_RET) + (((size_t)l * DEC_B + b) * 8 + h) * 8192;
#pragma unroll
        for (int dt = 0; dt < 4; ++dt)
#pragma unroll
            for (int j = 0; j < 4; ++j) accS[dt][j] = S0[(16 * dt + 4 * fq + j) * 128 + 16 * w + fr];
    } else {
#pragma unroll
        for (int dt = 0; dt < 4; ++dt) accS[dt] = (f32x4){0.f, 0.f, 0.f, 0.f};
    }
    __syncthreads();
#pragma unroll
    for (int dt = 0; dt < 4; ++dt) { u32x2 o; o.x = pk2(accS[dt][0], accS[dt][1]); o.y = pk2(accS[dt][2], accS[dt][3]); *(u32x2*)(sST + (16 * w + fr) * 72 + 16 * dt + 4 * fq) = o; }
    const int nch = grp ? 1 : 17;
    u32x4 q1 = {0u, 0u, 0u, 0u}, q2 = q1, k1 = q1, k2 = q1, vv[4];
#define RET_LOAD(ckx) do { const int _t0 = grp ? 0 : ((ckx) == 0 ? 0 : 16 + ((ckx) - 1) * 128), _C = grp ? 4 : ((ckx) == 0 ? 16 : 128); \
        const int _m = tid >> 2, _i0 = (tid & 3) * 8, _m2 = tid & 127, _e0 = (tid >> 7) * 32; \
        q1 = (u32x4){0u, 0u, 0u, 0u}; q2 = q1; k1 = q1; k2 = q1; \
        if (_m < _C) { const size_t _zr = (size_t)(rowb + _t0 + _m) * DIN; \
            q1 = *(const u32x4*)(Z + _zr + ZO_Q + h * 64 + _i0); q2 = *(const u32x4*)(Z + _zr + ZO_Q + h * 64 + 32 + _i0); \
            k1 = *(const u32x4*)(Z + _zr + ZO_K + h * 64 + _i0); k2 = *(const u32x4*)(Z + _zr + ZO_K + h * 64 + 32 + _i0); } \
        _Pragma("unroll") for (int _i = 0; _i < 4; ++_i) vv[_i] = (u32x4){0u, 0u, 0u, 0u}; \
        if (_m2 < _C) { const bf16_t* _vp = Z + (size_t)(rowb + _t0 + _m2) * DIN + ZO_V + h * 128 + _e0; \
            _Pragma("unroll") for (int _i = 0; _i < 4; ++_i) vv[_i] = *(const u32x4*)(_vp + 8 * _i); } } while (0)
    RET_LOAD(0);
    for (int ck = 0; ck < nch; ++ck) {
        const int t0 = grp ? 0 : (ck == 0 ? 0 : 16 + (ck - 1) * 128), C = grp ? 4 : (ck == 0 ? 16 : 128);
        {
            const int m = tid >> 2, i0 = (tid & 3) * 8;
            u32x4 q1w = {0u, 0u, 0u, 0u}, q2w = q1w, k1w = q1w, k2w = q1w;
            float kd1[8], kd2[8];
#pragma unroll
            for (int e = 0; e < 8; ++e) { kd1[e] = 0.f; kd2[e] = 0.f; }
            if (m < C) {
                const float* rp = rope + ((size_t)(tabb + t0 + m) * 32 + i0) * 2;
                const float kdec = __expf(lg * (float)(C - 1 - m));
                float qo1[8], qo2[8], ko1[8], ko2[8];
#pragma unroll
                for (int e = 0; e < 8; ++e) {
                    const float cs = rp[2 * e], sn = rp[2 * e + 1];
                    const unsigned qa = q1[e >> 1], qb = q2[e >> 1], ka = k1[e >> 1], kb = k2[e >> 1];
                    const float x1 = (e & 1) ? __uint_as_float(qa & 0xffff0000u) : __uint_as_float(qa << 16);
                    const float x2 = (e & 1) ? __uint_as_float(qb & 0xffff0000u) : __uint_as_float(qb << 16);
                    const float y1 = ((e & 1) ? __uint_as_float(ka & 0xffff0000u) : __uint_as_float(ka << 16)) * 0.125f;
                    const float y2 = ((e & 1) ? __uint_as_float(kb & 0xffff0000u) : __uint_as_float(kb << 16)) * 0.125f;
                    qo1[e] = x1 * cs - x2 * sn; qo2[e] = x2 * cs + x1 * sn;
                    ko1[e] = y1 * cs - y2 * sn; ko2[e] = y2 * cs + y1 * sn;
                    kd1[e] = ko1[e] * kdec; kd2[e] = ko2[e] * kdec;
                }
#pragma unroll
                for (int e = 0; e < 4; ++e) { q1w[e] = pk2(qo1[2 * e], qo1[2 * e + 1]); q2w[e] = pk2(qo2[2 * e], qo2[2 * e + 1]); k1w[e] = pk2(ko1[2 * e], ko1[2 * e + 1]); k2w[e] = pk2(ko2[2 * e], ko2[2 * e + 1]); }
            }
            *(u32x4*)(sQ + m * 72 + i0) = q1w; *(u32x4*)(sQ + m * 72 + 32 + i0) = q2w;
            *(u32x4*)(sK + m * 72 + i0) = k1w; *(u32x4*)(sK + m * 72 + 32 + i0) = k2w;
#pragma unroll
            for (int e = 0; e < 8; ++e) { sKdT[(i0 + e) * 136 + m] = f2bf(kd1[e]); sKdT[(32 + i0 + e) * 136 + m] = f2bf(kd2[e]); }
            const int m2 = tid & 127, e0 = (tid >> 7) * 32;
#pragma unroll
            for (int i = 0; i < 4; ++i)
#pragma unroll
                for (int e = 0; e < 4; ++e) { sVT[(e0 + 8 * i + 2 * e) * 136 + m2] = (bf16_t)(vv[i][e] & 0xffffu); sVT[(e0 + 8 * i + 2 * e + 1) * 136 + m2] = (bf16_t)(vv[i][e] >> 16); }
        }
        __syncthreads();
        if (ck + 1 < nch) RET_LOAD(ck + 1);
        f32x4 o[8];
        const bool act = (16 * w < C);
        unsigned gcp[4][4];
        if (act) {
#pragma unroll
            for (int j = 0; j < 4; ++j) { const int n = 16 * w + 4 * fq + j; const size_t row = (size_t)(rowb + t0 + (n < C ? n : 0));
#pragma unroll
                for (int e2 = 0; e2 < 4; ++e2) { const bf16_t lo = Z[row * DIN + ZO_GC + h * 128 + 32 * e2 + fr], hi = Z[row * DIN + ZO_GC + h * 128 + 32 * e2 + 16 + fr]; gcp[e2][j] = (unsigned)lo | ((unsigned)hi << 16); } }
        }
        if (act) {
            bf16x8 qf[2];
#pragma unroll
            for (int ks = 0; ks < 2; ++ks) qf[ks] = *(const bf16x8*)(sQ + (16 * w + fr) * 72 + 32 * ks + 8 * fq);
            const int mtN = (w | 1) + 1;
            for (int mt = 0; mt < mtN; ++mt) {
                f32x4 a = {0.f, 0.f, 0.f, 0.f};
#pragma unroll
                for (int ks = 0; ks < 2; ++ks) { const bf16x8 kf = *(const bf16x8*)(sK + (16 * mt + fr) * 72 + 32 * ks + 8 * fq); a = mfma16(qf[ks], kf, a); }
#pragma unroll
                for (int j = 0; j < 4; ++j) { const int d = (16 * w + 4 * fq + j) - (16 * mt + fr); const float v = d >= 0 ? a[j] * __expf(lg * (float)d) : 0.f; sP[(4 * fq + j) * 136 + 16 * mt + fr] = f2bf(v); }
            }
            lds_wait();
#pragma unroll
            for (int et = 0; et < 8; ++et) o[et] = (f32x4){0.f, 0.f, 0.f, 0.f};
            const int ksN = mtN >> 1;
            for (int ks = 0; ks < ksN; ++ks) {
                const bf16x8 pf = *(const bf16x8*)(sP + fr * 136 + 32 * ks + 8 * fq);
#pragma unroll
                for (int et = 0; et < 8; ++et) { const bf16x8 vf = *(const bf16x8*)(sVT + (16 * et + fr) * 136 + 32 * ks + 8 * fq); o[et] = mfma16(pf, vf, o[et]); }
            }
            f32x4 o2[8];
#pragma unroll
            for (int et = 0; et < 8; ++et) o2[et] = (f32x4){0.f, 0.f, 0.f, 0.f};
#pragma unroll
            for (int ks = 0; ks < 2; ++ks)
#pragma unroll
                for (int et = 0; et < 8; ++et) { const bf16x8 sf = *(const bf16x8*)(sST + (16 * et + fr) * 72 + 32 * ks + 8 * fq); o2[et] = mfma16(qf[ks], sf, o2[et]); }
#pragma unroll
            for (int j = 0; j < 4; ++j) { const float sc = __expf(lg * (float)(16 * w + 4 * fq + j + 1));
#pragma unroll
                for (int et = 0; et < 8; ++et) o[et][j] += o2[et][j] * sc; }
        }
        {
            const float gC = __expf(lg * (float)C);
#pragma unroll
            for (int dt = 0; dt < 4; ++dt) accS[dt] = accS[dt] * gC;
            const int ksN = (C + 31) >> 5;
            for (int ks = 0; ks < ksN; ++ks) {
                const bf16x8 vf = *(const bf16x8*)(sVT + (16 * w + fr) * 136 + 32 * ks + 8 * fq);
#pragma unroll
                for (int dt = 0; dt < 4; ++dt) { const bf16x8 kf = *(const bf16x8*)(sKdT + (16 * dt + fr) * 136 + 32 * ks + 8 * fq); accS[dt] = mfma16(kf, vf, accS[dt]); }
            }
        }
        __syncthreads();
#pragma unroll
        for (int dt = 0; dt < 4; ++dt) { u32x2 ow; ow.x = pk2(accS[dt][0], accS[dt][1]); ow.y = pk2(accS[dt][2], accS[dt][3]); *(u32x2*)(sST + (16 * w + fr) * 72 + 16 * dt + 4 * fq) = ow; }
        if (act) {
#pragma unroll
            for (int j = 0; j < 4; ++j) {
                float s = 0.f;
#pragma unroll
                for (int et = 0; et < 8; ++et) s += o[et][j];
                s = row16_sum(s);
                const float mu = s * (1.0f / 128.0f);
                float s2 = 0.f;
#pragma unroll
                for (int et = 0; et < 8; ++et) { const float d = o[et][j] - mu; s2 += d * d; }
                s2 = row16_sum(s2);
                const float rstd = rsqrtf(s2 * (1.0f / 128.0f) + EPS);
                const int n = 16 * w + 4 * fq + j;
                if (n < C) {
                    const size_t row = (size_t)(rowb + t0 + n);
#pragma unroll
                    for (int et = 0; et < 8; ++et) { const int e = 16 * et + fr; const unsigned gw_ = gcp[et >> 1][j]; const float gcv = (et & 1) ? __uint_as_float(gw_ & 0xffff0000u) : __uint_as_float(gw_ << 16);
                        const float yv = gcv * sigm(gcv) * (o[et][j] - mu) * rstd * ngv[et]; Y[row * LDY + 1536 + h * 128 + e] = f2bf(yv); }
                }
            }
        }
    }
    if (grp ? OUT_ON(12) : OUT_ON(6)) {
#pragma unroll
    for (int dt = 0; dt < 4; ++dt)
#pragma unroll
        for (int j = 0; j < 4; ++j) Sout[(16 * dt + 4 * fq + j) * 128 + 16 * w + fr] = accS[dt][j];
    }
}

__device__ __forceinline__ void lru_job(const Params& P, int l, int grp, int jid, int g0, int pb0, unsigned char* smem) {
    const int tid = otid(), w = __builtin_amdgcn_readfirstlane(tid >> 6), lane = tid & 63, fr = lane & 15, fq = lane >> 4;
    bf16_t* sA = (bf16_t*)(smem + w * 10752);
    float* sRI = (float*)(smem + w * 10752 + 2304);
    float* sComb = (float*)(smem + 8 * 10752);
    const bf16_t* Z = (const bf16_t*)(P.ws + R_Z) - (size_t)g0 * DIN; bf16_t* Y = (bf16_t*)(P.ws + R_Y) - (size_t)g0 * LDY;
    const int unit = grp ? jid * 8 + w : jid;
    const int bl = unit / 12, hb = unit - bl * 12, ch = hb * 64 + lane; const int b = grp ? bl : pb0 + bl;
    const int L = grp ? 4 : LP, rowb = grp ? TPR + b * 4 : b * LP;
    float cw[4];
#pragma unroll
    for (int j = 0; j < 4; ++j) cw[j] = INP(I_LCW)[((size_t)l * 4 + j) * 768 + ch];
    const float cb = INP(I_LCB)[l * 768 + ch], ba = INP(I_LBA)[l * 768 + ch], bx = INP(I_LBX)[l * 768 + ch];
    const float lam = INP(I_LAM)[l * 768 + ch];
    const float sp8 = 8.0f * (fmaxf(-lam, 0.f) + log1pf(__expf(-fabsf(lam))));
    bf16x8 Wa[4][2], Wx[4][2];
    { const float* wa = INP(I_LWA) + ((size_t)l * 12 + hb) * 4096; const float* wx = INP(I_LWX) + ((size_t)l * 12 + hb) * 4096;
#pragma unroll
      for (int nt = 0; nt < 4; ++nt)
#pragma unroll
          for (int ks = 0; ks < 2; ++ks)
#pragma unroll
              for (int j = 0; j < 8; ++j) { const int k = 32 * ks + 8 * fq + j, n = 16 * nt + fr; Wa[nt][ks][j] = (short)f2bf(wa[k * 64 + n]); Wx[nt][ks][j] = (short)f2bf(wx[k * 64 + n]); } }
    float carry = grp ? INP(I_LRUH)[((size_t)l * DEC_B + b) * 768 + ch] : 0.f;
    const float* cache = INP(I_LRUC) + ((size_t)l * DEC_B + b) * 3 * 768;
    const int nIter = grp ? 1 : 17;
    __syncthreads();
#ifndef LRU_REP
#define LRU_REP 1
#endif
    bf16_t xn[19];
    { const int tw0 = grp ? 0 : 16 * w;
#pragma unroll
      for (int i = 0; i < 19; ++i) { int t = tw0 - 3 + i; t = t < 0 ? 0 : (t > L - 1 ? L - 1 : t); xn[i] = Z[(size_t)(rowb + t) * DIN + ZO_XB + ch]; } }
    for (int it_ = 0; it_ < nIter * (grp ? 1 : LRU_REP); ++it_) {
        const int it = it_ % nIter; if (LRU_REP > 1 && it_ == nIter) carry = 0.f;
        const int tw = grp ? 0 : it * 128 + 16 * w;
        float xv[19];
#pragma unroll
        for (int i = 0; i < 19; ++i) { const int t = tw - 3 + i; xv[i] = (t >= 0 && t < L) ? bf2f(xn[i]) : 0.f; }
        if (grp) {
#pragma unroll
            for (int i = 0; i < 3; ++i) xv[i] = cache[i * 768 + ch];
        }
        if (it_ + 1 < nIter * (grp ? 1 : LRU_REP)) {
            const int twn = tw + 128;
#pragma unroll
            for (int i = 0; i < 19; ++i) { int t = twn - 3 + i; t = t < 0 ? 0 : (t > L - 1 ? L - 1 : t); xn[i] = Z[(size_t)(rowb + t) * DIN + ZO_XB + ch]; }
        }
        unsigned gtp[8];
#pragma unroll
        for (int i = 0; i < 8; ++i) { const int ta = tw + 2 * i, tb = ta + 1;
            const bf16_t lo = Z[(size_t)(rowb + (ta < L ? ta : L - 1)) * DIN + ZO_GB + ch], hi = Z[(size_t)(rowb + (tb < L ? tb : L - 1)) * DIN + ZO_GB + ch];
            gtp[i] = (unsigned)lo | ((unsigned)hi << 16); }
        float xc[16];
#pragma unroll
        for (int i = 0; i < 16; ++i) { xc[i] = cb + cw[0] * xv[i] + cw[1] * xv[i + 1] + cw[2] * xv[i + 2] + cw[3] * xv[i + 3]; sA[i * 72 + lane] = f2bf(xc[i]); }
        lds_wait();
        bf16x8 af[2];
#pragma unroll
        for (int ks = 0; ks < 2; ++ks) af[ks] = *(const bf16x8*)(sA + fr * 72 + 32 * ks + 8 * fq);
#pragma unroll
        for (int nt = 0; nt < 4; ++nt) {
            f32x4 ra = {0.f, 0.f, 0.f, 0.f}, rx = ra;
            ra = mfma16(af[0], Wa[nt][0], ra); ra = mfma16(af[1], Wa[nt][1], ra);
            rx = mfma16(af[0], Wx[nt][0], rx); rx = mfma16(af[1], Wx[nt][1], rx);
#pragma unroll
            for (int j = 0; j < 4; ++j) { sRI[(4 * fq + j) * 132 + 16 * nt + fr] = ra[j]; sRI[(4 * fq + j) * 132 + 64 + 16 * nt + fr] = rx[j]; }
        }
        lds_wait();
        float hloc[16], ca[16]; float hl = 0.f, cacc = 1.f;
#pragma unroll
        for (int i = 0; i < 16; ++i) {
            const float rp = sRI[i * 132 + lane], ip = sRI[i * 132 + 64 + lane];
            const float r = sigm(rp + ba), ii = sigm(ip + bx);
            const float la = -sp8 * r; float a = __expf(la);
            const float x2 = 2.0f * la;
            const float ser = -x2 * (1.0f + x2 * (0.5f + x2 * (0.16666667f + x2 * (0.041666668f + x2 * 0.0083333338f))));
            const float om = x2 > -0.25f ? ser : 1.0f - __expf(x2);
            float bv = __builtin_amdgcn_sqrtf(om) * ii * xc[i];
            if (tw + i >= L) { a = 1.f; bv = 0.f; }
            hl = a * hl + bv; cacc *= a; hloc[i] = hl; ca[i] = cacc;
        }
        float hin = carry;
        if (!grp) {
            float* sCb = sComb + (it_ & 1) * 1024;
            sCb[(w * 64 + lane) * 2] = cacc; sCb[(w * 64 + lane) * 2 + 1] = hl;
            __syncthreads();
            float run = carry;
#pragma unroll
            for (int ww = 0; ww < 8; ++ww) { if (ww == w) hin = run; run = sCb[(ww * 64 + lane) * 2] * run + sCb[(ww * 64 + lane) * 2 + 1]; }
            carry = run;
        } else carry = hloc[15] + ca[15] * hin;
#pragma unroll
        for (int i = 0; i < 16; ++i) { const int t = tw + i;
            if (t < L) { const size_t row = (size_t)(rowb + t); const float hh = hloc[i] + ca[i] * hin; const unsigned gw_ = gtp[i >> 1]; const float gt = (i & 1) ? __uint_as_float(gw_ & 0xffff0000u) : __uint_as_float(gw_ << 16); Y[row * LDY + 768 + ch] = f2bf(hh * gelu_t(gt)); } }
    }
    if (grp || w == 0) {
        float* ho = grp ? P.out + O_S_LRUH + ((size_t)l * DEC_B + b) * 768 + ch : P.out + O_P_LRUH + ((size_t)l * NB + b) * 768 + ch;
        if (grp ? OUT_ON(10) : OUT_ON(4)) *ho = carry;
        float* co = grp ? P.out + O_S_LRUC + ((size_t)l * DEC_B + b) * 3 * 768 + ch : P.out + O_P_LRUC + ((size_t)l * NB + b) * 3 * 768 + ch;
#pragma unroll
        for (int j = 0; j < 3; ++j) if (grp ? OUT_ON(11) : OUT_ON(5)) co[j * 768] = bf2f(Z[(size_t)(rowb + L - 3 + j) * DIN + ZO_XB + ch]);
    }
}

template <bool FULL>
__device__ __forceinline__ void s5_run(const bf16_t* Z, bf16_t* ZS, float* sBU, bf16_t* sH, const bf16x8 (&Bf)[8], const bf16x8 (&Cf)[4], float abr, float abi, float dsk,
                                       int rowb, int g, int L, int it0, int it1, float& hr, float& hi, int lane, int fr, int fq) {
    u32x4 ufn = {0u, 0u, 0u, 0u}; bf16_t udn[4] = {0, 0, 0, 0};
    { const int t1 = it0 * 16; const int v1 = (L - t1) < 16 ? (L - t1) : 16;
      if (fq < 2 && fr < v1) ufn = *(const u32x4*)(Z + (size_t)(rowb + t1 + fr) * DIN + ZO_UA + g * 16 + 8 * fq);
      if (FULL) {
#pragma unroll
          for (int j = 0; j < 4; ++j) if (4 * fq + j < v1) udn[j] = Z[(size_t)(rowb + t1 + 4 * fq + j) * DIN + ZO_UA + g * 16 + fr]; } }
    for (int it = it0; it < it1; ++it) {
        const int t0 = it * 16; const int valid = (L - t0) < 16 ? (L - t0) : 16;
        const bf16x8 uf = __builtin_bit_cast(bf16x8, ufn);
        bf16_t ud[4];
#pragma unroll
        for (int j = 0; j < 4; ++j) ud[j] = udn[j];
        if (it + 1 < it1) { const int t1 = t0 + 16; const int v1 = (L - t1) < 16 ? (L - t1) : 16;
            ufn = (u32x4){0u, 0u, 0u, 0u};
            if (fq < 2 && fr < v1) ufn = *(const u32x4*)(Z + (size_t)(rowb + t1 + fr) * DIN + ZO_UA + g * 16 + 8 * fq);
            if (FULL) {
#pragma unroll
                for (int j = 0; j < 4; ++j) { udn[j] = 0; if (4 * fq + j < v1) udn[j] = Z[(size_t)(rowb + t1 + 4 * fq + j) * DIN + ZO_UA + g * 16 + fr]; } } }
#pragma unroll
        for (int nt = 0; nt < 8; ++nt) { f32x4 a = {0.f, 0.f, 0.f, 0.f}; a = mfma16(uf, Bf[nt], a);
#pragma unroll
            for (int j = 0; j < 4; ++j) sBU[(4 * fq + j) * 132 + 16 * nt + fr] = a[j]; }
        lds_wait();
#pragma unroll
        for (int i = 0; i < 16; ++i) {
            float bur = sBU[i * 132 + lane], bui = sBU[i * 132 + 64 + lane];
            asm volatile("" : "+v"(bur), "+v"(bui));
            const float msk = (i < valid) ? 1.0f : 0.0f;
            float nr = __builtin_fmaf(abr, hr, bur); asm volatile("" : "+v"(nr));
            nr = __builtin_fmaf(-abi, hi, nr); asm volatile("" : "+v"(nr));
            float ni = __builtin_fmaf(abr, hi, bui); asm volatile("" : "+v"(ni));
            ni = __builtin_fmaf(abi, hr, ni); asm volatile("" : "+v"(ni));
            hr = __builtin_fmaf(msk, nr - hr, hr); hi = __builtin_fmaf(msk, ni - hi, hi);
            asm volatile("" : "+v"(hr), "+v"(hi));
            if (FULL) { sH[i * 136 + lane] = f2bf(hr); sH[i * 136 + 64 + lane] = f2bf(hi); }
        }
        lds_wait();
        if (FULL) {
            f32x4 y = {0.f, 0.f, 0.f, 0.f};
#pragma unroll
            for (int ks = 0; ks < 4; ++ks) { const bf16x8 hf = *(const bf16x8*)(sH + fr * 136 + 32 * ks + 8 * fq); y = mfma16(hf, Cf[ks], y); }
#pragma unroll
            for (int j = 0; j < 4; ++j) { const int t = 4 * fq + j;
                if (t < valid) { const size_t row = (size_t)(rowb + t0 + t); const float u = bf2f(ud[j]); ZS[row * 768 + g * 16 + fr] = f2bf(gelu_t(y[j] + dsk * u)); } }
            lds_wait();
        }
    }
}
__device__ __forceinline__ void cmul(float& ar, float& ai, float br, float bi) { const float r = ar * br - ai * bi, i = ar * bi + ai * br; ar = r; ai = i; }

__device__ __forceinline__ void s5_job(const Params& P, int l, int grp, int jid, int g0, int pb0, unsigned* s5done, unsigned char* smem) {
    const int tid = otid(), w = __builtin_amdgcn_readfirstlane(tid >> 6), lane = tid & 63, fr = lane & 15, fq = lane >> 4;
    float* sBU = (float*)(smem + w * 12800);
    bf16_t* sH = (bf16_t*)(smem + w * 12800 + 8448);
    float* sC = (float*)(smem + 8 * 12800);
    const bf16_t* Z = (const bf16_t*)(P.ws + R_Z) - (size_t)g0 * DIN; bf16_t* ZS = (bf16_t*)(P.ws + R_ZS5) - (size_t)g0 * 768;
    int g, b0;
    if (grp) { const int unit = jid * 8 + w; g = unit % 48; b0 = (unit / 48) * 16; } else { b0 = jid / 48; g = jid - b0 * 48; b0 += pb0; }
    const float dt = __expf(INP(I_LS)[l * 48 + g]);
    float abr = 0.f, abi = 0.f;
    bf16x8 Bf[8];
#pragma unroll
    for (int k = 0; k < 4; ++k) {
        const int p = 16 * k + fr;
        const float lr = INP(I_AR)[((size_t)l * 48 + g) * 64 + p], li = INP(I_AI)[((size_t)l * 48 + g) * 64 + p];
        const float mag = expf(lr * dt), ar_ = mag * cosf(li * dt), ai_ = mag * sinf(li * dt);
        if (k == fq) { abr = ar_; abi = ai_; }
        const float den = lr * lr + li * li, nr = ar_ - 1.0f;
        const float cr = (nr * lr + ai_ * li) / den, ci = (ai_ * lr - nr * li) / den;
        bf16x8 fre, fim;
#pragma unroll
        for (int j = 0; j < 8; ++j) { fre[j] = 0; fim[j] = 0; }
        if (fq < 2) {
            const float* bre = INP(I_BR) + (((size_t)l * 48 + g) * 64 + p) * 16 + 8 * fq; const float* bim = INP(I_BI) + (((size_t)l * 48 + g) * 64 + p) * 16 + 8 * fq;
#pragma unroll
            for (int j = 0; j < 8; ++j) { const float br_ = bre[j], bi_ = bim[j]; fre[j] = (short)f2bf(cr * br_ - ci * bi_); fim[j] = (short)f2bf(cr * bi_ + ci * br_); }
        }
        Bf[k] = fre; Bf[4 + k] = fim;
    }
    bf16x8 Cf[4];
#pragma unroll
    for (int ks = 0; ks < 4; ++ks) {
        const float* cp = (ks < 2 ? INP(I_CR) : INP(I_CI)) + (((size_t)l * 48 + g) * 16 + fr) * 64 + 32 * (ks & 1) + 8 * fq;
        const float sg = ks < 2 ? 1.0f : -1.0f;
#pragma unroll
        for (int j = 0; j < 8; ++j) Cf[ks][j] = (short)f2bf(sg * cp[j]);
    }
    const float dsk = INP(I_D)[l * 768 + g * 16 + fr];
    __syncthreads();
    if (grp) {
        for (int s = 0; s < 16; ++s) {
            const int b = b0 + s; const int rowb = TPR + b * 4;
            float hr = INP(I_S5RE)[(((size_t)l * DEC_B + b) * 48 + g) * 64 + lane], hi = INP(I_S5IM)[(((size_t)l * DEC_B + b) * 48 + g) * 64 + lane];
            s5_run<true>(Z, ZS, sBU, sH, Bf, Cf, abr, abi, dsk, rowb, g, 4, 0, 1, hr, hi, lane, fr, fq);
            P.out[O_S_S5RE + (((size_t)l * DEC_B + b) * 48 + g) * 64 + lane] = hr;
            P.out[O_S_S5IM + (((size_t)l * DEC_B + b) * 48 + g) * 64 + lane] = hi;
        }
    } else {
        const int b = b0, rowb = b * LP;
        const int it0 = w == 0 ? 0 : 17 + 16 * (w - 1), it1 = 17 + 16 * w;
        float hr = 0.f, hi = 0.f;
        s5_run<false>(Z, ZS, sBU, sH, Bf, Cf, abr, abi, dsk, rowb, g, LP, it0, it1, hr, hi, lane, fr, fq);
        sC[(w * 64 + lane) * 2] = hr; sC[(w * 64 + lane) * 2 + 1] = hi;
        float pr = abr, pi = abi, p16r = 0.f, p16i = 0.f;
#pragma unroll
        for (int q = 0; q < 8; ++q) { cmul(pr, pi, pr, pi); if (q == 3) { p16r = pr; p16i = pi; } }
        float qr = pr, qi = pi; cmul(qr, qi, p16r, p16i);
        __syncthreads();
        float cr_ = 0.f, ci_ = 0.f;
        for (int ww = 0; ww < w; ++ww) {
            const float ar2 = ww == 0 ? qr : pr, ai2 = ww == 0 ? qi : pi;
            cmul(cr_, ci_, ar2, ai2);
            cr_ += sC[(ww * 64 + lane) * 2]; ci_ += sC[(ww * 64 + lane) * 2 + 1];
        }
        hr = cr_; hi = ci_;
        s5_run<true>(Z, ZS, sBU, sH, Bf, Cf, abr, abi, dsk, rowb, g, LP, it0, it1, hr, hi, lane, fr, fq);
        if (w == 7) {
            P.out[O_P_S5RE + (((size_t)l * NB + b) * 48 + g) * 64 + lane] = hr;
            P.out[O_P_S5IM + (((size_t)l * NB + b) * 48 + g) * 64 + lane] = hi;
        }
    }
    asm volatile("s_waitcnt vmcnt(0)" ::: "memory");
    __syncthreads();
    if (threadIdx.x == 0) { __threadfence(); atomicAdd(s5done, 1u); }
}

__device__ __forceinline__ void mixers_phase(const Params& P, int l, int rg, unsigned char* smem, int rep) {
    const Grp G = get_grp(rg);
    const int j1 = G.npb * 8, j2 = j1 + G.npb * 12, j3 = j2 + G.npb * 48, j4 = j3 + (G.hasS ? 1024 : 0), j5 = j4 + (G.hasS ? 48 : 0), j6 = j5 + (G.hasS ? 192 : 0), j7 = j6 + G.npan * 12, NJ = j7 + G.npan * 3;
    unsigned* s5done = (unsigned*)(P.ws + A_CTR) + 32 + (l * NGRP + rg) + rep * 16;
    const unsigned s5total = (unsigned)(G.npb * 48 + (G.hasS ? 48 : 0));
    unsigned* ctr = (unsigned*)(P.ws + A_CTR) + (l * NGRP + rg) + rep * 16;
    int* slot = (int*)(smem + LDS_BYTES - 16);
#ifndef STATIC_JOBS
#define STATIC_JOBS 0
#endif
    for (int jj = blockIdx.x;; jj += gridDim.x) {
        __syncthreads();
#if STATIC_JOBS
        const int j = jj; (void)ctr; (void)slot;
#else
        if (threadIdx.x == 0) *slot = (int)atomicAdd(ctr, 1u);
        __syncthreads();
        const int j = *slot;
#endif
        if (j >= NJ) break;
        int type, sg, idx;
        if (j < j1) { type = 0; sg = 0; idx = j; }
        else if (j < j2) { type = 1; sg = 0; idx = j - j1; }
        else if (j < j3) { type = 2; sg = 0; idx = j - j2; }
        else if (j < j4) { type = 0; sg = 1; idx = j - j3; }
        else if (j < j5) { type = 2; sg = 1; idx = j - j4; }
        else if (j < j6) { type = 1; sg = 1; idx = j - j5; }
        else if (j < j7) { type = 4; sg = 0; idx = j - j6; }
        else { type = 3; sg = 0; idx = j - j7; }
        if (type == 4) {
            using namespace pg8;
            Gemm gg{(const bf16_t*)(P.ws + R_H), (const bf16_t*)(P.ws + W_IN) + (size_t)l * DIN * DM, DM, DM, G.npan, DIN / 256, DM / 64, nullptr};
            SchedOne S1{idx / 12, 21 + idx % 12, DM / 64};
            EpiBf E{(bf16_t*)(P.ws + R_Z), DIN, (bf16_t*)(P.ws + R_Z)};
            gemm_run((LAS unsigned char*)smem, gg, S1, E);
            continue;
        }
        if (type == 3) {
            if (threadIdx.x == 0) {
                unsigned sp = 0;
                while (__hip_atomic_load(s5done, __ATOMIC_RELAXED, __HIP_MEMORY_SCOPE_AGENT) < s5total) { __builtin_amdgcn_s_sleep(8); if (++sp > (1u << 22)) break; }
                __threadfence();
                asm volatile("s_waitcnt vmcnt(0)" ::: "memory");
            }
            __syncthreads();
            using namespace pg8;
            Gemm gg{(const bf16_t*)(P.ws + R_ZS5), (const bf16_t*)(P.ws + W_GLU) + (size_t)l * 768 * 768, 768, 768, G.npan, 3, 12, nullptr};
            SchedOne S1{idx / 3, idx % 3, 12};
            EpiGlu E{(bf16_t*)(P.ws + R_Y), (const bf16_t*)(P.ws + R_ZS5), INP(I_BGLU) + l * 768};
            gemm_run((LAS unsigned char*)smem, gg, S1, E);
            continue;
        }
        if (type == 0) ret_job(P, l, sg, (idx >> 3) + (sg ? 0 : G.pb0), idx & 7, G.g0, smem);
        else if (type == 1) lru_job(P, l, sg, idx, G.g0, G.pb0, smem);
        else s5_job(P, l, sg, idx, G.g0, G.pb0, s5done, smem);
    }
}

__device__ __forceinline__ void run_phase(const Params& P, int ph, unsigned char* smem, int rep) {
#ifndef PHSEL
#define PHSEL -1
#endif
#define PSEL(x) (PHSEL < 0 || PHSEL == (x))
    if (ph == 0) { if (PSEL(10)) phase0(P, smem); return; }
    const int l = (ph - 1) / (10 * NGRP), rg = ((ph - 1) / 10) % NGRP, s = (ph - 1) % 10;
    LAS unsigned char* lds = (LAS unsigned char*)smem;
    unsigned char* ws = P.ws;
    using namespace pg8;
    const int G = gridDim.x, c = blockIdx.x;
    const int npan = rg < 2 ? 25 : 19;
    switch (s) {
    case 0: if (PSEL(0)) { Gemm g{(const bf16_t*)(ws + R_H), (const bf16_t*)(ws + W_IN) + (size_t)l * DIN * DM, DM, DM, npan, 21, DM / 64, nullptr};
              Sched<1> S; S.init(g.nM, g.nN, G, c, g.nt); EpiBf E{(bf16_t*)(ws + R_Z), DIN, (bf16_t*)(ws + R_Z)}; gemm_run(lds, g, S, E); } break;
    case 1: if (PSEL(1)) mixers_phase(P, l, rg, smem, rep); break;
    case 2: if (PSEL(2)) { Gemm g{(const bf16_t*)(ws + R_ZS5), (const bf16_t*)(ws + W_GLU) + (size_t)l * 768 * 768, 768, 768, npan, 3, 12, nullptr};
              Sched<1> S; S.init(g.nM, g.nN, G, c, g.nt); EpiGlu E{(bf16_t*)(ws + R_Y), (const bf16_t*)(ws + R_ZS5), INP(I_BGLU) + l * 768}; gemm_run(lds, g, S, E); } break;
    case 3: if (PSEL(3)) { Gemm g{(const bf16_t*)(ws + R_Y), (const bf16_t*)(ws + W_BR) + (size_t)l * DM * LDY, LDY, LDY, npan, 4, 0, nullptr};
              SchedBr2 S; S.init(g.nM, g.nN, G, c); EpiBranch E{(const bf16_t*)(ws + R_Z) + ZO_GATE, (bf16_t*)(ws + R_M), (bf16_t*)(ws + R_M2)}; gemm_run(lds, g, S, E); } break;
    case 4: if (PSEL(4)) { Gemm g{(const bf16_t*)(ws + R_M), (const bf16_t*)(ws + W_OUT) + (size_t)l * DM * DM, DM, DM, npan, 4, 16, (const bf16_t*)(ws + R_M2)};
              Sched<2> S; S.init(g.nM, g.nN, G, c, g.nt); S.fullk = 1;     EpiBf E{(bf16_t*)(ws + R_F), DM, (bf16_t*)(ws + R_UP)}; gemm_run(lds, g, S, E); } break;
    case 5: if (PSEL(5) && rep == 0) norm_rows(P, 1, l, rg, smem); break;
    case 6: if (PSEL(6)) { Gemm g{(const bf16_t*)(ws + R_H), (const bf16_t*)(ws + W_UP) + (size_t)l * 2 * DFF * DM, DM, DM, npan, 22, 16, nullptr};
              Sched<1> S; S.init(g.nM, g.nN, G, c, g.nt); EpiBf E{(bf16_t*)(ws + R_UP), 2 * DFF, (bf16_t*)(ws + R_UP)}; gemm_run(lds, g, S, E); } break;
    case 7: if (PSEL(7)) ffn_conv_phase(P, l, rg, smem); break;
    case 8: if (PSEL(8)) { Gemm g{(const bf16_t*)(ws + R_FIN), (const bf16_t*)(ws + W_DOWN) + (size_t)l * DM * DFF, DFF, DFF, npan, 4, 44, nullptr};
              Sched<2> S; S.init(g.nM, g.nN, G, c, g.nt); EpiBf E{(bf16_t*)(ws + R_F), DM, (bf16_t*)(ws + R_UP)}; gemm_run(lds, g, S, E); } break;
    default: if (PSEL(9) && rep == 0) norm_rows(P, 2, l, rg, smem); break;
    }
}

#define XB_TMO      128
#define XB_XCNT(j)  (256  + 64 * (j))
#define XB_XSUB(j)  (1280 + 64 * (j))
#define XB_XGEN(j)  (2304 + 64 * (j))
#define XB_TOP      3328
#define XB_TOPGEN   3392
#define XCD_BAR_WORDS 3456
#define XB_SPIN_CAP (1u << 18)

__device__ __forceinline__ unsigned xb_ld(unsigned* p)              { return __hip_atomic_load(p, __ATOMIC_RELAXED, __HIP_MEMORY_SCOPE_AGENT); }
__device__ __forceinline__ unsigned xb_add(unsigned* p, unsigned v) { return __hip_atomic_fetch_add(p, v, __ATOMIC_RELAXED, __HIP_MEMORY_SCOPE_AGENT); }
__device__ __forceinline__ unsigned xb_xcc_id() { return (unsigned)__builtin_amdgcn_s_getreg((3 << 11) | 20) & 0xFu; }
#define XB_SPIN(cond, bar) do { unsigned _sp = 0; while (cond) { __builtin_amdgcn_s_sleep(1); \
    if ((++_sp & 255u) == 0u) { if (xb_ld(&(bar)[XB_TMO])) break; if (_sp > XB_SPIN_CAP) { atomicAdd(&(bar)[XB_TMO], 1u); break; } } } } while (0)

struct XcdBarrier {
    unsigned* bar; unsigned x;
    volatile LAS unsigned* st;
};

__device__ __forceinline__ XcdBarrier xcd_barrier_post(unsigned* bar, volatile LAS unsigned* st) {
    XcdBarrier b; b.bar = bar; b.x = xb_xcc_id(); b.st = st;
    if (threadIdx.x == 0) (void)xb_add(&bar[XB_XCNT(b.x)], 1u);
    return b;
}
__device__ __forceinline__ void xcd_barrier_complete(unsigned* bar, unsigned x, unsigned& nloc, unsigned& nx) {
    const unsigned G = gridDim.x * gridDim.y * gridDim.z;
    unsigned sum, cnt, mine, sp = 0u;
    for (;;) {
        sum = 0u; cnt = 0u; mine = 0u;
#pragma unroll
        for (unsigned j = 0; j < 16; ++j) { const unsigned c = xb_ld(&bar[XB_XCNT(j)]); sum += c; cnt += (c > 0u) ? 1u : 0u; mine = (j == x) ? c : mine; }
        if (sum == G) break;
        __builtin_amdgcn_s_sleep(1);
        if ((++sp & 255u) == 0u) { if (xb_ld(&bar[XB_TMO])) break; if (sp > XB_SPIN_CAP) { atomicAdd(&bar[XB_TMO], 1u); break; } }
    }
    nloc = mine > 0u ? mine : 1u; nx = cnt > 0u ? cnt : 1u;
}

__device__ __forceinline__ void xcd_barrier(const XcdBarrier& b) {
    asm volatile("s_waitcnt vmcnt(0)" ::: "memory");
    __syncthreads();
    if (threadIdx.x == 0) {
        unsigned* bar = b.bar;
        __builtin_amdgcn_s_waitcnt(0);
        unsigned nloc = b.st[0], nx = b.st[1];
        if (nloc == 0u) { xcd_barrier_complete(bar, b.x, nloc, nx); b.st[0] = nloc; b.st[1] = nx; }
        const unsigned old = xb_add(&bar[XB_XSUB(b.x)], 1u);
        const unsigned gen = old / nloc;
        if (old + 1u == (gen + 1u) * nloc) {
            __builtin_amdgcn_fence(__ATOMIC_RELEASE, "agent");
            asm volatile("s_waitcnt vmcnt(0)" ::: "memory");
            const unsigned og = xb_add(&bar[XB_TOP], 1u);
            const unsigned tg = og / nx;
            if (og + 1u == (tg + 1u) * nx) xb_add(&bar[XB_TOPGEN], 1u);
            else XB_SPIN(xb_ld(&bar[XB_TOPGEN]) == tg, bar);
            __builtin_amdgcn_fence(__ATOMIC_ACQUIRE, "agent");
            xb_add(&bar[XB_XGEN(b.x)], 1u);
            asm volatile("s_waitcnt vmcnt(0)" ::: "memory");
        } else {
            XB_SPIN(xb_ld(&bar[XB_XGEN(b.x)]) == gen, bar);
            __builtin_amdgcn_fence(__ATOMIC_ACQUIRE, "agent");
            asm volatile("s_waitcnt vmcnt(0)" ::: "memory");
        }
    }
    __syncthreads();
}


__global__ void __launch_bounds__(512, 2) mega(Params P, int ph_lo, int ph_hi) {
    extern __shared__ __attribute__((aligned(16))) unsigned char smem[];
    unsigned* xst = (unsigned*)(smem + LDS_BYTES - 32);
    if (threadIdx.x == 0) {
        const float** tab = (const float**)(smem + PTAB_OFF);
#pragma unroll
        for (int i = 0; i < N_IN; ++i) tab[i] = P.in[i];
        xst[0] = 0u; xst[1] = 0u;
    }
    __syncthreads();
    XcdBarrier xb = xcd_barrier_post((unsigned*)(P.ws + A_BAR), (volatile LAS unsigned*)xst);
#ifndef DUP_MASK
#define DUP_MASK 0x400
#endif
    for (int ph = ph_lo; ph < ph_hi; ++ph) {
        if (ph > 0 && (ph - 1) % 10 == 2) continue;
        int nrep = 1;
        if (DUP_MASK) { const int sidx = ph == 0 ? 10 : (ph - 1) % 10; if ((DUP_MASK >> sidx) & 1) nrep = 2; }
        for (int rep = 0; rep < nrep; ++rep) {
            run_phase(P, ph, smem, rep);
            if (ph + 1 < ph_hi || rep + 1 < nrep) xcd_barrier(xb);
        }
    }
}


#ifndef DBG_STOP
#define DBG_STOP 0
#endif
#ifndef DBG_OFF
#define DBG_OFF R_Z
#endif
__global__ void dbg_dump(const unsigned char* ws, float* out, size_t n) {
    const bf16_t* src = (const bf16_t*)(ws + DBG_OFF);
    for (size_t i = (size_t)blockIdx.x * blockDim.x + threadIdx.x; i < n; i += (size_t)gridDim.x * blockDim.x) out[i] = bf2f(src[i]);
}

extern "C" void kernel_launch(void* const* d_in, const int* in_sizes, int n_in, void* d_out, int out_size, void* d_ws, size_t ws_size, hipStream_t stream) {
    (void)in_sizes; (void)n_in; (void)out_size;
    if (ws_size < WS_TOTAL) { fprintf(stderr, "workspace too small: %zu < %zu\n", ws_size, (size_t)WS_TOTAL); return; }
    Params p{};
    for (int i = 0; i < N_IN; ++i) p.in[i] = (const float*)d_in[i];
    p.out = (float*)d_out; p.ws = (unsigned char*)d_ws;
    hipFuncSetAttribute((const void*)mega, hipFuncAttributeMaxDynamicSharedMemorySize, LDS_BYTES);
    int dev = 0, cus = 256, per_cu = 1;
    hipGetDevice(&dev);
    hipDeviceGetAttribute(&cus, hipDeviceAttributeMultiprocessorCount, dev);
    hipOccupancyMaxActiveBlocksPerMultiprocessor(&per_cu, mega, 512, LDS_BYTES);
    if (per_cu < 1) per_cu = 1;
    const int grid = cus * 1;
#if COOP
#ifndef PH_HI
#define PH_HI NPHASE
#endif
    hipMemsetAsync((unsigned char*)d_ws + A_BAR, 0, 16384, stream);
    int lo = 0, hi = PH_HI;
    void* args[] = {&p, &lo, &hi};
    hipError_t e = hipLaunchCooperativeKernel((void*)mega, dim3(grid), dim3(512), args, LDS_BYTES, stream);
    if (e != hipSuccess) fprintf(stderr, "cooperative launch failed: %s (grid %d)\n", hipGetErrorString(e), grid);
#else
#if DBG_STOP
    for (int ph = 0; ph < DBG_STOP; ++ph) hipLaunchKernelGGL(mega, dim3(grid), dim3(512), LDS_BYTES, stream, p, ph, ph + 1);
#ifdef DBG_EXTRA
    hipLaunchKernelGGL(mega, dim3(grid), dim3(512), LDS_BYTES, stream, p, DBG_EXTRA, DBG_EXTRA + 1);
#endif
    hipLaunchKernelGGL(dbg_dump, dim3(2048), dim3(256), 0, stream, (const unsigned char*)d_ws, (float*)d_out, (size_t)34873344);
#else
    for (int ph = 0; ph < NPHASE; ++ph) hipLaunchKernelGGL(mega, dim3(grid), dim3(512), LDS_BYTES, stream, p, ph, ph + 1);
#endif
#endif
}
```

```cpp
#include <hip/hip_runtime.h>
#include <hip/hip_cooperative_groups.h>
#include <cstdio>
namespace cg = cooperative_groups;

#define DUP_MASK 0
#ifndef COOP
#define COOP 1
#endif
#ifndef OUTMASK
#define OUTMASK 0x3FFF
#endif
#ifndef OUT_BMAX
#define OUT_BMAX 1000
#endif
#ifndef OUT_L
#define OUT_L 3
#endif
#define OUT_ON(k) (((OUTMASK >> (k)) & 1) && ((OUT_L >> l) & 1))
#ifndef DMA_AUX
#define DMA_AUX 17
#endif

#define LAS __attribute__((address_space(3)))
typedef unsigned short bf16_t;
typedef short bf16x8 __attribute__((ext_vector_type(8)));
typedef float f32x4 __attribute__((ext_vector_type(4)));
typedef unsigned u32x4 __attribute__((ext_vector_type(4)));
typedef unsigned u32x2 __attribute__((ext_vector_type(2)));

constexpr int DM = 1024, NB = 8, SEQ = 2048, LP = 2064, DEC_B = 128, DEC_S = 4;
constexpr int TPR = NB * LP;
constexpr int TT = TPR + DEC_B * DEC_S;
constexpr int TPAD = 17152;
constexpr int DIN = 8448, DFF = 2816;
constexpr int ZO_UA = 0, ZO_XB = 768, ZO_GB = 1536, ZO_Q = 2304, ZO_K = 2816, ZO_V = 3328, ZO_GC = 4352, ZO_GATE = 5376;
constexpr int LDY = 2560;
constexpr float EPS = 1e-6f;
constexpr int LDS_BYTES = 143360;

enum { I_XP = 0, I_XS, I_S5RE, I_S5IM, I_LRUH, I_LRUC, I_RET, I_FFNC, I_META, I_GPREMIX, I_GPOSTMIX, I_GPREFFN, I_GPOSTFFN, I_WIN,
       I_AR, I_AI, I_LS, I_BR, I_BI, I_CR, I_CI, I_D, I_WGLU, I_BGLU, I_LCW, I_LCB, I_LWA, I_LBA, I_LWX, I_LBX, I_LAM, I_RNG,
       I_WBA, I_WBB, I_WBC, I_WOUT, I_WUP, I_FCW, I_FCB, I_WDOWN, N_IN };

constexpr size_t O_YP = 0;
constexpr size_t O_YS = O_YP + (size_t)NB * SEQ * DM;
constexpr size_t O_P_S5RE = O_YS + (size_t)DEC_B * DEC_S * DM;
constexpr size_t O_P_S5IM = O_P_S5RE + 2 * NB * 48 * 64;
constexpr size_t O_P_LRUH = O_P_S5IM + 2 * NB * 48 * 64;
constexpr size_t O_P_LRUC = O_P_LRUH + 2 * NB * 768;
constexpr size_t O_P_RET = O_P_LRUC + 2 * NB * 3 * 768;
constexpr size_t O_P_FFNC = O_P_RET + (size_t)2 * NB * 8 * 64 * 128;
constexpr size_t O_S_S5RE = O_P_FFNC + 2 * NB * 2 * DFF;
constexpr size_t O_S_S5IM = O_S_S5RE + 2 * DEC_B * 48 * 64;
constexpr size_t O_S_LRUH = O_S_S5IM + 2 * DEC_B * 48 * 64;
constexpr size_t O_S_LRUC = O_S_LRUH + 2 * DEC_B * 768;
constexpr size_t O_S_RET = O_S_LRUC + 2 * DEC_B * 3 * 768;
constexpr size_t O_S_FFNC = O_S_RET + (size_t)2 * DEC_B * 8 * 64 * 128;

constexpr size_t al256(size_t x) { return (x + 255) & ~(size_t)255; }
constexpr size_t W_IN = 0;
constexpr size_t W_GLU = W_IN + (size_t)2 * DIN * DM * 2;
constexpr size_t W_BR = W_GLU + (size_t)2 * 768 * 768 * 2;
constexpr size_t W_OUT = W_BR + (size_t)2 * DM * LDY * 2;
constexpr size_t W_UP = W_OUT + (size_t)2 * DM * DM * 2;
constexpr size_t W_DOWN = W_UP + (size_t)2 * 2 * DFF * DM * 2;
constexpr size_t A_X = W_DOWN + (size_t)2 * DM * DFF * 2;
constexpr int GR = 6400;
constexpr size_t R_Z = A_X + (size_t)TPAD * DM * 4;
constexpr size_t R_ZS5 = R_Z + (size_t)GR * DIN * 2;
constexpr size_t R_Y = R_ZS5 + (size_t)GR * 768 * 2;
constexpr size_t R_M = R_Y + (size_t)GR * LDY * 2;
constexpr size_t R_END = R_M + (size_t)GR * DM * 2;
constexpr size_t R_H = R_M;
constexpr size_t R_F = R_Z;
constexpr size_t R_UP = R_Z + (size_t)GR * DM * 4;
constexpr size_t R_FIN = R_ZS5;
static_assert(R_UP + (size_t)GR * 2 * DFF * 2 <= R_ZS5, "UP inside Z");
static_assert(R_FIN + (size_t)GR * DFF * 2 <= R_M, "FIN inside ZS5|Y");
constexpr size_t A_ROPE = R_END;
constexpr size_t A_CTR = al256(A_ROPE + (size_t)2068 * 64 * 4);
constexpr size_t A_BAR = A_CTR + 4096;
constexpr size_t WS_TOTAL = A_BAR + 16384;
constexpr size_t R_M2 = A_X + (size_t)40 * 1024 * 1024;
static_assert(A_X + (size_t)TPAD * DM * 2 <= R_M2 && R_M2 + (size_t)GR * DM * 2 <= R_Z, "M2 inside the freed half of the X reservation");
constexpr int NGRP = 3;
constexpr int NPHASE = 1 + 2 * NGRP * 10;

struct Grp { int g0, nrows, npan, pb0, npb, hasS; };
__device__ __forceinline__ Grp get_grp(int g) {
    Grp r; r.g0 = g * 6192; r.nrows = g < 2 ? 6192 : 4640; r.npan = g < 2 ? 25 : 19; r.pb0 = g * 3; r.npb = g < 2 ? 3 : 2; r.hasS = g == 2; return r;
}

struct Params {
    const float* in[N_IN];
    float* out;
    unsigned char* ws;
};


constexpr int PTAB_OFF = 142336;
typedef const __attribute__((address_space(1))) float* gfp_t;
typedef const __attribute__((address_space(1))) f32x4* gf4p_t;
__device__ __forceinline__ gfp_t ldin(const unsigned char* smem, int i) {
    const unsigned long long v = ((const unsigned long long*)(smem + PTAB_OFF))[i];
    const unsigned lo = __builtin_amdgcn_readfirstlane((unsigned)v), hi = __builtin_amdgcn_readfirstlane((unsigned)(v >> 32));
    return (gfp_t)(((unsigned long long)hi << 32) | lo);
}
#define INP(i) ldin(smem, (i))
__device__ __forceinline__ int otid() { int t = threadIdx.x; asm volatile("" : "+v"(t)); return t; }

__device__ __forceinline__ float bf2f(bf16_t b) { return __uint_as_float(((unsigned)b) << 16); }
__device__ __forceinline__ bf16_t f2bf(float f) { unsigned u = __float_as_uint(f); u += 0x7FFFu + ((u >> 16) & 1u); return (bf16_t)(u >> 16); }
__device__ __forceinline__ unsigned pk2(float lo, float hi) { return (unsigned)f2bf(lo) | ((unsigned)f2bf(hi) << 16); }
__device__ __forceinline__ float sigm(float x) { return __builtin_amdgcn_rcpf(1.0f + __expf(-x)); }
__device__ __forceinline__ float gelu_t(float x) { const float v = 1.5957691216f * (x + 0.044715f * x * x * x); return x * __builtin_amdgcn_rcpf(1.0f + __expf(-v)); }
__device__ __forceinline__ void lds_wait() { asm volatile("s_waitcnt lgkmcnt(0)" ::: "memory"); __builtin_amdgcn_wave_barrier(); }
__device__ __forceinline__ f32x4 mfma16(bf16x8 a, bf16x8 b, f32x4 c) { return __builtin_amdgcn_mfma_f32_16x16x32_bf16(a, b, c, 0, 0, 0); }

namespace pg8 {
constexpr int BM = 256, BK = 64, HALF = 128, HTB = HALF * BK * 2, STAGE_BYTES = 8 * HTB, NXCD = 8, WGM = 8;
__device__ __forceinline__ int lds_byte(int r, int c) { const int st = (r >> 4) * 2 + (c >> 5), rr = r & 15, cc = c & 31, ob = rr * 64 + cc * 2; return st * 1024 + (ob ^ (((ob >> 9) & 1) << 5)); }
__device__ __forceinline__ void stage_rc(int b, int& R, int& C) { const int st = b / 1024, sb = b % 1024, swz = sb ^ (((sb >> 9) & 1) << 5); R = (st >> 1) * 16 + swz / 64; C = (st & 1) * 32 + (swz % 64) / 2; }

struct Unit { int pm, pn, br; };
struct Gemm { const bf16_t* A; const bf16_t* Bt; int lda, ldb, nM, nN, nt; const bf16_t* A2; };

struct SchedOne {
    int pm, pn, nt0;
    __device__ bool next(int i, Unit& u) const { if (i != 0) return false; u.pm = pm; u.pn = pn; u.br = 0; return true; }
    __device__ __forceinline__ void kr(const Unit&, size_t& koffB, int& nt) const { koffB = 0; nt = nt0; }
};
template <int NBR> struct Sched {
    int nM, nN, nwg, G, c, nt0, fullk;
    __device__ void init(int nM_, int nN_, int G_, int c_, int nt_) { nM = nM_; nN = nN_; nwg = nM * nN; G = G_; c = c_; nt0 = nt_; fullk = 0; }
    __device__ bool next(int i, Unit& u) const {
        int wgid;
        if (NBR == 2) {
            const long L = (long)i * G + c; if (L >= 2 * (long)nwg) return false;
            u.br = (int)(L / nwg); wgid = (int)(L - (long)u.br * nwg);
        } else {
            const int ti = i / NBR; u.br = i - ti * NBR;
            const long L = (long)ti * G + c; if (L >= nwg) return false;
            wgid = (int)L;
        } { const int q = nwg / NXCD, r = nwg % NXCD, xcd = wgid % NXCD, off = wgid / NXCD; wgid = (xcd < r ? xcd * (q + 1) : r * (q + 1) + (xcd - r) * q) + off; }
        const int nig = WGM * nN, gid = wgid / nig, fm = gid * WGM, gsz = (nM - fm) < WGM ? (nM - fm) : WGM;
        u.pm = fm + ((wgid % nig) % gsz); u.pn = (wgid % nig) / gsz; return true;
    }
    __device__ __forceinline__ void kr(const Unit& u, size_t& koffB, int& nt) const {
        if (NBR == 1) { koffB = 0; nt = nt0; }
        else if (NBR == 2) { if (fullk) { nt = nt0; koffB = 0; } else { nt = nt0 >> 1; koffB = (size_t)u.br * (size_t)nt * 128; } }
        else { koffB = (size_t)u.br * 1536; nt = (u.br == 2) ? 16 : 12; }
    }
};

struct SchedBr2 {
    int nM, nN, nwg, G, c;
    __device__ void init(int nM_, int nN_, int G_, int c_) { nM = nM_; nN = nN_; nwg = nM * nN; G = G_; c = c_; }
    __device__ bool next(int i, Unit& u) const {
        const int ti = i / 3, b = i - ti * 3;
        const long L = (long)ti * G + c; if (L >= 2 * (long)nwg) return false;
        const int half = (int)(L / nwg); int wgid = (int)(L - (long)half * nwg);
        { const int q = nwg / NXCD, r = nwg % NXCD, xcd = wgid % NXCD, off = wgid / NXCD; wgid = (xcd < r ? xcd * (q + 1) : r * (q + 1) + (xcd - r) * q) + off; }
        const int nig = WGM * nN, gid = wgid / nig, fm = gid * WGM, gsz = (nM - fm) < WGM ? (nM - fm) : WGM;
        u.pm = fm + ((wgid % nig) % gsz); u.pn = (wgid % nig) / gsz; u.br = b + 4 * half; return true;
    }
    __device__ __forceinline__ void kr(const Unit& u, size_t& koffB, int& nt) const {
        const int b = u.br & 3, half = u.br >> 2; nt = (b == 2) ? 8 : 6; koffB = (size_t)b * 1536 + (size_t)half * nt * 128;
    }
};
__device__ __forceinline__ unsigned cvt_pk_bf16(float lo, float hi) { unsigned r; asm volatile("s_nop 1\n\tv_cvt_pk_bf16_f32 %0, %1, %2" : "=v"(r) : "v"(lo), "v"(hi)); return r; }

template <class Epi, class SchedT>
__device__ __forceinline__ void gemm_phase(LAS unsigned char* lds, const Gemm g, const SchedT& S, const Epi& E) {
    const int tid = otid(), wid = __builtin_amdgcn_readfirstlane(tid >> 6), lane = tid & 63, wr = wid >> 2, wc = wid & 3, fr = lane & 15, fq = lane >> 4;
    unsigned voffA[2], voffB[2];
#pragma unroll
    for (int i = 0; i < 2; ++i) { int R, C; stage_rc(tid * 16 + i * 8192, R, C);
        voffA[i] = (unsigned)(R * g.lda + C) * 2u; voffB[i] = (unsigned)(R * g.ldb + C) * 2u; }
    const size_t kstep = (size_t)(BK * 2);
    const size_t hstepA = (size_t)HALF * g.lda * 2, hstepB = (size_t)HALF * g.ldb * 2;
    const size_t tstepA = 2 * hstepA, tstepB = 2 * hstepB;
    const unsigned ldsw = (unsigned)wid * 1024u;
    const int aoff = lds_byte(wr * 64 + fr, fq * 8), boff = lds_byte(wc * 32 + fr, fq * 8);
#define PG8_SA(b, h) (((b) * 2 + (h)) * HTB)
#define PG8_SB(b, h) ((4 + (b) * 2 + (h)) * HTB)
#define PG8_STAGE(bufoff, gbase, voff) do { _Pragma("unroll") for (int _i = 0; _i < 2; ++_i) \
        __builtin_amdgcn_global_load_lds((const unsigned*)((const char*)(gbase) + (voff)[_i]), (LAS unsigned*)(lds + (bufoff) + ldsw + _i * 8192), 16, 0, DMA_AUX); } while (0)
#define PG8_LDA(dst, b, h) do { _Pragma("unroll") for (int m = 0; m < 4; ++m) _Pragma("unroll") for (int k = 0; k < 2; ++k) dst[m][k] = *(const LAS bf16x8*)(lds + PG8_SA(b, h) + aoff + m * 2048 + k * 1024); } while (0)
#define PG8_LDB(dst, b, h) do { _Pragma("unroll") for (int n = 0; n < 2; ++n) _Pragma("unroll") for (int k = 0; k < 2; ++k) dst[n][k] = *(const LAS bf16x8*)(lds + PG8_SB(b, h) + boff + n * 2048 + k * 1024); } while (0)
#define PG8_MMA(ai, bj, At, Bt) do { __builtin_amdgcn_s_setprio(1); _Pragma("unroll") for (int m = 0; m < 4; ++m) _Pragma("unroll") for (int n = 0; n < 2; ++n) _Pragma("unroll") for (int k = 0; k < 2; ++k) \
        acc[ai][bj][m][n] = __builtin_amdgcn_mfma_f32_16x16x32_bf16(Bt[n][k], At[m][k], acc[ai][bj][m][n], 0, 0, 0); __builtin_amdgcn_s_setprio(0); } while (0)
#define PG8_WAIT_V(n) asm volatile("s_waitcnt vmcnt(" #n ")" ::: "memory")
#define PG8_WAIT_L(n) asm volatile("s_waitcnt lgkmcnt(" #n ")" ::: "memory")
#define PG8_BAR __builtin_amdgcn_s_barrier()
#define PG8_SCHED __builtin_amdgcn_sched_barrier(0)
    Unit cur, nxt; int ui = 0;
    if (!S.next(0, cur)) return;
    f32x4 acc[2][2][4][2];
#pragma unroll
    for (int a = 0; a < 2; ++a)
#pragma unroll
        for (int b = 0; b < 2; ++b)
#pragma unroll
            for (int m = 0; m < 4; ++m)
#pragma unroll
                for (int n = 0; n < 2; ++n) acc[a][b][m][n] = (f32x4){0.f, 0.f, 0.f, 0.f};
    bf16x8 At[4][2], B0[2][2], B1[2][2];
    size_t koc; int ntc; S.kr(cur, koc, ntc);
    const char* cA = (const char*)((g.A2 && cur.br) ? g.A2 : g.A) + (size_t)cur.pm * tstepA + koc; const char* cB = (const char*)g.Bt + (size_t)cur.pn * tstepB + koc;
    PG8_STAGE(PG8_SB(0, 0), cB, voffB); PG8_STAGE(PG8_SA(0, 0), cA, voffA); PG8_STAGE(PG8_SB(0, 1), cB + hstepB, voffB); PG8_STAGE(PG8_SA(0, 1), cA + hstepA, voffA);
    if (wr == 1) PG8_BAR;
    PG8_WAIT_V(4); PG8_BAR;
    PG8_STAGE(PG8_SB(1, 0), cB + kstep, voffB); PG8_STAGE(PG8_SA(1, 0), cA + kstep, voffA); PG8_STAGE(PG8_SB(1, 1), cB + hstepB + kstep, voffB);
    PG8_WAIT_V(6); PG8_BAR;
    for (;;) {
        const bool has_next = S.next(ui + 1, nxt);
        size_t kon = 0; int ntn = ntc; if (has_next) S.kr(nxt, kon, ntn);
        const char* nA = has_next ? (const char*)((g.A2 && nxt.br) ? g.A2 : g.A) + (size_t)nxt.pm * tstepA + kon : cA; const char* nB = has_next ? (const char*)g.Bt + (size_t)nxt.pn * tstepB + kon : cB;
        for (int t = 0; t < ntc; t += 2) {
            const bool last = (t == ntc - 2);
            const char* a1 = cA + (size_t)(t + 1) * kstep;
            const char* a2 = last ? nA : cA + (size_t)(t + 2) * kstep; const char* b2 = last ? nB : cB + (size_t)(t + 2) * kstep;
            const char* a3 = a2 + kstep; const char* b3 = b2 + kstep;
            PG8_LDB(B0, 0, 0); PG8_SCHED; PG8_LDA(At, 0, 0); PG8_STAGE(PG8_SA(1, 1), a1 + hstepA, voffA);
            PG8_WAIT_L(8); PG8_BAR; PG8_WAIT_L(0); PG8_MMA(0, 0, At, B0); PG8_BAR; PG8_SCHED;
            PG8_LDB(B1, 0, 1); PG8_STAGE(PG8_SB(0, 0), b2, voffB);
            PG8_BAR; PG8_WAIT_L(0); PG8_MMA(0, 1, At, B1); PG8_BAR;
            PG8_LDA(At, 0, 1); PG8_STAGE(PG8_SA(0, 0), a2, voffA);
            PG8_BAR; PG8_WAIT_L(0); PG8_MMA(1, 0, At, B0); PG8_BAR; PG8_SCHED;
            PG8_STAGE(PG8_SB(0, 1), b2 + hstepB, voffB);
            PG8_WAIT_V(6); PG8_BAR; PG8_MMA(1, 1, At, B1); PG8_BAR;
            PG8_LDB(B0, 1, 0); PG8_SCHED; PG8_LDA(At, 1, 0); PG8_STAGE(PG8_SA(0, 1), a2 + hstepA, voffA);
            PG8_WAIT_L(8); PG8_BAR; PG8_WAIT_L(0); PG8_MMA(0, 0, At, B0); PG8_BAR; PG8_SCHED;
            PG8_LDB(B1, 1, 1); PG8_STAGE(PG8_SB(1, 0), b3, voffB);
            PG8_BAR; PG8_WAIT_L(0); PG8_MMA(0, 1, At, B1); PG8_BAR;
            PG8_LDA(At, 1, 1); PG8_STAGE(PG8_SA(1, 0), a3, voffA);
            PG8_BAR; PG8_WAIT_L(0); PG8_MMA(1, 0, At, B0); PG8_BAR; PG8_SCHED;
            PG8_STAGE(PG8_SB(1, 1), b3 + hstepB, voffB);
            PG8_WAIT_V(6); PG8_BAR; PG8_MMA(1, 1, At, B1); PG8_BAR;
        }
        E(acc, cur, wr, wc, fr, fq);
        if (!has_next) break;
#pragma unroll
        for (int a = 0; a < 2; ++a)
#pragma unroll
            for (int b = 0; b < 2; ++b)
#pragma unroll
                for (int m = 0; m < 4; ++m)
#pragma unroll
                    for (int n = 0; n < 2; ++n) acc[a][b][m][n] = (f32x4){0.f, 0.f, 0.f, 0.f};
        cur = nxt; cA = nA; cB = nB; ntc = ntn; ++ui;
    }
    PG8_WAIT_V(0);
    if (wr == 0) PG8_BAR;
    PG8_BAR;
#undef PG8_SA
#undef PG8_SB
#undef PG8_STAGE
#undef PG8_LDA
#undef PG8_LDB
#undef PG8_MMA
#undef PG8_WAIT_V
#undef PG8_WAIT_L
#undef PG8_BAR
#undef PG8_SCHED
}

struct EpiBf {
    bf16_t* O; int ldc; bf16_t* O2;
    __device__ __forceinline__ void operator()(const f32x4 (&acc)[2][2][4][2], const Unit& u, int wr, int wc, int fr, int fq) const {
        const int row0 = u.pm * BM + wr * 64 + fr, col0 = u.pn * BM + wc * 32 + 4 * fq;
        bf16_t* O = u.br ? this->O2 : this->O;
#pragma unroll
        for (int ai = 0; ai < 2; ++ai)
#pragma unroll
            for (int m = 0; m < 4; ++m) { bf16_t* rowp = O + (size_t)(row0 + ai * HALF + m * 16) * ldc + col0;
#pragma unroll
                for (int bj = 0; bj < 2; ++bj)
#pragma unroll
                    for (int n = 0; n < 2; ++n) { const f32x4 v = acc[ai][bj][m][n]; u32x2 o; o.x = cvt_pk_bf16(v[0], v[1]); o.y = cvt_pk_bf16(v[2], v[3]); *(u32x2*)(rowp + bj * HALF + n * 16) = o; } }
    }
};
struct EpiSigBf {
    bf16_t* O; int ldc;
    __device__ __forceinline__ void operator()(const f32x4 (&acc)[2][2][4][2], const Unit& u, int wr, int wc, int fr, int fq) const {
        const int row0 = u.pm * BM + wr * 64 + fr, col0 = u.pn * BM + wc * 32 + 4 * fq;
#pragma unroll
        for (int ai = 0; ai < 2; ++ai)
#pragma unroll
            for (int m = 0; m < 4; ++m) { bf16_t* rowp = O + (size_t)(row0 + ai * HALF + m * 16) * ldc + col0;
#pragma unroll
                for (int bj = 0; bj < 2; ++bj)
#pragma unroll
                    for (int n = 0; n < 2; ++n) { const f32x4 v = acc[ai][bj][m][n]; u32x2 o; o.x = cvt_pk_bf16(sigm(v[0]), sigm(v[1])); o.y = cvt_pk_bf16(sigm(v[2]), sigm(v[3])); *(u32x2*)(rowp + bj * HALF + n * 16) = o; } }
    }
};
struct EpiF32 {
    float* C; int ldc; float* C2;
    __device__ __forceinline__ void operator()(const f32x4 (&acc)[2][2][4][2], const Unit& u, int wr, int wc, int fr, int fq) const {
        const int row0 = u.pm * BM + wr * 64 + fr, col0 = u.pn * BM + wc * 32 + 4 * fq;
        float* C = u.br ? this->C2 : this->C;
#pragma unroll
        for (int ai = 0; ai < 2; ++ai)
#pragma unroll
            for (int m = 0; m < 4; ++m) { float* rowp = C + (size_t)(row0 + ai * HALF + m * 16) * ldc + col0;
#pragma unroll
                for (int bj = 0; bj < 2; ++bj)
#pragma unroll
                    for (int n = 0; n < 2; ++n) *(f32x4*)(rowp + bj * HALF + n * 16) = acc[ai][bj][m][n]; }
    }
};
struct EpiGlu {
    bf16_t* Y; const bf16_t* Z; gfp_t bias;
    __device__ __forceinline__ void operator()(const f32x4 (&acc)[2][2][4][2], const Unit& u, int wr, int wc, int fr, int fq) const {
        const int row0 = u.pm * BM + wr * 64 + fr, col0 = u.pn * BM + wc * 32 + 4 * fq;
#pragma unroll
        for (int ai = 0; ai < 2; ++ai)
#pragma unroll
            for (int m = 0; m < 4; ++m) { const size_t r = (size_t)(row0 + ai * HALF + m * 16);
#pragma unroll
                for (int bj = 0; bj < 2; ++bj)
#pragma unroll
                    for (int n = 0; n < 2; ++n) { const int c = col0 + bj * HALF + n * 16; const f32x4 v = acc[ai][bj][m][n];
                        const u32x2 zz = *(const u32x2*)(Z + r * 768 + c); const f32x4 bb = *(const f32x4*)(bias + c);
                        const float z0 = __uint_as_float(zz.x << 16), z1 = __uint_as_float(zz.x & 0xffff0000u), z2 = __uint_as_float(zz.y << 16), z3 = __uint_as_float(zz.y & 0xffff0000u);
                        u32x2 o; o.x = cvt_pk_bf16(z0 * sigm(v[0] + bb[0]), z1 * sigm(v[1] + bb[1])); o.y = cvt_pk_bf16(z2 * sigm(v[2] + bb[2]), z3 * sigm(v[3] + bb[3]));
                        *(u32x2*)(Y + r * LDY + c) = o; } }
    }
};
struct EpiBranch {
    const bf16_t* Zg; bf16_t* Mo; bf16_t* Mo2;
    __device__ __forceinline__ void operator()(const f32x4 (&acc)[2][2][4][2], const Unit& u, int wr, int wc, int fr, int fq) const {
        const int row0 = u.pm * BM + wr * 64 + fr, col0 = u.pn * BM + wc * 32 + 4 * fq; const int br = u.br & 3; bf16_t* Mo = (u.br >> 2) ? this->Mo2 : this->Mo;
#pragma unroll
        for (int ai = 0; ai < 2; ++ai)
#pragma unroll
            for (int m = 0; m < 4; ++m) { const size_t r = (size_t)(row0 + ai * HALF + m * 16);
#pragma unroll
                for (int bj = 0; bj < 2; ++bj)
#pragma unroll
                    for (int n = 0; n < 2; ++n) { const int c = col0 + bj * HALF + n * 16; const f32x4 v = acc[ai][bj][m][n];
                        const u32x2 gg = *(const u32x2*)(Zg + r * DIN + br * 1024 + c);
                        f32x4 t; t[0] = v[0] * __uint_as_float(gg.x << 16); t[1] = v[1] * __uint_as_float(gg.x & 0xffff0000u);
                        t[2] = v[2] * __uint_as_float(gg.y << 16); t[3] = v[3] * __uint_as_float(gg.y & 0xffff0000u);
                        bf16_t* mp = Mo + r * DM + c;
                        if (br != 0) { u32x2 p; p.x = __hip_atomic_load((const unsigned*)mp, __ATOMIC_RELAXED, __HIP_MEMORY_SCOPE_AGENT); p.y = __hip_atomic_load((const unsigned*)mp + 1, __ATOMIC_RELAXED, __HIP_MEMORY_SCOPE_AGENT); t[0] += __uint_as_float(p.x << 16); t[1] += __uint_as_float(p.x & 0xffff0000u); t[2] += __uint_as_float(p.y << 16); t[3] += __uint_as_float(p.y & 0xffff0000u); }
                        u32x2 o; o.x = cvt_pk_bf16(t[0], t[1]); o.y = cvt_pk_bf16(t[2], t[3]); *(u32x2*)mp = o; } }
    }
};

#ifndef GEMM_SIMPLE
#define GEMM_SIMPLE 0
#endif
template <class Epi, class SchedT>
__device__ __forceinline__ void gemm_simple(LAS unsigned char* lds, const Gemm g, const SchedT& S, const Epi& E) {
    const int tid = otid(), wid = __builtin_amdgcn_readfirstlane(tid >> 6), lane = tid & 63, wr = wid >> 2, wc = wid & 3, fr = lane & 15, fq = lane >> 4;
    unsigned voffA[2], voffB[2];
#pragma unroll
    for (int i = 0; i < 2; ++i) { int R, C; stage_rc(tid * 16 + i * 8192, R, C);
        voffA[i] = (unsigned)(R * g.lda + C) * 2u; voffB[i] = (unsigned)(R * g.ldb + C) * 2u; }
    const size_t hstepA = (size_t)HALF * g.lda * 2, hstepB = (size_t)HALF * g.ldb * 2;
    const int aoff = lds_byte(wr * 64 + fr, fq * 8), boff = lds_byte(wc * 32 + fr, fq * 8);
    Unit cur;
    for (int ui = 0; S.next(ui, cur); ++ui) {
        size_t koc; int ntc; S.kr(cur, koc, ntc);
        const char* cA = (const char*)((g.A2 && cur.br) ? g.A2 : g.A) + (size_t)cur.pm * 2 * hstepA + koc; const char* cB = (const char*)g.Bt + (size_t)cur.pn * 2 * hstepB + koc;
        f32x4 acc[2][2][4][2];
#pragma unroll
        for (int a = 0; a < 2; ++a)
#pragma unroll
            for (int b = 0; b < 2; ++b)
#pragma unroll
                for (int m = 0; m < 4; ++m)
#pragma unroll
                    for (int n = 0; n < 2; ++n) acc[a][b][m][n] = (f32x4){0.f, 0.f, 0.f, 0.f};
        for (int t = 0; t < ntc; ++t) {
            u32x4 ra[2][2], rb[2][2];
#pragma unroll
            for (int h = 0; h < 2; ++h)
#pragma unroll
                for (int i = 0; i < 2; ++i) { ra[h][i] = *(const u32x4*)(cA + (size_t)t * 128 + h * hstepA + voffA[i]); rb[h][i] = *(const u32x4*)(cB + (size_t)t * 128 + h * hstepB + voffB[i]); }
            __syncthreads();
#pragma unroll
            for (int h = 0; h < 2; ++h)
#pragma unroll
                for (int i = 0; i < 2; ++i) { *(LAS u32x4*)(lds + h * HTB + tid * 16 + i * 8192) = ra[h][i]; *(LAS u32x4*)(lds + (4 + h) * HTB + tid * 16 + i * 8192) = rb[h][i]; }
            __syncthreads();
#pragma unroll
            for (int ai = 0; ai < 2; ++ai) {
                bf16x8 At[4][2];
#pragma unroll
                for (int m = 0; m < 4; ++m)
#pragma unroll
                    for (int k = 0; k < 2; ++k) At[m][k] = *(const LAS bf16x8*)(lds + ai * HTB + aoff + m * 2048 + k * 1024);
#pragma unroll
                for (int bj = 0; bj < 2; ++bj) {
                    bf16x8 Bf[2][2];
#pragma unroll
                    for (int n = 0; n < 2; ++n)
#pragma unroll
                        for (int k = 0; k < 2; ++k) Bf[n][k] = *(const LAS bf16x8*)(lds + (4 + bj) * HTB + boff + n * 2048 + k * 1024);
#pragma unroll
                    for (int m = 0; m < 4; ++m)
#pragma unroll
                        for (int n = 0; n < 2; ++n)
#pragma unroll
                            for (int k = 0; k < 2; ++k) acc[ai][bj][m][n] = __builtin_amdgcn_mfma_f32_16x16x32_bf16(Bf[n][k], At[m][k], acc[ai][bj][m][n], 0, 0, 0);
                }
            }
        }
        E(acc, cur, wr, wc, fr, fq);
    }
    __syncthreads();
}
template <class Epi, class SchedT>
__device__ __forceinline__ void gemm_run(LAS unsigned char* lds, const Gemm g, const SchedT& S, const Epi& E) {
#if GEMM_SIMPLE
    gemm_simple(lds, g, S, E);
#else
    gemm_phase(lds, g, S, E);
#endif
}
}

__device__ __forceinline__ void transpose_tile(gfp_t W, int N, bf16_t* __restrict__ dst, int ldd, int koff, int tk, int tn, float* tile) {
    const int tid = otid(), a = tid >> 6, bq = tid & 63;
    __syncthreads();
#pragma unroll
    for (int i = 0; i < 8; ++i) { const int k = a + 8 * i; tile[k * 65 + bq] = W[(size_t)(tk * 64 + k) * N + tn * 64 + bq]; }
    __syncthreads();
#pragma unroll
    for (int i = 0; i < 8; ++i) { const int n = a + 8 * i; dst[(size_t)(tn * 64 + n) * ldd + koff + tk * 64 + bq] = f2bf(tile[bq * 65 + n]); }
}

__device__ __forceinline__ f32x4 ldx4(const bf16_t* p) { const u32x2 v = *(const u32x2*)p; f32x4 r; r[0] = __uint_as_float(v.x << 16); r[1] = __uint_as_float(v.x & 0xffff0000u); r[2] = __uint_as_float(v.y << 16); r[3] = __uint_as_float(v.y & 0xffff0000u); return r; }
__device__ __forceinline__ void stx4(bf16_t* p, const f32x4 v) { u32x2 o; o.x = pk2(v[0], v[1]); o.y = pk2(v[2], v[3]); *(u32x2*)p = o; }
__device__ __forceinline__ float row16_sum(float v) {
    v += __builtin_bit_cast(float, __builtin_amdgcn_update_dpp(0, __builtin_bit_cast(int, v), 0xB1, 0xF, 0xF, true));
    v += __builtin_bit_cast(float, __builtin_amdgcn_update_dpp(0, __builtin_bit_cast(int, v), 0x4E, 0xF, 0xF, true));
    v += __builtin_bit_cast(float, __builtin_amdgcn_update_dpp(0, __builtin_bit_cast(int, v), 0x141, 0xF, 0xF, true));
    v += __builtin_bit_cast(float, __builtin_amdgcn_update_dpp(0, __builtin_bit_cast(int, v), 0x140, 0xF, 0xF, true));
    return v;
}
__device__ __forceinline__ float wave_sum(float v) {
    v = row16_sum(v);
    const int iv = __builtin_bit_cast(int, v);
    const float a = __builtin_bit_cast(float, __builtin_amdgcn_readlane(iv, 0)), b = __builtin_bit_cast(float, __builtin_amdgcn_readlane(iv, 16));
    const float c = __builtin_bit_cast(float, __builtin_amdgcn_readlane(iv, 32)), d = __builtin_bit_cast(float, __builtin_amdgcn_readlane(iv, 48));
    return (a + b) + (c + d);
}
__device__ __forceinline__ void rms_store(const f32x4 (&xv)[4], gfp_t g, bf16_t* dst, int lane) {
    float ss = 0.f;
#pragma unroll
    for (int i = 0; i < 4; ++i) ss += xv[i][0] * xv[i][0] + xv[i][1] * xv[i][1] + xv[i][2] * xv[i][2] + xv[i][3] * xv[i][3];
    ss = wave_sum(ss);
    const float rs = rsqrtf(ss * (1.0f / DM) + EPS);
#pragma unroll
    for (int i = 0; i < 4; ++i) { const int c = lane * 4 + 256 * i; const f32x4 gn = *(const f32x4*)(g + c); const f32x4 hv = xv[i] * gn * rs;
        u32x2 o; o.x = pk2(hv[0], hv[1]); o.y = pk2(hv[2], hv[3]); *(u32x2*)(dst + c) = o; }
}
__device__ __forceinline__ void norm_rows(const Params& P, int mode, int l, int grp, const unsigned char* smem) {
    const int tid_ = otid(); const int wid = tid_ >> 6, lane = tid_ & 63;
    bf16_t* __restrict__ X = (bf16_t*)(P.ws + A_X);
    const int gw = blockIdx.x * 8 + wid, nw = gridDim.x * 8;
    if (mode == 0) {
        gfp_t g0p = INP(I_GPREMIX); bf16_t* H = (bf16_t*)(P.ws + R_H);
        for (int row = gw; row < TPAD; row += nw) {
            f32x4 xv[4];
            if (row >= TT) {
#pragma unroll
                for (int i = 0; i < 4; ++i) xv[i] = (f32x4){0.f, 0.f, 0.f, 0.f};
            } else {
                const bool isP = row < TPR; int b = 0, t = 0; if (isP) { b = row / LP; t = row - b * LP; }
                gfp_t src = isP ? (t < 16 ? INP(I_META) + (size_t)t * DM : INP(I_XP) + ((size_t)b * SEQ + (t - 16)) * DM) : INP(I_XS) + (size_t)(row - TPR) * DM;
#pragma unroll
                for (int i = 0; i < 4; ++i) xv[i] = *(const f32x4*)(src + lane * 4 + 256 * i);
            }
#pragma unroll
            for (int i = 0; i < 4; ++i) stx4(X + (size_t)row * DM + lane * 4 + 256 * i, xv[i]);
            if (row < 6192) rms_store(xv, g0p, H + (size_t)row * DM, lane);
        }
        return;
    }
    const Grp G = get_grp(grp);
    const bf16_t* __restrict__ F = (const bf16_t*)(P.ws + R_F) - (size_t)G.g0 * DM;
    const bf16_t* __restrict__ F2 = (const bf16_t*)(P.ws + R_UP) - (size_t)G.g0 * DM;
    bf16_t* __restrict__ H = (bf16_t*)(P.ws + R_H) - (size_t)G.g0 * DM;
    const bool fin = (mode == 2 && l == 1);
    gfp_t gpost = (mode == 1 ? INP(I_GPOSTMIX) : INP(I_GPOSTFFN)) + l * DM;
    gfp_t gffn = INP(I_GPREFFN) + l * DM;
#pragma unroll 2
    for (int row = G.g0 + gw; row < G.g0 + G.nrows; row += nw) {
        f32x4 xv[4], fv[4]; float ss = 0.f;
#pragma unroll
        for (int i = 0; i < 4; ++i) { const int c = lane * 4 + 256 * i; xv[i] = ldx4(X + (size_t)row * DM + c);
            { const u32x2 fa = *(const u32x2*)(F + (size_t)row * DM + c), fb = *(const u32x2*)(F2 + (size_t)row * DM + c);
              fv[i][0] = __uint_as_float(fa.x << 16) + __uint_as_float(fb.x << 16); fv[i][1] = __uint_as_float(fa.x & 0xffff0000u) + __uint_as_float(fb.x & 0xffff0000u);
              fv[i][2] = __uint_as_float(fa.y << 16) + __uint_as_float(fb.y << 16); fv[i][3] = __uint_as_float(fa.y & 0xffff0000u) + __uint_as_float(fb.y & 0xffff0000u); }
            ss += fv[i][0] * fv[i][0] + fv[i][1] * fv[i][1] + fv[i][2] * fv[i][2] + fv[i][3] * fv[i][3]; }
        ss = wave_sum(ss);
        const float rs = rsqrtf(ss * (1.0f / DM) + EPS);
#pragma unroll
        for (int i = 0; i < 4; ++i) { const f32x4 gp = *(const f32x4*)(gpost + lane * 4 + 256 * i); xv[i] = xv[i] + fv[i] * gp * rs; }
        if (fin) {
            float* dst = nullptr;
            if (row < TPR) { const int b = row / LP, t = row - b * LP; if (t >= 16 && ((OUTMASK >> 0) & 1)) dst = P.out + O_YP + ((size_t)b * SEQ + (t - 16)) * DM; }
            else if ((OUTMASK >> 1) & 1) dst = P.out + O_YS + (size_t)(row - TPR) * DM;
            if (dst) {
#pragma unroll
                for (int i = 0; i < 4; ++i) *(f32x4*)(dst + lane * 4 + 256 * i) = xv[i];
            }
        } else {
#pragma unroll
            for (int i = 0; i < 4; ++i) stx4(X + (size_t)row * DM + lane * 4 + 256 * i, xv[i]);
        }
        if (mode == 1) rms_store(xv, gffn, H + (size_t)row * DM, lane);
    }
    if (mode == 2) {
        int nl = l, ng = grp + 1; if (ng == NGRP) { ng = 0; nl = l + 1; }
        if (nl < 2) {
            const Grp N = get_grp(ng); gfp_t gn = INP(I_GPREMIX) + nl * DM; bf16_t* Hn = (bf16_t*)(P.ws + R_H) - (size_t)N.g0 * DM;
            for (int row = N.g0 + gw; row < N.g0 + N.nrows; row += nw) {
                f32x4 xv[4];
#pragma unroll
                for (int i = 0; i < 4; ++i) xv[i] = ldx4(X + (size_t)row * DM + lane * 4 + 256 * i);
                rms_store(xv, gn, Hn + (size_t)row * DM, lane);
            }
        }
    }
}

__device__ __forceinline__ void phase0(const Params& P, unsigned char* smem) {
    float* tile = (float*)smem;
    constexpr int C0 = 2112, C1 = C0 + 144, C2 = C1 + 192, C3 = C2 + 192, C4 = C3 + 256, C5 = C4 + 256, C6 = C5 + 1408, C7 = C6 + 704;
    for (int id = blockIdx.x; id < 2 * C7; id += gridDim.x) {
        const int l = id / C7; int j = id - l * C7;
        gfp_t W; int N, ldd, koff = 0; bf16_t* dst;
        if (j < C0) { W = INP(I_WIN) + (size_t)l * DM * DIN; N = DIN; dst = (bf16_t*)(P.ws + W_IN) + (size_t)l * DIN * DM; ldd = DM; }
        else if (j < C1) { j -= C0; W = INP(I_WGLU) + (size_t)l * 768 * 768; N = 768; dst = (bf16_t*)(P.ws + W_GLU) + (size_t)l * 768 * 768; ldd = 768; }
        else if (j < C2) { j -= C1; W = INP(I_WBA) + (size_t)l * 768 * DM; N = DM; dst = (bf16_t*)(P.ws + W_BR) + (size_t)l * DM * LDY; ldd = LDY; }
        else if (j < C3) { j -= C2; W = INP(I_WBB) + (size_t)l * 768 * DM; N = DM; dst = (bf16_t*)(P.ws + W_BR) + (size_t)l * DM * LDY; ldd = LDY; koff = 768; }
        else if (j < C4) { j -= C3; W = INP(I_WBC) + (size_t)l * DM * DM; N = DM; dst = (bf16_t*)(P.ws + W_BR) + (size_t)l * DM * LDY; ldd = LDY; koff = 1536; }
        else if (j < C5) { j -= C4; W = INP(I_WOUT) + (size_t)l * DM * DM; N = DM; dst = (bf16_t*)(P.ws + W_OUT) + (size_t)l * DM * DM; ldd = DM; }
        else if (j < C6) { j -= C5; W = INP(I_WUP) + (size_t)l * DM * 2 * DFF; N = 2 * DFF; dst = (bf16_t*)(P.ws + W_UP) + (size_t)l * 2 * DFF * DM; ldd = DM; }
        else { j -= C6; W = INP(I_WDOWN) + (size_t)l * DFF * DM; N = DM; dst = (bf16_t*)(P.ws + W_DOWN) + (size_t)l * DM * DFF; ldd = DFF; }
        const int ntn = N / 64; const int tk = j / ntn, tn = j - tk * ntn;
        transpose_tile(W, N, dst, ldd, koff, tk, tn, tile);
    }
    norm_rows(P, 0, 0, 0, smem);
    float* rt = (float*)(P.ws + A_ROPE);
    for (int i = blockIdx.x * 512 + threadIdx.x; i < 2068 * 32; i += gridDim.x * 512) {
        const int pi = i >> 5, fi = i & 31; const double pos = pi < LP ? (double)pi : (double)(16384 + pi - LP);
        const double inv = exp(-(double)fi * (9.210340371976184 / 32.0));
        double ang = pos * inv; const double k = rint(ang * 0.15915494309189535); ang = ang - k * 6.283185307179586;
        const float af = (float)ang; rt[2 * i] = cosf(af); rt[2 * i + 1] = sinf(af);
    }
    if (blockIdx.x == 0 && threadIdx.x < 64) ((unsigned*)(P.ws + A_CTR))[threadIdx.x] = 0u;
}

__device__ __forceinline__ void ffn_conv_phase(const Params& P, int l, int grp, const unsigned char* smem) {
    const Grp G = get_grp(grp);
    const bf16_t* __restrict__ UP = (const bf16_t*)(P.ws + R_UP) - (size_t)G.g0 * (2 * DFF); bf16_t* __restrict__ FIN = (bf16_t*)(P.ws + R_FIN) - (size_t)G.g0 * DFF;
    gfp_t cw = INP(I_FCW) + (size_t)l * 3 * DFF; gfp_t cb = INP(I_FCB) + (size_t)l * DFF;
    gfp_t cache = INP(I_FFNC) + (size_t)l * DEC_B * 2 * DFF;
    constexpr int NCG = DFF / 8;
#pragma unroll 2
    for (int it = blockIdx.x * 512 + threadIdx.x; it < G.nrows * NCG; it += gridDim.x * 512) {
        const int rr = it / NCG, c = (it - rr * NCG) * 8, row = G.g0 + rr;
        int b, t, L; const bool isP = row < TPR;
        if (isP) { b = row / LP; t = row - b * LP; L = LP; } else { b = (row - TPR) >> 2; t = (row - TPR) & 3; L = 4; }
        float g0[8], g1[8], g2[8], uf[8];
        { const u32x4 v = *(const u32x4*)(UP + (size_t)row * (2 * DFF) + c);
#pragma unroll
          for (int i = 0; i < 4; ++i) { g0[2 * i] = __uint_as_float(v[i] << 16); g0[2 * i + 1] = __uint_as_float(v[i] & 0xffff0000u); } }
        { const u32x4 v = *(const u32x4*)(UP + (size_t)row * (2 * DFF) + DFF + c);
#pragma unroll
          for (int i = 0; i < 4; ++i) { uf[2 * i] = __uint_as_float(v[i] << 16); uf[2 * i + 1] = __uint_as_float(v[i] & 0xffff0000u); } }
        if (t >= 1) { const u32x4 v = *(const u32x4*)(UP + (size_t)(row - 1) * (2 * DFF) + c);
#pragma unroll
            for (int i = 0; i < 4; ++i) { g1[2 * i] = __uint_as_float(v[i] << 16); g1[2 * i + 1] = __uint_as_float(v[i] & 0xffff0000u); } }
        else {
#pragma unroll
            for (int i = 0; i < 8; ++i) g1[i] = isP ? 0.f : cache[((size_t)b * 2 + 1) * DFF + c + i]; }
        if (t >= 2) { const u32x4 v = *(const u32x4*)(UP + (size_t)(row - 2) * (2 * DFF) + c);
#pragma unroll
            for (int i = 0; i < 4; ++i) { g2[2 * i] = __uint_as_float(v[i] << 16); g2[2 * i + 1] = __uint_as_float(v[i] & 0xffff0000u); } }
        else {
#pragma unroll
            for (int i = 0; i < 8; ++i) g2[i] = isP ? 0.f : cache[((size_t)b * 2 + t) * DFF + c + i]; }
        float o[8];
#pragma unroll
        for (int i = 0; i < 8; ++i) { const float gc = cb[c + i] + cw[c + i] * g2[i] + cw[DFF + c + i] * g1[i] + cw[2 * DFF + c + i] * g0[i]; o[i] = gelu_t(gc) * uf[i]; }
        u32x4 ov; ov[0] = pk2(o[0], o[1]); ov[1] = pk2(o[2], o[3]); ov[2] = pk2(o[4], o[5]); ov[3] = pk2(o[6], o[7]);
        *(u32x4*)(FIN + (size_t)row * DFF + c) = ov;
        if (t >= L - 2 && (isP ? OUT_ON(7) : OUT_ON(13))) {
            float* dst = isP ? P.out + O_P_FFNC + (((size_t)l * NB + b) * 2 + (t - (L - 2))) * DFF + c : P.out + O_S_FFNC + (((size_t)l * DEC_B + b) * 2 + (t - (L - 2))) * DFF + c;
#pragma unroll
            for (int i = 0; i < 8; ++i) dst[i] = g0[i];
        }
    }
}

__device__ __forceinline__ void ret_job(const Params& P, int l, int grp, int b, int h, int g0, unsigned char* smem) {
    const int tid = otid(), w = __builtin_amdgcn_readfirstlane(tid >> 6), lane = tid & 63, fr = lane & 15, fq = lane >> 4;
    bf16_t* sQ = (bf16_t*)smem;
    bf16_t* sK = sQ + 128 * 72;
    bf16_t* sKdT = sK + 128 * 72;
    bf16_t* sVT = sKdT + 64 * 136;
    bf16_t* sST = sVT + 128 * 136;
    bf16_t* sP = sST + 128 * 72 + w * 16 * 136;
    const bf16_t* Z = (const bf16_t*)(P.ws + R_Z) - (size_t)g0 * DIN; bf16_t* Y = (bf16_t*)(P.ws + R_Y) - (size_t)g0 * LDY;
    const float* rope = (const float*)(P.ws + A_ROPE);
    const int L = grp ? 4 : LP, rowb = grp ? TPR + b * 4 : b * LP, tabb = grp ? LP : 0;
    const float lg = log1pf(-exp2f(-5.0f - (float)h));
    gfp_t ng = INP(I_RNG) + (size_t)l * 1024 + h * 128;
    float ngv[8];
#pragma unroll
    for (int et = 0; et < 8; ++et) ngv[et] = ng[16 * et + fr];
    f32x4 accS[4];
    float* Sout = P.out + (grp ? O_S_RET + (((size_t)l * DEC_B + b) * 8 + h) * 8192 : O_P_RET + (((size_t)l * NB + b) * 8 + h) * 8192);
    if (grp) { gfp_t S0 = INP(I_RET) + (((size_t)l * DEC_B + b) * 8 + h) * 8192;
#pragma unroll
        for (int dt = 0; dt < 4; ++dt)
#pragma unroll
            for (int j = 0; j < 4; ++j) accS[dt][j] = S0[(16 * dt + 4 * fq + j) * 128 + 16 * w + fr];
    } else {
#pragma unroll
        for (int dt = 0; dt < 4; ++dt) accS[dt] = (f32x4){0.f, 0.f, 0.f, 0.f};
    }
    __syncthreads();
#pragma unroll
    for (int dt = 0; dt < 4; ++dt) { u32x2 o; o.x = pk2(accS[dt][0], accS[dt][1]); o.y = pk2(accS[dt][2], accS[dt][3]); *(u32x2*)(sST + (16 * w + fr) * 72 + 16 * dt + 4 * fq) = o; }
    const int nch = grp ? 1 : 17;
    u32x4 q1 = {0u, 0u, 0u, 0u}, q2 = q1, k1 = q1, k2 = q1, vv[4];
#define RET_LOAD(ckx) do { const int _t0 = grp ? 0 : ((ckx) == 0 ? 0 : 16 + ((ckx) - 1) * 128), _C = grp ? 4 : ((ckx) == 0 ? 16 : 128); \
        const int _m = tid >> 2, _i0 = (tid & 3) * 8, _m2 = tid & 127, _e0 = (tid >> 7) * 32; \
        q1 = (u32x4){0u, 0u, 0u, 0u}; q2 = q1; k1 = q1; k2 = q1; \
        if (_m < _C) { const size_t _zr = (size_t)(rowb + _t0 + _m) * DIN; \
            q1 = *(const u32x4*)(Z + _zr + ZO_Q + h * 64 + _i0); q2 = *(const u32x4*)(Z + _zr + ZO_Q + h * 64 + 32 + _i0); \
            k1 = *(const u32x4*)(Z + _zr + ZO_K + h * 64 + _i0); k2 = *(const u32x4*)(Z + _zr + ZO_K + h * 64 + 32 + _i0); } \
        _Pragma("unroll") for (int _i = 0; _i < 4; ++_i) vv[_i] = (u32x4){0u, 0u, 0u, 0u}; \
        if (_m2 < _C) { const bf16_t* _vp = Z + (size_t)(rowb + _t0 + _m2) * DIN + ZO_V + h * 128 + _e0; \
            _Pragma("unroll") for (int _i = 0; _i < 4; ++_i) vv[_i] = *(const u32x4*)(_vp + 8 * _i); } } while (0)
    RET_LOAD(0);
    for (int ck = 0; ck < nch; ++ck) {
        const int t0 = grp ? 0 : (ck == 0 ? 0 : 16 + (ck - 1) * 128), C = grp ? 4 : (ck == 0 ? 16 : 128);
        {
            const int m = tid >> 2, i0 = (tid & 3) * 8;
            u32x4 q1w = {0u, 0u, 0u, 0u}, q2w = q1w, k1w = q1w, k2w = q1w;
            float kd1[8], kd2[8];
#pragma unroll
            for (int e = 0; e < 8; ++e) { kd1[e] = 0.f; kd2[e] = 0.f; }
            if (m < C) {
                const float* rp = rope + ((size_t)(tabb + t0 + m) * 32 + i0) * 2;
                const float kdec = __expf(lg * (float)(C - 1 - m));
                float qo1[8], qo2[8], ko1[8], ko2[8];
#pragma unroll
                for (int e = 0; e < 8; ++e) {
                    const float cs = rp[2 * e], sn = rp[2 * e + 1];
                    const unsigned qa = q1[e >> 1], qb = q2[e >> 1], ka = k1[e >> 1], kb = k2[e >> 1];
                    const float x1 = (e & 1) ? __uint_as_float(qa & 0xffff0000u) : __uint_as_float(qa << 16);
                    const float x2 = (e & 1) ? __uint_as_float(qb & 0xffff0000u) : __uint_as_float(qb << 16);
                    const float y1 = ((e & 1) ? __uint_as_float(ka & 0xffff0000u) : __uint_as_float(ka << 16)) * 0.125f;
                    const float y2 = ((e & 1) ? __uint_as_float(kb & 0xffff0000u) : __uint_as_float(kb << 16)) * 0.125f;
                    qo1[e] = x1 * cs - x2 * sn; qo2[e] = x2 * cs + x1 * sn;
                    ko1[e] = y1 * cs - y2 * sn; ko2[e] = y2 * cs + y1 * sn;
                    kd1[e] = ko1[e] * kdec; kd2[e] = ko2[e] * kdec;
                }
#pragma unroll
                for (int e = 0; e < 4; ++e) { q1w[e] = pk2(qo1[2 * e], qo1[2 * e + 1]); q2w[e] = pk2(qo2[2 * e], qo2[2 * e + 1]); k1w[e] = pk2(ko1[2 * e], ko1[2 * e + 1]); k2w[e] = pk2(ko2[2 * e], ko2[2 * e + 1]); }
            }
            *(u32x4*)(sQ + m * 72 + i0) = q1w; *(u32x4*)(sQ + m * 72 + 32 + i0) = q2w;
            *(u32x4*)(sK + m * 72 + i0) = k1w; *(u32x4*)(sK + m * 72 + 32 + i0) = k2w;
#pragma unroll
            for (int e = 0; e < 8; ++e) { sKdT[(i0 + e) * 136 + m] = f2bf(kd1[e]); sKdT[(32 + i0 + e) * 136 + m] = f2bf(kd2[e]); }
            const int m2 = tid & 127, e0 = (tid >> 7) * 32;
#pragma unroll
            for (int i = 0; i < 4; ++i)
#pragma unroll
                for (int e = 0; e < 4; ++e) { sVT[(e0 + 8 * i + 2 * e) * 136 + m2] = (bf16_t)(vv[i][e] & 0xffffu); sVT[(e0 + 8 * i + 2 * e + 1) * 136 + m2] = (bf16_t)(vv[i][e] >> 16); }
        }
        __syncthreads();
        if (ck + 1 < nch) RET_LOAD(ck + 1);
        f32x4 o[8];
        const bool act = (16 * w < C);
        unsigned gcp[4][4];
        if (act) {
#pragma unroll
            for (int j = 0; j < 4; ++j) { const int n = 16 * w + 4 * fq + j; const size_t row = (size_t)(rowb + t0 + (n < C ? n : 0));
#pragma unroll
                for (int e2 = 0; e2 < 4; ++e2) { const bf16_t lo = Z[row * DIN + ZO_GC + h * 128 + 32 * e2 + fr], hi = Z[row * DIN + ZO_GC + h * 128 + 32 * e2 + 16 + fr]; gcp[e2][j] = (unsigned)lo | ((unsigned)hi << 16); } }
        }
        if (act) {
            bf16x8 qf[2];
#pragma unroll
            for (int ks = 0; ks < 2; ++ks) qf[ks] = *(const bf16x8*)(sQ + (16 * w + fr) * 72 + 32 * ks + 8 * fq);
            const int mtN = (w | 1) + 1;
            for (int mt = 0; mt < mtN; ++mt) {
                f32x4 a = {0.f, 0.f, 0.f, 0.f};
#pragma unroll
                for (int ks = 0; ks < 2; ++ks) { const bf16x8 kf = *(const bf16x8*)(sK + (16 * mt + fr) * 72 + 32 * ks + 8 * fq); a = mfma16(qf[ks], kf, a); }
#pragma unroll
                for (int j = 0; j < 4; ++j) { const int d = (16 * w + 4 * fq + j) - (16 * mt + fr); const float v = d >= 0 ? a[j] * __expf(lg * (float)d) : 0.f; sP[(4 * fq + j) * 136 + 16 * mt + fr] = f2bf(v); }
            }
            lds_wait();
#pragma unroll
            for (int et = 0; et < 8; ++et) o[et] = (f32x4){0.f, 0.f, 0.f, 0.f};
            const int ksN = mtN >> 1;
            for (int ks = 0; ks < ksN; ++ks) {
                const bf16x8 pf = *(const bf16x8*)(sP + fr * 136 + 32 * ks + 8 * fq);
#pragma unroll
                for (int et = 0; et < 8; ++et) { const bf16x8 vf = *(const bf16x8*)(sVT + (16 * et + fr) * 136 + 32 * ks + 8 * fq); o[et] = mfma16(pf, vf, o[et]); }
            }
            f32x4 o2[8];
#pragma unroll
            for (int et = 0; et < 8; ++et) o2[et] = (f32x4){0.f, 0.f, 0.f, 0.f};
#pragma unroll
            for (int ks = 0; ks < 2; ++ks)
#pragma unroll
                for (int et = 0; et < 8; ++et) { const bf16x8 sf = *(const bf16x8*)(sST + (16 * et + fr) * 72 + 32 * ks + 8 * fq); o2[et] = mfma16(qf[ks], sf, o2[et]); }
#pragma unroll
            for (int j = 0; j < 4; ++j) { const float sc = __expf(lg * (float)(16 * w + 4 * fq + j + 1));
#pragma unroll
                for (int et = 0; et < 8; ++et) o[et][j] += o2[et][j] * sc; }
        }
        {
            const float gC = __expf(lg * (float)C);
#pragma unroll
            for (int dt = 0; dt < 4; ++dt) accS[dt] = accS[dt] * gC;
            const int ksN = (C + 31) >> 5;
            for (int ks = 0; ks < ksN; ++ks) {
                const bf16x8 vf = *(const bf16x8*)(sVT + (16 * w + fr) * 136 + 32 * ks + 8 * fq);
#pragma unroll
                for (int dt = 0; dt < 4; ++dt) { const bf16x8 kf = *(const bf16x8*)(sKdT + (16 * dt + fr) * 136 + 32 * ks + 8 * fq); accS[dt] = mfma16(kf, vf, accS[dt]); }
            }
        }
        __syncthreads();
#pragma unroll
        for (int dt = 0; dt < 4; ++dt) { u32x2 ow; ow.x = pk2(accS[dt][0], accS[dt][1]); ow.y = pk2(accS[dt][2], accS[dt][3]); *(u32x2*)(sST + (16 * w + fr) * 72 + 16 * dt + 4 * fq) = ow; }
        if (act) {
#pragma unroll
            for (int j = 0; j < 4; ++j) {
                float s = 0.f;
#pragma unroll
                for (int et = 0; et < 8; ++et) s += o[et][j];
                s = row16_sum(s);
                const float mu = s * (1.0f / 128.0f);
                float s2 = 0.f;
#pragma unroll
                for (int et = 0; et < 8; ++et) { const float d = o[et][j] - mu; s2 += d * d; }
                s2 = row16_sum(s2);
                const float rstd = rsqrtf(s2 * (1.0f / 128.0f) + EPS);
                const int n = 16 * w + 4 * fq + j;
                if (n < C) {
                    const size_t row = (size_t)(rowb + t0 + n);
#pragma unroll
                    for (int et = 0; et < 8; ++et) { const int e = 16 * et + fr; const unsigned gw_ = gcp[et >> 1][j]; const float gcv = (et & 1) ? __uint_as_float(gw_ & 0xffff0000u) : __uint_as_float(gw_ << 16);
                        const float yv = gcv * sigm(gcv) * (o[et][j] - mu) * rstd * ngv[et]; Y[row * LDY + 1536 + h * 128 + e] = f2bf(yv); }
                }
            }
        }
    }
    if (grp ? OUT_ON(12) : OUT_ON(6)) {
#pragma unroll
    for (int dt = 0; dt < 4; ++dt)
#pragma unroll
        for (int j = 0; j < 4; ++j) Sout[(16 * dt + 4 * fq + j) * 128 + 16 * w + fr] = accS[dt][j];
    }
}

__device__ __forceinline__ void lru_job(const Params& P, int l, int grp, int jid, int g0, int pb0, unsigned char* smem) {
    const int tid = otid(), w = __builtin_amdgcn_readfirstlane(tid >> 6), lane = tid & 63, fr = lane & 15, fq = lane >> 4;
    bf16_t* sA = (bf16_t*)(smem + w * 10752);
    float* sRI = (float*)(smem + w * 10752 + 2304);
    float* sComb = (float*)(smem + 8 * 10752);
    const bf16_t* Z = (const bf16_t*)(P.ws + R_Z) - (size_t)g0 * DIN; bf16_t* Y = (bf16_t*)(P.ws + R_Y) - (size_t)g0 * LDY;
    const int unit = grp ? jid * 8 + w : jid;
    const int bl = unit / 12, hb = unit - bl * 12, ch = hb * 64 + lane; const int b = grp ? bl : pb0 + bl;
    const int L = grp ? 4 : LP, rowb = grp ? TPR + b * 4 : b * LP;
    float cw[4];
#pragma unroll
    for (int j = 0; j < 4; ++j) cw[j] = INP(I_LCW)[((size_t)l * 4 + j) * 768 + ch];
    const float cb = INP(I_LCB)[l * 768 + ch], ba = INP(I_LBA)[l * 768 + ch], bx = INP(I_LBX)[l * 768 + ch];
    const float lam = INP(I_LAM)[l * 768 + ch];
    const float sp8 = 8.0f * (fmaxf(-lam, 0.f) + log1pf(__expf(-fabsf(lam))));
    bf16x8 Wa[4][2], Wx[4][2];
    { gfp_t wa = INP(I_LWA) + ((size_t)l * 12 + hb) * 4096; gfp_t wx = INP(I_LWX) + ((size_t)l * 12 + hb) * 4096;
#pragma unroll
      for (int nt = 0; nt < 4; ++nt)
#pragma unroll
          for (int ks = 0; ks < 2; ++ks)
#pragma unroll
              for (int j = 0; j < 8; ++j) { const int k = 32 * ks + 8 * fq + j, n = 16 * nt + fr; Wa[nt][ks][j] = (short)f2bf(wa[k * 64 + n]); Wx[nt][ks][j] = (short)f2bf(wx[k * 64 + n]); } }
    float carry = grp ? INP(I_LRUH)[((size_t)l * DEC_B + b) * 768 + ch] : 0.f;
    gfp_t cache = INP(I_LRUC) + ((size_t)l * DEC_B + b) * 3 * 768;
    const int nIter = grp ? 1 : 17;
    __syncthreads();
#ifndef LRU_REP
#define LRU_REP 1
#endif
    bf16_t xn[19];
    { const int tw0 = grp ? 0 : 16 * w;
#pragma unroll
      for (int i = 0; i < 19; ++i) { int t = tw0 - 3 + i; t = t < 0 ? 0 : (t > L - 1 ? L - 1 : t); xn[i] = Z[(size_t)(rowb + t) * DIN + ZO_XB + ch]; } }
    for (int it_ = 0; it_ < nIter * (grp ? 1 : LRU_REP); ++it_) {
        const int it = it_ % nIter; if (LRU_REP > 1 && it_ == nIter) carry = 0.f;
        const int tw = grp ? 0 : it * 128 + 16 * w;
        float xv[19];
#pragma unroll
        for (int i = 0; i < 19; ++i) { const int t = tw - 3 + i; xv[i] = (t >= 0 && t < L) ? bf2f(xn[i]) : 0.f; }
        if (grp) {
#pragma unroll
            for (int i = 0; i < 3; ++i) xv[i] = cache[i * 768 + ch];
        }
        if (it_ + 1 < nIter * (grp ? 1 : LRU_REP)) {
            const int twn = tw + 128;
#pragma unroll
            for (int i = 0; i < 19; ++i) { int t = twn - 3 + i; t = t < 0 ? 0 : (t > L - 1 ? L - 1 : t); xn[i] = Z[(size_t)(rowb + t) * DIN + ZO_XB + ch]; }
        }
        unsigned gtp[8];
#pragma unroll
        for (int i = 0; i < 8; ++i) { const int ta = tw + 2 * i, tb = ta + 1;
            const bf16_t lo = Z[(size_t)(rowb + (ta < L ? ta : L - 1)) * DIN + ZO_GB + ch], hi = Z[(size_t)(rowb + (tb < L ? tb : L - 1)) * DIN + ZO_GB + ch];
            gtp[i] = (unsigned)lo | ((unsigned)hi << 16); }
        float xc[16];
#pragma unroll
        for (int i = 0; i < 16; ++i) { xc[i] = cb + cw[0] * xv[i] + cw[1] * xv[i + 1] + cw[2] * xv[i + 2] + cw[3] * xv[i + 3]; sA[i * 72 + lane] = f2bf(xc[i]); }
        lds_wait();
        bf16x8 af[2];
#pragma unroll
        for (int ks = 0; ks < 2; ++ks) af[ks] = *(const bf16x8*)(sA + fr * 72 + 32 * ks + 8 * fq);
#pragma unroll
        for (int nt = 0; nt < 4; ++nt) {
            f32x4 ra = {0.f, 0.f, 0.f, 0.f}, rx = ra;
            ra = mfma16(af[0], Wa[nt][0], ra); ra = mfma16(af[1], Wa[nt][1], ra);
            rx = mfma16(af[0], Wx[nt][0], rx); rx = mfma16(af[1], Wx[nt][1], rx);
#pragma unroll
            for (int j = 0; j < 4; ++j) { sRI[(4 * fq + j) * 132 + 16 * nt + fr] = ra[j]; sRI[(4 * fq + j) * 132 + 64 + 16 * nt + fr] = rx[j]; }
        }
        lds_wait();
        float hloc[16], ca[16]; float hl = 0.f, cacc = 1.f;
#pragma unroll
        for (int i = 0; i < 16; ++i) {
            const float rp = sRI[i * 132 + lane], ip = sRI[i * 132 + 64 + lane];
            const float r = sigm(rp + ba), ii = sigm(ip + bx);
            const float la = -sp8 * r; float a = __expf(la);
            const float x2 = 2.0f * la;
            const float ser = -x2 * (1.0f + x2 * (0.5f + x2 * (0.16666667f + x2 * (0.041666668f + x2 * 0.0083333338f))));
            const float om = x2 > -0.25f ? ser : 1.0f - __expf(x2);
            float bv = __builtin_amdgcn_sqrtf(om) * ii * xc[i];
            if (tw + i >= L) { a = 1.f; bv = 0.f; }
            hl = a * hl + bv; cacc *= a; hloc[i] = hl; ca[i] = cacc;
        }
        float hin = carry;
        if (!grp) {
            float* sCb = sComb + (it_ & 1) * 1024;
            sCb[(w * 64 + lane) * 2] = cacc; sCb[(w * 64 + lane) * 2 + 1] = hl;
            __syncthreads();
            float run = carry;
#pragma unroll
            for (int ww = 0; ww < 8; ++ww) { if (ww == w) hin = run; run = sCb[(ww * 64 + lane) * 2] * run + sCb[(ww * 64 + lane) * 2 + 1]; }
            carry = run;
        } else carry = hloc[15] + ca[15] * hin;
#pragma unroll
        for (int i = 0; i < 16; ++i) { const int t = tw + i;
            if (t < L) { const size_t row = (size_t)(rowb + t); const float hh = hloc[i] + ca[i] * hin; const unsigned gw_ = gtp[i >> 1]; const float gt = (i & 1) ? __uint_as_float(gw_ & 0xffff0000u) : __uint_as_float(gw_ << 16); Y[row * LDY + 768 + ch] = f2bf(hh * gelu_t(gt)); } }
    }
    if (grp || w == 0) {
        float* ho = grp ? P.out + O_S_LRUH + ((size_t)l * DEC_B + b) * 768 + ch : P.out + O_P_LRUH + ((size_t)l * NB + b) * 768 + ch;
        if (grp ? OUT_ON(10) : OUT_ON(4)) *ho = carry;
        float* co = grp ? P.out + O_S_LRUC + ((size_t)l * DEC_B + b) * 3 * 768 + ch : P.out + O_P_LRUC + ((size_t)l * NB + b) * 3 * 768 + ch;
#pragma unroll
        for (int j = 0; j < 3; ++j) if (grp ? OUT_ON(11) : OUT_ON(5)) co[j * 768] = bf2f(Z[(size_t)(rowb + L - 3 + j) * DIN + ZO_XB + ch]);
    }
}

template <bool FULL>
__device__ __forceinline__ void s5_run(const bf16_t* Z, bf16_t* ZS, float* sBU, bf16_t* sH, const bf16x8 (&Bf)[8], const bf16x8 (&Cf)[4], float abr, float abi, float dsk,
                                       int rowb, int g, int L, int it0, int it1, float& hr, float& hi, int lane, int fr, int fq) {
    u32x4 ufn = {0u, 0u, 0u, 0u}; bf16_t udn[4] = {0, 0, 0, 0};
    { const int t1 = it0 * 16; const int v1 = (L - t1) < 16 ? (L - t1) : 16;
      if (fq < 2 && fr < v1) ufn = *(const u32x4*)(Z + (size_t)(rowb + t1 + fr) * DIN + ZO_UA + g * 16 + 8 * fq);
      if (FULL) {
#pragma unroll
          for (int j = 0; j < 4; ++j) if (4 * fq + j < v1) udn[j] = Z[(size_t)(rowb + t1 + 4 * fq + j) * DIN + ZO_UA + g * 16 + fr]; } }
    for (int it = it0; it < it1; ++it) {
        const int t0 = it * 16; const int valid = (L - t0) < 16 ? (L - t0) : 16;
        const bf16x8 uf = __builtin_bit_cast(bf16x8, ufn);
        bf16_t ud[4];
#pragma unroll
        for (int j = 0; j < 4; ++j) ud[j] = udn[j];
        if (it + 1 < it1) { const int t1 = t0 + 16; const int v1 = (L - t1) < 16 ? (L - t1) : 16;
            ufn = (u32x4){0u, 0u, 0u, 0u};
            if (fq < 2 && fr < v1) ufn = *(const u32x4*)(Z + (size_t)(rowb + t1 + fr) * DIN + ZO_UA + g * 16 + 8 * fq);
            if (FULL) {
#pragma unroll
                for (int j = 0; j < 4; ++j) { udn[j] = 0; if (4 * fq + j < v1) udn[j] = Z[(size_t)(rowb + t1 + 4 * fq + j) * DIN + ZO_UA + g * 16 + fr]; } } }
#pragma unroll
        for (int nt = 0; nt < 8; ++nt) { f32x4 a = {0.f, 0.f, 0.f, 0.f}; a = mfma16(uf, Bf[nt], a);
#pragma unroll
            for (int j = 0; j < 4; ++j) sBU[(4 * fq + j) * 132 + 16 * nt + fr] = a[j]; }
        lds_wait();
#pragma unroll
        for (int i = 0; i < 16; ++i) {
            float bur = sBU[i * 132 + lane], bui = sBU[i * 132 + 64 + lane];
            asm volatile("" : "+v"(bur), "+v"(bui));
            const float msk = (i < valid) ? 1.0f : 0.0f;
            float nr = __builtin_fmaf(abr, hr, bur); asm volatile("" : "+v"(nr));
            nr = __builtin_fmaf(-abi, hi, nr); asm volatile("" : "+v"(nr));
            float ni = __builtin_fmaf(abr, hi, bui); asm volatile("" : "+v"(ni));
            ni = __builtin_fmaf(abi, hr, ni); asm volatile("" : "+v"(ni));
            hr = __builtin_fmaf(msk, nr - hr, hr); hi = __builtin_fmaf(msk, ni - hi, hi);
            asm volatile("" : "+v"(hr), "+v"(hi));
            if (FULL) { sH[i * 136 + lane] = f2bf(hr); sH[i * 136 + 64 + lane] = f2bf(hi); }
        }
        lds_wait();
        if (FULL) {
            f32x4 y = {0.f, 0.f, 0.f, 0.f};
#pragma unroll
            for (int ks = 0; ks < 4; ++ks) { const bf16x8 hf = *(const bf16x8*)(sH + fr * 136 + 32 * ks + 8 * fq); y = mfma16(hf, Cf[ks], y); }
#pragma unroll
            for (int j = 0; j < 4; ++j) { const int t = 4 * fq + j;
                if (t < valid) { const size_t row = (size_t)(rowb + t0 + t); const float u = bf2f(ud[j]); ZS[row * 768 + g * 16 + fr] = f2bf(gelu_t(y[j] + dsk * u)); } }
            lds_wait();
        }
    }
}
__device__ __forceinline__ void cmul(float& ar, float& ai, float br, float bi) { const float r = ar * br - ai * bi, i = ar * bi + ai * br; ar = r; ai = i; }

__device__ __forceinline__ void s5_job(const Params& P, int l, int grp, int jid, int g0, int pb0, unsigned* s5done, unsigned char* smem) {
    const int tid = otid(), w = __builtin_amdgcn_readfirstlane(tid >> 6), lane = tid & 63, fr = lane & 15, fq = lane >> 4;
    float* sBU = (float*)(smem + w * 12800);
    bf16_t* sH = (bf16_t*)(smem + w * 12800 + 8448);
    float* sC = (float*)(smem + 8 * 12800);
    const bf16_t* Z = (const bf16_t*)(P.ws + R_Z) - (size_t)g0 * DIN; bf16_t* ZS = (bf16_t*)(P.ws + R_ZS5) - (size_t)g0 * 768;
    int g, b0;
    if (grp) { const int unit = jid * 8 + w; g = unit % 48; b0 = (unit / 48) * 16; } else { b0 = jid / 48; g = jid - b0 * 48; b0 += pb0; }
    const float dt = __expf(INP(I_LS)[l * 48 + g]);
    float abr = 0.f, abi = 0.f;
    bf16x8 Bf[8];
#pragma unroll
    for (int k = 0; k < 4; ++k) {
        const int p = 16 * k + fr;
        const float lr = INP(I_AR)[((size_t)l * 48 + g) * 64 + p], li = INP(I_AI)[((size_t)l * 48 + g) * 64 + p];
        const float mag = expf(lr * dt), ar_ = mag * cosf(li * dt), ai_ = mag * sinf(li * dt);
        if (k == fq) { abr = ar_; abi = ai_; }
        const float den = lr * lr + li * li, nr = ar_ - 1.0f;
        const float cr = (nr * lr + ai_ * li) / den, ci = (ai_ * lr - nr * li) / den;
        bf16x8 fre, fim;
#pragma unroll
        for (int j = 0; j < 8; ++j) { fre[j] = 0; fim[j] = 0; }
        if (fq < 2) {
            gfp_t bre = INP(I_BR) + (((size_t)l * 48 + g) * 64 + p) * 16 + 8 * fq; gfp_t bim = INP(I_BI) + (((size_t)l * 48 + g) * 64 + p) * 16 + 8 * fq;
#pragma unroll
            for (int j = 0; j < 8; ++j) { const float br_ = bre[j], bi_ = bim[j]; fre[j] = (short)f2bf(cr * br_ - ci * bi_); fim[j] = (short)f2bf(cr * bi_ + ci * br_); }
        }
        Bf[k] = fre; Bf[4 + k] = fim;
    }
    bf16x8 Cf[4];
#pragma unroll
    for (int ks = 0; ks < 4; ++ks) {
        gfp_t cp = (ks < 2 ? INP(I_CR) : INP(I_CI)) + (((size_t)l * 48 + g) * 16 + fr) * 64 + 32 * (ks & 1) + 8 * fq;
        const float sg = ks < 2 ? 1.0f : -1.0f;
#pragma unroll
        for (int j = 0; j < 8; ++j) Cf[ks][j] = (short)f2bf(sg * cp[j]);
    }
    const float dsk = INP(I_D)[l * 768 + g * 16 + fr];
    __syncthreads();
    if (grp) {
        for (int s = 0; s < 16; ++s) {
            const int b = b0 + s; const int rowb = TPR + b * 4;
            float hr = INP(I_S5RE)[(((size_t)l * DEC_B + b) * 48 + g) * 64 + lane], hi = INP(I_S5IM)[(((size_t)l * DEC_B + b) * 48 + g) * 64 + lane];
            s5_run<true>(Z, ZS, sBU, sH, Bf, Cf, abr, abi, dsk, rowb, g, 4, 0, 1, hr, hi, lane, fr, fq);
            P.out[O_S_S5RE + (((size_t)l * DEC_B + b) * 48 + g) * 64 + lane] = hr;
            P.out[O_S_S5IM + (((size_t)l * DEC_B + b) * 48 + g) * 64 + lane] = hi;
        }
    } else {
        const int b = b0, rowb = b * LP;
        const int it0 = w == 0 ? 0 : 17 + 16 * (w - 1), it1 = 17 + 16 * w;
        float hr = 0.f, hi = 0.f;
        s5_run<false>(Z, ZS, sBU, sH, Bf, Cf, abr, abi, dsk, rowb, g, LP, it0, it1, hr, hi, lane, fr, fq);
        sC[(w * 64 + lane) * 2] = hr; sC[(w * 64 + lane) * 2 + 1] = hi;
        float pr = abr, pi = abi, p16r = 0.f, p16i = 0.f;
#pragma unroll
        for (int q = 0; q < 8; ++q) { cmul(pr, pi, pr, pi); if (q == 3) { p16r = pr; p16i = pi; } }
        float qr = pr, qi = pi; cmul(qr, qi, p16r, p16i);
        __syncthreads();
        float cr_ = 0.f, ci_ = 0.f;
        for (int ww = 0; ww < w; ++ww) {
            const float ar2 = ww == 0 ? qr : pr, ai2 = ww == 0 ? qi : pi;
            cmul(cr_, ci_, ar2, ai2);
            cr_ += sC[(ww * 64 + lane) * 2]; ci_ += sC[(ww * 64 + lane) * 2 + 1];
        }
        hr = cr_; hi = ci_;
        s5_run<true>(Z, ZS, sBU, sH, Bf, Cf, abr, abi, dsk, rowb, g, LP, it0, it1, hr, hi, lane, fr, fq);
        if (w == 7) {
            P.out[O_P_S5RE + (((size_t)l * NB + b) * 48 + g) * 64 + lane] = hr;
            P.out[O_P_S5IM + (((size_t)l * NB + b) * 48 + g) * 64 + lane] = hi;
        }
    }
    asm volatile("s_waitcnt vmcnt(0)" ::: "memory");
    __syncthreads();
    if (threadIdx.x == 0) { __threadfence(); asm volatile("s_waitcnt vmcnt(0)" ::: "memory"); atomicAdd(s5done, 1u); }
}

__device__ __forceinline__ void mixers_phase(const Params& P, int l, int rg, unsigned char* smem, int rep) {
    const Grp G = get_grp(rg);
    const int j1 = G.npb * 8, j2 = j1 + G.npb * 12, j3 = j2 + G.npb * 48, j4 = j3 + (G.hasS ? 1024 : 0), j5 = j4 + (G.hasS ? 48 : 0), j6 = j5 + (G.hasS ? 192 : 0), j7 = j6 + G.npan * 12, NJ = j7 + G.npan * 3;
    unsigned* s5done = (unsigned*)(P.ws + A_CTR) + 32 + (l * NGRP + rg) + rep * 16;
    const unsigned s5total = (unsigned)(G.npb * 48 + (G.hasS ? 48 : 0));
    unsigned* ctr = (unsigned*)(P.ws + A_CTR) + (l * NGRP + rg) + rep * 16;
    int* slot = (int*)(smem + LDS_BYTES - 16);
#ifndef STATIC_JOBS
#define STATIC_JOBS 0
#endif
    for (int jj = blockIdx.x;; jj += gridDim.x) {
        __syncthreads();
#if STATIC_JOBS
        const int j = jj; (void)ctr; (void)slot;
#else
        if (threadIdx.x == 0) *slot = (int)atomicAdd(ctr, 1u);
        __syncthreads();
        const int j = *slot;
#endif
        if (j >= NJ) break;
        int type, sg, idx;
        if (j < j1) { type = 0; sg = 0; idx = j; }
        else if (j < j2) { type = 1; sg = 0; idx = j - j1; }
        else if (j < j3) { type = 2; sg = 0; idx = j - j2; }
        else if (j < j4) { type = 0; sg = 1; idx = j - j3; }
        else if (j < j5) { type = 2; sg = 1; idx = j - j4; }
        else if (j < j6) { type = 1; sg = 1; idx = j - j5; }
        else if (j < j7) { type = 4; sg = 0; idx = j - j6; }
        else { type = 3; sg = 0; idx = j - j7; }
        if (type == 4) {
            using namespace pg8;
            Gemm gg{(const bf16_t*)(P.ws + R_H), (const bf16_t*)(P.ws + W_IN) + (size_t)l * DIN * DM, DM, DM, G.npan, DIN / 256, DM / 64, nullptr};
            SchedOne S1{idx / 12, 21 + idx % 12, DM / 64};
            EpiSigBf E{(bf16_t*)(P.ws + R_Z), DIN};
            gemm_run((LAS unsigned char*)smem, gg, S1, E);
            continue;
        }
        if (type == 3) {
            if (threadIdx.x == 0) {
                unsigned sp = 0;
                while (__hip_atomic_load(s5done, __ATOMIC_RELAXED, __HIP_MEMORY_SCOPE_AGENT) < s5total) { __builtin_amdgcn_s_sleep(8); if (++sp > (1u << 22)) break; }
                __threadfence();
                asm volatile("s_waitcnt vmcnt(0)" ::: "memory");
            }
            __syncthreads();
            using namespace pg8;
            Gemm gg{(const bf16_t*)(P.ws + R_ZS5), (const bf16_t*)(P.ws + W_GLU) + (size_t)l * 768 * 768, 768, 768, G.npan, 3, 12, nullptr};
            SchedOne S1{idx / 3, idx % 3, 12};
            EpiGlu E{(bf16_t*)(P.ws + R_Y), (const bf16_t*)(P.ws + R_ZS5), INP(I_BGLU) + l * 768};
            gemm_run((LAS unsigned char*)smem, gg, S1, E);
            continue;
        }
        if (type == 0) ret_job(P, l, sg, (idx >> 3) + (sg ? 0 : G.pb0), idx & 7, G.g0, smem);
        else if (type == 1) lru_job(P, l, sg, idx, G.g0, G.pb0, smem);
        else s5_job(P, l, sg, idx, G.g0, G.pb0, s5done, smem);
    }
}

__device__ __forceinline__ void run_phase(const Params& P, int ph, unsigned char* smem, int rep) {
#ifndef PHSEL
#define PHSEL -1
#endif
#define PSEL(x) (PHSEL < 0 || PHSEL == (x))
    if (ph == 0) { if (PSEL(10)) phase0(P, smem); return; }
    const int l = (ph - 1) / (10 * NGRP), rg = ((ph - 1) / 10) % NGRP, s = (ph - 1) % 10;
    LAS unsigned char* lds = (LAS unsigned char*)smem;
    unsigned char* ws = P.ws;
    using namespace pg8;
    const int G = gridDim.x, c = blockIdx.x;
    const int npan = rg < 2 ? 25 : 19;
    switch (s) {
    case 0: if (PSEL(0)) { Gemm g{(const bf16_t*)(ws + R_H), (const bf16_t*)(ws + W_IN) + (size_t)l * DIN * DM, DM, DM, npan, 21, DM / 64, nullptr};
              Sched<1> S; S.init(g.nM, g.nN, G, c, g.nt); EpiBf E{(bf16_t*)(ws + R_Z), DIN, (bf16_t*)(ws + R_Z)}; gemm_run(lds, g, S, E); } break;
    case 1: if (PSEL(1)) mixers_phase(P, l, rg, smem, rep); break;
    case 2: if (PSEL(2)) { Gemm g{(const bf16_t*)(ws + R_ZS5), (const bf16_t*)(ws + W_GLU) + (size_t)l * 768 * 768, 768, 768, npan, 3, 12, nullptr};
              Sched<1> S; S.init(g.nM, g.nN, G, c, g.nt); EpiGlu E{(bf16_t*)(ws + R_Y), (const bf16_t*)(ws + R_ZS5), INP(I_BGLU) + l * 768}; gemm_run(lds, g, S, E); } break;
    case 3: if (PSEL(3)) { Gemm g{(const bf16_t*)(ws + R_Y), (const bf16_t*)(ws + W_BR) + (size_t)l * DM * LDY, LDY, LDY, npan, 4, 0, nullptr};
              SchedBr2 S; S.init(g.nM, g.nN, G, c); EpiBranch E{(const bf16_t*)(ws + R_Z) + ZO_GATE, (bf16_t*)(ws + R_M), (bf16_t*)(ws + R_M2)}; gemm_run(lds, g, S, E); } break;
    case 4: if (PSEL(4)) { Gemm g{(const bf16_t*)(ws + R_M), (const bf16_t*)(ws + W_OUT) + (size_t)l * DM * DM, DM, DM, npan, 4, 16, (const bf16_t*)(ws + R_M2)};
              Sched<2> S; S.init(g.nM, g.nN, G, c, g.nt); S.fullk = 1;     EpiBf E{(bf16_t*)(ws + R_F), DM, (bf16_t*)(ws + R_UP)}; gemm_run(lds, g, S, E); } break;
    case 5: if (PSEL(5) && rep == 0) norm_rows(P, 1, l, rg, smem); break;
    case 6: if (PSEL(6)) { Gemm g{(const bf16_t*)(ws + R_H), (const bf16_t*)(ws + W_UP) + (size_t)l * 2 * DFF * DM, DM, DM, npan, 22, 16, nullptr};
              Sched<1> S; S.init(g.nM, g.nN, G, c, g.nt); EpiBf E{(bf16_t*)(ws + R_UP), 2 * DFF, (bf16_t*)(ws + R_UP)}; gemm_run(lds, g, S, E); } break;
    case 7: if (PSEL(7)) ffn_conv_phase(P, l, rg, smem); break;
    case 8: if (PSEL(8)) { Gemm g{(const bf16_t*)(ws + R_FIN), (const bf16_t*)(ws + W_DOWN) + (size_t)l * DM * DFF, DFF, DFF, npan, 4, 44, nullptr};
              Sched<2> S; S.init(g.nM, g.nN, G, c, g.nt); EpiBf E{(bf16_t*)(ws + R_F), DM, (bf16_t*)(ws + R_UP)}; gemm_run(lds, g, S, E); } break;
    default: if (PSEL(9) && rep == 0) norm_rows(P, 2, l, rg, smem); break;
    }
}

#define XB_TMO      128
#define XB_XCNT(j)  (256  + 64 * (j))
#define XB_XSUB(j)  (1280 + 64 * (j))
#define XB_XGEN(j)  (2304 + 64 * (j))
#define XB_TOP      3328
#define XB_TOPGEN   3392
#define XCD_BAR_WORDS 3456
#define XB_SPIN_CAP (1u << 18)

__device__ __forceinline__ unsigned xb_ld(unsigned* p)              { return __hip_atomic_load(p, __ATOMIC_RELAXED, __HIP_MEMORY_SCOPE_AGENT); }
__device__ __forceinline__ unsigned xb_add(unsigned* p, unsigned v) { return __hip_atomic_fetch_add(p, v, __ATOMIC_RELAXED, __HIP_MEMORY_SCOPE_AGENT); }
__device__ __forceinline__ unsigned xb_xcc_id() { return (unsigned)__builtin_amdgcn_s_getreg((3 << 11) | 20) & 0xFu; }
#define XB_SPIN(cond, bar) do { unsigned _sp = 0; while (cond) { __builtin_amdgcn_s_sleep(1); \
    if ((++_sp & 255u) == 0u) { if (xb_ld(&(bar)[XB_TMO])) break; if (_sp > XB_SPIN_CAP) { atomicAdd(&(bar)[XB_TMO], 1u); break; } } } } while (0)

struct XcdBarrier {
    unsigned* bar; unsigned x;
    volatile LAS unsigned* st;
};

__device__ __forceinline__ XcdBarrier xcd_barrier_post(unsigned* bar, volatile LAS unsigned* st) {
    XcdBarrier b; b.bar = bar; b.x = xb_xcc_id(); b.st = st;
    if (threadIdx.x == 0) (void)xb_add(&bar[XB_XCNT(b.x)], 1u);
    return b;
}
__device__ __forceinline__ void xcd_barrier_complete(unsigned* bar, unsigned x, unsigned& nloc, unsigned& nx) {
    const unsigned G = gridDim.x * gridDim.y * gridDim.z;
    unsigned sum, cnt, mine, sp = 0u;
    for (;;) {
        sum = 0u; cnt = 0u; mine = 0u;
#pragma unroll
        for (unsigned j = 0; j < 16; ++j) { const unsigned c = xb_ld(&bar[XB_XCNT(j)]); sum += c; cnt += (c > 0u) ? 1u : 0u; mine = (j == x) ? c : mine; }
        if (sum == G) break;
        __builtin_amdgcn_s_sleep(1);
        if ((++sp & 255u) == 0u) { if (xb_ld(&bar[XB_TMO])) break; if (sp > XB_SPIN_CAP) { atomicAdd(&bar[XB_TMO], 1u); break; } }
    }
    nloc = mine > 0u ? mine : 1u; nx = cnt > 0u ? cnt : 1u;
}

__device__ __forceinline__ void xcd_barrier(const XcdBarrier& b) {
    asm volatile("s_waitcnt vmcnt(0)" ::: "memory");
    __syncthreads();
    if (threadIdx.x == 0) {
        unsigned* bar = b.bar;
        __builtin_amdgcn_s_waitcnt(0);
        unsigned nloc = b.st[0], nx = b.st[1];
        if (nloc == 0u) { xcd_barrier_complete(bar, b.x, nloc, nx); b.st[0] = nloc; b.st[1] = nx; }
        const unsigned old = xb_add(&bar[XB_XSUB(b.x)], 1u);
        const unsigned gen = old / nloc;
        if (old + 1u == (gen + 1u) * nloc) {
            __builtin_amdgcn_fence(__ATOMIC_RELEASE, "agent");
            asm volatile("s_waitcnt vmcnt(0)" ::: "memory");
            const unsigned og = xb_add(&bar[XB_TOP], 1u);
            const unsigned tg = og / nx;
            if (og + 1u == (tg + 1u) * nx) xb_add(&bar[XB_TOPGEN], 1u);
            else XB_SPIN(xb_ld(&bar[XB_TOPGEN]) == tg, bar);
            __builtin_amdgcn_fence(__ATOMIC_ACQUIRE, "agent");
            xb_add(&bar[XB_XGEN(b.x)], 1u);
            asm volatile("s_waitcnt vmcnt(0)" ::: "memory");
        } else {
            XB_SPIN(xb_ld(&bar[XB_XGEN(b.x)]) == gen, bar);
            __builtin_amdgcn_fence(__ATOMIC_ACQUIRE, "agent");
            asm volatile("s_waitcnt vmcnt(0)" ::: "memory");
        }
    }
    __syncthreads();
}


__global__ void __launch_bounds__(512, 2) mega(Params P, int ph_lo, int ph_hi) {
    extern __shared__ __attribute__((aligned(16))) unsigned char smem[];
    unsigned* xst = (unsigned*)(smem + LDS_BYTES - 32);
    if (threadIdx.x == 0) {
        const float** tab = (const float**)(smem + PTAB_OFF);
#pragma unroll
        for (int i = 0; i < N_IN; ++i) tab[i] = P.in[i];
        xst[0] = 0u; xst[1] = 0u;
    }
    __syncthreads();
    XcdBarrier xb = xcd_barrier_post((unsigned*)(P.ws + A_BAR), (volatile LAS unsigned*)xst);
#ifndef DUP_MASK
#define DUP_MASK 0x400
#endif
    for (int ph = ph_lo; ph < ph_hi; ++ph) {
        if (ph > 0 && (ph - 1) % 10 == 2) continue;
        int nrep = 1;
        if (DUP_MASK) { const int sidx = ph == 0 ? 10 : (ph - 1) % 10; if ((DUP_MASK >> sidx) & 1) nrep = 2; }
        for (int rep = 0; rep < nrep; ++rep) {
            run_phase(P, ph, smem, rep);
            if (ph + 1 < ph_hi || rep + 1 < nrep) xcd_barrier(xb);
        }
    }
}


#ifndef DBG_STOP
#define DBG_STOP 0
#endif
#ifndef DBG_OFF
#define DBG_OFF R_Z
#endif
__global__ void dbg_dump(const unsigned char* ws, float* out, size_t n) {
    const bf16_t* src = (const bf16_t*)(ws + DBG_OFF);
    for (size_t i = (size_t)blockIdx.x * blockDim.x + threadIdx.x; i < n; i += (size_t)gridDim.x * blockDim.x) out[i] = bf2f(src[i]);
}

extern "C" void kernel_launch(void* const* d_in, const int* in_sizes, int n_in, void* d_out, int out_size, void* d_ws, size_t ws_size, hipStream_t stream) {
    (void)in_sizes; (void)n_in; (void)out_size;
    if (ws_size < WS_TOTAL) { fprintf(stderr, "workspace too small: %zu < %zu\n", ws_size, (size_t)WS_TOTAL); return; }
    Params p{};
    for (int i = 0; i < N_IN; ++i) p.in[i] = (const float*)d_in[i];
    p.out = (float*)d_out; p.ws = (unsigned char*)d_ws;
    hipFuncSetAttribute((const void*)mega, hipFuncAttributeMaxDynamicSharedMemorySize, LDS_BYTES);
    int dev = 0, cus = 256, per_cu = 1;
    hipGetDevice(&dev);
    hipDeviceGetAttribute(&cus, hipDeviceAttributeMultiprocessorCount, dev);
    hipOccupancyMaxActiveBlocksPerMultiprocessor(&per_cu, mega, 512, LDS_BYTES);
    if (per_cu < 1) per_cu = 1;
    const int grid = cus * 1;
#if COOP
#ifndef PH_HI
#define PH_HI NPHASE
#endif
    hipMemsetAsync((unsigned char*)d_ws + A_BAR, 0, 16384, stream);
    int lo = 0, hi = PH_HI;
    void* args[] = {&p, &lo, &hi};
    hipError_t e = hipLaunchCooperativeKernel((void*)mega, dim3(grid), dim3(512), args, LDS_BYTES, stream);
    if (e != hipSuccess) fprintf(stderr, "cooperative launch failed: %s (grid %d)\n", hipGetErrorString(e), grid);
#else
#if DBG_STOP
    for (int ph = 0; ph < DBG_STOP; ++ph) hipLaunchKernelGGL(mega, dim3(grid), dim3(512), LDS_BYTES, stream, p, ph, ph + 1);
#ifdef DBG_EXTRA
    hipLaunchKernelGGL(mega, dim3(grid), dim3(512), LDS_BYTES, stream, p, DBG_EXTRA, DBG_EXTRA + 1);
#endif
    hipLaunchKernelGGL(dbg_dump, dim3(2048), dim3(256), 0, stream, (const unsigned char*)d_ws, (float*)d_out, (size_t)34873344);
#else
    for (int ph = 0; ph < NPHASE; ++ph) hipLaunchKernelGGL(mega, dim3(grid), dim3(512), LDS_BYTES, stream, p, ph, ph + 1);
#endif
#endif
}
```

```cpp
#include <hip/hip_runtime.h>
#include <hip/hip_cooperative_groups.h>
#include <cstdio>
namespace cg = cooperative_groups;

#define DUP_MASK 0
#ifndef COOP
#define COOP 1
#endif
#ifndef OUTMASK
#define OUTMASK 0x3FFF
#endif
#ifndef OUT_BMAX
#define OUT_BMAX 1000
#endif
#ifndef OUT_L
#define OUT_L 3
#endif
#define OUT_ON(k) (((OUTMASK >> (k)) & 1) && ((OUT_L >> l) & 1))
#ifndef DMA_AUX
#define DMA_AUX 17
#endif

#define LAS __attribute__((address_space(3)))
typedef unsigned short bf16_t;
typedef short bf16x8 __attribute__((ext_vector_type(8)));
typedef float f32x4 __attribute__((ext_vector_type(4)));
typedef unsigned u32x4 __attribute__((ext_vector_type(4)));
typedef unsigned u32x2 __attribute__((ext_vector_type(2)));

constexpr int DM = 1024, NB = 8, SEQ = 2048, LP = 2064, DEC_B = 128, DEC_S = 4;
constexpr int TPR = NB * LP;
constexpr int TT = TPR + DEC_B * DEC_S;
constexpr int TPAD = 17152;
constexpr int DIN = 8448, DFF = 2816;
constexpr int ZO_UA = 0, ZO_XB = 768, ZO_GB = 1536, ZO_Q = 2304, ZO_K = 2816, ZO_V = 3328, ZO_GC = 4352, ZO_GATE = 5376;
constexpr int LDY = 2560;
constexpr float EPS = 1e-6f;
constexpr int LDS_BYTES = 143360;

enum { I_XP = 0, I_XS, I_S5RE, I_S5IM, I_LRUH, I_LRUC, I_RET, I_FFNC, I_META, I_GPREMIX, I_GPOSTMIX, I_GPREFFN, I_GPOSTFFN, I_WIN,
       I_AR, I_AI, I_LS, I_BR, I_BI, I_CR, I_CI, I_D, I_WGLU, I_BGLU, I_LCW, I_LCB, I_LWA, I_LBA, I_LWX, I_LBX, I_LAM, I_RNG,
       I_WBA, I_WBB, I_WBC, I_WOUT, I_WUP, I_FCW, I_FCB, I_WDOWN, N_IN };

constexpr size_t O_YP = 0;
constexpr size_t O_YS = O_YP + (size_t)NB * SEQ * DM;
constexpr size_t O_P_S5RE = O_YS + (size_t)DEC_B * DEC_S * DM;
constexpr size_t O_P_S5IM = O_P_S5RE + 2 * NB * 48 * 64;
constexpr size_t O_P_LRUH = O_P_S5IM + 2 * NB * 48 * 64;
constexpr size_t O_P_LRUC = O_P_LRUH + 2 * NB * 768;
constexpr size_t O_P_RET = O_P_LRUC + 2 * NB * 3 * 768;
constexpr size_t O_P_FFNC = O_P_RET + (size_t)2 * NB * 8 * 64 * 128;
constexpr size_t O_S_S5RE = O_P_FFNC + 2 * NB * 2 * DFF;
constexpr size_t O_S_S5IM = O_S_S5RE + 2 * DEC_B * 48 * 64;
constexpr size_t O_S_LRUH = O_S_S5IM + 2 * DEC_B * 48 * 64;
constexpr size_t O_S_LRUC = O_S_LRUH + 2 * DEC_B * 768;
constexpr size_t O_S_RET = O_S_LRUC + 2 * DEC_B * 3 * 768;
constexpr size_t O_S_FFNC = O_S_RET + (size_t)2 * DEC_B * 8 * 64 * 128;

constexpr size_t al256(size_t x) { return (x + 255) & ~(size_t)255; }
constexpr size_t W_IN = 0;
constexpr size_t W_GLU = W_IN + (size_t)2 * DIN * DM * 2;
constexpr size_t W_BR = W_GLU + (size_t)2 * 768 * 768 * 2;
constexpr size_t W_OUT = W_BR + (size_t)2 * DM * LDY * 2;
constexpr size_t W_UP = W_OUT + (size_t)2 * DM * DM * 2;
constexpr size_t W_DOWN = W_UP + (size_t)2 * 2 * DFF * DM * 2;
constexpr size_t A_X = W_DOWN + (size_t)2 * DM * DFF * 2;
constexpr int GR = 6400;
constexpr size_t R_Z = A_X + (size_t)TPAD * DM * 4;
constexpr size_t R_ZS5 = R_Z + (size_t)GR * DIN * 2;
constexpr size_t R_Y = R_ZS5 + (size_t)GR * 768 * 2;
constexpr size_t R_M = R_Y + (size_t)GR * LDY * 2;
constexpr size_t R_END = R_M + (size_t)GR * DM * 2;
constexpr size_t R_H = R_M;
constexpr size_t R_F = R_Z;
constexpr size_t R_UP = R_Z + (size_t)GR * DM * 4;
constexpr size_t R_FIN = R_ZS5;
static_assert(R_UP + (size_t)GR * 2 * DFF * 2 <= R_ZS5, "UP inside Z");
static_assert(R_FIN + (size_t)GR * DFF * 2 <= R_M, "FIN inside ZS5|Y");
constexpr size_t A_ROPE = R_END;
constexpr size_t A_CTR = al256(A_ROPE + (size_t)2068 * 64 * 4);
constexpr size_t A_BAR = A_CTR + 4096;
constexpr size_t WS_TOTAL = A_BAR + 16384;
constexpr size_t R_M2 = A_X + (size_t)40 * 1024 * 1024;
static_assert(A_X + (size_t)TPAD * DM * 2 <= R_M2 && R_M2 + (size_t)GR * DM * 2 <= R_Z, "M2 inside the freed half of the X reservation");
constexpr int NGRP = 3;
constexpr int NPHASE = 1 + 2 * NGRP * 10;

struct Grp { int g0, nrows, npan, pb0, npb, hasS; };
__device__ __forceinline__ Grp get_grp(int g) {
    Grp r; r.g0 = g * 6192; r.nrows = g < 2 ? 6192 : 4640; r.npan = g < 2 ? 25 : 19; r.pb0 = g * 3; r.npb = g < 2 ? 3 : 2; r.hasS = g == 2; return r;
}

struct Params {
    const float* in[N_IN];
    float* out;
    unsigned char* ws;
};


constexpr int PTAB_OFF = 142336;
typedef const __attribute__((address_space(1))) float* gfp_t;
typedef const __attribute__((address_space(1))) f32x4* gf4p_t;
__device__ __forceinline__ gfp_t ldin(const unsigned char* smem, int i) {
    const unsigned long long v = ((const unsigned long long*)(smem + PTAB_OFF))[i];
    const unsigned lo = __builtin_amdgcn_readfirstlane((unsigned)v), hi = __builtin_amdgcn_readfirstlane((unsigned)(v >> 32));
    return (gfp_t)(((unsigned long long)hi << 32) | lo);
}
#define INP(i) ldin(smem, (i))
__device__ __forceinline__ int otid() { int t = threadIdx.x; asm volatile("" : "+v"(t)); return t; }

__device__ __forceinline__ float bf2f(bf16_t b) { return __uint_as_float(((unsigned)b) << 16); }
__device__ __forceinline__ bf16_t f2bf(float f) { unsigned u = __float_as_uint(f); u += 0x7FFFu + ((u >> 16) & 1u); return (bf16_t)(u >> 16); }
__device__ __forceinline__ unsigned pk2(float lo, float hi) { return (unsigned)f2bf(lo) | ((unsigned)f2bf(hi) << 16); }
__device__ __forceinline__ float sigm(float x) { return __builtin_amdgcn_rcpf(1.0f + __expf(-x)); }
__device__ __forceinline__ float gelu_t(float x) { const float v = 1.5957691216f * (x + 0.044715f * x * x * x); return x * __builtin_amdgcn_rcpf(1.0f + __expf(-v)); }
__device__ __forceinline__ void lds_wait() { asm volatile("s_waitcnt lgkmcnt(0)" ::: "memory"); __builtin_amdgcn_wave_barrier(); }
__device__ __forceinline__ f32x4 mfma16(bf16x8 a, bf16x8 b, f32x4 c) { return __builtin_amdgcn_mfma_f32_16x16x32_bf16(a, b, c, 0, 0, 0); }

namespace pg8 {
constexpr int BM = 256, BK = 64, HALF = 128, HTB = HALF * BK * 2, STAGE_BYTES = 8 * HTB, NXCD = 8, WGM = 8;
__device__ __forceinline__ int lds_byte(int r, int c) { const int st = (r >> 4) * 2 + (c >> 5), rr = r & 15, cc = c & 31, ob = rr * 64 + cc * 2; return st * 1024 + (ob ^ (((ob >> 9) & 1) << 5)); }
__device__ __forceinline__ void stage_rc(int b, int& R, int& C) { const int st = b / 1024, sb = b % 1024, swz = sb ^ (((sb >> 9) & 1) << 5); R = (st >> 1) * 16 + swz / 64; C = (st & 1) * 32 + (swz % 64) / 2; }

struct Unit { int pm, pn, br; };
struct Gemm { const bf16_t* A; const bf16_t* Bt; int lda, ldb, nM, nN, nt; const bf16_t* A2; };

struct SchedOne {
    int pm, pn, nt0;
    __device__ bool next(int i, Unit& u) const { if (i != 0) return false; u.pm = pm; u.pn = pn; u.br = 0; return true; }
    __device__ __forceinline__ void kr(const Unit&, size_t& koffB, int& nt) const { koffB = 0; nt = nt0; }
};
template <int NBR> struct Sched {
    int nM, nN, nwg, G, c, nt0, fullk;
    __device__ void init(int nM_, int nN_, int G_, int c_, int nt_) { nM = nM_; nN = nN_; nwg = nM * nN; G = G_; c = c_; nt0 = nt_; fullk = 0; }
    __device__ bool next(int i, Unit& u) const {
        int wgid;
        if (NBR == 2) {
            const long L = (long)i * G + c; if (L >= 2 * (long)nwg) return false;
            u.br = (int)(L / nwg); wgid = (int)(L - (long)u.br * nwg);
        } else {
            const int ti = i / NBR; u.br = i - ti * NBR;
            const long L = (long)ti * G + c; if (L >= nwg) return false;
            wgid = (int)L;
        } { const int q = nwg / NXCD, r = nwg % NXCD, xcd = wgid % NXCD, off = wgid / NXCD; wgid = (xcd < r ? xcd * (q + 1) : r * (q + 1) + (xcd - r) * q) + off; }
        const int nig = WGM * nN, gid = wgid / nig, fm = gid * WGM, gsz = (nM - fm) < WGM ? (nM - fm) : WGM;
        u.pm = fm + ((wgid % nig) % gsz); u.pn = (wgid % nig) / gsz; return true;
    }
    __device__ __forceinline__ void kr(const Unit& u, size_t& koffB, int& nt) const {
        if (NBR == 1) { koffB = 0; nt = nt0; }
        else if (NBR == 2) { if (fullk) { nt = nt0; koffB = 0; } else { nt = nt0 >> 1; koffB = (size_t)u.br * (size_t)nt * 128; } }
        else { koffB = (size_t)u.br * 1536; nt = (u.br == 2) ? 16 : 12; }
    }
};

struct SchedBr2 {
    int nM, nN, nwg, G, c;
    __device__ void init(int nM_, int nN_, int G_, int c_) { nM = nM_; nN = nN_; nwg = nM * nN; G = G_; c = c_; }
    __device__ bool next(int i, Unit& u) const {
        const int ti = i / 3, b = i - ti * 3;
        const long L = (long)ti * G + c; if (L >= 2 * (long)nwg) return false;
        const int half = (int)(L / nwg); int wgid = (int)(L - (long)half * nwg);
        { const int q = nwg / NXCD, r = nwg % NXCD, xcd = wgid % NXCD, off = wgid / NXCD; wgid = (xcd < r ? xcd * (q + 1) : r * (q + 1) + (xcd - r) * q) + off; }
        const int nig = WGM * nN, gid = wgid / nig, fm = gid * WGM, gsz = (nM - fm) < WGM ? (nM - fm) : WGM;
        u.pm = fm + ((wgid % nig) % gsz); u.pn = (wgid % nig) / gsz; u.br = b + 4 * half; return true;
    }
    __device__ __forceinline__ void kr(const Unit& u, size_t& koffB, int& nt) const {
        const int b = u.br & 3, half = u.br >> 2; nt = (b == 2) ? 8 : 6; koffB = (size_t)b * 1536 + (size_t)half * nt * 128;
    }
};
__device__ __forceinline__ unsigned cvt_pk_bf16(float lo, float hi) { unsigned r; asm volatile("s_nop 1\n\tv_cvt_pk_bf16_f32 %0, %1, %2" : "=v"(r) : "v"(lo), "v"(hi)); return r; }

template <class Epi, class SchedT>
__device__ __forceinline__ void gemm_phase(LAS unsigned char* lds, const Gemm g, const SchedT& S, const Epi& E) {
    const int tid = otid(), wid = __builtin_amdgcn_readfirstlane(tid >> 6), lane = tid & 63, wr = wid >> 2, wc = wid & 3, fr = lane & 15, fq = lane >> 4;
    unsigned voffA[2], voffB[2];
#pragma unroll
    for (int i = 0; i < 2; ++i) { int R, C; stage_rc(tid * 16 + i * 8192, R, C);
        voffA[i] = (unsigned)(R * g.lda + C) * 2u; voffB[i] = (unsigned)(R * g.ldb + C) * 2u; }
    const size_t kstep = (size_t)(BK * 2);
    const size_t hstepA = (size_t)HALF * g.lda * 2, hstepB = (size_t)HALF * g.ldb * 2;
    const size_t tstepA = 2 * hstepA, tstepB = 2 * hstepB;
    const unsigned ldsw = (unsigned)wid * 1024u;
    const int aoff = lds_byte(wr * 64 + fr, fq * 8), boff = lds_byte(wc * 32 + fr, fq * 8);
#define PG8_SA(b, h) (((b) * 2 + (h)) * HTB)
#define PG8_SB(b, h) ((4 + (b) * 2 + (h)) * HTB)
#define PG8_STAGE(bufoff, gbase, voff) do { _Pragma("unroll") for (int _i = 0; _i < 2; ++_i) \
        __builtin_amdgcn_global_load_lds((const unsigned*)((const char*)(gbase) + (voff)[_i]), (LAS unsigned*)(lds + (bufoff) + ldsw + _i * 8192), 16, 0, DMA_AUX); } while (0)
#define PG8_LDA(dst, b, h) do { _Pragma("unroll") for (int m = 0; m < 4; ++m) _Pragma("unroll") for (int k = 0; k < 2; ++k) dst[m][k] = *(const LAS bf16x8*)(lds + PG8_SA(b, h) + aoff + m * 2048 + k * 1024); } while (0)
#define PG8_LDB(dst, b, h) do { _Pragma("unroll") for (int n = 0; n < 2; ++n) _Pragma("unroll") for (int k = 0; k < 2; ++k) dst[n][k] = *(const LAS bf16x8*)(lds + PG8_SB(b, h) + boff + n * 2048 + k * 1024); } while (0)
#define PG8_MMA(ai, bj, At, Bt) do { __builtin_amdgcn_s_setprio(1); _Pragma("unroll") for (int m = 0; m < 4; ++m) _Pragma("unroll") for (int n = 0; n < 2; ++n) _Pragma("unroll") for (int k = 0; k < 2; ++k) \
        acc[ai][bj][m][n] = __builtin_amdgcn_mfma_f32_16x16x32_bf16(Bt[n][k], At[m][k], acc[ai][bj][m][n], 0, 0, 0); __builtin_amdgcn_s_setprio(0); } while (0)
#define PG8_WAIT_V(n) asm volatile("s_waitcnt vmcnt(" #n ")" ::: "memory")
#define PG8_WAIT_L(n) asm volatile("s_waitcnt lgkmcnt(" #n ")" ::: "memory")
#define PG8_BAR __builtin_amdgcn_s_barrier()
#define PG8_SCHED __builtin_amdgcn_sched_barrier(0)
    Unit cur, nxt; int ui = 0;
    if (!S.next(0, cur)) return;
    f32x4 acc[2][2][4][2];
#pragma unroll
    for (int a = 0; a < 2; ++a)
#pragma unroll
        for (int b = 0; b < 2; ++b)
#pragma unroll
            for (int m = 0; m < 4; ++m)
#pragma unroll
                for (int n = 0; n < 2; ++n) acc[a][b][m][n] = (f32x4){0.f, 0.f, 0.f, 0.f};
    bf16x8 At[4][2], B0[2][2], B1[2][2];
    size_t koc; int ntc; S.kr(cur, koc, ntc);
    const char* cA = (const char*)((g.A2 && cur.br) ? g.A2 : g.A) + (size_t)cur.pm * tstepA + koc; const char* cB = (const char*)g.Bt + (size_t)cur.pn * tstepB + koc;
    PG8_STAGE(PG8_SB(0, 0), cB, voffB); PG8_STAGE(PG8_SA(0, 0), cA, voffA); PG8_STAGE(PG8_SB(0, 1), cB + hstepB, voffB); PG8_STAGE(PG8_SA(0, 1), cA + hstepA, voffA);
    if (wr == 1) PG8_BAR;
    PG8_WAIT_V(4); PG8_BAR;
    PG8_STAGE(PG8_SB(1, 0), cB + kstep, voffB); PG8_STAGE(PG8_SA(1, 0), cA + kstep, voffA); PG8_STAGE(PG8_SB(1, 1), cB + hstepB + kstep, voffB);
    PG8_WAIT_V(6); PG8_BAR;
    for (;;) {
        const bool has_next = S.next(ui + 1, nxt);
        size_t kon = 0; int ntn = ntc; if (has_next) S.kr(nxt, kon, ntn);
        const char* nA = has_next ? (const char*)((g.A2 && nxt.br) ? g.A2 : g.A) + (size_t)nxt.pm * tstepA + kon : cA; const char* nB = has_next ? (const char*)g.Bt + (size_t)nxt.pn * tstepB + kon : cB;
        for (int t = 0; t < ntc; t += 2) {
            const bool last = (t == ntc - 2);
            const char* a1 = cA + (size_t)(t + 1) * kstep;
            const char* a2 = last ? nA : cA + (size_t)(t + 2) * kstep; const char* b2 = last ? nB : cB + (size_t)(t + 2) * kstep;
            const char* a3 = a2 + kstep; const char* b3 = b2 + kstep;
            PG8_LDB(B0, 0, 0); PG8_SCHED; PG8_LDA(At, 0, 0); PG8_STAGE(PG8_SA(1, 1), a1 + hstepA, voffA);
            PG8_WAIT_L(8); PG8_BAR; PG8_WAIT_L(0); PG8_MMA(0, 0, At, B0); PG8_BAR; PG8_SCHED;
            PG8_LDB(B1, 0, 1); PG8_STAGE(PG8_SB(0, 0), b2, voffB);
            PG8_BAR; PG8_WAIT_L(0); PG8_MMA(0, 1, At, B1); PG8_BAR;
            PG8_LDA(At, 0, 1); PG8_STAGE(PG8_SA(0, 0), a2, voffA);
            PG8_BAR; PG8_WAIT_L(0); PG8_MMA(1, 0, At, B0); PG8_BAR; PG8_SCHED;
            PG8_STAGE(PG8_SB(0, 1), b2 + hstepB, voffB);
            PG8_WAIT_V(6); PG8_BAR; PG8_MMA(1, 1, At, B1); PG8_BAR;
            PG8_LDB(B0, 1, 0); PG8_SCHED; PG8_LDA(At, 1, 0); PG8_STAGE(PG8_SA(0, 1), a2 + hstepA, voffA);
            PG8_WAIT_L(8); PG8_BAR; PG8_WAIT_L(0); PG8_MMA(0, 0, At, B0); PG8_BAR; PG8_SCHED;
            PG8_LDB(B1, 1, 1); PG8_STAGE(PG8_SB(1, 0), b3, voffB);
            PG8_BAR; PG8_WAIT_L(0); PG8_MMA(0, 1, At, B1); PG8_BAR;
            PG8_LDA(At, 1, 1); PG8_STAGE(PG8_SA(1, 0), a3, voffA);
            PG8_BAR; PG8_WAIT_L(0); PG8_MMA(1, 0, At, B0); PG8_BAR; PG8_SCHED;
            PG8_STAGE(PG8_SB(1, 1), b3 + hstepB, voffB);
            PG8_WAIT_V(6); PG8_BAR; PG8_MMA(1, 1, At, B1); PG8_BAR;
        }
        E(acc, cur, wr, wc, fr, fq);
        if (!has_next) break;
#pragma unroll
        for (int a = 0; a < 2; ++a)
#pragma unroll
            for (int b = 0; b < 2; ++b)
#pragma unroll
                for (int m = 0; m < 4; ++m)
#pragma unroll
                    for (int n = 0; n < 2; ++n) acc[a][b][m][n] = (f32x4){0.f, 0.f, 0.f, 0.f};
        cur = nxt; cA = nA; cB = nB; ntc = ntn; ++ui;
    }
    PG8_WAIT_V(0);
    if (wr == 0) PG8_BAR;
    PG8_BAR;
#undef PG8_SA
#undef PG8_SB
#undef PG8_STAGE
#undef PG8_LDA
#undef PG8_LDB
#undef PG8_MMA
#undef PG8_WAIT_V
#undef PG8_WAIT_L
#undef PG8_BAR
#undef PG8_SCHED
}

struct EpiBf {
    bf16_t* O; int ldc; bf16_t* O2;
    __device__ __forceinline__ void operator()(const f32x4 (&acc)[2][2][4][2], const Unit& u, int wr, int wc, int fr, int fq) const {
        const int row0 = u.pm * BM + wr * 64 + fr, col0 = u.pn * BM + wc * 32 + 4 * fq;
        bf16_t* O = u.br ? this->O2 : this->O;
#pragma unroll
        for (int ai = 0; ai < 2; ++ai)
#pragma unroll
            for (int m = 0; m < 4; ++m) { bf16_t* rowp = O + (size_t)(row0 + ai * HALF + m * 16) * ldc + col0;
#pragma unroll
                for (int bj = 0; bj < 2; ++bj)
#pragma unroll
                    for (int n = 0; n < 2; ++n) { const f32x4 v = acc[ai][bj][m][n]; u32x2 o; o.x = cvt_pk_bf16(v[0], v[1]); o.y = cvt_pk_bf16(v[2], v[3]); *(u32x2*)(rowp + bj * HALF + n * 16) = o; } }
    }
};
struct EpiSigBf {
    bf16_t* O; int ldc;
    __device__ __forceinline__ void operator()(const f32x4 (&acc)[2][2][4][2], const Unit& u, int wr, int wc, int fr, int fq) const {
        const int row0 = u.pm * BM + wr * 64 + fr, col0 = u.pn * BM + wc * 32 + 4 * fq;
#pragma unroll
        for (int ai = 0; ai < 2; ++ai)
#pragma unroll
            for (int m = 0; m < 4; ++m) { bf16_t* rowp = O + (size_t)(row0 + ai * HALF + m * 16) * ldc + col0;
#pragma unroll
                for (int bj = 0; bj < 2; ++bj)
#pragma unroll
                    for (int n = 0; n < 2; ++n) { const f32x4 v = acc[ai][bj][m][n]; u32x2 o; o.x = cvt_pk_bf16(sigm(v[0]), sigm(v[1])); o.y = cvt_pk_bf16(sigm(v[2]), sigm(v[3])); *(u32x2*)(rowp + bj * HALF + n * 16) = o; } }
    }
};
struct EpiF32 {
    float* C; int ldc; float* C2;
    __device__ __forceinline__ void operator()(const f32x4 (&acc)[2][2][4][2], const Unit& u, int wr, int wc, int fr, int fq) const {
        const int row0 = u.pm * BM + wr * 64 + fr, col0 = u.pn * BM + wc * 32 + 4 * fq;
        float* C = u.br ? this->C2 : this->C;
#pragma unroll
        for (int ai = 0; ai < 2; ++ai)
#pragma unroll
            for (int m = 0; m < 4; ++m) { float* rowp = C + (size_t)(row0 + ai * HALF + m * 16) * ldc + col0;
#pragma unroll
                for (int bj = 0; bj < 2; ++bj)
#pragma unroll
                    for (int n = 0; n < 2; ++n) *(f32x4*)(rowp + bj * HALF + n * 16) = acc[ai][bj][m][n]; }
    }
};
struct EpiGlu {
    bf16_t* Y; const bf16_t* Z; gfp_t bias;
    __device__ __forceinline__ void operator()(const f32x4 (&acc)[2][2][4][2], const Unit& u, int wr, int wc, int fr, int fq) const {
        const int row0 = u.pm * BM + wr * 64 + fr, col0 = u.pn * BM + wc * 32 + 4 * fq;
#pragma unroll
        for (int ai = 0; ai < 2; ++ai)
#pragma unroll
            for (int m = 0; m < 4; ++m) { const size_t r = (size_t)(row0 + ai * HALF + m * 16);
#pragma unroll
                for (int bj = 0; bj < 2; ++bj)
#pragma unroll
                    for (int n = 0; n < 2; ++n) { const int c = col0 + bj * HALF + n * 16; const f32x4 v = acc[ai][bj][m][n];
                        const u32x2 zz = *(const u32x2*)(Z + r * 768 + c); const f32x4 bb = *(const f32x4*)(bias + c);
                        const float z0 = __uint_as_float(zz.x << 16), z1 = __uint_as_float(zz.x & 0xffff0000u), z2 = __uint_as_float(zz.y << 16), z3 = __uint_as_float(zz.y & 0xffff0000u);
                        u32x2 o; o.x = cvt_pk_bf16(z0 * sigm(v[0] + bb[0]), z1 * sigm(v[1] + bb[1])); o.y = cvt_pk_bf16(z2 * sigm(v[2] + bb[2]), z3 * sigm(v[3] + bb[3]));
                        *(u32x2*)(Y + r * LDY + c) = o; } }
    }
};
struct EpiBranch {
    const bf16_t* Zg; bf16_t* Mo; bf16_t* Mo2;
    __device__ __forceinline__ void operator()(const f32x4 (&acc)[2][2][4][2], const Unit& u, int wr, int wc, int fr, int fq) const {
        const int row0 = u.pm * BM + wr * 64 + fr, col0 = u.pn * BM + wc * 32 + 4 * fq; const int br = u.br & 3; bf16_t* Mo = (u.br >> 2) ? this->Mo2 : this->Mo;
#pragma unroll
        for (int ai = 0; ai < 2; ++ai)
#pragma unroll
            for (int m = 0; m < 4; ++m) { const size_t r = (size_t)(row0 + ai * HALF + m * 16);
#pragma unroll
                for (int bj = 0; bj < 2; ++bj)
#pragma unroll
                    for (int n = 0; n < 2; ++n) { const int c = col0 + bj * HALF + n * 16; const f32x4 v = acc[ai][bj][m][n];
                        const u32x2 gg = *(const u32x2*)(Zg + r * DIN + br * 1024 + c);
                        f32x4 t; t[0] = v[0] * __uint_as_float(gg.x << 16); t[1] = v[1] * __uint_as_float(gg.x & 0xffff0000u);
                        t[2] = v[2] * __uint_as_float(gg.y << 16); t[3] = v[3] * __uint_as_float(gg.y & 0xffff0000u);
                        bf16_t* mp = Mo + r * DM + c;
                        if (br != 0) { u32x2 p; p.x = __hip_atomic_load((const unsigned*)mp, __ATOMIC_RELAXED, __HIP_MEMORY_SCOPE_AGENT); p.y = __hip_atomic_load((const unsigned*)mp + 1, __ATOMIC_RELAXED, __HIP_MEMORY_SCOPE_AGENT); t[0] += __uint_as_float(p.x << 16); t[1] += __uint_as_float(p.x & 0xffff0000u); t[2] += __uint_as_float(p.y << 16); t[3] += __uint_as_float(p.y & 0xffff0000u); }
                        u32x2 o; o.x = cvt_pk_bf16(t[0], t[1]); o.y = cvt_pk_bf16(t[2], t[3]); *(u32x2*)mp = o; } }
    }
};

#ifndef GEMM_SIMPLE
#define GEMM_SIMPLE 0
#endif
template <class Epi, class SchedT>
__device__ __forceinline__ void gemm_simple(LAS unsigned char* lds, const Gemm g, const SchedT& S, const Epi& E) {
    const int tid = otid(), wid = __builtin_amdgcn_readfirstlane(tid >> 6), lane = tid & 63, wr = wid >> 2, wc = wid & 3, fr = lane & 15, fq = lane >> 4;
    unsigned voffA[2], voffB[2];
#pragma unroll
    for (int i = 0; i < 2; ++i) { int R, C; stage_rc(tid * 16 + i * 8192, R, C);
        voffA[i] = (unsigned)(R * g.lda + C) * 2u; voffB[i] = (unsigned)(R * g.ldb + C) * 2u; }
    const size_t hstepA = (size_t)HALF * g.lda * 2, hstepB = (size_t)HALF * g.ldb * 2;
    const int aoff = lds_byte(wr * 64 + fr, fq * 8), boff = lds_byte(wc * 32 + fr, fq * 8);
    Unit cur;
    for (int ui = 0; S.next(ui, cur); ++ui) {
        size_t koc; int ntc; S.kr(cur, koc, ntc);
        const char* cA = (const char*)((g.A2 && cur.br) ? g.A2 : g.A) + (size_t)cur.pm * 2 * hstepA + koc; const char* cB = (const char*)g.Bt + (size_t)cur.pn * 2 * hstepB + koc;
        f32x4 acc[2][2][4][2];
#pragma unroll
        for (int a = 0; a < 2; ++a)
#pragma unroll
            for (int b = 0; b < 2; ++b)
#pragma unroll
                for (int m = 0; m < 4; ++m)
#pragma unroll
                    for (int n = 0; n < 2; ++n) acc[a][b][m][n] = (f32x4){0.f, 0.f, 0.f, 0.f};
        for (int t = 0; t < ntc; ++t) {
            u32x4 ra[2][2], rb[2][2];
#pragma unroll
            for (int h = 0; h < 2; ++h)
#pragma unroll
                for (int i = 0; i < 2; ++i) { ra[h][i] = *(const u32x4*)(cA + (size_t)t * 128 + h * hstepA + voffA[i]); rb[h][i] = *(const u32x4*)(cB + (size_t)t * 128 + h * hstepB + voffB[i]); }
            __syncthreads();
#pragma unroll
            for (int h = 0; h < 2; ++h)
#pragma unroll
                for (int i = 0; i < 2; ++i) { *(LAS u32x4*)(lds + h * HTB + tid * 16 + i * 8192) = ra[h][i]; *(LAS u32x4*)(lds + (4 + h) * HTB + tid * 16 + i * 8192) = rb[h][i]; }
            __syncthreads();
#pragma unroll
            for (int ai = 0; ai < 2; ++ai) {
                bf16x8 At[4][2];
#pragma unroll
                for (int m = 0; m < 4; ++m)
#pragma unroll
                    for (int k = 0; k < 2; ++k) At[m][k] = *(const LAS bf16x8*)(lds + ai * HTB + aoff + m * 2048 + k * 1024);
#pragma unroll
                for (int bj = 0; bj < 2; ++bj) {
                    bf16x8 Bf[2][2];
#pragma unroll
                    for (int n = 0; n < 2; ++n)
#pragma unroll
                        for (int k = 0; k < 2; ++k) Bf[n][k] = *(const LAS bf16x8*)(lds + (4 + bj) * HTB + boff + n * 2048 + k * 1024);
#pragma unroll
                    for (int m = 0; m < 4; ++m)
#pragma unroll
                        for (int n = 0; n < 2; ++n)
#pragma unroll
                            for (int k = 0; k < 2; ++k) acc[ai][bj][m][n] = __builtin_amdgcn_mfma_f32_16x16x32_bf16(Bf[n][k], At[m][k], acc[ai][bj][m][n], 0, 0, 0);
                }
            }
        }
        E(acc, cur, wr, wc, fr, fq);
    }
    __syncthreads();
}
template <class Epi, class SchedT>
__device__ __forceinline__ void gemm_run(LAS unsigned char* lds, const Gemm g, const SchedT& S, const Epi& E) {
#if GEMM_SIMPLE
    gemm_simple(lds, g, S, E);
#else
    gemm_phase(lds, g, S, E);
#endif
}
}

__device__ __forceinline__ void transpose_tile(gfp_t W, int N, bf16_t* __restrict__ dst, int ldd, int koff, int tk, int tn, float* tile) {
    const int tid = otid(), a = tid >> 6, bq = tid & 63;
    __syncthreads();
#pragma unroll
    for (int i = 0; i < 8; ++i) { const int k = a + 8 * i; tile[k * 65 + bq] = W[(size_t)(tk * 64 + k) * N + tn * 64 + bq]; }
    __syncthreads();
#pragma unroll
    for (int i = 0; i < 8; ++i) { const int n = a + 8 * i; dst[(size_t)(tn * 64 + n) * ldd + koff + tk * 64 + bq] = f2bf(tile[bq * 65 + n]); }
}

__device__ __forceinline__ f32x4 ldx4(const bf16_t* p) { const u32x2 v = *(const u32x2*)p; f32x4 r; r[0] = __uint_as_float(v.x << 16); r[1] = __uint_as_float(v.x & 0xffff0000u); r[2] = __uint_as_float(v.y << 16); r[3] = __uint_as_float(v.y & 0xffff0000u); return r; }
__device__ __forceinline__ void stx4(bf16_t* p, const f32x4 v) { u32x2 o; o.x = pk2(v[0], v[1]); o.y = pk2(v[2], v[3]); *(u32x2*)p = o; }
__device__ __forceinline__ float row16_sum(float v) {
    v += __builtin_bit_cast(float, __builtin_amdgcn_update_dpp(0, __builtin_bit_cast(int, v), 0xB1, 0xF, 0xF, true));
    v += __builtin_bit_cast(float, __builtin_amdgcn_update_dpp(0, __builtin_bit_cast(int, v), 0x4E, 0xF, 0xF, true));
    v += __builtin_bit_cast(float, __builtin_amdgcn_update_dpp(0, __builtin_bit_cast(int, v), 0x141, 0xF, 0xF, true));
    v += __builtin_bit_cast(float, __builtin_amdgcn_update_dpp(0, __builtin_bit_cast(int, v), 0x140, 0xF, 0xF, true));
    return v;
}
__device__ __forceinline__ float wave_sum(float v) {
    v = row16_sum(v);
    const int iv = __builtin_bit_cast(int, v);
    const float a = __builtin_bit_cast(float, __builtin_amdgcn_readlane(iv, 0)), b = __builtin_bit_cast(float, __builtin_amdgcn_readlane(iv, 16));
    const float c = __builtin_bit_cast(float, __builtin_amdgcn_readlane(iv, 32)), d = __builtin_bit_cast(float, __builtin_amdgcn_readlane(iv, 48));
    return (a + b) + (c + d);
}
__device__ __forceinline__ void rms_store_r(const f32x4 (&xv)[4], const f32x4 (&gr)[4], bf16_t* dst, int lane) {
    float ss = 0.f;
#pragma unroll
    for (int i = 0; i < 4; ++i) ss += xv[i][0] * xv[i][0] + xv[i][1] * xv[i][1] + xv[i][2] * xv[i][2] + xv[i][3] * xv[i][3];
    ss = wave_sum(ss);
    const float rs = rsqrtf(ss * (1.0f / DM) + EPS);
#pragma unroll
    for (int i = 0; i < 4; ++i) { const int c = lane * 4 + 256 * i; const f32x4 hv = xv[i] * gr[i] * rs;
        u32x2 o; o.x = pk2(hv[0], hv[1]); o.y = pk2(hv[2], hv[3]); *(u32x2*)(dst + c) = o; }
}
__device__ __forceinline__ void rms_store(const f32x4 (&xv)[4], gfp_t g, bf16_t* dst, int lane) {
    float ss = 0.f;
#pragma unroll
    for (int i = 0; i < 4; ++i) ss += xv[i][0] * xv[i][0] + xv[i][1] * xv[i][1] + xv[i][2] * xv[i][2] + xv[i][3] * xv[i][3];
    ss = wave_sum(ss);
    const float rs = rsqrtf(ss * (1.0f / DM) + EPS);
#pragma unroll
    for (int i = 0; i < 4; ++i) { const int c = lane * 4 + 256 * i; const f32x4 gn = *(const f32x4*)(g + c); const f32x4 hv = xv[i] * gn * rs;
        u32x2 o; o.x = pk2(hv[0], hv[1]); o.y = pk2(hv[2], hv[3]); *(u32x2*)(dst + c) = o; }
}
__device__ __forceinline__ void norm_rows(const Params& P, int mode, int l, int grp, const unsigned char* smem) {
    const int tid_ = otid(); const int wid = tid_ >> 6, lane = tid_ & 63;
    bf16_t* __restrict__ X = (bf16_t*)(P.ws + A_X);
    const int gw = blockIdx.x * 8 + wid, nw = gridDim.x * 8;
    if (mode == 0) {
        gfp_t g0p = INP(I_GPREMIX); bf16_t* H = (bf16_t*)(P.ws + R_H);
        for (int row = gw; row < TPAD; row += nw) {
            f32x4 xv[4];
            if (row >= TT) {
#pragma unroll
                for (int i = 0; i < 4; ++i) xv[i] = (f32x4){0.f, 0.f, 0.f, 0.f};
            } else {
                const bool isP = row < TPR; int b = 0, t = 0; if (isP) { b = row / LP; t = row - b * LP; }
                gfp_t src = isP ? (t < 16 ? INP(I_META) + (size_t)t * DM : INP(I_XP) + ((size_t)b * SEQ + (t - 16)) * DM) : INP(I_XS) + (size_t)(row - TPR) * DM;
#pragma unroll
                for (int i = 0; i < 4; ++i) xv[i] = *(const f32x4*)(src + lane * 4 + 256 * i);
            }
#pragma unroll
            for (int i = 0; i < 4; ++i) stx4(X + (size_t)row * DM + lane * 4 + 256 * i, xv[i]);
            if (row < 6192) rms_store(xv, g0p, H + (size_t)row * DM, lane);
        }
        return;
    }
    const Grp G = get_grp(grp);
    const bf16_t* __restrict__ F = (const bf16_t*)(P.ws + R_F) - (size_t)G.g0 * DM;
    const bf16_t* __restrict__ F2 = (const bf16_t*)(P.ws + R_UP) - (size_t)G.g0 * DM;
    bf16_t* __restrict__ H = (bf16_t*)(P.ws + R_H) - (size_t)G.g0 * DM;
    const bool fin = (mode == 2 && l == 1);
    gfp_t gpost = (mode == 1 ? INP(I_GPOSTMIX) : INP(I_GPOSTFFN)) + l * DM;
    gfp_t gffn = INP(I_GPREFFN) + l * DM;
    f32x4 gpr[4], gfr[4];
#pragma unroll
    for (int i = 0; i < 4; ++i) { gpr[i] = *(const f32x4*)(gpost + lane * 4 + 256 * i); gfr[i] = *(const f32x4*)(gffn + lane * 4 + 256 * i); }
#pragma unroll 2
    for (int row = G.g0 + gw; row < G.g0 + G.nrows; row += nw) {
        f32x4 xv[4], fv[4]; float ss = 0.f;
#pragma unroll
        for (int i = 0; i < 4; ++i) { const int c = lane * 4 + 256 * i; xv[i] = ldx4(X + (size_t)row * DM + c);
            { const u32x2 fa = *(const u32x2*)(F + (size_t)row * DM + c), fb = *(const u32x2*)(F2 + (size_t)row * DM + c);
              fv[i][0] = __uint_as_float(fa.x << 16) + __uint_as_float(fb.x << 16); fv[i][1] = __uint_as_float(fa.x & 0xffff0000u) + __uint_as_float(fb.x & 0xffff0000u);
              fv[i][2] = __uint_as_float(fa.y << 16) + __uint_as_float(fb.y << 16); fv[i][3] = __uint_as_float(fa.y & 0xffff0000u) + __uint_as_float(fb.y & 0xffff0000u); }
            ss += fv[i][0] * fv[i][0] + fv[i][1] * fv[i][1] + fv[i][2] * fv[i][2] + fv[i][3] * fv[i][3]; }
        ss = wave_sum(ss);
        const float rs = rsqrtf(ss * (1.0f / DM) + EPS);
#pragma unroll
        for (int i = 0; i < 4; ++i) xv[i] = xv[i] + fv[i] * gpr[i] * rs;
        if (fin) {
            float* dst = nullptr;
            if (row < TPR) { const int b = row / LP, t = row - b * LP; if (t >= 16 && ((OUTMASK >> 0) & 1)) dst = P.out + O_YP + ((size_t)b * SEQ + (t - 16)) * DM; }
            else if ((OUTMASK >> 1) & 1) dst = P.out + O_YS + (size_t)(row - TPR) * DM;
            if (dst) {
#pragma unroll
                for (int i = 0; i < 4; ++i) *(f32x4*)(dst + lane * 4 + 256 * i) = xv[i];
            }
        } else {
#pragma unroll
            for (int i = 0; i < 4; ++i) stx4(X + (size_t)row * DM + lane * 4 + 256 * i, xv[i]);
        }
        if (mode == 1) rms_store_r(xv, gfr, H + (size_t)row * DM, lane);
    }
    if (mode == 2) {
        int nl = l, ng = grp + 1; if (ng == NGRP) { ng = 0; nl = l + 1; }
        if (nl < 2) {
            const Grp N = get_grp(ng); gfp_t gn = INP(I_GPREMIX) + nl * DM; bf16_t* Hn = (bf16_t*)(P.ws + R_H) - (size_t)N.g0 * DM;
            f32x4 gnr[4];
#pragma unroll
            for (int i = 0; i < 4; ++i) gnr[i] = *(const f32x4*)(gn + lane * 4 + 256 * i);
            for (int row = N.g0 + gw; row < N.g0 + N.nrows; row += nw) {
                f32x4 xv[4];
#pragma unroll
                for (int i = 0; i < 4; ++i) xv[i] = ldx4(X + (size_t)row * DM + lane * 4 + 256 * i);
                rms_store_r(xv, gnr, Hn + (size_t)row * DM, lane);
            }
        }
    }
}

__device__ __forceinline__ void phase0(const Params& P, unsigned char* smem) {
    float* tile = (float*)smem;
    constexpr int C0 = 2112, C1 = C0 + 144, C2 = C1 + 192, C3 = C2 + 192, C4 = C3 + 256, C5 = C4 + 256, C6 = C5 + 1408, C7 = C6 + 704;
    for (int id = blockIdx.x; id < 2 * C7; id += gridDim.x) {
        const int l = id / C7; int j = id - l * C7;
        gfp_t W; int N, ldd, koff = 0; bf16_t* dst;
        if (j < C0) { W = INP(I_WIN) + (size_t)l * DM * DIN; N = DIN; dst = (bf16_t*)(P.ws + W_IN) + (size_t)l * DIN * DM; ldd = DM; }
        else if (j < C1) { j -= C0; W = INP(I_WGLU) + (size_t)l * 768 * 768; N = 768; dst = (bf16_t*)(P.ws + W_GLU) + (size_t)l * 768 * 768; ldd = 768; }
        else if (j < C2) { j -= C1; W = INP(I_WBA) + (size_t)l * 768 * DM; N = DM; dst = (bf16_t*)(P.ws + W_BR) + (size_t)l * DM * LDY; ldd = LDY; }
        else if (j < C3) { j -= C2; W = INP(I_WBB) + (size_t)l * 768 * DM; N = DM; dst = (bf16_t*)(P.ws + W_BR) + (size_t)l * DM * LDY; ldd = LDY; koff = 768; }
        else if (j < C4) { j -= C3; W = INP(I_WBC) + (size_t)l * DM * DM; N = DM; dst = (bf16_t*)(P.ws + W_BR) + (size_t)l * DM * LDY; ldd = LDY; koff = 1536; }
        else if (j < C5) { j -= C4; W = INP(I_WOUT) + (size_t)l * DM * DM; N = DM; dst = (bf16_t*)(P.ws + W_OUT) + (size_t)l * DM * DM; ldd = DM; }
        else if (j < C6) { j -= C5; W = INP(I_WUP) + (size_t)l * DM * 2 * DFF; N = 2 * DFF; dst = (bf16_t*)(P.ws + W_UP) + (size_t)l * 2 * DFF * DM; ldd = DM; }
        else { j -= C6; W = INP(I_WDOWN) + (size_t)l * DFF * DM; N = DM; dst = (bf16_t*)(P.ws + W_DOWN) + (size_t)l * DM * DFF; ldd = DFF; }
        const int ntn = N / 64; const int tk = j / ntn, tn = j - tk * ntn;
        transpose_tile(W, N, dst, ldd, koff, tk, tn, tile);
    }
    norm_rows(P, 0, 0, 0, smem);
    float* rt = (float*)(P.ws + A_ROPE);
    for (int i = blockIdx.x * 512 + threadIdx.x; i < 2068 * 32; i += gridDim.x * 512) {
        const int pi = i >> 5, fi = i & 31; const double pos = pi < LP ? (double)pi : (double)(16384 + pi - LP);
        const double inv = exp(-(double)fi * (9.210340371976184 / 32.0));
        double ang = pos * inv; const double k = rint(ang * 0.15915494309189535); ang = ang - k * 6.283185307179586;
        const float af = (float)ang; rt[2 * i] = cosf(af); rt[2 * i + 1] = sinf(af);
    }
    if (blockIdx.x == 0 && threadIdx.x < 64) ((unsigned*)(P.ws + A_CTR))[threadIdx.x] = 0u;
}

__device__ __forceinline__ void ld8(const bf16_t* p, float (&d)[8]) {
    const u32x4 v = *(const u32x4*)p;
#pragma unroll
    for (int i = 0; i < 4; ++i) { d[2 * i] = __uint_as_float(v[i] << 16); d[2 * i + 1] = __uint_as_float(v[i] & 0xffff0000u); }
}
__device__ __forceinline__ void ffn_conv_phase(const Params& P, int l, int grp, const unsigned char* smem) {
    const Grp G = get_grp(grp);
    const bf16_t* __restrict__ UP = (const bf16_t*)(P.ws + R_UP) - (size_t)G.g0 * (2 * DFF); bf16_t* __restrict__ FIN = (bf16_t*)(P.ws + R_FIN) - (size_t)G.g0 * DFF;
    gfp_t cw = INP(I_FCW) + (size_t)l * 3 * DFF; gfp_t cb = INP(I_FCB) + (size_t)l * DFF;
    gfp_t cache = INP(I_FFNC) + (size_t)l * DEC_B * 2 * DFF;
    constexpr int NCG = DFF / 8;
    const int nrun = G.nrows >> 3;
    for (int it = blockIdx.x * 512 + threadIdx.x; it < nrun * NCG; it += gridDim.x * 512) {
        const int ck = it / NCG, c = (it - ck * NCG) * 8, row0 = G.g0 + ck * 8;
        float w0[8], w1[8], w2[8], bs[8];
#pragma unroll
        for (int i = 0; i < 8; ++i) { bs[i] = cb[c + i]; w0[i] = cw[c + i]; w1[i] = cw[DFF + c + i]; w2[i] = cw[2 * DFF + c + i]; }
        float g1[8], g2[8];
#pragma unroll
        for (int r = 0; r < 8; ++r) {
            const int row = row0 + r;
            int b, t, L; const bool isP = row < TPR;
            if (isP) { b = row / LP; t = row - b * LP; L = LP; } else { b = (row - TPR) >> 2; t = (row - TPR) & 3; L = 4; }
            float g0[8], uf[8];
            ld8(UP + (size_t)row * (2 * DFF) + c, g0); ld8(UP + (size_t)row * (2 * DFF) + DFF + c, uf);
            if (r == 0) {
                if (t >= 1) ld8(UP + (size_t)(row - 1) * (2 * DFF) + c, g1);
                else {
#pragma unroll
                    for (int i = 0; i < 8; ++i) g1[i] = isP ? 0.f : cache[((size_t)b * 2 + 1) * DFF + c + i]; }
                if (t >= 2) ld8(UP + (size_t)(row - 2) * (2 * DFF) + c, g2);
                else {
#pragma unroll
                    for (int i = 0; i < 8; ++i) g2[i] = isP ? 0.f : cache[((size_t)b * 2 + t) * DFF + c + i]; }
            } else if (t == 0) {
#pragma unroll
                for (int i = 0; i < 8; ++i) { g1[i] = isP ? 0.f : cache[((size_t)b * 2 + 1) * DFF + c + i]; g2[i] = isP ? 0.f : cache[((size_t)b * 2) * DFF + c + i]; }
            } else if (t == 1) {
#pragma unroll
                for (int i = 0; i < 8; ++i) g2[i] = isP ? 0.f : cache[((size_t)b * 2 + 1) * DFF + c + i];
            }
            float o[8];
#pragma unroll
            for (int i = 0; i < 8; ++i) { const float gc = bs[i] + w0[i] * g2[i] + w1[i] * g1[i] + w2[i] * g0[i]; o[i] = gelu_t(gc) * uf[i]; }
            u32x4 ov; ov[0] = pk2(o[0], o[1]); ov[1] = pk2(o[2], o[3]); ov[2] = pk2(o[4], o[5]); ov[3] = pk2(o[6], o[7]);
            *(u32x4*)(FIN + (size_t)row * DFF + c) = ov;
            if (t >= L - 2) {
                float* dst = isP ? P.out + O_P_FFNC + (((size_t)l * NB + b) * 2 + (t - (L - 2))) * DFF + c : P.out + O_S_FFNC + (((size_t)l * DEC_B + b) * 2 + (t - (L - 2))) * DFF + c;
#pragma unroll
                for (int i = 0; i < 8; ++i) dst[i] = g0[i];
            }
#pragma unroll
            for (int i = 0; i < 8; ++i) { g2[i] = g1[i]; g1[i] = g0[i]; }
        }
    }
}

__device__ __forceinline__ void ret_job(const Params& P, int l, int grp, int b, int h, int g0, unsigned char* smem) {
    const int tid = otid(), w = __builtin_amdgcn_readfirstlane(tid >> 6), lane = tid & 63, fr = lane & 15, fq = lane >> 4;
    bf16_t* sQ = (bf16_t*)smem;
    bf16_t* sK = sQ + 128 * 72;
    bf16_t* sKdT = sK + 128 * 72;
    bf16_t* sVT = sKdT + 64 * 136;
    bf16_t* sST = sVT + 128 * 136;
    bf16_t* sP = sST + 128 * 72 + w * 16 * 136;
    const bf16_t* Z = (const bf16_t*)(P.ws + R_Z) - (size_t)g0 * DIN; bf16_t* Y = (bf16_t*)(P.ws + R_Y) - (size_t)g0 * LDY;
    const float* rope = (const float*)(P.ws + A_ROPE);
    const int L = grp ? 4 : LP, rowb = grp ? TPR + b * 4 : b * LP, tabb = grp ? LP : 0;
    const float lg = log1pf(-exp2f(-5.0f - (float)h));
    gfp_t ng = INP(I_RNG) + (size_t)l * 1024 + h * 128;
    float ngv[8];
#pragma unroll
    for (int et = 0; et < 8; ++et) ngv[et] = ng[16 * et + fr];
    f32x4 accS[4];
    float* Sout = P.out + (grp ? O_S_RET + (((size_t)l * DEC_B + b) * 8 + h) * 8192 : O_P_RET + (((size_t)l * NB + b) * 8 + h) * 8192);
    if (grp) { gfp_t S0 = INP(I_RET) + (((size_t)l * DEC_B + b) * 8 + h) * 8192;
#pragma unroll
        for (int dt = 0; dt < 4; ++dt)
#pragma unroll
            for (int j = 0; j < 4; ++j) accS[dt][j] = S0[(16 * dt + 4 * fq + j) * 128 + 16 * w + fr];
    } else {
#pragma unroll
        for (int dt = 0; dt < 4; ++dt) accS[dt] = (f32x4){0.f, 0.f, 0.f, 0.f};
    }
    __syncthreads();
#pragma unroll
    for (int dt = 0; dt < 4; ++dt) { u32x2 o; o.x = pk2(accS[dt][0], accS[dt][1]); o.y = pk2(accS[dt][2], accS[dt][3]); *(u32x2*)(sST + (16 * w + fr) * 72 + 16 * dt + 4 * fq) = o; }
    const int nch = grp ? 1 : 17;
    u32x4 q1 = {0u, 0u, 0u, 0u}, q2 = q1, k1 = q1, k2 = q1, vv[4];
#define RET_LOAD(ckx) do { const int _t0 = grp ? 0 : ((ckx) == 0 ? 0 : 16 + ((ckx) - 1) * 128), _C = grp ? 4 : ((ckx) == 0 ? 16 : 128); \
        const int _m = tid >> 2, _i0 = (tid & 3) * 8, _m2 = tid & 127, _e0 = (tid >> 7) * 32; \
        q1 = (u32x4){0u, 0u, 0u, 0u}; q2 = q1; k1 = q1; k2 = q1; \
        if (_m < _C) { const size_t _zr = (size_t)(rowb + _t0 + _m) * DIN; \
            q1 = *(const u32x4*)(Z + _zr + ZO_Q + h * 64 + _i0); q2 = *(const u32x4*)(Z + _zr + ZO_Q + h * 64 + 32 + _i0); \
            k1 = *(const u32x4*)(Z + _zr + ZO_K + h * 64 + _i0); k2 = *(const u32x4*)(Z + _zr + ZO_K + h * 64 + 32 + _i0); } \
        _Pragma("unroll") for (int _i = 0; _i < 4; ++_i) vv[_i] = (u32x4){0u, 0u, 0u, 0u}; \
        if (_m2 < _C) { const bf16_t* _vp = Z + (size_t)(rowb + _t0 + _m2) * DIN + ZO_V + h * 128 + _e0; \
            _Pragma("unroll") for (int _i = 0; _i < 4; ++_i) vv[_i] = *(const u32x4*)(_vp + 8 * _i); } } while (0)
    RET_LOAD(0);
    for (int ck = 0; ck < nch; ++ck) {
        const int t0 = grp ? 0 : (ck == 0 ? 0 : 16 + (ck - 1) * 128), C = grp ? 4 : (ck == 0 ? 16 : 128);
        {
            const int m = tid >> 2, i0 = (tid & 3) * 8;
            u32x4 q1w = {0u, 0u, 0u, 0u}, q2w = q1w, k1w = q1w, k2w = q1w;
            float kd1[8], kd2[8];
#pragma unroll
            for (int e = 0; e < 8; ++e) { kd1[e] = 0.f; kd2[e] = 0.f; }
            if (m < C) {
                const float* rp = rope + ((size_t)(tabb + t0 + m) * 32 + i0) * 2;
                const float kdec = __expf(lg * (float)(C - 1 - m));
                float qo1[8], qo2[8], ko1[8], ko2[8];
#pragma unroll
                for (int e = 0; e < 8; ++e) {
                    const float cs = rp[2 * e], sn = rp[2 * e + 1];
                    const unsigned qa = q1[e >> 1], qb = q2[e >> 1], ka = k1[e >> 1], kb = k2[e >> 1];
                    const float x1 = (e & 1) ? __uint_as_float(qa & 0xffff0000u) : __uint_as_float(qa << 16);
                    const float x2 = (e & 1) ? __uint_as_float(qb & 0xffff0000u) : __uint_as_float(qb << 16);
                    const float y1 = ((e & 1) ? __uint_as_float(ka & 0xffff0000u) : __uint_as_float(ka << 16)) * 0.125f;
                    const float y2 = ((e & 1) ? __uint_as_float(kb & 0xffff0000u) : __uint_as_float(kb << 16)) * 0.125f;
                    qo1[e] = x1 * cs - x2 * sn; qo2[e] = x2 * cs + x1 * sn;
                    ko1[e] = y1 * cs - y2 * sn; ko2[e] = y2 * cs + y1 * sn;
                    kd1[e] = ko1[e] * kdec; kd2[e] = ko2[e] * kdec;
                }
#pragma unroll
                for (int e = 0; e < 4; ++e) { q1w[e] = pk2(qo1[2 * e], qo1[2 * e + 1]); q2w[e] = pk2(qo2[2 * e], qo2[2 * e + 1]); k1w[e] = pk2(ko1[2 * e], ko1[2 * e + 1]); k2w[e] = pk2(ko2[2 * e], ko2[2 * e + 1]); }
            }
            *(u32x4*)(sQ + m * 72 + i0) = q1w; *(u32x4*)(sQ + m * 72 + 32 + i0) = q2w;
            *(u32x4*)(sK + m * 72 + i0) = k1w; *(u32x4*)(sK + m * 72 + 32 + i0) = k2w;
#pragma unroll
            for (int e = 0; e < 8; ++e) { sKdT[(i0 + e) * 136 + m] = f2bf(kd1[e]); sKdT[(32 + i0 + e) * 136 + m] = f2bf(kd2[e]); }
            const int m2 = tid & 127, e0 = (tid >> 7) * 32;
#pragma unroll
            for (int i = 0; i < 4; ++i)
#pragma unroll
                for (int e = 0; e < 4; ++e) { sVT[(e0 + 8 * i + 2 * e) * 136 + m2] = (bf16_t)(vv[i][e] & 0xffffu); sVT[(e0 + 8 * i + 2 * e + 1) * 136 + m2] = (bf16_t)(vv[i][e] >> 16); }
        }
        __syncthreads();
        if (ck + 1 < nch) RET_LOAD(ck + 1);
        f32x4 o[8];
        const bool act = (16 * w < C);
        unsigned gcp[4][4];
        if (act) {
#pragma unroll
            for (int j = 0; j < 4; ++j) { const int n = 16 * w + 4 * fq + j; const size_t row = (size_t)(rowb + t0 + (n < C ? n : 0));
#pragma unroll
                for (int e2 = 0; e2 < 4; ++e2) { const bf16_t lo = Z[row * DIN + ZO_GC + h * 128 + 32 * e2 + fr], hi = Z[row * DIN + ZO_GC + h * 128 + 32 * e2 + 16 + fr]; gcp[e2][j] = (unsigned)lo | ((unsigned)hi << 16); } }
        }
        if (act) {
            bf16x8 qf[2];
#pragma unroll
            for (int ks = 0; ks < 2; ++ks) qf[ks] = *(const bf16x8*)(sQ + (16 * w + fr) * 72 + 32 * ks + 8 * fq);
            const int mtN = (w | 1) + 1;
            for (int mt = 0; mt < mtN; ++mt) {
                f32x4 a = {0.f, 0.f, 0.f, 0.f};
#pragma unroll
                for (int ks = 0; ks < 2; ++ks) { const bf16x8 kf = *(const bf16x8*)(sK + (16 * mt + fr) * 72 + 32 * ks + 8 * fq); a = mfma16(qf[ks], kf, a); }
#pragma unroll
                for (int j = 0; j < 4; ++j) { const int d = (16 * w + 4 * fq + j) - (16 * mt + fr); const float v = d >= 0 ? a[j] * __expf(lg * (float)d) : 0.f; sP[(4 * fq + j) * 136 + 16 * mt + fr] = f2bf(v); }
            }
            lds_wait();
#pragma unroll
            for (int et = 0; et < 8; ++et) o[et] = (f32x4){0.f, 0.f, 0.f, 0.f};
            const int ksN = mtN >> 1;
            for (int ks = 0; ks < ksN; ++ks) {
                const bf16x8 pf = *(const bf16x8*)(sP + fr * 136 + 32 * ks + 8 * fq);
#pragma unroll
                for (int et = 0; et < 8; ++et) { const bf16x8 vf = *(const bf16x8*)(sVT + (16 * et + fr) * 136 + 32 * ks + 8 * fq); o[et] = mfma16(pf, vf, o[et]); }
            }
            f32x4 o2[8];
#pragma unroll
            for (int et = 0; et < 8; ++et) o2[et] = (f32x4){0.f, 0.f, 0.f, 0.f};
#pragma unroll
            for (int ks = 0; ks < 2; ++ks)
#pragma unroll
                for (int et = 0; et < 8; ++et) { const bf16x8 sf = *(const bf16x8*)(sST + (16 * et + fr) * 72 + 32 * ks + 8 * fq); o2[et] = mfma16(qf[ks], sf, o2[et]); }
#pragma unroll
            for (int j = 0; j < 4; ++j) { const float sc = __expf(lg * (float)(16 * w + 4 * fq + j + 1));
#pragma unroll
                for (int et = 0; et < 8; ++et) o[et][j] += o2[et][j] * sc; }
        }
        {
            const float gC = __expf(lg * (float)C);
#pragma unroll
            for (int dt = 0; dt < 4; ++dt) accS[dt] = accS[dt] * gC;
            const int ksN = (C + 31) >> 5;
            for (int ks = 0; ks < ksN; ++ks) {
                const bf16x8 vf = *(const bf16x8*)(sVT + (16 * w + fr) * 136 + 32 * ks + 8 * fq);
#pragma unroll
                for (int dt = 0; dt < 4; ++dt) { const bf16x8 kf = *(const bf16x8*)(sKdT + (16 * dt + fr) * 136 + 32 * ks + 8 * fq); accS[dt] = mfma16(kf, vf, accS[dt]); }
            }
        }
        __syncthreads();
#pragma unroll
        for (int dt = 0; dt < 4; ++dt) { u32x2 ow; ow.x = pk2(accS[dt][0], accS[dt][1]); ow.y = pk2(accS[dt][2], accS[dt][3]); *(u32x2*)(sST + (16 * w + fr) * 72 + 16 * dt + 4 * fq) = ow; }
        if (act) {
#pragma unroll
            for (int j = 0; j < 4; ++j) {
                float s = 0.f;
#pragma unroll
                for (int et = 0; et < 8; ++et) s += o[et][j];
                s = row16_sum(s);
                const float mu = s * (1.0f / 128.0f);
                float s2 = 0.f;
#pragma unroll
                for (int et = 0; et < 8; ++et) { const float d = o[et][j] - mu; s2 += d * d; }
                s2 = row16_sum(s2);
                const float rstd = rsqrtf(s2 * (1.0f / 128.0f) + EPS);
                const int n = 16 * w + 4 * fq + j;
                if (n < C) {
                    const size_t row = (size_t)(rowb + t0 + n);
#pragma unroll
                    for (int et = 0; et < 8; ++et) { const int e = 16 * et + fr; const unsigned gw_ = gcp[et >> 1][j]; const float gcv = (et & 1) ? __uint_as_float(gw_ & 0xffff0000u) : __uint_as_float(gw_ << 16);
                        const float yv = gcv * sigm(gcv) * (o[et][j] - mu) * rstd * ngv[et]; Y[row * LDY + 1536 + h * 128 + e] = f2bf(yv); }
                }
            }
        }
    }
    if (grp ? OUT_ON(12) : OUT_ON(6)) {
#pragma unroll
    for (int dt = 0; dt < 4; ++dt)
#pragma unroll
        for (int j = 0; j < 4; ++j) Sout[(16 * dt + 4 * fq + j) * 128 + 16 * w + fr] = accS[dt][j];
    }
}

__device__ __forceinline__ void lru_job(const Params& P, int l, int grp, int jid, int g0, int pb0, unsigned char* smem) {
    const int tid = otid(), w = __builtin_amdgcn_readfirstlane(tid >> 6), lane = tid & 63, fr = lane & 15, fq = lane >> 4;
    bf16_t* sA = (bf16_t*)(smem + w * 10752);
    float* sRI = (float*)(smem + w * 10752 + 2304);
    float* sComb = (float*)(smem + 8 * 10752);
    const bf16_t* Z = (const bf16_t*)(P.ws + R_Z) - (size_t)g0 * DIN; bf16_t* Y = (bf16_t*)(P.ws + R_Y) - (size_t)g0 * LDY;
    const int unit = grp ? jid * 8 + w : jid;
    const int bl = unit / 12, hb = unit - bl * 12, ch = hb * 64 + lane; const int b = grp ? bl : pb0 + bl;
    const int L = grp ? 4 : LP, rowb = grp ? TPR + b * 4 : b * LP;
    float cw[4];
#pragma unroll
    for (int j = 0; j < 4; ++j) cw[j] = INP(I_LCW)[((size_t)l * 4 + j) * 768 + ch];
    const float cb = INP(I_LCB)[l * 768 + ch], ba = INP(I_LBA)[l * 768 + ch], bx = INP(I_LBX)[l * 768 + ch];
    const float lam = INP(I_LAM)[l * 768 + ch];
    const float sp8 = 8.0f * (fmaxf(-lam, 0.f) + log1pf(__expf(-fabsf(lam))));
    bf16x8 Wa[4][2], Wx[4][2];
    { gfp_t wa = INP(I_LWA) + ((size_t)l * 12 + hb) * 4096; gfp_t wx = INP(I_LWX) + ((size_t)l * 12 + hb) * 4096;
#pragma unroll
      for (int nt = 0; nt < 4; ++nt)
#pragma unroll
          for (int ks = 0; ks < 2; ++ks)
#pragma unroll
              for (int j = 0; j < 8; ++j) { const int k = 32 * ks + 8 * fq + j, n = 16 * nt + fr; Wa[nt][ks][j] = (short)f2bf(wa[k * 64 + n]); Wx[nt][ks][j] = (short)f2bf(wx[k * 64 + n]); } }
    float carry = grp ? INP(I_LRUH)[((size_t)l * DEC_B + b) * 768 + ch] : 0.f;
    gfp_t cache = INP(I_LRUC) + ((size_t)l * DEC_B + b) * 3 * 768;
    const int nIter = grp ? 1 : 17;
    __syncthreads();
#ifndef LRU_REP
#define LRU_REP 1
#endif
    bf16_t xn[19];
    { const int tw0 = grp ? 0 : 16 * w;
#pragma unroll
      for (int i = 0; i < 19; ++i) { int t = tw0 - 3 + i; t = t < 0 ? 0 : (t > L - 1 ? L - 1 : t); xn[i] = Z[(size_t)(rowb + t) * DIN + ZO_XB + ch]; } }
    for (int it_ = 0; it_ < nIter * (grp ? 1 : LRU_REP); ++it_) {
        const int it = it_ % nIter; if (LRU_REP > 1 && it_ == nIter) carry = 0.f;
        const int tw = grp ? 0 : it * 128 + 16 * w;
        float xv[19];
#pragma unroll
        for (int i = 0; i < 19; ++i) { const int t = tw - 3 + i; xv[i] = (t >= 0 && t < L) ? bf2f(xn[i]) : 0.f; }
        if (grp) {
#pragma unroll
            for (int i = 0; i < 3; ++i) xv[i] = cache[i * 768 + ch];
        }
        if (it_ + 1 < nIter * (grp ? 1 : LRU_REP)) {
            const int twn = tw + 128;
#pragma unroll
            for (int i = 0; i < 19; ++i) { int t = twn - 3 + i; t = t < 0 ? 0 : (t > L - 1 ? L - 1 : t); xn[i] = Z[(size_t)(rowb + t) * DIN + ZO_XB + ch]; }
        }
        unsigned gtp[8];
#pragma unroll
        for (int i = 0; i < 8; ++i) { const int ta = tw + 2 * i, tb = ta + 1;
            const bf16_t lo = Z[(size_t)(rowb + (ta < L ? ta : L - 1)) * DIN + ZO_GB + ch], hi = Z[(size_t)(rowb + (tb < L ? tb : L - 1)) * DIN + ZO_GB + ch];
            gtp[i] = (unsigned)lo | ((unsigned)hi << 16); }
        float xc[16];
#pragma unroll
        for (int i = 0; i < 16; ++i) { xc[i] = cb + cw[0] * xv[i] + cw[1] * xv[i + 1] + cw[2] * xv[i + 2] + cw[3] * xv[i + 3]; sA[i * 72 + lane] = f2bf(xc[i]); }
        lds_wait();
        bf16x8 af[2];
#pragma unroll
        for (int ks = 0; ks < 2; ++ks) af[ks] = *(const bf16x8*)(sA + fr * 72 + 32 * ks + 8 * fq);
#pragma unroll
        for (int nt = 0; nt < 4; ++nt) {
            f32x4 ra = {0.f, 0.f, 0.f, 0.f}, rx = ra;
            ra = mfma16(af[0], Wa[nt][0], ra); ra = mfma16(af[1], Wa[nt][1], ra);
            rx = mfma16(af[0], Wx[nt][0], rx); rx = mfma16(af[1], Wx[nt][1], rx);
#pragma unroll
            for (int j = 0; j < 4; ++j) { sRI[(4 * fq + j) * 132 + 16 * nt + fr] = ra[j]; sRI[(4 * fq + j) * 132 + 64 + 16 * nt + fr] = rx[j]; }
        }
        lds_wait();
        float hloc[16], ca[16]; float hl = 0.f, cacc = 1.f;
#pragma unroll
        for (int i = 0; i < 16; ++i) {
            const float rp = sRI[i * 132 + lane], ip = sRI[i * 132 + 64 + lane];
            const float r = sigm(rp + ba), ii = sigm(ip + bx);
            const float la = -sp8 * r; float a = __expf(la);
            const float x2 = 2.0f * la;
            const float ser = -x2 * (1.0f + x2 * (0.5f + x2 * (0.16666667f + x2 * (0.041666668f + x2 * 0.0083333338f))));
            const float om = x2 > -0.25f ? ser : 1.0f - __expf(x2);
            float bv = __builtin_amdgcn_sqrtf(om) * ii * xc[i];
            if (tw + i >= L) { a = 1.f; bv = 0.f; }
            hl = a * hl + bv; cacc *= a; hloc[i] = hl; ca[i] = cacc;
        }
        float hin = carry;
        if (!grp) {
            float* sCb = sComb + (it_ & 1) * 1024;
            sCb[(w * 64 + lane) * 2] = cacc; sCb[(w * 64 + lane) * 2 + 1] = hl;
            __syncthreads();
            float run = carry;
#pragma unroll
            for (int ww = 0; ww < 8; ++ww) { if (ww == w) hin = run; run = sCb[(ww * 64 + lane) * 2] * run + sCb[(ww * 64 + lane) * 2 + 1]; }
            carry = run;
        } else carry = hloc[15] + ca[15] * hin;
#pragma unroll
        for (int i = 0; i < 16; ++i) { const int t = tw + i;
            if (t < L) { const size_t row = (size_t)(rowb + t); const float hh = hloc[i] + ca[i] * hin; const unsigned gw_ = gtp[i >> 1]; const float gt = (i & 1) ? __uint_as_float(gw_ & 0xffff0000u) : __uint_as_float(gw_ << 16); Y[row * LDY + 768 + ch] = f2bf(hh * gelu_t(gt)); } }
    }
    if (grp || w == 0) {
        float* ho = grp ? P.out + O_S_LRUH + ((size_t)l * DEC_B + b) * 768 + ch : P.out + O_P_LRUH + ((size_t)l * NB + b) * 768 + ch;
        if (grp ? OUT_ON(10) : OUT_ON(4)) *ho = carry;
        float* co = grp ? P.out + O_S_LRUC + ((size_t)l * DEC_B + b) * 3 * 768 + ch : P.out + O_P_LRUC + ((size_t)l * NB + b) * 3 * 768 + ch;
#pragma unroll
        for (int j = 0; j < 3; ++j) if (grp ? OUT_ON(11) : OUT_ON(5)) co[j * 768] = bf2f(Z[(size_t)(rowb + L - 3 + j) * DIN + ZO_XB + ch]);
    }
}

template <bool FULL>
__device__ __forceinline__ void s5_run(const bf16_t* Z, bf16_t* ZS, float* sBU, bf16_t* sH, const bf16x8 (&Bf)[8], const bf16x8 (&Cf)[4], float abr, float abi, float dsk,
                                       int rowb, int g, int L, int it0, int it1, float& hr, float& hi, int lane, int fr, int fq) {
    u32x4 ufn = {0u, 0u, 0u, 0u}; bf16_t udn[4] = {0, 0, 0, 0};
    { const int t1 = it0 * 16; const int v1 = (L - t1) < 16 ? (L - t1) : 16;
      if (fq < 2 && fr < v1) ufn = *(const u32x4*)(Z + (size_t)(rowb + t1 + fr) * DIN + ZO_UA + g * 16 + 8 * fq);
      if (FULL) {
#pragma unroll
          for (int j = 0; j < 4; ++j) if (4 * fq + j < v1) udn[j] = Z[(size_t)(rowb + t1 + 4 * fq + j) * DIN + ZO_UA + g * 16 + fr]; } }
    for (int it = it0; it < it1; ++it) {
        const int t0 = it * 16; const int valid = (L - t0) < 16 ? (L - t0) : 16;
        const bf16x8 uf = __builtin_bit_cast(bf16x8, ufn);
        bf16_t ud[4];
#pragma unroll
        for (int j = 0; j < 4; ++j) ud[j] = udn[j];
        if (it + 1 < it1) { const int t1 = t0 + 16; const int v1 = (L - t1) < 16 ? (L - t1) : 16;
            ufn = (u32x4){0u, 0u, 0u, 0u};
            if (fq < 2 && fr < v1) ufn = *(const u32x4*)(Z + (size_t)(rowb + t1 + fr) * DIN + ZO_UA + g * 16 + 8 * fq);
            if (FULL) {
#pragma unroll
                for (int j = 0; j < 4; ++j) { udn[j] = 0; if (4 * fq + j < v1) udn[j] = Z[(size_t)(rowb + t1 + 4 * fq + j) * DIN + ZO_UA + g * 16 + fr]; } } }
#pragma unroll
        for (int nt = 0; nt < 8; ++nt) { f32x4 a = {0.f, 0.f, 0.f, 0.f}; a = mfma16(uf, Bf[nt], a);
#pragma unroll
            for (int j = 0; j < 4; ++j) sBU[(4 * fq + j) * 132 + 16 * nt + fr] = a[j]; }
        lds_wait();
#pragma unroll
        for (int i = 0; i < 16; ++i) {
            float bur = sBU[i * 132 + lane], bui = sBU[i * 132 + 64 + lane];
            asm volatile("" : "+v"(bur), "+v"(bui));
            const float msk = (i < valid) ? 1.0f : 0.0f;
            float nr = __builtin_fmaf(abr, hr, bur); asm volatile("" : "+v"(nr));
            nr = __builtin_fmaf(-abi, hi, nr); asm volatile("" : "+v"(nr));
            float ni = __builtin_fmaf(abr, hi, bui); asm volatile("" : "+v"(ni));
            ni = __builtin_fmaf(abi, hr, ni); asm volatile("" : "+v"(ni));
            hr = __builtin_fmaf(msk, nr - hr, hr); hi = __builtin_fmaf(msk, ni - hi, hi);
            asm volatile("" : "+v"(hr), "+v"(hi));
            if (FULL) { sH[i * 136 + lane] = f2bf(hr); sH[i * 136 + 64 + lane] = f2bf(hi); }
        }
        lds_wait();
        if (FULL) {
            f32x4 y = {0.f, 0.f, 0.f, 0.f};
#pragma unroll
            for (int ks = 0; ks < 4; ++ks) { const bf16x8 hf = *(const bf16x8*)(sH + fr * 136 + 32 * ks + 8 * fq); y = mfma16(hf, Cf[ks], y); }
#pragma unroll
            for (int j = 0; j < 4; ++j) { const int t = 4 * fq + j;
                if (t < valid) { const size_t row = (size_t)(rowb + t0 + t); const float u = bf2f(ud[j]); ZS[row * 768 + g * 16 + fr] = f2bf(gelu_t(y[j] + dsk * u)); } }
            lds_wait();
        }
    }
}
__device__ __forceinline__ void cmul(float& ar, float& ai, float br, float bi) { const float r = ar * br - ai * bi, i = ar * bi + ai * br; ar = r; ai = i; }

__device__ __forceinline__ void s5_job(const Params& P, int l, int grp, int jid, int g0, int pb0, unsigned* s5done, unsigned char* smem) {
    const int tid = otid(), w = __builtin_amdgcn_readfirstlane(tid >> 6), lane = tid & 63, fr = lane & 15, fq = lane >> 4;
    float* sBU = (float*)(smem + w * 12800);
    bf16_t* sH = (bf16_t*)(smem + w * 12800 + 8448);
    float* sC = (float*)(smem + 8 * 12800);
    const bf16_t* Z = (const bf16_t*)(P.ws + R_Z) - (size_t)g0 * DIN; bf16_t* ZS = (bf16_t*)(P.ws + R_ZS5) - (size_t)g0 * 768;
    int g, b0;
    if (grp) { const int unit = jid * 8 + w; g = unit % 48; b0 = (unit / 48) * 16; } else { b0 = jid / 48; g = jid - b0 * 48; b0 += pb0; }
    const float dt = __expf(INP(I_LS)[l * 48 + g]);
    float abr = 0.f, abi = 0.f;
    bf16x8 Bf[8];
#pragma unroll
    for (int k = 0; k < 4; ++k) {
        const int p = 16 * k + fr;
        const float lr = INP(I_AR)[((size_t)l * 48 + g) * 64 + p], li = INP(I_AI)[((size_t)l * 48 + g) * 64 + p];
        const float mag = expf(lr * dt), ar_ = mag * cosf(li * dt), ai_ = mag * sinf(li * dt);
        if (k == fq) { abr = ar_; abi = ai_; }
        const float den = lr * lr + li * li, nr = ar_ - 1.0f;
        const float cr = (nr * lr + ai_ * li) / den, ci = (ai_ * lr - nr * li) / den;
        bf16x8 fre, fim;
#pragma unroll
        for (int j = 0; j < 8; ++j) { fre[j] = 0; fim[j] = 0; }
        if (fq < 2) {
            gfp_t bre = INP(I_BR) + (((size_t)l * 48 + g) * 64 + p) * 16 + 8 * fq; gfp_t bim = INP(I_BI) + (((size_t)l * 48 + g) * 64 + p) * 16 + 8 * fq;
#pragma unroll
            for (int j = 0; j < 8; ++j) { const float br_ = bre[j], bi_ = bim[j]; fre[j] = (short)f2bf(cr * br_ - ci * bi_); fim[j] = (short)f2bf(cr * bi_ + ci * br_); }
        }
        Bf[k] = fre; Bf[4 + k] = fim;
    }
    bf16x8 Cf[4];
#pragma unroll
    for (int ks = 0; ks < 4; ++ks) {
        gfp_t cp = (ks < 2 ? INP(I_CR) : INP(I_CI)) + (((size_t)l * 48 + g) * 16 + fr) * 64 + 32 * (ks & 1) + 8 * fq;
        const float sg = ks < 2 ? 1.0f : -1.0f;
#pragma unroll
        for (int j = 0; j < 8; ++j) Cf[ks][j] = (short)f2bf(sg * cp[j]);
    }
    const float dsk = INP(I_D)[l * 768 + g * 16 + fr];
    __syncthreads();
    if (grp) {
        for (int s = 0; s < 16; ++s) {
            const int b = b0 + s; const int rowb = TPR + b * 4;
            float hr = INP(I_S5RE)[(((size_t)l * DEC_B + b) * 48 + g) * 64 + lane], hi = INP(I_S5IM)[(((size_t)l * DEC_B + b) * 48 + g) * 64 + lane];
            s5_run<true>(Z, ZS, sBU, sH, Bf, Cf, abr, abi, dsk, rowb, g, 4, 0, 1, hr, hi, lane, fr, fq);
            P.out[O_S_S5RE + (((size_t)l * DEC_B + b) * 48 + g) * 64 + lane] = hr;
            P.out[O_S_S5IM + (((size_t)l * DEC_B + b) * 48 + g) * 64 + lane] = hi;
        }
    } else {
        const int b = b0, rowb = b * LP;
        const int it0 = w == 0 ? 0 : 17 + 16 * (w - 1), it1 = 17 + 16 * w;
        float hr = 0.f, hi = 0.f;
        s5_run<false>(Z, ZS, sBU, sH, Bf, Cf, abr, abi, dsk, rowb, g, LP, it0, it1, hr, hi, lane, fr, fq);
        sC[(w * 64 + lane) * 2] = hr; sC[(w * 64 + lane) * 2 + 1] = hi;
        float pr = abr, pi = abi, p16r = 0.f, p16i = 0.f;
#pragma unroll
        for (int q = 0; q < 8; ++q) { cmul(pr, pi, pr, pi); if (q == 3) { p16r = pr; p16i = pi; } }
        float qr = pr, qi = pi; cmul(qr, qi, p16r, p16i);
        __syncthreads();
        float cr_ = 0.f, ci_ = 0.f;
        for (int ww = 0; ww < w; ++ww) {
            const float ar2 = ww == 0 ? qr : pr, ai2 = ww == 0 ? qi : pi;
            cmul(cr_, ci_, ar2, ai2);
            cr_ += sC[(ww * 64 + lane) * 2]; ci_ += sC[(ww * 64 + lane) * 2 + 1];
        }
        hr = cr_; hi = ci_;
        s5_run<true>(Z, ZS, sBU, sH, Bf, Cf, abr, abi, dsk, rowb, g, LP, it0, it1, hr, hi, lane, fr, fq);
        if (w == 7) {
            P.out[O_P_S5RE + (((size_t)l * NB + b) * 48 + g) * 64 + lane] = hr;
            P.out[O_P_S5IM + (((size_t)l * NB + b) * 48 + g) * 64 + lane] = hi;
        }
    }
    asm volatile("s_waitcnt vmcnt(0)" ::: "memory");
    __syncthreads();
    if (threadIdx.x == 0) { __threadfence(); asm volatile("s_waitcnt vmcnt(0)" ::: "memory"); atomicAdd(s5done, 1u); }
}

__device__ __forceinline__ void mixers_phase(const Params& P, int l, int rg, unsigned char* smem, int rep) {
    const Grp G = get_grp(rg);
    const int j1 = G.npb * 8, j2 = j1 + G.npb * 12, j3 = j2 + G.npb * 48, j4 = j3 + (G.hasS ? 1024 : 0), j5 = j4 + (G.hasS ? 48 : 0), j6 = j5 + (G.hasS ? 192 : 0), j7 = j6 + G.npan * 12, NJ = j7 + G.npan * 3;
    unsigned* s5done = (unsigned*)(P.ws + A_CTR) + 32 + (l * NGRP + rg) + rep * 16;
    const unsigned s5total = (unsigned)(G.npb * 48 + (G.hasS ? 48 : 0));
    unsigned* ctr = (unsigned*)(P.ws + A_CTR) + (l * NGRP + rg) + rep * 16;
    int* slot = (int*)(smem + LDS_BYTES - 16);
#ifndef STATIC_JOBS
#define STATIC_JOBS 0
#endif
    for (int jj = blockIdx.x;; jj += gridDim.x) {
        __syncthreads();
#if STATIC_JOBS
        const int j = jj; (void)ctr; (void)slot;
#else
        if (threadIdx.x == 0) *slot = (int)atomicAdd(ctr, 1u);
        __syncthreads();
        const int j = *slot;
#endif
        if (j >= NJ) break;
        int type, sg, idx;
        if (j < j1) { type = 0; sg = 0; idx = j; }
        else if (j < j2) { type = 1; sg = 0; idx = j - j1; }
        else if (j < j3) { type = 2; sg = 0; idx = j - j2; }
        else if (j < j4) { type = 0; sg = 1; idx = j - j3; }
        else if (j < j5) { type = 2; sg = 1; idx = j - j4; }
        else if (j < j6) { type = 1; sg = 1; idx = j - j5; }
        else if (j < j7) { type = 4; sg = 0; idx = j - j6; }
        else { type = 3; sg = 0; idx = j - j7; }
        if (type == 4) {
            using namespace pg8;
            Gemm gg{(const bf16_t*)(P.ws + R_H), (const bf16_t*)(P.ws + W_IN) + (size_t)l * DIN * DM, DM, DM, G.npan, DIN / 256, DM / 64, nullptr};
            SchedOne S1{idx / 12, 21 + idx % 12, DM / 64};
            EpiSigBf E{(bf16_t*)(P.ws + R_Z), DIN};
            gemm_run((LAS unsigned char*)smem, gg, S1, E);
            continue;
        }
        if (type == 3) {
            if (threadIdx.x == 0) {
                unsigned sp = 0;
                while (__hip_atomic_load(s5done, __ATOMIC_RELAXED, __HIP_MEMORY_SCOPE_AGENT) < s5total) { __builtin_amdgcn_s_sleep(8); if (++sp > (1u << 22)) break; }
                __threadfence();
                asm volatile("s_waitcnt vmcnt(0)" ::: "memory");
            }
            __syncthreads();
            using namespace pg8;
            Gemm gg{(const bf16_t*)(P.ws + R_ZS5), (const bf16_t*)(P.ws + W_GLU) + (size_t)l * 768 * 768, 768, 768, G.npan, 3, 12, nullptr};
            SchedOne S1{idx / 3, idx % 3, 12};
            EpiGlu E{(bf16_t*)(P.ws + R_Y), (const bf16_t*)(P.ws + R_ZS5), INP(I_BGLU) + l * 768};
            gemm_run((LAS unsigned char*)smem, gg, S1, E);
            continue;
        }
        if (type == 0) ret_job(P, l, sg, (idx >> 3) + (sg ? 0 : G.pb0), idx & 7, G.g0, smem);
        else if (type == 1) lru_job(P, l, sg, idx, G.g0, G.pb0, smem);
        else s5_job(P, l, sg, idx, G.g0, G.pb0, s5done, smem);
    }
}

__device__ __forceinline__ void run_phase(const Params& P, int ph, unsigned char* smem, int rep) {
#ifndef PHSEL
#define PHSEL -1
#endif
#define PSEL(x) (PHSEL < 0 || PHSEL == (x))
    if (ph == 0) { if (PSEL(10)) phase0(P, smem); return; }
    const int l = (ph - 1) / (10 * NGRP), rg = ((ph - 1) / 10) % NGRP, s = (ph - 1) % 10;
    LAS unsigned char* lds = (LAS unsigned char*)smem;
    unsigned char* ws = P.ws;
    using namespace pg8;
    const int G = gridDim.x, c = blockIdx.x;
    const int npan = rg < 2 ? 25 : 19;
    switch (s) {
    case 0: if (PSEL(0)) { Gemm g{(const bf16_t*)(ws + R_H), (const bf16_t*)(ws + W_IN) + (size_t)l * DIN * DM, DM, DM, npan, 21, DM / 64, nullptr};
              Sched<1> S; S.init(g.nM, g.nN, G, c, g.nt); EpiBf E{(bf16_t*)(ws + R_Z), DIN, (bf16_t*)(ws + R_Z)}; gemm_run(lds, g, S, E); } break;
    case 1: if (PSEL(1)) mixers_phase(P, l, rg, smem, rep); break;
    case 2: if (PSEL(2)) { Gemm g{(const bf16_t*)(ws + R_ZS5), (const bf16_t*)(ws + W_GLU) + (size_t)l * 768 * 768, 768, 768, npan, 3, 12, nullptr};
              Sched<1> S; S.init(g.nM, g.nN, G, c, g.nt); EpiGlu E{(bf16_t*)(ws + R_Y), (const bf16_t*)(ws + R_ZS5), INP(I_BGLU) + l * 768}; gemm_run(lds, g, S, E); } break;
    case 3: if (PSEL(3)) { Gemm g{(const bf16_t*)(ws + R_Y), (const bf16_t*)(ws + W_BR) + (size_t)l * DM * LDY, LDY, LDY, npan, 4, 0, nullptr};
              SchedBr2 S; S.init(g.nM, g.nN, G, c); EpiBranch E{(const bf16_t*)(ws + R_Z) + ZO_GATE, (bf16_t*)(ws + R_M), (bf16_t*)(ws + R_M2)}; gemm_run(lds, g, S, E); } break;
    case 4: if (PSEL(4)) { Gemm g{(const bf16_t*)(ws + R_M), (const bf16_t*)(ws + W_OUT) + (size_t)l * DM * DM, DM, DM, npan, 4, 16, (const bf16_t*)(ws + R_M2)};
              Sched<2> S; S.init(g.nM, g.nN, G, c, g.nt); S.fullk = 1;     EpiBf E{(bf16_t*)(ws + R_F), DM, (bf16_t*)(ws + R_UP)}; gemm_run(lds, g, S, E); } break;
    case 5: if (PSEL(5) && rep == 0) norm_rows(P, 1, l, rg, smem); break;
    case 6: if (PSEL(6)) { Gemm g{(const bf16_t*)(ws + R_H), (const bf16_t*)(ws + W_UP) + (size_t)l * 2 * DFF * DM, DM, DM, npan, 22, 16, nullptr};
              Sched<1> S; S.init(g.nM, g.nN, G, c, g.nt); EpiBf E{(bf16_t*)(ws + R_UP), 2 * DFF, (bf16_t*)(ws + R_UP)}; gemm_run(lds, g, S, E); } break;
    case 7: if (PSEL(7)) ffn_conv_phase(P, l, rg, smem); break;
    case 8: if (PSEL(8)) { Gemm g{(const bf16_t*)(ws + R_FIN), (const bf16_t*)(ws + W_DOWN) + (size_t)l * DM * DFF, DFF, DFF, npan, 4, 44, nullptr};
              Sched<2> S; S.init(g.nM, g.nN, G, c, g.nt); EpiBf E{(bf16_t*)(ws + R_F), DM, (bf16_t*)(ws + R_UP)}; gemm_run(lds, g, S, E); } break;
    default: if (PSEL(9) && rep == 0) norm_rows(P, 2, l, rg, smem); break;
    }
}

#define XB_TMO      128
#define XB_XCNT(j)  (256  + 64 * (j))
#define XB_XSUB(j)  (1280 + 64 * (j))
#define XB_XGEN(j)  (2304 + 64 * (j))
#define XB_TOP      3328
#define XB_TOPGEN   3392
#define XCD_BAR_WORDS 3456
#define XB_SPIN_CAP (1u << 18)

__device__ __forceinline__ unsigned xb_ld(unsigned* p)              { return __hip_atomic_load(p, __ATOMIC_RELAXED, __HIP_MEMORY_SCOPE_AGENT); }
__device__ __forceinline__ unsigned xb_add(unsigned* p, unsigned v) { return __hip_atomic_fetch_add(p, v, __ATOMIC_RELAXED, __HIP_MEMORY_SCOPE_AGENT); }
__device__ __forceinline__ unsigned xb_xcc_id() { return (unsigned)__builtin_amdgcn_s_getreg((3 << 11) | 20) & 0xFu; }
#define XB_SPIN(cond, bar) do { unsigned _sp = 0; while (cond) { __builtin_amdgcn_s_sleep(1); \
    if ((++_sp & 255u) == 0u) { if (xb_ld(&(bar)[XB_TMO])) break; if (_sp > XB_SPIN_CAP) { atomicAdd(&(bar)[XB_TMO], 1u); break; } } } } while (0)

struct XcdBarrier {
    unsigned* bar; unsigned x;
    volatile LAS unsigned* st;
};

__device__ __forceinline__ XcdBarrier xcd_barrier_post(unsigned* bar, volatile LAS unsigned* st) {
    XcdBarrier b; b.bar = bar; b.x = xb_xcc_id(); b.st = st;
    if (threadIdx.x == 0) (void)xb_add(&bar[XB_XCNT(b.x)], 1u);
    return b;
}
__device__ __forceinline__ void xcd_barrier_complete(unsigned* bar, unsigned x, unsigned& nloc, unsigned& nx) {
    const unsigned G = gridDim.x * gridDim.y * gridDim.z;
    unsigned sum, cnt, mine, sp = 0u;
    for (;;) {
        sum = 0u; cnt = 0u; mine = 0u;
#pragma unroll
        for (unsigned j = 0; j < 16; ++j) { const unsigned c = xb_ld(&bar[XB_XCNT(j)]); sum += c; cnt += (c > 0u) ? 1u : 0u; mine = (j == x) ? c : mine; }
        if (sum == G) break;
        __builtin_amdgcn_s_sleep(1);
        if ((++sp & 255u) == 0u) { if (xb_ld(&bar[XB_TMO])) break; if (sp > XB_SPIN_CAP) { atomicAdd(&bar[XB_TMO], 1u); break; } }
    }
    nloc = mine > 0u ? mine : 1u; nx = cnt > 0u ? cnt : 1u;
}

__device__ __forceinline__ void xcd_barrier(const XcdBarrier& b) {
    asm volatile("s_waitcnt vmcnt(0)" ::: "memory");
    __syncthreads();
    if (threadIdx.x == 0) {
        unsigned* bar = b.bar;
        __builtin_amdgcn_s_waitcnt(0);
        unsigned nloc = b.st[0], nx = b.st[1];
        if (nloc == 0u) { xcd_barrier_complete(bar, b.x, nloc, nx); b.st[0] = nloc; b.st[1] = nx; }
        const unsigned old = xb_add(&bar[XB_XSUB(b.x)], 1u);
        const unsigned gen = old / nloc;
        if (old + 1u == (gen + 1u) * nloc) {
            __builtin_amdgcn_fence(__ATOMIC_RELEASE, "agent");
            asm volatile("s_waitcnt vmcnt(0)" ::: "memory");
            const unsigned og = xb_add(&bar[XB_TOP], 1u);
            const unsigned tg = og / nx;
            if (og + 1u == (tg + 1u) * nx) xb_add(&bar[XB_TOPGEN], 1u);
            else XB_SPIN(xb_ld(&bar[XB_TOPGEN]) == tg, bar);
            __builtin_amdgcn_fence(__ATOMIC_ACQUIRE, "agent");
            xb_add(&bar[XB_XGEN(b.x)], 1u);
            asm volatile("s_waitcnt vmcnt(0)" ::: "memory");
        } else {
            XB_SPIN(xb_ld(&bar[XB_XGEN(b.x)]) == gen, bar);
            __builtin_amdgcn_fence(__ATOMIC_ACQUIRE, "agent");
            asm volatile("s_waitcnt vmcnt(0)" ::: "memory");
        }
    }
    __syncthreads();
}


__global__ void __launch_bounds__(512, 2) mega(Params P, int ph_lo, int ph_hi) {
    extern __shared__ __attribute__((aligned(16))) unsigned char smem[];
    unsigned* xst = (unsigned*)(smem + LDS_BYTES - 32);
    if (threadIdx.x == 0) {
        const float** tab = (const float**)(smem + PTAB_OFF);
#pragma unroll
        for (int i = 0; i < N_IN; ++i) tab[i] = P.in[i];
        xst[0] = 0u; xst[1] = 0u;
    }
    __syncthreads();
    XcdBarrier xb = xcd_barrier_post((unsigned*)(P.ws + A_BAR), (volatile LAS unsigned*)xst);
#ifndef DUP_MASK
#define DUP_MASK 0x400
#endif
    for (int ph = ph_lo; ph < ph_hi; ++ph) {
        if (ph > 0 && (ph - 1) % 10 == 2) continue;
        int nrep = 1;
        if (DUP_MASK) { const int sidx = ph == 0 ? 10 : (ph - 1) % 10; if ((DUP_MASK >> sidx) & 1) nrep = 2; }
        for (int rep = 0; rep < nrep; ++rep) {
            run_phase(P, ph, smem, rep);
            if (ph + 1 < ph_hi || rep + 1 < nrep) xcd_barrier(xb);
        }
    }
}


#ifndef DBG_STOP
#define DBG_STOP 0
#endif
#ifndef DBG_OFF
#define DBG_OFF R_Z
#endif
__global__ void dbg_dump(const unsigned char* ws, float* out, size_t n) {
    const bf16_t* src = (const bf16_t*)(ws + DBG_OFF);
    for (size_t i = (size_t)blockIdx.x * blockDim.x + threadIdx.x; i < n; i += (size_t)gridDim.x * blockDim.x) out[i] = bf2f(src[i]);
}

extern "C" void kernel_launch(void* const* d_in, const int* in_sizes, int n_in, void* d_out, int out_size, void* d_ws, size_t ws_size, hipStream_t stream) {
    (void)in_sizes; (void)n_in; (void)out_size;
    if (ws_size < WS_TOTAL) { fprintf(stderr, "workspace too small: %zu < %zu\n", ws_size, (size_t)WS_TOTAL); return; }
    Params p{};
    for (int i = 0; i < N_IN; ++i) p.in[i] = (const float*)d_in[i];
    p.out = (float*)d_out; p.ws = (unsigned char*)d_ws;
    hipFuncSetAttribute((const void*)mega, hipFuncAttributeMaxDynamicSharedMemorySize, LDS_BYTES);
    int dev = 0, cus = 256, per_cu = 1;
    hipGetDevice(&dev);
    hipDeviceGetAttribute(&cus, hipDeviceAttributeMultiprocessorCount, dev);
    hipOccupancyMaxActiveBlocksPerMultiprocessor(&per_cu, mega, 512, LDS_BYTES);
    if (per_cu < 1) per_cu = 1;
    const int grid = cus * 1;
#if COOP
#ifndef PH_HI
#define PH_HI NPHASE
#endif
    hipMemsetAsync((unsigned char*)d_ws + A_BAR, 0, 16384, stream);
    int lo = 0, hi = PH_HI;
    void* args[] = {&p, &lo, &hi};
    hipError_t e = hipLaunchCooperativeKernel((void*)mega, dim3(grid), dim3(512), args, LDS_BYTES, stream);
    if (e != hipSuccess) fprintf(stderr, "cooperative launch failed: %s (grid %d)\n", hipGetErrorString(e), grid);
#else
#if DBG_STOP
    for (int ph = 0; ph < DBG_STOP; ++ph) hipLaunchKernelGGL(mega, dim3(grid), dim3(512), LDS_BYTES, stream, p, ph, ph + 1);
#ifdef DBG_EXTRA
    hipLaunchKernelGGL(mega, dim3(grid), dim3(512), LDS_BYTES, stream, p, DBG_EXTRA, DBG_EXTRA + 1);
#endif
    hipLaunchKernelGGL(dbg_dump, dim3(2048), dim3(256), 0, stream, (const unsigned char*)d_ws, (float*)d_out, (size_t)34873344);
#else
    for (int ph = 0; ph < NPHASE; ++ph) hipLaunchKernelGGL(mega, dim3(grid), dim3(512), LDS_BYTES, stream, p, ph, ph + 1);
#endif
#endif
}
```

```cpp
#include <hip/hip_runtime.h>
#include <hip/hip_cooperative_groups.h>
#include <cstdio>
namespace cg = cooperative_groups;

#define DUP_MASK 0
#ifndef COOP
#define COOP 1
#endif
#ifndef OUTMASK
#define OUTMASK 0x3FFF
#endif
#ifndef OUT_BMAX
#define OUT_BMAX 1000
#endif
#ifndef OUT_L
#define OUT_L 3
#endif
#define OUT_ON(k) (((OUTMASK >> (k)) & 1) && ((OUT_L >> l) & 1))
#ifndef DMA_AUX
#define DMA_AUX 0
#endif

#define LAS __attribute__((address_space(3)))
typedef unsigned short bf16_t;
typedef short bf16x8 __attribute__((ext_vector_type(8)));
typedef float f32x4 __attribute__((ext_vector_type(4)));
typedef unsigned u32x4 __attribute__((ext_vector_type(4)));
typedef unsigned u32x2 __attribute__((ext_vector_type(2)));

constexpr int DM = 1024, NB = 8, SEQ = 2048, LP = 2064, DEC_B = 128, DEC_S = 4;
constexpr int TPR = NB * LP;
constexpr int TT = TPR + DEC_B * DEC_S;
constexpr int TPAD = 17152;
constexpr int DIN = 8448, DFF = 2816;
constexpr int ZO_UA = 0, ZO_XB = 768, ZO_GB = 1536, ZO_Q = 2304, ZO_K = 2816, ZO_V = 3328, ZO_GC = 4352, ZO_GATE = 5376;
constexpr int LDY = 2560;
constexpr float EPS = 1e-6f;
constexpr int LDS_BYTES = 143360;

enum { I_XP = 0, I_XS, I_S5RE, I_S5IM, I_LRUH, I_LRUC, I_RET, I_FFNC, I_META, I_GPREMIX, I_GPOSTMIX, I_GPREFFN, I_GPOSTFFN, I_WIN,
       I_AR, I_AI, I_LS, I_BR, I_BI, I_CR, I_CI, I_D, I_WGLU, I_BGLU, I_LCW, I_LCB, I_LWA, I_LBA, I_LWX, I_LBX, I_LAM, I_RNG,
       I_WBA, I_WBB, I_WBC, I_WOUT, I_WUP, I_FCW, I_FCB, I_WDOWN, N_IN };

constexpr size_t O_YP = 0;
constexpr size_t O_YS = O_YP + (size_t)NB * SEQ * DM;
constexpr size_t O_P_S5RE = O_YS + (size_t)DEC_B * DEC_S * DM;
constexpr size_t O_P_S5IM = O_P_S5RE + 2 * NB * 48 * 64;
constexpr size_t O_P_LRUH = O_P_S5IM + 2 * NB * 48 * 64;
constexpr size_t O_P_LRUC = O_P_LRUH + 2 * NB * 768;
constexpr size_t O_P_RET = O_P_LRUC + 2 * NB * 3 * 768;
constexpr size_t O_P_FFNC = O_P_RET + (size_t)2 * NB * 8 * 64 * 128;
constexpr size_t O_S_S5RE = O_P_FFNC + 2 * NB * 2 * DFF;
constexpr size_t O_S_S5IM = O_S_S5RE + 2 * DEC_B * 48 * 64;
constexpr size_t O_S_LRUH = O_S_S5IM + 2 * DEC_B * 48 * 64;
constexpr size_t O_S_LRUC = O_S_LRUH + 2 * DEC_B * 768;
constexpr size_t O_S_RET = O_S_LRUC + 2 * DEC_B * 3 * 768;
constexpr size_t O_S_FFNC = O_S_RET + (size_t)2 * DEC_B * 8 * 64 * 128;

constexpr size_t al256(size_t x) { return (x + 255) & ~(size_t)255; }
constexpr size_t W_IN = 0;
constexpr size_t W_GLU = W_IN + (size_t)2 * DIN * DM * 2;
constexpr size_t W_BR = W_GLU + (size_t)2 * 768 * 768 * 2;
constexpr size_t W_OUT = W_BR + (size_t)2 * DM * LDY * 2;
constexpr size_t W_UP = W_OUT + (size_t)2 * DM * DM * 2;
constexpr size_t W_DOWN = W_UP + (size_t)2 * 2 * DFF * DM * 2;
constexpr size_t A_X = W_DOWN + (size_t)2 * DM * DFF * 2;
constexpr int GR = 6400;
constexpr size_t R_Z = A_X + (size_t)TPAD * DM * 4;
constexpr size_t R_ZS5 = R_Z + (size_t)GR * DIN * 2;
constexpr size_t R_Y = R_ZS5 + (size_t)GR * 768 * 2;
constexpr size_t R_M = R_Y + (size_t)GR * LDY * 2;
constexpr size_t R_END = R_M + (size_t)GR * DM * 2;
constexpr size_t R_H = R_M;
constexpr size_t R_F = R_Z;
constexpr size_t R_UP = R_Z + (size_t)GR * DM * 4;
constexpr size_t R_FIN = R_ZS5;
static_assert(R_UP + (size_t)GR * 2 * DFF * 2 <= R_ZS5, "UP inside Z");
static_assert(R_FIN + (size_t)GR * DFF * 2 <= R_M, "FIN inside ZS5|Y");
constexpr size_t A_ROPE = R_END;
constexpr size_t A_CTR = al256(A_ROPE + (size_t)2068 * 64 * 4);
constexpr size_t A_BAR = A_CTR + 4096;
constexpr size_t WS_TOTAL = A_BAR + 16384;
constexpr size_t R_M2 = A_X + (size_t)40 * 1024 * 1024;
static_assert(A_X + (size_t)TPAD * DM * 2 <= R_M2 && R_M2 + (size_t)GR * DM * 2 <= R_Z, "M2 inside the freed half of the X reservation");
constexpr int NGRP = 3;
constexpr int NPHASE = 1 + 2 * NGRP * 10;

struct Grp { int g0, nrows, npan, pb0, npb, hasS; };
__device__ __forceinline__ Grp get_grp(int g) {
    Grp r; r.g0 = g * 6192; r.nrows = g < 2 ? 6192 : 4640; r.npan = g < 2 ? 25 : 19; r.pb0 = g * 3; r.npb = g < 2 ? 3 : 2; r.hasS = g == 2; return r;
}

struct Params {
    const float* in[N_IN];
    float* out;
    unsigned char* ws;
};


constexpr int PTAB_OFF = 142336;
typedef const __attribute__((address_space(1))) float* gfp_t;
typedef const __attribute__((address_space(1))) f32x4* gf4p_t;
__device__ __forceinline__ gfp_t ldin(const unsigned char* smem, int i) {
    const unsigned long long v = ((const unsigned long long*)(smem + PTAB_OFF))[i];
    const unsigned lo = __builtin_amdgcn_readfirstlane((unsigned)v), hi = __builtin_amdgcn_readfirstlane((unsigned)(v >> 32));
    return (gfp_t)(((unsigned long long)hi << 32) | lo);
}
#define INP(i) ldin(smem, (i))
__device__ __forceinline__ int otid() { int t = threadIdx.x; asm volatile("" : "+v"(t)); return t; }

__device__ __forceinline__ float bf2f(bf16_t b) { return __uint_as_float(((unsigned)b) << 16); }
__device__ __forceinline__ bf16_t f2bf(float f) { unsigned u = __float_as_uint(f); u += 0x7FFFu + ((u >> 16) & 1u); return (bf16_t)(u >> 16); }
__device__ __forceinline__ unsigned pk2(float lo, float hi) { return (unsigned)f2bf(lo) | ((unsigned)f2bf(hi) << 16); }
__device__ __forceinline__ float sigm(float x) { return __builtin_amdgcn_rcpf(1.0f + __expf(-x)); }
__device__ __forceinline__ float gelu_t(float x) { const float v = 1.5957691216f * (x + 0.044715f * x * x * x); return x * __builtin_amdgcn_rcpf(1.0f + __expf(-v)); }
__device__ __forceinline__ void lds_wait() { asm volatile("s_waitcnt lgkmcnt(0)" ::: "memory"); __builtin_amdgcn_wave_barrier(); }
__device__ __forceinline__ f32x4 mfma16(bf16x8 a, bf16x8 b, f32x4 c) { return __builtin_amdgcn_mfma_f32_16x16x32_bf16(a, b, c, 0, 0, 0); }

namespace pg8 {
constexpr int BM = 256, BK = 64, HALF = 128, HTB = HALF * BK * 2, STAGE_BYTES = 8 * HTB, NXCD = 8, WGM = 8;
__device__ __forceinline__ int lds_byte(int r, int c) { const int st = (r >> 4) * 2 + (c >> 5), rr = r & 15, cc = c & 31, ob = rr * 64 + cc * 2; return st * 1024 + (ob ^ (((ob >> 9) & 1) << 5)); }
__device__ __forceinline__ void stage_rc(int b, int& R, int& C) { const int st = b / 1024, sb = b % 1024, swz = sb ^ (((sb >> 9) & 1) << 5); R = (st >> 1) * 16 + swz / 64; C = (st & 1) * 32 + (swz % 64) / 2; }

struct Unit { int pm, pn, br; };
struct Gemm { const bf16_t* A; const bf16_t* Bt; int lda, ldb, nM, nN, nt; const bf16_t* A2; };

struct SchedOne {
    int pm, pn, nt0;
    __device__ bool next(int i, Unit& u) const { if (i != 0) return false; u.pm = pm; u.pn = pn; u.br = 0; return true; }
    __device__ __forceinline__ void kr(const Unit&, size_t& koffB, int& nt) const { koffB = 0; nt = nt0; }
};
template <int NBR> struct Sched {
    int nM, nN, nwg, G, c, nt0, fullk;
    __device__ void init(int nM_, int nN_, int G_, int c_, int nt_) { nM = nM_; nN = nN_; nwg = nM * nN; G = G_; c = c_; nt0 = nt_; fullk = 0; }
    __device__ bool next(int i, Unit& u) const {
        int wgid;
        if (NBR == 2) {
            const long L = (long)i * G + c; if (L >= 2 * (long)nwg) return false;
            u.br = (int)(L / nwg); wgid = (int)(L - (long)u.br * nwg);
        } else {
            const int ti = i / NBR; u.br = i - ti * NBR;
            const long L = (long)ti * G + c; if (L >= nwg) return false;
            wgid = (int)L;
        } { const int q = nwg / NXCD, r = nwg % NXCD, xcd = wgid % NXCD, off = wgid / NXCD; wgid = (xcd < r ? xcd * (q + 1) : r * (q + 1) + (xcd - r) * q) + off; }
        const int nig = WGM * nN, gid = wgid / nig, fm = gid * WGM, gsz = (nM - fm) < WGM ? (nM - fm) : WGM;
        u.pm = fm + ((wgid % nig) % gsz); u.pn = (wgid % nig) / gsz; return true;
    }
    __device__ __forceinline__ void kr(const Unit& u, size_t& koffB, int& nt) const {
        if (NBR == 1) { koffB = 0; nt = nt0; }
        else if (NBR == 2) { if (fullk) { nt = nt0; koffB = 0; } else { nt = nt0 >> 1; koffB = (size_t)u.br * (size_t)nt * 128; } }
        else { koffB = (size_t)u.br * 1536; nt = (u.br == 2) ? 16 : 12; }
    }
};

struct SchedBr2 {
    int nM, nN, nwg, G, c;
    __device__ void init(int nM_, int nN_, int G_, int c_) { nM = nM_; nN = nN_; nwg = nM * nN; G = G_; c = c_; }
    __device__ bool next(int i, Unit& u) const {
        const int ti = i / 3, b = i - ti * 3;
        const long L = (long)ti * G + c; if (L >= 2 * (long)nwg) return false;
        const int half = (int)(L / nwg); int wgid = (int)(L - (long)half * nwg);
        { const int q = nwg / NXCD, r = nwg % NXCD, xcd = wgid % NXCD, off = wgid / NXCD; wgid = (xcd < r ? xcd * (q + 1) : r * (q + 1) + (xcd - r) * q) + off; }
        const int nig = WGM * nN, gid = wgid / nig, fm = gid * WGM, gsz = (nM - fm) < WGM ? (nM - fm) : WGM;
        u.pm = fm + ((wgid % nig) % gsz); u.pn = (wgid % nig) / gsz; u.br = b + 4 * half; return true;
    }
    __device__ __forceinline__ void kr(const Unit& u, size_t& koffB, int& nt) const {
        const int b = u.br & 3, half = u.br >> 2; nt = (b == 2) ? 8 : 6; koffB = (size_t)b * 1536 + (size_t)half * nt * 128;
    }
};
__device__ __forceinline__ unsigned cvt_pk_bf16(float lo, float hi) { unsigned r; asm volatile("s_nop 1\n\tv_cvt_pk_bf16_f32 %0, %1, %2" : "=v"(r) : "v"(lo), "v"(hi)); return r; }

template <class Epi, class SchedT>
__device__ __forceinline__ void gemm_phase(LAS unsigned char* lds, const Gemm g, const SchedT& S, const Epi& E) {
    const int tid = otid(), wid = __builtin_amdgcn_readfirstlane(tid >> 6), lane = tid & 63, wr = wid >> 2, wc = wid & 3, fr = lane & 15, fq = lane >> 4;
    unsigned voffA[2], voffB[2];
#pragma unroll
    for (int i = 0; i < 2; ++i) { int R, C; stage_rc(tid * 16 + i * 8192, R, C);
        voffA[i] = (unsigned)(R * g.lda + C) * 2u; voffB[i] = (unsigned)(R * g.ldb + C) * 2u; }
    const size_t kstep = (size_t)(BK * 2);
    const size_t hstepA = (size_t)HALF * g.lda * 2, hstepB = (size_t)HALF * g.ldb * 2;
    const size_t tstepA = 2 * hstepA, tstepB = 2 * hstepB;
    const unsigned ldsw = (unsigned)wid * 1024u;
    const int aoff = lds_byte(wr * 64 + fr, fq * 8), boff = lds_byte(wc * 32 + fr, fq * 8);
#define PG8_SA(b, h) (((b) * 2 + (h)) * HTB)
#define PG8_SB(b, h) ((4 + (b) * 2 + (h)) * HTB)
#define PG8_STAGE(bufoff, gbase, voff) do { _Pragma("unroll") for (int _i = 0; _i < 2; ++_i) \
        __builtin_amdgcn_global_load_lds((const unsigned*)((const char*)(gbase) + (voff)[_i]), (LAS unsigned*)(lds + (bufoff) + ldsw + _i * 8192), 16, 0, DMA_AUX); } while (0)
#define PG8_LDA(dst, b, h) do { _Pragma("unroll") for (int m = 0; m < 4; ++m) _Pragma("unroll") for (int k = 0; k < 2; ++k) dst[m][k] = *(const LAS bf16x8*)(lds + PG8_SA(b, h) + aoff + m * 2048 + k * 1024); } while (0)
#define PG8_LDB(dst, b, h) do { _Pragma("unroll") for (int n = 0; n < 2; ++n) _Pragma("unroll") for (int k = 0; k < 2; ++k) dst[n][k] = *(const LAS bf16x8*)(lds + PG8_SB(b, h) + boff + n * 2048 + k * 1024); } while (0)
#define PG8_MMA(ai, bj, At, Bt) do { __builtin_amdgcn_s_setprio(1); _Pragma("unroll") for (int m = 0; m < 4; ++m) _Pragma("unroll") for (int n = 0; n < 2; ++n) _Pragma("unroll") for (int k = 0; k < 2; ++k) \
        acc[ai][bj][m][n] = __builtin_amdgcn_mfma_f32_16x16x32_bf16(Bt[n][k], At[m][k], acc[ai][bj][m][n], 0, 0, 0); __builtin_amdgcn_s_setprio(0); } while (0)
#define PG8_WAIT_V(n) asm volatile("s_waitcnt vmcnt(" #n ")" ::: "memory")
#define PG8_WAIT_L(n) asm volatile("s_waitcnt lgkmcnt(" #n ")" ::: "memory")
#define PG8_BAR __builtin_amdgcn_s_barrier()
#define PG8_SCHED __builtin_amdgcn_sched_barrier(0)
    Unit cur, nxt; int ui = 0;
    if (!S.next(0, cur)) return;
    f32x4 acc[2][2][4][2];
#pragma unroll
    for (int a = 0; a < 2; ++a)
#pragma unroll
        for (int b = 0; b < 2; ++b)
#pragma unroll
            for (int m = 0; m < 4; ++m)
#pragma unroll
                for (int n = 0; n < 2; ++n) acc[a][b][m][n] = (f32x4){0.f, 0.f, 0.f, 0.f};
    bf16x8 At[4][2], B0[2][2], B1[2][2];
    size_t koc; int ntc; S.kr(cur, koc, ntc);
    const char* cA = (const char*)((g.A2 && cur.br) ? g.A2 : g.A) + (size_t)cur.pm * tstepA + koc; const char* cB = (const char*)g.Bt + (size_t)cur.pn * tstepB + koc;
    PG8_STAGE(PG8_SB(0, 0), cB, voffB); PG8_STAGE(PG8_SA(0, 0), cA, voffA); PG8_STAGE(PG8_SB(0, 1), cB + hstepB, voffB); PG8_STAGE(PG8_SA(0, 1), cA + hstepA, voffA);
    if (wr == 1) PG8_BAR;
    PG8_WAIT_V(4); PG8_BAR;
    PG8_STAGE(PG8_SB(1, 0), cB + kstep, voffB); PG8_STAGE(PG8_SA(1, 0), cA + kstep, voffA); PG8_STAGE(PG8_SB(1, 1), cB + hstepB + kstep, voffB);
    PG8_WAIT_V(6); PG8_BAR;
    for (;;) {
        const bool has_next = S.next(ui + 1, nxt);
        size_t kon = 0; int ntn = ntc; if (has_next) S.kr(nxt, kon, ntn);
        const char* nA = has_next ? (const char*)((g.A2 && nxt.br) ? g.A2 : g.A) + (size_t)nxt.pm * tstepA + kon : cA; const char* nB = has_next ? (const char*)g.Bt + (size_t)nxt.pn * tstepB + kon : cB;
        for (int t = 0; t < ntc; t += 2) {
            const bool last = (t == ntc - 2);
            const char* a1 = cA + (size_t)(t + 1) * kstep;
            const char* a2 = last ? nA : cA + (size_t)(t + 2) * kstep; const char* b2 = last ? nB : cB + (size_t)(t + 2) * kstep;
            const char* a3 = a2 + kstep; const char* b3 = b2 + kstep;
            PG8_LDB(B0, 0, 0); PG8_SCHED; PG8_LDA(At, 0, 0); PG8_STAGE(PG8_SA(1, 1), a1 + hstepA, voffA);
            PG8_WAIT_L(8); PG8_BAR; PG8_WAIT_L(0); PG8_MMA(0, 0, At, B0); PG8_BAR; PG8_SCHED;
            PG8_LDB(B1, 0, 1); PG8_STAGE(PG8_SB(0, 0), b2, voffB);
            PG8_BAR; PG8_WAIT_L(0); PG8_MMA(0, 1, At, B1); PG8_BAR;
            PG8_LDA(At, 0, 1); PG8_STAGE(PG8_SA(0, 0), a2, voffA);
            PG8_BAR; PG8_WAIT_L(0); PG8_MMA(1, 0, At, B0); PG8_BAR; PG8_SCHED;
            PG8_STAGE(PG8_SB(0, 1), b2 + hstepB, voffB);
            PG8_WAIT_V(6); PG8_BAR; PG8_MMA(1, 1, At, B1); PG8_BAR;
            PG8_LDB(B0, 1, 0); PG8_SCHED; PG8_LDA(At, 1, 0); PG8_STAGE(PG8_SA(0, 1), a2 + hstepA, voffA);
            PG8_WAIT_L(8); PG8_BAR; PG8_WAIT_L(0); PG8_MMA(0, 0, At, B0); PG8_BAR; PG8_SCHED;
            PG8_LDB(B1, 1, 1); PG8_STAGE(PG8_SB(1, 0), b3, voffB);
            PG8_BAR; PG8_WAIT_L(0); PG8_MMA(0, 1, At, B1); PG8_BAR;
            PG8_LDA(At, 1, 1); PG8_STAGE(PG8_SA(1, 0), a3, voffA);
            PG8_BAR; PG8_WAIT_L(0); PG8_MMA(1, 0, At, B0); PG8_BAR; PG8_SCHED;
            PG8_STAGE(PG8_SB(1, 1), b3 + hstepB, voffB);
            PG8_WAIT_V(6); PG8_BAR; PG8_MMA(1, 1, At, B1); PG8_BAR;
        }
        E(acc, cur, wr, wc, fr, fq);
        if (!has_next) break;
#pragma unroll
        for (int a = 0; a < 2; ++a)
#pragma unroll
            for (int b = 0; b < 2; ++b)
#pragma unroll
                for (int m = 0; m < 4; ++m)
#pragma unroll
                    for (int n = 0; n < 2; ++n) acc[a][b][m][n] = (f32x4){0.f, 0.f, 0.f, 0.f};
        cur = nxt; cA = nA; cB = nB; ntc = ntn; ++ui;
    }
    PG8_WAIT_V(0);
    if (wr == 0) PG8_BAR;
    PG8_BAR;
#undef PG8_SA
#undef PG8_SB
#undef PG8_STAGE
#undef PG8_LDA
#undef PG8_LDB
#undef PG8_MMA
#undef PG8_WAIT_V
#undef PG8_WAIT_L
#undef PG8_BAR
#undef PG8_SCHED
}

struct EpiBf {
    bf16_t* O; int ldc; bf16_t* O2;
    __device__ __forceinline__ void operator()(const f32x4 (&acc)[2][2][4][2], const Unit& u, int wr, int wc, int fr, int fq) const {
        const int row0 = u.pm * BM + wr * 64 + fr, col0 = u.pn * BM + wc * 32 + 4 * fq;
        bf16_t* O = u.br ? this->O2 : this->O;
#pragma unroll
        for (int ai = 0; ai < 2; ++ai)
#pragma unroll
            for (int m = 0; m < 4; ++m) { bf16_t* rowp = O + (size_t)(row0 + ai * HALF + m * 16) * ldc + col0;
#pragma unroll
                for (int bj = 0; bj < 2; ++bj)
#pragma unroll
                    for (int n = 0; n < 2; ++n) { const f32x4 v = acc[ai][bj][m][n]; u32x2 o; o.x = cvt_pk_bf16(v[0], v[1]); o.y = cvt_pk_bf16(v[2], v[3]); *(u32x2*)(rowp + bj * HALF + n * 16) = o; } }
    }
};
struct EpiSigBf {
    bf16_t* O; int ldc;
    __device__ __forceinline__ void operator()(const f32x4 (&acc)[2][2][4][2], const Unit& u, int wr, int wc, int fr, int fq) const {
        const int row0 = u.pm * BM + wr * 64 + fr, col0 = u.pn * BM + wc * 32 + 4 * fq;
#pragma unroll
        for (int ai = 0; ai < 2; ++ai)
#pragma unroll
            for (int m = 0; m < 4; ++m) { bf16_t* rowp = O + (size_t)(row0 + ai * HALF + m * 16) * ldc + col0;
#pragma unroll
                for (int bj = 0; bj < 2; ++bj)
#pragma unroll
                    for (int n = 0; n < 2; ++n) { const f32x4 v = acc[ai][bj][m][n]; u32x2 o; o.x = cvt_pk_bf16(sigm(v[0]), sigm(v[1])); o.y = cvt_pk_bf16(sigm(v[2]), sigm(v[3])); *(u32x2*)(rowp + bj * HALF + n * 16) = o; } }
    }
};
struct EpiF32 {
    float* C; int ldc; float* C2;
    __device__ __forceinline__ void operator()(const f32x4 (&acc)[2][2][4][2], const Unit& u, int wr, int wc, int fr, int fq) const {
        const int row0 = u.pm * BM + wr * 64 + fr, col0 = u.pn * BM + wc * 32 + 4 * fq;
        float* C = u.br ? this->C2 : this->C;
#pragma unroll
        for (int ai = 0; ai < 2; ++ai)
#pragma unroll
            for (int m = 0; m < 4; ++m) { float* rowp = C + (size_t)(row0 + ai * HALF + m * 16) * ldc + col0;
#pragma unroll
                for (int bj = 0; bj < 2; ++bj)
#pragma unroll
                    for (int n = 0; n < 2; ++n) *(f32x4*)(rowp + bj * HALF + n * 16) = acc[ai][bj][m][n]; }
    }
};
struct EpiGlu {
    bf16_t* Y; const bf16_t* Z; gfp_t bias;
    __device__ __forceinline__ void operator()(const f32x4 (&acc)[2][2][4][2], const Unit& u, int wr, int wc, int fr, int fq) const {
        const int row0 = u.pm * BM + wr * 64 + fr, col0 = u.pn * BM + wc * 32 + 4 * fq;
#pragma unroll
        for (int ai = 0; ai < 2; ++ai)
#pragma unroll
            for (int m = 0; m < 4; ++m) { const size_t r = (size_t)(row0 + ai * HALF + m * 16);
#pragma unroll
                for (int bj = 0; bj < 2; ++bj)
#pragma unroll
                    for (int n = 0; n < 2; ++n) { const int c = col0 + bj * HALF + n * 16; const f32x4 v = acc[ai][bj][m][n];
                        const u32x2 zz = *(const u32x2*)(Z + r * 768 + c); const f32x4 bb = *(const f32x4*)(bias + c);
                        const float z0 = __uint_as_float(zz.x << 16), z1 = __uint_as_float(zz.x & 0xffff0000u), z2 = __uint_as_float(zz.y << 16), z3 = __uint_as_float(zz.y & 0xffff0000u);
                        u32x2 o; o.x = cvt_pk_bf16(z0 * sigm(v[0] + bb[0]), z1 * sigm(v[1] + bb[1])); o.y = cvt_pk_bf16(z2 * sigm(v[2] + bb[2]), z3 * sigm(v[3] + bb[3]));
                        *(u32x2*)(Y + r * LDY + c) = o; } }
    }
};
struct EpiBranch {
    const bf16_t* Zg; bf16_t* Mo; bf16_t* Mo2;
    __device__ __forceinline__ void operator()(const f32x4 (&acc)[2][2][4][2], const Unit& u, int wr, int wc, int fr, int fq) const {
        const int row0 = u.pm * BM + wr * 64 + fr, col0 = u.pn * BM + wc * 32 + 4 * fq; const int br = u.br & 3; bf16_t* Mo = (u.br >> 2) ? this->Mo2 : this->Mo;
#pragma unroll
        for (int ai = 0; ai < 2; ++ai)
#pragma unroll
            for (int m = 0; m < 4; ++m) { const size_t r = (size_t)(row0 + ai * HALF + m * 16);
#pragma unroll
                for (int bj = 0; bj < 2; ++bj)
#pragma unroll
                    for (int n = 0; n < 2; ++n) { const int c = col0 + bj * HALF + n * 16; const f32x4 v = acc[ai][bj][m][n];
                        const u32x2 gg = *(const u32x2*)(Zg + r * DIN + br * 1024 + c);
                        f32x4 t; t[0] = v[0] * __uint_as_float(gg.x << 16); t[1] = v[1] * __uint_as_float(gg.x & 0xffff0000u);
                        t[2] = v[2] * __uint_as_float(gg.y << 16); t[3] = v[3] * __uint_as_float(gg.y & 0xffff0000u);
                        bf16_t* mp = Mo + r * DM + c;
                        if (br != 0) { u32x2 p; p.x = __hip_atomic_load((const unsigned*)mp, __ATOMIC_RELAXED, __HIP_MEMORY_SCOPE_AGENT); p.y = __hip_atomic_load((const unsigned*)mp + 1, __ATOMIC_RELAXED, __HIP_MEMORY_SCOPE_AGENT); t[0] += __uint_as_float(p.x << 16); t[1] += __uint_as_float(p.x & 0xffff0000u); t[2] += __uint_as_float(p.y << 16); t[3] += __uint_as_float(p.y & 0xffff0000u); }
                        u32x2 o; o.x = cvt_pk_bf16(t[0], t[1]); o.y = cvt_pk_bf16(t[2], t[3]); *(u32x2*)mp = o; } }
    }
};

#ifndef GEMM_SIMPLE
#define GEMM_SIMPLE 0
#endif
template <class Epi, class SchedT>
__device__ __forceinline__ void gemm_simple(LAS unsigned char* lds, const Gemm g, const SchedT& S, const Epi& E) {
    const int tid = otid(), wid = __builtin_amdgcn_readfirstlane(tid >> 6), lane = tid & 63, wr = wid >> 2, wc = wid & 3, fr = lane & 15, fq = lane >> 4;
    unsigned voffA[2], voffB[2];
#pragma unroll
    for (int i = 0; i < 2; ++i) { int R, C; stage_rc(tid * 16 + i * 8192, R, C);
        voffA[i] = (unsigned)(R * g.lda + C) * 2u; voffB[i] = (unsigned)(R * g.ldb + C) * 2u; }
    const size_t hstepA = (size_t)HALF * g.lda * 2, hstepB = (size_t)HALF * g.ldb * 2;
    const int aoff = lds_byte(wr * 64 + fr, fq * 8), boff = lds_byte(wc * 32 + fr, fq * 8);
    Unit cur;
    for (int ui = 0; S.next(ui, cur); ++ui) {
        size_t koc; int ntc; S.kr(cur, koc, ntc);
        const char* cA = (const char*)((g.A2 && cur.br) ? g.A2 : g.A) + (size_t)cur.pm * 2 * hstepA + koc; const char* cB = (const char*)g.Bt + (size_t)cur.pn * 2 * hstepB + koc;
        f32x4 acc[2][2][4][2];
#pragma unroll
        for (int a = 0; a < 2; ++a)
#pragma unroll
            for (int b = 0; b < 2; ++b)
#pragma unroll
                for (int m = 0; m < 4; ++m)
#pragma unroll
                    for (int n = 0; n < 2; ++n) acc[a][b][m][n] = (f32x4){0.f, 0.f, 0.f, 0.f};
        for (int t = 0; t < ntc; ++t) {
            u32x4 ra[2][2], rb[2][2];
#pragma unroll
            for (int h = 0; h < 2; ++h)
#pragma unroll
                for (int i = 0; i < 2; ++i) { ra[h][i] = *(const u32x4*)(cA + (size_t)t * 128 + h * hstepA + voffA[i]); rb[h][i] = *(const u32x4*)(cB + (size_t)t * 128 + h * hstepB + voffB[i]); }
            __syncthreads();
#pragma unroll
            for (int h = 0; h < 2; ++h)
#pragma unroll
                for (int i = 0; i < 2; ++i) { *(LAS u32x4*)(lds + h * HTB + tid * 16 + i * 8192) = ra[h][i]; *(LAS u32x4*)(lds + (4 + h) * HTB + tid * 16 + i * 8192) = rb[h][i]; }
            __syncthreads();
#pragma unroll
            for (int ai = 0; ai < 2; ++ai) {
                bf16x8 At[4][2];
#pragma unroll
                for (int m = 0; m < 4; ++m)
#pragma unroll
                    for (int k = 0; k < 2; ++k) At[m][k] = *(const LAS bf16x8*)(lds + ai * HTB + aoff + m * 2048 + k * 1024);
#pragma unroll
                for (int bj = 0; bj < 2; ++bj) {
                    bf16x8 Bf[2][2];
#pragma unroll
                    for (int n = 0; n < 2; ++n)
#pragma unroll
                        for (int k = 0; k < 2; ++k) Bf[n][k] = *(const LAS bf16x8*)(lds + (4 + bj) * HTB + boff + n * 2048 + k * 1024);
#pragma unroll
                    for (int m = 0; m < 4; ++m)
#pragma unroll
                        for (int n = 0; n < 2; ++n)
#pragma unroll
                            for (int k = 0; k < 2; ++k) acc[ai][bj][m][n] = __builtin_amdgcn_mfma_f32_16x16x32_bf16(Bf[n][k], At[m][k], acc[ai][bj][m][n], 0, 0, 0);
                }
            }
        }
        E(acc, cur, wr, wc, fr, fq);
    }
    __syncthreads();
}
template <class Epi, class SchedT>
__device__ __forceinline__ void gemm_run(LAS unsigned char* lds, const Gemm g, const SchedT& S, const Epi& E) {
#if GEMM_SIMPLE
    gemm_simple(lds, g, S, E);
#else
    gemm_phase(lds, g, S, E);
#endif
}
}

__device__ __forceinline__ void transpose_tile(gfp_t W, int N, bf16_t* __restrict__ dst, int ldd, int koff, int tk, int tn, float* tile) {
    const int tid = otid(), a = tid >> 6, bq = tid & 63;
    __syncthreads();
#pragma unroll
    for (int i = 0; i < 8; ++i) { const int k = a + 8 * i; tile[k * 65 + bq] = W[(size_t)(tk * 64 + k) * N + tn * 64 + bq]; }
    __syncthreads();
#pragma unroll
    for (int i = 0; i < 8; ++i) { const int n = a + 8 * i; dst[(size_t)(tn * 64 + n) * ldd + koff + tk * 64 + bq] = f2bf(tile[bq * 65 + n]); }
}

__device__ __forceinline__ f32x4 ldx4(const bf16_t* p) { const u32x2 v = *(const u32x2*)p; f32x4 r; r[0] = __uint_as_float(v.x << 16); r[1] = __uint_as_float(v.x & 0xffff0000u); r[2] = __uint_as_float(v.y << 16); r[3] = __uint_as_float(v.y & 0xffff0000u); return r; }
__device__ __forceinline__ void stx4(bf16_t* p, const f32x4 v) { u32x2 o; o.x = pk2(v[0], v[1]); o.y = pk2(v[2], v[3]); *(u32x2*)p = o; }
__device__ __forceinline__ float row16_sum(float v) {
    v += __builtin_bit_cast(float, __builtin_amdgcn_update_dpp(0, __builtin_bit_cast(int, v), 0xB1, 0xF, 0xF, true));
    v += __builtin_bit_cast(float, __builtin_amdgcn_update_dpp(0, __builtin_bit_cast(int, v), 0x4E, 0xF, 0xF, true));
    v += __builtin_bit_cast(float, __builtin_amdgcn_update_dpp(0, __builtin_bit_cast(int, v), 0x141, 0xF, 0xF, true));
    v += __builtin_bit_cast(float, __builtin_amdgcn_update_dpp(0, __builtin_bit_cast(int, v), 0x140, 0xF, 0xF, true));
    return v;
}
__device__ __forceinline__ float wave_sum(float v) {
    v = row16_sum(v);
    const int iv = __builtin_bit_cast(int, v);
    const float a = __builtin_bit_cast(float, __builtin_amdgcn_readlane(iv, 0)), b = __builtin_bit_cast(float, __builtin_amdgcn_readlane(iv, 16));
    const float c = __builtin_bit_cast(float, __builtin_amdgcn_readlane(iv, 32)), d = __builtin_bit_cast(float, __builtin_amdgcn_readlane(iv, 48));
    return (a + b) + (c + d);
}
__device__ __forceinline__ void rms_store_r(const f32x4 (&xv)[4], const f32x4 (&gr)[4], bf16_t* dst, int lane) {
    float ss = 0.f;
#pragma unroll
    for (int i = 0; i < 4; ++i) ss += xv[i][0] * xv[i][0] + xv[i][1] * xv[i][1] + xv[i][2] * xv[i][2] + xv[i][3] * xv[i][3];
    ss = wave_sum(ss);
    const float rs = rsqrtf(ss * (1.0f / DM) + EPS);
#pragma unroll
    for (int i = 0; i < 4; ++i) { const int c = lane * 4 + 256 * i; const f32x4 hv = xv[i] * gr[i] * rs;
        u32x2 o; o.x = pk2(hv[0], hv[1]); o.y = pk2(hv[2], hv[3]); *(u32x2*)(dst + c) = o; }
}
__device__ __forceinline__ void rms_store(const f32x4 (&xv)[4], gfp_t g, bf16_t* dst, int lane) {
    float ss = 0.f;
#pragma unroll
    for (int i = 0; i < 4; ++i) ss += xv[i][0] * xv[i][0] + xv[i][1] * xv[i][1] + xv[i][2] * xv[i][2] + xv[i][3] * xv[i][3];
    ss = wave_sum(ss);
    const float rs = rsqrtf(ss * (1.0f / DM) + EPS);
#pragma unroll
    for (int i = 0; i < 4; ++i) { const int c = lane * 4 + 256 * i; const f32x4 gn = *(const f32x4*)(g + c); const f32x4 hv = xv[i] * gn * rs;
        u32x2 o; o.x = pk2(hv[0], hv[1]); o.y = pk2(hv[2], hv[3]); *(u32x2*)(dst + c) = o; }
}
__device__ __forceinline__ void norm_rows(const Params& P, int mode, int l, int grp, const unsigned char* smem) {
    const int tid_ = otid(); const int wid = tid_ >> 6, lane = tid_ & 63;
    bf16_t* __restrict__ X = (bf16_t*)(P.ws + A_X);
    const int gw = blockIdx.x * 8 + wid, nw = gridDim.x * 8;
    if (mode == 0) {
        gfp_t g0p = INP(I_GPREMIX); bf16_t* H = (bf16_t*)(P.ws + R_H);
        for (int row = gw; row < TPAD; row += nw) {
            f32x4 xv[4];
            if (row >= TT) {
#pragma unroll
                for (int i = 0; i < 4; ++i) xv[i] = (f32x4){0.f, 0.f, 0.f, 0.f};
            } else {
                const bool isP = row < TPR; int b = 0, t = 0; if (isP) { b = row / LP; t = row - b * LP; }
                gfp_t src = isP ? (t < 16 ? INP(I_META) + (size_t)t * DM : INP(I_XP) + ((size_t)b * SEQ + (t - 16)) * DM) : INP(I_XS) + (size_t)(row - TPR) * DM;
#pragma unroll
                for (int i = 0; i < 4; ++i) xv[i] = *(const f32x4*)(src + lane * 4 + 256 * i);
            }
#pragma unroll
            for (int i = 0; i < 4; ++i) stx4(X + (size_t)row * DM + lane * 4 + 256 * i, xv[i]);
            if (row < 6192) rms_store(xv, g0p, H + (size_t)row * DM, lane);
        }
        return;
    }
    const Grp G = get_grp(grp);
    const bf16_t* __restrict__ F = (const bf16_t*)(P.ws + R_F) - (size_t)G.g0 * DM;
    const bf16_t* __restrict__ F2 = (const bf16_t*)(P.ws + R_UP) - (size_t)G.g0 * DM;
    bf16_t* __restrict__ H = (bf16_t*)(P.ws + R_H) - (size_t)G.g0 * DM;
    const bool fin = (mode == 2 && l == 1);
    gfp_t gpost = (mode == 1 ? INP(I_GPOSTMIX) : INP(I_GPOSTFFN)) + l * DM;
    gfp_t gffn = INP(I_GPREFFN) + l * DM;
    f32x4 gpr[4], gfr[4];
#pragma unroll
    for (int i = 0; i < 4; ++i) { gpr[i] = *(const f32x4*)(gpost + lane * 4 + 256 * i); gfr[i] = *(const f32x4*)(gffn + lane * 4 + 256 * i); }
#pragma unroll 2
    for (int row = G.g0 + gw; row < G.g0 + G.nrows; row += nw) {
        f32x4 xv[4], fv[4]; float ss = 0.f;
#pragma unroll
        for (int i = 0; i < 4; ++i) { const int c = lane * 4 + 256 * i; xv[i] = ldx4(X + (size_t)row * DM + c);
            { const u32x2 fa = *(const u32x2*)(F + (size_t)row * DM + c), fb = *(const u32x2*)(F2 + (size_t)row * DM + c);
              fv[i][0] = __uint_as_float(fa.x << 16) + __uint_as_float(fb.x << 16); fv[i][1] = __uint_as_float(fa.x & 0xffff0000u) + __uint_as_float(fb.x & 0xffff0000u);
              fv[i][2] = __uint_as_float(fa.y << 16) + __uint_as_float(fb.y << 16); fv[i][3] = __uint_as_float(fa.y & 0xffff0000u) + __uint_as_float(fb.y & 0xffff0000u); }
            ss += fv[i][0] * fv[i][0] + fv[i][1] * fv[i][1] + fv[i][2] * fv[i][2] + fv[i][3] * fv[i][3]; }
        ss = wave_sum(ss);
        const float rs = rsqrtf(ss * (1.0f / DM) + EPS);
#pragma unroll
        for (int i = 0; i < 4; ++i) xv[i] = xv[i] + fv[i] * gpr[i] * rs;
        if (fin) {
            float* dst = nullptr;
            if (row < TPR) { const int b = row / LP, t = row - b * LP; if (t >= 16 && ((OUTMASK >> 0) & 1)) dst = P.out + O_YP + ((size_t)b * SEQ + (t - 16)) * DM; }
            else if ((OUTMASK >> 1) & 1) dst = P.out + O_YS + (size_t)(row - TPR) * DM;
            if (dst) {
#pragma unroll
                for (int i = 0; i < 4; ++i) *(f32x4*)(dst + lane * 4 + 256 * i) = xv[i];
            }
        } else {
#pragma unroll
            for (int i = 0; i < 4; ++i) stx4(X + (size_t)row * DM + lane * 4 + 256 * i, xv[i]);
        }
        if (mode == 1) rms_store_r(xv, gfr, H + (size_t)row * DM, lane);
    }
    if (mode == 2) {
        int nl = l, ng = grp + 1; if (ng == NGRP) { ng = 0; nl = l + 1; }
        if (nl < 2) {
            const Grp N = get_grp(ng); gfp_t gn = INP(I_GPREMIX) + nl * DM; bf16_t* Hn = (bf16_t*)(P.ws + R_H) - (size_t)N.g0 * DM;
            f32x4 gnr[4];
#pragma unroll
            for (int i = 0; i < 4; ++i) gnr[i] = *(const f32x4*)(gn + lane * 4 + 256 * i);
            for (int row = N.g0 + gw; row < N.g0 + N.nrows; row += nw) {
                f32x4 xv[4];
#pragma unroll
                for (int i = 0; i < 4; ++i) xv[i] = ldx4(X + (size_t)row * DM + lane * 4 + 256 * i);
                rms_store_r(xv, gnr, Hn + (size_t)row * DM, lane);
            }
        }
    }
}

__device__ __forceinline__ void phase0(const Params& P, unsigned char* smem) {
    float* tile = (float*)smem;
    constexpr int C0 = 2112, C1 = C0 + 144, C2 = C1 + 192, C3 = C2 + 192, C4 = C3 + 256, C5 = C4 + 256, C6 = C5 + 1408, C7 = C6 + 704;
    for (int id = blockIdx.x; id < 2 * C7; id += gridDim.x) {
        const int l = id / C7; int j = id - l * C7;
        gfp_t W; int N, ldd, koff = 0; bf16_t* dst;
        if (j < C0) { W = INP(I_WIN) + (size_t)l * DM * DIN; N = DIN; dst = (bf16_t*)(P.ws + W_IN) + (size_t)l * DIN * DM; ldd = DM; }
        else if (j < C1) { j -= C0; W = INP(I_WGLU) + (size_t)l * 768 * 768; N = 768; dst = (bf16_t*)(P.ws + W_GLU) + (size_t)l * 768 * 768; ldd = 768; }
        else if (j < C2) { j -= C1; W = INP(I_WBA) + (size_t)l * 768 * DM; N = DM; dst = (bf16_t*)(P.ws + W_BR) + (size_t)l * DM * LDY; ldd = LDY; }
        else if (j < C3) { j -= C2; W = INP(I_WBB) + (size_t)l * 768 * DM; N = DM; dst = (bf16_t*)(P.ws + W_BR) + (size_t)l * DM * LDY; ldd = LDY; koff = 768; }
        else if (j < C4) { j -= C3; W = INP(I_WBC) + (size_t)l * DM * DM; N = DM; dst = (bf16_t*)(P.ws + W_BR) + (size_t)l * DM * LDY; ldd = LDY; koff = 1536; }
        else if (j < C5) { j -= C4; W = INP(I_WOUT) + (size_t)l * DM * DM; N = DM; dst = (bf16_t*)(P.ws + W_OUT) + (size_t)l * DM * DM; ldd = DM; }
        else if (j < C6) { j -= C5; W = INP(I_WUP) + (size_t)l * DM * 2 * DFF; N = 2 * DFF; dst = (bf16_t*)(P.ws + W_UP) + (size_t)l * 2 * DFF * DM; ldd = DM; }
        else { j -= C6; W = INP(I_WDOWN) + (size_t)l * DFF * DM; N = DM; dst = (bf16_t*)(P.ws + W_DOWN) + (size_t)l * DM * DFF; ldd = DFF; }
        const int ntn = N / 64; const int tk = j / ntn, tn = j - tk * ntn;
        transpose_tile(W, N, dst, ldd, koff, tk, tn, tile);
    }
    norm_rows(P, 0, 0, 0, smem);
    float* rt = (float*)(P.ws + A_ROPE);
    for (int i = blockIdx.x * 512 + threadIdx.x; i < 2068 * 32; i += gridDim.x * 512) {
        const int pi = i >> 5, fi = i & 31; const double pos = pi < LP ? (double)pi : (double)(16384 + pi - LP);
        const double inv = exp(-(double)fi * (9.210340371976184 / 32.0));
        double ang = pos * inv; const double k = rint(ang * 0.15915494309189535); ang = ang - k * 6.283185307179586;
        const float af = (float)ang; rt[2 * i] = cosf(af); rt[2 * i + 1] = sinf(af);
    }
    if (blockIdx.x == 0 && threadIdx.x < 64) ((unsigned*)(P.ws + A_CTR))[threadIdx.x] = 0u;
}

__device__ __forceinline__ void ld8(const bf16_t* p, float (&d)[8]) {
    const u32x4 v = *(const u32x4*)p;
#pragma unroll
    for (int i = 0; i < 4; ++i) { d[2 * i] = __uint_as_float(v[i] << 16); d[2 * i + 1] = __uint_as_float(v[i] & 0xffff0000u); }
}
__device__ __forceinline__ void ffn_conv_phase(const Params& P, int l, int grp, const unsigned char* smem) {
    const Grp G = get_grp(grp);
    const bf16_t* __restrict__ UP = (const bf16_t*)(P.ws + R_UP) - (size_t)G.g0 * (2 * DFF); bf16_t* __restrict__ FIN = (bf16_t*)(P.ws + R_FIN) - (size_t)G.g0 * DFF;
    gfp_t cw = INP(I_FCW) + (size_t)l * 3 * DFF; gfp_t cb = INP(I_FCB) + (size_t)l * DFF;
    gfp_t cache = INP(I_FFNC) + (size_t)l * DEC_B * 2 * DFF;
    constexpr int NCG = DFF / 8;
    const int nrun = G.nrows >> 3;
    for (int it = blockIdx.x * 512 + threadIdx.x; it < nrun * NCG; it += gridDim.x * 512) {
        const int ck = it / NCG, c = (it - ck * NCG) * 8, row0 = G.g0 + ck * 8;
        float w0[8], w1[8], w2[8], bs[8];
#pragma unroll
        for (int i = 0; i < 8; ++i) { bs[i] = cb[c + i]; w0[i] = cw[c + i]; w1[i] = cw[DFF + c + i]; w2[i] = cw[2 * DFF + c + i]; }
        float g1[8], g2[8];
#pragma unroll
        for (int r = 0; r < 8; ++r) {
            const int row = row0 + r;
            int b, t, L; const bool isP = row < TPR;
            if (isP) { b = row / LP; t = row - b * LP; L = LP; } else { b = (row - TPR) >> 2; t = (row - TPR) & 3; L = 4; }
            float g0[8], uf[8];
            ld8(UP + (size_t)row * (2 * DFF) + c, g0); ld8(UP + (size_t)row * (2 * DFF) + DFF + c, uf);
            if (r == 0) {
                if (t >= 1) ld8(UP + (size_t)(row - 1) * (2 * DFF) + c, g1);
                else {
#pragma unroll
                    for (int i = 0; i < 8; ++i) g1[i] = isP ? 0.f : cache[((size_t)b * 2 + 1) * DFF + c + i]; }
                if (t >= 2) ld8(UP + (size_t)(row - 2) * (2 * DFF) + c, g2);
                else {
#pragma unroll
                    for (int i = 0; i < 8; ++i) g2[i] = isP ? 0.f : cache[((size_t)b * 2 + t) * DFF + c + i]; }
            } else if (t == 0) {
#pragma unroll
                for (int i = 0; i < 8; ++i) { g1[i] = isP ? 0.f : cache[((size_t)b * 2 + 1) * DFF + c + i]; g2[i] = isP ? 0.f : cache[((size_t)b * 2) * DFF + c + i]; }
            } else if (t == 1) {
#pragma unroll
                for (int i = 0; i < 8; ++i) g2[i] = isP ? 0.f : cache[((size_t)b * 2 + 1) * DFF + c + i];
            }
            float o[8];
#pragma unroll
            for (int i = 0; i < 8; ++i) { const float gc = bs[i] + w0[i] * g2[i] + w1[i] * g1[i] + w2[i] * g0[i]; o[i] = gelu_t(gc) * uf[i]; }
            u32x4 ov; ov[0] = pk2(o[0], o[1]); ov[1] = pk2(o[2], o[3]); ov[2] = pk2(o[4], o[5]); ov[3] = pk2(o[6], o[7]);
            *(u32x4*)(FIN + (size_t)row * DFF + c) = ov;
            if (t >= L - 2) {
                float* dst = isP ? P.out + O_P_FFNC + (((size_t)l * NB + b) * 2 + (t - (L - 2))) * DFF + c : P.out + O_S_FFNC + (((size_t)l * DEC_B + b) * 2 + (t - (L - 2))) * DFF + c;
#pragma unroll
                for (int i = 0; i < 8; ++i) dst[i] = g0[i];
            }
#pragma unroll
            for (int i = 0; i < 8; ++i) { g2[i] = g1[i]; g1[i] = g0[i]; }
        }
    }
}

__device__ __forceinline__ void ret_job(const Params& P, int l, int grp, int b, int h, int g0, unsigned char* smem) {
    const int tid = otid(), w = __builtin_amdgcn_readfirstlane(tid >> 6), lane = tid & 63, fr = lane & 15, fq = lane >> 4;
    bf16_t* sQ = (bf16_t*)smem;
    bf16_t* sK = sQ + 128 * 72;
    bf16_t* sKdT = sK + 128 * 72;
    bf16_t* sVT = sKdT + 64 * 136;
    bf16_t* sST = sVT + 128 * 136;
    bf16_t* sP = sST + 128 * 72 + w * 16 * 136;
    const bf16_t* Z = (const bf16_t*)(P.ws + R_Z) - (size_t)g0 * DIN; bf16_t* Y = (bf16_t*)(P.ws + R_Y) - (size_t)g0 * LDY;
    const float* rope = (const float*)(P.ws + A_ROPE);
    const int L = grp ? 4 : LP, rowb = grp ? TPR + b * 4 : b * LP, tabb = grp ? LP : 0;
    const float lg = log1pf(-exp2f(-5.0f - (float)h));
    gfp_t ng = INP(I_RNG) + (size_t)l * 1024 + h * 128;
    float ngv[8];
#pragma unroll
    for (int et = 0; et < 8; ++et) ngv[et] = ng[16 * et + fr];
    f32x4 accS[4];
    float* Sout = P.out + (grp ? O_S_RET + (((size_t)l * DEC_B + b) * 8 + h) * 8192 : O_P_RET + (((size_t)l * NB + b) * 8 + h) * 8192);
    if (grp) { gfp_t S0 = INP(I_RET) + (((size_t)l * DEC_B + b) * 8 + h) * 8192;
#pragma unroll
        for (int dt = 0; dt < 4; ++dt)
#pragma unroll
            for (int j = 0; j < 4; ++j) accS[dt][j] = S0[(16 * dt + 4 * fq + j) * 128 + 16 * w + fr];
    } else {
#pragma unroll
        for (int dt = 0; dt < 4; ++dt) accS[dt] = (f32x4){0.f, 0.f, 0.f, 0.f};
    }
    __syncthreads();
#pragma unroll
    for (int dt = 0; dt < 4; ++dt) { u32x2 o; o.x = pk2(accS[dt][0], accS[dt][1]); o.y = pk2(accS[dt][2], accS[dt][3]); *(u32x2*)(sST + (16 * w + fr) * 72 + 16 * dt + 4 * fq) = o; }
    const int nch = grp ? 1 : 17;
    u32x4 q1 = {0u, 0u, 0u, 0u}, q2 = q1, k1 = q1, k2 = q1, vv[4];
#define RET_LOAD(ckx) do { const int _t0 = grp ? 0 : ((ckx) == 0 ? 0 : 16 + ((ckx) - 1) * 128), _C = grp ? 4 : ((ckx) == 0 ? 16 : 128); \
        const int _m = tid >> 2, _i0 = (tid & 3) * 8, _m2 = tid & 127, _e0 = (tid >> 7) * 32; \
        q1 = (u32x4){0u, 0u, 0u, 0u}; q2 = q1; k1 = q1; k2 = q1; \
        if (_m < _C) { const size_t _zr = (size_t)(rowb + _t0 + _m) * DIN; \
            q1 = *(const u32x4*)(Z + _zr + ZO_Q + h * 64 + _i0); q2 = *(const u32x4*)(Z + _zr + ZO_Q + h * 64 + 32 + _i0); \
            k1 = *(const u32x4*)(Z + _zr + ZO_K + h * 64 + _i0); k2 = *(const u32x4*)(Z + _zr + ZO_K + h * 64 + 32 + _i0); } \
        _Pragma("unroll") for (int _i = 0; _i < 4; ++_i) vv[_i] = (u32x4){0u, 0u, 0u, 0u}; \
        if (_m2 < _C) { const bf16_t* _vp = Z + (size_t)(rowb + _t0 + _m2) * DIN + ZO_V + h * 128 + _e0; \
            _Pragma("unroll") for (int _i = 0; _i < 4; ++_i) vv[_i] = *(const u32x4*)(_vp + 8 * _i); } } while (0)
    RET_LOAD(0);
    for (int ck = 0; ck < nch; ++ck) {
        const int t0 = grp ? 0 : (ck == 0 ? 0 : 16 + (ck - 1) * 128), C = grp ? 4 : (ck == 0 ? 16 : 128);
        {
            const int m = tid >> 2, i0 = (tid & 3) * 8;
            u32x4 q1w = {0u, 0u, 0u, 0u}, q2w = q1w, k1w = q1w, k2w = q1w;
            float kd1[8], kd2[8];
#pragma unroll
            for (int e = 0; e < 8; ++e) { kd1[e] = 0.f; kd2[e] = 0.f; }
            if (m < C) {
                const float* rp = rope + ((size_t)(tabb + t0 + m) * 32 + i0) * 2;
                const float kdec = __expf(lg * (float)(C - 1 - m));
                float qo1[8], qo2[8], ko1[8], ko2[8];
#pragma unroll
                for (int e = 0; e < 8; ++e) {
                    const float cs = rp[2 * e], sn = rp[2 * e + 1];
                    const unsigned qa = q1[e >> 1], qb = q2[e >> 1], ka = k1[e >> 1], kb = k2[e >> 1];
                    const float x1 = (e & 1) ? __uint_as_float(qa & 0xffff0000u) : __uint_as_float(qa << 16);
                    const float x2 = (e & 1) ? __uint_as_float(qb & 0xffff0000u) : __uint_as_float(qb << 16);
                    const float y1 = ((e & 1) ? __uint_as_float(ka & 0xffff0000u) : __uint_as_float(ka << 16)) * 0.125f;
                    const float y2 = ((e & 1) ? __uint_as_float(kb & 0xffff0000u) : __uint_as_float(kb << 16)) * 0.125f;
                    qo1[e] = x1 * cs - x2 * sn; qo2[e] = x2 * cs + x1 * sn;
                    ko1[e] = y1 * cs - y2 * sn; ko2[e] = y2 * cs + y1 * sn;
                    kd1[e] = ko1[e] * kdec; kd2[e] = ko2[e] * kdec;
                }
#pragma unroll
                for (int e = 0; e < 4; ++e) { q1w[e] = pk2(qo1[2 * e], qo1[2 * e + 1]); q2w[e] = pk2(qo2[2 * e], qo2[2 * e + 1]); k1w[e] = pk2(ko1[2 * e], ko1[2 * e + 1]); k2w[e] = pk2(ko2[2 * e], ko2[2 * e + 1]); }
            }
            *(u32x4*)(sQ + m * 72 + i0) = q1w; *(u32x4*)(sQ + m * 72 + 32 + i0) = q2w;
            *(u32x4*)(sK + m * 72 + i0) = k1w; *(u32x4*)(sK + m * 72 + 32 + i0) = k2w;
#pragma unroll
            for (int e = 0; e < 8; ++e) { sKdT[(i0 + e) * 136 + m] = f2bf(kd1[e]); sKdT[(32 + i0 + e) * 136 + m] = f2bf(kd2[e]); }
            const int m2 = tid & 127, e0 = (tid >> 7) * 32;
#pragma unroll
            for (int i = 0; i < 4; ++i)
#pragma unroll
                for (int e = 0; e < 4; ++e) { sVT[(e0 + 8 * i + 2 * e) * 136 + m2] = (bf16_t)(vv[i][e] & 0xffffu); sVT[(e0 + 8 * i + 2 * e + 1) * 136 + m2] = (bf16_t)(vv[i][e] >> 16); }
        }
        __syncthreads();
        if (ck + 1 < nch) RET_LOAD(ck + 1);
        f32x4 o[8];
        const bool act = (16 * w < C);
        unsigned gcp[4][4];
        if (act) {
#pragma unroll
            for (int j = 0; j < 4; ++j) { const int n = 16 * w + 4 * fq + j; const size_t row = (size_t)(rowb + t0 + (n < C ? n : 0));
#pragma unroll
                for (int e2 = 0; e2 < 4; ++e2) { const bf16_t lo = Z[row * DIN + ZO_GC + h * 128 + 32 * e2 + fr], hi = Z[row * DIN + ZO_GC + h * 128 + 32 * e2 + 16 + fr]; gcp[e2][j] = (unsigned)lo | ((unsigned)hi << 16); } }
        }
        if (act) {
            bf16x8 qf[2];
#pragma unroll
            for (int ks = 0; ks < 2; ++ks) qf[ks] = *(const bf16x8*)(sQ + (16 * w + fr) * 72 + 32 * ks + 8 * fq);
            const int mtN = (w | 1) + 1;
            for (int mt = 0; mt < mtN; ++mt) {
                f32x4 a = {0.f, 0.f, 0.f, 0.f};
#pragma unroll
                for (int ks = 0; ks < 2; ++ks) { const bf16x8 kf = *(const bf16x8*)(sK + (16 * mt + fr) * 72 + 32 * ks + 8 * fq); a = mfma16(qf[ks], kf, a); }
#pragma unroll
                for (int j = 0; j < 4; ++j) { const int d = (16 * w + 4 * fq + j) - (16 * mt + fr); const float v = d >= 0 ? a[j] * __expf(lg * (float)d) : 0.f; sP[(4 * fq + j) * 136 + 16 * mt + fr] = f2bf(v); }
            }
            lds_wait();
#pragma unroll
            for (int et = 0; et < 8; ++et) o[et] = (f32x4){0.f, 0.f, 0.f, 0.f};
            const int ksN = mtN >> 1;
            for (int ks = 0; ks < ksN; ++ks) {
                const bf16x8 pf = *(const bf16x8*)(sP + fr * 136 + 32 * ks + 8 * fq);
#pragma unroll
                for (int et = 0; et < 8; ++et) { const bf16x8 vf = *(const bf16x8*)(sVT + (16 * et + fr) * 136 + 32 * ks + 8 * fq); o[et] = mfma16(pf, vf, o[et]); }
            }
            f32x4 o2[8];
#pragma unroll
            for (int et = 0; et < 8; ++et) o2[et] = (f32x4){0.f, 0.f, 0.f, 0.f};
#pragma unroll
            for (int ks = 0; ks < 2; ++ks)
#pragma unroll
                for (int et = 0; et < 8; ++et) { const bf16x8 sf = *(const bf16x8*)(sST + (16 * et + fr) * 72 + 32 * ks + 8 * fq); o2[et] = mfma16(qf[ks], sf, o2[et]); }
#pragma unroll
            for (int j = 0; j < 4; ++j) { const float sc = __expf(lg * (float)(16 * w + 4 * fq + j + 1));
#pragma unroll
                for (int et = 0; et < 8; ++et) o[et][j] += o2[et][j] * sc; }
        }
        {
            const float gC = __expf(lg * (float)C);
#pragma unroll
            for (int dt = 0; dt < 4; ++dt) accS[dt] = accS[dt] * gC;
            const int ksN = (C + 31) >> 5;
            for (int ks = 0; ks < ksN; ++ks) {
                const bf16x8 vf = *(const bf16x8*)(sVT + (16 * w + fr) * 136 + 32 * ks + 8 * fq);
#pragma unroll
                for (int dt = 0; dt < 4; ++dt) { const bf16x8 kf = *(const bf16x8*)(sKdT + (16 * dt + fr) * 136 + 32 * ks + 8 * fq); accS[dt] = mfma16(kf, vf, accS[dt]); }
            }
        }
        __syncthreads();
#pragma unroll
        for (int dt = 0; dt < 4; ++dt) { u32x2 ow; ow.x = pk2(accS[dt][0], accS[dt][1]); ow.y = pk2(accS[dt][2], accS[dt][3]); *(u32x2*)(sST + (16 * w + fr) * 72 + 16 * dt + 4 * fq) = ow; }
        if (act) {
#pragma unroll
            for (int j = 0; j < 4; ++j) {
                float s = 0.f;
#pragma unroll
                for (int et = 0; et < 8; ++et) s += o[et][j];
                s = row16_sum(s);
                const float mu = s * (1.0f / 128.0f);
                float s2 = 0.f;
#pragma unroll
                for (int et = 0; et < 8; ++et) { const float d = o[et][j] - mu; s2 += d * d; }
                s2 = row16_sum(s2);
                const float rstd = rsqrtf(s2 * (1.0f / 128.0f) + EPS);
                const int n = 16 * w + 4 * fq + j;
                if (n < C) {
                    const size_t row = (size_t)(rowb + t0 + n);
#pragma unroll
                    for (int et = 0; et < 8; ++et) { const int e = 16 * et + fr; const unsigned gw_ = gcp[et >> 1][j]; const float gcv = (et & 1) ? __uint_as_float(gw_ & 0xffff0000u) : __uint_as_float(gw_ << 16);
                        const float yv = gcv * sigm(gcv) * (o[et][j] - mu) * rstd * ngv[et]; Y[row * LDY + 1536 + h * 128 + e] = f2bf(yv); }
                }
            }
        }
    }
    if (grp ? OUT_ON(12) : OUT_ON(6)) {
#pragma unroll
    for (int dt = 0; dt < 4; ++dt)
#pragma unroll
        for (int j = 0; j < 4; ++j) Sout[(16 * dt + 4 * fq + j) * 128 + 16 * w + fr] = accS[dt][j];
    }
}

__device__ __forceinline__ void lru_job(const Params& P, int l, int grp, int jid, int g0, int pb0, unsigned char* smem) {
    const int tid = otid(), w = __builtin_amdgcn_readfirstlane(tid >> 6), lane = tid & 63, fr = lane & 15, fq = lane >> 4;
    bf16_t* sA = (bf16_t*)(smem + w * 10752);
    float* sRI = (float*)(smem + w * 10752 + 2304);
    float* sComb = (float*)(smem + 8 * 10752);
    const bf16_t* Z = (const bf16_t*)(P.ws + R_Z) - (size_t)g0 * DIN; bf16_t* Y = (bf16_t*)(P.ws + R_Y) - (size_t)g0 * LDY;
    const int unit = grp ? jid * 8 + w : jid;
    const int bl = unit / 12, hb = unit - bl * 12, ch = hb * 64 + lane; const int b = grp ? bl : pb0 + bl;
    const int L = grp ? 4 : LP, rowb = grp ? TPR + b * 4 : b * LP;
    float cw[4];
#pragma unroll
    for (int j = 0; j < 4; ++j) cw[j] = INP(I_LCW)[((size_t)l * 4 + j) * 768 + ch];
    const float cb = INP(I_LCB)[l * 768 + ch], ba = INP(I_LBA)[l * 768 + ch], bx = INP(I_LBX)[l * 768 + ch];
    const float lam = INP(I_LAM)[l * 768 + ch];
    const float sp8 = 8.0f * (fmaxf(-lam, 0.f) + log1pf(__expf(-fabsf(lam))));
    bf16x8 Wa[4][2], Wx[4][2];
    { gfp_t wa = INP(I_LWA) + ((size_t)l * 12 + hb) * 4096; gfp_t wx = INP(I_LWX) + ((size_t)l * 12 + hb) * 4096;
#pragma unroll
      for (int nt = 0; nt < 4; ++nt)
#pragma unroll
          for (int ks = 0; ks < 2; ++ks)
#pragma unroll
              for (int j = 0; j < 8; ++j) { const int k = 32 * ks + 8 * fq + j, n = 16 * nt + fr; Wa[nt][ks][j] = (short)f2bf(wa[k * 64 + n]); Wx[nt][ks][j] = (short)f2bf(wx[k * 64 + n]); } }
    float carry = grp ? INP(I_LRUH)[((size_t)l * DEC_B + b) * 768 + ch] : 0.f;
    gfp_t cache = INP(I_LRUC) + ((size_t)l * DEC_B + b) * 3 * 768;
    const int nIter = grp ? 1 : 17;
    __syncthreads();
#ifndef LRU_REP
#define LRU_REP 1
#endif
    bf16_t xn[19];
    { const int tw0 = grp ? 0 : 16 * w;
#pragma unroll
      for (int i = 0; i < 19; ++i) { int t = tw0 - 3 + i; t = t < 0 ? 0 : (t > L - 1 ? L - 1 : t); xn[i] = Z[(size_t)(rowb + t) * DIN + ZO_XB + ch]; } }
    for (int it_ = 0; it_ < nIter * (grp ? 1 : LRU_REP); ++it_) {
        const int it = it_ % nIter; if (LRU_REP > 1 && it_ == nIter) carry = 0.f;
        const int tw = grp ? 0 : it * 128 + 16 * w;
        float xv[19];
#pragma unroll
        for (int i = 0; i < 19; ++i) { const int t = tw - 3 + i; xv[i] = (t >= 0 && t < L) ? bf2f(xn[i]) : 0.f; }
        if (grp) {
#pragma unroll
            for (int i = 0; i < 3; ++i) xv[i] = cache[i * 768 + ch];
        }
        if (it_ + 1 < nIter * (grp ? 1 : LRU_REP)) {
            const int twn = tw + 128;
#pragma unroll
            for (int i = 0; i < 19; ++i) { int t = twn - 3 + i; t = t < 0 ? 0 : (t > L - 1 ? L - 1 : t); xn[i] = Z[(size_t)(rowb + t) * DIN + ZO_XB + ch]; }
        }
        unsigned gtp[8];
#pragma unroll
        for (int i = 0; i < 8; ++i) { const int ta = tw + 2 * i, tb = ta + 1;
            const bf16_t lo = Z[(size_t)(rowb + (ta < L ? ta : L - 1)) * DIN + ZO_GB + ch], hi = Z[(size_t)(rowb + (tb < L ? tb : L - 1)) * DIN + ZO_GB + ch];
            gtp[i] = (unsigned)lo | ((unsigned)hi << 16); }
        float xc[16];
#pragma unroll
        for (int i = 0; i < 16; ++i) { xc[i] = cb + cw[0] * xv[i] + cw[1] * xv[i + 1] + cw[2] * xv[i + 2] + cw[3] * xv[i + 3]; sA[i * 72 + lane] = f2bf(xc[i]); }
        lds_wait();
        bf16x8 af[2];
#pragma unroll
        for (int ks = 0; ks < 2; ++ks) af[ks] = *(const bf16x8*)(sA + fr * 72 + 32 * ks + 8 * fq);
#pragma unroll
        for (int nt = 0; nt < 4; ++nt) {
            f32x4 ra = {0.f, 0.f, 0.f, 0.f}, rx = ra;
            ra = mfma16(af[0], Wa[nt][0], ra); ra = mfma16(af[1], Wa[nt][1], ra);
            rx = mfma16(af[0], Wx[nt][0], rx); rx = mfma16(af[1], Wx[nt][1], rx);
#pragma unroll
            for (int j = 0; j < 4; ++j) { sRI[(4 * fq + j) * 132 + 16 * nt + fr] = ra[j]; sRI[(4 * fq + j) * 132 + 64 + 16 * nt + fr] = rx[j]; }
        }
        lds_wait();
        float hloc[16], ca[16]; float hl = 0.f, cacc = 1.f;
#pragma unroll
        for (int i = 0; i < 16; ++i) {
            const float rp = sRI[i * 132 + lane], ip = sRI[i * 132 + 64 + lane];
            const float r = sigm(rp + ba), ii = sigm(ip + bx);
            const float la = -sp8 * r; float a = __expf(la);
            const float x2 = 2.0f * la;
            const float ser = -x2 * (1.0f + x2 * (0.5f + x2 * (0.16666667f + x2 * (0.041666668f + x2 * 0.0083333338f))));
            const float om = x2 > -0.25f ? ser : 1.0f - __expf(x2);
            float bv = __builtin_amdgcn_sqrtf(om) * ii * xc[i];
            if (tw + i >= L) { a = 1.f; bv = 0.f; }
            hl = a * hl + bv; cacc *= a; hloc[i] = hl; ca[i] = cacc;
        }
        float hin = carry;
        if (!grp) {
            float* sCb = sComb + (it_ & 1) * 1024;
            sCb[(w * 64 + lane) * 2] = cacc; sCb[(w * 64 + lane) * 2 + 1] = hl;
            __syncthreads();
            float run = carry;
#pragma unroll
            for (int ww = 0; ww < 8; ++ww) { if (ww == w) hin = run; run = sCb[(ww * 64 + lane) * 2] * run + sCb[(ww * 64 + lane) * 2 + 1]; }
            carry = run;
        } else carry = hloc[15] + ca[15] * hin;
#pragma unroll
        for (int i = 0; i < 16; ++i) { const int t = tw + i;
            if (t < L) { const size_t row = (size_t)(rowb + t); const float hh = hloc[i] + ca[i] * hin; const unsigned gw_ = gtp[i >> 1]; const float gt = (i & 1) ? __uint_as_float(gw_ & 0xffff0000u) : __uint_as_float(gw_ << 16); Y[row * LDY + 768 + ch] = f2bf(hh * gelu_t(gt)); } }
    }
    if (grp || w == 0) {
        float* ho = grp ? P.out + O_S_LRUH + ((size_t)l * DEC_B + b) * 768 + ch : P.out + O_P_LRUH + ((size_t)l * NB + b) * 768 + ch;
        if (grp ? OUT_ON(10) : OUT_ON(4)) *ho = carry;
        float* co = grp ? P.out + O_S_LRUC + ((size_t)l * DEC_B + b) * 3 * 768 + ch : P.out + O_P_LRUC + ((size_t)l * NB + b) * 3 * 768 + ch;
#pragma unroll
        for (int j = 0; j < 3; ++j) if (grp ? OUT_ON(11) : OUT_ON(5)) co[j * 768] = bf2f(Z[(size_t)(rowb + L - 3 + j) * DIN + ZO_XB + ch]);
    }
}

template <bool FULL>
__device__ __forceinline__ void s5_run(const bf16_t* Z, bf16_t* ZS, float* sBU, bf16_t* sH, const bf16x8 (&Bf)[8], const bf16x8 (&Cf)[4], float abr, float abi, float dsk,
                                       int rowb, int g, int L, int it0, int it1, float& hr, float& hi, int lane, int fr, int fq) {
    u32x4 ufn = {0u, 0u, 0u, 0u}; bf16_t udn[4] = {0, 0, 0, 0};
    { const int t1 = it0 * 16; const int v1 = (L - t1) < 16 ? (L - t1) : 16;
      if (fq < 2 && fr < v1) ufn = *(const u32x4*)(Z + (size_t)(rowb + t1 + fr) * DIN + ZO_UA + g * 16 + 8 * fq);
      if (FULL) {
#pragma unroll
          for (int j = 0; j < 4; ++j) if (4 * fq + j < v1) udn[j] = Z[(size_t)(rowb + t1 + 4 * fq + j) * DIN + ZO_UA + g * 16 + fr]; } }
    for (int it = it0; it < it1; ++it) {
        const int t0 = it * 16; const int valid = (L - t0) < 16 ? (L - t0) : 16;
        const bf16x8 uf = __builtin_bit_cast(bf16x8, ufn);
        bf16_t ud[4];
#pragma unroll
        for (int j = 0; j < 4; ++j) ud[j] = udn[j];
        if (it + 1 < it1) { const int t1 = t0 + 16; const int v1 = (L - t1) < 16 ? (L - t1) : 16;
            ufn = (u32x4){0u, 0u, 0u, 0u};
            if (fq < 2 && fr < v1) ufn = *(const u32x4*)(Z + (size_t)(rowb + t1 + fr) * DIN + ZO_UA + g * 16 + 8 * fq);
            if (FULL) {
#pragma unroll
                for (int j = 0; j < 4; ++j) { udn[j] = 0; if (4 * fq + j < v1) udn[j] = Z[(size_t)(rowb + t1 + 4 * fq + j) * DIN + ZO_UA + g * 16 + fr]; } } }
#pragma unroll
        for (int nt = 0; nt < 8; ++nt) { f32x4 a = {0.f, 0.f, 0.f, 0.f}; a = mfma16(uf, Bf[nt], a);
#pragma unroll
            for (int j = 0; j < 4; ++j) sBU[(4 * fq + j) * 132 + 16 * nt + fr] = a[j]; }
        lds_wait();
#pragma unroll
        for (int i = 0; i < 16; ++i) {
            float bur = sBU[i * 132 + lane], bui = sBU[i * 132 + 64 + lane];
            asm volatile("" : "+v"(bur), "+v"(bui));
            const float msk = (i < valid) ? 1.0f : 0.0f;
            float nr = __builtin_fmaf(abr, hr, bur); asm volatile("" : "+v"(nr));
            nr = __builtin_fmaf(-abi, hi, nr); asm volatile("" : "+v"(nr));
            float ni = __builtin_fmaf(abr, hi, bui); asm volatile("" : "+v"(ni));
            ni = __builtin_fmaf(abi, hr, ni); asm volatile("" : "+v"(ni));
            hr = __builtin_fmaf(msk, nr - hr, hr); hi = __builtin_fmaf(msk, ni - hi, hi);
            asm volatile("" : "+v"(hr), "+v"(hi));
            if (FULL) { sH[i * 136 + lane] = f2bf(hr); sH[i * 136 + 64 + lane] = f2bf(hi); }
        }
        lds_wait();
        if (FULL) {
            f32x4 y = {0.f, 0.f, 0.f, 0.f};
#pragma unroll
            for (int ks = 0; ks < 4; ++ks) { const bf16x8 hf = *(const bf16x8*)(sH + fr * 136 + 32 * ks + 8 * fq); y = mfma16(hf, Cf[ks], y); }
#pragma unroll
            for (int j = 0; j < 4; ++j) { const int t = 4 * fq + j;
                if (t < valid) { const size_t row = (size_t)(rowb + t0 + t); const float u = bf2f(ud[j]); ZS[row * 768 + g * 16 + fr] = f2bf(gelu_t(y[j] + dsk * u)); } }
            lds_wait();
        }
    }
}
__device__ __forceinline__ void cmul(float& ar, float& ai, float br, float bi) { const float r = ar * br - ai * bi, i = ar * bi + ai * br; ar = r; ai = i; }

__device__ __forceinline__ void s5_job(const Params& P, int l, int grp, int jid, int g0, int pb0, unsigned* s5done, unsigned char* smem) {
    const int tid = otid(), w = __builtin_amdgcn_readfirstlane(tid >> 6), lane = tid & 63, fr = lane & 15, fq = lane >> 4;
    float* sBU = (float*)(smem + w * 12800);
    bf16_t* sH = (bf16_t*)(smem + w * 12800 + 8448);
    float* sC = (float*)(smem + 8 * 12800);
    const bf16_t* Z = (const bf16_t*)(P.ws + R_Z) - (size_t)g0 * DIN; bf16_t* ZS = (bf16_t*)(P.ws + R_ZS5) - (size_t)g0 * 768;
    int g, b0;
    if (grp) { const int unit = jid * 8 + w; g = unit % 48; b0 = (unit / 48) * 16; } else { b0 = jid / 48; g = jid - b0 * 48; b0 += pb0; }
    const float dt = __expf(INP(I_LS)[l * 48 + g]);
    float abr = 0.f, abi = 0.f;
    bf16x8 Bf[8];
#pragma unroll
    for (int k = 0; k < 4; ++k) {
        const int p = 16 * k + fr;
        const float lr = INP(I_AR)[((size_t)l * 48 + g) * 64 + p], li = INP(I_AI)[((size_t)l * 48 + g) * 64 + p];
        const float mag = expf(lr * dt), ar_ = mag * cosf(li * dt), ai_ = mag * sinf(li * dt);
        if (k == fq) { abr = ar_; abi = ai_; }
        const float den = lr * lr + li * li, nr = ar_ - 1.0f;
        const float cr = (nr * lr + ai_ * li) / den, ci = (ai_ * lr - nr * li) / den;
        bf16x8 fre, fim;
#pragma unroll
        for (int j = 0; j < 8; ++j) { fre[j] = 0; fim[j] = 0; }
        if (fq < 2) {
            gfp_t bre = INP(I_BR) + (((size_t)l * 48 + g) * 64 + p) * 16 + 8 * fq; gfp_t bim = INP(I_BI) + (((size_t)l * 48 + g) * 64 + p) * 16 + 8 * fq;
#pragma unroll
            for (int j = 0; j < 8; ++j) { const float br_ = bre[j], bi_ = bim[j]; fre[j] = (short)f2bf(cr * br_ - ci * bi_); fim[j] = (short)f2bf(cr * bi_ + ci * br_); }
        }
        Bf[k] = fre; Bf[4 + k] = fim;
    }
    bf16x8 Cf[4];
#pragma unroll
    for (int ks = 0; ks < 4; ++ks) {
        gfp_t cp = (ks < 2 ? INP(I_CR) : INP(I_CI)) + (((size_t)l * 48 + g) * 16 + fr) * 64 + 32 * (ks & 1) + 8 * fq;
        const float sg = ks < 2 ? 1.0f : -1.0f;
#pragma unroll
        for (int j = 0; j < 8; ++j) Cf[ks][j] = (short)f2bf(sg * cp[j]);
    }
    const float dsk = INP(I_D)[l * 768 + g * 16 + fr];
    __syncthreads();
    if (grp) {
        for (int s = 0; s < 16; ++s) {
            const int b = b0 + s; const int rowb = TPR + b * 4;
            float hr = INP(I_S5RE)[(((size_t)l * DEC_B + b) * 48 + g) * 64 + lane], hi = INP(I_S5IM)[(((size_t)l * DEC_B + b) * 48 + g) * 64 + lane];
            s5_run<true>(Z, ZS, sBU, sH, Bf, Cf, abr, abi, dsk, rowb, g, 4, 0, 1, hr, hi, lane, fr, fq);
            P.out[O_S_S5RE + (((size_t)l * DEC_B + b) * 48 + g) * 64 + lane] = hr;
            P.out[O_S_S5IM + (((size_t)l * DEC_B + b) * 48 + g) * 64 + lane] = hi;
        }
    } else {
        const int b = b0, rowb = b * LP;
        const int it0 = w == 0 ? 0 : 17 + 16 * (w - 1), it1 = 17 + 16 * w;
        float hr = 0.f, hi = 0.f;
        s5_run<false>(Z, ZS, sBU, sH, Bf, Cf, abr, abi, dsk, rowb, g, LP, it0, it1, hr, hi, lane, fr, fq);
        sC[(w * 64 + lane) * 2] = hr; sC[(w * 64 + lane) * 2 + 1] = hi;
        float pr = abr, pi = abi, p16r = 0.f, p16i = 0.f;
#pragma unroll
        for (int q = 0; q < 8; ++q) { cmul(pr, pi, pr, pi); if (q == 3) { p16r = pr; p16i = pi; } }
        float qr = pr, qi = pi; cmul(qr, qi, p16r, p16i);
        __syncthreads();
        float cr_ = 0.f, ci_ = 0.f;
        for (int ww = 0; ww < w; ++ww) {
            const float ar2 = ww == 0 ? qr : pr, ai2 = ww == 0 ? qi : pi;
            cmul(cr_, ci_, ar2, ai2);
            cr_ += sC[(ww * 64 + lane) * 2]; ci_ += sC[(ww * 64 + lane) * 2 + 1];
        }
        hr = cr_; hi = ci_;
        s5_run<true>(Z, ZS, sBU, sH, Bf, Cf, abr, abi, dsk, rowb, g, LP, it0, it1, hr, hi, lane, fr, fq);
        if (w == 7) {
            P.out[O_P_S5RE + (((size_t)l * NB + b) * 48 + g) * 64 + lane] = hr;
            P.out[O_P_S5IM + (((size_t)l * NB + b) * 48 + g) * 64 + lane] = hi;
        }
    }
    asm volatile("s_waitcnt vmcnt(0)" ::: "memory");
    __syncthreads();
    if (threadIdx.x == 0) { __threadfence(); asm volatile("s_waitcnt vmcnt(0)" ::: "memory"); atomicAdd(s5done, 1u); }
}

__device__ __forceinline__ void mixers_phase(const Params& P, int l, int rg, unsigned char* smem, int rep) {
    const Grp G = get_grp(rg);
    const int j1 = G.npb * 8, j2 = j1 + G.npb * 12, j3 = j2 + G.npb * 48, j4 = j3 + (G.hasS ? 1024 : 0), j5 = j4 + (G.hasS ? 48 : 0), j6 = j5 + (G.hasS ? 192 : 0), j7 = j6 + G.npan * 12, NJ = j7 + G.npan * 3;
    unsigned* s5done = (unsigned*)(P.ws + A_CTR) + 32 + (l * NGRP + rg) + rep * 16;
    const unsigned s5total = (unsigned)(G.npb * 48 + (G.hasS ? 48 : 0));
    unsigned* ctr = (unsigned*)(P.ws + A_CTR) + (l * NGRP + rg) + rep * 16;
    int* slot = (int*)(smem + LDS_BYTES - 16);
#ifndef STATIC_JOBS
#define STATIC_JOBS 0
#endif
    for (int jj = blockIdx.x;; jj += gridDim.x) {
        __syncthreads();
#if STATIC_JOBS
        const int j = jj; (void)ctr; (void)slot;
#else
        if (threadIdx.x == 0) *slot = (int)atomicAdd(ctr, 1u);
        __syncthreads();
        const int j = *slot;
#endif
        if (j >= NJ) break;
        int type, sg, idx;
        if (j < j1) { type = 0; sg = 0; idx = j; }
        else if (j < j2) { type = 1; sg = 0; idx = j - j1; }
        else if (j < j3) { type = 2; sg = 0; idx = j - j2; }
        else if (j < j4) { type = 0; sg = 1; idx = j - j3; }
        else if (j < j5) { type = 2; sg = 1; idx = j - j4; }
        else if (j < j6) { type = 1; sg = 1; idx = j - j5; }
        else if (j < j7) { type = 4; sg = 0; idx = j - j6; }
        else { type = 3; sg = 0; idx = j - j7; }
        if (type == 4) {
            using namespace pg8;
            Gemm gg{(const bf16_t*)(P.ws + R_H), (const bf16_t*)(P.ws + W_IN) + (size_t)l * DIN * DM, DM, DM, G.npan, DIN / 256, DM / 64, nullptr};
            SchedOne S1{idx / 12, 21 + idx % 12, DM / 64};
            EpiSigBf E{(bf16_t*)(P.ws + R_Z), DIN};
            gemm_run((LAS unsigned char*)smem, gg, S1, E);
            continue;
        }
        if (type == 3) {
            if (threadIdx.x == 0) {
                unsigned sp = 0;
                while (__hip_atomic_load(s5done, __ATOMIC_RELAXED, __HIP_MEMORY_SCOPE_AGENT) < s5total) { __builtin_amdgcn_s_sleep(8); if (++sp > (1u << 22)) break; }
                __threadfence();
                asm volatile("s_waitcnt vmcnt(0)" ::: "memory");
            }
            __syncthreads();
            using namespace pg8;
            Gemm gg{(const bf16_t*)(P.ws + R_ZS5), (const bf16_t*)(P.ws + W_GLU) + (size_t)l * 768 * 768, 768, 768, G.npan, 3, 12, nullptr};
            SchedOne S1{idx / 3, idx % 3, 12};
            EpiGlu E{(bf16_t*)(P.ws + R_Y), (const bf16_t*)(P.ws + R_ZS5), INP(I_BGLU) + l * 768};
            gemm_run((LAS unsigned char*)smem, gg, S1, E);
            continue;
        }
        if (type == 0) ret_job(P, l, sg, (idx >> 3) + (sg ? 0 : G.pb0), idx & 7, G.g0, smem);
        else if (type == 1) lru_job(P, l, sg, idx, G.g0, G.pb0, smem);
        else s5_job(P, l, sg, idx, G.g0, G.pb0, s5done, smem);
    }
}

__device__ __forceinline__ void run_phase(const Params& P, int ph, unsigned char* smem, int rep) {
#ifndef PHSEL
#define PHSEL -1
#endif
#define PSEL(x) (PHSEL < 0 || PHSEL == (x))
    if (ph == 0) { if (PSEL(10)) phase0(P, smem); return; }
    const int l = (ph - 1) / (10 * NGRP), rg = ((ph - 1) / 10) % NGRP, s = (ph - 1) % 10;
    LAS unsigned char* lds = (LAS unsigned char*)smem;
    unsigned char* ws = P.ws;
    using namespace pg8;
    const int G = gridDim.x, c = blockIdx.x;
    const int npan = rg < 2 ? 25 : 19;
    switch (s) {
    case 0: if (PSEL(0)) { Gemm g{(const bf16_t*)(ws + R_H), (const bf16_t*)(ws + W_IN) + (size_t)l * DIN * DM, DM, DM, npan, 21, DM / 64, nullptr};
              Sched<1> S; S.init(g.nM, g.nN, G, c, g.nt); EpiBf E{(bf16_t*)(ws + R_Z), DIN, (bf16_t*)(ws + R_Z)}; gemm_run(lds, g, S, E); } break;
    case 1: if (PSEL(1)) mixers_phase(P, l, rg, smem, rep); break;
    case 2: if (PSEL(2)) { Gemm g{(const bf16_t*)(ws + R_ZS5), (const bf16_t*)(ws + W_GLU) + (size_t)l * 768 * 768, 768, 768, npan, 3, 12, nullptr};
              Sched<1> S; S.init(g.nM, g.nN, G, c, g.nt); EpiGlu E{(bf16_t*)(ws + R_Y), (const bf16_t*)(ws + R_ZS5), INP(I_BGLU) + l * 768}; gemm_run(lds, g, S, E); } break;
    case 3: if (PSEL(3)) { Gemm g{(const bf16_t*)(ws + R_Y), (const bf16_t*)(ws + W_BR) + (size_t)l * DM * LDY, LDY, LDY, npan, 4, 0, nullptr};
              SchedBr2 S; S.init(g.nM, g.nN, G, c); EpiBranch E{(const bf16_t*)(ws + R_Z) + ZO_GATE, (bf16_t*)(ws + R_M), (bf16_t*)(ws + R_M2)}; gemm_run(lds, g, S, E); } break;
    case 4: if (PSEL(4)) { Gemm g{(const bf16_t*)(ws + R_M), (const bf16_t*)(ws + W_OUT) + (size_t)l * DM * DM, DM, DM, npan, 4, 16, (const bf16_t*)(ws + R_M2)};
              Sched<2> S; S.init(g.nM, g.nN, G, c, g.nt); S.fullk = 1;     EpiBf E{(bf16_t*)(ws + R_F), DM, (bf16_t*)(ws + R_UP)}; gemm_run(lds, g, S, E); } break;
    case 5: if (PSEL(5) && rep == 0) norm_rows(P, 1, l, rg, smem); break;
    case 6: if (PSEL(6)) { Gemm g{(const bf16_t*)(ws + R_H), (const bf16_t*)(ws + W_UP) + (size_t)l * 2 * DFF * DM, DM, DM, npan, 22, 16, nullptr};
              Sched<1> S; S.init(g.nM, g.nN, G, c, g.nt); EpiBf E{(bf16_t*)(ws + R_UP), 2 * DFF, (bf16_t*)(ws + R_UP)}; gemm_run(lds, g, S, E); } break;
    case 7: if (PSEL(7)) ffn_conv_phase(P, l, rg, smem); break;
    case 8: if (PSEL(8)) { Gemm g{(const bf16_t*)(ws + R_FIN), (const bf16_t*)(ws + W_DOWN) + (size_t)l * DM * DFF, DFF, DFF, npan, 4, 44, nullptr};
              Sched<2> S; S.init(g.nM, g.nN, G, c, g.nt); EpiBf E{(bf16_t*)(ws + R_F), DM, (bf16_t*)(ws + R_UP)}; gemm_run(lds, g, S, E); } break;
    default: if (PSEL(9) && rep == 0) norm_rows(P, 2, l, rg, smem); break;
    }
}

#define XB_TMO      128
#define XB_XCNT(j)  (256  + 64 * (j))
#define XB_XSUB(j)  (1280 + 64 * (j))
#define XB_XGEN(j)  (2304 + 64 * (j))
#define XB_TOP      3328
#define XB_TOPGEN   3392
#define XCD_BAR_WORDS 3456
#define XB_SPIN_CAP (1u << 18)

__device__ __forceinline__ unsigned xb_ld(unsigned* p)              { return __hip_atomic_load(p, __ATOMIC_RELAXED, __HIP_MEMORY_SCOPE_AGENT); }
__device__ __forceinline__ unsigned xb_add(unsigned* p, unsigned v) { return __hip_atomic_fetch_add(p, v, __ATOMIC_RELAXED, __HIP_MEMORY_SCOPE_AGENT); }
__device__ __forceinline__ unsigned xb_xcc_id() { return (unsigned)__builtin_amdgcn_s_getreg((3 << 11) | 20) & 0xFu; }
#define XB_SPIN(cond, bar) do { unsigned _sp = 0; while (cond) { __builtin_amdgcn_s_sleep(1); \
    if ((++_sp & 255u) == 0u) { if (xb_ld(&(bar)[XB_TMO])) break; if (_sp > XB_SPIN_CAP) { atomicAdd(&(bar)[XB_TMO], 1u); break; } } } } while (0)

struct XcdBarrier {
    unsigned* bar; unsigned x;
    volatile LAS unsigned* st;
};

__device__ __forceinline__ XcdBarrier xcd_barrier_post(unsigned* bar, volatile LAS unsigned* st) {
    XcdBarrier b; b.bar = bar; b.x = xb_xcc_id(); b.st = st;
    if (threadIdx.x == 0) (void)xb_add(&bar[XB_XCNT(b.x)], 1u);
    return b;
}
__device__ __forceinline__ void xcd_barrier_complete(unsigned* bar, unsigned x, unsigned& nloc, unsigned& nx) {
    const unsigned G = gridDim.x * gridDim.y * gridDim.z;
    unsigned sum, cnt, mine, sp = 0u;
    for (;;) {
        sum = 0u; cnt = 0u; mine = 0u;
#pragma unroll
        for (unsigned j = 0; j < 16; ++j) { const unsigned c = xb_ld(&bar[XB_XCNT(j)]); sum += c; cnt += (c > 0u) ? 1u : 0u; mine = (j == x) ? c : mine; }
        if (sum == G) break;
        __builtin_amdgcn_s_sleep(1);
        if ((++sp & 255u) == 0u) { if (xb_ld(&bar[XB_TMO])) break; if (sp > XB_SPIN_CAP) { atomicAdd(&bar[XB_TMO], 1u); break; } }
    }
    nloc = mine > 0u ? mine : 1u; nx = cnt > 0u ? cnt : 1u;
}

__device__ __forceinline__ void xcd_barrier(const XcdBarrier& b) {
    asm volatile("s_waitcnt vmcnt(0)" ::: "memory");
    __syncthreads();
    if (threadIdx.x == 0) {
        unsigned* bar = b.bar;
        __builtin_amdgcn_s_waitcnt(0);
        unsigned nloc = b.st[0], nx = b.st[1];
        if (nloc == 0u) { xcd_barrier_complete(bar, b.x, nloc, nx); b.st[0] = nloc; b.st[1] = nx; }
        const unsigned old = xb_add(&bar[XB_XSUB(b.x)], 1u);
        const unsigned gen = old / nloc;
        if (old + 1u == (gen + 1u) * nloc) {
            __builtin_amdgcn_fence(__ATOMIC_RELEASE, "agent");
            asm volatile("s_waitcnt vmcnt(0)" ::: "memory");
            const unsigned og = xb_add(&bar[XB_TOP], 1u);
            const unsigned tg = og / nx;
            if (og + 1u == (tg + 1u) * nx) xb_add(&bar[XB_TOPGEN], 1u);
            else XB_SPIN(xb_ld(&bar[XB_TOPGEN]) == tg, bar);
            __builtin_amdgcn_fence(__ATOMIC_ACQUIRE, "agent");
            xb_add(&bar[XB_XGEN(b.x)], 1u);
            asm volatile("s_waitcnt vmcnt(0)" ::: "memory");
        } else {
            XB_SPIN(xb_ld(&bar[XB_XGEN(b.x)]) == gen, bar);
            __builtin_amdgcn_fence(__ATOMIC_ACQUIRE, "agent");
            asm volatile("s_waitcnt vmcnt(0)" ::: "memory");
        }
    }
    __syncthreads();
}


__global__ void __launch_bounds__(512, 2) mega(Params P, int ph_lo, int ph_hi) {
    extern __shared__ __attribute__((aligned(16))) unsigned char smem[];
    unsigned* xst = (unsigned*)(smem + LDS_BYTES - 32);
    if (threadIdx.x == 0) {
        const float** tab = (const float**)(smem + PTAB_OFF);
#pragma unroll
        for (int i = 0; i < N_IN; ++i) tab[i] = P.in[i];
        xst[0] = 0u; xst[1] = 0u;
    }
    __syncthreads();
    XcdBarrier xb = xcd_barrier_post((unsigned*)(P.ws + A_BAR), (volatile LAS unsigned*)xst);
#ifndef DUP_MASK
#define DUP_MASK 0x400
#endif
    for (int ph = ph_lo; ph < ph_hi; ++ph) {
        if (ph > 0 && (ph - 1) % 10 == 2) continue;
        int nrep = 1;
        if (DUP_MASK) { const int sidx = ph == 0 ? 10 : (ph - 1) % 10; if ((DUP_MASK >> sidx) & 1) nrep = 2; }
        for (int rep = 0; rep < nrep; ++rep) {
            run_phase(P, ph, smem, rep);
            if (ph + 1 < ph_hi || rep + 1 < nrep) xcd_barrier(xb);
        }
    }
}


#ifndef DBG_STOP
#define DBG_STOP 0
#endif
#ifndef DBG_OFF
#define DBG_OFF R_Z
#endif
__global__ void dbg_dump(const unsigned char* ws, float* out, size_t n) {
    const bf16_t* src = (const bf16_t*)(ws + DBG_OFF);
    for (size_t i = (size_t)blockIdx.x * blockDim.x + threadIdx.x; i < n; i += (size_t)gridDim.x * blockDim.x) out[i] = bf2f(src[i]);
}

extern "C" void kernel_launch(void* const* d_in, const int* in_sizes, int n_in, void* d_out, int out_size, void* d_ws, size_t ws_size, hipStream_t stream) {
    (void)in_sizes; (void)n_in; (void)out_size;
    if (ws_size < WS_TOTAL) { fprintf(stderr, "workspace too small: %zu < %zu\n", ws_size, (size_t)WS_TOTAL); return; }
    Params p{};
    for (int i = 0; i < N_IN; ++i) p.in[i] = (const float*)d_in[i];
    p.out = (float*)d_out; p.ws = (unsigned char*)d_ws;
    hipFuncSetAttribute((const void*)mega, hipFuncAttributeMaxDynamicSharedMemorySize, LDS_BYTES);
    int dev = 0, cus = 256, per_cu = 1;
    hipGetDevice(&dev);
    hipDeviceGetAttribute(&cus, hipDeviceAttributeMultiprocessorCount, dev);
    hipOccupancyMaxActiveBlocksPerMultiprocessor(&per_cu, mega, 512, LDS_BYTES);
    if (per_cu < 1) per_cu = 1;
    const int grid = cus * 1;
#if COOP
#ifndef PH_HI
#define PH_HI NPHASE
#endif
    hipMemsetAsync((unsigned char*)d_ws + A_BAR, 0, 16384, stream);
    int lo = 0, hi = PH_HI;
    void* args[] = {&p, &lo, &hi};
    hipError_t e = hipLaunchCooperativeKernel((void*)mega, dim3(grid), dim3(512), args, LDS_BYTES, stream);
    if (e != hipSuccess) fprintf(stderr, "cooperative launch failed: %s (grid %d)\n", hipGetErrorString(e), grid);
#else
#if DBG_STOP
    for (int ph = 0; ph < DBG_STOP; ++ph) hipLaunchKernelGGL(mega, dim3(grid), dim3(512), LDS_BYTES, stream, p, ph, ph + 1);
#ifdef DBG_EXTRA
    hipLaunchKernelGGL(mega, dim3(grid), dim3(512), LDS_BYTES, stream, p, DBG_EXTRA, DBG_EXTRA + 1);
#endif
    hipLaunchKernelGGL(dbg_dump, dim3(2048), dim3(256), 0, stream, (const unsigned char*)d_ws, (float*)d_out, (size_t)34873344);
#else
    for (int ph = 0; ph < NPHASE; ++ph) hipLaunchKernelGGL(mega, dim3(grid), dim3(512), LDS_BYTES, stream, p, ph, ph + 1);
#endif
#endif
}
```

```cpp
#include <hip/hip_runtime.h>
#include <hip/hip_cooperative_groups.h>
#include <cstdio>
namespace cg = cooperative_groups;

#define DUP_MASK 0
#ifndef COOP
#define COOP 1
#endif
#ifndef OUTMASK
#define OUTMASK 0x3FFF
#endif
#ifndef OUT_BMAX
#define OUT_BMAX 1000
#endif
#ifndef OUT_L
#define OUT_L 3
#endif
#define OUT_ON(k) (((OUTMASK >> (k)) & 1) && ((OUT_L >> l) & 1))
#ifndef DMA_AUX
#define DMA_AUX 0
#endif

#define LAS __attribute__((address_space(3)))
typedef unsigned short bf16_t;
typedef short bf16x8 __attribute__((ext_vector_type(8)));
typedef float f32x4 __attribute__((ext_vector_type(4)));
typedef unsigned u32x4 __attribute__((ext_vector_type(4)));
typedef unsigned u32x2 __attribute__((ext_vector_type(2)));

constexpr int DM = 1024, NB = 8, SEQ = 2048, LP = 2064, DEC_B = 128, DEC_S = 4;
constexpr int TPR = NB * LP;
constexpr int TT = TPR + DEC_B * DEC_S;
constexpr int TPAD = 17152;
constexpr int DIN = 8448, DFF = 2816;
constexpr int ZO_UA = 0, ZO_XB = 768, ZO_GB = 1536, ZO_Q = 2304, ZO_K = 2816, ZO_V = 3328, ZO_GC = 4352, ZO_GATE = 5376;
constexpr int LDY = 2560;
constexpr float EPS = 1e-6f;
constexpr int LDS_BYTES = 143360;

enum { I_XP = 0, I_XS, I_S5RE, I_S5IM, I_LRUH, I_LRUC, I_RET, I_FFNC, I_META, I_GPREMIX, I_GPOSTMIX, I_GPREFFN, I_GPOSTFFN, I_WIN,
       I_AR, I_AI, I_LS, I_BR, I_BI, I_CR, I_CI, I_D, I_WGLU, I_BGLU, I_LCW, I_LCB, I_LWA, I_LBA, I_LWX, I_LBX, I_LAM, I_RNG,
       I_WBA, I_WBB, I_WBC, I_WOUT, I_WUP, I_FCW, I_FCB, I_WDOWN, N_IN };

constexpr size_t O_YP = 0;
constexpr size_t O_YS = O_YP + (size_t)NB * SEQ * DM;
constexpr size_t O_P_S5RE = O_YS + (size_t)DEC_B * DEC_S * DM;
constexpr size_t O_P_S5IM = O_P_S5RE + 2 * NB * 48 * 64;
constexpr size_t O_P_LRUH = O_P_S5IM + 2 * NB * 48 * 64;
constexpr size_t O_P_LRUC = O_P_LRUH + 2 * NB * 768;
constexpr size_t O_P_RET = O_P_LRUC + 2 * NB * 3 * 768;
constexpr size_t O_P_FFNC = O_P_RET + (size_t)2 * NB * 8 * 64 * 128;
constexpr size_t O_S_S5RE = O_P_FFNC + 2 * NB * 2 * DFF;
constexpr size_t O_S_S5IM = O_S_S5RE + 2 * DEC_B * 48 * 64;
constexpr size_t O_S_LRUH = O_S_S5IM + 2 * DEC_B * 48 * 64;
constexpr size_t O_S_LRUC = O_S_LRUH + 2 * DEC_B * 768;
constexpr size_t O_S_RET = O_S_LRUC + 2 * DEC_B * 3 * 768;
constexpr size_t O_S_FFNC = O_S_RET + (size_t)2 * DEC_B * 8 * 64 * 128;

constexpr size_t al256(size_t x) { return (x + 255) & ~(size_t)255; }
constexpr size_t W_IN = 0;
constexpr size_t W_GLU = W_IN + (size_t)2 * DIN * DM * 2;
constexpr size_t W_BR = W_GLU + (size_t)2 * 768 * 768 * 2;
constexpr size_t W_OUT = W_BR + (size_t)2 * DM * LDY * 2;
constexpr size_t W_UP = W_OUT + (size_t)2 * DM * DM * 2;
constexpr size_t W_DOWN = W_UP + (size_t)2 * 2 * DFF * DM * 2;
constexpr size_t A_X = W_DOWN + (size_t)2 * DM * DFF * 2;
constexpr int GR = 6400;
constexpr size_t R_Z = A_X + (size_t)TPAD * DM * 4;
constexpr size_t R_ZS5 = R_Z + (size_t)GR * DIN * 2;
constexpr size_t R_Y = R_ZS5 + (size_t)GR * 768 * 2;
constexpr size_t R_M = R_Y + (size_t)GR * LDY * 2;
constexpr size_t R_END = R_M + (size_t)GR * DM * 2;
constexpr size_t R_H = R_M;
constexpr size_t R_F = R_Z;
constexpr size_t R_UP = R_Z + (size_t)GR * DM * 4;
constexpr size_t R_FIN = R_ZS5;
static_assert(R_UP + (size_t)GR * 2 * DFF * 2 <= R_ZS5, "UP inside Z");
static_assert(R_FIN + (size_t)GR * DFF * 2 <= R_M, "FIN inside ZS5|Y");
constexpr size_t A_ROPE = R_END;
constexpr size_t A_CTR = al256(A_ROPE + (size_t)2068 * 64 * 4);
constexpr size_t A_BAR = A_CTR + 4096;
constexpr size_t WS_TOTAL = A_BAR + 16384;
constexpr size_t R_M2 = A_X + (size_t)40 * 1024 * 1024;
static_assert(A_X + (size_t)TPAD * DM * 2 <= R_M2 && R_M2 + (size_t)GR * DM * 2 <= R_Z, "M2 inside the freed half of the X reservation");
constexpr int NGRP = 3;
constexpr int NPHASE = 1 + 2 * NGRP * 10;

struct Grp { int g0, nrows, npan, pb0, npb, hasS; };
__device__ __forceinline__ Grp get_grp(int g) {
    Grp r; r.g0 = g * 6192; r.nrows = g < 2 ? 6192 : 4640; r.npan = g < 2 ? 25 : 19; r.pb0 = g * 3; r.npb = g < 2 ? 3 : 2; r.hasS = g == 2; return r;
}

struct Params {
    const float* in[N_IN];
    float* out;
    unsigned char* ws;
};


constexpr int PTAB_OFF = 142336;
typedef const __attribute__((address_space(1))) float* gfp_t;
typedef const __attribute__((address_space(1))) f32x4* gf4p_t;
__device__ __forceinline__ gfp_t ldin(const unsigned char* smem, int i) {
    const unsigned long long v = ((const unsigned long long*)(smem + PTAB_OFF))[i];
    const unsigned lo = __builtin_amdgcn_readfirstlane((unsigned)v), hi = __builtin_amdgcn_readfirstlane((unsigned)(v >> 32));
    return (gfp_t)(((unsigned long long)hi << 32) | lo);
}
#define INP(i) ldin(smem, (i))
__device__ __forceinline__ int otid() { int t = threadIdx.x; asm volatile("" : "+v"(t)); return t; }

__device__ __forceinline__ float bf2f(bf16_t b) { return __uint_as_float(((unsigned)b) << 16); }
__device__ __forceinline__ bf16_t f2bf(float f) { unsigned u = __float_as_uint(f); u += 0x7FFFu + ((u >> 16) & 1u); return (bf16_t)(u >> 16); }
__device__ __forceinline__ unsigned pk2(float lo, float hi) { return (unsigned)f2bf(lo) | ((unsigned)f2bf(hi) << 16); }
__device__ __forceinline__ float sigm(float x) { return __builtin_amdgcn_rcpf(1.0f + __expf(-x)); }
__device__ __forceinline__ float gelu_t(float x) { const float v = 1.5957691216f * (x + 0.044715f * x * x * x); return x * __builtin_amdgcn_rcpf(1.0f + __expf(-v)); }
__device__ __forceinline__ void lds_wait() { asm volatile("s_waitcnt lgkmcnt(0)" ::: "memory"); __builtin_amdgcn_wave_barrier(); }
__device__ __forceinline__ f32x4 mfma16(bf16x8 a, bf16x8 b, f32x4 c) { return __builtin_amdgcn_mfma_f32_16x16x32_bf16(a, b, c, 0, 0, 0); }

namespace pg8 {
constexpr int BM = 256, BK = 64, HALF = 128, HTB = HALF * BK * 2, STAGE_BYTES = 8 * HTB, NXCD = 8, WGM = 8;
__device__ __forceinline__ int lds_byte(int r, int c) { const int st = (r >> 4) * 2 + (c >> 5), rr = r & 15, cc = c & 31, ob = rr * 64 + cc * 2; return st * 1024 + (ob ^ (((ob >> 9) & 1) << 5)); }
__device__ __forceinline__ void stage_rc(int b, int& R, int& C) { const int st = b / 1024, sb = b % 1024, swz = sb ^ (((sb >> 9) & 1) << 5); R = (st >> 1) * 16 + swz / 64; C = (st & 1) * 32 + (swz % 64) / 2; }

struct Unit { int pm, pn, br; };
struct Gemm { const bf16_t* A; const bf16_t* Bt; int lda, ldb, nM, nN, nt; const bf16_t* A2; };

struct SchedOne {
    int pm, pn, nt0;
    __device__ bool next(int i, Unit& u) const { if (i != 0) return false; u.pm = pm; u.pn = pn; u.br = 0; return true; }
    __device__ __forceinline__ void kr(const Unit&, size_t& koffB, int& nt) const { koffB = 0; nt = nt0; }
};
template <int NBR> struct Sched {
    int nM, nN, nwg, G, c, nt0, fullk;
    __device__ void init(int nM_, int nN_, int G_, int c_, int nt_) { nM = nM_; nN = nN_; nwg = nM * nN; G = G_; c = c_; nt0 = nt_; fullk = 0; }
    __device__ bool next(int i, Unit& u) const {
        int wgid;
        if (NBR == 2) {
            const long L = (long)i * G + c; if (L >= 2 * (long)nwg) return false;
            u.br = (int)(L / nwg); wgid = (int)(L - (long)u.br * nwg);
        } else {
            const int ti = i / NBR; u.br = i - ti * NBR;
            const long L = (long)ti * G + c; if (L >= nwg) return false;
            wgid = (int)L;
        } { const int q = nwg / NXCD, r = nwg % NXCD, xcd = wgid % NXCD, off = wgid / NXCD; wgid = (xcd < r ? xcd * (q + 1) : r * (q + 1) + (xcd - r) * q) + off; }
        const int nig = WGM * nN, gid = wgid / nig, fm = gid * WGM, gsz = (nM - fm) < WGM ? (nM - fm) : WGM;
        u.pm = fm + ((wgid % nig) % gsz); u.pn = (wgid % nig) / gsz; return true;
    }
    __device__ __forceinline__ void kr(const Unit& u, size_t& koffB, int& nt) const {
        if (NBR == 1) { koffB = 0; nt = nt0; }
        else if (NBR == 2) { if (fullk) { nt = nt0; koffB = 0; } else { nt = nt0 >> 1; koffB = (size_t)u.br * (size_t)nt * 128; } }
        else { koffB = (size_t)u.br * 1536; nt = (u.br == 2) ? 16 : 12; }
    }
};

struct SchedBr2 {
    int nM, nN, nwg, G, c;
    __device__ void init(int nM_, int nN_, int G_, int c_) { nM = nM_; nN = nN_; nwg = nM * nN; G = G_; c = c_; }
    __device__ bool next(int i, Unit& u) const {
        const int ti = i / 3, b = i - ti * 3;
        const long L = (long)ti * G + c; if (L >= 2 * (long)nwg) return false;
        const int half = (int)(L / nwg); int wgid = (int)(L - (long)half * nwg);
        { const int q = nwg / NXCD, r = nwg % NXCD, xcd = wgid % NXCD, off = wgid / NXCD; wgid = (xcd < r ? xcd * (q + 1) : r * (q + 1) + (xcd - r) * q) + off; }
        const int nig = WGM * nN, gid = wgid / nig, fm = gid * WGM, gsz = (nM - fm) < WGM ? (nM - fm) : WGM;
        u.pm = fm + ((wgid % nig) % gsz); u.pn = (wgid % nig) / gsz; u.br = b + 4 * half; return true;
    }
    __device__ __forceinline__ void kr(const Unit& u, size_t& koffB, int& nt) const {
        const int b = u.br & 3, half = u.br >> 2; nt = (b == 2) ? 8 : 6; koffB = (size_t)b * 1536 + (size_t)half * nt * 128;
    }
};
__device__ __forceinline__ unsigned cvt_pk_bf16(float lo, float hi) { unsigned r; asm volatile("s_nop 1\n\tv_cvt_pk_bf16_f32 %0, %1, %2" : "=v"(r) : "v"(lo), "v"(hi)); return r; }

template <class Epi, class SchedT>
__device__ __forceinline__ void gemm_phase(LAS unsigned char* lds, const Gemm g, const SchedT& S, const Epi& E) {
    const int tid = otid(), wid = __builtin_amdgcn_readfirstlane(tid >> 6), lane = tid & 63, wr = wid >> 2, wc = wid & 3, fr = lane & 15, fq = lane >> 4;
    unsigned voffA[2], voffB[2];
#pragma unroll
    for (int i = 0; i < 2; ++i) { int R, C; stage_rc(tid * 16 + i * 8192, R, C);
        voffA[i] = (unsigned)(R * g.lda + C) * 2u; voffB[i] = (unsigned)(R * g.ldb + C) * 2u; }
    const size_t kstep = (size_t)(BK * 2);
    const size_t hstepA = (size_t)HALF * g.lda * 2, hstepB = (size_t)HALF * g.ldb * 2;
    const size_t tstepA = 2 * hstepA, tstepB = 2 * hstepB;
    const unsigned ldsw = (unsigned)wid * 1024u;
    const int aoff = lds_byte(wr * 64 + fr, fq * 8), boff = lds_byte(wc * 32 + fr, fq * 8);
#define PG8_SA(b, h) (((b) * 2 + (h)) * HTB)
#define PG8_SB(b, h) ((4 + (b) * 2 + (h)) * HTB)
#define PG8_STAGE(bufoff, gbase, voff) do { _Pragma("unroll") for (int _i = 0; _i < 2; ++_i) \
        __builtin_amdgcn_global_load_lds((const unsigned*)((const char*)(gbase) + (voff)[_i]), (LAS unsigned*)(lds + (bufoff) + ldsw + _i * 8192), 16, 0, DMA_AUX); } while (0)
#define PG8_LDA(dst, b, h) do { _Pragma("unroll") for (int m = 0; m < 4; ++m) _Pragma("unroll") for (int k = 0; k < 2; ++k) dst[m][k] = *(const LAS bf16x8*)(lds + PG8_SA(b, h) + aoff + m * 2048 + k * 1024); } while (0)
#define PG8_LDB(dst, b, h) do { _Pragma("unroll") for (int n = 0; n < 2; ++n) _Pragma("unroll") for (int k = 0; k < 2; ++k) dst[n][k] = *(const LAS bf16x8*)(lds + PG8_SB(b, h) + boff + n * 2048 + k * 1024); } while (0)
#define PG8_MMA(ai, bj, At, Bt) do { __builtin_amdgcn_s_setprio(1); _Pragma("unroll") for (int m = 0; m < 4; ++m) _Pragma("unroll") for (int n = 0; n < 2; ++n) _Pragma("unroll") for (int k = 0; k < 2; ++k) \
        acc[ai][bj][m][n] = __builtin_amdgcn_mfma_f32_16x16x32_bf16(Bt[n][k], At[m][k], acc[ai][bj][m][n], 0, 0, 0); __builtin_amdgcn_s_setprio(0); } while (0)
#define PG8_WAIT_V(n) asm volatile("s_waitcnt vmcnt(" #n ")" ::: "memory")
#define PG8_WAIT_L(n) asm volatile("s_waitcnt lgkmcnt(" #n ")" ::: "memory")
#define PG8_BAR __builtin_amdgcn_s_barrier()
#define PG8_SCHED __builtin_amdgcn_sched_barrier(0)
    Unit cur, nxt; int ui = 0;
    if (!S.next(0, cur)) return;
    f32x4 acc[2][2][4][2];
#pragma unroll
    for (int a = 0; a < 2; ++a)
#pragma unroll
        for (int b = 0; b < 2; ++b)
#pragma unroll
            for (int m = 0; m < 4; ++m)
#pragma unroll
                for (int n = 0; n < 2; ++n) acc[a][b][m][n] = (f32x4){0.f, 0.f, 0.f, 0.f};
    bf16x8 At[4][2], B0[2][2], B1[2][2];
    size_t koc; int ntc; S.kr(cur, koc, ntc);
    const char* cA = (const char*)((g.A2 && cur.br) ? g.A2 : g.A) + (size_t)cur.pm * tstepA + koc; const char* cB = (const char*)g.Bt + (size_t)cur.pn * tstepB + koc;
    PG8_STAGE(PG8_SB(0, 0), cB, voffB); PG8_STAGE(PG8_SA(0, 0), cA, voffA); PG8_STAGE(PG8_SB(0, 1), cB + hstepB, voffB); PG8_STAGE(PG8_SA(0, 1), cA + hstepA, voffA);
    if (wr == 1) PG8_BAR;
    PG8_WAIT_V(4); PG8_BAR;
    PG8_STAGE(PG8_SB(1, 0), cB + kstep, voffB); PG8_STAGE(PG8_SA(1, 0), cA + kstep, voffA); PG8_STAGE(PG8_SB(1, 1), cB + hstepB + kstep, voffB);
    PG8_WAIT_V(6); PG8_BAR;
    for (;;) {
        const bool has_next = S.next(ui + 1, nxt);
        size_t kon = 0; int ntn = ntc; if (has_next) S.kr(nxt, kon, ntn);
        const char* nA = has_next ? (const char*)((g.A2 && nxt.br) ? g.A2 : g.A) + (size_t)nxt.pm * tstepA + kon : cA; const char* nB = has_next ? (const char*)g.Bt + (size_t)nxt.pn * tstepB + kon : cB;
        for (int t = 0; t < ntc; t += 2) {
            const bool last = (t == ntc - 2);
            const char* a1 = cA + (size_t)(t + 1) * kstep;
            const char* a2 = last ? nA : cA + (size_t)(t + 2) * kstep; const char* b2 = last ? nB : cB + (size_t)(t + 2) * kstep;
            const char* a3 = a2 + kstep; const char* b3 = b2 + kstep;
            PG8_LDB(B0, 0, 0); PG8_SCHED; PG8_LDA(At, 0, 0); PG8_STAGE(PG8_SA(1, 1), a1 + hstepA, voffA);
            PG8_WAIT_L(8); PG8_BAR; PG8_WAIT_L(0); PG8_MMA(0, 0, At, B0); PG8_BAR; PG8_SCHED;
            PG8_LDB(B1, 0, 1); PG8_STAGE(PG8_SB(0, 0), b2, voffB);
            PG8_BAR; PG8_WAIT_L(0); PG8_MMA(0, 1, At, B1); PG8_BAR;
            PG8_LDA(At, 0, 1); PG8_STAGE(PG8_SA(0, 0), a2, voffA);
            PG8_BAR; PG8_WAIT_L(0); PG8_MMA(1, 0, At, B0); PG8_BAR; PG8_SCHED;
            PG8_STAGE(PG8_SB(0, 1), b2 + hstepB, voffB);
            PG8_WAIT_V(6); PG8_BAR; PG8_MMA(1, 1, At, B1); PG8_BAR;
            PG8_LDB(B0, 1, 0); PG8_SCHED; PG8_LDA(At, 1, 0); PG8_STAGE(PG8_SA(0, 1), a2 + hstepA, voffA);
            PG8_WAIT_L(8); PG8_BAR; PG8_WAIT_L(0); PG8_MMA(0, 0, At, B0); PG8_BAR; PG8_SCHED;
            PG8_LDB(B1, 1, 1); PG8_STAGE(PG8_SB(1, 0), b3, voffB);
            PG8_BAR; PG8_WAIT_L(0); PG8_MMA(0, 1, At, B1); PG8_BAR;
            PG8_LDA(At, 1, 1); PG8_STAGE(PG8_SA(1, 0), a3, voffA);
            PG8_BAR; PG8_WAIT_L(0); PG8_MMA(1, 0, At, B0); PG8_BAR; PG8_SCHED;
            PG8_STAGE(PG8_SB(1, 1), b3 + hstepB, voffB);
            PG8_WAIT_V(6); PG8_BAR; PG8_MMA(1, 1, At, B1); PG8_BAR;
        }
        E(acc, cur, wr, wc, fr, fq);
        if (!has_next) break;
#pragma unroll
        for (int a = 0; a < 2; ++a)
#pragma unroll
            for (int b = 0; b < 2; ++b)
#pragma unroll
                for (int m = 0; m < 4; ++m)
#pragma unroll
                    for (int n = 0; n < 2; ++n) acc[a][b][m][n] = (f32x4){0.f, 0.f, 0.f, 0.f};
        cur = nxt; cA = nA; cB = nB; ntc = ntn; ++ui;
    }
    PG8_WAIT_V(0);
    if (wr == 0) PG8_BAR;
    PG8_BAR;
#undef PG8_SA
#undef PG8_SB
#undef PG8_STAGE
#undef PG8_LDA
#undef PG8_LDB
#undef PG8_MMA
#undef PG8_WAIT_V
#undef PG8_WAIT_L
#undef PG8_BAR
#undef PG8_SCHED
}

struct EpiBf {
    bf16_t* O; int ldc; bf16_t* O2;
    __device__ __forceinline__ void operator()(const f32x4 (&acc)[2][2][4][2], const Unit& u, int wr, int wc, int fr, int fq) const {
        const int row0 = u.pm * BM + wr * 64 + fr, col0 = u.pn * BM + wc * 32 + 4 * fq;
        bf16_t* O = u.br ? this->O2 : this->O;
#pragma unroll
        for (int ai = 0; ai < 2; ++ai)
#pragma unroll
            for (int m = 0; m < 4; ++m) { bf16_t* rowp = O + (size_t)(row0 + ai * HALF + m * 16) * ldc + col0;
#pragma unroll
                for (int bj = 0; bj < 2; ++bj)
#pragma unroll
                    for (int n = 0; n < 2; ++n) { const f32x4 v = acc[ai][bj][m][n]; u32x2 o; o.x = cvt_pk_bf16(v[0], v[1]); o.y = cvt_pk_bf16(v[2], v[3]); *(u32x2*)(rowp + bj * HALF + n * 16) = o; } }
    }
};
struct EpiSigBf {
    bf16_t* O; int ldc;
    __device__ __forceinline__ void operator()(const f32x4 (&acc)[2][2][4][2], const Unit& u, int wr, int wc, int fr, int fq) const {
        const int row0 = u.pm * BM + wr * 64 + fr, col0 = u.pn * BM + wc * 32 + 4 * fq;
#pragma unroll
        for (int ai = 0; ai < 2; ++ai)
#pragma unroll
            for (int m = 0; m < 4; ++m) { bf16_t* rowp = O + (size_t)(row0 + ai * HALF + m * 16) * ldc + col0;
#pragma unroll
                for (int bj = 0; bj < 2; ++bj)
#pragma unroll
                    for (int n = 0; n < 2; ++n) { const f32x4 v = acc[ai][bj][m][n]; u32x2 o; o.x = cvt_pk_bf16(sigm(v[0]), sigm(v[1])); o.y = cvt_pk_bf16(sigm(v[2]), sigm(v[3])); *(u32x2*)(rowp + bj * HALF + n * 16) = o; } }
    }
};
struct EpiF32 {
    float* C; int ldc; float* C2;
    __device__ __forceinline__ void operator()(const f32x4 (&acc)[2][2][4][2], const Unit& u, int wr, int wc, int fr, int fq) const {
        const int row0 = u.pm * BM + wr * 64 + fr, col0 = u.pn * BM + wc * 32 + 4 * fq;
        float* C = u.br ? this->C2 : this->C;
#pragma unroll
        for (int ai = 0; ai < 2; ++ai)
#pragma unroll
            for (int m = 0; m < 4; ++m) { float* rowp = C + (size_t)(row0 + ai * HALF + m * 16) * ldc + col0;
#pragma unroll
                for (int bj = 0; bj < 2; ++bj)
#pragma unroll
                    for (int n = 0; n < 2; ++n) *(f32x4*)(rowp + bj * HALF + n * 16) = acc[ai][bj][m][n]; }
    }
};
struct EpiGlu {
    bf16_t* Y; const bf16_t* Z; gfp_t bias;
    __device__ __forceinline__ void operator()(const f32x4 (&acc)[2][2][4][2], const Unit& u, int wr, int wc, int fr, int fq) const {
        const int row0 = u.pm * BM + wr * 64 + fr, col0 = u.pn * BM + wc * 32 + 4 * fq;
#pragma unroll
        for (int ai = 0; ai < 2; ++ai)
#pragma unroll
            for (int m = 0; m < 4; ++m) { const size_t r = (size_t)(row0 + ai * HALF + m * 16);
#pragma unroll
                for (int bj = 0; bj < 2; ++bj)
#pragma unroll
                    for (int n = 0; n < 2; ++n) { const int c = col0 + bj * HALF + n * 16; const f32x4 v = acc[ai][bj][m][n];
                        const u32x2 zz = *(const u32x2*)(Z + r * 768 + c); const f32x4 bb = *(const f32x4*)(bias + c);
                        const float z0 = __uint_as_float(zz.x << 16), z1 = __uint_as_float(zz.x & 0xffff0000u), z2 = __uint_as_float(zz.y << 16), z3 = __uint_as_float(zz.y & 0xffff0000u);
                        u32x2 o; o.x = cvt_pk_bf16(z0 * sigm(v[0] + bb[0]), z1 * sigm(v[1] + bb[1])); o.y = cvt_pk_bf16(z2 * sigm(v[2] + bb[2]), z3 * sigm(v[3] + bb[3]));
                        *(u32x2*)(Y + r * LDY + c) = o; } }
    }
};
struct EpiBranch {
    const bf16_t* Zg; bf16_t* Mo; bf16_t* Mo2;
    __device__ __forceinline__ void operator()(const f32x4 (&acc)[2][2][4][2], const Unit& u, int wr, int wc, int fr, int fq) const {
        const int row0 = u.pm * BM + wr * 64 + fr, col0 = u.pn * BM + wc * 32 + 4 * fq; const int br = u.br & 3; bf16_t* Mo = (u.br >> 2) ? this->Mo2 : this->Mo;
#pragma unroll
        for (int ai = 0; ai < 2; ++ai)
#pragma unroll
            for (int m = 0; m < 4; ++m) { const size_t r = (size_t)(row0 + ai * HALF + m * 16);
#pragma unroll
                for (int bj = 0; bj < 2; ++bj)
#pragma unroll
                    for (int n = 0; n < 2; ++n) { const int c = col0 + bj * HALF + n * 16; const f32x4 v = acc[ai][bj][m][n];
                        const u32x2 gg = *(const u32x2*)(Zg + r * DIN + br * 1024 + c);
                        f32x4 t; t[0] = v[0] * __uint_as_float(gg.x << 16); t[1] = v[1] * __uint_as_float(gg.x & 0xffff0000u);
                        t[2] = v[2] * __uint_as_float(gg.y << 16); t[3] = v[3] * __uint_as_float(gg.y & 0xffff0000u);
                        bf16_t* mp = Mo + r * DM + c;
                        if (br != 0) { const u32x2 p = *(const u32x2*)mp; t[0] += __uint_as_float(p.x << 16); t[1] += __uint_as_float(p.x & 0xffff0000u); t[2] += __uint_as_float(p.y << 16); t[3] += __uint_as_float(p.y & 0xffff0000u); }
                        u32x2 o; o.x = cvt_pk_bf16(t[0], t[1]); o.y = cvt_pk_bf16(t[2], t[3]); *(u32x2*)mp = o; } }
    }
};

#ifndef GEMM_SIMPLE
#define GEMM_SIMPLE 0
#endif
template <class Epi, class SchedT>
__device__ __forceinline__ void gemm_simple(LAS unsigned char* lds, const Gemm g, const SchedT& S, const Epi& E) {
    const int tid = otid(), wid = __builtin_amdgcn_readfirstlane(tid >> 6), lane = tid & 63, wr = wid >> 2, wc = wid & 3, fr = lane & 15, fq = lane >> 4;
    unsigned voffA[2], voffB[2];
#pragma unroll
    for (int i = 0; i < 2; ++i) { int R, C; stage_rc(tid * 16 + i * 8192, R, C);
        voffA[i] = (unsigned)(R * g.lda + C) * 2u; voffB[i] = (unsigned)(R * g.ldb + C) * 2u; }
    const size_t hstepA = (size_t)HALF * g.lda * 2, hstepB = (size_t)HALF * g.ldb * 2;
    const int aoff = lds_byte(wr * 64 + fr, fq * 8), boff = lds_byte(wc * 32 + fr, fq * 8);
    Unit cur;
    for (int ui = 0; S.next(ui, cur); ++ui) {
        size_t koc; int ntc; S.kr(cur, koc, ntc);
        const char* cA = (const char*)((g.A2 && cur.br) ? g.A2 : g.A) + (size_t)cur.pm * 2 * hstepA + koc; const char* cB = (const char*)g.Bt + (size_t)cur.pn * 2 * hstepB + koc;
        f32x4 acc[2][2][4][2];
#pragma unroll
        for (int a = 0; a < 2; ++a)
#pragma unroll
            for (int b = 0; b < 2; ++b)
#pragma unroll
                for (int m = 0; m < 4; ++m)
#pragma unroll
                    for (int n = 0; n < 2; ++n) acc[a][b][m][n] = (f32x4){0.f, 0.f, 0.f, 0.f};
        for (int t = 0; t < ntc; ++t) {
            u32x4 ra[2][2], rb[2][2];
#pragma unroll
            for (int h = 0; h < 2; ++h)
#pragma unroll
                for (int i = 0; i < 2; ++i) { ra[h][i] = *(const u32x4*)(cA + (size_t)t * 128 + h * hstepA + voffA[i]); rb[h][i] = *(const u32x4*)(cB + (size_t)t * 128 + h * hstepB + voffB[i]); }
            __syncthreads();
#pragma unroll
            for (int h = 0; h < 2; ++h)
#pragma unroll
                for (int i = 0; i < 2; ++i) { *(LAS u32x4*)(lds + h * HTB + tid * 16 + i * 8192) = ra[h][i]; *(LAS u32x4*)(lds + (4 + h) * HTB + tid * 16 + i * 8192) = rb[h][i]; }
            __syncthreads();
#pragma unroll
            for (int ai = 0; ai < 2; ++ai) {
                bf16x8 At[4][2];
#pragma unroll
                for (int m = 0; m < 4; ++m)
#pragma unroll
                    for (int k = 0; k < 2; ++k) At[m][k] = *(const LAS bf16x8*)(lds + ai * HTB + aoff + m * 2048 + k * 1024);
#pragma unroll
                for (int bj = 0; bj < 2; ++bj) {
                    bf16x8 Bf[2][2];
#pragma unroll
                    for (int n = 0; n < 2; ++n)
#pragma unroll
                        for (int k = 0; k < 2; ++k) Bf[n][k] = *(const LAS bf16x8*)(lds + (4 + bj) * HTB + boff + n * 2048 + k * 1024);
#pragma unroll
                    for (int m = 0; m < 4; ++m)
#pragma unroll
                        for (int n = 0; n < 2; ++n)
#pragma unroll
                            for (int k = 0; k < 2; ++k) acc[ai][bj][m][n] = __builtin_amdgcn_mfma_f32_16x16x32_bf16(Bf[n][k], At[m][k], acc[ai][bj][m][n], 0, 0, 0);
                }
            }
        }
        E(acc, cur, wr, wc, fr, fq);
    }
    __syncthreads();
}
template <class Epi, class SchedT>
__device__ __forceinline__ void gemm_run(LAS unsigned char* lds, const Gemm g, const SchedT& S, const Epi& E) {
#if GEMM_SIMPLE
    gemm_simple(lds, g, S, E);
#else
    gemm_phase(lds, g, S, E);
#endif
}
}

__device__ __forceinline__ void transpose_tile(gfp_t W, int N, bf16_t* __restrict__ dst, int ldd, int koff, int tk, int tn, float* tile) {
    const int tid = otid(), a = tid >> 6, bq = tid & 63;
    __syncthreads();
#pragma unroll
    for (int i = 0; i < 8; ++i) { const int k = a + 8 * i; tile[k * 65 + bq] = W[(size_t)(tk * 64 + k) * N + tn * 64 + bq]; }
    __syncthreads();
#pragma unroll
    for (int i = 0; i < 8; ++i) { const int n = a + 8 * i; dst[(size_t)(tn * 64 + n) * ldd + koff + tk * 64 + bq] = f2bf(tile[bq * 65 + n]); }
}

__device__ __forceinline__ f32x4 ldx4(const bf16_t* p) { const u32x2 v = *(const u32x2*)p; f32x4 r; r[0] = __uint_as_float(v.x << 16); r[1] = __uint_as_float(v.x & 0xffff0000u); r[2] = __uint_as_float(v.y << 16); r[3] = __uint_as_float(v.y & 0xffff0000u); return r; }
__device__ __forceinline__ void stx4(bf16_t* p, const f32x4 v) { u32x2 o; o.x = pk2(v[0], v[1]); o.y = pk2(v[2], v[3]); *(u32x2*)p = o; }
__device__ __forceinline__ float row16_sum(float v) {
    v += __builtin_bit_cast(float, __builtin_amdgcn_update_dpp(0, __builtin_bit_cast(int, v), 0xB1, 0xF, 0xF, true));
    v += __builtin_bit_cast(float, __builtin_amdgcn_update_dpp(0, __builtin_bit_cast(int, v), 0x4E, 0xF, 0xF, true));
    v += __builtin_bit_cast(float, __builtin_amdgcn_update_dpp(0, __builtin_bit_cast(int, v), 0x141, 0xF, 0xF, true));
    v += __builtin_bit_cast(float, __builtin_amdgcn_update_dpp(0, __builtin_bit_cast(int, v), 0x140, 0xF, 0xF, true));
    return v;
}
__device__ __forceinline__ float wave_sum(float v) {
    v = row16_sum(v);
    const int iv = __builtin_bit_cast(int, v);
    const float a = __builtin_bit_cast(float, __builtin_amdgcn_readlane(iv, 0)), b = __builtin_bit_cast(float, __builtin_amdgcn_readlane(iv, 16));
    const float c = __builtin_bit_cast(float, __builtin_amdgcn_readlane(iv, 32)), d = __builtin_bit_cast(float, __builtin_amdgcn_readlane(iv, 48));
    return (a + b) + (c + d);
}
__device__ __forceinline__ void rms_store_r(const f32x4 (&xv)[4], const f32x4 (&gr)[4], bf16_t* dst, int lane) {
    float ss = 0.f;
#pragma unroll
    for (int i = 0; i < 4; ++i) ss += xv[i][0] * xv[i][0] + xv[i][1] * xv[i][1] + xv[i][2] * xv[i][2] + xv[i][3] * xv[i][3];
    ss = wave_sum(ss);
    const float rs = rsqrtf(ss * (1.0f / DM) + EPS);
#pragma unroll
    for (int i = 0; i < 4; ++i) { const int c = lane * 4 + 256 * i; const f32x4 hv = xv[i] * gr[i] * rs;
        u32x2 o; o.x = pk2(hv[0], hv[1]); o.y = pk2(hv[2], hv[3]); *(u32x2*)(dst + c) = o; }
}
__device__ __forceinline__ void rms_store(const f32x4 (&xv)[4], gfp_t g, bf16_t* dst, int lane) {
    float ss = 0.f;
#pragma unroll
    for (int i = 0; i < 4; ++i) ss += xv[i][0] * xv[i][0] + xv[i][1] * xv[i][1] + xv[i][2] * xv[i][2] + xv[i][3] * xv[i][3];
    ss = wave_sum(ss);
    const float rs = rsqrtf(ss * (1.0f / DM) + EPS);
#pragma unroll
    for (int i = 0; i < 4; ++i) { const int c = lane * 4 + 256 * i; const f32x4 gn = *(const f32x4*)(g + c); const f32x4 hv = xv[i] * gn * rs;
        u32x2 o; o.x = pk2(hv[0], hv[1]); o.y = pk2(hv[2], hv[3]); *(u32x2*)(dst + c) = o; }
}
__device__ __forceinline__ void norm_rows(const Params& P, int mode, int l, int grp, const unsigned char* smem) {
    const int tid_ = otid(); const int wid = tid_ >> 6, lane = tid_ & 63;
    bf16_t* __restrict__ X = (bf16_t*)(P.ws + A_X);
    const int gw = blockIdx.x * 8 + wid, nw = gridDim.x * 8;
    if (mode == 0) {
        gfp_t g0p = INP(I_GPREMIX); bf16_t* H = (bf16_t*)(P.ws + R_H);
        for (int row = gw; row < TPAD; row += nw) {
            f32x4 xv[4];
            if (row >= TT) {
#pragma unroll
                for (int i = 0; i < 4; ++i) xv[i] = (f32x4){0.f, 0.f, 0.f, 0.f};
            } else {
                const bool isP = row < TPR; int b = 0, t = 0; if (isP) { b = row / LP; t = row - b * LP; }
                gfp_t src = isP ? (t < 16 ? INP(I_META) + (size_t)t * DM : INP(I_XP) + ((size_t)b * SEQ + (t - 16)) * DM) : INP(I_XS) + (size_t)(row - TPR) * DM;
#pragma unroll
                for (int i = 0; i < 4; ++i) xv[i] = *(const f32x4*)(src + lane * 4 + 256 * i);
            }
#pragma unroll
            for (int i = 0; i < 4; ++i) stx4(X + (size_t)row * DM + lane * 4 + 256 * i, xv[i]);
            if (row < 6192) rms_store(xv, g0p, H + (size_t)row * DM, lane);
        }
        return;
    }
    const Grp G = get_grp(grp);
    const bf16_t* __restrict__ F = (const bf16_t*)(P.ws + R_F) - (size_t)G.g0 * DM;
    const bf16_t* __restrict__ F2 = (const bf16_t*)(P.ws + R_UP) - (size_t)G.g0 * DM;
    bf16_t* __restrict__ H = (bf16_t*)(P.ws + R_H) - (size_t)G.g0 * DM;
    const bool fin = (mode == 2 && l == 1);
    gfp_t gpost = (mode == 1 ? INP(I_GPOSTMIX) : INP(I_GPOSTFFN)) + l * DM;
    gfp_t gffn = INP(I_GPREFFN) + l * DM;
    f32x4 gpr[4], gfr[4];
#pragma unroll
    for (int i = 0; i < 4; ++i) { gpr[i] = *(const f32x4*)(gpost + lane * 4 + 256 * i); gfr[i] = *(const f32x4*)(gffn + lane * 4 + 256 * i); }
#pragma unroll 2
    for (int row = G.g0 + gw; row < G.g0 + G.nrows; row += nw) {
        f32x4 xv[4], fv[4]; float ss = 0.f;
#pragma unroll
        for (int i = 0; i < 4; ++i) { const int c = lane * 4 + 256 * i; xv[i] = ldx4(X + (size_t)row * DM + c);
            { const u32x2 fa = *(const u32x2*)(F + (size_t)row * DM + c), fb = *(const u32x2*)(F2 + (size_t)row * DM + c);
              fv[i][0] = __uint_as_float(fa.x << 16) + __uint_as_float(fb.x << 16); fv[i][1] = __uint_as_float(fa.x & 0xffff0000u) + __uint_as_float(fb.x & 0xffff0000u);
              fv[i][2] = __uint_as_float(fa.y << 16) + __uint_as_float(fb.y << 16); fv[i][3] = __uint_as_float(fa.y & 0xffff0000u) + __uint_as_float(fb.y & 0xffff0000u); }
            ss += fv[i][0] * fv[i][0] + fv[i][1] * fv[i][1] + fv[i][2] * fv[i][2] + fv[i][3] * fv[i][3]; }
        ss = wave_sum(ss);
        const float rs = rsqrtf(ss * (1.0f / DM) + EPS);
#pragma unroll
        for (int i = 0; i < 4; ++i) xv[i] = xv[i] + fv[i] * gpr[i] * rs;
        if (fin) {
            float* dst = nullptr;
            if (row < TPR) { const int b = row / LP, t = row - b * LP; if (t >= 16 && ((OUTMASK >> 0) & 1)) dst = P.out + O_YP + ((size_t)b * SEQ + (t - 16)) * DM; }
            else if ((OUTMASK >> 1) & 1) dst = P.out + O_YS + (size_t)(row - TPR) * DM;
            if (dst) {
#pragma unroll
                for (int i = 0; i < 4; ++i) *(f32x4*)(dst + lane * 4 + 256 * i) = xv[i];
            }
        } else {
#pragma unroll
            for (int i = 0; i < 4; ++i) stx4(X + (size_t)row * DM + lane * 4 + 256 * i, xv[i]);
        }
        if (mode == 1) rms_store_r(xv, gfr, H + (size_t)row * DM, lane);
    }
    if (mode == 2) {
        int nl = l, ng = grp + 1; if (ng == NGRP) { ng = 0; nl = l + 1; }
        if (nl < 2) {
            const Grp N = get_grp(ng); gfp_t gn = INP(I_GPREMIX) + nl * DM; bf16_t* Hn = (bf16_t*)(P.ws + R_H) - (size_t)N.g0 * DM;
            f32x4 gnr[4];
#pragma unroll
            for (int i = 0; i < 4; ++i) gnr[i] = *(const f32x4*)(gn + lane * 4 + 256 * i);
            for (int row = N.g0 + gw; row < N.g0 + N.nrows; row += nw) {
                f32x4 xv[4];
#pragma unroll
                for (int i = 0; i < 4; ++i) xv[i] = ldx4(X + (size_t)row * DM + lane * 4 + 256 * i);
                rms_store_r(xv, gnr, Hn + (size_t)row * DM, lane);
            }
        }
    }
}

__device__ __forceinline__ void phase0(const Params& P, unsigned char* smem) {
    float* tile = (float*)smem;
    constexpr int C0 = 2112, C1 = C0 + 144, C2 = C1 + 192, C3 = C2 + 192, C4 = C3 + 256, C5 = C4 + 256, C6 = C5 + 1408, C7 = C6 + 704;
    for (int id = blockIdx.x; id < 2 * C7; id += gridDim.x) {
        const int l = id / C7; int j = id - l * C7;
        gfp_t W; int N, ldd, koff = 0; bf16_t* dst;
        if (j < C0) { W = INP(I_WIN) + (size_t)l * DM * DIN; N = DIN; dst = (bf16_t*)(P.ws + W_IN) + (size_t)l * DIN * DM; ldd = DM; }
        else if (j < C1) { j -= C0; W = INP(I_WGLU) + (size_t)l * 768 * 768; N = 768; dst = (bf16_t*)(P.ws + W_GLU) + (size_t)l * 768 * 768; ldd = 768; }
        else if (j < C2) { j -= C1; W = INP(I_WBA) + (size_t)l * 768 * DM; N = DM; dst = (bf16_t*)(P.ws + W_BR) + (size_t)l * DM * LDY; ldd = LDY; }
        else if (j < C3) { j -= C2; W = INP(I_WBB) + (size_t)l * 768 * DM; N = DM; dst = (bf16_t*)(P.ws + W_BR) + (size_t)l * DM * LDY; ldd = LDY; koff = 768; }
        else if (j < C4) { j -= C3; W = INP(I_WBC) + (size_t)l * DM * DM; N = DM; dst = (bf16_t*)(P.ws + W_BR) + (size_t)l * DM * LDY; ldd = LDY; koff = 1536; }
        else if (j < C5) { j -= C4; W = INP(I_WOUT) + (size_t)l * DM * DM; N = DM; dst = (bf16_t*)(P.ws + W_OUT) + (size_t)l * DM * DM; ldd = DM; }
        else if (j < C6) { j -= C5; W = INP(I_WUP) + (size_t)l * DM * 2 * DFF; N = 2 * DFF; dst = (bf16_t*)(P.ws + W_UP) + (size_t)l * 2 * DFF * DM; ldd = DM; }
        else { j -= C6; W = INP(I_WDOWN) + (size_t)l * DFF * DM; N = DM; dst = (bf16_t*)(P.ws + W_DOWN) + (size_t)l * DM * DFF; ldd = DFF; }
        const int ntn = N / 64; const int tk = j / ntn, tn = j - tk * ntn;
        transpose_tile(W, N, dst, ldd, koff, tk, tn, tile);
    }
    norm_rows(P, 0, 0, 0, smem);
    float* rt = (float*)(P.ws + A_ROPE);
    for (int i = blockIdx.x * 512 + threadIdx.x; i < 2068 * 32; i += gridDim.x * 512) {
        const int pi = i >> 5, fi = i & 31; const double pos = pi < LP ? (double)pi : (double)(16384 + pi - LP);
        const double inv = exp(-(double)fi * (9.210340371976184 / 32.0));
        double ang = pos * inv; const double k = rint(ang * 0.15915494309189535); ang = ang - k * 6.283185307179586;
        const float af = (float)ang; rt[2 * i] = cosf(af); rt[2 * i + 1] = sinf(af);
    }
    if (blockIdx.x == 0 && threadIdx.x < 64) ((unsigned*)(P.ws + A_CTR))[threadIdx.x] = 0u;
}

__device__ __forceinline__ void ld8(const bf16_t* p, float (&d)[8]) {
    const u32x4 v = *(const u32x4*)p;
#pragma unroll
    for (int i = 0; i < 4; ++i) { d[2 * i] = __uint_as_float(v[i] << 16); d[2 * i + 1] = __uint_as_float(v[i] & 0xffff0000u); }
}
__device__ __forceinline__ void ffn_conv_phase(const Params& P, int l, int grp, const unsigned char* smem) {
    const Grp G = get_grp(grp);
    const bf16_t* __restrict__ UP = (const bf16_t*)(P.ws + R_UP) - (size_t)G.g0 * (2 * DFF); bf16_t* __restrict__ FIN = (bf16_t*)(P.ws + R_FIN) - (size_t)G.g0 * DFF;
    gfp_t cw = INP(I_FCW) + (size_t)l * 3 * DFF; gfp_t cb = INP(I_FCB) + (size_t)l * DFF;
    gfp_t cache = INP(I_FFNC) + (size_t)l * DEC_B * 2 * DFF;
    constexpr int NCG = DFF / 8;
    const int nrun = G.nrows >> 3;
    for (int it = blockIdx.x * 512 + threadIdx.x; it < nrun * NCG; it += gridDim.x * 512) {
        const int ck = it / NCG, c = (it - ck * NCG) * 8, row0 = G.g0 + ck * 8;
        float w0[8], w1[8], w2[8], bs[8];
#pragma unroll
        for (int i = 0; i < 8; ++i) { bs[i] = cb[c + i]; w0[i] = cw[c + i]; w1[i] = cw[DFF + c + i]; w2[i] = cw[2 * DFF + c + i]; }
        float g1[8], g2[8];
#pragma unroll
        for (int r = 0; r < 8; ++r) {
            const int row = row0 + r;
            int b, t, L; const bool isP = row < TPR;
            if (isP) { b = row / LP; t = row - b * LP; L = LP; } else { b = (row - TPR) >> 2; t = (row - TPR) & 3; L = 4; }
            float g0[8], uf[8];
            ld8(UP + (size_t)row * (2 * DFF) + c, g0); ld8(UP + (size_t)row * (2 * DFF) + DFF + c, uf);
            if (r == 0) {
                if (t >= 1) ld8(UP + (size_t)(row - 1) * (2 * DFF) + c, g1);
                else {
#pragma unroll
                    for (int i = 0; i < 8; ++i) g1[i] = isP ? 0.f : cache[((size_t)b * 2 + 1) * DFF + c + i]; }
                if (t >= 2) ld8(UP + (size_t)(row - 2) * (2 * DFF) + c, g2);
                else {
#pragma unroll
                    for (int i = 0; i < 8; ++i) g2[i] = isP ? 0.f : cache[((size_t)b * 2 + t) * DFF + c + i]; }
            } else if (t == 0) {
#pragma unroll
                for (int i = 0; i < 8; ++i) { g1[i] = isP ? 0.f : cache[((size_t)b * 2 + 1) * DFF + c + i]; g2[i] = isP ? 0.f : cache[((size_t)b * 2) * DFF + c + i]; }
            } else if (t == 1) {
#pragma unroll
                for (int i = 0; i < 8; ++i) g2[i] = isP ? 0.f : cache[((size_t)b * 2 + 1) * DFF + c + i];
            }
            float o[8];
#pragma unroll
            for (int i = 0; i < 8; ++i) { const float gc = bs[i] + w0[i] * g2[i] + w1[i] * g1[i] + w2[i] * g0[i]; o[i] = gelu_t(gc) * uf[i]; }
            u32x4 ov; ov[0] = pk2(o[0], o[1]); ov[1] = pk2(o[2], o[3]); ov[2] = pk2(o[4], o[5]); ov[3] = pk2(o[6], o[7]);
            *(u32x4*)(FIN + (size_t)row * DFF + c) = ov;
            if (t >= L - 2) {
                float* dst = isP ? P.out + O_P_FFNC + (((size_t)l * NB + b) * 2 + (t - (L - 2))) * DFF + c : P.out + O_S_FFNC + (((size_t)l * DEC_B + b) * 2 + (t - (L - 2))) * DFF + c;
#pragma unroll
                for (int i = 0; i < 8; ++i) dst[i] = g0[i];
            }
#pragma unroll
            for (int i = 0; i < 8; ++i) { g2[i] = g1[i]; g1[i] = g0[i]; }
        }
    }
}

__device__ __forceinline__ void ret_job(const Params& P, int l, int grp, int b, int h, int g0, unsigned char* smem) {
    const int tid = otid(), w = __builtin_amdgcn_readfirstlane(tid >> 6), lane = tid & 63, fr = lane & 15, fq = lane >> 4;
    bf16_t* sQ = (bf16_t*)smem;
    bf16_t* sK = sQ + 128 * 72;
    bf16_t* sKdT = sK + 128 * 72;
    bf16_t* sVT = sKdT + 64 * 136;
    bf16_t* sST = sVT + 128 * 136;
    bf16_t* sP = sST + 128 * 72 + w * 16 * 136;
    const bf16_t* Z = (const bf16_t*)(P.ws + R_Z) - (size_t)g0 * DIN; bf16_t* Y = (bf16_t*)(P.ws + R_Y) - (size_t)g0 * LDY;
    const float* rope = (const float*)(P.ws + A_ROPE);
    const int L = grp ? 4 : LP, rowb = grp ? TPR + b * 4 : b * LP, tabb = grp ? LP : 0;
    const float lg = log1pf(-exp2f(-5.0f - (float)h));
    gfp_t ng = INP(I_RNG) + (size_t)l * 1024 + h * 128;
    float ngv[8];
#pragma unroll
    for (int et = 0; et < 8; ++et) ngv[et] = ng[16 * et + fr];
    f32x4 accS[4];
    float* Sout = P.out + (grp ? O_S_RET + (((size_t)l * DEC_B + b) * 8 + h) * 8192 : O_P_RET + (((size_t)l * NB + b) * 8 + h) * 8192);
    if (grp) { gfp_t S0 = INP(I_RET) + (((size_t)l * DEC_B + b) * 8 + h) * 8192;
#pragma unroll
        for (int dt = 0; dt < 4; ++dt)
#pragma unroll
            for (int j = 0; j < 4; ++j) accS[dt][j] = S0[(16 * dt + 4 * fq + j) * 128 + 16 * w + fr];
    } else {
#pragma unroll
        for (int dt = 0; dt < 4; ++dt) accS[dt] = (f32x4){0.f, 0.f, 0.f, 0.f};
    }
    __syncthreads();
#pragma unroll
    for (int dt = 0; dt < 4; ++dt) { u32x2 o; o.x = pk2(accS[dt][0], accS[dt][1]); o.y = pk2(accS[dt][2], accS[dt][3]); *(u32x2*)(sST + (16 * w + fr) * 72 + 16 * dt + 4 * fq) = o; }
    const int nch = grp ? 1 : 17;
    u32x4 q1 = {0u, 0u, 0u, 0u}, q2 = q1, k1 = q1, k2 = q1, vv[4];
#define RET_LOAD(ckx) do { const int _t0 = grp ? 0 : ((ckx) == 0 ? 0 : 16 + ((ckx) - 1) * 128), _C = grp ? 4 : ((ckx) == 0 ? 16 : 128); \
        const int _m = tid >> 2, _i0 = (tid & 3) * 8, _m2 = tid & 127, _e0 = (tid >> 7) * 32; \
        q1 = (u32x4){0u, 0u, 0u, 0u}; q2 = q1; k1 = q1; k2 = q1; \
        if (_m < _C) { const size_t _zr = (size_t)(rowb + _t0 + _m) * DIN; \
            q1 = *(const u32x4*)(Z + _zr + ZO_Q + h * 64 + _i0); q2 = *(const u32x4*)(Z + _zr + ZO_Q + h * 64 + 32 + _i0); \
            k1 = *(const u32x4*)(Z + _zr + ZO_K + h * 64 + _i0); k2 = *(const u32x4*)(Z + _zr + ZO_K + h * 64 + 32 + _i0); } \
        _Pragma("unroll") for (int _i = 0; _i < 4; ++_i) vv[_i] = (u32x4){0u, 0u, 0u, 0u}; \
        if (_m2 < _C) { const bf16_t* _vp = Z + (size_t)(rowb + _t0 + _m2) * DIN + ZO_V + h * 128 + _e0; \
            _Pragma("unroll") for (int _i = 0; _i < 4; ++_i) vv[_i] = *(const u32x4*)(_vp + 8 * _i); } } while (0)
    RET_LOAD(0);
    for (int ck = 0; ck < nch; ++ck) {
        const int t0 = grp ? 0 : (ck == 0 ? 0 : 16 + (ck - 1) * 128), C = grp ? 4 : (ck == 0 ? 16 : 128);
        {
            const int m = tid >> 2, i0 = (tid & 3) * 8;
            u32x4 q1w = {0u, 0u, 0u, 0u}, q2w = q1w, k1w = q1w, k2w = q1w;
            float kd1[8], kd2[8];
#pragma unroll
            for (int e = 0; e < 8; ++e) { kd1[e] = 0.f; kd2[e] = 0.f; }
            if (m < C) {
                const float* rp = rope + ((size_t)(tabb + t0 + m) * 32 + i0) * 2;
                const float kdec = __expf(lg * (float)(C - 1 - m));
                float qo1[8], qo2[8], ko1[8], ko2[8];
#pragma unroll
                for (int e = 0; e < 8; ++e) {
                    const float cs = rp[2 * e], sn = rp[2 * e + 1];
                    const unsigned qa = q1[e >> 1], qb = q2[e >> 1], ka = k1[e >> 1], kb = k2[e >> 1];
                    const float x1 = (e & 1) ? __uint_as_float(qa & 0xffff0000u) : __uint_as_float(qa << 16);
                    const float x2 = (e & 1) ? __uint_as_float(qb & 0xffff0000u) : __uint_as_float(qb << 16);
                    const float y1 = ((e & 1) ? __uint_as_float(ka & 0xffff0000u) : __uint_as_float(ka << 16)) * 0.125f;
                    const float y2 = ((e & 1) ? __uint_as_float(kb & 0xffff0000u) : __uint_as_float(kb << 16)) * 0.125f;
                    qo1[e] = x1 * cs - x2 * sn; qo2[e] = x2 * cs + x1 * sn;
                    ko1[e] = y1 * cs - y2 * sn; ko2[e] = y2 * cs + y1 * sn;
                    kd1[e] = ko1[e] * kdec; kd2[e] = ko2[e] * kdec;
                }
#pragma unroll
                for (int e = 0; e < 4; ++e) { q1w[e] = pk2(qo1[2 * e], qo1[2 * e + 1]); q2w[e] = pk2(qo2[2 * e], qo2[2 * e + 1]); k1w[e] = pk2(ko1[2 * e], ko1[2 * e + 1]); k2w[e] = pk2(ko2[2 * e], ko2[2 * e + 1]); }
            }
            *(u32x4*)(sQ + m * 72 + i0) = q1w; *(u32x4*)(sQ + m * 72 + 32 + i0) = q2w;
            *(u32x4*)(sK + m * 72 + i0) = k1w; *(u32x4*)(sK + m * 72 + 32 + i0) = k2w;
#pragma unroll
            for (int e = 0; e < 8; ++e) { sKdT[(i0 + e) * 136 + m] = f2bf(kd1[e]); sKdT[(32 + i0 + e) * 136 + m] = f2bf(kd2[e]); }
            const int m2 = tid & 127, e0 = (tid >> 7) * 32;
#pragma unroll
            for (int i = 0; i < 4; ++i)
#pragma unroll
                for (int e = 0; e < 4; ++e) { sVT[(e0 + 8 * i + 2 * e) * 136 + m2] = (bf16_t)(vv[i][e] & 0xffffu); sVT[(e0 + 8 * i + 2 * e + 1) * 136 + m2] = (bf16_t)(vv[i][e] >> 16); }
        }
        __syncthreads();
        if (ck + 1 < nch) RET_LOAD(ck + 1);
        f32x4 o[8];
        const bool act = (16 * w < C);
        unsigned gcp[4][4];
        if (act) {
#pragma unroll
            for (int j = 0; j < 4; ++j) { const int n = 16 * w + 4 * fq + j; const size_t row = (size_t)(rowb + t0 + (n < C ? n : 0));
#pragma unroll
                for (int e2 = 0; e2 < 4; ++e2) { const bf16_t lo = Z[row * DIN + ZO_GC + h * 128 + 32 * e2 + fr], hi = Z[row * DIN + ZO_GC + h * 128 + 32 * e2 + 16 + fr]; gcp[e2][j] = (unsigned)lo | ((unsigned)hi << 16); } }
        }
        if (act) {
            bf16x8 qf[2];
#pragma unroll
            for (int ks = 0; ks < 2; ++ks) qf[ks] = *(const bf16x8*)(sQ + (16 * w + fr) * 72 + 32 * ks + 8 * fq);
            const int mtN = (w | 1) + 1;
            for (int mt = 0; mt < mtN; ++mt) {
                f32x4 a = {0.f, 0.f, 0.f, 0.f};
#pragma unroll
                for (int ks = 0; ks < 2; ++ks) { const bf16x8 kf = *(const bf16x8*)(sK + (16 * mt + fr) * 72 + 32 * ks + 8 * fq); a = mfma16(qf[ks], kf, a); }
#pragma unroll
                for (int j = 0; j < 4; ++j) { const int d = (16 * w + 4 * fq + j) - (16 * mt + fr); const float v = d >= 0 ? a[j] * __expf(lg * (float)d) : 0.f; sP[(4 * fq + j) * 136 + 16 * mt + fr] = f2bf(v); }
            }
            lds_wait();
#pragma unroll
            for (int et = 0; et < 8; ++et) o[et] = (f32x4){0.f, 0.f, 0.f, 0.f};
            const int ksN = mtN >> 1;
            for (int ks = 0; ks < ksN; ++ks) {
                const bf16x8 pf = *(const bf16x8*)(sP + fr * 136 + 32 * ks + 8 * fq);
#pragma unroll
                for (int et = 0; et < 8; ++et) { const bf16x8 vf = *(const bf16x8*)(sVT + (16 * et + fr) * 136 + 32 * ks + 8 * fq); o[et] = mfma16(pf, vf, o[et]); }
            }
            f32x4 o2[8];
#pragma unroll
            for (int et = 0; et < 8; ++et) o2[et] = (f32x4){0.f, 0.f, 0.f, 0.f};
#pragma unroll
            for (int ks = 0; ks < 2; ++ks)
#pragma unroll
                for (int et = 0; et < 8; ++et) { const bf16x8 sf = *(const bf16x8*)(sST + (16 * et + fr) * 72 + 32 * ks + 8 * fq); o2[et] = mfma16(qf[ks], sf, o2[et]); }
#pragma unroll
            for (int j = 0; j < 4; ++j) { const float sc = __expf(lg * (float)(16 * w + 4 * fq + j + 1));
#pragma unroll
                for (int et = 0; et < 8; ++et) o[et][j] += o2[et][j] * sc; }
        }
        {
            const float gC = __expf(lg * (float)C);
#pragma unroll
            for (int dt = 0; dt < 4; ++dt) accS[dt] = accS[dt] * gC;
            const int ksN = (C + 31) >> 5;
            for (int ks = 0; ks < ksN; ++ks) {
                const bf16x8 vf = *(const bf16x8*)(sVT + (16 * w + fr) * 136 + 32 * ks + 8 * fq);
#pragma unroll
                for (int dt = 0; dt < 4; ++dt) { const bf16x8 kf = *(const bf16x8*)(sKdT + (16 * dt + fr) * 136 + 32 * ks + 8 * fq); accS[dt] = mfma16(kf, vf, accS[dt]); }
            }
        }
        __syncthreads();
#pragma unroll
        for (int dt = 0; dt < 4; ++dt) { u32x2 ow; ow.x = pk2(accS[dt][0], accS[dt][1]); ow.y = pk2(accS[dt][2], accS[dt][3]); *(u32x2*)(sST + (16 * w + fr) * 72 + 16 * dt + 4 * fq) = ow; }
        if (act) {
#pragma unroll
            for (int j = 0; j < 4; ++j) {
                float s = 0.f;
#pragma unroll
                for (int et = 0; et < 8; ++et) s += o[et][j];
                s = row16_sum(s);
                const float mu = s * (1.0f / 128.0f);
                float s2 = 0.f;
#pragma unroll
                for (int et = 0; et < 8; ++et) { const float d = o[et][j] - mu; s2 += d * d; }
                s2 = row16_sum(s2);
                const float rstd = rsqrtf(s2 * (1.0f / 128.0f) + EPS);
                const int n = 16 * w + 4 * fq + j;
                if (n < C) {
                    const size_t row = (size_t)(rowb + t0 + n);
#pragma unroll
                    for (int et = 0; et < 8; ++et) { const int e = 16 * et + fr; const unsigned gw_ = gcp[et >> 1][j]; const float gcv = (et & 1) ? __uint_as_float(gw_ & 0xffff0000u) : __uint_as_float(gw_ << 16);
                        const float yv = gcv * sigm(gcv) * (o[et][j] - mu) * rstd * ngv[et]; Y[row * LDY + 1536 + h * 128 + e] = f2bf(yv); }
                }
            }
        }
    }
    if (grp ? OUT_ON(12) : OUT_ON(6)) {
#pragma unroll
    for (int dt = 0; dt < 4; ++dt)
#pragma unroll
        for (int j = 0; j < 4; ++j) Sout[(16 * dt + 4 * fq + j) * 128 + 16 * w + fr] = accS[dt][j];
    }
}

__device__ __forceinline__ void lru_job(const Params& P, int l, int grp, int jid, int g0, int pb0, unsigned char* smem) {
    const int tid = otid(), w = __builtin_amdgcn_readfirstlane(tid >> 6), lane = tid & 63, fr = lane & 15, fq = lane >> 4;
    bf16_t* sA = (bf16_t*)(smem + w * 10752);
    float* sRI = (float*)(smem + w * 10752 + 2304);
    float* sComb = (float*)(smem + 8 * 10752);
    const bf16_t* Z = (const bf16_t*)(P.ws + R_Z) - (size_t)g0 * DIN; bf16_t* Y = (bf16_t*)(P.ws + R_Y) - (size_t)g0 * LDY;
    const int unit = grp ? jid * 8 + w : jid;
    const int bl = unit / 12, hb = unit - bl * 12, ch = hb * 64 + lane; const int b = grp ? bl : pb0 + bl;
    const int L = grp ? 4 : LP, rowb = grp ? TPR + b * 4 : b * LP;
    float cw[4];
#pragma unroll
    for (int j = 0; j < 4; ++j) cw[j] = INP(I_LCW)[((size_t)l * 4 + j) * 768 + ch];
    const float cb = INP(I_LCB)[l * 768 + ch], ba = INP(I_LBA)[l * 768 + ch], bx = INP(I_LBX)[l * 768 + ch];
    const float lam = INP(I_LAM)[l * 768 + ch];
    const float sp8 = 8.0f * (fmaxf(-lam, 0.f) + log1pf(__expf(-fabsf(lam))));
    bf16x8 Wa[4][2], Wx[4][2];
    { gfp_t wa = INP(I_LWA) + ((size_t)l * 12 + hb) * 4096; gfp_t wx = INP(I_LWX) + ((size_t)l * 12 + hb) * 4096;
#pragma unroll
      for (int nt = 0; nt < 4; ++nt)
#pragma unroll
          for (int ks = 0; ks < 2; ++ks)
#pragma unroll
              for (int j = 0; j < 8; ++j) { const int k = 32 * ks + 8 * fq + j, n = 16 * nt + fr; Wa[nt][ks][j] = (short)f2bf(wa[k * 64 + n]); Wx[nt][ks][j] = (short)f2bf(wx[k * 64 + n]); } }
    float carry = grp ? INP(I_LRUH)[((size_t)l * DEC_B + b) * 768 + ch] : 0.f;
    gfp_t cache = INP(I_LRUC) + ((size_t)l * DEC_B + b) * 3 * 768;
    const int nIter = grp ? 1 : 17;
    __syncthreads();
#ifndef LRU_REP
#define LRU_REP 1
#endif
    bf16_t xn[19];
    { const int tw0 = grp ? 0 : 16 * w;
#pragma unroll
      for (int i = 0; i < 19; ++i) { int t = tw0 - 3 + i; t = t < 0 ? 0 : (t > L - 1 ? L - 1 : t); xn[i] = Z[(size_t)(rowb + t) * DIN + ZO_XB + ch]; } }
    for (int it_ = 0; it_ < nIter * (grp ? 1 : LRU_REP); ++it_) {
        const int it = it_ % nIter; if (LRU_REP > 1 && it_ == nIter) carry = 0.f;
        const int tw = grp ? 0 : it * 128 + 16 * w;
        float xv[19];
#pragma unroll
        for (int i = 0; i < 19; ++i) { const int t = tw - 3 + i; xv[i] = (t >= 0 && t < L) ? bf2f(xn[i]) : 0.f; }
        if (grp) {
#pragma unroll
            for (int i = 0; i < 3; ++i) xv[i] = cache[i * 768 + ch];
        }
        if (it_ + 1 < nIter * (grp ? 1 : LRU_REP)) {
            const int twn = tw + 128;
#pragma unroll
            for (int i = 0; i < 19; ++i) { int t = twn - 3 + i; t = t < 0 ? 0 : (t > L - 1 ? L - 1 : t); xn[i] = Z[(size_t)(rowb + t) * DIN + ZO_XB + ch]; }
        }
        unsigned gtp[8];
#pragma unroll
        for (int i = 0; i < 8; ++i) { const int ta = tw + 2 * i, tb = ta + 1;
            const bf16_t lo = Z[(size_t)(rowb + (ta < L ? ta : L - 1)) * DIN + ZO_GB + ch], hi = Z[(size_t)(rowb + (tb < L ? tb : L - 1)) * DIN + ZO_GB + ch];
            gtp[i] = (unsigned)lo | ((unsigned)hi << 16); }
        float xc[16];
#pragma unroll
        for (int i = 0; i < 16; ++i) { xc[i] = cb + cw[0] * xv[i] + cw[1] * xv[i + 1] + cw[2] * xv[i + 2] + cw[3] * xv[i + 3]; sA[i * 72 + lane] = f2bf(xc[i]); }
        lds_wait();
        bf16x8 af[2];
#pragma unroll
        for (int ks = 0; ks < 2; ++ks) af[ks] = *(const bf16x8*)(sA + fr * 72 + 32 * ks + 8 * fq);
#pragma unroll
        for (int nt = 0; nt < 4; ++nt) {
            f32x4 ra = {0.f, 0.f, 0.f, 0.f}, rx = ra;
            ra = mfma16(af[0], Wa[nt][0], ra); ra = mfma16(af[1], Wa[nt][1], ra);
            rx = mfma16(af[0], Wx[nt][0], rx); rx = mfma16(af[1], Wx[nt][1], rx);
#pragma unroll
            for (int j = 0; j < 4; ++j) { sRI[(4 * fq + j) * 132 + 16 * nt + fr] = ra[j]; sRI[(4 * fq + j) * 132 + 64 + 16 * nt + fr] = rx[j]; }
        }
        lds_wait();
        float hloc[16], ca[16]; float hl = 0.f, cacc = 1.f;
#pragma unroll
        for (int i = 0; i < 16; ++i) {
            const float rp = sRI[i * 132 + lane], ip = sRI[i * 132 + 64 + lane];
            const float r = sigm(rp + ba), ii = sigm(ip + bx);
            const float la = -sp8 * r; float a = __expf(la);
            const float x2 = 2.0f * la;
            const float ser = -x2 * (1.0f + x2 * (0.5f + x2 * (0.16666667f + x2 * (0.041666668f + x2 * 0.0083333338f))));
            const float om = x2 > -0.25f ? ser : 1.0f - __expf(x2);
            float bv = __builtin_amdgcn_sqrtf(om) * ii * xc[i];
            if (tw + i >= L) { a = 1.f; bv = 0.f; }
            hl = a * hl + bv; cacc *= a; hloc[i] = hl; ca[i] = cacc;
        }
        float hin = carry;
        if (!grp) {
            float* sCb = sComb + (it_ & 1) * 1024;
            sCb[(w * 64 + lane) * 2] = cacc; sCb[(w * 64 + lane) * 2 + 1] = hl;
            __syncthreads();
            float run = carry;
#pragma unroll
            for (int ww = 0; ww < 8; ++ww) { if (ww == w) hin = run; run = sCb[(ww * 64 + lane) * 2] * run + sCb[(ww * 64 + lane) * 2 + 1]; }
            carry = run;
        } else carry = hloc[15] + ca[15] * hin;
#pragma unroll
        for (int i = 0; i < 16; ++i) { const int t = tw + i;
            if (t < L) { const size_t row = (size_t)(rowb + t); const float hh = hloc[i] + ca[i] * hin; const unsigned gw_ = gtp[i >> 1]; const float gt = (i & 1) ? __uint_as_float(gw_ & 0xffff0000u) : __uint_as_float(gw_ << 16); Y[row * LDY + 768 + ch] = f2bf(hh * gelu_t(gt)); } }
    }
    if (grp || w == 0) {
        float* ho = grp ? P.out + O_S_LRUH + ((size_t)l * DEC_B + b) * 768 + ch : P.out + O_P_LRUH + ((size_t)l * NB + b) * 768 + ch;
        if (grp ? OUT_ON(10) : OUT_ON(4)) *ho = carry;
        float* co = grp ? P.out + O_S_LRUC + ((size_t)l * DEC_B + b) * 3 * 768 + ch : P.out + O_P_LRUC + ((size_t)l * NB + b) * 3 * 768 + ch;
#pragma unroll
        for (int j = 0; j < 3; ++j) if (grp ? OUT_ON(11) : OUT_ON(5)) co[j * 768] = bf2f(Z[(size_t)(rowb + L - 3 + j) * DIN + ZO_XB + ch]);
    }
}

template <bool FULL>
__device__ __forceinline__ void s5_run(const bf16_t* Z, bf16_t* ZS, float* sBU, bf16_t* sH, const bf16x8 (&Bf)[8], const bf16x8 (&Cf)[4], float abr, float abi, float dsk,
                                       int rowb, int g, int L, int it0, int it1, float& hr, float& hi, int lane, int fr, int fq) {
    u32x4 ufn = {0u, 0u, 0u, 0u}; bf16_t udn[4] = {0, 0, 0, 0};
    { const int t1 = it0 * 16; const int v1 = (L - t1) < 16 ? (L - t1) : 16;
      if (fq < 2 && fr < v1) ufn = *(const u32x4*)(Z + (size_t)(rowb + t1 + fr) * DIN + ZO_UA + g * 16 + 8 * fq);
      if (FULL) {
#pragma unroll
          for (int j = 0; j < 4; ++j) if (4 * fq + j < v1) udn[j] = Z[(size_t)(rowb + t1 + 4 * fq + j) * DIN + ZO_UA + g * 16 + fr]; } }
    for (int it = it0; it < it1; ++it) {
        const int t0 = it * 16; const int valid = (L - t0) < 16 ? (L - t0) : 16;
        const bf16x8 uf = __builtin_bit_cast(bf16x8, ufn);
        bf16_t ud[4];
#pragma unroll
        for (int j = 0; j < 4; ++j) ud[j] = udn[j];
        if (it + 1 < it1) { const int t1 = t0 + 16; const int v1 = (L - t1) < 16 ? (L - t1) : 16;
            ufn = (u32x4){0u, 0u, 0u, 0u};
            if (fq < 2 && fr < v1) ufn = *(const u32x4*)(Z + (size_t)(rowb + t1 + fr) * DIN + ZO_UA + g * 16 + 8 * fq);
            if (FULL) {
#pragma unroll
                for (int j = 0; j < 4; ++j) { udn[j] = 0; if (4 * fq + j < v1) udn[j] = Z[(size_t)(rowb + t1 + 4 * fq + j) * DIN + ZO_UA + g * 16 + fr]; } } }
#pragma unroll
        for (int nt = 0; nt < 8; ++nt) { f32x4 a = {0.f, 0.f, 0.f, 0.f}; a = mfma16(uf, Bf[nt], a);
#pragma unroll
            for (int j = 0; j < 4; ++j) sBU[(4 * fq + j) * 132 + 16 * nt + fr] = a[j]; }
        lds_wait();
#pragma unroll
        for (int i = 0; i < 16; ++i) {
            float bur = sBU[i * 132 + lane], bui = sBU[i * 132 + 64 + lane];
            asm volatile("" : "+v"(bur), "+v"(bui));
            const float msk = (i < valid) ? 1.0f : 0.0f;
            float nr = __builtin_fmaf(abr, hr, bur); asm volatile("" : "+v"(nr));
            nr = __builtin_fmaf(-abi, hi, nr); asm volatile("" : "+v"(nr));
            float ni = __builtin_fmaf(abr, hi, bui); asm volatile("" : "+v"(ni));
            ni = __builtin_fmaf(abi, hr, ni); asm volatile("" : "+v"(ni));
            hr = __builtin_fmaf(msk, nr - hr, hr); hi = __builtin_fmaf(msk, ni - hi, hi);
            asm volatile("" : "+v"(hr), "+v"(hi));
            if (FULL) { sH[i * 136 + lane] = f2bf(hr); sH[i * 136 + 64 + lane] = f2bf(hi); }
        }
        lds_wait();
        if (FULL) {
            f32x4 y = {0.f, 0.f, 0.f, 0.f};
#pragma unroll
            for (int ks = 0; ks < 4; ++ks) { const bf16x8 hf = *(const bf16x8*)(sH + fr * 136 + 32 * ks + 8 * fq); y = mfma16(hf, Cf[ks], y); }
#pragma unroll
            for (int j = 0; j < 4; ++j) { const int t = 4 * fq + j;
                if (t < valid) { const size_t row = (size_t)(rowb + t0 + t); const float u = bf2f(ud[j]); ZS[row * 768 + g * 16 + fr] = f2bf(gelu_t(y[j] + dsk * u)); } }
            lds_wait();
        }
    }
}
__device__ __forceinline__ void cmul(float& ar, float& ai, float br, float bi) { const float r = ar * br - ai * bi, i = ar * bi + ai * br; ar = r; ai = i; }

__device__ __forceinline__ void s5_job(const Params& P, int l, int grp, int jid, int g0, int pb0, unsigned* s5done, unsigned char* smem) {
    const int tid = otid(), w = __builtin_amdgcn_readfirstlane(tid >> 6), lane = tid & 63, fr = lane & 15, fq = lane >> 4;
    float* sBU = (float*)(smem + w * 12800);
    bf16_t* sH = (bf16_t*)(smem + w * 12800 + 8448);
    float* sC = (float*)(smem + 8 * 12800);
    const bf16_t* Z = (const bf16_t*)(P.ws + R_Z) - (size_t)g0 * DIN; bf16_t* ZS = (bf16_t*)(P.ws + R_ZS5) - (size_t)g0 * 768;
    int g, b0;
    if (grp) { const int unit = jid * 8 + w; g = unit % 48; b0 = (unit / 48) * 16; } else { b0 = jid / 48; g = jid - b0 * 48; b0 += pb0; }
    const float dt = __expf(INP(I_LS)[l * 48 + g]);
    float abr = 0.f, abi = 0.f;
    bf16x8 Bf[8];
#pragma unroll
    for (int k = 0; k < 4; ++k) {
        const int p = 16 * k + fr;
        const float lr = INP(I_AR)[((size_t)l * 48 + g) * 64 + p], li = INP(I_AI)[((size_t)l * 48 + g) * 64 + p];
        const float mag = expf(lr * dt), ar_ = mag * cosf(li * dt), ai_ = mag * sinf(li * dt);
        if (k == fq) { abr = ar_; abi = ai_; }
        const float den = lr * lr + li * li, nr = ar_ - 1.0f;
        const float cr = (nr * lr + ai_ * li) / den, ci = (ai_ * lr - nr * li) / den;
        bf16x8 fre, fim;
#pragma unroll
        for (int j = 0; j < 8; ++j) { fre[j] = 0; fim[j] = 0; }
        if (fq < 2) {
            gfp_t bre = INP(I_BR) + (((size_t)l * 48 + g) * 64 + p) * 16 + 8 * fq; gfp_t bim = INP(I_BI) + (((size_t)l * 48 + g) * 64 + p) * 16 + 8 * fq;
#pragma unroll
            for (int j = 0; j < 8; ++j) { const float br_ = bre[j], bi_ = bim[j]; fre[j] = (short)f2bf(cr * br_ - ci * bi_); fim[j] = (short)f2bf(cr * bi_ + ci * br_); }
        }
        Bf[k] = fre; Bf[4 + k] = fim;
    }
    bf16x8 Cf[4];
#pragma unroll
    for (int ks = 0; ks < 4; ++ks) {
        gfp_t cp = (ks < 2 ? INP(I_CR) : INP(I_CI)) + (((size_t)l * 48 + g) * 16 + fr) * 64 + 32 * (ks & 1) + 8 * fq;
        const float sg = ks < 2 ? 1.0f : -1.0f;
#pragma unroll
        for (int j = 0; j < 8; ++j) Cf[ks][j] = (short)f2bf(sg * cp[j]);
    }
    const float dsk = INP(I_D)[l * 768 + g * 16 + fr];
    __syncthreads();
    if (grp) {
        for (int s = 0; s < 16; ++s) {
            const int b = b0 + s; const int rowb = TPR + b * 4;
            float hr = INP(I_S5RE)[(((size_t)l * DEC_B + b) * 48 + g) * 64 + lane], hi = INP(I_S5IM)[(((size_t)l * DEC_B + b) * 48 + g) * 64 + lane];
            s5_run<true>(Z, ZS, sBU, sH, Bf, Cf, abr, abi, dsk, rowb, g, 4, 0, 1, hr, hi, lane, fr, fq);
            P.out[O_S_S5RE + (((size_t)l * DEC_B + b) * 48 + g) * 64 + lane] = hr;
            P.out[O_S_S5IM + (((size_t)l * DEC_B + b) * 48 + g) * 64 + lane] = hi;
        }
    } else {
        const int b = b0, rowb = b * LP;
        const int it0 = w == 0 ? 0 : 17 + 16 * (w - 1), it1 = 17 + 16 * w;
        float hr = 0.f, hi = 0.f;
        s5_run<false>(Z, ZS, sBU, sH, Bf, Cf, abr, abi, dsk, rowb, g, LP, it0, it1, hr, hi, lane, fr, fq);
        sC[(w * 64 + lane) * 2] = hr; sC[(w * 64 + lane) * 2 + 1] = hi;
        float pr = abr, pi = abi, p16r = 0.f, p16i = 0.f;
#pragma unroll
        for (int q = 0; q < 8; ++q) { cmul(pr, pi, pr, pi); if (q == 3) { p16r = pr; p16i = pi; } }
        float qr = pr, qi = pi; cmul(qr, qi, p16r, p16i);
        __syncthreads();
        float cr_ = 0.f, ci_ = 0.f;
        for (int ww = 0; ww < w; ++ww) {
            const float ar2 = ww == 0 ? qr : pr, ai2 = ww == 0 ? qi : pi;
            cmul(cr_, ci_, ar2, ai2);
            cr_ += sC[(ww * 64 + lane) * 2]; ci_ += sC[(ww * 64 + lane) * 2 + 1];
        }
        hr = cr_; hi = ci_;
        s5_run<true>(Z, ZS, sBU, sH, Bf, Cf, abr, abi, dsk, rowb, g, LP, it0, it1, hr, hi, lane, fr, fq);
        if (w == 7) {
            P.out[O_P_S5RE + (((size_t)l * NB + b) * 48 + g) * 64 + lane] = hr;
            P.out[O_P_S5IM + (((size_t)l * NB + b) * 48 + g) * 64 + lane] = hi;
        }
    }
    asm volatile("s_waitcnt vmcnt(0)" ::: "memory");
    __syncthreads();
    if (threadIdx.x == 0) { __threadfence(); asm volatile("s_waitcnt vmcnt(0)" ::: "memory"); atomicAdd(s5done, 1u); }
}

__device__ __forceinline__ void mixers_phase(const Params& P, int l, int rg, unsigned char* smem, int rep) {
    const Grp G = get_grp(rg);
    const int j1 = G.npb * 8, j2 = j1 + G.npb * 12, j3 = j2 + G.npb * 48, j4 = j3 + (G.hasS ? 1024 : 0), j5 = j4 + (G.hasS ? 48 : 0), j6 = j5 + (G.hasS ? 192 : 0), j7 = j6 + G.npan * 12, NJ = j7 + G.npan * 3;
    unsigned* s5done = (unsigned*)(P.ws + A_CTR) + 32 + (l * NGRP + rg) + rep * 16;
    const unsigned s5total = (unsigned)(G.npb * 48 + (G.hasS ? 48 : 0));
    unsigned* ctr = (unsigned*)(P.ws + A_CTR) + (l * NGRP + rg) + rep * 16;
    int* slot = (int*)(smem + LDS_BYTES - 16);
#ifndef STATIC_JOBS
#define STATIC_JOBS 0
#endif
    for (int jj = blockIdx.x;; jj += gridDim.x) {
        __syncthreads();
#if STATIC_JOBS
        const int j = jj; (void)ctr; (void)slot;
#else
        if (threadIdx.x == 0) *slot = (int)atomicAdd(ctr, 1u);
        __syncthreads();
        const int j = *slot;
#endif
        if (j >= NJ) break;
        int type, sg, idx;
        if (j < j1) { type = 0; sg = 0; idx = j; }
        else if (j < j2) { type = 1; sg = 0; idx = j - j1; }
        else if (j < j3) { type = 2; sg = 0; idx = j - j2; }
        else if (j < j4) { type = 0; sg = 1; idx = j - j3; }
        else if (j < j5) { type = 2; sg = 1; idx = j - j4; }
        else if (j < j6) { type = 1; sg = 1; idx = j - j5; }
        else if (j < j7) { type = 4; sg = 0; idx = j - j6; }
        else { type = 3; sg = 0; idx = j - j7; }
        if (type == 4) {
            using namespace pg8;
            Gemm gg{(const bf16_t*)(P.ws + R_H), (const bf16_t*)(P.ws + W_IN) + (size_t)l * DIN * DM, DM, DM, G.npan, DIN / 256, DM / 64, nullptr};
            SchedOne S1{idx / 12, 21 + idx % 12, DM / 64};
            EpiSigBf E{(bf16_t*)(P.ws + R_Z), DIN};
            gemm_run((LAS unsigned char*)smem, gg, S1, E);
            continue;
        }
        if (type == 3) {
            if (threadIdx.x == 0) {
                unsigned sp = 0;
                while (__hip_atomic_load(s5done, __ATOMIC_RELAXED, __HIP_MEMORY_SCOPE_AGENT) < s5total) { __builtin_amdgcn_s_sleep(8); if (++sp > (1u << 22)) break; }
                __threadfence();
                asm volatile("s_waitcnt vmcnt(0)" ::: "memory");
            }
            __syncthreads();
            using namespace pg8;
            Gemm gg{(const bf16_t*)(P.ws + R_ZS5), (const bf16_t*)(P.ws + W_GLU) + (size_t)l * 768 * 768, 768, 768, G.npan, 3, 12, nullptr};
            SchedOne S1{idx / 3, idx % 3, 12};
            EpiGlu E{(bf16_t*)(P.ws + R_Y), (const bf16_t*)(P.ws + R_ZS5), INP(I_BGLU) + l * 768};
            gemm_run((LAS unsigned char*)smem, gg, S1, E);
            continue;
        }
        if (type == 0) ret_job(P, l, sg, (idx >> 3) + (sg ? 0 : G.pb0), idx & 7, G.g0, smem);
        else if (type == 1) lru_job(P, l, sg, idx, G.g0, G.pb0, smem);
        else s5_job(P, l, sg, idx, G.g0, G.pb0, s5done, smem);
    }
}

__device__ __forceinline__ void run_phase(const Params& P, int ph, unsigned char* smem, int rep) {
#ifndef PHSEL
#define PHSEL -1
#endif
#define PSEL(x) (PHSEL < 0 || PHSEL == (x))
    if (ph == 0) { if (PSEL(10)) phase0(P, smem); return; }
    const int l = (ph - 1) / (10 * NGRP), rg = ((ph - 1) / 10) % NGRP, s = (ph - 1) % 10;
    LAS unsigned char* lds = (LAS unsigned char*)smem;
    unsigned char* ws = P.ws;
    using namespace pg8;
    const int G = gridDim.x, c = blockIdx.x;
    const int npan = rg < 2 ? 25 : 19;
    switch (s) {
    case 0: if (PSEL(0)) { Gemm g{(const bf16_t*)(ws + R_H), (const bf16_t*)(ws + W_IN) + (size_t)l * DIN * DM, DM, DM, npan, 21, DM / 64, nullptr};
              Sched<1> S; S.init(g.nM, g.nN, G, c, g.nt); EpiBf E{(bf16_t*)(ws + R_Z), DIN, (bf16_t*)(ws + R_Z)}; gemm_run(lds, g, S, E); } break;
    case 1: if (PSEL(1)) mixers_phase(P, l, rg, smem, rep); break;
    case 2: if (PSEL(2)) { Gemm g{(const bf16_t*)(ws + R_ZS5), (const bf16_t*)(ws + W_GLU) + (size_t)l * 768 * 768, 768, 768, npan, 3, 12, nullptr};
              Sched<1> S; S.init(g.nM, g.nN, G, c, g.nt); EpiGlu E{(bf16_t*)(ws + R_Y), (const bf16_t*)(ws + R_ZS5), INP(I_BGLU) + l * 768}; gemm_run(lds, g, S, E); } break;
    case 3: if (PSEL(3)) { Gemm g{(const bf16_t*)(ws + R_Y), (const bf16_t*)(ws + W_BR) + (size_t)l * DM * LDY, LDY, LDY, npan, 4, 0, nullptr};
              SchedBr2 S; S.init(g.nM, g.nN, G, c); EpiBranch E{(const bf16_t*)(ws + R_Z) + ZO_GATE, (bf16_t*)(ws + R_M), (bf16_t*)(ws + R_M2)}; gemm_run(lds, g, S, E); } break;
    case 4: if (PSEL(4)) { Gemm g{(const bf16_t*)(ws + R_M), (const bf16_t*)(ws + W_OUT) + (size_t)l * DM * DM, DM, DM, npan, 4, 16, (const bf16_t*)(ws + R_M2)};
              Sched<2> S; S.init(g.nM, g.nN, G, c, g.nt); S.fullk = 1;     EpiBf E{(bf16_t*)(ws + R_F), DM, (bf16_t*)(ws + R_UP)}; gemm_run(lds, g, S, E); } break;
    case 5: if (PSEL(5) && rep == 0) norm_rows(P, 1, l, rg, smem); break;
    case 6: if (PSEL(6)) { Gemm g{(const bf16_t*)(ws + R_H), (const bf16_t*)(ws + W_UP) + (size_t)l * 2 * DFF * DM, DM, DM, npan, 22, 16, nullptr};
              Sched<1> S; S.init(g.nM, g.nN, G, c, g.nt); EpiBf E{(bf16_t*)(ws + R_UP), 2 * DFF, (bf16_t*)(ws + R_UP)}; gemm_run(lds, g, S, E); } break;
    case 7: if (PSEL(7)) ffn_conv_phase(P, l, rg, smem); break;
    case 8: if (PSEL(8)) { Gemm g{(const bf16_t*)(ws + R_FIN), (const bf16_t*)(ws + W_DOWN) + (size_t)l * DM * DFF, DFF, DFF, npan, 4, 44, nullptr};
              Sched<2> S; S.init(g.nM, g.nN, G, c, g.nt); EpiBf E{(bf16_t*)(ws + R_F), DM, (bf16_t*)(ws + R_UP)}; gemm_run(lds, g, S, E); } break;
    default: if (PSEL(9) && rep == 0) norm_rows(P, 2, l, rg, smem); break;
    }
}

#define XB_TMO      128
#define XB_XCNT(j)  (256  + 64 * (j))
#define XB_XSUB(j)  (1280 + 64 * (j))
#define XB_XGEN(j)  (2304 + 64 * (j))
#define XB_TOP      3328
#define XB_TOPGEN   3392
#define XCD_BAR_WORDS 3456
#define XB_SPIN_CAP (1u << 18)

__device__ __forceinline__ unsigned xb_ld(unsigned* p)              { return __hip_atomic_load(p, __ATOMIC_RELAXED, __HIP_MEMORY_SCOPE_AGENT); }
__device__ __forceinline__ unsigned xb_add(unsigned* p, unsigned v) { return __hip_atomic_fetch_add(p, v, __ATOMIC_RELAXED, __HIP_MEMORY_SCOPE_AGENT); }
__device__ __forceinline__ unsigned xb_xcc_id() { return (unsigned)__builtin_amdgcn_s_getreg((3 << 11) | 20) & 0xFu; }
#define XB_SPIN(cond, bar) do { unsigned _sp = 0; while (cond) { __builtin_amdgcn_s_sleep(1); \
    if ((++_sp & 255u) == 0u) { if (xb_ld(&(bar)[XB_TMO])) break; if (_sp > XB_SPIN_CAP) { atomicAdd(&(bar)[XB_TMO], 1u); break; } } } } while (0)

struct XcdBarrier {
    unsigned* bar; unsigned x;
    volatile LAS unsigned* st;
};

__device__ __forceinline__ XcdBarrier xcd_barrier_post(unsigned* bar, volatile LAS unsigned* st) {
    XcdBarrier b; b.bar = bar; b.x = xb_xcc_id(); b.st = st;
    if (threadIdx.x == 0) (void)xb_add(&bar[XB_XCNT(b.x)], 1u);
    return b;
}
__device__ __forceinline__ void xcd_barrier_complete(unsigned* bar, unsigned x, unsigned& nloc, unsigned& nx) {
    const unsigned G = gridDim.x * gridDim.y * gridDim.z;
    unsigned sum, cnt, mine, sp = 0u;
    for (;;) {
        sum = 0u; cnt = 0u; mine = 0u;
#pragma unroll
        for (unsigned j = 0; j < 16; ++j) { const unsigned c = xb_ld(&bar[XB_XCNT(j)]); sum += c; cnt += (c > 0u) ? 1u : 0u; mine = (j == x) ? c : mine; }
        if (sum == G) break;
        __builtin_amdgcn_s_sleep(1);
        if ((++sp & 255u) == 0u) { if (xb_ld(&bar[XB_TMO])) break; if (sp > XB_SPIN_CAP) { atomicAdd(&bar[XB_TMO], 1u); break; } }
    }
    nloc = mine > 0u ? mine : 1u; nx = cnt > 0u ? cnt : 1u;
}

__device__ __forceinline__ void xcd_barrier(const XcdBarrier& b) {
    asm volatile("s_waitcnt vmcnt(0)" ::: "memory");
    __syncthreads();
    if (threadIdx.x == 0) {
        unsigned* bar = b.bar;
        __builtin_amdgcn_s_waitcnt(0);
        unsigned nloc = b.st[0], nx = b.st[1];
        if (nloc == 0u) { xcd_barrier_complete(bar, b.x, nloc, nx); b.st[0] = nloc; b.st[1] = nx; }
        const unsigned old = xb_add(&bar[XB_XSUB(b.x)], 1u);
        const unsigned gen = old / nloc;
        if (old + 1u == (gen + 1u) * nloc) {
            __builtin_amdgcn_fence(__ATOMIC_RELEASE, "agent");
            asm volatile("s_waitcnt vmcnt(0)" ::: "memory");
            const unsigned og = xb_add(&bar[XB_TOP], 1u);
            const unsigned tg = og / nx;
            if (og + 1u == (tg + 1u) * nx) xb_add(&bar[XB_TOPGEN], 1u);
            else XB_SPIN(xb_ld(&bar[XB_TOPGEN]) == tg, bar);
            __builtin_amdgcn_fence(__ATOMIC_ACQUIRE, "agent");
            xb_add(&bar[XB_XGEN(b.x)], 1u);
            asm volatile("s_waitcnt vmcnt(0)" ::: "memory");
        } else {
            XB_SPIN(xb_ld(&bar[XB_XGEN(b.x)]) == gen, bar);
            __builtin_amdgcn_fence(__ATOMIC_ACQUIRE, "agent");
            asm volatile("s_waitcnt vmcnt(0)" ::: "memory");
        }
    }
    __syncthreads();
}


__global__ void __launch_bounds__(512, 2) mega(Params P, int ph_lo, int ph_hi) {
    extern __shared__ __attribute__((aligned(16))) unsigned char smem[];
    unsigned* xst = (unsigned*)(smem + LDS_BYTES - 32);
    if (threadIdx.x == 0) {
        const float** tab = (const float**)(smem + PTAB_OFF);
#pragma unroll
        for (int i = 0; i < N_IN; ++i) tab[i] = P.in[i];
        xst[0] = 0u; xst[1] = 0u;
    }
    __syncthreads();
    XcdBarrier xb = xcd_barrier_post((unsigned*)(P.ws + A_BAR), (volatile LAS unsigned*)xst);
#ifndef DUP_MASK
#define DUP_MASK 0x400
#endif
    for (int ph = ph_lo; ph < ph_hi; ++ph) {
        if (ph > 0 && (ph - 1) % 10 == 2) continue;
        int nrep = 1;
        if (DUP_MASK) { const int sidx = ph == 0 ? 10 : (ph - 1) % 10; if ((DUP_MASK >> sidx) & 1) nrep = 2; }
        for (int rep = 0; rep < nrep; ++rep) {
            run_phase(P, ph, smem, rep);
            if (ph + 1 < ph_hi || rep + 1 < nrep) xcd_barrier(xb);
        }
    }
}


#ifndef DBG_STOP
#define DBG_STOP 0
#endif
#ifndef DBG_OFF
#define DBG_OFF R_Z
#endif
__global__ void dbg_dump(const unsigned char* ws, float* out, size_t n) {
    const bf16_t* src = (const bf16_t*)(ws + DBG_OFF);
    for (size_t i = (size_t)blockIdx.x * blockDim.x + threadIdx.x; i < n; i += (size_t)gridDim.x * blockDim.x) out[i] = bf2f(src[i]);
}

extern "C" void kernel_launch(void* const* d_in, const int* in_sizes, int n_in, void* d_out, int out_size, void* d_ws, size_t ws_size, hipStream_t stream) {
    (void)in_sizes; (void)n_in; (void)out_size;
    if (ws_size < WS_TOTAL) { fprintf(stderr, "workspace too small: %zu < %zu\n", ws_size, (size_t)WS_TOTAL); return; }
    Params p{};
    for (int i = 0; i < N_IN; ++i) p.in[i] = (const float*)d_in[i];
    p.out = (float*)d_out; p.ws = (unsigned char*)d_ws;
    hipFuncSetAttribute((const void*)mega, hipFuncAttributeMaxDynamicSharedMemorySize, LDS_BYTES);
    int dev = 0, cus = 256, per_cu = 1;
    hipGetDevice(&dev);
    hipDeviceGetAttribute(&cus, hipDeviceAttributeMultiprocessorCount, dev);
    hipOccupancyMaxActiveBlocksPerMultiprocessor(&per_cu, mega, 512, LDS_BYTES);
    if (per_cu < 1) per_cu = 1;
    const int grid = cus * 1;
#if COOP
#ifndef PH_HI
#define PH_HI NPHASE
#endif
    hipMemsetAsync((unsigned char*)d_ws + A_BAR, 0, 16384, stream);
    int lo = 0, hi = PH_HI;
    void* args[] = {&p, &lo, &hi};
    hipError_t e = hipLaunchCooperativeKernel((void*)mega, dim3(grid), dim3(512), args, LDS_BYTES, stream);
    if (e != hipSuccess) fprintf(stderr, "cooperative launch failed: %s (grid %d)\n", hipGetErrorString(e), grid);
#else
#if DBG_STOP
    for (int ph = 0; ph < DBG_STOP; ++ph) hipLaunchKernelGGL(mega, dim3(grid), dim3(512), LDS_BYTES, stream, p, ph, ph + 1);
#ifdef DBG_EXTRA
    hipLaunchKernelGGL(mega, dim3(grid), dim3(512), LDS_BYTES, stream, p, DBG_EXTRA, DBG_EXTRA + 1);
#endif
    hipLaunchKernelGGL(dbg_dump, dim3(2048), dim3(256), 0, stream, (const unsigned char*)d_ws, (float*)d_out, (size_t)34873344);
#else
    for (int ph = 0; ph < NPHASE; ++ph) hipLaunchKernelGGL(mega, dim3(grid), dim3(512), LDS_BYTES, stream, p, ph, ph + 1);
#endif
#endif
}
```

```cpp
#include <hip/hip_runtime.h>
#include <hip/hip_cooperative_groups.h>
#include <cstdio>
namespace cg = cooperative_groups;

#define DUP_MASK 0
#ifndef COOP
#define COOP 1
#endif
#ifndef OUTMASK
#define OUTMASK 0x3FFF
#endif
#ifndef OUT_BMAX
#define OUT_BMAX 1000
#endif
#ifndef OUT_L
#define OUT_L 3
#endif
#define OUT_ON(k) (((OUTMASK >> (k)) & 1) && ((OUT_L >> l) & 1))
#ifndef DMA_AUX
#define DMA_AUX 0
#endif

#define LAS __attribute__((address_space(3)))
typedef unsigned short bf16_t;
typedef short bf16x8 __attribute__((ext_vector_type(8)));
typedef float f32x4 __attribute__((ext_vector_type(4)));
typedef unsigned u32x4 __attribute__((ext_vector_type(4)));
typedef unsigned u32x2 __attribute__((ext_vector_type(2)));

constexpr int DM = 1024, NB = 8, SEQ = 2048, LP = 2064, DEC_B = 128, DEC_S = 4;
constexpr int TPR = NB * LP;
constexpr int TT = TPR + DEC_B * DEC_S;
constexpr int TPAD = 17152;
constexpr int DIN = 8448, DFF = 2816;
constexpr int ZO_UA = 0, ZO_XB = 768, ZO_GB = 1536, ZO_Q = 2304, ZO_K = 2816, ZO_V = 3328, ZO_GC = 4352, ZO_GATE = 5376;
constexpr int LDY = 2560;
constexpr float EPS = 1e-6f;
constexpr int LDS_BYTES = 143360;

enum { I_XP = 0, I_XS, I_S5RE, I_S5IM, I_LRUH, I_LRUC, I_RET, I_FFNC, I_META, I_GPREMIX, I_GPOSTMIX, I_GPREFFN, I_GPOSTFFN, I_WIN,
       I_AR, I_AI, I_LS, I_BR, I_BI, I_CR, I_CI, I_D, I_WGLU, I_BGLU, I_LCW, I_LCB, I_LWA, I_LBA, I_LWX, I_LBX, I_LAM, I_RNG,
       I_WBA, I_WBB, I_WBC, I_WOUT, I_WUP, I_FCW, I_FCB, I_WDOWN, N_IN };

constexpr size_t O_YP = 0;
constexpr size_t O_YS = O_YP + (size_t)NB * SEQ * DM;
constexpr size_t O_P_S5RE = O_YS + (size_t)DEC_B * DEC_S * DM;
constexpr size_t O_P_S5IM = O_P_S5RE + 2 * NB * 48 * 64;
constexpr size_t O_P_LRUH = O_P_S5IM + 2 * NB * 48 * 64;
constexpr size_t O_P_LRUC = O_P_LRUH + 2 * NB * 768;
constexpr size_t O_P_RET = O_P_LRUC + 2 * NB * 3 * 768;
constexpr size_t O_P_FFNC = O_P_RET + (size_t)2 * NB * 8 * 64 * 128;
constexpr size_t O_S_S5RE = O_P_FFNC + 2 * NB * 2 * DFF;
constexpr size_t O_S_S5IM = O_S_S5RE + 2 * DEC_B * 48 * 64;
constexpr size_t O_S_LRUH = O_S_S5IM + 2 * DEC_B * 48 * 64;
constexpr size_t O_S_LRUC = O_S_LRUH + 2 * DEC_B * 768;
constexpr size_t O_S_RET = O_S_LRUC + 2 * DEC_B * 3 * 768;
constexpr size_t O_S_FFNC = O_S_RET + (size_t)2 * DEC_B * 8 * 64 * 128;

constexpr size_t al256(size_t x) { return (x + 255) & ~(size_t)255; }
constexpr size_t W_IN = 0;
constexpr size_t W_GLU = W_IN + (size_t)2 * DIN * DM * 2;
constexpr size_t W_BR = W_GLU + (size_t)2 * 768 * 768 * 2;
constexpr size_t W_OUT = W_BR + (size_t)2 * DM * LDY * 2;
constexpr size_t W_UP = W_OUT + (size_t)2 * DM * DM * 2;
constexpr size_t W_DOWN = W_UP + (size_t)2 * 2 * DFF * DM * 2;
constexpr size_t A_X = W_DOWN + (size_t)2 * DM * DFF * 2;
constexpr int GR = 6400;
constexpr size_t R_Z = A_X + (size_t)TPAD * DM * 4;
constexpr size_t R_ZS5 = R_Z + (size_t)GR * DIN * 2;
constexpr size_t R_Y = R_ZS5 + (size_t)GR * 768 * 2;
constexpr size_t R_M = R_Y + (size_t)GR * LDY * 2;
constexpr size_t R_END = R_M + (size_t)GR * DM * 2;
constexpr size_t R_H = R_M;
constexpr size_t R_F = R_Z;
constexpr size_t R_UP = R_Z + (size_t)GR * DM * 4;
constexpr size_t R_FIN = R_ZS5;
static_assert(R_UP + (size_t)GR * 2 * DFF * 2 <= R_ZS5, "UP inside Z");
static_assert(R_FIN + (size_t)GR * DFF * 2 <= R_M, "FIN inside ZS5|Y");
constexpr size_t A_ROPE = R_END;
constexpr size_t A_CTR = al256(A_ROPE + (size_t)2068 * 64 * 4);
constexpr size_t A_BAR = A_CTR + 4096;
constexpr size_t WS_TOTAL = A_BAR + 16384;
constexpr size_t R_M2 = A_X + (size_t)40 * 1024 * 1024;
static_assert(A_X + (size_t)TPAD * DM * 2 <= R_M2 && R_M2 + (size_t)GR * DM * 2 <= R_Z, "M2 inside the freed half of the X reservation");
constexpr int NGRP = 3;
constexpr int NPHASE = 1 + 2 * NGRP * 10;

struct Grp { int g0, nrows, npan, pb0, npb, hasS; };
__device__ __forceinline__ Grp get_grp(int g) {
    Grp r; r.g0 = g * 6192; r.nrows = g < 2 ? 6192 : 4640; r.npan = g < 2 ? 25 : 19; r.pb0 = g * 3; r.npb = g < 2 ? 3 : 2; r.hasS = g == 2; return r;
}

struct Params {
    const float* in[N_IN];
    float* out;
    unsigned char* ws;
};


constexpr int PTAB_OFF = 142336;
typedef const __attribute__((address_space(1))) float* gfp_t;
typedef const __attribute__((address_space(1))) f32x4* gf4p_t;
__device__ __forceinline__ gfp_t ldin(const unsigned char* smem, int i) {
    const unsigned long long v = ((const unsigned long long*)(smem + PTAB_OFF))[i];
    const unsigned lo = __builtin_amdgcn_readfirstlane((unsigned)v), hi = __builtin_amdgcn_readfirstlane((unsigned)(v >> 32));
    return (gfp_t)(((unsigned long long)hi << 32) | lo);
}
#define INP(i) ldin(smem, (i))
__device__ __forceinline__ int otid() { int t = threadIdx.x; asm volatile("" : "+v"(t)); return t; }

__device__ __forceinline__ float bf2f(bf16_t b) { return __uint_as_float(((unsigned)b) << 16); }
__device__ __forceinline__ bf16_t f2bf(float f) { unsigned u = __float_as_uint(f); u += 0x7FFFu + ((u >> 16) & 1u); return (bf16_t)(u >> 16); }
__device__ __forceinline__ unsigned pk2(float lo, float hi) { return (unsigned)f2bf(lo) | ((unsigned)f2bf(hi) << 16); }
__device__ __forceinline__ float sigm(float x) { return __builtin_amdgcn_rcpf(1.0f + __expf(-x)); }
__device__ __forceinline__ float gelu_t(float x) { const float v = 1.5957691216f * (x + 0.044715f * x * x * x); return x * __builtin_amdgcn_rcpf(1.0f + __expf(-v)); }
__device__ __forceinline__ void lds_wait() { asm volatile("s_waitcnt lgkmcnt(0)" ::: "memory"); __builtin_amdgcn_wave_barrier(); }
__device__ __forceinline__ f32x4 mfma16(bf16x8 a, bf16x8 b, f32x4 c) { return __builtin_amdgcn_mfma_f32_16x16x32_bf16(a, b, c, 0, 0, 0); }

namespace pg8 {
constexpr int BM = 256, BK = 64, HALF = 128, HTB = HALF * BK * 2, STAGE_BYTES = 8 * HTB, NXCD = 8, WGM = 8;
__device__ __forceinline__ int lds_byte(int r, int c) { const int st = (r >> 4) * 2 + (c >> 5), rr = r & 15, cc = c & 31, ob = rr * 64 + cc * 2; return st * 1024 + (ob ^ (((ob >> 9) & 1) << 5)); }
__device__ __forceinline__ void stage_rc(int b, int& R, int& C) { const int st = b / 1024, sb = b % 1024, swz = sb ^ (((sb >> 9) & 1) << 5); R = (st >> 1) * 16 + swz / 64; C = (st & 1) * 32 + (swz % 64) / 2; }

struct Unit { int pm, pn, br; };
struct Gemm { const bf16_t* A; const bf16_t* Bt; int lda, ldb, nM, nN, nt; const bf16_t* A2; };

struct SchedOne {
    int pm, pn, nt0;
    __device__ bool next(int i, Unit& u) const { if (i != 0) return false; u.pm = pm; u.pn = pn; u.br = 0; return true; }
    __device__ __forceinline__ void kr(const Unit&, size_t& koffB, int& nt) const { koffB = 0; nt = nt0; }
};
template <int NBR> struct Sched {
    int nM, nN, nwg, G, c, nt0, fullk;
    __device__ void init(int nM_, int nN_, int G_, int c_, int nt_) { nM = nM_; nN = nN_; nwg = nM * nN; G = G_; c = c_; nt0 = nt_; fullk = 0; }
    __device__ bool next(int i, Unit& u) const {
        int wgid;
        if (NBR == 2) {
            const long L = (long)i * G + c; if (L >= 2 * (long)nwg) return false;
            u.br = (int)(L / nwg); wgid = (int)(L - (long)u.br * nwg);
        } else {
            const int ti = i / NBR; u.br = i - ti * NBR;
            const long L = (long)ti * G + c; if (L >= nwg) return false;
            wgid = (int)L;
        } { const int q = nwg / NXCD, r = nwg % NXCD, xcd = wgid % NXCD, off = wgid / NXCD; wgid = (xcd < r ? xcd * (q + 1) : r * (q + 1) + (xcd - r) * q) + off; }
        const int nig = WGM * nN, gid = wgid / nig, fm = gid * WGM, gsz = (nM - fm) < WGM ? (nM - fm) : WGM;
        u.pm = fm + ((wgid % nig) % gsz); u.pn = (wgid % nig) / gsz; return true;
    }
    __device__ __forceinline__ void kr(const Unit& u, size_t& koffB, int& nt) const {
        if (NBR == 1) { koffB = 0; nt = nt0; }
        else if (NBR == 2) { if (fullk) { nt = nt0; koffB = 0; } else { nt = nt0 >> 1; koffB = (size_t)u.br * (size_t)nt * 128; } }
        else { koffB = (size_t)u.br * 1536; nt = (u.br == 2) ? 16 : 12; }
    }
};

struct SchedBr2 {
    int nM, nN, nwg, G, c;
    __device__ void init(int nM_, int nN_, int G_, int c_) { nM = nM_; nN = nN_; nwg = nM * nN; G = G_; c = c_; }
    __device__ bool next(int i, Unit& u) const {
        const int ti = i / 3, b = i - ti * 3;
        const long L = (long)ti * G + c; if (L >= 2 * (long)nwg) return false;
        const int half = (int)(L / nwg); int wgid = (int)(L - (long)half * nwg);
        { const int q = nwg / NXCD, r = nwg % NXCD, xcd = wgid % NXCD, off = wgid / NXCD; wgid = (xcd < r ? xcd * (q + 1) : r * (q + 1) + (xcd - r) * q) + off; }
        const int nig = WGM * nN, gid = wgid / nig, fm = gid * WGM, gsz = (nM - fm) < WGM ? (nM - fm) : WGM;
        u.pm = fm + ((wgid % nig) % gsz); u.pn = (wgid % nig) / gsz; u.br = b + 4 * half; return true;
    }
    __device__ __forceinline__ void kr(const Unit& u, size_t& koffB, int& nt) const {
        const int b = u.br & 3, half = u.br >> 2; nt = (b == 2) ? 8 : 6; koffB = (size_t)b * 1536 + (size_t)half * nt * 128;
    }
};
__device__ __forceinline__ unsigned cvt_pk_bf16(float lo, float hi) { unsigned r; asm volatile("s_nop 1\n\tv_cvt_pk_bf16_f32 %0, %1, %2" : "=v"(r) : "v"(lo), "v"(hi)); return r; }

template <class Epi, class SchedT>
__device__ __forceinline__ void gemm_phase(LAS unsigned char* lds, const Gemm g, const SchedT& S, const Epi& E) {
    const int tid = otid(), wid = __builtin_amdgcn_readfirstlane(tid >> 6), lane = tid & 63, wr = wid >> 2, wc = wid & 3, fr = lane & 15, fq = lane >> 4;
    unsigned voffA[2], voffB[2];
#pragma unroll
    for (int i = 0; i < 2; ++i) { int R, C; stage_rc(tid * 16 + i * 8192, R, C);
        voffA[i] = (unsigned)(R * g.lda + C) * 2u; voffB[i] = (unsigned)(R * g.ldb + C) * 2u; }
    const size_t kstep = (size_t)(BK * 2);
    const size_t hstepA = (size_t)HALF * g.lda * 2, hstepB = (size_t)HALF * g.ldb * 2;
    const size_t tstepA = 2 * hstepA, tstepB = 2 * hstepB;
    const unsigned ldsw = (unsigned)wid * 1024u;
    const int aoff = lds_byte(wr * 64 + fr, fq * 8), boff = lds_byte(wc * 32 + fr, fq * 8);
#define PG8_SA(b, h) (((b) * 2 + (h)) * HTB)
#define PG8_SB(b, h) ((4 + (b) * 2 + (h)) * HTB)
#define PG8_STAGE(bufoff, gbase, voff) do { _Pragma("unroll") for (int _i = 0; _i < 2; ++_i) \
        __builtin_amdgcn_global_load_lds((const unsigned*)((const char*)(gbase) + (voff)[_i]), (LAS unsigned*)(lds + (bufoff) + ldsw + _i * 8192), 16, 0, DMA_AUX); } while (0)
#define PG8_LDA(dst, b, h) do { _Pragma("unroll") for (int m = 0; m < 4; ++m) _Pragma("unroll") for (int k = 0; k < 2; ++k) dst[m][k] = *(const LAS bf16x8*)(lds + PG8_SA(b, h) + aoff + m * 2048 + k * 1024); } while (0)
#define PG8_LDB(dst, b, h) do { _Pragma("unroll") for (int n = 0; n < 2; ++n) _Pragma("unroll") for (int k = 0; k < 2; ++k) dst[n][k] = *(const LAS bf16x8*)(lds + PG8_SB(b, h) + boff + n * 2048 + k * 1024); } while (0)
#define PG8_MMA(ai, bj, At, Bt) do { __builtin_amdgcn_s_setprio(1); _Pragma("unroll") for (int m = 0; m < 4; ++m) _Pragma("unroll") for (int n = 0; n < 2; ++n) _Pragma("unroll") for (int k = 0; k < 2; ++k) \
        acc[ai][bj][m][n] = __builtin_amdgcn_mfma_f32_16x16x32_bf16(Bt[n][k], At[m][k], acc[ai][bj][m][n], 0, 0, 0); __builtin_amdgcn_s_setprio(0); } while (0)
#define PG8_WAIT_V(n) asm volatile("s_waitcnt vmcnt(" #n ")" ::: "memory")
#define PG8_WAIT_L(n) asm volatile("s_waitcnt lgkmcnt(" #n ")" ::: "memory")
#define PG8_BAR __builtin_amdgcn_s_barrier()
#define PG8_SCHED __builtin_amdgcn_sched_barrier(0)
    Unit cur, nxt; int ui = 0;
    if (!S.next(0, cur)) return;
    f32x4 acc[2][2][4][2];
#pragma unroll
    for (int a = 0; a < 2; ++a)
#pragma unroll
        for (int b = 0; b < 2; ++b)
#pragma unroll
            for (int m = 0; m < 4; ++m)
#pragma unroll
                for (int n = 0; n < 2; ++n) acc[a][b][m][n] = (f32x4){0.f, 0.f, 0.f, 0.f};
    bf16x8 At[4][2], B0[2][2], B1[2][2];
    size_t koc; int ntc; S.kr(cur, koc, ntc);
    const char* cA = (const char*)((g.A2 && cur.br) ? g.A2 : g.A) + (size_t)cur.pm * tstepA + koc; const char* cB = (const char*)g.Bt + (size_t)cur.pn * tstepB + koc;
    PG8_STAGE(PG8_SB(0, 0), cB, voffB); PG8_STAGE(PG8_SA(0, 0), cA, voffA); PG8_STAGE(PG8_SB(0, 1), cB + hstepB, voffB); PG8_STAGE(PG8_SA(0, 1), cA + hstepA, voffA);
    if (wr == 1) PG8_BAR;
    PG8_WAIT_V(4); PG8_BAR;
    PG8_STAGE(PG8_SB(1, 0), cB + kstep, voffB); PG8_STAGE(PG8_SA(1, 0), cA + kstep, voffA); PG8_STAGE(PG8_SB(1, 1), cB + hstepB + kstep, voffB);
    PG8_WAIT_V(6); PG8_BAR;
    for (;;) {
        const bool has_next = S.next(ui + 1, nxt);
        size_t kon = 0; int ntn = ntc; if (has_next) S.kr(nxt, kon, ntn);
        const char* nA = has_next ? (const char*)((g.A2 && nxt.br) ? g.A2 : g.A) + (size_t)nxt.pm * tstepA + kon : cA; const char* nB = has_next ? (const char*)g.Bt + (size_t)nxt.pn * tstepB + kon : cB;
        for (int t = 0; t < ntc; t += 2) {
            const bool last = (t == ntc - 2);
            const char* a1 = cA + (size_t)(t + 1) * kstep;
            const char* a2 = last ? nA : cA + (size_t)(t + 2) * kstep; const char* b2 = last ? nB : cB + (size_t)(t + 2) * kstep;
            const char* a3 = a2 + kstep; const char* b3 = b2 + kstep;
            PG8_LDB(B0, 0, 0); PG8_SCHED; PG8_LDA(At, 0, 0); PG8_STAGE(PG8_SA(1, 1), a1 + hstepA, voffA);
            PG8_WAIT_L(8); PG8_BAR; PG8_WAIT_L(0); PG8_MMA(0, 0, At, B0); PG8_BAR; PG8_SCHED;
            PG8_LDB(B1, 0, 1); PG8_STAGE(PG8_SB(0, 0), b2, voffB);
            PG8_BAR; PG8_WAIT_L(0); PG8_MMA(0, 1, At, B1); PG8_BAR;
            PG8_LDA(At, 0, 1); PG8_STAGE(PG8_SA(0, 0), a2, voffA);
            PG8_BAR; PG8_WAIT_L(0); PG8_MMA(1, 0, At, B0); PG8_BAR; PG8_SCHED;
            PG8_STAGE(PG8_SB(0, 1), b2 + hstepB, voffB);
            PG8_WAIT_V(6); PG8_BAR; PG8_MMA(1, 1, At, B1); PG8_BAR;
            PG8_LDB(B0, 1, 0); PG8_SCHED; PG8_LDA(At, 1, 0); PG8_STAGE(PG8_SA(0, 1), a2 + hstepA, voffA);
            PG8_WAIT_L(8); PG8_BAR; PG8_WAIT_L(0); PG8_MMA(0, 0, At, B0); PG8_BAR; PG8_SCHED;
            PG8_LDB(B1, 1, 1); PG8_STAGE(PG8_SB(1, 0), b3, voffB);
            PG8_BAR; PG8_WAIT_L(0); PG8_MMA(0, 1, At, B1); PG8_BAR;
            PG8_LDA(At, 1, 1); PG8_STAGE(PG8_SA(1, 0), a3, voffA);
            PG8_BAR; PG8_WAIT_L(0); PG8_MMA(1, 0, At, B0); PG8_BAR; PG8_SCHED;
            PG8_STAGE(PG8_SB(1, 1), b3 + hstepB, voffB);
            PG8_WAIT_V(6); PG8_BAR; PG8_MMA(1, 1, At, B1); PG8_BAR;
        }
        E(acc, cur, wr, wc, fr, fq);
        if (!has_next) break;
#pragma unroll
        for (int a = 0; a < 2; ++a)
#pragma unroll
            for (int b = 0; b < 2; ++b)
#pragma unroll
                for (int m = 0; m < 4; ++m)
#pragma unroll
                    for (int n = 0; n < 2; ++n) acc[a][b][m][n] = (f32x4){0.f, 0.f, 0.f, 0.f};
        cur = nxt; cA = nA; cB = nB; ntc = ntn; ++ui;
    }
    PG8_WAIT_V(0);
    if (wr == 0) PG8_BAR;
    PG8_BAR;
#undef PG8_SA
#undef PG8_SB
#undef PG8_STAGE
#undef PG8_LDA
#undef PG8_LDB
#undef PG8_MMA
#undef PG8_WAIT_V
#undef PG8_WAIT_L
#undef PG8_BAR
#undef PG8_SCHED
}

struct EpiBf {
    bf16_t* O; int ldc; bf16_t* O2;
    __device__ __forceinline__ void operator()(const f32x4 (&acc)[2][2][4][2], const Unit& u, int wr, int wc, int fr, int fq) const {
        const int row0 = u.pm * BM + wr * 64 + fr, col0 = u.pn * BM + wc * 32 + 4 * fq;
        bf16_t* O = u.br ? this->O2 : this->O;
#pragma unroll
        for (int ai = 0; ai < 2; ++ai)
#pragma unroll
            for (int m = 0; m < 4; ++m) { bf16_t* rowp = O + (size_t)(row0 + ai * HALF + m * 16) * ldc + col0;
#pragma unroll
                for (int bj = 0; bj < 2; ++bj)
#pragma unroll
                    for (int n = 0; n < 2; ++n) { const f32x4 v = acc[ai][bj][m][n]; u32x2 o; o.x = cvt_pk_bf16(v[0], v[1]); o.y = cvt_pk_bf16(v[2], v[3]); *(u32x2*)(rowp + bj * HALF + n * 16) = o; } }
    }
};
struct EpiSigBf {
    bf16_t* O; int ldc;
    __device__ __forceinline__ void operator()(const f32x4 (&acc)[2][2][4][2], const Unit& u, int wr, int wc, int fr, int fq) const {
        const int row0 = u.pm * BM + wr * 64 + fr, col0 = u.pn * BM + wc * 32 + 4 * fq;
#pragma unroll
        for (int ai = 0; ai < 2; ++ai)
#pragma unroll
            for (int m = 0; m < 4; ++m) { bf16_t* rowp = O + (size_t)(row0 + ai * HALF + m * 16) * ldc + col0;
#pragma unroll
                for (int bj = 0; bj < 2; ++bj)
#pragma unroll
                    for (int n = 0; n < 2; ++n) { const f32x4 v = acc[ai][bj][m][n]; u32x2 o; o.x = cvt_pk_bf16(sigm(v[0]), sigm(v[1])); o.y = cvt_pk_bf16(sigm(v[2]), sigm(v[3])); *(u32x2*)(rowp + bj * HALF + n * 16) = o; } }
    }
};
struct EpiF32 {
    float* C; int ldc; float* C2;
    __device__ __forceinline__ void operator()(const f32x4 (&acc)[2][2][4][2], const Unit& u, int wr, int wc, int fr, int fq) const {
        const int row0 = u.pm * BM + wr * 64 + fr, col0 = u.pn * BM + wc * 32 + 4 * fq;
        float* C = u.br ? this->C2 : this->C;
#pragma unroll
        for (int ai = 0; ai < 2; ++ai)
#pragma unroll
            for (int m = 0; m < 4; ++m) { float* rowp = C + (size_t)(row0 + ai * HALF + m * 16) * ldc + col0;
#pragma unroll
                for (int bj = 0; bj < 2; ++bj)
#pragma unroll
                    for (int n = 0; n < 2; ++n) *(f32x4*)(rowp + bj * HALF + n * 16) = acc[ai][bj][m][n]; }
    }
};
struct EpiGlu {
    bf16_t* Y; const bf16_t* Z; gfp_t bias;
    __device__ __forceinline__ void operator()(const f32x4 (&acc)[2][2][4][2], const Unit& u, int wr, int wc, int fr, int fq) const {
        const int row0 = u.pm * BM + wr * 64 + fr, col0 = u.pn * BM + wc * 32 + 4 * fq;
#pragma unroll
        for (int ai = 0; ai < 2; ++ai)
#pragma unroll
            for (int m = 0; m < 4; ++m) { const size_t r = (size_t)(row0 + ai * HALF + m * 16);
#pragma unroll
                for (int bj = 0; bj < 2; ++bj)
#pragma unroll
                    for (int n = 0; n < 2; ++n) { const int c = col0 + bj * HALF + n * 16; const f32x4 v = acc[ai][bj][m][n];
                        const u32x2 zz = *(const u32x2*)(Z + r * 768 + c); const f32x4 bb = *(const f32x4*)(bias + c);
                        const float z0 = __uint_as_float(zz.x << 16), z1 = __uint_as_float(zz.x & 0xffff0000u), z2 = __uint_as_float(zz.y << 16), z3 = __uint_as_float(zz.y & 0xffff0000u);
                        u32x2 o; o.x = cvt_pk_bf16(z0 * sigm(v[0] + bb[0]), z1 * sigm(v[1] + bb[1])); o.y = cvt_pk_bf16(z2 * sigm(v[2] + bb[2]), z3 * sigm(v[3] + bb[3]));
                        *(u32x2*)(Y + r * LDY + c) = o; } }
    }
};
struct EpiBranch {
    const bf16_t* Zg; bf16_t* Mo; bf16_t* Mo2;
    __device__ __forceinline__ void operator()(const f32x4 (&acc)[2][2][4][2], const Unit& u, int wr, int wc, int fr, int fq) const {
        const int row0 = u.pm * BM + wr * 64 + fr, col0 = u.pn * BM + wc * 32 + 4 * fq; const int br = u.br & 3; bf16_t* Mo = (u.br >> 2) ? this->Mo2 : this->Mo;
#pragma unroll
        for (int ai = 0; ai < 2; ++ai)
#pragma unroll
            for (int m = 0; m < 4; ++m) { const size_t r = (size_t)(row0 + ai * HALF + m * 16);
#pragma unroll
                for (int bj = 0; bj < 2; ++bj)
#pragma unroll
                    for (int n = 0; n < 2; ++n) { const int c = col0 + bj * HALF + n * 16; const f32x4 v = acc[ai][bj][m][n];
                        const u32x2 gg = *(const u32x2*)(Zg + r * DIN + br * 1024 + c);
                        f32x4 t; t[0] = v[0] * __uint_as_float(gg.x << 16); t[1] = v[1] * __uint_as_float(gg.x & 0xffff0000u);
                        t[2] = v[2] * __uint_as_float(gg.y << 16); t[3] = v[3] * __uint_as_float(gg.y & 0xffff0000u);
                        bf16_t* mp = Mo + r * DM + c;
                        if (br != 0) { const u32x2 p = *(const u32x2*)mp; t[0] += __uint_as_float(p.x << 16); t[1] += __uint_as_float(p.x & 0xffff0000u); t[2] += __uint_as_float(p.y << 16); t[3] += __uint_as_float(p.y & 0xffff0000u); }
                        u32x2 o; o.x = cvt_pk_bf16(t[0], t[1]); o.y = cvt_pk_bf16(t[2], t[3]); *(u32x2*)mp = o; } }
    }
};

#ifndef GEMM_SIMPLE
#define GEMM_SIMPLE 0
#endif
template <class Epi, class SchedT>
__device__ __forceinline__ void gemm_simple(LAS unsigned char* lds, const Gemm g, const SchedT& S, const Epi& E) {
    const int tid = otid(), wid = __builtin_amdgcn_readfirstlane(tid >> 6), lane = tid & 63, wr = wid >> 2, wc = wid & 3, fr = lane & 15, fq = lane >> 4;
    unsigned voffA[2], voffB[2];
#pragma unroll
    for (int i = 0; i < 2; ++i) { int R, C; stage_rc(tid * 16 + i * 8192, R, C);
        voffA[i] = (unsigned)(R * g.lda + C) * 2u; voffB[i] = (unsigned)(R * g.ldb + C) * 2u; }
    const size_t hstepA = (size_t)HALF * g.lda * 2, hstepB = (size_t)HALF * g.ldb * 2;
    const int aoff = lds_byte(wr * 64 + fr, fq * 8), boff = lds_byte(wc * 32 + fr, fq * 8);
    Unit cur;
    for (int ui = 0; S.next(ui, cur); ++ui) {
        size_t koc; int ntc; S.kr(cur, koc, ntc);
        const char* cA = (const char*)((g.A2 && cur.br) ? g.A2 : g.A) + (size_t)cur.pm * 2 * hstepA + koc; const char* cB = (const char*)g.Bt + (size_t)cur.pn * 2 * hstepB + koc;
        f32x4 acc[2][2][4][2];
#pragma unroll
        for (int a = 0; a < 2; ++a)
#pragma unroll
            for (int b = 0; b < 2; ++b)
#pragma unroll
                for (int m = 0; m < 4; ++m)
#pragma unroll
                    for (int n = 0; n < 2; ++n) acc[a][b][m][n] = (f32x4){0.f, 0.f, 0.f, 0.f};
        for (int t = 0; t < ntc; ++t) {
            u32x4 ra[2][2], rb[2][2];
#pragma unroll
            for (int h = 0; h < 2; ++h)
#pragma unroll
                for (int i = 0; i < 2; ++i) { ra[h][i] = *(const u32x4*)(cA + (size_t)t * 128 + h * hstepA + voffA[i]); rb[h][i] = *(const u32x4*)(cB + (size_t)t * 128 + h * hstepB + voffB[i]); }
            __syncthreads();
#pragma unroll
            for (int h = 0; h < 2; ++h)
#pragma unroll
                for (int i = 0; i < 2; ++i) { *(LAS u32x4*)(lds + h * HTB + tid * 16 + i * 8192) = ra[h][i]; *(LAS u32x4*)(lds + (4 + h) * HTB + tid * 16 + i * 8192) = rb[h][i]; }
            __syncthreads();
#pragma unroll
            for (int ai = 0; ai < 2; ++ai) {
                bf16x8 At[4][2];
#pragma unroll
                for (int m = 0; m < 4; ++m)
#pragma unroll
                    for (int k = 0; k < 2; ++k) At[m][k] = *(const LAS bf16x8*)(lds + ai * HTB + aoff + m * 2048 + k * 1024);
#pragma unroll
                for (int bj = 0; bj < 2; ++bj) {
                    bf16x8 Bf[2][2];
#pragma unroll
                    for (int n = 0; n < 2; ++n)
#pragma unroll
                        for (int k = 0; k < 2; ++k) Bf[n][k] = *(const LAS bf16x8*)(lds + (4 + bj) * HTB + boff + n * 2048 + k * 1024);
#pragma unroll
                    for (int m = 0; m < 4; ++m)
#pragma unroll
                        for (int n = 0; n < 2; ++n)
#pragma unroll
                            for (int k = 0; k < 2; ++k) acc[ai][bj][m][n] = __builtin_amdgcn_mfma_f32_16x16x32_bf16(Bf[n][k], At[m][k], acc[ai][bj][m][n], 0, 0, 0);
                }
            }
        }
        E(acc, cur, wr, wc, fr, fq);
    }
    __syncthreads();
}
template <class Epi, class SchedT>
__device__ __forceinline__ void gemm_run(LAS unsigned char* lds, const Gemm g, const SchedT& S, const Epi& E) {
#if GEMM_SIMPLE
    gemm_simple(lds, g, S, E);
#else
    gemm_phase(lds, g, S, E);
#endif
}
}

__device__ __forceinline__ void transpose_tile(gfp_t W, int N, bf16_t* __restrict__ dst, int ldd, int koff, int tk, int tn, float* tile) {
    const int tid = otid(), a = tid >> 6, bq = tid & 63;
    __syncthreads();
#pragma unroll
    for (int i = 0; i < 8; ++i) { const int k = a + 8 * i; tile[k * 65 + bq] = W[(size_t)(tk * 64 + k) * N + tn * 64 + bq]; }
    __syncthreads();
#pragma unroll
    for (int i = 0; i < 8; ++i) { const int n = a + 8 * i; dst[(size_t)(tn * 64 + n) * ldd + koff + tk * 64 + bq] = f2bf(tile[bq * 65 + n]); }
}

__device__ __forceinline__ f32x4 ldx4(const bf16_t* p) { const u32x2 v = *(const u32x2*)p; f32x4 r; r[0] = __uint_as_float(v.x << 16); r[1] = __uint_as_float(v.x & 0xffff0000u); r[2] = __uint_as_float(v.y << 16); r[3] = __uint_as_float(v.y & 0xffff0000u); return r; }
__device__ __forceinline__ void stx4(bf16_t* p, const f32x4 v) { u32x2 o; o.x = pk2(v[0], v[1]); o.y = pk2(v[2], v[3]); *(u32x2*)p = o; }
__device__ __forceinline__ float row16_sum(float v) {
    v += __builtin_bit_cast(float, __builtin_amdgcn_update_dpp(0, __builtin_bit_cast(int, v), 0xB1, 0xF, 0xF, true));
    v += __builtin_bit_cast(float, __builtin_amdgcn_update_dpp(0, __builtin_bit_cast(int, v), 0x4E, 0xF, 0xF, true));
    v += __builtin_bit_cast(float, __builtin_amdgcn_update_dpp(0, __builtin_bit_cast(int, v), 0x141, 0xF, 0xF, true));
    v += __builtin_bit_cast(float, __builtin_amdgcn_update_dpp(0, __builtin_bit_cast(int, v), 0x140, 0xF, 0xF, true));
    return v;
}
__device__ __forceinline__ float wave_sum(float v) {
    v = row16_sum(v);
    const int iv = __builtin_bit_cast(int, v);
    const float a = __builtin_bit_cast(float, __builtin_amdgcn_readlane(iv, 0)), b = __builtin_bit_cast(float, __builtin_amdgcn_readlane(iv, 16));
    const float c = __builtin_bit_cast(float, __builtin_amdgcn_readlane(iv, 32)), d = __builtin_bit_cast(float, __builtin_amdgcn_readlane(iv, 48));
    return (a + b) + (c + d);
}
__device__ __forceinline__ void rms_store_r(const f32x4 (&xv)[4], const f32x4 (&gr)[4], bf16_t* dst, int lane) {
    float ss = 0.f;
#pragma unroll
    for (int i = 0; i < 4; ++i) ss += xv[i][0] * xv[i][0] + xv[i][1] * xv[i][1] + xv[i][2] * xv[i][2] + xv[i][3] * xv[i][3];
    ss = wave_sum(ss);
    const float rs = rsqrtf(ss * (1.0f / DM) + EPS);
#pragma unroll
    for (int i = 0; i < 4; ++i) { const int c = lane * 4 + 256 * i; const f32x4 hv = xv[i] * gr[i] * rs;
        u32x2 o; o.x = pk2(hv[0], hv[1]); o.y = pk2(hv[2], hv[3]); *(u32x2*)(dst + c) = o; }
}
__device__ __forceinline__ void rms_store(const f32x4 (&xv)[4], gfp_t g, bf16_t* dst, int lane) {
    float ss = 0.f;
#pragma unroll
    for (int i = 0; i < 4; ++i) ss += xv[i][0] * xv[i][0] + xv[i][1] * xv[i][1] + xv[i][2] * xv[i][2] + xv[i][3] * xv[i][3];
    ss = wave_sum(ss);
    const float rs = rsqrtf(ss * (1.0f / DM) + EPS);
#pragma unroll
    for (int i = 0; i < 4; ++i) { const int c = lane * 4 + 256 * i; const f32x4 gn = *(const f32x4*)(g + c); const f32x4 hv = xv[i] * gn * rs;
        u32x2 o; o.x = pk2(hv[0], hv[1]); o.y = pk2(hv[2], hv[3]); *(u32x2*)(dst + c) = o; }
}
__device__ __forceinline__ void norm_rows(const Params& P, int mode, int l, int grp, const unsigned char* smem) {
    const int tid_ = otid(); const int wid = tid_ >> 6, lane = tid_ & 63;
    bf16_t* __restrict__ X = (bf16_t*)(P.ws + A_X);
    const int gw = blockIdx.x * 8 + wid, nw = gridDim.x * 8;
    if (mode == 0) {
        gfp_t g0p = INP(I_GPREMIX); bf16_t* H = (bf16_t*)(P.ws + R_H);
        for (int row = gw; row < TPAD; row += nw) {
            f32x4 xv[4];
            if (row >= TT) {
#pragma unroll
                for (int i = 0; i < 4; ++i) xv[i] = (f32x4){0.f, 0.f, 0.f, 0.f};
            } else {
                const bool isP = row < TPR; int b = 0, t = 0; if (isP) { b = row / LP; t = row - b * LP; }
                gfp_t src = isP ? (t < 16 ? INP(I_META) + (size_t)t * DM : INP(I_XP) + ((size_t)b * SEQ + (t - 16)) * DM) : INP(I_XS) + (size_t)(row - TPR) * DM;
#pragma unroll
                for (int i = 0; i < 4; ++i) xv[i] = *(const f32x4*)(src + lane * 4 + 256 * i);
            }
#pragma unroll
            for (int i = 0; i < 4; ++i) stx4(X + (size_t)row * DM + lane * 4 + 256 * i, xv[i]);
            if (row < 6192) rms_store(xv, g0p, H + (size_t)row * DM, lane);
        }
        return;
    }
    const Grp G = get_grp(grp);
    const bf16_t* __restrict__ F = (const bf16_t*)(P.ws + R_F) - (size_t)G.g0 * DM;
    const bf16_t* __restrict__ F2 = (const bf16_t*)(P.ws + R_UP) - (size_t)G.g0 * DM;
    bf16_t* __restrict__ H = (bf16_t*)(P.ws + R_H) - (size_t)G.g0 * DM;
    const bool fin = (mode == 2 && l == 1);
    gfp_t gpost = (mode == 1 ? INP(I_GPOSTMIX) : INP(I_GPOSTFFN)) + l * DM;
    gfp_t gffn = INP(I_GPREFFN) + l * DM;
    f32x4 gpr[4], gfr[4];
#pragma unroll
    for (int i = 0; i < 4; ++i) { gpr[i] = *(const f32x4*)(gpost + lane * 4 + 256 * i); gfr[i] = *(const f32x4*)(gffn + lane * 4 + 256 * i); }
#pragma unroll 2
    for (int row = G.g0 + gw; row < G.g0 + G.nrows; row += nw) {
        f32x4 xv[4], fv[4]; float ss = 0.f;
#pragma unroll
        for (int i = 0; i < 4; ++i) { const int c = lane * 4 + 256 * i; xv[i] = ldx4(X + (size_t)row * DM + c);
            { const u32x2 fa = *(const u32x2*)(F + (size_t)row * DM + c), fb = *(const u32x2*)(F2 + (size_t)row * DM + c);
              fv[i][0] = __uint_as_float(fa.x << 16) + __uint_as_float(fb.x << 16); fv[i][1] = __uint_as_float(fa.x & 0xffff0000u) + __uint_as_float(fb.x & 0xffff0000u);
              fv[i][2] = __uint_as_float(fa.y << 16) + __uint_as_float(fb.y << 16); fv[i][3] = __uint_as_float(fa.y & 0xffff0000u) + __uint_as_float(fb.y & 0xffff0000u); }
            ss += fv[i][0] * fv[i][0] + fv[i][1] * fv[i][1] + fv[i][2] * fv[i][2] + fv[i][3] * fv[i][3]; }
        ss = wave_sum(ss);
        const float rs = rsqrtf(ss * (1.0f / DM) + EPS);
#pragma unroll
        for (int i = 0; i < 4; ++i) xv[i] = xv[i] + fv[i] * gpr[i] * rs;
        if (fin) {
            float* dst = nullptr;
            if (row < TPR) { const int b = row / LP, t = row - b * LP; if (t >= 16 && ((OUTMASK >> 0) & 1)) dst = P.out + O_YP + ((size_t)b * SEQ + (t - 16)) * DM; }
            else if ((OUTMASK >> 1) & 1) dst = P.out + O_YS + (size_t)(row - TPR) * DM;
            if (dst) {
#pragma unroll
                for (int i = 0; i < 4; ++i) *(f32x4*)(dst + lane * 4 + 256 * i) = xv[i];
            }
        } else {
#pragma unroll
            for (int i = 0; i < 4; ++i) stx4(X + (size_t)row * DM + lane * 4 + 256 * i, xv[i]);
        }
        if (mode == 1) rms_store_r(xv, gfr, H + (size_t)row * DM, lane);
    }
}

__device__ __forceinline__ void next_h_rows(const Params& P, int l, int grp, int gw, int nw, const unsigned char* smem) {
    int nl = l, ng = grp + 1; if (ng == NGRP) { ng = 0; nl = l + 1; }
    if (nl >= 2) return;
    const int tid_ = otid(); const int lane = tid_ & 63;
    const bf16_t* __restrict__ X = (const bf16_t*)(P.ws + A_X);
    const Grp N = get_grp(ng); gfp_t gn = INP(I_GPREMIX) + nl * DM; bf16_t* __restrict__ Hn = (bf16_t*)(P.ws + R_H) - (size_t)N.g0 * DM;
    f32x4 gnr[4];
#pragma unroll
    for (int i = 0; i < 4; ++i) gnr[i] = *(const f32x4*)(gn + lane * 4 + 256 * i);
#pragma unroll 2
    for (int row = N.g0 + gw; row < N.g0 + N.nrows; row += nw) {
        f32x4 xv[4];
#pragma unroll
        for (int i = 0; i < 4; ++i) xv[i] = ldx4(X + (size_t)row * DM + lane * 4 + 256 * i);
        rms_store_r(xv, gnr, Hn + (size_t)row * DM, lane);
    }
}

__device__ __forceinline__ void phase0(const Params& P, unsigned char* smem) {
    float* tile = (float*)smem;
    constexpr int C0 = 2112, C1 = C0 + 144, C2 = C1 + 192, C3 = C2 + 192, C4 = C3 + 256, C5 = C4 + 256, C6 = C5 + 1408, C7 = C6 + 704;
    for (int id = blockIdx.x; id < 2 * C7; id += gridDim.x) {
        const int l = id / C7; int j = id - l * C7;
        gfp_t W; int N, ldd, koff = 0; bf16_t* dst;
        if (j < C0) { W = INP(I_WIN) + (size_t)l * DM * DIN; N = DIN; dst = (bf16_t*)(P.ws + W_IN) + (size_t)l * DIN * DM; ldd = DM; }
        else if (j < C1) { j -= C0; W = INP(I_WGLU) + (size_t)l * 768 * 768; N = 768; dst = (bf16_t*)(P.ws + W_GLU) + (size_t)l * 768 * 768; ldd = 768; }
        else if (j < C2) { j -= C1; W = INP(I_WBA) + (size_t)l * 768 * DM; N = DM; dst = (bf16_t*)(P.ws + W_BR) + (size_t)l * DM * LDY; ldd = LDY; }
        else if (j < C3) { j -= C2; W = INP(I_WBB) + (size_t)l * 768 * DM; N = DM; dst = (bf16_t*)(P.ws + W_BR) + (size_t)l * DM * LDY; ldd = LDY; koff = 768; }
        else if (j < C4) { j -= C3; W = INP(I_WBC) + (size_t)l * DM * DM; N = DM; dst = (bf16_t*)(P.ws + W_BR) + (size_t)l * DM * LDY; ldd = LDY; koff = 1536; }
        else if (j < C5) { j -= C4; W = INP(I_WOUT) + (size_t)l * DM * DM; N = DM; dst = (bf16_t*)(P.ws + W_OUT) + (size_t)l * DM * DM; ldd = DM; }
        else if (j < C6) { j -= C5; W = INP(I_WUP) + (size_t)l * DM * 2 * DFF; N = 2 * DFF; dst = (bf16_t*)(P.ws + W_UP) + (size_t)l * 2 * DFF * DM; ldd = DM; }
        else { j -= C6; W = INP(I_WDOWN) + (size_t)l * DFF * DM; N = DM; dst = (bf16_t*)(P.ws + W_DOWN) + (size_t)l * DM * DFF; ldd = DFF; }
        const int ntn = N / 64; const int tk = j / ntn, tn = j - tk * ntn;
        transpose_tile(W, N, dst, ldd, koff, tk, tn, tile);
    }
    norm_rows(P, 0, 0, 0, smem);
    float* rt = (float*)(P.ws + A_ROPE);
    for (int i = blockIdx.x * 512 + threadIdx.x; i < 2068 * 32; i += gridDim.x * 512) {
        const int pi = i >> 5, fi = i & 31; const double pos = pi < LP ? (double)pi : (double)(16384 + pi - LP);
        const double inv = exp(-(double)fi * (9.210340371976184 / 32.0));
        double ang = pos * inv; const double k = rint(ang * 0.15915494309189535); ang = ang - k * 6.283185307179586;
        const float af = (float)ang; rt[2 * i] = cosf(af); rt[2 * i + 1] = sinf(af);
    }
    if (blockIdx.x == 0 && threadIdx.x < 64) ((unsigned*)(P.ws + A_CTR))[threadIdx.x] = 0u;
}

__device__ __forceinline__ void ld8(const bf16_t* p, float (&d)[8]) {
    const u32x4 v = *(const u32x4*)p;
#pragma unroll
    for (int i = 0; i < 4; ++i) { d[2 * i] = __uint_as_float(v[i] << 16); d[2 * i + 1] = __uint_as_float(v[i] & 0xffff0000u); }
}
__device__ __forceinline__ void ffn_conv_phase(const Params& P, int l, int grp, const unsigned char* smem) {
    const Grp G = get_grp(grp);
    const bf16_t* __restrict__ UP = (const bf16_t*)(P.ws + R_UP) - (size_t)G.g0 * (2 * DFF); bf16_t* __restrict__ FIN = (bf16_t*)(P.ws + R_FIN) - (size_t)G.g0 * DFF;
    gfp_t cw = INP(I_FCW) + (size_t)l * 3 * DFF; gfp_t cb = INP(I_FCB) + (size_t)l * DFF;
    gfp_t cache = INP(I_FFNC) + (size_t)l * DEC_B * 2 * DFF;
    constexpr int NCG = DFF / 8;
    const int nrun = G.nrows >> 3;
    for (int it = blockIdx.x * 512 + threadIdx.x; it < nrun * NCG; it += gridDim.x * 512) {
        const int ck = it / NCG, c = (it - ck * NCG) * 8, row0 = G.g0 + ck * 8;
        float w0[8], w1[8], w2[8], bs[8];
#pragma unroll
        for (int i = 0; i < 8; ++i) { bs[i] = cb[c + i]; w0[i] = cw[c + i]; w1[i] = cw[DFF + c + i]; w2[i] = cw[2 * DFF + c + i]; }
        float g1[8], g2[8];
#pragma unroll
        for (int r = 0; r < 8; ++r) {
            const int row = row0 + r;
            int b, t, L; const bool isP = row < TPR;
            if (isP) { b = row / LP; t = row - b * LP; L = LP; } else { b = (row - TPR) >> 2; t = (row - TPR) & 3; L = 4; }
            float g0[8], uf[8];
            ld8(UP + (size_t)row * (2 * DFF) + c, g0); ld8(UP + (size_t)row * (2 * DFF) + DFF + c, uf);
            if (r == 0) {
                if (t >= 1) ld8(UP + (size_t)(row - 1) * (2 * DFF) + c, g1);
                else {
#pragma unroll
                    for (int i = 0; i < 8; ++i) g1[i] = isP ? 0.f : cache[((size_t)b * 2 + 1) * DFF + c + i]; }
                if (t >= 2) ld8(UP + (size_t)(row - 2) * (2 * DFF) + c, g2);
                else {
#pragma unroll
                    for (int i = 0; i < 8; ++i) g2[i] = isP ? 0.f : cache[((size_t)b * 2 + t) * DFF + c + i]; }
            } else if (t == 0) {
#pragma unroll
                for (int i = 0; i < 8; ++i) { g1[i] = isP ? 0.f : cache[((size_t)b * 2 + 1) * DFF + c + i]; g2[i] = isP ? 0.f : cache[((size_t)b * 2) * DFF + c + i]; }
            } else if (t == 1) {
#pragma unroll
                for (int i = 0; i < 8; ++i) g2[i] = isP ? 0.f : cache[((size_t)b * 2 + 1) * DFF + c + i];
            }
            float o[8];
#pragma unroll
            for (int i = 0; i < 8; ++i) { const float gc = bs[i] + w0[i] * g2[i] + w1[i] * g1[i] + w2[i] * g0[i]; o[i] = gelu_t(gc) * uf[i]; }
            u32x4 ov; ov[0] = pk2(o[0], o[1]); ov[1] = pk2(o[2], o[3]); ov[2] = pk2(o[4], o[5]); ov[3] = pk2(o[6], o[7]);
            *(u32x4*)(FIN + (size_t)row * DFF + c) = ov;
            if (t >= L - 2) {
                float* dst = isP ? P.out + O_P_FFNC + (((size_t)l * NB + b) * 2 + (t - (L - 2))) * DFF + c : P.out + O_S_FFNC + (((size_t)l * DEC_B + b) * 2 + (t - (L - 2))) * DFF + c;
#pragma unroll
                for (int i = 0; i < 8; ++i) dst[i] = g0[i];
            }
#pragma unroll
            for (int i = 0; i < 8; ++i) { g2[i] = g1[i]; g1[i] = g0[i]; }
        }
    }
}

__device__ __forceinline__ void ret_job(const Params& P, int l, int grp, int b, int h, int g0, unsigned char* smem) {
    const int tid = otid(), w = __builtin_amdgcn_readfirstlane(tid >> 6), lane = tid & 63, fr = lane & 15, fq = lane >> 4;
    bf16_t* sQ = (bf16_t*)smem;
    bf16_t* sK = sQ + 128 * 72;
    bf16_t* sKdT = sK + 128 * 72;
    bf16_t* sVT = sKdT + 64 * 136;
    bf16_t* sST = sVT + 128 * 136;
    bf16_t* sP = sST + 128 * 72 + w * 16 * 136;
    const bf16_t* Z = (const bf16_t*)(P.ws + R_Z) - (size_t)g0 * DIN; bf16_t* Y = (bf16_t*)(P.ws + R_Y) - (size_t)g0 * LDY;
    const float* rope = (const float*)(P.ws + A_ROPE);
    const int L = grp ? 4 : LP, rowb = grp ? TPR + b * 4 : b * LP, tabb = grp ? LP : 0;
    const float lg = log1pf(-exp2f(-5.0f - (float)h));
    gfp_t ng = INP(I_RNG) + (size_t)l * 1024 + h * 128;
    float ngv[8];
#pragma unroll
    for (int et = 0; et < 8; ++et) ngv[et] = ng[16 * et + fr];
    f32x4 accS[4];
    float* Sout = P.out + (grp ? O_S_RET + (((size_t)l * DEC_B + b) * 8 + h) * 8192 : O_P_RET + (((size_t)l * NB + b) * 8 + h) * 8192);
    if (grp) { gfp_t S0 = INP(I_RET) + (((size_t)l * DEC_B + b) * 8 + h) * 8192;
#pragma unroll
        for (int dt = 0; dt < 4; ++dt)
#pragma unroll
            for (int j = 0; j < 4; ++j) accS[dt][j] = S0[(16 * dt + 4 * fq + j) * 128 + 16 * w + fr];
    } else {
#pragma unroll
        for (int dt = 0; dt < 4; ++dt) accS[dt] = (f32x4){0.f, 0.f, 0.f, 0.f};
    }
    __syncthreads();
#pragma unroll
    for (int dt = 0; dt < 4; ++dt) { u32x2 o; o.x = pk2(accS[dt][0], accS[dt][1]); o.y = pk2(accS[dt][2], accS[dt][3]); *(u32x2*)(sST + (16 * w + fr) * 72 + 16 * dt + 4 * fq) = o; }
    const int nch = grp ? 1 : 17;
    u32x4 q1 = {0u, 0u, 0u, 0u}, q2 = q1, k1 = q1, k2 = q1, vv[4];
#define RET_LOAD(ckx) do { const int _t0 = grp ? 0 : ((ckx) == 0 ? 0 : 16 + ((ckx) - 1) * 128), _C = grp ? 4 : ((ckx) == 0 ? 16 : 128); \
        const int _m = tid >> 2, _i0 = (tid & 3) * 8, _m2 = tid & 127, _e0 = (tid >> 7) * 32; \
        q1 = (u32x4){0u, 0u, 0u, 0u}; q2 = q1; k1 = q1; k2 = q1; \
        if (_m < _C) { const size_t _zr = (size_t)(rowb + _t0 + _m) * DIN; \
            q1 = *(const u32x4*)(Z + _zr + ZO_Q + h * 64 + _i0); q2 = *(const u32x4*)(Z + _zr + ZO_Q + h * 64 + 32 + _i0); \
            k1 = *(const u32x4*)(Z + _zr + ZO_K + h * 64 + _i0); k2 = *(const u32x4*)(Z + _zr + ZO_K + h * 64 + 32 + _i0); } \
        _Pragma("unroll") for (int _i = 0; _i < 4; ++_i) vv[_i] = (u32x4){0u, 0u, 0u, 0u}; \
        if (_m2 < _C) { const bf16_t* _vp = Z + (size_t)(rowb + _t0 + _m2) * DIN + ZO_V + h * 128 + _e0; \
            _Pragma("unroll") for (int _i = 0; _i < 4; ++_i) vv[_i] = *(const u32x4*)(_vp + 8 * _i); } } while (0)
    RET_LOAD(0);
    for (int ck = 0; ck < nch; ++ck) {
        const int t0 = grp ? 0 : (ck == 0 ? 0 : 16 + (ck - 1) * 128), C = grp ? 4 : (ck == 0 ? 16 : 128);
        {
            const int m = tid >> 2, i0 = (tid & 3) * 8;
            u32x4 q1w = {0u, 0u, 0u, 0u}, q2w = q1w, k1w = q1w, k2w = q1w;
            float kd1[8], kd2[8];
#pragma unroll
            for (int e = 0; e < 8; ++e) { kd1[e] = 0.f; kd2[e] = 0.f; }
            if (m < C) {
                const float* rp = rope + ((size_t)(tabb + t0 + m) * 32 + i0) * 2;
                const float kdec = __expf(lg * (float)(C - 1 - m));
                float qo1[8], qo2[8], ko1[8], ko2[8];
#pragma unroll
                for (int e = 0; e < 8; ++e) {
                    const float cs = rp[2 * e], sn = rp[2 * e + 1];
                    const unsigned qa = q1[e >> 1], qb = q2[e >> 1], ka = k1[e >> 1], kb = k2[e >> 1];
                    const float x1 = (e & 1) ? __uint_as_float(qa & 0xffff0000u) : __uint_as_float(qa << 16);
                    const float x2 = (e & 1) ? __uint_as_float(qb & 0xffff0000u) : __uint_as_float(qb << 16);
                    const float y1 = ((e & 1) ? __uint_as_float(ka & 0xffff0000u) : __uint_as_float(ka << 16)) * 0.125f;
                    const float y2 = ((e & 1) ? __uint_as_float(kb & 0xffff0000u) : __uint_as_float(kb << 16)) * 0.125f;
                    qo1[e] = x1 * cs - x2 * sn; qo2[e] = x2 * cs + x1 * sn;
                    ko1[e] = y1 * cs - y2 * sn; ko2[e] = y2 * cs + y1 * sn;
                    kd1[e] = ko1[e] * kdec; kd2[e] = ko2[e] * kdec;
                }
#pragma unroll
                for (int e = 0; e < 4; ++e) { q1w[e] = pk2(qo1[2 * e], qo1[2 * e + 1]); q2w[e] = pk2(qo2[2 * e], qo2[2 * e + 1]); k1w[e] = pk2(ko1[2 * e], ko1[2 * e + 1]); k2w[e] = pk2(ko2[2 * e], ko2[2 * e + 1]); }
            }
            *(u32x4*)(sQ + m * 72 + i0) = q1w; *(u32x4*)(sQ + m * 72 + 32 + i0) = q2w;
            *(u32x4*)(sK + m * 72 + i0) = k1w; *(u32x4*)(sK + m * 72 + 32 + i0) = k2w;
#pragma unroll
            for (int e = 0; e < 8; ++e) { sKdT[(i0 + e) * 136 + m] = f2bf(kd1[e]); sKdT[(32 + i0 + e) * 136 + m] = f2bf(kd2[e]); }
            const int m2 = tid & 127, e0 = (tid >> 7) * 32;
#pragma unroll
            for (int i = 0; i < 4; ++i)
#pragma unroll
                for (int e = 0; e < 4; ++e) { sVT[(e0 + 8 * i + 2 * e) * 136 + m2] = (bf16_t)(vv[i][e] & 0xffffu); sVT[(e0 + 8 * i + 2 * e + 1) * 136 + m2] = (bf16_t)(vv[i][e] >> 16); }
        }
        __syncthreads();
        if (ck + 1 < nch) RET_LOAD(ck + 1);
        f32x4 o[8];
        const bool act = (16 * w < C);
        unsigned gcp[4][4];
        if (act) {
#pragma unroll
            for (int j = 0; j < 4; ++j) { const int n = 16 * w + 4 * fq + j; const size_t row = (size_t)(rowb + t0 + (n < C ? n : 0));
#pragma unroll
                for (int e2 = 0; e2 < 4; ++e2) { const bf16_t lo = Z[row * DIN + ZO_GC + h * 128 + 32 * e2 + fr], hi = Z[row * DIN + ZO_GC + h * 128 + 32 * e2 + 16 + fr]; gcp[e2][j] = (unsigned)lo | ((unsigned)hi << 16); } }
        }
        if (act) {
            bf16x8 qf[2];
#pragma unroll
            for (int ks = 0; ks < 2; ++ks) qf[ks] = *(const bf16x8*)(sQ + (16 * w + fr) * 72 + 32 * ks + 8 * fq);
            const int mtN = (w | 1) + 1;
            for (int mt = 0; mt < mtN; ++mt) {
                f32x4 a = {0.f, 0.f, 0.f, 0.f};
#pragma unroll
                for (int ks = 0; ks < 2; ++ks) { const bf16x8 kf = *(const bf16x8*)(sK + (16 * mt + fr) * 72 + 32 * ks + 8 * fq); a = mfma16(qf[ks], kf, a); }
#pragma unroll
                for (int j = 0; j < 4; ++j) { const int d = (16 * w + 4 * fq + j) - (16 * mt + fr); const float v = d >= 0 ? a[j] * __expf(lg * (float)d) : 0.f; sP[(4 * fq + j) * 136 + 16 * mt + fr] = f2bf(v); }
            }
            lds_wait();
#pragma unroll
            for (int et = 0; et < 8; ++et) o[et] = (f32x4){0.f, 0.f, 0.f, 0.f};
            const int ksN = mtN >> 1;
            for (int ks = 0; ks < ksN; ++ks) {
                const bf16x8 pf = *(const bf16x8*)(sP + fr * 136 + 32 * ks + 8 * fq);
#pragma unroll
                for (int et = 0; et < 8; ++et) { const bf16x8 vf = *(const bf16x8*)(sVT + (16 * et + fr) * 136 + 32 * ks + 8 * fq); o[et] = mfma16(pf, vf, o[et]); }
            }
            f32x4 o2[8];
#pragma unroll
            for (int et = 0; et < 8; ++et) o2[et] = (f32x4){0.f, 0.f, 0.f, 0.f};
#pragma unroll
            for (int ks = 0; ks < 2; ++ks)
#pragma unroll
                for (int et = 0; et < 8; ++et) { const bf16x8 sf = *(const bf16x8*)(sST + (16 * et + fr) * 72 + 32 * ks + 8 * fq); o2[et] = mfma16(qf[ks], sf, o2[et]); }
#pragma unroll
            for (int j = 0; j < 4; ++j) { const float sc = __expf(lg * (float)(16 * w + 4 * fq + j + 1));
#pragma unroll
                for (int et = 0; et < 8; ++et) o[et][j] += o2[et][j] * sc; }
        }
        {
            const float gC = __expf(lg * (float)C);
#pragma unroll
            for (int dt = 0; dt < 4; ++dt) accS[dt] = accS[dt] * gC;
            const int ksN = (C + 31) >> 5;
            for (int ks = 0; ks < ksN; ++ks) {
                const bf16x8 vf = *(const bf16x8*)(sVT + (16 * w + fr) * 136 + 32 * ks + 8 * fq);
#pragma unroll
                for (int dt = 0; dt < 4; ++dt) { const bf16x8 kf = *(const bf16x8*)(sKdT + (16 * dt + fr) * 136 + 32 * ks + 8 * fq); accS[dt] = mfma16(kf, vf, accS[dt]); }
            }
        }
        __syncthreads();
#pragma unroll
        for (int dt = 0; dt < 4; ++dt) { u32x2 ow; ow.x = pk2(accS[dt][0], accS[dt][1]); ow.y = pk2(accS[dt][2], accS[dt][3]); *(u32x2*)(sST + (16 * w + fr) * 72 + 16 * dt + 4 * fq) = ow; }
        if (act) {
#pragma unroll
            for (int j = 0; j < 4; ++j) {
                float s = 0.f;
#pragma unroll
                for (int et = 0; et < 8; ++et) s += o[et][j];
                s = row16_sum(s);
                const float mu = s * (1.0f / 128.0f);
                float s2 = 0.f;
#pragma unroll
                for (int et = 0; et < 8; ++et) { const float d = o[et][j] - mu; s2 += d * d; }
                s2 = row16_sum(s2);
                const float rstd = rsqrtf(s2 * (1.0f / 128.0f) + EPS);
                const int n = 16 * w + 4 * fq + j;
                if (n < C) {
                    const size_t row = (size_t)(rowb + t0 + n);
#pragma unroll
                    for (int et = 0; et < 8; ++et) { const int e = 16 * et + fr; const unsigned gw_ = gcp[et >> 1][j]; const float gcv = (et & 1) ? __uint_as_float(gw_ & 0xffff0000u) : __uint_as_float(gw_ << 16);
                        const float yv = gcv * sigm(gcv) * (o[et][j] - mu) * rstd * ngv[et]; Y[row * LDY + 1536 + h * 128 + e] = f2bf(yv); }
                }
            }
        }
    }
    if (grp ? OUT_ON(12) : OUT_ON(6)) {
#pragma unroll
    for (int dt = 0; dt < 4; ++dt)
#pragma unroll
        for (int j = 0; j < 4; ++j) Sout[(16 * dt + 4 * fq + j) * 128 + 16 * w + fr] = accS[dt][j];
    }
}

__device__ __forceinline__ void lru_job(const Params& P, int l, int grp, int jid, int g0, int pb0, unsigned char* smem) {
    const int tid = otid(), w = __builtin_amdgcn_readfirstlane(tid >> 6), lane = tid & 63, fr = lane & 15, fq = lane >> 4;
    bf16_t* sA = (bf16_t*)(smem + w * 10752);
    float* sRI = (float*)(smem + w * 10752 + 2304);
    float* sComb = (float*)(smem + 8 * 10752);
    const bf16_t* Z = (const bf16_t*)(P.ws + R_Z) - (size_t)g0 * DIN; bf16_t* Y = (bf16_t*)(P.ws + R_Y) - (size_t)g0 * LDY;
    const int unit = grp ? jid * 8 + w : jid;
    const int bl = unit / 12, hb = unit - bl * 12, ch = hb * 64 + lane; const int b = grp ? bl : pb0 + bl;
    const int L = grp ? 4 : LP, rowb = grp ? TPR + b * 4 : b * LP;
    float cw[4];
#pragma unroll
    for (int j = 0; j < 4; ++j) cw[j] = INP(I_LCW)[((size_t)l * 4 + j) * 768 + ch];
    const float cb = INP(I_LCB)[l * 768 + ch], ba = INP(I_LBA)[l * 768 + ch], bx = INP(I_LBX)[l * 768 + ch];
    const float lam = INP(I_LAM)[l * 768 + ch];
    const float sp8 = 8.0f * (fmaxf(-lam, 0.f) + log1pf(__expf(-fabsf(lam))));
    bf16x8 Wa[4][2], Wx[4][2];
    { gfp_t wa = INP(I_LWA) + ((size_t)l * 12 + hb) * 4096; gfp_t wx = INP(I_LWX) + ((size_t)l * 12 + hb) * 4096;
#pragma unroll
      for (int nt = 0; nt < 4; ++nt)
#pragma unroll
          for (int ks = 0; ks < 2; ++ks)
#pragma unroll
              for (int j = 0; j < 8; ++j) { const int k = 32 * ks + 8 * fq + j, n = 16 * nt + fr; Wa[nt][ks][j] = (short)f2bf(wa[k * 64 + n]); Wx[nt][ks][j] = (short)f2bf(wx[k * 64 + n]); } }
    float carry = grp ? INP(I_LRUH)[((size_t)l * DEC_B + b) * 768 + ch] : 0.f;
    gfp_t cache = INP(I_LRUC) + ((size_t)l * DEC_B + b) * 3 * 768;
    const int nIter = grp ? 1 : 17;
    __syncthreads();
#ifndef LRU_REP
#define LRU_REP 1
#endif
    bf16_t xn[19];
    { const int tw0 = grp ? 0 : 16 * w;
#pragma unroll
      for (int i = 0; i < 19; ++i) { int t = tw0 - 3 + i; t = t < 0 ? 0 : (t > L - 1 ? L - 1 : t); xn[i] = Z[(size_t)(rowb + t) * DIN + ZO_XB + ch]; } }
    for (int it_ = 0; it_ < nIter * (grp ? 1 : LRU_REP); ++it_) {
        const int it = it_ % nIter; if (LRU_REP > 1 && it_ == nIter) carry = 0.f;
        const int tw = grp ? 0 : it * 128 + 16 * w;
        float xv[19];
#pragma unroll
        for (int i = 0; i < 19; ++i) { const int t = tw - 3 + i; xv[i] = (t >= 0 && t < L) ? bf2f(xn[i]) : 0.f; }
        if (grp) {
#pragma unroll
            for (int i = 0; i < 3; ++i) xv[i] = cache[i * 768 + ch];
        }
        if (it_ + 1 < nIter * (grp ? 1 : LRU_REP)) {
            const int twn = tw + 128;
#pragma unroll
            for (int i = 0; i < 19; ++i) { int t = twn - 3 + i; t = t < 0 ? 0 : (t > L - 1 ? L - 1 : t); xn[i] = Z[(size_t)(rowb + t) * DIN + ZO_XB + ch]; }
        }
        unsigned gtp[8];
#pragma unroll
        for (int i = 0; i < 8; ++i) { const int ta = tw + 2 * i, tb = ta + 1;
            const bf16_t lo = Z[(size_t)(rowb + (ta < L ? ta : L - 1)) * DIN + ZO_GB + ch], hi = Z[(size_t)(rowb + (tb < L ? tb : L - 1)) * DIN + ZO_GB + ch];
            gtp[i] = (unsigned)lo | ((unsigned)hi << 16); }
        float xc[16];
#pragma unroll
        for (int i = 0; i < 16; ++i) { xc[i] = cb + cw[0] * xv[i] + cw[1] * xv[i + 1] + cw[2] * xv[i + 2] + cw[3] * xv[i + 3]; sA[i * 72 + lane] = f2bf(xc[i]); }
        lds_wait();
        bf16x8 af[2];
#pragma unroll
        for (int ks = 0; ks < 2; ++ks) af[ks] = *(const bf16x8*)(sA + fr * 72 + 32 * ks + 8 * fq);
#pragma unroll
        for (int nt = 0; nt < 4; ++nt) {
            f32x4 ra = {0.f, 0.f, 0.f, 0.f}, rx = ra;
            ra = mfma16(af[0], Wa[nt][0], ra); ra = mfma16(af[1], Wa[nt][1], ra);
            rx = mfma16(af[0], Wx[nt][0], rx); rx = mfma16(af[1], Wx[nt][1], rx);
#pragma unroll
            for (int j = 0; j < 4; ++j) { sRI[(4 * fq + j) * 132 + 16 * nt + fr] = ra[j]; sRI[(4 * fq + j) * 132 + 64 + 16 * nt + fr] = rx[j]; }
        }
        lds_wait();
        float hloc[16], ca[16]; float hl = 0.f, cacc = 1.f;
#pragma unroll
        for (int i = 0; i < 16; ++i) {
            const float rp = sRI[i * 132 + lane], ip = sRI[i * 132 + 64 + lane];
            const float r = sigm(rp + ba), ii = sigm(ip + bx);
            const float la = -sp8 * r; float a = __expf(la);
            const float x2 = 2.0f * la;
            const float ser = -x2 * (1.0f + x2 * (0.5f + x2 * (0.16666667f + x2 * (0.041666668f + x2 * 0.0083333338f))));
            const float om = x2 > -0.25f ? ser : 1.0f - __expf(x2);
            float bv = __builtin_amdgcn_sqrtf(om) * ii * xc[i];
            if (tw + i >= L) { a = 1.f; bv = 0.f; }
            hl = a * hl + bv; cacc *= a; hloc[i] = hl; ca[i] = cacc;
        }
        float hin = carry;
        if (!grp) {
            float* sCb = sComb + (it_ & 1) * 1024;
            sCb[(w * 64 + lane) * 2] = cacc; sCb[(w * 64 + lane) * 2 + 1] = hl;
            __syncthreads();
            float run = carry;
#pragma unroll
            for (int ww = 0; ww < 8; ++ww) { if (ww == w) hin = run; run = sCb[(ww * 64 + lane) * 2] * run + sCb[(ww * 64 + lane) * 2 + 1]; }
            carry = run;
        } else carry = hloc[15] + ca[15] * hin;
#pragma unroll
        for (int i = 0; i < 16; ++i) { const int t = tw + i;
            if (t < L) { const size_t row = (size_t)(rowb + t); const float hh = hloc[i] + ca[i] * hin; const unsigned gw_ = gtp[i >> 1]; const float gt = (i & 1) ? __uint_as_float(gw_ & 0xffff0000u) : __uint_as_float(gw_ << 16); Y[row * LDY + 768 + ch] = f2bf(hh * gelu_t(gt)); } }
    }
    if (grp || w == 0) {
        float* ho = grp ? P.out + O_S_LRUH + ((size_t)l * DEC_B + b) * 768 + ch : P.out + O_P_LRUH + ((size_t)l * NB + b) * 768 + ch;
        if (grp ? OUT_ON(10) : OUT_ON(4)) *ho = carry;
        float* co = grp ? P.out + O_S_LRUC + ((size_t)l * DEC_B + b) * 3 * 768 + ch : P.out + O_P_LRUC + ((size_t)l * NB + b) * 3 * 768 + ch;
#pragma unroll
        for (int j = 0; j < 3; ++j) if (grp ? OUT_ON(11) : OUT_ON(5)) co[j * 768] = bf2f(Z[(size_t)(rowb + L - 3 + j) * DIN + ZO_XB + ch]);
    }
}

template <bool FULL>
__device__ __forceinline__ void s5_run(const bf16_t* Z, bf16_t* ZS, float* sBU, bf16_t* sH, const bf16x8 (&Bf)[8], const bf16x8 (&Cf)[4], float abr, float abi, float dsk,
                                       int rowb, int g, int L, int it0, int it1, float& hr, float& hi, int lane, int fr, int fq) {
    u32x4 ufn = {0u, 0u, 0u, 0u}; bf16_t udn[4] = {0, 0, 0, 0};
    { const int t1 = it0 * 16; const int v1 = (L - t1) < 16 ? (L - t1) : 16;
      if (fq < 2 && fr < v1) ufn = *(const u32x4*)(Z + (size_t)(rowb + t1 + fr) * DIN + ZO_UA + g * 16 + 8 * fq);
      if (FULL) {
#pragma unroll
          for (int j = 0; j < 4; ++j) if (4 * fq + j < v1) udn[j] = Z[(size_t)(rowb + t1 + 4 * fq + j) * DIN + ZO_UA + g * 16 + fr]; } }
    for (int it = it0; it < it1; ++it) {
        const int t0 = it * 16; const int valid = (L - t0) < 16 ? (L - t0) : 16;
        const bf16x8 uf = __builtin_bit_cast(bf16x8, ufn);
        bf16_t ud[4];
#pragma unroll
        for (int j = 0; j < 4; ++j) ud[j] = udn[j];
        if (it + 1 < it1) { const int t1 = t0 + 16; const int v1 = (L - t1) < 16 ? (L - t1) : 16;
            ufn = (u32x4){0u, 0u, 0u, 0u};
            if (fq < 2 && fr < v1) ufn = *(const u32x4*)(Z + (size_t)(rowb + t1 + fr) * DIN + ZO_UA + g * 16 + 8 * fq);
            if (FULL) {
#pragma unroll
                for (int j = 0; j < 4; ++j) { udn[j] = 0; if (4 * fq + j < v1) udn[j] = Z[(size_t)(rowb + t1 + 4 * fq + j) * DIN + ZO_UA + g * 16 + fr]; } } }
#pragma unroll
        for (int nt = 0; nt < 8; ++nt) { f32x4 a = {0.f, 0.f, 0.f, 0.f}; a = mfma16(uf, Bf[nt], a);
#pragma unroll
            for (int j = 0; j < 4; ++j) sBU[(4 * fq + j) * 132 + 16 * nt + fr] = a[j]; }
        lds_wait();
#pragma unroll
        for (int i = 0; i < 16; ++i) {
            float bur = sBU[i * 132 + lane], bui = sBU[i * 132 + 64 + lane];
            asm volatile("" : "+v"(bur), "+v"(bui));
            const float msk = (i < valid) ? 1.0f : 0.0f;
            float nr = __builtin_fmaf(abr, hr, bur); asm volatile("" : "+v"(nr));
            nr = __builtin_fmaf(-abi, hi, nr); asm volatile("" : "+v"(nr));
            float ni = __builtin_fmaf(abr, hi, bui); asm volatile("" : "+v"(ni));
            ni = __builtin_fmaf(abi, hr, ni); asm volatile("" : "+v"(ni));
            hr = __builtin_fmaf(msk, nr - hr, hr); hi = __builtin_fmaf(msk, ni - hi, hi);
            asm volatile("" : "+v"(hr), "+v"(hi));
            if (FULL) { sH[i * 136 + lane] = f2bf(hr); sH[i * 136 + 64 + lane] = f2bf(hi); }
        }
        lds_wait();
        if (FULL) {
            f32x4 y = {0.f, 0.f, 0.f, 0.f};
#pragma unroll
            for (int ks = 0; ks < 4; ++ks) { const bf16x8 hf = *(const bf16x8*)(sH + fr * 136 + 32 * ks + 8 * fq); y = mfma16(hf, Cf[ks], y); }
#pragma unroll
            for (int j = 0; j < 4; ++j) { const int t = 4 * fq + j;
                if (t < valid) { const size_t row = (size_t)(rowb + t0 + t); const float u = bf2f(ud[j]); ZS[row * 768 + g * 16 + fr] = f2bf(gelu_t(y[j] + dsk * u)); } }
            lds_wait();
        }
    }
}
__device__ __forceinline__ void cmul(float& ar, float& ai, float br, float bi) { const float r = ar * br - ai * bi, i = ar * bi + ai * br; ar = r; ai = i; }

__device__ __forceinline__ void s5_job(const Params& P, int l, int grp, int jid, int g0, int pb0, unsigned* s5done, unsigned char* smem) {
    const int tid = otid(), w = __builtin_amdgcn_readfirstlane(tid >> 6), lane = tid & 63, fr = lane & 15, fq = lane >> 4;
    float* sBU = (float*)(smem + w * 12800);
    bf16_t* sH = (bf16_t*)(smem + w * 12800 + 8448);
    float* sC = (float*)(smem + 8 * 12800);
    const bf16_t* Z = (const bf16_t*)(P.ws + R_Z) - (size_t)g0 * DIN; bf16_t* ZS = (bf16_t*)(P.ws + R_ZS5) - (size_t)g0 * 768;
    int g, b0;
    if (grp) { const int unit = jid * 8 + w; g = unit % 48; b0 = (unit / 48) * 16; } else { b0 = jid / 48; g = jid - b0 * 48; b0 += pb0; }
    const float dt = __expf(INP(I_LS)[l * 48 + g]);
    float abr = 0.f, abi = 0.f;
    bf16x8 Bf[8];
#pragma unroll
    for (int k = 0; k < 4; ++k) {
        const int p = 16 * k + fr;
        const float lr = INP(I_AR)[((size_t)l * 48 + g) * 64 + p], li = INP(I_AI)[((size_t)l * 48 + g) * 64 + p];
        const float mag = expf(lr * dt), ar_ = mag * cosf(li * dt), ai_ = mag * sinf(li * dt);
        if (k == fq) { abr = ar_; abi = ai_; }
        const float den = lr * lr + li * li, nr = ar_ - 1.0f;
        const float cr = (nr * lr + ai_ * li) / den, ci = (ai_ * lr - nr * li) / den;
        bf16x8 fre, fim;
#pragma unroll
        for (int j = 0; j < 8; ++j) { fre[j] = 0; fim[j] = 0; }
        if (fq < 2) {
            gfp_t bre = INP(I_BR) + (((size_t)l * 48 + g) * 64 + p) * 16 + 8 * fq; gfp_t bim = INP(I_BI) + (((size_t)l * 48 + g) * 64 + p) * 16 + 8 * fq;
#pragma unroll
            for (int j = 0; j < 8; ++j) { const float br_ = bre[j], bi_ = bim[j]; fre[j] = (short)f2bf(cr * br_ - ci * bi_); fim[j] = (short)f2bf(cr * bi_ + ci * br_); }
        }
        Bf[k] = fre; Bf[4 + k] = fim;
    }
    bf16x8 Cf[4];
#pragma unroll
    for (int ks = 0; ks < 4; ++ks) {
        gfp_t cp = (ks < 2 ? INP(I_CR) : INP(I_CI)) + (((size_t)l * 48 + g) * 16 + fr) * 64 + 32 * (ks & 1) + 8 * fq;
        const float sg = ks < 2 ? 1.0f : -1.0f;
#pragma unroll
        for (int j = 0; j < 8; ++j) Cf[ks][j] = (short)f2bf(sg * cp[j]);
    }
    const float dsk = INP(I_D)[l * 768 + g * 16 + fr];
    __syncthreads();
    if (grp) {
        for (int s = 0; s < 16; ++s) {
            const int b = b0 + s; const int rowb = TPR + b * 4;
            float hr = INP(I_S5RE)[(((size_t)l * DEC_B + b) * 48 + g) * 64 + lane], hi = INP(I_S5IM)[(((size_t)l * DEC_B + b) * 48 + g) * 64 + lane];
            s5_run<true>(Z, ZS, sBU, sH, Bf, Cf, abr, abi, dsk, rowb, g, 4, 0, 1, hr, hi, lane, fr, fq);
            P.out[O_S_S5RE + (((size_t)l * DEC_B + b) * 48 + g) * 64 + lane] = hr;
            P.out[O_S_S5IM + (((size_t)l * DEC_B + b) * 48 + g) * 64 + lane] = hi;
        }
    } else {
        const int b = b0, rowb = b * LP;
        const int it0 = w == 0 ? 0 : 17 + 16 * (w - 1), it1 = 17 + 16 * w;
        float hr = 0.f, hi = 0.f;
        s5_run<false>(Z, ZS, sBU, sH, Bf, Cf, abr, abi, dsk, rowb, g, LP, it0, it1, hr, hi, lane, fr, fq);
        sC[(w * 64 + lane) * 2] = hr; sC[(w * 64 + lane) * 2 + 1] = hi;
        float pr = abr, pi = abi, p16r = 0.f, p16i = 0.f;
#pragma unroll
        for (int q = 0; q < 8; ++q) { cmul(pr, pi, pr, pi); if (q == 3) { p16r = pr; p16i = pi; } }
        float qr = pr, qi = pi; cmul(qr, qi, p16r, p16i);
        __syncthreads();
        float cr_ = 0.f, ci_ = 0.f;
        for (int ww = 0; ww < w; ++ww) {
            const float ar2 = ww == 0 ? qr : pr, ai2 = ww == 0 ? qi : pi;
            cmul(cr_, ci_, ar2, ai2);
            cr_ += sC[(ww * 64 + lane) * 2]; ci_ += sC[(ww * 64 + lane) * 2 + 1];
        }
        hr = cr_; hi = ci_;
        s5_run<true>(Z, ZS, sBU, sH, Bf, Cf, abr, abi, dsk, rowb, g, LP, it0, it1, hr, hi, lane, fr, fq);
        if (w == 7) {
            P.out[O_P_S5RE + (((size_t)l * NB + b) * 48 + g) * 64 + lane] = hr;
            P.out[O_P_S5IM + (((size_t)l * NB + b) * 48 + g) * 64 + lane] = hi;
        }
    }
    asm volatile("s_waitcnt vmcnt(0)" ::: "memory");
    __syncthreads();
    if (threadIdx.x == 0) { __threadfence(); asm volatile("s_waitcnt vmcnt(0)" ::: "memory"); atomicAdd(s5done, 1u); }
}

__device__ __forceinline__ void mixers_phase(const Params& P, int l, int rg, unsigned char* smem, int rep) {
    const Grp G = get_grp(rg);
    const int j1 = G.npb * 8, j2 = j1 + G.npb * 12, j3 = j2 + G.npb * 48, j4 = j3 + (G.hasS ? 1024 : 0), j5 = j4 + (G.hasS ? 48 : 0), j6 = j5 + (G.hasS ? 192 : 0), j7 = j6 + G.npan * 12, NJ = j7 + G.npan * 3;
    unsigned* s5done = (unsigned*)(P.ws + A_CTR) + 32 + (l * NGRP + rg) + rep * 16;
    const unsigned s5total = (unsigned)(G.npb * 48 + (G.hasS ? 48 : 0));
    unsigned* ctr = (unsigned*)(P.ws + A_CTR) + (l * NGRP + rg) + rep * 16;
    int* slot = (int*)(smem + LDS_BYTES - 16);
#ifndef STATIC_JOBS
#define STATIC_JOBS 0
#endif
    for (int jj = blockIdx.x;; jj += gridDim.x) {
        __syncthreads();
#if STATIC_JOBS
        const int j = jj; (void)ctr; (void)slot;
#else
        if (threadIdx.x == 0) *slot = (int)atomicAdd(ctr, 1u);
        __syncthreads();
        const int j = *slot;
#endif
        if (j >= NJ) break;
        int type, sg, idx;
        if (j < j1) { type = 0; sg = 0; idx = j; }
        else if (j < j2) { type = 1; sg = 0; idx = j - j1; }
        else if (j < j3) { type = 2; sg = 0; idx = j - j2; }
        else if (j < j4) { type = 0; sg = 1; idx = j - j3; }
        else if (j < j5) { type = 2; sg = 1; idx = j - j4; }
        else if (j < j6) { type = 1; sg = 1; idx = j - j5; }
        else if (j < j7) { type = 4; sg = 0; idx = j - j6; }
        else { type = 3; sg = 0; idx = j - j7; }
        if (type == 4) {
            using namespace pg8;
            Gemm gg{(const bf16_t*)(P.ws + R_H), (const bf16_t*)(P.ws + W_IN) + (size_t)l * DIN * DM, DM, DM, G.npan, DIN / 256, DM / 64, nullptr};
            SchedOne S1{idx / 12, 21 + idx % 12, DM / 64};
            EpiSigBf E{(bf16_t*)(P.ws + R_Z), DIN};
            gemm_run((LAS unsigned char*)smem, gg, S1, E);
            continue;
        }
        if (type == 3) {
            if (threadIdx.x == 0) {
                unsigned sp = 0;
                while (__hip_atomic_load(s5done, __ATOMIC_RELAXED, __HIP_MEMORY_SCOPE_AGENT) < s5total) { __builtin_amdgcn_s_sleep(8); if (++sp > (1u << 22)) break; }
                __threadfence();
                asm volatile("s_waitcnt vmcnt(0)" ::: "memory");
            }
            __syncthreads();
            using namespace pg8;
            Gemm gg{(const bf16_t*)(P.ws + R_ZS5), (const bf16_t*)(P.ws + W_GLU) + (size_t)l * 768 * 768, 768, 768, G.npan, 3, 12, nullptr};
            SchedOne S1{idx / 3, idx % 3, 12};
            EpiGlu E{(bf16_t*)(P.ws + R_Y), (const bf16_t*)(P.ws + R_ZS5), INP(I_BGLU) + l * 768};
            gemm_run((LAS unsigned char*)smem, gg, S1, E);
            continue;
        }
        if (type == 0) ret_job(P, l, sg, (idx >> 3) + (sg ? 0 : G.pb0), idx & 7, G.g0, smem);
        else if (type == 1) lru_job(P, l, sg, idx, G.g0, G.pb0, smem);
        else s5_job(P, l, sg, idx, G.g0, G.pb0, s5done, smem);
    }
}

__device__ __forceinline__ void run_phase(const Params& P, int ph, unsigned char* smem, int rep) {
#ifndef PHSEL
#define PHSEL -1
#endif
#define PSEL(x) (PHSEL < 0 || PHSEL == (x))
    if (ph == 0) { if (PSEL(10)) phase0(P, smem); return; }
    const int l = (ph - 1) / (10 * NGRP), rg = ((ph - 1) / 10) % NGRP, s = (ph - 1) % 10;
    LAS unsigned char* lds = (LAS unsigned char*)smem;
    unsigned char* ws = P.ws;
    using namespace pg8;
    const int G = gridDim.x, c = blockIdx.x;
    const int npan = rg < 2 ? 25 : 19;
    switch (s) {
    case 0: if (PSEL(0)) { Gemm g{(const bf16_t*)(ws + R_H), (const bf16_t*)(ws + W_IN) + (size_t)l * DIN * DM, DM, DM, npan, 21, DM / 64, nullptr};
              Sched<1> S; S.init(g.nM, g.nN, G, c, g.nt); EpiBf E{(bf16_t*)(ws + R_Z), DIN, (bf16_t*)(ws + R_Z)}; gemm_run(lds, g, S, E); } break;
    case 1: if (PSEL(1)) mixers_phase(P, l, rg, smem, rep); break;
    case 2: if (PSEL(2)) { Gemm g{(const bf16_t*)(ws + R_ZS5), (const bf16_t*)(ws + W_GLU) + (size_t)l * 768 * 768, 768, 768, npan, 3, 12, nullptr};
              Sched<1> S; S.init(g.nM, g.nN, G, c, g.nt); EpiGlu E{(bf16_t*)(ws + R_Y), (const bf16_t*)(ws + R_ZS5), INP(I_BGLU) + l * 768}; gemm_run(lds, g, S, E); } break;
    case 3: if (PSEL(3)) { Gemm g{(const bf16_t*)(ws + R_Y), (const bf16_t*)(ws + W_BR) + (size_t)l * DM * LDY, LDY, LDY, npan, 4, 0, nullptr};
              SchedBr2 S; S.init(g.nM, g.nN, G, c); EpiBranch E{(const bf16_t*)(ws + R_Z) + ZO_GATE, (bf16_t*)(ws + R_M), (bf16_t*)(ws + R_M2)}; gemm_run(lds, g, S, E); } break;
    case 4: if (PSEL(4)) { Gemm g{(const bf16_t*)(ws + R_M), (const bf16_t*)(ws + W_OUT) + (size_t)l * DM * DM, DM, DM, npan, 4, 16, (const bf16_t*)(ws + R_M2)};
              Sched<2> S; S.init(g.nM, g.nN, G, c, g.nt); S.fullk = 1;     EpiBf E{(bf16_t*)(ws + R_F), DM, (bf16_t*)(ws + R_UP)}; gemm_run(lds, g, S, E); } break;
    case 5: if (PSEL(5) && rep == 0) norm_rows(P, 1, l, rg, smem); break;
    case 6: if (PSEL(6)) { Gemm g{(const bf16_t*)(ws + R_H), (const bf16_t*)(ws + W_UP) + (size_t)l * 2 * DFF * DM, DM, DM, npan, 22, 16, nullptr};
              Sched<1> S; S.init(g.nM, g.nN, G, c, g.nt); EpiBf E{(bf16_t*)(ws + R_UP), 2 * DFF, (bf16_t*)(ws + R_UP)}; gemm_run(lds, g, S, E); } break;
    case 7: if (PSEL(7)) ffn_conv_phase(P, l, rg, smem); break;
    case 8: if (PSEL(8)) { Gemm g{(const bf16_t*)(ws + R_FIN), (const bf16_t*)(ws + W_DOWN) + (size_t)l * DM * DFF, DFF, DFF, npan, 4, 44, nullptr};
              Sched<2> S; S.init(g.nM, g.nN, G, c, g.nt); EpiBf E{(bf16_t*)(ws + R_F), DM, (bf16_t*)(ws + R_UP)}; gemm_run(lds, g, S, E);
              const int nun = 2 * npan * 4;
              if (c >= nun) next_h_rows(P, l, rg, (c - nun) * 8 + (int)(threadIdx.x >> 6), (G - nun) * 8, smem);
              else if (G <= nun) next_h_rows(P, l, rg, c * 8 + (int)(threadIdx.x >> 6), G * 8, smem); } break;
    default: if (PSEL(9) && rep == 0) norm_rows(P, 2, l, rg, smem); break;
    }
}

#define XB_TMO      128
#define XB_XCNT(j)  (256  + 64 * (j))
#define XB_XSUB(j)  (1280 + 64 * (j))
#define XB_XGEN(j)  (2304 + 64 * (j))
#define XB_TOP      3328
#define XB_TOPGEN   3392
#define XCD_BAR_WORDS 3456
#define XB_SPIN_CAP (1u << 18)

__device__ __forceinline__ unsigned xb_ld(unsigned* p)              { return __hip_atomic_load(p, __ATOMIC_RELAXED, __HIP_MEMORY_SCOPE_AGENT); }
__device__ __forceinline__ unsigned xb_add(unsigned* p, unsigned v) { return __hip_atomic_fetch_add(p, v, __ATOMIC_RELAXED, __HIP_MEMORY_SCOPE_AGENT); }
__device__ __forceinline__ unsigned xb_xcc_id() { return (unsigned)__builtin_amdgcn_s_getreg((3 << 11) | 20) & 0xFu; }
#define XB_SPIN(cond, bar) do { unsigned _sp = 0; while (cond) { __builtin_amdgcn_s_sleep(1); \
    if ((++_sp & 255u) == 0u) { if (xb_ld(&(bar)[XB_TMO])) break; if (_sp > XB_SPIN_CAP) { atomicAdd(&(bar)[XB_TMO], 1u); break; } } } } while (0)

struct XcdBarrier {
    unsigned* bar; unsigned x;
    volatile LAS unsigned* st;
};

__device__ __forceinline__ XcdBarrier xcd_barrier_post(unsigned* bar, volatile LAS unsigned* st) {
    XcdBarrier b; b.bar = bar; b.x = xb_xcc_id(); b.st = st;
    if (threadIdx.x == 0) (void)xb_add(&bar[XB_XCNT(b.x)], 1u);
    return b;
}
__device__ __forceinline__ void xcd_barrier_complete(unsigned* bar, unsigned x, unsigned& nloc, unsigned& nx) {
    const unsigned G = gridDim.x * gridDim.y * gridDim.z;
    unsigned sum, cnt, mine, sp = 0u;
    for (;;) {
        sum = 0u; cnt = 0u; mine = 0u;
#pragma unroll
        for (unsigned j = 0; j < 16; ++j) { const unsigned c = xb_ld(&bar[XB_XCNT(j)]); sum += c; cnt += (c > 0u) ? 1u : 0u; mine = (j == x) ? c : mine; }
        if (sum == G) break;
        __builtin_amdgcn_s_sleep(1);
        if ((++sp & 255u) == 0u) { if (xb_ld(&bar[XB_TMO])) break; if (sp > XB_SPIN_CAP) { atomicAdd(&bar[XB_TMO], 1u); break; } }
    }
    nloc = mine > 0u ? mine : 1u; nx = cnt > 0u ? cnt : 1u;
}

__device__ __forceinline__ void xcd_barrier(const XcdBarrier& b) {
    asm volatile("s_waitcnt vmcnt(0)" ::: "memory");
    __syncthreads();
    if (threadIdx.x == 0) {
        unsigned* bar = b.bar;
        __builtin_amdgcn_s_waitcnt(0);
        unsigned nloc = b.st[0], nx = b.st[1];
        if (nloc == 0u) { xcd_barrier_complete(bar, b.x, nloc, nx); b.st[0] = nloc; b.st[1] = nx; }
        const unsigned old = xb_add(&bar[XB_XSUB(b.x)], 1u);
        const unsigned gen = old / nloc;
        if (old + 1u == (gen + 1u) * nloc) {
            __builtin_amdgcn_fence(__ATOMIC_RELEASE, "agent");
            asm volatile("s_waitcnt vmcnt(0)" ::: "memory");
            const unsigned og = xb_add(&bar[XB_TOP], 1u);
            const unsigned tg = og / nx;
            if (og + 1u == (tg + 1u) * nx) xb_add(&bar[XB_TOPGEN], 1u);
            else XB_SPIN(xb_ld(&bar[XB_TOPGEN]) == tg, bar);
            __builtin_amdgcn_fence(__ATOMIC_ACQUIRE, "agent");
            xb_add(&bar[XB_XGEN(b.x)], 1u);
            asm volatile("s_waitcnt vmcnt(0)" ::: "memory");
        } else {
            XB_SPIN(xb_ld(&bar[XB_XGEN(b.x)]) == gen, bar);
            __builtin_amdgcn_fence(__ATOMIC_ACQUIRE, "agent");
            asm volatile("s_waitcnt vmcnt(0)" ::: "memory");
        }
    }
    __syncthreads();
}


__global__ void __launch_bounds__(512, 2) mega(Params P, int ph_lo, int ph_hi) {
    extern __shared__ __attribute__((aligned(16))) unsigned char smem[];
    unsigned* xst = (unsigned*)(smem + LDS_BYTES - 32);
    if (threadIdx.x == 0) {
        const float** tab = (const float**)(smem + PTAB_OFF);
#pragma unroll
        for (int i = 0; i < N_IN; ++i) tab[i] = P.in[i];
        xst[0] = 0u; xst[1] = 0u;
    }
    __syncthreads();
    XcdBarrier xb = xcd_barrier_post((unsigned*)(P.ws + A_BAR), (volatile LAS unsigned*)xst);
#ifndef DUP_MASK
#define DUP_MASK 0x400
#endif
    for (int ph = ph_lo; ph < ph_hi; ++ph) {
        if (ph > 0 && (ph - 1) % 10 == 2) continue;
        int nrep = 1;
        if (DUP_MASK) { const int sidx = ph == 0 ? 10 : (ph - 1) % 10; if ((DUP_MASK >> sidx) & 1) nrep = 2; }
        for (int rep = 0; rep < nrep; ++rep) {
            run_phase(P, ph, smem, rep);
            if (ph + 1 < ph_hi || rep + 1 < nrep) xcd_barrier(xb);
        }
    }
}


#ifndef DBG_STOP
#define DBG_STOP 0
#endif
#ifndef DBG_OFF
#define DBG_OFF R_Z
#endif
__global__ void dbg_dump(const unsigned char* ws, float* out, size_t n) {
    const bf16_t* src = (const bf16_t*)(ws + DBG_OFF);
    for (size_t i = (size_t)blockIdx.x * blockDim.x + threadIdx.x; i < n; i += (size_t)gridDim.x * blockDim.x) out[i] = bf2f(src[i]);
}

extern "C" void kernel_launch(void* const* d_in, const int* in_sizes, int n_in, void* d_out, int out_size, void* d_ws, size_t ws_size, hipStream_t stream) {
    (void)in_sizes; (void)n_in; (void)out_size;
    if (ws_size < WS_TOTAL) { fprintf(stderr, "workspace too small: %zu < %zu\n", ws_size, (size_t)WS_TOTAL); return; }
    Params p{};
    for (int i = 0; i < N_IN; ++i) p.in[i] = (const float*)d_in[i];
    p.out = (float*)d_out; p.ws = (unsigned char*)d_ws;
    hipFuncSetAttribute((const void*)mega, hipFuncAttributeMaxDynamicSharedMemorySize, LDS_BYTES);
    int dev = 0, cus = 256, per_cu = 1;
    hipGetDevice(&dev);
    hipDeviceGetAttribute(&cus, hipDeviceAttributeMultiprocessorCount, dev);
    hipOccupancyMaxActiveBlocksPerMultiprocessor(&per_cu, mega, 512, LDS_BYTES);
    if (per_cu < 1) per_cu = 1;
    const int grid = cus * 1;
#if COOP
#ifndef PH_HI
#define PH_HI NPHASE
#endif
    hipMemsetAsync((unsigned char*)d_ws + A_BAR, 0, 16384, stream);
    int lo = 0, hi = PH_HI;
    void* args[] = {&p, &lo, &hi};
    hipError_t e = hipLaunchCooperativeKernel((void*)mega, dim3(grid), dim3(512), args, LDS_BYTES, stream);
    if (e != hipSuccess) fprintf(stderr, "cooperative launch failed: %s (grid %d)\n", hipGetErrorString(e), grid);
#else
#if DBG_STOP
    for (int ph = 0; ph < DBG_STOP; ++ph) hipLaunchKernelGGL(mega, dim3(grid), dim3(512), LDS_BYTES, stream, p, ph, ph + 1);
#ifdef DBG_EXTRA
    hipLaunchKernelGGL(mega, dim3(grid), dim3(512), LDS_BYTES, stream, p, DBG_EXTRA, DBG_EXTRA + 1);
#endif
    hipLaunchKernelGGL(dbg_dump, dim3(2048), dim3(256), 0, stream, (const unsigned char*)d_ws, (float*)d_out, (size_t)34873344);
#else
    for (int ph = 0; ph < NPHASE; ++ph) hipLaunchKernelGGL(mega, dim3(grid), dim3(512), LDS_BYTES, stream, p, ph, ph + 1);
#endif
#endif
}
```

```cpp
#include <hip/hip_runtime.h>
#include <hip/hip_cooperative_groups.h>
#include <cstdio>
namespace cg = cooperative_groups;

#define DUP_MASK 0
#ifndef COOP
#define COOP 1
#endif
#ifndef OUTMASK
#define OUTMASK 0x3FFF
#endif
#ifndef OUT_BMAX
#define OUT_BMAX 1000
#endif
#ifndef OUT_L
#define OUT_L 3
#endif
#define OUT_ON(k) (((OUTMASK >> (k)) & 1) && ((OUT_L >> l) & 1))
#ifndef DMA_AUX
#define DMA_AUX 0
#endif

#define LAS __attribute__((address_space(3)))
typedef unsigned short bf16_t;
typedef short bf16x8 __attribute__((ext_vector_type(8)));
typedef float f32x4 __attribute__((ext_vector_type(4)));
typedef unsigned u32x4 __attribute__((ext_vector_type(4)));
typedef unsigned u32x2 __attribute__((ext_vector_type(2)));

constexpr int DM = 1024, NB = 8, SEQ = 2048, LP = 2064, DEC_B = 128, DEC_S = 4;
constexpr int TPR = NB * LP;
constexpr int TT = TPR + DEC_B * DEC_S;
constexpr int TPAD = 17152;
constexpr int DIN = 8448, DFF = 2816;
constexpr int ZO_UA = 0, ZO_XB = 768, ZO_GB = 1536, ZO_Q = 2304, ZO_K = 2816, ZO_V = 3328, ZO_GC = 4352, ZO_GATE = 5376;
constexpr int LDY = 2560;
constexpr float EPS = 1e-6f;
constexpr int LDS_BYTES = 143360;

enum { I_XP = 0, I_XS, I_S5RE, I_S5IM, I_LRUH, I_LRUC, I_RET, I_FFNC, I_META, I_GPREMIX, I_GPOSTMIX, I_GPREFFN, I_GPOSTFFN, I_WIN,
       I_AR, I_AI, I_LS, I_BR, I_BI, I_CR, I_CI, I_D, I_WGLU, I_BGLU, I_LCW, I_LCB, I_LWA, I_LBA, I_LWX, I_LBX, I_LAM, I_RNG,
       I_WBA, I_WBB, I_WBC, I_WOUT, I_WUP, I_FCW, I_FCB, I_WDOWN, N_IN };

constexpr size_t O_YP = 0;
constexpr size_t O_YS = O_YP + (size_t)NB * SEQ * DM;
constexpr size_t O_P_S5RE = O_YS + (size_t)DEC_B * DEC_S * DM;
constexpr size_t O_P_S5IM = O_P_S5RE + 2 * NB * 48 * 64;
constexpr size_t O_P_LRUH = O_P_S5IM + 2 * NB * 48 * 64;
constexpr size_t O_P_LRUC = O_P_LRUH + 2 * NB * 768;
constexpr size_t O_P_RET = O_P_LRUC + 2 * NB * 3 * 768;
constexpr size_t O_P_FFNC = O_P_RET + (size_t)2 * NB * 8 * 64 * 128;
constexpr size_t O_S_S5RE = O_P_FFNC + 2 * NB * 2 * DFF;
constexpr size_t O_S_S5IM = O_S_S5RE + 2 * DEC_B * 48 * 64;
constexpr size_t O_S_LRUH = O_S_S5IM + 2 * DEC_B * 48 * 64;
constexpr size_t O_S_LRUC = O_S_LRUH + 2 * DEC_B * 768;
constexpr size_t O_S_RET = O_S_LRUC + 2 * DEC_B * 3 * 768;
constexpr size_t O_S_FFNC = O_S_RET + (size_t)2 * DEC_B * 8 * 64 * 128;

constexpr size_t al256(size_t x) { return (x + 255) & ~(size_t)255; }
constexpr size_t W_IN = 0;
constexpr size_t W_GLU = W_IN + (size_t)2 * DIN * DM * 2;
constexpr size_t W_BR = W_GLU + (size_t)2 * 768 * 768 * 2;
constexpr size_t W_OUT = W_BR + (size_t)2 * DM * LDY * 2;
constexpr size_t W_UP = W_OUT + (size_t)2 * DM * DM * 2;
constexpr size_t W_DOWN = W_UP + (size_t)2 * 2 * DFF * DM * 2;
constexpr size_t A_X = W_DOWN + (size_t)2 * DM * DFF * 2;
constexpr int GR = 6400;
constexpr size_t R_Z = A_X + (size_t)TPAD * DM * 4;
constexpr size_t R_ZS5 = R_Z + (size_t)GR * DIN * 2;
constexpr size_t R_Y = R_ZS5 + (size_t)GR * 768 * 2;
constexpr size_t R_M = R_Y + (size_t)GR * LDY * 2;
constexpr size_t R_END = R_M + (size_t)GR * DM * 2;
constexpr size_t R_H = R_M;
constexpr size_t R_F = R_Z;
constexpr size_t R_UP = R_Z + (size_t)GR * DM * 4;
constexpr size_t R_FIN = R_ZS5;
static_assert(R_UP + (size_t)GR * 2 * DFF * 2 <= R_ZS5, "UP inside Z");
static_assert(R_FIN + (size_t)GR * DFF * 2 <= R_M, "FIN inside ZS5|Y");
constexpr size_t A_ROPE = R_END;
constexpr size_t A_CTR = al256(A_ROPE + (size_t)2068 * 64 * 4);
constexpr size_t A_BAR = A_CTR + 4096;
constexpr size_t WS_TOTAL = A_BAR + 16384;
constexpr size_t R_M2 = A_X + (size_t)40 * 1024 * 1024;
static_assert(A_X + (size_t)TPAD * DM * 2 <= R_M2 && R_M2 + (size_t)GR * DM * 2 <= R_Z, "M2 inside the freed half of the X reservation");
constexpr int NGRP = 3;
constexpr int NPHASE = 1 + 2 * NGRP * 10;

struct Grp { int g0, nrows, npan, pb0, npb, hasS; };
__device__ __forceinline__ Grp get_grp(int g) {
    Grp r; r.g0 = g * 6192; r.nrows = g < 2 ? 6192 : 4640; r.npan = g < 2 ? 25 : 19; r.pb0 = g * 3; r.npb = g < 2 ? 3 : 2; r.hasS = g == 2; return r;
}

struct Params {
    const float* in[N_IN];
    float* out;
    unsigned char* ws;
};


constexpr int PTAB_OFF = 142336;
typedef const __attribute__((address_space(1))) float* gfp_t;
typedef const __attribute__((address_space(1))) f32x4* gf4p_t;
__device__ __forceinline__ gfp_t ldin(const unsigned char* smem, int i) {
    const unsigned long long v = ((const unsigned long long*)(smem + PTAB_OFF))[i];
    const unsigned lo = __builtin_amdgcn_readfirstlane((unsigned)v), hi = __builtin_amdgcn_readfirstlane((unsigned)(v >> 32));
    return (gfp_t)(((unsigned long long)hi << 32) | lo);
}
#define INP(i) ldin(smem, (i))
__device__ __forceinline__ int otid() { int t = threadIdx.x; asm volatile("" : "+v"(t)); return t; }

__device__ __forceinline__ float bf2f(bf16_t b) { return __uint_as_float(((unsigned)b) << 16); }
__device__ __forceinline__ bf16_t f2bf(float f) { unsigned u = __float_as_uint(f); u += 0x7FFFu + ((u >> 16) & 1u); return (bf16_t)(u >> 16); }
__device__ __forceinline__ unsigned pk2(float lo, float hi) { return (unsigned)f2bf(lo) | ((unsigned)f2bf(hi) << 16); }
__device__ __forceinline__ float sigm(float x) { return __builtin_amdgcn_rcpf(1.0f + __expf(-x)); }
__device__ __forceinline__ float gelu_t(float x) { const float v = 1.5957691216f * (x + 0.044715f * x * x * x); return x * __builtin_amdgcn_rcpf(1.0f + __expf(-v)); }
__device__ __forceinline__ void lds_wait() { asm volatile("s_waitcnt lgkmcnt(0)" ::: "memory"); __builtin_amdgcn_wave_barrier(); }
__device__ __forceinline__ f32x4 mfma16(bf16x8 a, bf16x8 b, f32x4 c) { return __builtin_amdgcn_mfma_f32_16x16x32_bf16(a, b, c, 0, 0, 0); }

namespace pg8 {
constexpr int BM = 256, BK = 64, HALF = 128, HTB = HALF * BK * 2, STAGE_BYTES = 8 * HTB, NXCD = 8, WGM = 8;
__device__ __forceinline__ int lds_byte(int r, int c) { const int st = (r >> 4) * 2 + (c >> 5), rr = r & 15, cc = c & 31, ob = rr * 64 + cc * 2; return st * 1024 + (ob ^ (((ob >> 9) & 1) << 5)); }
__device__ __forceinline__ void stage_rc(int b, int& R, int& C) { const int st = b / 1024, sb = b % 1024, swz = sb ^ (((sb >> 9) & 1) << 5); R = (st >> 1) * 16 + swz / 64; C = (st & 1) * 32 + (swz % 64) / 2; }

struct Unit { int pm, pn, br; };
struct Gemm { const bf16_t* A; const bf16_t* Bt; int lda, ldb, nM, nN, nt; const bf16_t* A2; };

struct SchedOne {
    int pm, pn, nt0;
    __device__ bool next(int i, Unit& u) const { if (i != 0) return false; u.pm = pm; u.pn = pn; u.br = 0; return true; }
    __device__ __forceinline__ void kr(const Unit&, size_t& koffB, int& nt) const { koffB = 0; nt = nt0; }
};
template <int NBR> struct Sched {
    int nM, nN, nwg, G, c, nt0, fullk;
    __device__ void init(int nM_, int nN_, int G_, int c_, int nt_) { nM = nM_; nN = nN_; nwg = nM * nN; G = G_; c = c_; nt0 = nt_; fullk = 0; }
    __device__ bool next(int i, Unit& u) const {
        int wgid;
        if (NBR == 2) {
            const long L = (long)i * G + c; if (L >= 2 * (long)nwg) return false;
            u.br = (int)(L / nwg); wgid = (int)(L - (long)u.br * nwg);
        } else {
            const int ti = i / NBR; u.br = i - ti * NBR;
            const long L = (long)ti * G + c; if (L >= nwg) return false;
            wgid = (int)L;
        } { const int q = nwg / NXCD, r = nwg % NXCD, xcd = wgid % NXCD, off = wgid / NXCD; wgid = (xcd < r ? xcd * (q + 1) : r * (q + 1) + (xcd - r) * q) + off; }
        const int nig = WGM * nN, gid = wgid / nig, fm = gid * WGM, gsz = (nM - fm) < WGM ? (nM - fm) : WGM;
        u.pm = fm + ((wgid % nig) % gsz); u.pn = (wgid % nig) / gsz; return true;
    }
    __device__ __forceinline__ void kr(const Unit& u, size_t& koffB, int& nt) const {
        if (NBR == 1) { koffB = 0; nt = nt0; }
        else if (NBR == 2) { if (fullk) { nt = nt0; koffB = 0; } else { nt = nt0 >> 1; koffB = (size_t)u.br * (size_t)nt * 128; } }
        else { koffB = (size_t)u.br * 1536; nt = (u.br == 2) ? 16 : 12; }
    }
};

struct SchedBr2 {
    int nM, nN, nwg, G, c;
    __device__ void init(int nM_, int nN_, int G_, int c_) { nM = nM_; nN = nN_; nwg = nM * nN; G = G_; c = c_; }
    __device__ bool next(int i, Unit& u) const {
        const int ti = i / 3, b = i - ti * 3;
        const long L = (long)ti * G + c; if (L >= 2 * (long)nwg) return false;
        const int half = (int)(L / nwg); int wgid = (int)(L - (long)half * nwg);
        { const int q = nwg / NXCD, r = nwg % NXCD, xcd = wgid % NXCD, off = wgid / NXCD; wgid = (xcd < r ? xcd * (q + 1) : r * (q + 1) + (xcd - r) * q) + off; }
        const int nig = WGM * nN, gid = wgid / nig, fm = gid * WGM, gsz = (nM - fm) < WGM ? (nM - fm) : WGM;
        u.pm = fm + ((wgid % nig) % gsz); u.pn = (wgid % nig) / gsz; u.br = b + 4 * half; return true;
    }
    __device__ __forceinline__ void kr(const Unit& u, size_t& koffB, int& nt) const {
        const int b = u.br & 3, half = u.br >> 2; nt = (b == 2) ? 8 : 6; koffB = (size_t)b * 1536 + (size_t)half * nt * 128;
    }
};
__device__ __forceinline__ unsigned cvt_pk_bf16(float lo, float hi) { unsigned r; asm volatile("s_nop 1\n\tv_cvt_pk_bf16_f32 %0, %1, %2" : "=v"(r) : "v"(lo), "v"(hi)); return r; }

template <class Epi, class SchedT>
__device__ __forceinline__ void gemm_phase(LAS unsigned char* lds, const Gemm g, const SchedT& S, const Epi& E) {
    const int tid = otid(), wid = __builtin_amdgcn_readfirstlane(tid >> 6), lane = tid & 63, wr = wid >> 2, wc = wid & 3, fr = lane & 15, fq = lane >> 4;
    unsigned voffA[2], voffB[2];
#pragma unroll
    for (int i = 0; i < 2; ++i) { int R, C; stage_rc(tid * 16 + i * 8192, R, C);
        voffA[i] = (unsigned)(R * g.lda + C) * 2u; voffB[i] = (unsigned)(R * g.ldb + C) * 2u; }
    const size_t kstep = (size_t)(BK * 2);
    const size_t hstepA = (size_t)HALF * g.lda * 2, hstepB = (size_t)HALF * g.ldb * 2;
    const size_t tstepA = 2 * hstepA, tstepB = 2 * hstepB;
    const unsigned ldsw = (unsigned)wid * 1024u;
    const int aoff = lds_byte(wr * 64 + fr, fq * 8), boff = lds_byte(wc * 32 + fr, fq * 8);
#define PG8_SA(b, h) (((b) * 2 + (h)) * HTB)
#define PG8_SB(b, h) ((4 + (b) * 2 + (h)) * HTB)
#define PG8_STAGE(bufoff, gbase, voff) do { _Pragma("unroll") for (int _i = 0; _i < 2; ++_i) \
        __builtin_amdgcn_global_load_lds((const unsigned*)((const char*)(gbase) + (voff)[_i]), (LAS unsigned*)(lds + (bufoff) + ldsw + _i * 8192), 16, 0, DMA_AUX); } while (0)
#define PG8_LDA(dst, b, h) do { _Pragma("unroll") for (int m = 0; m < 4; ++m) _Pragma("unroll") for (int k = 0; k < 2; ++k) dst[m][k] = *(const LAS bf16x8*)(lds + PG8_SA(b, h) + aoff + m * 2048 + k * 1024); } while (0)
#define PG8_LDB(dst, b, h) do { _Pragma("unroll") for (int n = 0; n < 2; ++n) _Pragma("unroll") for (int k = 0; k < 2; ++k) dst[n][k] = *(const LAS bf16x8*)(lds + PG8_SB(b, h) + boff + n * 2048 + k * 1024); } while (0)
#define PG8_MMA(ai, bj, At, Bt) do { __builtin_amdgcn_s_setprio(1); _Pragma("unroll") for (int m = 0; m < 4; ++m) _Pragma("unroll") for (int n = 0; n < 2; ++n) _Pragma("unroll") for (int k = 0; k < 2; ++k) \
        acc[ai][bj][m][n] = __builtin_amdgcn_mfma_f32_16x16x32_bf16(Bt[n][k], At[m][k], acc[ai][bj][m][n], 0, 0, 0); __builtin_amdgcn_s_setprio(0); } while (0)
#define PG8_WAIT_V(n) asm volatile("s_waitcnt vmcnt(" #n ")" ::: "memory")
#define PG8_WAIT_L(n) asm volatile("s_waitcnt lgkmcnt(" #n ")" ::: "memory")
#define PG8_BAR __builtin_amdgcn_s_barrier()
#define PG8_SCHED __builtin_amdgcn_sched_barrier(0)
    Unit cur, nxt; int ui = 0;
    if (!S.next(0, cur)) return;
    f32x4 acc[2][2][4][2];
#pragma unroll
    for (int a = 0; a < 2; ++a)
#pragma unroll
        for (int b = 0; b < 2; ++b)
#pragma unroll
            for (int m = 0; m < 4; ++m)
#pragma unroll
                for (int n = 0; n < 2; ++n) acc[a][b][m][n] = (f32x4){0.f, 0.f, 0.f, 0.f};
    bf16x8 At[4][2], B0[2][2], B1[2][2];
    size_t koc; int ntc; S.kr(cur, koc, ntc);
    const char* cA = (const char*)((g.A2 && cur.br) ? g.A2 : g.A) + (size_t)cur.pm * tstepA + koc; const char* cB = (const char*)g.Bt + (size_t)cur.pn * tstepB + koc;
    PG8_STAGE(PG8_SB(0, 0), cB, voffB); PG8_STAGE(PG8_SA(0, 0), cA, voffA); PG8_STAGE(PG8_SB(0, 1), cB + hstepB, voffB); PG8_STAGE(PG8_SA(0, 1), cA + hstepA, voffA);
    if (wr == 1) PG8_BAR;
    PG8_WAIT_V(4); PG8_BAR;
    PG8_STAGE(PG8_SB(1, 0), cB + kstep, voffB); PG8_STAGE(PG8_SA(1, 0), cA + kstep, voffA); PG8_STAGE(PG8_SB(1, 1), cB + hstepB + kstep, voffB);
    PG8_WAIT_V(6); PG8_BAR;
    for (;;) {
        const bool has_next = S.next(ui + 1, nxt);
        size_t kon = 0; int ntn = ntc; if (has_next) S.kr(nxt, kon, ntn);
        const char* nA = has_next ? (const char*)((g.A2 && nxt.br) ? g.A2 : g.A) + (size_t)nxt.pm * tstepA + kon : cA; const char* nB = has_next ? (const char*)g.Bt + (size_t)nxt.pn * tstepB + kon : cB;
        for (int t = 0; t < ntc; t += 2) {
            const bool last = (t == ntc - 2);
            const char* a1 = cA + (size_t)(t + 1) * kstep;
            const char* a2 = last ? nA : cA + (size_t)(t + 2) * kstep; const char* b2 = last ? nB : cB + (size_t)(t + 2) * kstep;
            const char* a3 = a2 + kstep; const char* b3 = b2 + kstep;
            PG8_LDB(B0, 0, 0); PG8_SCHED; PG8_LDA(At, 0, 0); PG8_STAGE(PG8_SA(1, 1), a1 + hstepA, voffA);
            PG8_WAIT_L(8); PG8_BAR; PG8_WAIT_L(0); PG8_MMA(0, 0, At, B0); PG8_BAR; PG8_SCHED;
            PG8_LDB(B1, 0, 1); PG8_STAGE(PG8_SB(0, 0), b2, voffB);
            PG8_BAR; PG8_WAIT_L(0); PG8_MMA(0, 1, At, B1); PG8_BAR;
            PG8_LDA(At, 0, 1); PG8_STAGE(PG8_SA(0, 0), a2, voffA);
            PG8_BAR; PG8_WAIT_L(0); PG8_MMA(1, 0, At, B0); PG8_BAR; PG8_SCHED;
            PG8_STAGE(PG8_SB(0, 1), b2 + hstepB, voffB);
            PG8_WAIT_V(6); PG8_BAR; PG8_MMA(1, 1, At, B1); PG8_BAR;
            PG8_LDB(B0, 1, 0); PG8_SCHED; PG8_LDA(At, 1, 0); PG8_STAGE(PG8_SA(0, 1), a2 + hstepA, voffA);
            PG8_WAIT_L(8); PG8_BAR; PG8_WAIT_L(0); PG8_MMA(0, 0, At, B0); PG8_BAR; PG8_SCHED;
            PG8_LDB(B1, 1, 1); PG8_STAGE(PG8_SB(1, 0), b3, voffB);
            PG8_BAR; PG8_WAIT_L(0); PG8_MMA(0, 1, At, B1); PG8_BAR;
            PG8_LDA(At, 1, 1); PG8_STAGE(PG8_SA(1, 0), a3, voffA);
            PG8_BAR; PG8_WAIT_L(0); PG8_MMA(1, 0, At, B0); PG8_BAR; PG8_SCHED;
            PG8_STAGE(PG8_SB(1, 1), b3 + hstepB, voffB);
            PG8_WAIT_V(6); PG8_BAR; PG8_MMA(1, 1, At, B1); PG8_BAR;
        }
        E(acc, cur, wr, wc, fr, fq);
        if (!has_next) break;
#pragma unroll
        for (int a = 0; a < 2; ++a)
#pragma unroll
            for (int b = 0; b < 2; ++b)
#pragma unroll
                for (int m = 0; m < 4; ++m)
#pragma unroll
                    for (int n = 0; n < 2; ++n) acc[a][b][m][n] = (f32x4){0.f, 0.f, 0.f, 0.f};
        cur = nxt; cA = nA; cB = nB; ntc = ntn; ++ui;
    }
    PG8_WAIT_V(0);
    if (wr == 0) PG8_BAR;
    PG8_BAR;
#undef PG8_SA
#undef PG8_SB
#undef PG8_STAGE
#undef PG8_LDA
#undef PG8_LDB
#undef PG8_MMA
#undef PG8_WAIT_V
#undef PG8_WAIT_L
#undef PG8_BAR
#undef PG8_SCHED
}

struct EpiBf {
    bf16_t* O; int ldc; bf16_t* O2;
    __device__ __forceinline__ void operator()(const f32x4 (&acc)[2][2][4][2], const Unit& u, int wr, int wc, int fr, int fq) const {
        const int row0 = u.pm * BM + wr * 64 + fr, col0 = u.pn * BM + wc * 32 + 4 * fq;
        bf16_t* O = u.br ? this->O2 : this->O;
#pragma unroll
        for (int ai = 0; ai < 2; ++ai)
#pragma unroll
            for (int m = 0; m < 4; ++m) { bf16_t* rowp = O + (size_t)(row0 + ai * HALF + m * 16) * ldc + col0;
#pragma unroll
                for (int bj = 0; bj < 2; ++bj)
#pragma unroll
                    for (int n = 0; n < 2; ++n) { const f32x4 v = acc[ai][bj][m][n]; u32x2 o; o.x = cvt_pk_bf16(v[0], v[1]); o.y = cvt_pk_bf16(v[2], v[3]); *(u32x2*)(rowp + bj * HALF + n * 16) = o; } }
    }
};
struct EpiSigBf {
    bf16_t* O; int ldc;
    __device__ __forceinline__ void operator()(const f32x4 (&acc)[2][2][4][2], const Unit& u, int wr, int wc, int fr, int fq) const {
        const int row0 = u.pm * BM + wr * 64 + fr, col0 = u.pn * BM + wc * 32 + 4 * fq;
#pragma unroll
        for (int ai = 0; ai < 2; ++ai)
#pragma unroll
            for (int m = 0; m < 4; ++m) { bf16_t* rowp = O + (size_t)(row0 + ai * HALF + m * 16) * ldc + col0;
#pragma unroll
                for (int bj = 0; bj < 2; ++bj)
#pragma unroll
                    for (int n = 0; n < 2; ++n) { const f32x4 v = acc[ai][bj][m][n]; u32x2 o; o.x = cvt_pk_bf16(sigm(v[0]), sigm(v[1])); o.y = cvt_pk_bf16(sigm(v[2]), sigm(v[3])); *(u32x2*)(rowp + bj * HALF + n * 16) = o; } }
    }
};
struct EpiF32 {
    float* C; int ldc; float* C2;
    __device__ __forceinline__ void operator()(const f32x4 (&acc)[2][2][4][2], const Unit& u, int wr, int wc, int fr, int fq) const {
        const int row0 = u.pm * BM + wr * 64 + fr, col0 = u.pn * BM + wc * 32 + 4 * fq;
        float* C = u.br ? this->C2 : this->C;
#pragma unroll
        for (int ai = 0; ai < 2; ++ai)
#pragma unroll
            for (int m = 0; m < 4; ++m) { float* rowp = C + (size_t)(row0 + ai * HALF + m * 16) * ldc + col0;
#pragma unroll
                for (int bj = 0; bj < 2; ++bj)
#pragma unroll
                    for (int n = 0; n < 2; ++n) *(f32x4*)(rowp + bj * HALF + n * 16) = acc[ai][bj][m][n]; }
    }
};
struct EpiGlu {
    bf16_t* Y; const bf16_t* Z; gfp_t bias;
    __device__ __forceinline__ void operator()(const f32x4 (&acc)[2][2][4][2], const Unit& u, int wr, int wc, int fr, int fq) const {
        const int row0 = u.pm * BM + wr * 64 + fr, col0 = u.pn * BM + wc * 32 + 4 * fq;
#pragma unroll
        for (int ai = 0; ai < 2; ++ai)
#pragma unroll
            for (int m = 0; m < 4; ++m) { const size_t r = (size_t)(row0 + ai * HALF + m * 16);
#pragma unroll
                for (int bj = 0; bj < 2; ++bj)
#pragma unroll
                    for (int n = 0; n < 2; ++n) { const int c = col0 + bj * HALF + n * 16; const f32x4 v = acc[ai][bj][m][n];
                        const u32x2 zz = *(const u32x2*)(Z + r * 768 + c); const f32x4 bb = *(const f32x4*)(bias + c);
                        const float z0 = __uint_as_float(zz.x << 16), z1 = __uint_as_float(zz.x & 0xffff0000u), z2 = __uint_as_float(zz.y << 16), z3 = __uint_as_float(zz.y & 0xffff0000u);
                        u32x2 o; o.x = cvt_pk_bf16(z0 * sigm(v[0] + bb[0]), z1 * sigm(v[1] + bb[1])); o.y = cvt_pk_bf16(z2 * sigm(v[2] + bb[2]), z3 * sigm(v[3] + bb[3]));
                        *(u32x2*)(Y + r * LDY + c) = o; } }
    }
};
struct EpiBranch {
    const bf16_t* Zg; bf16_t* Mo; bf16_t* Mo2;
    __device__ __forceinline__ void operator()(const f32x4 (&acc)[2][2][4][2], const Unit& u, int wr, int wc, int fr, int fq) const {
        const int row0 = u.pm * BM + wr * 64 + fr, col0 = u.pn * BM + wc * 32 + 4 * fq; const int br = u.br & 3; bf16_t* Mo = (u.br >> 2) ? this->Mo2 : this->Mo;
#pragma unroll
        for (int ai = 0; ai < 2; ++ai)
#pragma unroll
            for (int m = 0; m < 4; ++m) { const size_t r = (size_t)(row0 + ai * HALF + m * 16);
#pragma unroll
                for (int bj = 0; bj < 2; ++bj)
#pragma unroll
                    for (int n = 0; n < 2; ++n) { const int c = col0 + bj * HALF + n * 16; const f32x4 v = acc[ai][bj][m][n];
                        const u32x2 gg = *(const u32x2*)(Zg + r * DIN + br * 1024 + c);
                        f32x4 t; t[0] = v[0] * __uint_as_float(gg.x << 16); t[1] = v[1] * __uint_as_float(gg.x & 0xffff0000u);
                        t[2] = v[2] * __uint_as_float(gg.y << 16); t[3] = v[3] * __uint_as_float(gg.y & 0xffff0000u);
                        bf16_t* mp = Mo + r * DM + c;
                        if (br != 0) { const u32x2 p = *(const u32x2*)mp; t[0] += __uint_as_float(p.x << 16); t[1] += __uint_as_float(p.x & 0xffff0000u); t[2] += __uint_as_float(p.y << 16); t[3] += __uint_as_float(p.y & 0xffff0000u); }
                        u32x2 o; o.x = cvt_pk_bf16(t[0], t[1]); o.y = cvt_pk_bf16(t[2], t[3]); *(u32x2*)mp = o; } }
    }
};

#ifndef GEMM_SIMPLE
#define GEMM_SIMPLE 0
#endif
template <class Epi, class SchedT>
__device__ __forceinline__ void gemm_simple(LAS unsigned char* lds, const Gemm g, const SchedT& S, const Epi& E) {
    const int tid = otid(), wid = __builtin_amdgcn_readfirstlane(tid >> 6), lane = tid & 63, wr = wid >> 2, wc = wid & 3, fr = lane & 15, fq = lane >> 4;
    unsigned voffA[2], voffB[2];
#pragma unroll
    for (int i = 0; i < 2; ++i) { int R, C; stage_rc(tid * 16 + i * 8192, R, C);
        voffA[i] = (unsigned)(R * g.lda + C) * 2u; voffB[i] = (unsigned)(R * g.ldb + C) * 2u; }
    const size_t hstepA = (size_t)HALF * g.lda * 2, hstepB = (size_t)HALF * g.ldb * 2;
    const int aoff = lds_byte(wr * 64 + fr, fq * 8), boff = lds_byte(wc * 32 + fr, fq * 8);
    Unit cur;
    for (int ui = 0; S.next(ui, cur); ++ui) {
        size_t koc; int ntc; S.kr(cur, koc, ntc);
        const char* cA = (const char*)((g.A2 && cur.br) ? g.A2 : g.A) + (size_t)cur.pm * 2 * hstepA + koc; const char* cB = (const char*)g.Bt + (size_t)cur.pn * 2 * hstepB + koc;
        f32x4 acc[2][2][4][2];
#pragma unroll
        for (int a = 0; a < 2; ++a)
#pragma unroll
            for (int b = 0; b < 2; ++b)
#pragma unroll
                for (int m = 0; m < 4; ++m)
#pragma unroll
                    for (int n = 0; n < 2; ++n) acc[a][b][m][n] = (f32x4){0.f, 0.f, 0.f, 0.f};
        for (int t = 0; t < ntc; ++t) {
            u32x4 ra[2][2], rb[2][2];
#pragma unroll
            for (int h = 0; h < 2; ++h)
#pragma unroll
                for (int i = 0; i < 2; ++i) { ra[h][i] = *(const u32x4*)(cA + (size_t)t * 128 + h * hstepA + voffA[i]); rb[h][i] = *(const u32x4*)(cB + (size_t)t * 128 + h * hstepB + voffB[i]); }
            __syncthreads();
#pragma unroll
            for (int h = 0; h < 2; ++h)
#pragma unroll
                for (int i = 0; i < 2; ++i) { *(LAS u32x4*)(lds + h * HTB + tid * 16 + i * 8192) = ra[h][i]; *(LAS u32x4*)(lds + (4 + h) * HTB + tid * 16 + i * 8192) = rb[h][i]; }
            __syncthreads();
#pragma unroll
            for (int ai = 0; ai < 2; ++ai) {
                bf16x8 At[4][2];
#pragma unroll
                for (int m = 0; m < 4; ++m)
#pragma unroll
                    for (int k = 0; k < 2; ++k) At[m][k] = *(const LAS bf16x8*)(lds + ai * HTB + aoff + m * 2048 + k * 1024);
#pragma unroll
                for (int bj = 0; bj < 2; ++bj) {
                    bf16x8 Bf[2][2];
#pragma unroll
                    for (int n = 0; n < 2; ++n)
#pragma unroll
                        for (int k = 0; k < 2; ++k) Bf[n][k] = *(const LAS bf16x8*)(lds + (4 + bj) * HTB + boff + n * 2048 + k * 1024);
#pragma unroll
                    for (int m = 0; m < 4; ++m)
#pragma unroll
                        for (int n = 0; n < 2; ++n)
#pragma unroll
                            for (int k = 0; k < 2; ++k) acc[ai][bj][m][n] = __builtin_amdgcn_mfma_f32_16x16x32_bf16(Bf[n][k], At[m][k], acc[ai][bj][m][n], 0, 0, 0);
                }
            }
        }
        E(acc, cur, wr, wc, fr, fq);
    }
    __syncthreads();
}
template <class Epi, class SchedT>
__device__ __forceinline__ void gemm_run(LAS unsigned char* lds, const Gemm g, const SchedT& S, const Epi& E) {
#if GEMM_SIMPLE
    gemm_simple(lds, g, S, E);
#else
    gemm_phase(lds, g, S, E);
#endif
}
}

__device__ __forceinline__ void transpose_tile(gfp_t W, int N, bf16_t* __restrict__ dst, int ldd, int koff, int tk, int tn, float* tile) {
    const int tid = otid(), a = tid >> 6, bq = tid & 63;
    __syncthreads();
#pragma unroll
    for (int i = 0; i < 8; ++i) { const int k = a + 8 * i; tile[k * 65 + bq] = W[(size_t)(tk * 64 + k) * N + tn * 64 + bq]; }
    __syncthreads();
#pragma unroll
    for (int i = 0; i < 8; ++i) { const int n = a + 8 * i; dst[(size_t)(tn * 64 + n) * ldd + koff + tk * 64 + bq] = f2bf(tile[bq * 65 + n]); }
}

__device__ __forceinline__ f32x4 ldx4(const bf16_t* p) { const u32x2 v = *(const u32x2*)p; f32x4 r; r[0] = __uint_as_float(v.x << 16); r[1] = __uint_as_float(v.x & 0xffff0000u); r[2] = __uint_as_float(v.y << 16); r[3] = __uint_as_float(v.y & 0xffff0000u); return r; }
__device__ __forceinline__ void stx4(bf16_t* p, const f32x4 v) { u32x2 o; o.x = pk2(v[0], v[1]); o.y = pk2(v[2], v[3]); *(u32x2*)p = o; }
__device__ __forceinline__ float row16_sum(float v) {
    v += __builtin_bit_cast(float, __builtin_amdgcn_update_dpp(0, __builtin_bit_cast(int, v), 0xB1, 0xF, 0xF, true));
    v += __builtin_bit_cast(float, __builtin_amdgcn_update_dpp(0, __builtin_bit_cast(int, v), 0x4E, 0xF, 0xF, true));
    v += __builtin_bit_cast(float, __builtin_amdgcn_update_dpp(0, __builtin_bit_cast(int, v), 0x141, 0xF, 0xF, true));
    v += __builtin_bit_cast(float, __builtin_amdgcn_update_dpp(0, __builtin_bit_cast(int, v), 0x140, 0xF, 0xF, true));
    return v;
}
__device__ __forceinline__ float wave_sum(float v) {
    v = row16_sum(v);
    const int iv = __builtin_bit_cast(int, v);
    const float a = __builtin_bit_cast(float, __builtin_amdgcn_readlane(iv, 0)), b = __builtin_bit_cast(float, __builtin_amdgcn_readlane(iv, 16));
    const float c = __builtin_bit_cast(float, __builtin_amdgcn_readlane(iv, 32)), d = __builtin_bit_cast(float, __builtin_amdgcn_readlane(iv, 48));
    return (a + b) + (c + d);
}
__device__ __forceinline__ void rms_store_r(const f32x4 (&xv)[4], const f32x4 (&gr)[4], bf16_t* dst, int lane) {
    float ss = 0.f;
#pragma unroll
    for (int i = 0; i < 4; ++i) ss += xv[i][0] * xv[i][0] + xv[i][1] * xv[i][1] + xv[i][2] * xv[i][2] + xv[i][3] * xv[i][3];
    ss = wave_sum(ss);
    const float rs = rsqrtf(ss * (1.0f / DM) + EPS);
#pragma unroll
    for (int i = 0; i < 4; ++i) { const int c = lane * 4 + 256 * i; const f32x4 hv = xv[i] * gr[i] * rs;
        u32x2 o; o.x = pk2(hv[0], hv[1]); o.y = pk2(hv[2], hv[3]); *(u32x2*)(dst + c) = o; }
}
__device__ __forceinline__ void rms_store(const f32x4 (&xv)[4], gfp_t g, bf16_t* dst, int lane) {
    float ss = 0.f;
#pragma unroll
    for (int i = 0; i < 4; ++i) ss += xv[i][0] * xv[i][0] + xv[i][1] * xv[i][1] + xv[i][2] * xv[i][2] + xv[i][3] * xv[i][3];
    ss = wave_sum(ss);
    const float rs = rsqrtf(ss * (1.0f / DM) + EPS);
#pragma unroll
    for (int i = 0; i < 4; ++i) { const int c = lane * 4 + 256 * i; const f32x4 gn = *(const f32x4*)(g + c); const f32x4 hv = xv[i] * gn * rs;
        u32x2 o; o.x = pk2(hv[0], hv[1]); o.y = pk2(hv[2], hv[3]); *(u32x2*)(dst + c) = o; }
}
__device__ __forceinline__ void norm_rows(const Params& P, int mode, int l, int grp, const unsigned char* smem) {
    const int tid_ = otid(); const int wid = tid_ >> 6, lane = tid_ & 63;
    bf16_t* __restrict__ X = (bf16_t*)(P.ws + A_X);
    const int gw = blockIdx.x * 8 + wid, nw = gridDim.x * 8;
    if (mode == 0) {
        gfp_t g0p = INP(I_GPREMIX); bf16_t* H = (bf16_t*)(P.ws + R_H);
        for (int row = gw; row < TPAD; row += nw) {
            f32x4 xv[4];
            if (row >= TT) {
#pragma unroll
                for (int i = 0; i < 4; ++i) xv[i] = (f32x4){0.f, 0.f, 0.f, 0.f};
            } else {
                const bool isP = row < TPR; int b = 0, t = 0; if (isP) { b = row / LP; t = row - b * LP; }
                gfp_t src = isP ? (t < 16 ? INP(I_META) + (size_t)t * DM : INP(I_XP) + ((size_t)b * SEQ + (t - 16)) * DM) : INP(I_XS) + (size_t)(row - TPR) * DM;
#pragma unroll
                for (int i = 0; i < 4; ++i) xv[i] = *(const f32x4*)(src + lane * 4 + 256 * i);
            }
#pragma unroll
            for (int i = 0; i < 4; ++i) stx4(X + (size_t)row * DM + lane * 4 + 256 * i, xv[i]);
            if (row < 6192) rms_store(xv, g0p, H + (size_t)row * DM, lane);
        }
        return;
    }
    const Grp G = get_grp(grp);
    const bf16_t* __restrict__ F = (const bf16_t*)(P.ws + R_F) - (size_t)G.g0 * DM;
    const bf16_t* __restrict__ F2 = (const bf16_t*)(P.ws + R_UP) - (size_t)G.g0 * DM;
    bf16_t* __restrict__ H = (bf16_t*)(P.ws + R_H) - (size_t)G.g0 * DM;
    const bool fin = (mode == 2 && l == 1);
    gfp_t gpost = (mode == 1 ? INP(I_GPOSTMIX) : INP(I_GPOSTFFN)) + l * DM;
    gfp_t gffn = INP(I_GPREFFN) + l * DM;
    f32x4 gpr[4], gfr[4];
#pragma unroll
    for (int i = 0; i < 4; ++i) { gpr[i] = *(const f32x4*)(gpost + lane * 4 + 256 * i); gfr[i] = *(const f32x4*)(gffn + lane * 4 + 256 * i); }
#pragma unroll 2
    for (int row = G.g0 + gw; row < G.g0 + G.nrows; row += nw) {
        f32x4 xv[4], fv[4]; float ss = 0.f;
#pragma unroll
        for (int i = 0; i < 4; ++i) { const int c = lane * 4 + 256 * i; xv[i] = ldx4(X + (size_t)row * DM + c);
            { const u32x2 fa = *(const u32x2*)(F + (size_t)row * DM + c), fb = *(const u32x2*)(F2 + (size_t)row * DM + c);
              fv[i][0] = __uint_as_float(fa.x << 16) + __uint_as_float(fb.x << 16); fv[i][1] = __uint_as_float(fa.x & 0xffff0000u) + __uint_as_float(fb.x & 0xffff0000u);
              fv[i][2] = __uint_as_float(fa.y << 16) + __uint_as_float(fb.y << 16); fv[i][3] = __uint_as_float(fa.y & 0xffff0000u) + __uint_as_float(fb.y & 0xffff0000u); }
            ss += fv[i][0] * fv[i][0] + fv[i][1] * fv[i][1] + fv[i][2] * fv[i][2] + fv[i][3] * fv[i][3]; }
        ss = wave_sum(ss);
        const float rs = rsqrtf(ss * (1.0f / DM) + EPS);
#pragma unroll
        for (int i = 0; i < 4; ++i) xv[i] = xv[i] + fv[i] * gpr[i] * rs;
        if (fin) {
            float* dst = nullptr;
            if (row < TPR) { const int b = row / LP, t = row - b * LP; if (t >= 16 && ((OUTMASK >> 0) & 1)) dst = P.out + O_YP + ((size_t)b * SEQ + (t - 16)) * DM; }
            else if ((OUTMASK >> 1) & 1) dst = P.out + O_YS + (size_t)(row - TPR) * DM;
            if (dst) {
#pragma unroll
                for (int i = 0; i < 4; ++i) *(f32x4*)(dst + lane * 4 + 256 * i) = xv[i];
            }
        } else {
#pragma unroll
            for (int i = 0; i < 4; ++i) stx4(X + (size_t)row * DM + lane * 4 + 256 * i, xv[i]);
        }
        if (mode == 1) rms_store_r(xv, gfr, H + (size_t)row * DM, lane);
    }
}

__device__ __forceinline__ void next_h_rows(const Params& P, int l, int grp, int gw, int nw, const unsigned char* smem) {
    int nl = l, ng = grp + 1; if (ng == NGRP) { ng = 0; nl = l + 1; }
    if (nl >= 2) return;
    const int tid_ = otid(); const int lane = tid_ & 63;
    const bf16_t* __restrict__ X = (const bf16_t*)(P.ws + A_X);
    const Grp N = get_grp(ng); gfp_t gn = INP(I_GPREMIX) + nl * DM; bf16_t* __restrict__ Hn = (bf16_t*)(P.ws + R_H) - (size_t)N.g0 * DM;
    f32x4 gnr[4];
#pragma unroll
    for (int i = 0; i < 4; ++i) gnr[i] = *(const f32x4*)(gn + lane * 4 + 256 * i);
#pragma unroll 2
    for (int row = N.g0 + gw; row < N.g0 + N.nrows; row += nw) {
        f32x4 xv[4];
#pragma unroll
        for (int i = 0; i < 4; ++i) xv[i] = ldx4(X + (size_t)row * DM + lane * 4 + 256 * i);
        rms_store_r(xv, gnr, Hn + (size_t)row * DM, lane);
    }
}

__device__ __forceinline__ void phase0(const Params& P, unsigned char* smem) {
    float* tile = (float*)smem;
    constexpr int C0 = 2112, C1 = C0 + 144, C2 = C1 + 192, C3 = C2 + 192, C4 = C3 + 256, C5 = C4 + 256, C6 = C5 + 1408, C7 = C6 + 704;
    for (int id = blockIdx.x; id < 2 * C7; id += gridDim.x) {
        const int l = id / C7; int j = id - l * C7;
        gfp_t W; int N, ldd, koff = 0; bf16_t* dst;
        if (j < C0) { W = INP(I_WIN) + (size_t)l * DM * DIN; N = DIN; dst = (bf16_t*)(P.ws + W_IN) + (size_t)l * DIN * DM; ldd = DM; }
        else if (j < C1) { j -= C0; W = INP(I_WGLU) + (size_t)l * 768 * 768; N = 768; dst = (bf16_t*)(P.ws + W_GLU) + (size_t)l * 768 * 768; ldd = 768; }
        else if (j < C2) { j -= C1; W = INP(I_WBA) + (size_t)l * 768 * DM; N = DM; dst = (bf16_t*)(P.ws + W_BR) + (size_t)l * DM * LDY; ldd = LDY; }
        else if (j < C3) { j -= C2; W = INP(I_WBB) + (size_t)l * 768 * DM; N = DM; dst = (bf16_t*)(P.ws + W_BR) + (size_t)l * DM * LDY; ldd = LDY; koff = 768; }
        else if (j < C4) { j -= C3; W = INP(I_WBC) + (size_t)l * DM * DM; N = DM; dst = (bf16_t*)(P.ws + W_BR) + (size_t)l * DM * LDY; ldd = LDY; koff = 1536; }
        else if (j < C5) { j -= C4; W = INP(I_WOUT) + (size_t)l * DM * DM; N = DM; dst = (bf16_t*)(P.ws + W_OUT) + (size_t)l * DM * DM; ldd = DM; }
        else if (j < C6) { j -= C5; W = INP(I_WUP) + (size_t)l * DM * 2 * DFF; N = 2 * DFF; dst = (bf16_t*)(P.ws + W_UP) + (size_t)l * 2 * DFF * DM; ldd = DM; }
        else { j -= C6; W = INP(I_WDOWN) + (size_t)l * DFF * DM; N = DM; dst = (bf16_t*)(P.ws + W_DOWN) + (size_t)l * DM * DFF; ldd = DFF; }
        const int ntn = N / 64; const int tk = j / ntn, tn = j - tk * ntn;
        transpose_tile(W, N, dst, ldd, koff, tk, tn, tile);
    }
    norm_rows(P, 0, 0, 0, smem);
    float* rt = (float*)(P.ws + A_ROPE);
    for (int i = blockIdx.x * 512 + threadIdx.x; i < 2068 * 32; i += gridDim.x * 512) {
        const int pi = i >> 5, fi = i & 31; const double pos = pi < LP ? (double)pi : (double)(16384 + pi - LP);
        const double inv = exp(-(double)fi * (9.210340371976184 / 32.0));
        double ang = pos * inv; const double k = rint(ang * 0.15915494309189535); ang = ang - k * 6.283185307179586;
        const float af = (float)ang; rt[2 * i] = cosf(af); rt[2 * i + 1] = sinf(af);
    }
    if (blockIdx.x == 0 && threadIdx.x < 64) ((unsigned*)(P.ws + A_CTR))[threadIdx.x] = 0u;
}

__device__ __forceinline__ void ld8(const bf16_t* p, float (&d)[8]) {
    const u32x4 v = *(const u32x4*)p;
#pragma unroll
    for (int i = 0; i < 4; ++i) { d[2 * i] = __uint_as_float(v[i] << 16); d[2 * i + 1] = __uint_as_float(v[i] & 0xffff0000u); }
}
__device__ __forceinline__ void ffn_conv_phase(const Params& P, int l, int grp, const unsigned char* smem) {
    const Grp G = get_grp(grp);
    const bf16_t* __restrict__ UP = (const bf16_t*)(P.ws + R_UP) - (size_t)G.g0 * (2 * DFF); bf16_t* __restrict__ FIN = (bf16_t*)(P.ws + R_FIN) - (size_t)G.g0 * DFF;
    gfp_t cw = INP(I_FCW) + (size_t)l * 3 * DFF; gfp_t cb = INP(I_FCB) + (size_t)l * DFF;
    gfp_t cache = INP(I_FFNC) + (size_t)l * DEC_B * 2 * DFF;
    constexpr int NCG = DFF / 8;
    const int RL = grp < 2 ? 6 : 8;
    const int nrun = G.nrows / RL;
    for (int it = blockIdx.x * 512 + threadIdx.x; it < nrun * NCG; it += gridDim.x * 512) {
        const int ck = it / NCG, c = (it - ck * NCG) * 8, row0 = G.g0 + ck * RL;
        float w0[8], w1[8], w2[8], bs[8];
#pragma unroll
        for (int i = 0; i < 8; ++i) { bs[i] = cb[c + i]; w0[i] = cw[c + i]; w1[i] = cw[DFF + c + i]; w2[i] = cw[2 * DFF + c + i]; }
        float g1[8], g2[8];
#pragma unroll
        for (int r = 0; r < 8; ++r) {
            if (r >= RL) break;
            const int row = row0 + r;
            int b, t, L; const bool isP = row < TPR;
            if (isP) { b = row / LP; t = row - b * LP; L = LP; } else { b = (row - TPR) >> 2; t = (row - TPR) & 3; L = 4; }
            float g0[8], uf[8];
            ld8(UP + (size_t)row * (2 * DFF) + c, g0); ld8(UP + (size_t)row * (2 * DFF) + DFF + c, uf);
            if (r == 0) {
                if (t >= 1) ld8(UP + (size_t)(row - 1) * (2 * DFF) + c, g1);
                else {
#pragma unroll
                    for (int i = 0; i < 8; ++i) g1[i] = isP ? 0.f : cache[((size_t)b * 2 + 1) * DFF + c + i]; }
                if (t >= 2) ld8(UP + (size_t)(row - 2) * (2 * DFF) + c, g2);
                else {
#pragma unroll
                    for (int i = 0; i < 8; ++i) g2[i] = isP ? 0.f : cache[((size_t)b * 2 + t) * DFF + c + i]; }
            } else if (t == 0) {
#pragma unroll
                for (int i = 0; i < 8; ++i) { g1[i] = isP ? 0.f : cache[((size_t)b * 2 + 1) * DFF + c + i]; g2[i] = isP ? 0.f : cache[((size_t)b * 2) * DFF + c + i]; }
            } else if (t == 1) {
#pragma unroll
                for (int i = 0; i < 8; ++i) g2[i] = isP ? 0.f : cache[((size_t)b * 2 + 1) * DFF + c + i];
            }
            float o[8];
#pragma unroll
            for (int i = 0; i < 8; ++i) { const float gc = bs[i] + w0[i] * g2[i] + w1[i] * g1[i] + w2[i] * g0[i]; o[i] = gelu_t(gc) * uf[i]; }
            u32x4 ov; ov[0] = pk2(o[0], o[1]); ov[1] = pk2(o[2], o[3]); ov[2] = pk2(o[4], o[5]); ov[3] = pk2(o[6], o[7]);
            *(u32x4*)(FIN + (size_t)row * DFF + c) = ov;
            if (t >= L - 2) {
                float* dst = isP ? P.out + O_P_FFNC + (((size_t)l * NB + b) * 2 + (t - (L - 2))) * DFF + c : P.out + O_S_FFNC + (((size_t)l * DEC_B + b) * 2 + (t - (L - 2))) * DFF + c;
#pragma unroll
                for (int i = 0; i < 8; ++i) dst[i] = g0[i];
            }
#pragma unroll
            for (int i = 0; i < 8; ++i) { g2[i] = g1[i]; g1[i] = g0[i]; }
        }
    }
}

__device__ __forceinline__ void ret_job(const Params& P, int l, int grp, int b, int h, int g0, unsigned char* smem) {
    const int tid = otid(), w = __builtin_amdgcn_readfirstlane(tid >> 6), lane = tid & 63, fr = lane & 15, fq = lane >> 4;
    bf16_t* sQ = (bf16_t*)smem;
    bf16_t* sK = sQ + 128 * 72;
    bf16_t* sKdT = sK + 128 * 72;
    bf16_t* sVT = sKdT + 64 * 136;
    bf16_t* sST = sVT + 128 * 136;
    bf16_t* sP = sST + 128 * 72 + w * 16 * 136;
    const bf16_t* Z = (const bf16_t*)(P.ws + R_Z) - (size_t)g0 * DIN; bf16_t* Y = (bf16_t*)(P.ws + R_Y) - (size_t)g0 * LDY;
    const float* rope = (const float*)(P.ws + A_ROPE);
    const int L = grp ? 4 : LP, rowb = grp ? TPR + b * 4 : b * LP, tabb = grp ? LP : 0;
    const float lg = log1pf(-exp2f(-5.0f - (float)h));
    gfp_t ng = INP(I_RNG) + (size_t)l * 1024 + h * 128;
    float ngv[8];
#pragma unroll
    for (int et = 0; et < 8; ++et) ngv[et] = ng[16 * et + fr];
    f32x4 accS[4];
    float* Sout = P.out + (grp ? O_S_RET + (((size_t)l * DEC_B + b) * 8 + h) * 8192 : O_P_RET + (((size_t)l * NB + b) * 8 + h) * 8192);
    if (grp) { gfp_t S0 = INP(I_RET) + (((size_t)l * DEC_B + b) * 8 + h) * 8192;
#pragma unroll
        for (int dt = 0; dt < 4; ++dt)
#pragma unroll
            for (int j = 0; j < 4; ++j) accS[dt][j] = S0[(16 * dt + 4 * fq + j) * 128 + 16 * w + fr];
    } else {
#pragma unroll
        for (int dt = 0; dt < 4; ++dt) accS[dt] = (f32x4){0.f, 0.f, 0.f, 0.f};
    }
    __syncthreads();
#pragma unroll
    for (int dt = 0; dt < 4; ++dt) { u32x2 o; o.x = pk2(accS[dt][0], accS[dt][1]); o.y = pk2(accS[dt][2], accS[dt][3]); *(u32x2*)(sST + (16 * w + fr) * 72 + 16 * dt + 4 * fq) = o; }
    const int nch = grp ? 1 : 17;
    u32x4 q1 = {0u, 0u, 0u, 0u}, q2 = q1, k1 = q1, k2 = q1, vv[4];
#define RET_LOAD(ckx) do { const int _t0 = grp ? 0 : ((ckx) == 0 ? 0 : 16 + ((ckx) - 1) * 128), _C = grp ? 4 : ((ckx) == 0 ? 16 : 128); \
        const int _m = tid >> 2, _i0 = (tid & 3) * 8, _m2 = tid & 127, _e0 = (tid >> 7) * 32; \
        q1 = (u32x4){0u, 0u, 0u, 0u}; q2 = q1; k1 = q1; k2 = q1; \
        if (_m < _C) { const size_t _zr = (size_t)(rowb + _t0 + _m) * DIN; \
            q1 = *(const u32x4*)(Z + _zr + ZO_Q + h * 64 + _i0); q2 = *(const u32x4*)(Z + _zr + ZO_Q + h * 64 + 32 + _i0); \
            k1 = *(const u32x4*)(Z + _zr + ZO_K + h * 64 + _i0); k2 = *(const u32x4*)(Z + _zr + ZO_K + h * 64 + 32 + _i0); } \
        _Pragma("unroll") for (int _i = 0; _i < 4; ++_i) vv[_i] = (u32x4){0u, 0u, 0u, 0u}; \
        if (_m2 < _C) { const bf16_t* _vp = Z + (size_t)(rowb + _t0 + _m2) * DIN + ZO_V + h * 128 + _e0; \
            _Pragma("unroll") for (int _i = 0; _i < 4; ++_i) vv[_i] = *(const u32x4*)(_vp + 8 * _i); } } while (0)
    RET_LOAD(0);
    for (int ck = 0; ck < nch; ++ck) {
        const int t0 = grp ? 0 : (ck == 0 ? 0 : 16 + (ck - 1) * 128), C = grp ? 4 : (ck == 0 ? 16 : 128);
        {
            const int m = tid >> 2, i0 = (tid & 3) * 8;
            u32x4 q1w = {0u, 0u, 0u, 0u}, q2w = q1w, k1w = q1w, k2w = q1w;
            float kd1[8], kd2[8];
#pragma unroll
            for (int e = 0; e < 8; ++e) { kd1[e] = 0.f; kd2[e] = 0.f; }
            if (m < C) {
                const float* rp = rope + ((size_t)(tabb + t0 + m) * 32 + i0) * 2;
                const float kdec = __expf(lg * (float)(C - 1 - m));
                float qo1[8], qo2[8], ko1[8], ko2[8];
#pragma unroll
                for (int e = 0; e < 8; ++e) {
                    const float cs = rp[2 * e], sn = rp[2 * e + 1];
                    const unsigned qa = q1[e >> 1], qb = q2[e >> 1], ka = k1[e >> 1], kb = k2[e >> 1];
                    const float x1 = (e & 1) ? __uint_as_float(qa & 0xffff0000u) : __uint_as_float(qa << 16);
                    const float x2 = (e & 1) ? __uint_as_float(qb & 0xffff0000u) : __uint_as_float(qb << 16);
                    const float y1 = ((e & 1) ? __uint_as_float(ka & 0xffff0000u) : __uint_as_float(ka << 16)) * 0.125f;
                    const float y2 = ((e & 1) ? __uint_as_float(kb & 0xffff0000u) : __uint_as_float(kb << 16)) * 0.125f;
                    qo1[e] = x1 * cs - x2 * sn; qo2[e] = x2 * cs + x1 * sn;
                    ko1[e] = y1 * cs - y2 * sn; ko2[e] = y2 * cs + y1 * sn;
                    kd1[e] = ko1[e] * kdec; kd2[e] = ko2[e] * kdec;
                }
#pragma unroll
                for (int e = 0; e < 4; ++e) { q1w[e] = pk2(qo1[2 * e], qo1[2 * e + 1]); q2w[e] = pk2(qo2[2 * e], qo2[2 * e + 1]); k1w[e] = pk2(ko1[2 * e], ko1[2 * e + 1]); k2w[e] = pk2(ko2[2 * e], ko2[2 * e + 1]); }
            }
            *(u32x4*)(sQ + m * 72 + i0) = q1w; *(u32x4*)(sQ + m * 72 + 32 + i0) = q2w;
            *(u32x4*)(sK + m * 72 + i0) = k1w; *(u32x4*)(sK + m * 72 + 32 + i0) = k2w;
#pragma unroll
            for (int e = 0; e < 8; ++e) { sKdT[(i0 + e) * 136 + m] = f2bf(kd1[e]); sKdT[(32 + i0 + e) * 136 + m] = f2bf(kd2[e]); }
            const int m2 = tid & 127, e0 = (tid >> 7) * 32;
#pragma unroll
            for (int i = 0; i < 4; ++i)
#pragma unroll
                for (int e = 0; e < 4; ++e) { sVT[(e0 + 8 * i + 2 * e) * 136 + m2] = (bf16_t)(vv[i][e] & 0xffffu); sVT[(e0 + 8 * i + 2 * e + 1) * 136 + m2] = (bf16_t)(vv[i][e] >> 16); }
        }
        __syncthreads();
        if (ck + 1 < nch) RET_LOAD(ck + 1);
        f32x4 o[8];
        const bool act = (16 * w < C);
        unsigned gcp[4][4];
        if (act) {
#pragma unroll
            for (int j = 0; j < 4; ++j) { const int n = 16 * w + 4 * fq + j; const size_t row = (size_t)(rowb + t0 + (n < C ? n : 0));
#pragma unroll
                for (int e2 = 0; e2 < 4; ++e2) { const bf16_t lo = Z[row * DIN + ZO_GC + h * 128 + 32 * e2 + fr], hi = Z[row * DIN + ZO_GC + h * 128 + 32 * e2 + 16 + fr]; gcp[e2][j] = (unsigned)lo | ((unsigned)hi << 16); } }
        }
        if (act) {
            bf16x8 qf[2];
#pragma unroll
            for (int ks = 0; ks < 2; ++ks) qf[ks] = *(const bf16x8*)(sQ + (16 * w + fr) * 72 + 32 * ks + 8 * fq);
            const int mtN = (w | 1) + 1;
            for (int mt = 0; mt < mtN; ++mt) {
                f32x4 a = {0.f, 0.f, 0.f, 0.f};
#pragma unroll
                for (int ks = 0; ks < 2; ++ks) { const bf16x8 kf = *(const bf16x8*)(sK + (16 * mt + fr) * 72 + 32 * ks + 8 * fq); a = mfma16(qf[ks], kf, a); }
#pragma unroll
                for (int j = 0; j < 4; ++j) { const int d = (16 * w + 4 * fq + j) - (16 * mt + fr); const float v = d >= 0 ? a[j] * __expf(lg * (float)d) : 0.f; sP[(4 * fq + j) * 136 + 16 * mt + fr] = f2bf(v); }
            }
            lds_wait();
#pragma unroll
            for (int et = 0; et < 8; ++et) o[et] = (f32x4){0.f, 0.f, 0.f, 0.f};
            const int ksN = mtN >> 1;
            for (int ks = 0; ks < ksN; ++ks) {
                const bf16x8 pf = *(const bf16x8*)(sP + fr * 136 + 32 * ks + 8 * fq);
#pragma unroll
                for (int et = 0; et < 8; ++et) { const bf16x8 vf = *(const bf16x8*)(sVT + (16 * et + fr) * 136 + 32 * ks + 8 * fq); o[et] = mfma16(pf, vf, o[et]); }
            }
            f32x4 o2[8];
#pragma unroll
            for (int et = 0; et < 8; ++et) o2[et] = (f32x4){0.f, 0.f, 0.f, 0.f};
#pragma unroll
            for (int ks = 0; ks < 2; ++ks)
#pragma unroll
                for (int et = 0; et < 8; ++et) { const bf16x8 sf = *(const bf16x8*)(sST + (16 * et + fr) * 72 + 32 * ks + 8 * fq); o2[et] = mfma16(qf[ks], sf, o2[et]); }
#pragma unroll
            for (int j = 0; j < 4; ++j) { const float sc = __expf(lg * (float)(16 * w + 4 * fq + j + 1));
#pragma unroll
                for (int et = 0; et < 8; ++et) o[et][j] += o2[et][j] * sc; }
        }
        {
            const float gC = __expf(lg * (float)C);
#pragma unroll
            for (int dt = 0; dt < 4; ++dt) accS[dt] = accS[dt] * gC;
            const int ksN = (C + 31) >> 5;
            for (int ks = 0; ks < ksN; ++ks) {
                const bf16x8 vf = *(const bf16x8*)(sVT + (16 * w + fr) * 136 + 32 * ks + 8 * fq);
#pragma unroll
                for (int dt = 0; dt < 4; ++dt) { const bf16x8 kf = *(const bf16x8*)(sKdT + (16 * dt + fr) * 136 + 32 * ks + 8 * fq); accS[dt] = mfma16(kf, vf, accS[dt]); }
            }
        }
        __syncthreads();
#pragma unroll
        for (int dt = 0; dt < 4; ++dt) { u32x2 ow; ow.x = pk2(accS[dt][0], accS[dt][1]); ow.y = pk2(accS[dt][2], accS[dt][3]); *(u32x2*)(sST + (16 * w + fr) * 72 + 16 * dt + 4 * fq) = ow; }
        if (act) {
#pragma unroll
            for (int j = 0; j < 4; ++j) {
                float s = 0.f;
#pragma unroll
                for (int et = 0; et < 8; ++et) s += o[et][j];
                s = row16_sum(s);
                const float mu = s * (1.0f / 128.0f);
                float s2 = 0.f;
#pragma unroll
                for (int et = 0; et < 8; ++et) { const float d = o[et][j] - mu; s2 += d * d; }
                s2 = row16_sum(s2);
                const float rstd = rsqrtf(s2 * (1.0f / 128.0f) + EPS);
                const int n = 16 * w + 4 * fq + j;
                if (n < C) {
                    const size_t row = (size_t)(rowb + t0 + n);
#pragma unroll
                    for (int et = 0; et < 8; ++et) { const int e = 16 * et + fr; const unsigned gw_ = gcp[et >> 1][j]; const float gcv = (et & 1) ? __uint_as_float(gw_ & 0xffff0000u) : __uint_as_float(gw_ << 16);
                        const float yv = gcv * sigm(gcv) * (o[et][j] - mu) * rstd * ngv[et]; Y[row * LDY + 1536 + h * 128 + e] = f2bf(yv); }
                }
            }
        }
    }
    if (grp ? OUT_ON(12) : OUT_ON(6)) {
#pragma unroll
    for (int dt = 0; dt < 4; ++dt)
#pragma unroll
        for (int j = 0; j < 4; ++j) Sout[(16 * dt + 4 * fq + j) * 128 + 16 * w + fr] = accS[dt][j];
    }
}

__device__ __forceinline__ void lru_job(const Params& P, int l, int grp, int jid, int g0, int pb0, unsigned char* smem) {
    const int tid = otid(), w = __builtin_amdgcn_readfirstlane(tid >> 6), lane = tid & 63, fr = lane & 15, fq = lane >> 4;
    bf16_t* sA = (bf16_t*)(smem + w * 10752);
    float* sRI = (float*)(smem + w * 10752 + 2304);
    float* sComb = (float*)(smem + 8 * 10752);
    const bf16_t* Z = (const bf16_t*)(P.ws + R_Z) - (size_t)g0 * DIN; bf16_t* Y = (bf16_t*)(P.ws + R_Y) - (size_t)g0 * LDY;
    const int unit = grp ? jid * 8 + w : jid;
    const int bl = unit / 12, hb = unit - bl * 12, ch = hb * 64 + lane; const int b = grp ? bl : pb0 + bl;
    const int L = grp ? 4 : LP, rowb = grp ? TPR + b * 4 : b * LP;
    float cw[4];
#pragma unroll
    for (int j = 0; j < 4; ++j) cw[j] = INP(I_LCW)[((size_t)l * 4 + j) * 768 + ch];
    const float cb = INP(I_LCB)[l * 768 + ch], ba = INP(I_LBA)[l * 768 + ch], bx = INP(I_LBX)[l * 768 + ch];
    const float lam = INP(I_LAM)[l * 768 + ch];
    const float sp8 = 8.0f * (fmaxf(-lam, 0.f) + log1pf(__expf(-fabsf(lam))));
    bf16x8 Wa[4][2], Wx[4][2];
    { gfp_t wa = INP(I_LWA) + ((size_t)l * 12 + hb) * 4096; gfp_t wx = INP(I_LWX) + ((size_t)l * 12 + hb) * 4096;
#pragma unroll
      for (int nt = 0; nt < 4; ++nt)
#pragma unroll
          for (int ks = 0; ks < 2; ++ks)
#pragma unroll
              for (int j = 0; j < 8; ++j) { const int k = 32 * ks + 8 * fq + j, n = 16 * nt + fr; Wa[nt][ks][j] = (short)f2bf(wa[k * 64 + n]); Wx[nt][ks][j] = (short)f2bf(wx[k * 64 + n]); } }
    float carry = grp ? INP(I_LRUH)[((size_t)l * DEC_B + b) * 768 + ch] : 0.f;
    gfp_t cache = INP(I_LRUC) + ((size_t)l * DEC_B + b) * 3 * 768;
    const int nIter = grp ? 1 : 17;
    __syncthreads();
#ifndef LRU_REP
#define LRU_REP 1
#endif
    bf16_t xn[19];
    { const int tw0 = grp ? 0 : 16 * w;
#pragma unroll
      for (int i = 0; i < 19; ++i) { int t = tw0 - 3 + i; t = t < 0 ? 0 : (t > L - 1 ? L - 1 : t); xn[i] = Z[(size_t)(rowb + t) * DIN + ZO_XB + ch]; } }
    for (int it_ = 0; it_ < nIter * (grp ? 1 : LRU_REP); ++it_) {
        const int it = it_ % nIter; if (LRU_REP > 1 && it_ == nIter) carry = 0.f;
        const int tw = grp ? 0 : it * 128 + 16 * w;
        float xv[19];
#pragma unroll
        for (int i = 0; i < 19; ++i) { const int t = tw - 3 + i; xv[i] = (t >= 0 && t < L) ? bf2f(xn[i]) : 0.f; }
        if (grp) {
#pragma unroll
            for (int i = 0; i < 3; ++i) xv[i] = cache[i * 768 + ch];
        }
        if (it_ + 1 < nIter * (grp ? 1 : LRU_REP)) {
            const int twn = tw + 128;
#pragma unroll
            for (int i = 0; i < 19; ++i) { int t = twn - 3 + i; t = t < 0 ? 0 : (t > L - 1 ? L - 1 : t); xn[i] = Z[(size_t)(rowb + t) * DIN + ZO_XB + ch]; }
        }
        unsigned gtp[8];
#pragma unroll
        for (int i = 0; i < 8; ++i) { const int ta = tw + 2 * i, tb = ta + 1;
            const bf16_t lo = Z[(size_t)(rowb + (ta < L ? ta : L - 1)) * DIN + ZO_GB + ch], hi = Z[(size_t)(rowb + (tb < L ? tb : L - 1)) * DIN + ZO_GB + ch];
            gtp[i] = (unsigned)lo | ((unsigned)hi << 16); }
        float xc[16];
#pragma unroll
        for (int i = 0; i < 16; ++i) { xc[i] = cb + cw[0] * xv[i] + cw[1] * xv[i + 1] + cw[2] * xv[i + 2] + cw[3] * xv[i + 3]; sA[i * 72 + lane] = f2bf(xc[i]); }
        lds_wait();
        bf16x8 af[2];
#pragma unroll
        for (int ks = 0; ks < 2; ++ks) af[ks] = *(const bf16x8*)(sA + fr * 72 + 32 * ks + 8 * fq);
#pragma unroll
        for (int nt = 0; nt < 4; ++nt) {
            f32x4 ra = {0.f, 0.f, 0.f, 0.f}, rx = ra;
            ra = mfma16(af[0], Wa[nt][0], ra); ra = mfma16(af[1], Wa[nt][1], ra);
            rx = mfma16(af[0], Wx[nt][0], rx); rx = mfma16(af[1], Wx[nt][1], rx);
#pragma unroll
            for (int j = 0; j < 4; ++j) { sRI[(4 * fq + j) * 132 + 16 * nt + fr] = ra[j]; sRI[(4 * fq + j) * 132 + 64 + 16 * nt + fr] = rx[j]; }
        }
        lds_wait();
        float hloc[16], ca[16]; float hl = 0.f, cacc = 1.f;
#pragma unroll
        for (int i = 0; i < 16; ++i) {
            const float rp = sRI[i * 132 + lane], ip = sRI[i * 132 + 64 + lane];
            const float r = sigm(rp + ba), ii = sigm(ip + bx);
            const float la = -sp8 * r; float a = __expf(la);
            const float x2 = 2.0f * la;
            const float ser = -x2 * (1.0f + x2 * (0.5f + x2 * (0.16666667f + x2 * (0.041666668f + x2 * 0.0083333338f))));
            const float om = x2 > -0.25f ? ser : 1.0f - __expf(x2);
            float bv = __builtin_amdgcn_sqrtf(om) * ii * xc[i];
            if (tw + i >= L) { a = 1.f; bv = 0.f; }
            hl = a * hl + bv; cacc *= a; hloc[i] = hl; ca[i] = cacc;
        }
        float hin = carry;
        if (!grp) {
            float* sCb = sComb + (it_ & 1) * 1024;
            sCb[(w * 64 + lane) * 2] = cacc; sCb[(w * 64 + lane) * 2 + 1] = hl;
            __syncthreads();
            float run = carry;
#pragma unroll
            for (int ww = 0; ww < 8; ++ww) { if (ww == w) hin = run; run = sCb[(ww * 64 + lane) * 2] * run + sCb[(ww * 64 + lane) * 2 + 1]; }
            carry = run;
        } else carry = hloc[15] + ca[15] * hin;
#pragma unroll
        for (int i = 0; i < 16; ++i) { const int t = tw + i;
            if (t < L) { const size_t row = (size_t)(rowb + t); const float hh = hloc[i] + ca[i] * hin; const unsigned gw_ = gtp[i >> 1]; const float gt = (i & 1) ? __uint_as_float(gw_ & 0xffff0000u) : __uint_as_float(gw_ << 16); Y[row * LDY + 768 + ch] = f2bf(hh * gelu_t(gt)); } }
    }
    if (grp || w == 0) {
        float* ho = grp ? P.out + O_S_LRUH + ((size_t)l * DEC_B + b) * 768 + ch : P.out + O_P_LRUH + ((size_t)l * NB + b) * 768 + ch;
        if (grp ? OUT_ON(10) : OUT_ON(4)) *ho = carry;
        float* co = grp ? P.out + O_S_LRUC + ((size_t)l * DEC_B + b) * 3 * 768 + ch : P.out + O_P_LRUC + ((size_t)l * NB + b) * 3 * 768 + ch;
#pragma unroll
        for (int j = 0; j < 3; ++j) if (grp ? OUT_ON(11) : OUT_ON(5)) co[j * 768] = bf2f(Z[(size_t)(rowb + L - 3 + j) * DIN + ZO_XB + ch]);
    }
}

template <bool FULL>
__device__ __forceinline__ void s5_run(const bf16_t* Z, bf16_t* ZS, float* sBU, bf16_t* sH, const bf16x8 (&Bf)[8], const bf16x8 (&Cf)[4], float abr, float abi, float dsk,
                                       int rowb, int g, int L, int it0, int it1, float& hr, float& hi, int lane, int fr, int fq) {
    u32x4 ufn = {0u, 0u, 0u, 0u}; bf16_t udn[4] = {0, 0, 0, 0};
    { const int t1 = it0 * 16; const int v1 = (L - t1) < 16 ? (L - t1) : 16;
      if (fq < 2 && fr < v1) ufn = *(const u32x4*)(Z + (size_t)(rowb + t1 + fr) * DIN + ZO_UA + g * 16 + 8 * fq);
      if (FULL) {
#pragma unroll
          for (int j = 0; j < 4; ++j) if (4 * fq + j < v1) udn[j] = Z[(size_t)(rowb + t1 + 4 * fq + j) * DIN + ZO_UA + g * 16 + fr]; } }
    for (int it = it0; it < it1; ++it) {
        const int t0 = it * 16; const int valid = (L - t0) < 16 ? (L - t0) : 16;
        const bf16x8 uf = __builtin_bit_cast(bf16x8, ufn);
        bf16_t ud[4];
#pragma unroll
        for (int j = 0; j < 4; ++j) ud[j] = udn[j];
        if (it + 1 < it1) { const int t1 = t0 + 16; const int v1 = (L - t1) < 16 ? (L - t1) : 16;
            ufn = (u32x4){0u, 0u, 0u, 0u};
            if (fq < 2 && fr < v1) ufn = *(const u32x4*)(Z + (size_t)(rowb + t1 + fr) * DIN + ZO_UA + g * 16 + 8 * fq);
            if (FULL) {
#pragma unroll
                for (int j = 0; j < 4; ++j) { udn[j] = 0; if (4 * fq + j < v1) udn[j] = Z[(size_t)(rowb + t1 + 4 * fq + j) * DIN + ZO_UA + g * 16 + fr]; } } }
#pragma unroll
        for (int nt = 0; nt < 8; ++nt) { f32x4 a = {0.f, 0.f, 0.f, 0.f}; a = mfma16(uf, Bf[nt], a);
#pragma unroll
            for (int j = 0; j < 4; ++j) sBU[(4 * fq + j) * 132 + 16 * nt + fr] = a[j]; }
        lds_wait();
#pragma unroll
        for (int i = 0; i < 16; ++i) {
            float bur = sBU[i * 132 + lane], bui = sBU[i * 132 + 64 + lane];
            asm volatile("" : "+v"(bur), "+v"(bui));
            const float msk = (i < valid) ? 1.0f : 0.0f;
            float nr = __builtin_fmaf(abr, hr, bur); asm volatile("" : "+v"(nr));
            nr = __builtin_fmaf(-abi, hi, nr); asm volatile("" : "+v"(nr));
            float ni = __builtin_fmaf(abr, hi, bui); asm volatile("" : "+v"(ni));
            ni = __builtin_fmaf(abi, hr, ni); asm volatile("" : "+v"(ni));
            hr = __builtin_fmaf(msk, nr - hr, hr); hi = __builtin_fmaf(msk, ni - hi, hi);
            asm volatile("" : "+v"(hr), "+v"(hi));
            if (FULL) { sH[i * 136 + lane] = f2bf(hr); sH[i * 136 + 64 + lane] = f2bf(hi); }
        }
        lds_wait();
        if (FULL) {
            f32x4 y = {0.f, 0.f, 0.f, 0.f};
#pragma unroll
            for (int ks = 0; ks < 4; ++ks) { const bf16x8 hf = *(const bf16x8*)(sH + fr * 136 + 32 * ks + 8 * fq); y = mfma16(hf, Cf[ks], y); }
#pragma unroll
            for (int j = 0; j < 4; ++j) { const int t = 4 * fq + j;
                if (t < valid) { const size_t row = (size_t)(rowb + t0 + t); const float u = bf2f(ud[j]); ZS[row * 768 + g * 16 + fr] = f2bf(gelu_t(y[j] + dsk * u)); } }
            lds_wait();
        }
    }
}
__device__ __forceinline__ void cmul(float& ar, float& ai, float br, float bi) { const float r = ar * br - ai * bi, i = ar * bi + ai * br; ar = r; ai = i; }

__device__ __forceinline__ void s5_job(const Params& P, int l, int grp, int jid, int g0, int pb0, unsigned* s5done, unsigned char* smem) {
    const int tid = otid(), w = __builtin_amdgcn_readfirstlane(tid >> 6), lane = tid & 63, fr = lane & 15, fq = lane >> 4;
    float* sBU = (float*)(smem + w * 12800);
    bf16_t* sH = (bf16_t*)(smem + w * 12800 + 8448);
    float* sC = (float*)(smem + 8 * 12800);
    const bf16_t* Z = (const bf16_t*)(P.ws + R_Z) - (size_t)g0 * DIN; bf16_t* ZS = (bf16_t*)(P.ws + R_ZS5) - (size_t)g0 * 768;
    int g, b0;
    if (grp) { const int unit = jid * 8 + w; g = unit % 48; b0 = (unit / 48) * 16; } else { b0 = jid / 48; g = jid - b0 * 48; b0 += pb0; }
    const float dt = __expf(INP(I_LS)[l * 48 + g]);
    float abr = 0.f, abi = 0.f;
    bf16x8 Bf[8];
#pragma unroll
    for (int k = 0; k < 4; ++k) {
        const int p = 16 * k + fr;
        const float lr = INP(I_AR)[((size_t)l * 48 + g) * 64 + p], li = INP(I_AI)[((size_t)l * 48 + g) * 64 + p];
        const float mag = expf(lr * dt), ar_ = mag * cosf(li * dt), ai_ = mag * sinf(li * dt);
        if (k == fq) { abr = ar_; abi = ai_; }
        const float den = lr * lr + li * li, nr = ar_ - 1.0f;
        const float cr = (nr * lr + ai_ * li) / den, ci = (ai_ * lr - nr * li) / den;
        bf16x8 fre, fim;
#pragma unroll
        for (int j = 0; j < 8; ++j) { fre[j] = 0; fim[j] = 0; }
        if (fq < 2) {
            gfp_t bre = INP(I_BR) + (((size_t)l * 48 + g) * 64 + p) * 16 + 8 * fq; gfp_t bim = INP(I_BI) + (((size_t)l * 48 + g) * 64 + p) * 16 + 8 * fq;
#pragma unroll
            for (int j = 0; j < 8; ++j) { const float br_ = bre[j], bi_ = bim[j]; fre[j] = (short)f2bf(cr * br_ - ci * bi_); fim[j] = (short)f2bf(cr * bi_ + ci * br_); }
        }
        Bf[k] = fre; Bf[4 + k] = fim;
    }
    bf16x8 Cf[4];
#pragma unroll
    for (int ks = 0; ks < 4; ++ks) {
        gfp_t cp = (ks < 2 ? INP(I_CR) : INP(I_CI)) + (((size_t)l * 48 + g) * 16 + fr) * 64 + 32 * (ks & 1) + 8 * fq;
        const float sg = ks < 2 ? 1.0f : -1.0f;
#pragma unroll
        for (int j = 0; j < 8; ++j) Cf[ks][j] = (short)f2bf(sg * cp[j]);
    }
    const float dsk = INP(I_D)[l * 768 + g * 16 + fr];
    __syncthreads();
    if (grp) {
        for (int s = 0; s < 16; ++s) {
            const int b = b0 + s; const int rowb = TPR + b * 4;
            float hr = INP(I_S5RE)[(((size_t)l * DEC_B + b) * 48 + g) * 64 + lane], hi = INP(I_S5IM)[(((size_t)l * DEC_B + b) * 48 + g) * 64 + lane];
            s5_run<true>(Z, ZS, sBU, sH, Bf, Cf, abr, abi, dsk, rowb, g, 4, 0, 1, hr, hi, lane, fr, fq);
            P.out[O_S_S5RE + (((size_t)l * DEC_B + b) * 48 + g) * 64 + lane] = hr;
            P.out[O_S_S5IM + (((size_t)l * DEC_B + b) * 48 + g) * 64 + lane] = hi;
        }
    } else {
        const int b = b0, rowb = b * LP;
        const int it0 = w == 0 ? 0 : 17 + 16 * (w - 1), it1 = 17 + 16 * w;
        float hr = 0.f, hi = 0.f;
        s5_run<false>(Z, ZS, sBU, sH, Bf, Cf, abr, abi, dsk, rowb, g, LP, it0, it1, hr, hi, lane, fr, fq);
        sC[(w * 64 + lane) * 2] = hr; sC[(w * 64 + lane) * 2 + 1] = hi;
        float pr = abr, pi = abi, p16r = 0.f, p16i = 0.f;
#pragma unroll
        for (int q = 0; q < 8; ++q) { cmul(pr, pi, pr, pi); if (q == 3) { p16r = pr; p16i = pi; } }
        float qr = pr, qi = pi; cmul(qr, qi, p16r, p16i);
        __syncthreads();
        float cr_ = 0.f, ci_ = 0.f;
        for (int ww = 0; ww < w; ++ww) {
            const float ar2 = ww == 0 ? qr : pr, ai2 = ww == 0 ? qi : pi;
            cmul(cr_, ci_, ar2, ai2);
            cr_ += sC[(ww * 64 + lane) * 2]; ci_ += sC[(ww * 64 + lane) * 2 + 1];
        }
        hr = cr_; hi = ci_;
        s5_run<true>(Z, ZS, sBU, sH, Bf, Cf, abr, abi, dsk, rowb, g, LP, it0, it1, hr, hi, lane, fr, fq);
        if (w == 7) {
            P.out[O_P_S5RE + (((size_t)l * NB + b) * 48 + g) * 64 + lane] = hr;
            P.out[O_P_S5IM + (((size_t)l * NB + b) * 48 + g) * 64 + lane] = hi;
        }
    }
    asm volatile("s_waitcnt vmcnt(0)" ::: "memory");
    __syncthreads();
    if (threadIdx.x == 0) { __threadfence(); asm volatile("s_waitcnt vmcnt(0)" ::: "memory"); atomicAdd(s5done, 1u); }
}

__device__ __forceinline__ void mixers_phase(const Params& P, int l, int rg, unsigned char* smem, int rep) {
    const Grp G = get_grp(rg);
    const int j1 = G.npb * 8, j2 = j1 + G.npb * 12, j3 = j2 + G.npb * 48, j4 = j3 + (G.hasS ? 1024 : 0), j5 = j4 + (G.hasS ? 48 : 0), j6 = j5 + (G.hasS ? 192 : 0), j7 = j6 + G.npan * 12, NJ = j7 + G.npan * 3;
    unsigned* s5done = (unsigned*)(P.ws + A_CTR) + 32 + (l * NGRP + rg) + rep * 16;
    const unsigned s5total = (unsigned)(G.npb * 48 + (G.hasS ? 48 : 0));
    unsigned* ctr = (unsigned*)(P.ws + A_CTR) + (l * NGRP + rg) + rep * 16;
    int* slot = (int*)(smem + LDS_BYTES - 16);
#ifndef STATIC_JOBS
#define STATIC_JOBS 0
#endif
    for (int jj = blockIdx.x;; jj += gridDim.x) {
        __syncthreads();
#if STATIC_JOBS
        const int j = jj; (void)ctr; (void)slot;
#else
        if (threadIdx.x == 0) *slot = (int)atomicAdd(ctr, 1u);
        __syncthreads();
        const int j = *slot;
#endif
        if (j >= NJ) break;
        int type, sg, idx;
        if (j < j1) { type = 0; sg = 0; idx = j; }
        else if (j < j2) { type = 1; sg = 0; idx = j - j1; }
        else if (j < j3) { type = 2; sg = 0; idx = j - j2; }
        else if (j < j4) { type = 0; sg = 1; idx = j - j3; }
        else if (j < j5) { type = 2; sg = 1; idx = j - j4; }
        else if (j < j6) { type = 1; sg = 1; idx = j - j5; }
        else if (j < j7) { type = 4; sg = 0; idx = j - j6; }
        else { type = 3; sg = 0; idx = j - j7; }
        if (type == 4) {
            using namespace pg8;
            Gemm gg{(const bf16_t*)(P.ws + R_H), (const bf16_t*)(P.ws + W_IN) + (size_t)l * DIN * DM, DM, DM, G.npan, DIN / 256, DM / 64, nullptr};
            SchedOne S1{idx / 12, 21 + idx % 12, DM / 64};
            EpiSigBf E{(bf16_t*)(P.ws + R_Z), DIN};
            gemm_run((LAS unsigned char*)smem, gg, S1, E);
            continue;
        }
        if (type == 3) {
            if (threadIdx.x == 0) {
                unsigned sp = 0;
                while (__hip_atomic_load(s5done, __ATOMIC_RELAXED, __HIP_MEMORY_SCOPE_AGENT) < s5total) { __builtin_amdgcn_s_sleep(8); if (++sp > (1u << 22)) break; }
                __threadfence();
                asm volatile("s_waitcnt vmcnt(0)" ::: "memory");
            }
            __syncthreads();
            using namespace pg8;
            Gemm gg{(const bf16_t*)(P.ws + R_ZS5), (const bf16_t*)(P.ws + W_GLU) + (size_t)l * 768 * 768, 768, 768, G.npan, 3, 12, nullptr};
            SchedOne S1{idx / 3, idx % 3, 12};
            EpiGlu E{(bf16_t*)(P.ws + R_Y), (const bf16_t*)(P.ws + R_ZS5), INP(I_BGLU) + l * 768};
            gemm_run((LAS unsigned char*)smem, gg, S1, E);
            continue;
        }
        if (type == 0) ret_job(P, l, sg, (idx >> 3) + (sg ? 0 : G.pb0), idx & 7, G.g0, smem);
        else if (type == 1) lru_job(P, l, sg, idx, G.g0, G.pb0, smem);
        else s5_job(P, l, sg, idx, G.g0, G.pb0, s5done, smem);
    }
}

__device__ __forceinline__ void run_phase(const Params& P, int ph, unsigned char* smem, int rep) {
#ifndef PHSEL
#define PHSEL -1
#endif
#define PSEL(x) (PHSEL < 0 || PHSEL == (x))
    if (ph == 0) { if (PSEL(10)) phase0(P, smem); return; }
    const int l = (ph - 1) / (10 * NGRP), rg = ((ph - 1) / 10) % NGRP, s = (ph - 1) % 10;
    LAS unsigned char* lds = (LAS unsigned char*)smem;
    unsigned char* ws = P.ws;
    using namespace pg8;
    const int G = gridDim.x, c = blockIdx.x;
    const int npan = rg < 2 ? 25 : 19;
    switch (s) {
    case 0: if (PSEL(0)) { Gemm g{(const bf16_t*)(ws + R_H), (const bf16_t*)(ws + W_IN) + (size_t)l * DIN * DM, DM, DM, npan, 21, DM / 64, nullptr};
              Sched<1> S; S.init(g.nM, g.nN, G, c, g.nt); EpiBf E{(bf16_t*)(ws + R_Z), DIN, (bf16_t*)(ws + R_Z)}; gemm_run(lds, g, S, E); } break;
    case 1: if (PSEL(1)) mixers_phase(P, l, rg, smem, rep); break;
    case 2: if (PSEL(2)) { Gemm g{(const bf16_t*)(ws + R_ZS5), (const bf16_t*)(ws + W_GLU) + (size_t)l * 768 * 768, 768, 768, npan, 3, 12, nullptr};
              Sched<1> S; S.init(g.nM, g.nN, G, c, g.nt); EpiGlu E{(bf16_t*)(ws + R_Y), (const bf16_t*)(ws + R_ZS5), INP(I_BGLU) + l * 768}; gemm_run(lds, g, S, E); } break;
    case 3: if (PSEL(3)) { Gemm g{(const bf16_t*)(ws + R_Y), (const bf16_t*)(ws + W_BR) + (size_t)l * DM * LDY, LDY, LDY, npan, 4, 0, nullptr};
              SchedBr2 S; S.init(g.nM, g.nN, G, c); EpiBranch E{(const bf16_t*)(ws + R_Z) + ZO_GATE, (bf16_t*)(ws + R_M), (bf16_t*)(ws + R_M2)}; gemm_run(lds, g, S, E); } break;
    case 4: if (PSEL(4)) { Gemm g{(const bf16_t*)(ws + R_M), (const bf16_t*)(ws + W_OUT) + (size_t)l * DM * DM, DM, DM, npan, 4, 16, (const bf16_t*)(ws + R_M2)};
              Sched<2> S; S.init(g.nM, g.nN, G, c, g.nt); S.fullk = 1;     EpiBf E{(bf16_t*)(ws + R_F), DM, (bf16_t*)(ws + R_UP)}; gemm_run(lds, g, S, E); } break;
    case 5: if (PSEL(5) && rep == 0) norm_rows(P, 1, l, rg, smem); break;
    case 6: if (PSEL(6)) { Gemm g{(const bf16_t*)(ws + R_H), (const bf16_t*)(ws + W_UP) + (size_t)l * 2 * DFF * DM, DM, DM, npan, 22, 16, nullptr};
              Sched<1> S; S.init(g.nM, g.nN, G, c, g.nt); EpiBf E{(bf16_t*)(ws + R_UP), 2 * DFF, (bf16_t*)(ws + R_UP)}; gemm_run(lds, g, S, E); } break;
    case 7: if (PSEL(7)) ffn_conv_phase(P, l, rg, smem); break;
    case 8: if (PSEL(8)) { Gemm g{(const bf16_t*)(ws + R_FIN), (const bf16_t*)(ws + W_DOWN) + (size_t)l * DM * DFF, DFF, DFF, npan, 4, 44, nullptr};
              Sched<2> S; S.init(g.nM, g.nN, G, c, g.nt); EpiBf E{(bf16_t*)(ws + R_F), DM, (bf16_t*)(ws + R_UP)}; gemm_run(lds, g, S, E);
              const int nun = 2 * npan * 4;
              if (c >= nun) next_h_rows(P, l, rg, (c - nun) * 8 + (int)(threadIdx.x >> 6), (G - nun) * 8, smem);
              else if (G <= nun) next_h_rows(P, l, rg, c * 8 + (int)(threadIdx.x >> 6), G * 8, smem); } break;
    default: if (PSEL(9) && rep == 0) norm_rows(P, 2, l, rg, smem); break;
    }
}

#define XB_TMO      128
#define XB_XCNT(j)  (256  + 64 * (j))
#define XB_XSUB(j)  (1280 + 64 * (j))
#define XB_XGEN(j)  (2304 + 64 * (j))
#define XB_TOP      3328
#define XB_TOPGEN   3392
#define XCD_BAR_WORDS 3456
#define XB_SPIN_CAP (1u << 18)

__device__ __forceinline__ unsigned xb_ld(unsigned* p)              { return __hip_atomic_load(p, __ATOMIC_RELAXED, __HIP_MEMORY_SCOPE_AGENT); }
__device__ __forceinline__ unsigned xb_add(unsigned* p, unsigned v) { return __hip_atomic_fetch_add(p, v, __ATOMIC_RELAXED, __HIP_MEMORY_SCOPE_AGENT); }
__device__ __forceinline__ unsigned xb_xcc_id() { return (unsigned)__builtin_amdgcn_s_getreg((3 << 11) | 20) & 0xFu; }
#define XB_SPIN(cond, bar) do { unsigned _sp = 0; while (cond) { __builtin_amdgcn_s_sleep(1); \
    if ((++_sp & 255u) == 0u) { if (xb_ld(&(bar)[XB_TMO])) break; if (_sp > XB_SPIN_CAP) { atomicAdd(&(bar)[XB_TMO], 1u); break; } } } } while (0)

struct XcdBarrier {
    unsigned* bar; unsigned x;
    volatile LAS unsigned* st;
};

__device__ __forceinline__ XcdBarrier xcd_barrier_post(unsigned* bar, volatile LAS unsigned* st) {
    XcdBarrier b; b.bar = bar; b.x = xb_xcc_id(); b.st = st;
    if (threadIdx.x == 0) (void)xb_add(&bar[XB_XCNT(b.x)], 1u);
    return b;
}
__device__ __forceinline__ void xcd_barrier_complete(unsigned* bar, unsigned x, unsigned& nloc, unsigned& nx) {
    const unsigned G = gridDim.x * gridDim.y * gridDim.z;
    unsigned sum, cnt, mine, sp = 0u;
    for (;;) {
        sum = 0u; cnt = 0u; mine = 0u;
#pragma unroll
        for (unsigned j = 0; j < 16; ++j) { const unsigned c = xb_ld(&bar[XB_XCNT(j)]); sum += c; cnt += (c > 0u) ? 1u : 0u; mine = (j == x) ? c : mine; }
        if (sum == G) break;
        __builtin_amdgcn_s_sleep(1);
        if ((++sp & 255u) == 0u) { if (xb_ld(&bar[XB_TMO])) break; if (sp > XB_SPIN_CAP) { atomicAdd(&bar[XB_TMO], 1u); break; } }
    }
    nloc = mine > 0u ? mine : 1u; nx = cnt > 0u ? cnt : 1u;
}

__device__ __forceinline__ void xcd_barrier(const XcdBarrier& b) {
    asm volatile("s_waitcnt vmcnt(0)" ::: "memory");
    __syncthreads();
    if (threadIdx.x == 0) {
        unsigned* bar = b.bar;
        __builtin_amdgcn_s_waitcnt(0);
        unsigned nloc = b.st[0], nx = b.st[1];
        if (nloc == 0u) { xcd_barrier_complete(bar, b.x, nloc, nx); b.st[0] = nloc; b.st[1] = nx; }
        const unsigned old = xb_add(&bar[XB_XSUB(b.x)], 1u);
        const unsigned gen = old / nloc;
        if (old + 1u == (gen + 1u) * nloc) {
            __builtin_amdgcn_fence(__ATOMIC_RELEASE, "agent");
            asm volatile("s_waitcnt vmcnt(0)" ::: "memory");
            const unsigned og = xb_add(&bar[XB_TOP], 1u);
            const unsigned tg = og / nx;
            if (og + 1u == (tg + 1u) * nx) xb_add(&bar[XB_TOPGEN], 1u);
            else XB_SPIN(xb_ld(&bar[XB_TOPGEN]) == tg, bar);
            __builtin_amdgcn_fence(__ATOMIC_ACQUIRE, "agent");
            xb_add(&bar[XB_XGEN(b.x)], 1u);
            asm volatile("s_waitcnt vmcnt(0)" ::: "memory");
        } else {
            XB_SPIN(xb_ld(&bar[XB_XGEN(b.x)]) == gen, bar);
            __builtin_amdgcn_fence(__ATOMIC_ACQUIRE, "agent");
            asm volatile("s_waitcnt vmcnt(0)" ::: "memory");
        }
    }
    __syncthreads();
}


__global__ void __launch_bounds__(512, 2) mega(Params P, int ph_lo, int ph_hi) {
    extern __shared__ __attribute__((aligned(16))) unsigned char smem[];
    unsigned* xst = (unsigned*)(smem + LDS_BYTES - 32);
    if (threadIdx.x == 0) {
        const float** tab = (const float**)(smem + PTAB_OFF);
#pragma unroll
        for (int i = 0; i < N_IN; ++i) tab[i] = P.in[i];
        xst[0] = 0u; xst[1] = 0u;
    }
    __syncthreads();
    XcdBarrier xb = xcd_barrier_post((unsigned*)(P.ws + A_BAR), (volatile LAS unsigned*)xst);
#ifndef DUP_MASK
#define DUP_MASK 0x400
#endif
    for (int ph = ph_lo; ph < ph_hi; ++ph) {
        if (ph > 0 && (ph - 1) % 10 == 2) continue;
        int nrep = 1;
        if (DUP_MASK) { const int sidx = ph == 0 ? 10 : (ph - 1) % 10; if ((DUP_MASK >> sidx) & 1) nrep = 2; }
        for (int rep = 0; rep < nrep; ++rep) {
            run_phase(P, ph, smem, rep);
            if (ph + 1 < ph_hi || rep + 1 < nrep) xcd_barrier(xb);
        }
    }
}


#ifndef DBG_STOP
#define DBG_STOP 0
#endif
#ifndef DBG_OFF
#define DBG_OFF R_Z
#endif
__global__ void dbg_dump(const unsigned char* ws, float* out, size_t n) {
    const bf16_t* src = (const bf16_t*)(ws + DBG_OFF);
    for (size_t i = (size_t)blockIdx.x * blockDim.x + threadIdx.x; i < n; i += (size_t)gridDim.x * blockDim.x) out[i] = bf2f(src[i]);
}

extern "C" void kernel_launch(void* const* d_in, const int* in_sizes, int n_in, void* d_out, int out_size, void* d_ws, size_t ws_size, hipStream_t stream) {
    (void)in_sizes; (void)n_in; (void)out_size;
    if (ws_size < WS_TOTAL) { fprintf(stderr, "workspace too small: %zu < %zu\n", ws_size, (size_t)WS_TOTAL); return; }
    Params p{};
    for (int i = 0; i < N_IN; ++i) p.in[i] = (const float*)d_in[i];
    p.out = (float*)d_out; p.ws = (unsigned char*)d_ws;
    hipFuncSetAttribute((const void*)mega, hipFuncAttributeMaxDynamicSharedMemorySize, LDS_BYTES);
    int dev = 0, cus = 256, per_cu = 1;
    hipGetDevice(&dev);
    hipDeviceGetAttribute(&cus, hipDeviceAttributeMultiprocessorCount, dev);
    hipOccupancyMaxActiveBlocksPerMultiprocessor(&per_cu, mega, 512, LDS_BYTES);
    if (per_cu < 1) per_cu = 1;
    const int grid = cus * 1;
#if COOP
#ifndef PH_HI
#define PH_HI NPHASE
#endif
    hipMemsetAsync((unsigned char*)d_ws + A_BAR, 0, 16384, stream);
    int lo = 0, hi = PH_HI;
    void* args[] = {&p, &lo, &hi};
    hipError_t e = hipLaunchCooperativeKernel((void*)mega, dim3(grid), dim3(512), args, LDS_BYTES, stream);
    if (e != hipSuccess) fprintf(stderr, "cooperative launch failed: %s (grid %d)\n", hipGetErrorString(e), grid);
#else
#if DBG_STOP
    for (int ph = 0; ph < DBG_STOP; ++ph) hipLaunchKernelGGL(mega, dim3(grid), dim3(512), LDS_BYTES, stream, p, ph, ph + 1);
#ifdef DBG_EXTRA
    hipLaunchKernelGGL(mega, dim3(grid), dim3(512), LDS_BYTES, stream, p, DBG_EXTRA, DBG_EXTRA + 1);
#endif
    hipLaunchKernelGGL(dbg_dump, dim3(2048), dim3(256), 0, stream, (const unsigned char*)d_ws, (float*)d_out, (size_t)34873344);
#else
    for (int ph = 0; ph < NPHASE; ++ph) hipLaunchKernelGGL(mega, dim3(grid), dim3(512), LDS_BYTES, stream, p, ph, ph + 1);
#endif
#endif
}
```

```cpp
#include <hip/hip_runtime.h>
#include <hip/hip_cooperative_groups.h>
#include <cstdio>
namespace cg = cooperative_groups;

#define DUP_MASK 0
#ifndef COOP
#define COOP 1
#endif
#ifndef OUTMASK
#define OUTMASK 0x3FFF
#endif
#ifndef OUT_BMAX
#define OUT_BMAX 1000
#endif
#ifndef OUT_L
#define OUT_L 3
#endif
#define OUT_ON(k) (((OUTMASK >> (k)) & 1) && ((OUT_L >> l) & 1))
#ifndef DMA_AUX
#define DMA_AUX 0
#endif

#define LAS __attribute__((address_space(3)))
typedef unsigned short bf16_t;
typedef short bf16x8 __attribute__((ext_vector_type(8)));
typedef float f32x4 __attribute__((ext_vector_type(4)));
typedef unsigned u32x4 __attribute__((ext_vector_type(4)));
typedef unsigned u32x2 __attribute__((ext_vector_type(2)));

constexpr int DM = 1024, NB = 8, SEQ = 2048, LP = 2064, DEC_B = 128, DEC_S = 4;
constexpr int TPR = NB * LP;
constexpr int TT = TPR + DEC_B * DEC_S;
constexpr int TPAD = 17152;
constexpr int DIN = 8448, DFF = 2816;
constexpr int ZO_UA = 0, ZO_XB = 768, ZO_GB = 1536, ZO_Q = 2304, ZO_K = 2816, ZO_V = 3328, ZO_GC = 4352, ZO_GATE = 5376;
constexpr int LDY = 2560;
constexpr float EPS = 1e-6f;
constexpr int LDS_BYTES = 143360;

enum { I_XP = 0, I_XS, I_S5RE, I_S5IM, I_LRUH, I_LRUC, I_RET, I_FFNC, I_META, I_GPREMIX, I_GPOSTMIX, I_GPREFFN, I_GPOSTFFN, I_WIN,
       I_AR, I_AI, I_LS, I_BR, I_BI, I_CR, I_CI, I_D, I_WGLU, I_BGLU, I_LCW, I_LCB, I_LWA, I_LBA, I_LWX, I_LBX, I_LAM, I_RNG,
       I_WBA, I_WBB, I_WBC, I_WOUT, I_WUP, I_FCW, I_FCB, I_WDOWN, N_IN };

constexpr size_t O_YP = 0;
constexpr size_t O_YS = O_YP + (size_t)NB * SEQ * DM;
constexpr size_t O_P_S5RE = O_YS + (size_t)DEC_B * DEC_S * DM;
constexpr size_t O_P_S5IM = O_P_S5RE + 2 * NB * 48 * 64;
constexpr size_t O_P_LRUH = O_P_S5IM + 2 * NB * 48 * 64;
constexpr size_t O_P_LRUC = O_P_LRUH + 2 * NB * 768;
constexpr size_t O_P_RET = O_P_LRUC + 2 * NB * 3 * 768;
constexpr size_t O_P_FFNC = O_P_RET + (size_t)2 * NB * 8 * 64 * 128;
constexpr size_t O_S_S5RE = O_P_FFNC + 2 * NB * 2 * DFF;
constexpr size_t O_S_S5IM = O_S_S5RE + 2 * DEC_B * 48 * 64;
constexpr size_t O_S_LRUH = O_S_S5IM + 2 * DEC_B * 48 * 64;
constexpr size_t O_S_LRUC = O_S_LRUH + 2 * DEC_B * 768;
constexpr size_t O_S_RET = O_S_LRUC + 2 * DEC_B * 3 * 768;
constexpr size_t O_S_FFNC = O_S_RET + (size_t)2 * DEC_B * 8 * 64 * 128;

constexpr size_t al256(size_t x) { return (x + 255) & ~(size_t)255; }
constexpr size_t W_IN = 0;
constexpr size_t W_GLU = W_IN + (size_t)2 * DIN * DM * 2;
constexpr size_t W_BR = W_GLU + (size_t)2 * 768 * 768 * 2;
constexpr size_t W_OUT = W_BR + (size_t)2 * DM * LDY * 2;
constexpr size_t W_UP = W_OUT + (size_t)2 * DM * DM * 2;
constexpr size_t W_DOWN = W_UP + (size_t)2 * 2 * DFF * DM * 2;
constexpr size_t A_X = W_DOWN + (size_t)2 * DM * DFF * 2;
constexpr int GR = 6400;
constexpr size_t R_Z = A_X + (size_t)TPAD * DM * 4;
constexpr size_t R_ZS5 = R_Z + (size_t)GR * DIN * 2;
constexpr size_t R_Y = R_ZS5 + (size_t)GR * 768 * 2;
constexpr size_t R_M = R_Y + (size_t)GR * LDY * 2;
constexpr size_t R_END = R_M + (size_t)GR * DM * 2;
constexpr size_t R_H = R_M;
constexpr size_t R_F = R_Z;
constexpr size_t R_UP = R_Z + (size_t)GR * DM * 4;
constexpr size_t R_FIN = R_ZS5;
static_assert(R_UP + (size_t)GR * 2 * DFF * 2 <= R_ZS5, "UP inside Z");
static_assert(R_FIN + (size_t)GR * DFF * 2 <= R_M, "FIN inside ZS5|Y");
constexpr size_t A_ROPE = R_END;
constexpr size_t A_CTR = al256(A_ROPE + (size_t)2068 * 64 * 4);
constexpr size_t A_BAR = A_CTR + 4096;
constexpr size_t WS_TOTAL = A_BAR + 16384;
constexpr size_t R_M2 = A_X + (size_t)40 * 1024 * 1024;
static_assert(A_X + (size_t)TPAD * DM * 2 <= R_M2 && R_M2 + (size_t)GR * DM * 2 <= R_Z, "M2 inside the freed half of the X reservation");
constexpr int NGRP = 3;
constexpr int NPHASE = 1 + 2 * NGRP * 10;

struct Grp { int g0, nrows, npan, pb0, npb, hasS; };
__device__ __forceinline__ Grp get_grp(int g) {
    Grp r; r.g0 = g * 6192; r.nrows = g < 2 ? 6192 : 4640; r.npan = g < 2 ? 25 : 19; r.pb0 = g * 3; r.npb = g < 2 ? 3 : 2; r.hasS = g == 2; return r;
}

struct Params {
    const float* in[N_IN];
    float* out;
    unsigned char* ws;
};


constexpr int PTAB_OFF = 142336;
typedef const __attribute__((address_space(1))) float* gfp_t;
typedef const __attribute__((address_space(1))) f32x4* gf4p_t;
__device__ __forceinline__ gfp_t ldin(const unsigned char* smem, int i) {
    const unsigned long long v = ((const unsigned long long*)(smem + PTAB_OFF))[i];
    const unsigned lo = __builtin_amdgcn_readfirstlane((unsigned)v), hi = __builtin_amdgcn_readfirstlane((unsigned)(v >> 32));
    return (gfp_t)(((unsigned long long)hi << 32) | lo);
}
#define INP(i) ldin(smem, (i))
__device__ __forceinline__ int otid() { int t = threadIdx.x; asm volatile("" : "+v"(t)); return t; }

__device__ __forceinline__ float bf2f(bf16_t b) { return __uint_as_float(((unsigned)b) << 16); }
__device__ __forceinline__ bf16_t f2bf(float f) { unsigned u = __float_as_uint(f); u += 0x7FFFu + ((u >> 16) & 1u); return (bf16_t)(u >> 16); }
__device__ __forceinline__ unsigned pk2(float lo, float hi) { return (unsigned)f2bf(lo) | ((unsigned)f2bf(hi) << 16); }
__device__ __forceinline__ float sigm(float x) { return __builtin_amdgcn_rcpf(1.0f + __expf(-x)); }
__device__ __forceinline__ float gelu_t(float x) { const float v = 1.5957691216f * (x + 0.044715f * x * x * x); return x * __builtin_amdgcn_rcpf(1.0f + __expf(-v)); }
__device__ __forceinline__ void lds_wait() { asm volatile("s_waitcnt lgkmcnt(0)" ::: "memory"); __builtin_amdgcn_wave_barrier(); }
__device__ __forceinline__ f32x4 mfma16(bf16x8 a, bf16x8 b, f32x4 c) { return __builtin_amdgcn_mfma_f32_16x16x32_bf16(a, b, c, 0, 0, 0); }

namespace pg8 {
constexpr int BM = 256, BK = 64, HALF = 128, HTB = HALF * BK * 2, STAGE_BYTES = 8 * HTB, NXCD = 8, WGM = 8;
__device__ __forceinline__ int lds_byte(int r, int c) { const int st = (r >> 4) * 2 + (c >> 5), rr = r & 15, cc = c & 31, ob = rr * 64 + cc * 2; return st * 1024 + (ob ^ (((ob >> 9) & 1) << 5)); }
__device__ __forceinline__ void stage_rc(int b, int& R, int& C) { const int st = b / 1024, sb = b % 1024, swz = sb ^ (((sb >> 9) & 1) << 5); R = (st >> 1) * 16 + swz / 64; C = (st & 1) * 32 + (swz % 64) / 2; }

struct Unit { int pm, pn, br; };
struct Gemm { const bf16_t* A; const bf16_t* Bt; int lda, ldb, nM, nN, nt; const bf16_t* A2; };

struct SchedOne {
    int pm, pn, nt0;
    __device__ bool next(int i, Unit& u) const { if (i != 0) return false; u.pm = pm; u.pn = pn; u.br = 0; return true; }
    __device__ __forceinline__ void kr(const Unit&, size_t& koffB, int& nt) const { koffB = 0; nt = nt0; }
};
template <int NBR> struct Sched {
    int nM, nN, nwg, G, c, nt0, fullk;
    __device__ void init(int nM_, int nN_, int G_, int c_, int nt_) { nM = nM_; nN = nN_; nwg = nM * nN; G = G_; c = c_; nt0 = nt_; fullk = 0; }
    __device__ bool next(int i, Unit& u) const {
        int wgid;
        if (NBR == 2) {
            const long L = (long)i * G + c; if (L >= 2 * (long)nwg) return false;
            u.br = (int)(L / nwg); wgid = (int)(L - (long)u.br * nwg);
        } else {
            const int ti = i / NBR; u.br = i - ti * NBR;
            const long L = (long)ti * G + c; if (L >= nwg) return false;
            wgid = (int)L;
        } { const int q = nwg / NXCD, r = nwg % NXCD, xcd = wgid % NXCD, off = wgid / NXCD; wgid = (xcd < r ? xcd * (q + 1) : r * (q + 1) + (xcd - r) * q) + off; }
        const int nig = WGM * nN, gid = wgid / nig, fm = gid * WGM, gsz = (nM - fm) < WGM ? (nM - fm) : WGM;
        u.pm = fm + ((wgid % nig) % gsz); u.pn = (wgid % nig) / gsz; return true;
    }
    __device__ __forceinline__ void kr(const Unit& u, size_t& koffB, int& nt) const {
        if (NBR == 1) { koffB = 0; nt = nt0; }
        else if (NBR == 2) { if (fullk) { nt = nt0; koffB = 0; } else { nt = nt0 >> 1; koffB = (size_t)u.br * (size_t)nt * 128; } }
        else { koffB = (size_t)u.br * 1536; nt = (u.br == 2) ? 16 : 12; }
    }
};

struct SchedBr2 {
    int nM, nN, nwg, G, c;
    __device__ void init(int nM_, int nN_, int G_, int c_) { nM = nM_; nN = nN_; nwg = nM * nN; G = G_; c = c_; }
    __device__ bool next(int i, Unit& u) const {
        const int ti = i / 3, b = i - ti * 3;
        const long L = (long)ti * G + c; if (L >= 2 * (long)nwg) return false;
        const int half = (int)(L / nwg); int wgid = (int)(L - (long)half * nwg);
        { const int q = nwg / NXCD, r = nwg % NXCD, xcd = wgid % NXCD, off = wgid / NXCD; wgid = (xcd < r ? xcd * (q + 1) : r * (q + 1) + (xcd - r) * q) + off; }
        const int nig = WGM * nN, gid = wgid / nig, fm = gid * WGM, gsz = (nM - fm) < WGM ? (nM - fm) : WGM;
        u.pm = fm + ((wgid % nig) % gsz); u.pn = (wgid % nig) / gsz; u.br = b + 4 * half; return true;
    }
    __device__ __forceinline__ void kr(const Unit& u, size_t& koffB, int& nt) const {
        const int b = u.br & 3, half = u.br >> 2; nt = (b == 2) ? 8 : 6; koffB = (size_t)b * 1536 + (size_t)half * nt * 128;
    }
};
__device__ __forceinline__ unsigned cvt_pk_bf16(float lo, float hi) { unsigned r; asm volatile("s_nop 1\n\tv_cvt_pk_bf16_f32 %0, %1, %2" : "=v"(r) : "v"(lo), "v"(hi)); return r; }

template <class Epi, class SchedT>
__device__ __forceinline__ void gemm_phase(LAS unsigned char* lds, const Gemm g, const SchedT& S, const Epi& E) {
    const int tid = otid(), wid = __builtin_amdgcn_readfirstlane(tid >> 6), lane = tid & 63, wr = wid >> 2, wc = wid & 3, fr = lane & 15, fq = lane >> 4;
    unsigned voffA[2], voffB[2];
#pragma unroll
    for (int i = 0; i < 2; ++i) { int R, C; stage_rc(tid * 16 + i * 8192, R, C);
        voffA[i] = (unsigned)(R * g.lda + C) * 2u; voffB[i] = (unsigned)(R * g.ldb + C) * 2u; }
    const size_t kstep = (size_t)(BK * 2);
    const size_t hstepA = (size_t)HALF * g.lda * 2, hstepB = (size_t)HALF * g.ldb * 2;
    const size_t tstepA = 2 * hstepA, tstepB = 2 * hstepB;
    const unsigned ldsw = (unsigned)wid * 1024u;
    const int aoff = lds_byte(wr * 64 + fr, fq * 8), boff = lds_byte(wc * 32 + fr, fq * 8);
#define PG8_SA(b, h) (((b) * 2 + (h)) * HTB)
#define PG8_SB(b, h) ((4 + (b) * 2 + (h)) * HTB)
#define PG8_STAGE(bufoff, gbase, voff) do { _Pragma("unroll") for (int _i = 0; _i < 2; ++_i) \
        __builtin_amdgcn_global_load_lds((const unsigned*)((const char*)(gbase) + (voff)[_i]), (LAS unsigned*)(lds + (bufoff) + ldsw + _i * 8192), 16, 0, DMA_AUX); } while (0)
#define PG8_LDA(dst, b, h) do { _Pragma("unroll") for (int m = 0; m < 4; ++m) _Pragma("unroll") for (int k = 0; k < 2; ++k) dst[m][k] = *(const LAS bf16x8*)(lds + PG8_SA(b, h) + aoff + m * 2048 + k * 1024); } while (0)
#define PG8_LDB(dst, b, h) do { _Pragma("unroll") for (int n = 0; n < 2; ++n) _Pragma("unroll") for (int k = 0; k < 2; ++k) dst[n][k] = *(const LAS bf16x8*)(lds + PG8_SB(b, h) + boff + n * 2048 + k * 1024); } while (0)
#define PG8_MMA(ai, bj, At, Bt) do { __builtin_amdgcn_s_setprio(1); _Pragma("unroll") for (int m = 0; m < 4; ++m) _Pragma("unroll") for (int n = 0; n < 2; ++n) _Pragma("unroll") for (int k = 0; k < 2; ++k) \
        acc[ai][bj][m][n] = __builtin_amdgcn_mfma_f32_16x16x32_bf16(Bt[n][k], At[m][k], acc[ai][bj][m][n], 0, 0, 0); __builtin_amdgcn_s_setprio(0); } while (0)
#define PG8_WAIT_V(n) asm volatile("s_waitcnt vmcnt(" #n ")" ::: "memory")
#define PG8_WAIT_L(n) asm volatile("s_waitcnt lgkmcnt(" #n ")" ::: "memory")
#define PG8_BAR __builtin_amdgcn_s_barrier()
#define PG8_SCHED __builtin_amdgcn_sched_barrier(0)
    Unit cur, nxt; int ui = 0;
    if (!S.next(0, cur)) return;
    f32x4 acc[2][2][4][2];
#pragma unroll
    for (int a = 0; a < 2; ++a)
#pragma unroll
        for (int b = 0; b < 2; ++b)
#pragma unroll
            for (int m = 0; m < 4; ++m)
#pragma unroll
                for (int n = 0; n < 2; ++n) acc[a][b][m][n] = (f32x4){0.f, 0.f, 0.f, 0.f};
    bf16x8 At[4][2], B0[2][2], B1[2][2];
    size_t koc; int ntc; S.kr(cur, koc, ntc);
    const char* cA = (const char*)((g.A2 && cur.br) ? g.A2 : g.A) + (size_t)cur.pm * tstepA + koc; const char* cB = (const char*)g.Bt + (size_t)cur.pn * tstepB + koc;
    PG8_STAGE(PG8_SB(0, 0), cB, voffB); PG8_STAGE(PG8_SA(0, 0), cA, voffA); PG8_STAGE(PG8_SB(0, 1), cB + hstepB, voffB); PG8_STAGE(PG8_SA(0, 1), cA + hstepA, voffA);
    if (wr == 1) PG8_BAR;
    PG8_WAIT_V(4); PG8_BAR;
    PG8_STAGE(PG8_SB(1, 0), cB + kstep, voffB); PG8_STAGE(PG8_SA(1, 0), cA + kstep, voffA); PG8_STAGE(PG8_SB(1, 1), cB + hstepB + kstep, voffB);
    PG8_WAIT_V(6); PG8_BAR;
    for (;;) {
        const bool has_next = S.next(ui + 1, nxt);
        size_t kon = 0; int ntn = ntc; if (has_next) S.kr(nxt, kon, ntn);
        const char* nA = has_next ? (const char*)((g.A2 && nxt.br) ? g.A2 : g.A) + (size_t)nxt.pm * tstepA + kon : cA; const char* nB = has_next ? (const char*)g.Bt + (size_t)nxt.pn * tstepB + kon : cB;
        for (int t = 0; t < ntc; t += 2) {
            const bool last = (t == ntc - 2);
            const char* a1 = cA + (size_t)(t + 1) * kstep;
            const char* a2 = last ? nA : cA + (size_t)(t + 2) * kstep; const char* b2 = last ? nB : cB + (size_t)(t + 2) * kstep;
            const char* a3 = a2 + kstep; const char* b3 = b2 + kstep;
            PG8_LDB(B0, 0, 0); PG8_SCHED; PG8_LDA(At, 0, 0); PG8_STAGE(PG8_SA(1, 1), a1 + hstepA, voffA);
            PG8_WAIT_L(8); PG8_BAR; PG8_WAIT_L(0); PG8_MMA(0, 0, At, B0); PG8_BAR; PG8_SCHED;
            PG8_LDB(B1, 0, 1); PG8_STAGE(PG8_SB(0, 0), b2, voffB);
            PG8_BAR; PG8_WAIT_L(0); PG8_MMA(0, 1, At, B1); PG8_BAR;
            PG8_LDA(At, 0, 1); PG8_STAGE(PG8_SA(0, 0), a2, voffA);
            PG8_BAR; PG8_WAIT_L(0); PG8_MMA(1, 0, At, B0); PG8_BAR; PG8_SCHED;
            PG8_STAGE(PG8_SB(0, 1), b2 + hstepB, voffB);
            PG8_WAIT_V(6); PG8_BAR; PG8_MMA(1, 1, At, B1); PG8_BAR;
            PG8_LDB(B0, 1, 0); PG8_SCHED; PG8_LDA(At, 1, 0); PG8_STAGE(PG8_SA(0, 1), a2 + hstepA, voffA);
            PG8_WAIT_L(8); PG8_BAR; PG8_WAIT_L(0); PG8_MMA(0, 0, At, B0); PG8_BAR; PG8_SCHED;
            PG8_LDB(B1, 1, 1); PG8_STAGE(PG8_SB(1, 0), b3, voffB);
            PG8_BAR; PG8_WAIT_L(0); PG8_MMA(0, 1, At, B1); PG8_BAR;
            PG8_LDA(At, 1, 1); PG8_STAGE(PG8_SA(1, 0), a3, voffA);
            PG8_BAR; PG8_WAIT_L(0); PG8_MMA(1, 0, At, B0); PG8_BAR; PG8_SCHED;
            PG8_STAGE(PG8_SB(1, 1), b3 + hstepB, voffB);
            PG8_WAIT_V(6); PG8_BAR; PG8_MMA(1, 1, At, B1); PG8_BAR;
        }
        E(acc, cur, wr, wc, fr, fq);
        if (!has_next) break;
#pragma unroll
        for (int a = 0; a < 2; ++a)
#pragma unroll
            for (int b = 0; b < 2; ++b)
#pragma unroll
                for (int m = 0; m < 4; ++m)
#pragma unroll
                    for (int n = 0; n < 2; ++n) acc[a][b][m][n] = (f32x4){0.f, 0.f, 0.f, 0.f};
        cur = nxt; cA = nA; cB = nB; ntc = ntn; ++ui;
    }
    PG8_WAIT_V(0);
    if (wr == 0) PG8_BAR;
    PG8_BAR;
#undef PG8_SA
#undef PG8_SB
#undef PG8_STAGE
#undef PG8_LDA
#undef PG8_LDB
#undef PG8_MMA
#undef PG8_WAIT_V
#undef PG8_WAIT_L
#undef PG8_BAR
#undef PG8_SCHED
}

struct EpiBf {
    bf16_t* O; int ldc; bf16_t* O2;
    __device__ __forceinline__ void operator()(const f32x4 (&acc)[2][2][4][2], const Unit& u, int wr, int wc, int fr, int fq) const {
        const int row0 = u.pm * BM + wr * 64 + fr, col0 = u.pn * BM + wc * 32 + 4 * fq;
        bf16_t* O = u.br ? this->O2 : this->O;
#pragma unroll
        for (int ai = 0; ai < 2; ++ai)
#pragma unroll
            for (int m = 0; m < 4; ++m) { bf16_t* rowp = O + (size_t)(row0 + ai * HALF + m * 16) * ldc + col0;
#pragma unroll
                for (int bj = 0; bj < 2; ++bj)
#pragma unroll
                    for (int n = 0; n < 2; ++n) { const f32x4 v = acc[ai][bj][m][n]; u32x2 o; o.x = cvt_pk_bf16(v[0], v[1]); o.y = cvt_pk_bf16(v[2], v[3]); *(u32x2*)(rowp + bj * HALF + n * 16) = o; } }
    }
};
struct EpiSigBf {
    bf16_t* O; int ldc;
    __device__ __forceinline__ void operator()(const f32x4 (&acc)[2][2][4][2], const Unit& u, int wr, int wc, int fr, int fq) const {
        const int row0 = u.pm * BM + wr * 64 + fr, col0 = u.pn * BM + wc * 32 + 4 * fq;
#pragma unroll
        for (int ai = 0; ai < 2; ++ai)
#pragma unroll
            for (int m = 0; m < 4; ++m) { bf16_t* rowp = O + (size_t)(row0 + ai * HALF + m * 16) * ldc + col0;
#pragma unroll
                for (int bj = 0; bj < 2; ++bj)
#pragma unroll
                    for (int n = 0; n < 2; ++n) { const f32x4 v = acc[ai][bj][m][n]; u32x2 o; o.x = cvt_pk_bf16(sigm(v[0]), sigm(v[1])); o.y = cvt_pk_bf16(sigm(v[2]), sigm(v[3])); *(u32x2*)(rowp + bj * HALF + n * 16) = o; } }
    }
};
struct EpiF32 {
    float* C; int ldc; float* C2;
    __device__ __forceinline__ void operator()(const f32x4 (&acc)[2][2][4][2], const Unit& u, int wr, int wc, int fr, int fq) const {
        const int row0 = u.pm * BM + wr * 64 + fr, col0 = u.pn * BM + wc * 32 + 4 * fq;
        float* C = u.br ? this->C2 : this->C;
#pragma unroll
        for (int ai = 0; ai < 2; ++ai)
#pragma unroll
            for (int m = 0; m < 4; ++m) { float* rowp = C + (size_t)(row0 + ai * HALF + m * 16) * ldc + col0;
#pragma unroll
                for (int bj = 0; bj < 2; ++bj)
#pragma unroll
                    for (int n = 0; n < 2; ++n) *(f32x4*)(rowp + bj * HALF + n * 16) = acc[ai][bj][m][n]; }
    }
};
struct EpiGlu {
    bf16_t* Y; const bf16_t* Z; gfp_t bias;
    __device__ __forceinline__ void operator()(const f32x4 (&acc)[2][2][4][2], const Unit& u, int wr, int wc, int fr, int fq) const {
        const int row0 = u.pm * BM + wr * 64 + fr, col0 = u.pn * BM + wc * 32 + 4 * fq;
#pragma unroll
        for (int ai = 0; ai < 2; ++ai)
#pragma unroll
            for (int m = 0; m < 4; ++m) { const size_t r = (size_t)(row0 + ai * HALF + m * 16);
#pragma unroll
                for (int bj = 0; bj < 2; ++bj)
#pragma unroll
                    for (int n = 0; n < 2; ++n) { const int c = col0 + bj * HALF + n * 16; const f32x4 v = acc[ai][bj][m][n];
                        const u32x2 zz = *(const u32x2*)(Z + r * 768 + c); const f32x4 bb = *(const f32x4*)(bias + c);
                        const float z0 = __uint_as_float(zz.x << 16), z1 = __uint_as_float(zz.x & 0xffff0000u), z2 = __uint_as_float(zz.y << 16), z3 = __uint_as_float(zz.y & 0xffff0000u);
                        u32x2 o; o.x = cvt_pk_bf16(z0 * sigm(v[0] + bb[0]), z1 * sigm(v[1] + bb[1])); o.y = cvt_pk_bf16(z2 * sigm(v[2] + bb[2]), z3 * sigm(v[3] + bb[3]));
                        *(u32x2*)(Y + r * LDY + c) = o; } }
    }
};
struct EpiBranch {
    const bf16_t* Zg; bf16_t* Mo; bf16_t* Mo2;
    __device__ __forceinline__ void operator()(const f32x4 (&acc)[2][2][4][2], const Unit& u, int wr, int wc, int fr, int fq) const {
        const int row0 = u.pm * BM + wr * 64 + fr, col0 = u.pn * BM + wc * 32 + 4 * fq; const int br = u.br & 3; bf16_t* Mo = (u.br >> 2) ? this->Mo2 : this->Mo;
#pragma unroll
        for (int ai = 0; ai < 2; ++ai)
#pragma unroll
            for (int m = 0; m < 4; ++m) { const size_t r = (size_t)(row0 + ai * HALF + m * 16);
#pragma unroll
                for (int bj = 0; bj < 2; ++bj)
#pragma unroll
                    for (int n = 0; n < 2; ++n) { const int c = col0 + bj * HALF + n * 16; const f32x4 v = acc[ai][bj][m][n];
                        const u32x2 gg = *(const u32x2*)(Zg + r * DIN + br * 1024 + c);
                        f32x4 t; t[0] = v[0] * __uint_as_float(gg.x << 16); t[1] = v[1] * __uint_as_float(gg.x & 0xffff0000u);
                        t[2] = v[2] * __uint_as_float(gg.y << 16); t[3] = v[3] * __uint_as_float(gg.y & 0xffff0000u);
                        bf16_t* mp = Mo + r * DM + c;
                        if (br != 0) { const u32x2 p = *(const u32x2*)mp; t[0] += __uint_as_float(p.x << 16); t[1] += __uint_as_float(p.x & 0xffff0000u); t[2] += __uint_as_float(p.y << 16); t[3] += __uint_as_float(p.y & 0xffff0000u); }
                        u32x2 o; o.x = cvt_pk_bf16(t[0], t[1]); o.y = cvt_pk_bf16(t[2], t[3]); *(u32x2*)mp = o; } }
    }
};

#ifndef GEMM_SIMPLE
#define GEMM_SIMPLE 0
#endif
template <class Epi, class SchedT>
__device__ __forceinline__ void gemm_simple(LAS unsigned char* lds, const Gemm g, const SchedT& S, const Epi& E) {
    const int tid = otid(), wid = __builtin_amdgcn_readfirstlane(tid >> 6), lane = tid & 63, wr = wid >> 2, wc = wid & 3, fr = lane & 15, fq = lane >> 4;
    unsigned voffA[2], voffB[2];
#pragma unroll
    for (int i = 0; i < 2; ++i) { int R, C; stage_rc(tid * 16 + i * 8192, R, C);
        voffA[i] = (unsigned)(R * g.lda + C) * 2u; voffB[i] = (unsigned)(R * g.ldb + C) * 2u; }
    const size_t hstepA = (size_t)HALF * g.lda * 2, hstepB = (size_t)HALF * g.ldb * 2;
    const int aoff = lds_byte(wr * 64 + fr, fq * 8), boff = lds_byte(wc * 32 + fr, fq * 8);
    Unit cur;
    for (int ui = 0; S.next(ui, cur); ++ui) {
        size_t koc; int ntc; S.kr(cur, koc, ntc);
        const char* cA = (const char*)((g.A2 && cur.br) ? g.A2 : g.A) + (size_t)cur.pm * 2 * hstepA + koc; const char* cB = (const char*)g.Bt + (size_t)cur.pn * 2 * hstepB + koc;
        f32x4 acc[2][2][4][2];
#pragma unroll
        for (int a = 0; a < 2; ++a)
#pragma unroll
            for (int b = 0; b < 2; ++b)
#pragma unroll
                for (int m = 0; m < 4; ++m)
#pragma unroll
                    for (int n = 0; n < 2; ++n) acc[a][b][m][n] = (f32x4){0.f, 0.f, 0.f, 0.f};
        for (int t = 0; t < ntc; ++t) {
            u32x4 ra[2][2], rb[2][2];
#pragma unroll
            for (int h = 0; h < 2; ++h)
#pragma unroll
                for (int i = 0; i < 2; ++i) { ra[h][i] = *(const u32x4*)(cA + (size_t)t * 128 + h * hstepA + voffA[i]); rb[h][i] = *(const u32x4*)(cB + (size_t)t * 128 + h * hstepB + voffB[i]); }
            __syncthreads();
#pragma unroll
            for (int h = 0; h < 2; ++h)
#pragma unroll
                for (int i = 0; i < 2; ++i) { *(LAS u32x4*)(lds + h * HTB + tid * 16 + i * 8192) = ra[h][i]; *(LAS u32x4*)(lds + (4 + h) * HTB + tid * 16 + i * 8192) = rb[h][i]; }
            __syncthreads();
#pragma unroll
            for (int ai = 0; ai < 2; ++ai) {
                bf16x8 At[4][2];
#pragma unroll
                for (int m = 0; m < 4; ++m)
#pragma unroll
                    for (int k = 0; k < 2; ++k) At[m][k] = *(const LAS bf16x8*)(lds + ai * HTB + aoff + m * 2048 + k * 1024);
#pragma unroll
                for (int bj = 0; bj < 2; ++bj) {
                    bf16x8 Bf[2][2];
#pragma unroll
                    for (int n = 0; n < 2; ++n)
#pragma unroll
                        for (int k = 0; k < 2; ++k) Bf[n][k] = *(const LAS bf16x8*)(lds + (4 + bj) * HTB + boff + n * 2048 + k * 1024);
#pragma unroll
                    for (int m = 0; m < 4; ++m)
#pragma unroll
                        for (int n = 0; n < 2; ++n)
#pragma unroll
                            for (int k = 0; k < 2; ++k) acc[ai][bj][m][n] = __builtin_amdgcn_mfma_f32_16x16x32_bf16(Bf[n][k], At[m][k], acc[ai][bj][m][n], 0, 0, 0);
                }
            }
        }
        E(acc, cur, wr, wc, fr, fq);
    }
    __syncthreads();
}
template <class Epi, class SchedT>
__device__ __forceinline__ void gemm_run(LAS unsigned char* lds, const Gemm g, const SchedT& S, const Epi& E) {
#if GEMM_SIMPLE
    gemm_simple(lds, g, S, E);
#else
    gemm_phase(lds, g, S, E);
#endif
}
}

__device__ __forceinline__ void transpose_tile(gfp_t W, int N, bf16_t* __restrict__ dst, int ldd, int koff, int tk, int tn, float* tile) {
    const int tid = otid(), a = tid >> 6, bq = tid & 63;
    __syncthreads();
#pragma unroll
    for (int i = 0; i < 8; ++i) { const int k = a + 8 * i; tile[k * 65 + bq] = W[(size_t)(tk * 64 + k) * N + tn * 64 + bq]; }
    __syncthreads();
#pragma unroll
    for (int i = 0; i < 8; ++i) { const int n = a + 8 * i; dst[(size_t)(tn * 64 + n) * ldd + koff + tk * 64 + bq] = f2bf(tile[bq * 65 + n]); }
}

__device__ __forceinline__ f32x4 ldx4(const bf16_t* p) { const u32x2 v = *(const u32x2*)p; f32x4 r; r[0] = __uint_as_float(v.x << 16); r[1] = __uint_as_float(v.x & 0xffff0000u); r[2] = __uint_as_float(v.y << 16); r[3] = __uint_as_float(v.y & 0xffff0000u); return r; }
__device__ __forceinline__ void stx4(bf16_t* p, const f32x4 v) { u32x2 o; o.x = pk2(v[0], v[1]); o.y = pk2(v[2], v[3]); *(u32x2*)p = o; }
__device__ __forceinline__ float row16_sum(float v) {
    v += __builtin_bit_cast(float, __builtin_amdgcn_update_dpp(0, __builtin_bit_cast(int, v), 0xB1, 0xF, 0xF, true));
    v += __builtin_bit_cast(float, __builtin_amdgcn_update_dpp(0, __builtin_bit_cast(int, v), 0x4E, 0xF, 0xF, true));
    v += __builtin_bit_cast(float, __builtin_amdgcn_update_dpp(0, __builtin_bit_cast(int, v), 0x141, 0xF, 0xF, true));
    v += __builtin_bit_cast(float, __builtin_amdgcn_update_dpp(0, __builtin_bit_cast(int, v), 0x140, 0xF, 0xF, true));
    return v;
}
__device__ __forceinline__ float wave_sum(float v) {
    v = row16_sum(v);
    const int iv = __builtin_bit_cast(int, v);
    const float a = __builtin_bit_cast(float, __builtin_amdgcn_readlane(iv, 0)), b = __builtin_bit_cast(float, __builtin_amdgcn_readlane(iv, 16));
    const float c = __builtin_bit_cast(float, __builtin_amdgcn_readlane(iv, 32)), d = __builtin_bit_cast(float, __builtin_amdgcn_readlane(iv, 48));
    return (a + b) + (c + d);
}
__device__ __forceinline__ void rms_store_r(const f32x4 (&xv)[4], const f32x4 (&gr)[4], bf16_t* dst, int lane) {
    float ss = 0.f;
#pragma unroll
    for (int i = 0; i < 4; ++i) ss += xv[i][0] * xv[i][0] + xv[i][1] * xv[i][1] + xv[i][2] * xv[i][2] + xv[i][3] * xv[i][3];
    ss = wave_sum(ss);
    const float rs = rsqrtf(ss * (1.0f / DM) + EPS);
#pragma unroll
    for (int i = 0; i < 4; ++i) { const int c = lane * 4 + 256 * i; const f32x4 hv = xv[i] * gr[i] * rs;
        u32x2 o; o.x = pk2(hv[0], hv[1]); o.y = pk2(hv[2], hv[3]); *(u32x2*)(dst + c) = o; }
}
__device__ __forceinline__ void rms_store(const f32x4 (&xv)[4], gfp_t g, bf16_t* dst, int lane) {
    float ss = 0.f;
#pragma unroll
    for (int i = 0; i < 4; ++i) ss += xv[i][0] * xv[i][0] + xv[i][1] * xv[i][1] + xv[i][2] * xv[i][2] + xv[i][3] * xv[i][3];
    ss = wave_sum(ss);
    const float rs = rsqrtf(ss * (1.0f / DM) + EPS);
#pragma unroll
    for (int i = 0; i < 4; ++i) { const int c = lane * 4 + 256 * i; const f32x4 gn = *(const f32x4*)(g + c); const f32x4 hv = xv[i] * gn * rs;
        u32x2 o; o.x = pk2(hv[0], hv[1]); o.y = pk2(hv[2], hv[3]); *(u32x2*)(dst + c) = o; }
}
__device__ __forceinline__ void norm_rows(const Params& P, int mode, int l, int grp, const unsigned char* smem) {
    const int tid_ = otid(); const int wid = tid_ >> 6, lane = tid_ & 63;
    bf16_t* __restrict__ X = (bf16_t*)(P.ws + A_X);
    const int gw = blockIdx.x * 8 + wid, nw = gridDim.x * 8;
    if (mode == 0) {
        gfp_t g0p = INP(I_GPREMIX); bf16_t* H = (bf16_t*)(P.ws + R_H);
        for (int row = gw; row < TPAD; row += nw) {
            f32x4 xv[4];
            if (row >= TT) {
#pragma unroll
                for (int i = 0; i < 4; ++i) xv[i] = (f32x4){0.f, 0.f, 0.f, 0.f};
            } else {
                const bool isP = row < TPR; int b = 0, t = 0; if (isP) { b = row / LP; t = row - b * LP; }
                gfp_t src = isP ? (t < 16 ? INP(I_META) + (size_t)t * DM : INP(I_XP) + ((size_t)b * SEQ + (t - 16)) * DM) : INP(I_XS) + (size_t)(row - TPR) * DM;
#pragma unroll
                for (int i = 0; i < 4; ++i) xv[i] = *(const f32x4*)(src + lane * 4 + 256 * i);
            }
#pragma unroll
            for (int i = 0; i < 4; ++i) stx4(X + (size_t)row * DM + lane * 4 + 256 * i, xv[i]);
            if (row < 6192) rms_store(xv, g0p, H + (size_t)row * DM, lane);
        }
        return;
    }
    const Grp G = get_grp(grp);
    const bf16_t* __restrict__ F = (const bf16_t*)(P.ws + R_F) - (size_t)G.g0 * DM;
    const bf16_t* __restrict__ F2 = (const bf16_t*)(P.ws + R_UP) - (size_t)G.g0 * DM;
    bf16_t* __restrict__ H = (bf16_t*)(P.ws + R_H) - (size_t)G.g0 * DM;
    const bool fin = (mode == 2 && l == 1);
    gfp_t gpost = (mode == 1 ? INP(I_GPOSTMIX) : INP(I_GPOSTFFN)) + l * DM;
    gfp_t gffn = INP(I_GPREFFN) + l * DM;
    f32x4 gpr[4], gfr[4];
#pragma unroll
    for (int i = 0; i < 4; ++i) { gpr[i] = *(const f32x4*)(gpost + lane * 4 + 256 * i); gfr[i] = *(const f32x4*)(gffn + lane * 4 + 256 * i); }
#pragma unroll 2
    for (int row = G.g0 + gw; row < G.g0 + G.nrows; row += nw) {
        f32x4 xv[4], fv[4]; float ss = 0.f;
#pragma unroll
        for (int i = 0; i < 4; ++i) { const int c = lane * 4 + 256 * i; xv[i] = ldx4(X + (size_t)row * DM + c);
            { const u32x2 fa = *(const u32x2*)(F + (size_t)row * DM + c), fb = *(const u32x2*)(F2 + (size_t)row * DM + c);
              fv[i][0] = __uint_as_float(fa.x << 16) + __uint_as_float(fb.x << 16); fv[i][1] = __uint_as_float(fa.x & 0xffff0000u) + __uint_as_float(fb.x & 0xffff0000u);
              fv[i][2] = __uint_as_float(fa.y << 16) + __uint_as_float(fb.y << 16); fv[i][3] = __uint_as_float(fa.y & 0xffff0000u) + __uint_as_float(fb.y & 0xffff0000u); }
            ss += fv[i][0] * fv[i][0] + fv[i][1] * fv[i][1] + fv[i][2] * fv[i][2] + fv[i][3] * fv[i][3]; }
        ss = wave_sum(ss);
        const float rs = rsqrtf(ss * (1.0f / DM) + EPS);
#pragma unroll
        for (int i = 0; i < 4; ++i) xv[i] = xv[i] + fv[i] * gpr[i] * rs;
        if (fin) {
            float* dst = nullptr;
            if (row < TPR) { const int b = row / LP, t = row - b * LP; if (t >= 16 && ((OUTMASK >> 0) & 1)) dst = P.out + O_YP + ((size_t)b * SEQ + (t - 16)) * DM; }
            else if ((OUTMASK >> 1) & 1) dst = P.out + O_YS + (size_t)(row - TPR) * DM;
            if (dst) {
#pragma unroll
                for (int i = 0; i < 4; ++i) *(f32x4*)(dst + lane * 4 + 256 * i) = xv[i];
            }
        } else {
#pragma unroll
            for (int i = 0; i < 4; ++i) stx4(X + (size_t)row * DM + lane * 4 + 256 * i, xv[i]);
        }
        if (mode == 1) rms_store_r(xv, gfr, H + (size_t)row * DM, lane);
    }
}

__device__ __forceinline__ void next_h_rows(const Params& P, int l, int grp, int gw, int nw, const unsigned char* smem) {
    int nl = l, ng = grp + 1; if (ng == NGRP) { ng = 0; nl = l + 1; }
    if (nl >= 2) return;
    const int tid_ = otid(); const int lane = tid_ & 63;
    const bf16_t* __restrict__ X = (const bf16_t*)(P.ws + A_X);
    const Grp N = get_grp(ng); gfp_t gn = INP(I_GPREMIX) + nl * DM; bf16_t* __restrict__ Hn = (bf16_t*)(P.ws + R_H) - (size_t)N.g0 * DM;
    f32x4 gnr[4];
#pragma unroll
    for (int i = 0; i < 4; ++i) gnr[i] = *(const f32x4*)(gn + lane * 4 + 256 * i);
#pragma unroll 2
    for (int row = N.g0 + gw; row < N.g0 + N.nrows; row += nw) {
        f32x4 xv[4];
#pragma unroll
        for (int i = 0; i < 4; ++i) xv[i] = ldx4(X + (size_t)row * DM + lane * 4 + 256 * i);
        rms_store_r(xv, gnr, Hn + (size_t)row * DM, lane);
    }
}

__device__ __forceinline__ void phase0(const Params& P, unsigned char* smem) {
    float* tile = (float*)smem;
    constexpr int C0 = 2112, C1 = C0 + 144, C2 = C1 + 192, C3 = C2 + 192, C4 = C3 + 256, C5 = C4 + 256, C6 = C5 + 1408, C7 = C6 + 704;
    for (int id = blockIdx.x; id < 2 * C7; id += gridDim.x) {
        const int l = id / C7; int j = id - l * C7;
        gfp_t W; int N, ldd, koff = 0; bf16_t* dst;
        if (j < C0) { W = INP(I_WIN) + (size_t)l * DM * DIN; N = DIN; dst = (bf16_t*)(P.ws + W_IN) + (size_t)l * DIN * DM; ldd = DM; }
        else if (j < C1) { j -= C0; W = INP(I_WGLU) + (size_t)l * 768 * 768; N = 768; dst = (bf16_t*)(P.ws + W_GLU) + (size_t)l * 768 * 768; ldd = 768; }
        else if (j < C2) { j -= C1; W = INP(I_WBA) + (size_t)l * 768 * DM; N = DM; dst = (bf16_t*)(P.ws + W_BR) + (size_t)l * DM * LDY; ldd = LDY; }
        else if (j < C3) { j -= C2; W = INP(I_WBB) + (size_t)l * 768 * DM; N = DM; dst = (bf16_t*)(P.ws + W_BR) + (size_t)l * DM * LDY; ldd = LDY; koff = 768; }
        else if (j < C4) { j -= C3; W = INP(I_WBC) + (size_t)l * DM * DM; N = DM; dst = (bf16_t*)(P.ws + W_BR) + (size_t)l * DM * LDY; ldd = LDY; koff = 1536; }
        else if (j < C5) { j -= C4; W = INP(I_WOUT) + (size_t)l * DM * DM; N = DM; dst = (bf16_t*)(P.ws + W_OUT) + (size_t)l * DM * DM; ldd = DM; }
        else if (j < C6) { j -= C5; W = INP(I_WUP) + (size_t)l * DM * 2 * DFF; N = 2 * DFF; dst = (bf16_t*)(P.ws + W_UP) + (size_t)l * 2 * DFF * DM; ldd = DM; }
        else { j -= C6; W = INP(I_WDOWN) + (size_t)l * DFF * DM; N = DM; dst = (bf16_t*)(P.ws + W_DOWN) + (size_t)l * DM * DFF; ldd = DFF; }
        const int ntn = N / 64; const int tk = j / ntn, tn = j - tk * ntn;
        transpose_tile(W, N, dst, ldd, koff, tk, tn, tile);
    }
    norm_rows(P, 0, 0, 0, smem);
    float* rt = (float*)(P.ws + A_ROPE);
    for (int i = blockIdx.x * 512 + threadIdx.x; i < 2068 * 32; i += gridDim.x * 512) {
        const int pi = i >> 5, fi = i & 31; const double pos = pi < LP ? (double)pi : (double)(16384 + pi - LP);
        const double inv = exp(-(double)fi * (9.210340371976184 / 32.0));
        double ang = pos * inv; const double k = rint(ang * 0.15915494309189535); ang = ang - k * 6.283185307179586;
        const float af = (float)ang; rt[2 * i] = cosf(af); rt[2 * i + 1] = sinf(af);
    }
    if (blockIdx.x == 0 && threadIdx.x < 64) ((unsigned*)(P.ws + A_CTR))[threadIdx.x] = 0u;
}

__device__ __forceinline__ void ld8(const bf16_t* p, float (&d)[8]) {
    const u32x4 v = *(const u32x4*)p;
#pragma unroll
    for (int i = 0; i < 4; ++i) { d[2 * i] = __uint_as_float(v[i] << 16); d[2 * i + 1] = __uint_as_float(v[i] & 0xffff0000u); }
}
__device__ __forceinline__ void ffn_conv_phase(const Params& P, int l, int grp, const unsigned char* smem) {
    const Grp G = get_grp(grp);
    const bf16_t* __restrict__ UP = (const bf16_t*)(P.ws + R_UP) - (size_t)G.g0 * (2 * DFF); bf16_t* __restrict__ FIN = (bf16_t*)(P.ws + R_FIN) - (size_t)G.g0 * DFF;
    gfp_t cw = INP(I_FCW) + (size_t)l * 3 * DFF; gfp_t cb = INP(I_FCB) + (size_t)l * DFF;
    gfp_t cache = INP(I_FFNC) + (size_t)l * DEC_B * 2 * DFF;
    constexpr int NCG = DFF / 8;
    const int RL = grp < 2 ? 6 : 8;
    const int nrun = G.nrows / RL;
    for (int it = blockIdx.x * 512 + threadIdx.x; it < nrun * NCG; it += gridDim.x * 512) {
        const int ck = it / NCG, c = (it - ck * NCG) * 8, row0 = G.g0 + ck * RL;
        float w0[8], w1[8], w2[8], bs[8];
#pragma unroll
        for (int i = 0; i < 8; ++i) { bs[i] = cb[c + i]; w0[i] = cw[c + i]; w1[i] = cw[DFF + c + i]; w2[i] = cw[2 * DFF + c + i]; }
        float g1[8], g2[8];
#pragma unroll
        for (int r = 0; r < 8; ++r) {
            if (r >= RL) break;
            const int row = row0 + r;
            int b, t, L; const bool isP = row < TPR;
            if (isP) { b = row / LP; t = row - b * LP; L = LP; } else { b = (row - TPR) >> 2; t = (row - TPR) & 3; L = 4; }
            float g0[8], uf[8];
            ld8(UP + (size_t)row * (2 * DFF) + c, g0); ld8(UP + (size_t)row * (2 * DFF) + DFF + c, uf);
            if (r == 0) {
                if (t >= 1) ld8(UP + (size_t)(row - 1) * (2 * DFF) + c, g1);
                else {
#pragma unroll
                    for (int i = 0; i < 8; ++i) g1[i] = isP ? 0.f : cache[((size_t)b * 2 + 1) * DFF + c + i]; }
                if (t >= 2) ld8(UP + (size_t)(row - 2) * (2 * DFF) + c, g2);
                else {
#pragma unroll
                    for (int i = 0; i < 8; ++i) g2[i] = isP ? 0.f : cache[((size_t)b * 2 + t) * DFF + c + i]; }
            } else if (t == 0) {
#pragma unroll
                for (int i = 0; i < 8; ++i) { g1[i] = isP ? 0.f : cache[((size_t)b * 2 + 1) * DFF + c + i]; g2[i] = isP ? 0.f : cache[((size_t)b * 2) * DFF + c + i]; }
            } else if (t == 1) {
#pragma unroll
                for (int i = 0; i < 8; ++i) g2[i] = isP ? 0.f : cache[((size_t)b * 2 + 1) * DFF + c + i];
            }
            float o[8];
#pragma unroll
            for (int i = 0; i < 8; ++i) { const float gc = bs[i] + w0[i] * g2[i] + w1[i] * g1[i] + w2[i] * g0[i]; o[i] = gelu_t(gc) * uf[i]; }
            u32x4 ov; ov[0] = pk2(o[0], o[1]); ov[1] = pk2(o[2], o[3]); ov[2] = pk2(o[4], o[5]); ov[3] = pk2(o[6], o[7]);
            *(u32x4*)(FIN + (size_t)row * DFF + c) = ov;
            if (t >= L - 2) {
                float* dst = isP ? P.out + O_P_FFNC + (((size_t)l * NB + b) * 2 + (t - (L - 2))) * DFF + c : P.out + O_S_FFNC + (((size_t)l * DEC_B + b) * 2 + (t - (L - 2))) * DFF + c;
#pragma unroll
                for (int i = 0; i < 8; ++i) dst[i] = g0[i];
            }
#pragma unroll
            for (int i = 0; i < 8; ++i) { g2[i] = g1[i]; g1[i] = g0[i]; }
        }
    }
}

__device__ __forceinline__ void ret_job(const Params& P, int l, int grp, int b, int h, int g0, unsigned char* smem) {
    const int tid = otid(), w = __builtin_amdgcn_readfirstlane(tid >> 6), lane = tid & 63, fr = lane & 15, fq = lane >> 4;
    bf16_t* sQ = (bf16_t*)smem;
    bf16_t* sK = sQ + 128 * 72;
    bf16_t* sKdT = sK + 128 * 72;
    bf16_t* sVT = sKdT + 64 * 136;
    bf16_t* sST = sVT + 128 * 136;
    bf16_t* sP = sST + 128 * 72 + w * 16 * 136;
    const bf16_t* Z = (const bf16_t*)(P.ws + R_Z) - (size_t)g0 * DIN; bf16_t* Y = (bf16_t*)(P.ws + R_Y) - (size_t)g0 * LDY;
    const float* rope = (const float*)(P.ws + A_ROPE);
    const int L = grp ? 4 : LP, rowb = grp ? TPR + b * 4 : b * LP, tabb = grp ? LP : 0;
    const float lg = log1pf(-exp2f(-5.0f - (float)h));
    gfp_t ng = INP(I_RNG) + (size_t)l * 1024 + h * 128;
    float ngv[8];
#pragma unroll
    for (int et = 0; et < 8; ++et) ngv[et] = ng[16 * et + fr];
    f32x4 accS[4];
    float* Sout = P.out + (grp ? O_S_RET + (((size_t)l * DEC_B + b) * 8 + h) * 8192 : O_P_RET + (((size_t)l * NB + b) * 8 + h) * 8192);
    if (grp) { gfp_t S0 = INP(I_RET) + (((size_t)l * DEC_B + b) * 8 + h) * 8192;
#pragma unroll
        for (int dt = 0; dt < 4; ++dt)
#pragma unroll
            for (int j = 0; j < 4; ++j) accS[dt][j] = S0[(16 * dt + 4 * fq + j) * 128 + 16 * w + fr];
    } else {
#pragma unroll
        for (int dt = 0; dt < 4; ++dt) accS[dt] = (f32x4){0.f, 0.f, 0.f, 0.f};
    }
    __syncthreads();
#pragma unroll
    for (int dt = 0; dt < 4; ++dt) { u32x2 o; o.x = pk2(accS[dt][0], accS[dt][1]); o.y = pk2(accS[dt][2], accS[dt][3]); *(u32x2*)(sST + (16 * w + fr) * 72 + 16 * dt + 4 * fq) = o; }
    const int nch = grp ? 1 : 17;
    u32x4 q1 = {0u, 0u, 0u, 0u}, q2 = q1, k1 = q1, k2 = q1, vv[4];
#define RET_LOAD(ckx) do { const int _t0 = grp ? 0 : ((ckx) == 0 ? 0 : 16 + ((ckx) - 1) * 128), _C = grp ? 4 : ((ckx) == 0 ? 16 : 128); \
        const int _m = tid >> 2, _i0 = (tid & 3) * 8, _m2 = tid & 127, _e0 = (tid >> 7) * 32; \
        q1 = (u32x4){0u, 0u, 0u, 0u}; q2 = q1; k1 = q1; k2 = q1; \
        if (_m < _C) { const size_t _zr = (size_t)(rowb + _t0 + _m) * DIN; \
            q1 = *(const u32x4*)(Z + _zr + ZO_Q + h * 64 + _i0); q2 = *(const u32x4*)(Z + _zr + ZO_Q + h * 64 + 32 + _i0); \
            k1 = *(const u32x4*)(Z + _zr + ZO_K + h * 64 + _i0); k2 = *(const u32x4*)(Z + _zr + ZO_K + h * 64 + 32 + _i0); } \
        _Pragma("unroll") for (int _i = 0; _i < 4; ++_i) vv[_i] = (u32x4){0u, 0u, 0u, 0u}; \
        if (_m2 < _C) { const bf16_t* _vp = Z + (size_t)(rowb + _t0 + _m2) * DIN + ZO_V + h * 128 + _e0; \
            _Pragma("unroll") for (int _i = 0; _i < 4; ++_i) vv[_i] = *(const u32x4*)(_vp + 8 * _i); } } while (0)
    RET_LOAD(0);
    for (int ck = 0; ck < nch; ++ck) {
        const int t0 = grp ? 0 : (ck == 0 ? 0 : 16 + (ck - 1) * 128), C = grp ? 4 : (ck == 0 ? 16 : 128);
        {
            const int m = tid >> 2, i0 = (tid & 3) * 8;
            u32x4 q1w = {0u, 0u, 0u, 0u}, q2w = q1w, k1w = q1w, k2w = q1w;
            float kd1[8], kd2[8];
#pragma unroll
            for (int e = 0; e < 8; ++e) { kd1[e] = 0.f; kd2[e] = 0.f; }
            if (m < C) {
                const float* rp = rope + ((size_t)(tabb + t0 + m) * 32 + i0) * 2;
                const float kdec = __expf(lg * (float)(C - 1 - m));
                float qo1[8], qo2[8], ko1[8], ko2[8];
#pragma unroll
                for (int e = 0; e < 8; ++e) {
                    const float cs = rp[2 * e], sn = rp[2 * e + 1];
                    const unsigned qa = q1[e >> 1], qb = q2[e >> 1], ka = k1[e >> 1], kb = k2[e >> 1];
                    const float x1 = (e & 1) ? __uint_as_float(qa & 0xffff0000u) : __uint_as_float(qa << 16);
                    const float x2 = (e & 1) ? __uint_as_float(qb & 0xffff0000u) : __uint_as_float(qb << 16);
                    const float y1 = ((e & 1) ? __uint_as_float(ka & 0xffff0000u) : __uint_as_float(ka << 16)) * 0.125f;
                    const float y2 = ((e & 1) ? __uint_as_float(kb & 0xffff0000u) : __uint_as_float(kb << 16)) * 0.125f;
                    qo1[e] = x1 * cs - x2 * sn; qo2[e] = x2 * cs + x1 * sn;
                    ko1[e] = y1 * cs - y2 * sn; ko2[e] = y2 * cs + y1 * sn;
                    kd1[e] = ko1[e] * kdec; kd2[e] = ko2[e] * kdec;
                }
#pragma unroll
                for (int e = 0; e < 4; ++e) { q1w[e] = pk2(qo1[2 * e], qo1[2 * e + 1]); q2w[e] = pk2(qo2[2 * e], qo2[2 * e + 1]); k1w[e] = pk2(ko1[2 * e], ko1[2 * e + 1]); k2w[e] = pk2(ko2[2 * e], ko2[2 * e + 1]); }
            }
            *(u32x4*)(sQ + m * 72 + i0) = q1w; *(u32x4*)(sQ + m * 72 + 32 + i0) = q2w;
            *(u32x4*)(sK + m * 72 + i0) = k1w; *(u32x4*)(sK + m * 72 + 32 + i0) = k2w;
#pragma unroll
            for (int e = 0; e < 8; ++e) { sKdT[(i0 + e) * 136 + m] = f2bf(kd1[e]); sKdT[(32 + i0 + e) * 136 + m] = f2bf(kd2[e]); }
            const int m2 = tid & 127, e0 = (tid >> 7) * 32;
#pragma unroll
            for (int i = 0; i < 4; ++i)
#pragma unroll
                for (int e = 0; e < 4; ++e) { sVT[(e0 + 8 * i + 2 * e) * 136 + m2] = (bf16_t)(vv[i][e] & 0xffffu); sVT[(e0 + 8 * i + 2 * e + 1) * 136 + m2] = (bf16_t)(vv[i][e] >> 16); }
        }
        __syncthreads();
        if (ck + 1 < nch) RET_LOAD(ck + 1);
        f32x4 o[8];
        const bool act = (16 * w < C);
        unsigned gcp[4][4];
        if (act) {
#pragma unroll
            for (int j = 0; j < 4; ++j) { const int n = 16 * w + 4 * fq + j; const size_t row = (size_t)(rowb + t0 + (n < C ? n : 0));
#pragma unroll
                for (int e2 = 0; e2 < 4; ++e2) { const bf16_t lo = Z[row * DIN + ZO_GC + h * 128 + 32 * e2 + fr], hi = Z[row * DIN + ZO_GC + h * 128 + 32 * e2 + 16 + fr]; gcp[e2][j] = (unsigned)lo | ((unsigned)hi << 16); } }
        }
        if (act) {
            bf16x8 qf[2];
#pragma unroll
            for (int ks = 0; ks < 2; ++ks) qf[ks] = *(const bf16x8*)(sQ + (16 * w + fr) * 72 + 32 * ks + 8 * fq);
            const int mtN = (w | 1) + 1;
            for (int mt = 0; mt < mtN; ++mt) {
                f32x4 a = {0.f, 0.f, 0.f, 0.f};
#pragma unroll
                for (int ks = 0; ks < 2; ++ks) { const bf16x8 kf = *(const bf16x8*)(sK + (16 * mt + fr) * 72 + 32 * ks + 8 * fq); a = mfma16(qf[ks], kf, a); }
                { const int d0 = (16 * w + 4 * fq) - (16 * mt + fr); float e = __expf(lg * (float)d0); const float g1 = __expf(lg);
#pragma unroll
                  for (int j = 0; j < 4; ++j) { const float v = (d0 + j) >= 0 ? a[j] * e : 0.f; sP[(4 * fq + j) * 136 + 16 * mt + fr] = f2bf(v); e *= g1; } }
            }
            lds_wait();
#pragma unroll
            for (int et = 0; et < 8; ++et) o[et] = (f32x4){0.f, 0.f, 0.f, 0.f};
            const int ksN = mtN >> 1;
            for (int ks = 0; ks < ksN; ++ks) {
                const bf16x8 pf = *(const bf16x8*)(sP + fr * 136 + 32 * ks + 8 * fq);
#pragma unroll
                for (int et = 0; et < 8; ++et) { const bf16x8 vf = *(const bf16x8*)(sVT + (16 * et + fr) * 136 + 32 * ks + 8 * fq); o[et] = mfma16(pf, vf, o[et]); }
            }
            f32x4 o2[8];
#pragma unroll
            for (int et = 0; et < 8; ++et) o2[et] = (f32x4){0.f, 0.f, 0.f, 0.f};
#pragma unroll
            for (int ks = 0; ks < 2; ++ks)
#pragma unroll
                for (int et = 0; et < 8; ++et) { const bf16x8 sf = *(const bf16x8*)(sST + (16 * et + fr) * 72 + 32 * ks + 8 * fq); o2[et] = mfma16(qf[ks], sf, o2[et]); }
#pragma unroll
            for (int j = 0; j < 4; ++j) { const float sc = __expf(lg * (float)(16 * w + 4 * fq + j + 1));
#pragma unroll
                for (int et = 0; et < 8; ++et) o[et][j] += o2[et][j] * sc; }
        }
        {
            const float gC = __expf(lg * (float)C);
#pragma unroll
            for (int dt = 0; dt < 4; ++dt) accS[dt] = accS[dt] * gC;
            const int ksN = (C + 31) >> 5;
            for (int ks = 0; ks < ksN; ++ks) {
                const bf16x8 vf = *(const bf16x8*)(sVT + (16 * w + fr) * 136 + 32 * ks + 8 * fq);
#pragma unroll
                for (int dt = 0; dt < 4; ++dt) { const bf16x8 kf = *(const bf16x8*)(sKdT + (16 * dt + fr) * 136 + 32 * ks + 8 * fq); accS[dt] = mfma16(kf, vf, accS[dt]); }
            }
        }
        __syncthreads();
#pragma unroll
        for (int dt = 0; dt < 4; ++dt) { u32x2 ow; ow.x = pk2(accS[dt][0], accS[dt][1]); ow.y = pk2(accS[dt][2], accS[dt][3]); *(u32x2*)(sST + (16 * w + fr) * 72 + 16 * dt + 4 * fq) = ow; }
        if (act) {
#pragma unroll
            for (int j = 0; j < 4; ++j) {
                float s = 0.f;
#pragma unroll
                for (int et = 0; et < 8; ++et) s += o[et][j];
                s = row16_sum(s);
                const float mu = s * (1.0f / 128.0f);
                float s2 = 0.f;
#pragma unroll
                for (int et = 0; et < 8; ++et) { const float d = o[et][j] - mu; s2 += d * d; }
                s2 = row16_sum(s2);
                const float rstd = rsqrtf(s2 * (1.0f / 128.0f) + EPS);
                const int n = 16 * w + 4 * fq + j;
                if (n < C) {
                    const size_t row = (size_t)(rowb + t0 + n);
#pragma unroll
                    for (int et = 0; et < 8; ++et) { const int e = 16 * et + fr; const unsigned gw_ = gcp[et >> 1][j]; const float gcv = (et & 1) ? __uint_as_float(gw_ & 0xffff0000u) : __uint_as_float(gw_ << 16);
                        const float yv = gcv * sigm(gcv) * (o[et][j] - mu) * rstd * ngv[et]; Y[row * LDY + 1536 + h * 128 + e] = f2bf(yv); }
                }
            }
        }
    }
    if (grp ? OUT_ON(12) : OUT_ON(6)) {
#pragma unroll
    for (int dt = 0; dt < 4; ++dt)
#pragma unroll
        for (int j = 0; j < 4; ++j) Sout[(16 * dt + 4 * fq + j) * 128 + 16 * w + fr] = accS[dt][j];
    }
}

__device__ __forceinline__ void lru_job(const Params& P, int l, int grp, int jid, int g0, int pb0, unsigned char* smem) {
    const int tid = otid(), w = __builtin_amdgcn_readfirstlane(tid >> 6), lane = tid & 63, fr = lane & 15, fq = lane >> 4;
    bf16_t* sA = (bf16_t*)(smem + w * 10752);
    float* sRI = (float*)(smem + w * 10752 + 2304);
    float* sComb = (float*)(smem + 8 * 10752);
    const bf16_t* Z = (const bf16_t*)(P.ws + R_Z) - (size_t)g0 * DIN; bf16_t* Y = (bf16_t*)(P.ws + R_Y) - (size_t)g0 * LDY;
    const int unit = grp ? jid * 8 + w : jid;
    const int bl = unit / 12, hb = unit - bl * 12, ch = hb * 64 + lane; const int b = grp ? bl : pb0 + bl;
    const int L = grp ? 4 : LP, rowb = grp ? TPR + b * 4 : b * LP;
    float cw[4];
#pragma unroll
    for (int j = 0; j < 4; ++j) cw[j] = INP(I_LCW)[((size_t)l * 4 + j) * 768 + ch];
    const float cb = INP(I_LCB)[l * 768 + ch], ba = INP(I_LBA)[l * 768 + ch], bx = INP(I_LBX)[l * 768 + ch];
    const float lam = INP(I_LAM)[l * 768 + ch];
    const float sp8 = 8.0f * (fmaxf(-lam, 0.f) + log1pf(__expf(-fabsf(lam))));
    bf16x8 Wa[4][2], Wx[4][2];
    { gfp_t wa = INP(I_LWA) + ((size_t)l * 12 + hb) * 4096; gfp_t wx = INP(I_LWX) + ((size_t)l * 12 + hb) * 4096;
#pragma unroll
      for (int nt = 0; nt < 4; ++nt)
#pragma unroll
          for (int ks = 0; ks < 2; ++ks)
#pragma unroll
              for (int j = 0; j < 8; ++j) { const int k = 32 * ks + 8 * fq + j, n = 16 * nt + fr; Wa[nt][ks][j] = (short)f2bf(wa[k * 64 + n]); Wx[nt][ks][j] = (short)f2bf(wx[k * 64 + n]); } }
    float carry = grp ? INP(I_LRUH)[((size_t)l * DEC_B + b) * 768 + ch] : 0.f;
    gfp_t cache = INP(I_LRUC) + ((size_t)l * DEC_B + b) * 3 * 768;
    const int nIter = grp ? 1 : 17;
    __syncthreads();
#ifndef LRU_REP
#define LRU_REP 1
#endif
    bf16_t xn[19];
    { const int tw0 = grp ? 0 : 16 * w;
#pragma unroll
      for (int i = 0; i < 19; ++i) { int t = tw0 - 3 + i; t = t < 0 ? 0 : (t > L - 1 ? L - 1 : t); xn[i] = Z[(size_t)(rowb + t) * DIN + ZO_XB + ch]; } }
    for (int it_ = 0; it_ < nIter * (grp ? 1 : LRU_REP); ++it_) {
        const int it = it_ % nIter; if (LRU_REP > 1 && it_ == nIter) carry = 0.f;
        const int tw = grp ? 0 : it * 128 + 16 * w;
        float xv[19];
#pragma unroll
        for (int i = 0; i < 19; ++i) { const int t = tw - 3 + i; xv[i] = (t >= 0 && t < L) ? bf2f(xn[i]) : 0.f; }
        if (grp) {
#pragma unroll
            for (int i = 0; i < 3; ++i) xv[i] = cache[i * 768 + ch];
        }
        if (it_ + 1 < nIter * (grp ? 1 : LRU_REP)) {
            const int twn = tw + 128;
#pragma unroll
            for (int i = 0; i < 19; ++i) { int t = twn - 3 + i; t = t < 0 ? 0 : (t > L - 1 ? L - 1 : t); xn[i] = Z[(size_t)(rowb + t) * DIN + ZO_XB + ch]; }
        }
        unsigned gtp[8];
#pragma unroll
        for (int i = 0; i < 8; ++i) { const int ta = tw + 2 * i, tb = ta + 1;
            const bf16_t lo = Z[(size_t)(rowb + (ta < L ? ta : L - 1)) * DIN + ZO_GB + ch], hi = Z[(size_t)(rowb + (tb < L ? tb : L - 1)) * DIN + ZO_GB + ch];
            gtp[i] = (unsigned)lo | ((unsigned)hi << 16); }
        float xc[16];
#pragma unroll
        for (int i = 0; i < 16; ++i) { xc[i] = cb + cw[0] * xv[i] + cw[1] * xv[i + 1] + cw[2] * xv[i + 2] + cw[3] * xv[i + 3]; sA[i * 72 + lane] = f2bf(xc[i]); }
        lds_wait();
        bf16x8 af[2];
#pragma unroll
        for (int ks = 0; ks < 2; ++ks) af[ks] = *(const bf16x8*)(sA + fr * 72 + 32 * ks + 8 * fq);
#pragma unroll
        for (int nt = 0; nt < 4; ++nt) {
            f32x4 ra = {0.f, 0.f, 0.f, 0.f}, rx = ra;
            ra = mfma16(af[0], Wa[nt][0], ra); ra = mfma16(af[1], Wa[nt][1], ra);
            rx = mfma16(af[0], Wx[nt][0], rx); rx = mfma16(af[1], Wx[nt][1], rx);
#pragma unroll
            for (int j = 0; j < 4; ++j) { sRI[(4 * fq + j) * 132 + 16 * nt + fr] = ra[j]; sRI[(4 * fq + j) * 132 + 64 + 16 * nt + fr] = rx[j]; }
        }
        lds_wait();
        float hloc[16], ca[16]; float hl = 0.f, cacc = 1.f;
#pragma unroll
        for (int i = 0; i < 16; ++i) {
            const float rp = sRI[i * 132 + lane], ip = sRI[i * 132 + 64 + lane];
            const float r = sigm(rp + ba), ii = sigm(ip + bx);
            const float la = -sp8 * r; float a = __expf(la);
            const float x2 = 2.0f * la;
            const float ser = -x2 * (1.0f + x2 * (0.5f + x2 * (0.16666667f + x2 * (0.041666668f + x2 * 0.0083333338f))));
            const float om = x2 > -0.25f ? ser : 1.0f - __expf(x2);
            float bv = __builtin_amdgcn_sqrtf(om) * ii * xc[i];
            if (tw + i >= L) { a = 1.f; bv = 0.f; }
            hl = a * hl + bv; cacc *= a; hloc[i] = hl; ca[i] = cacc;
        }
        float hin = carry;
        if (!grp) {
            float* sCb = sComb + (it_ & 1) * 1024;
            sCb[(w * 64 + lane) * 2] = cacc; sCb[(w * 64 + lane) * 2 + 1] = hl;
            __syncthreads();
            float run = carry;
#pragma unroll
            for (int ww = 0; ww < 8; ++ww) { if (ww == w) hin = run; run = sCb[(ww * 64 + lane) * 2] * run + sCb[(ww * 64 + lane) * 2 + 1]; }
            carry = run;
        } else carry = hloc[15] + ca[15] * hin;
#pragma unroll
        for (int i = 0; i < 16; ++i) { const int t = tw + i;
            if (t < L) { const size_t row = (size_t)(rowb + t); const float hh = hloc[i] + ca[i] * hin; const unsigned gw_ = gtp[i >> 1]; const float gt = (i & 1) ? __uint_as_float(gw_ & 0xffff0000u) : __uint_as_float(gw_ << 16); Y[row * LDY + 768 + ch] = f2bf(hh * gelu_t(gt)); } }
    }
    if (grp || w == 0) {
        float* ho = grp ? P.out + O_S_LRUH + ((size_t)l * DEC_B + b) * 768 + ch : P.out + O_P_LRUH + ((size_t)l * NB + b) * 768 + ch;
        if (grp ? OUT_ON(10) : OUT_ON(4)) *ho = carry;
        float* co = grp ? P.out + O_S_LRUC + ((size_t)l * DEC_B + b) * 3 * 768 + ch : P.out + O_P_LRUC + ((size_t)l * NB + b) * 3 * 768 + ch;
#pragma unroll
        for (int j = 0; j < 3; ++j) if (grp ? OUT_ON(11) : OUT_ON(5)) co[j * 768] = bf2f(Z[(size_t)(rowb + L - 3 + j) * DIN + ZO_XB + ch]);
    }
}

template <bool FULL>
__device__ __forceinline__ void s5_run(const bf16_t* Z, bf16_t* ZS, float* sBU, bf16_t* sH, const bf16x8 (&Bf)[8], const bf16x8 (&Cf)[4], float abr, float abi, float dsk,
                                       int rowb, int g, int L, int it0, int it1, float& hr, float& hi, int lane, int fr, int fq) {
    u32x4 ufn = {0u, 0u, 0u, 0u}; bf16_t udn[4] = {0, 0, 0, 0};
    { const int t1 = it0 * 16; const int v1 = (L - t1) < 16 ? (L - t1) : 16;
      if (fq < 2 && fr < v1) ufn = *(const u32x4*)(Z + (size_t)(rowb + t1 + fr) * DIN + ZO_UA + g * 16 + 8 * fq);
      if (FULL) {
#pragma unroll
          for (int j = 0; j < 4; ++j) if (4 * fq + j < v1) udn[j] = Z[(size_t)(rowb + t1 + 4 * fq + j) * DIN + ZO_UA + g * 16 + fr]; } }
    for (int it = it0; it < it1; ++it) {
        const int t0 = it * 16; const int valid = (L - t0) < 16 ? (L - t0) : 16;
        const bf16x8 uf = __builtin_bit_cast(bf16x8, ufn);
        bf16_t ud[4];
#pragma unroll
        for (int j = 0; j < 4; ++j) ud[j] = udn[j];
        if (it + 1 < it1) { const int t1 = t0 + 16; const int v1 = (L - t1) < 16 ? (L - t1) : 16;
            ufn = (u32x4){0u, 0u, 0u, 0u};
            if (fq < 2 && fr < v1) ufn = *(const u32x4*)(Z + (size_t)(rowb + t1 + fr) * DIN + ZO_UA + g * 16 + 8 * fq);
            if (FULL) {
#pragma unroll
                for (int j = 0; j < 4; ++j) { udn[j] = 0; if (4 * fq + j < v1) udn[j] = Z[(size_t)(rowb + t1 + 4 * fq + j) * DIN + ZO_UA + g * 16 + fr]; } } }
#pragma unroll
        for (int nt = 0; nt < 8; ++nt) { f32x4 a = {0.f, 0.f, 0.f, 0.f}; a = mfma16(uf, Bf[nt], a);
#pragma unroll
            for (int j = 0; j < 4; ++j) sBU[(4 * fq + j) * 132 + 16 * nt + fr] = a[j]; }
        lds_wait();
#pragma unroll
        for (int i = 0; i < 16; ++i) {
            float bur = sBU[i * 132 + lane], bui = sBU[i * 132 + 64 + lane];
            asm volatile("" : "+v"(bur), "+v"(bui));
            const float msk = (i < valid) ? 1.0f : 0.0f;
            float nr = __builtin_fmaf(abr, hr, bur); asm volatile("" : "+v"(nr));
            nr = __builtin_fmaf(-abi, hi, nr); asm volatile("" : "+v"(nr));
            float ni = __builtin_fmaf(abr, hi, bui); asm volatile("" : "+v"(ni));
            ni = __builtin_fmaf(abi, hr, ni); asm volatile("" : "+v"(ni));
            hr = __builtin_fmaf(msk, nr - hr, hr); hi = __builtin_fmaf(msk, ni - hi, hi);
            asm volatile("" : "+v"(hr), "+v"(hi));
            if (FULL) { sH[i * 136 + lane] = f2bf(hr); sH[i * 136 + 64 + lane] = f2bf(hi); }
        }
        lds_wait();
        if (FULL) {
            f32x4 y = {0.f, 0.f, 0.f, 0.f};
#pragma unroll
            for (int ks = 0; ks < 4; ++ks) { const bf16x8 hf = *(const bf16x8*)(sH + fr * 136 + 32 * ks + 8 * fq); y = mfma16(hf, Cf[ks], y); }
#pragma unroll
            for (int j = 0; j < 4; ++j) { const int t = 4 * fq + j;
                if (t < valid) { const size_t row = (size_t)(rowb + t0 + t); const float u = bf2f(ud[j]); ZS[row * 768 + g * 16 + fr] = f2bf(gelu_t(y[j] + dsk * u)); } }
            lds_wait();
        }
    }
}
__device__ __forceinline__ void cmul(float& ar, float& ai, float br, float bi) { const float r = ar * br - ai * bi, i = ar * bi + ai * br; ar = r; ai = i; }

__device__ __forceinline__ void s5_job(const Params& P, int l, int grp, int jid, int g0, int pb0, unsigned* s5done, unsigned char* smem) {
    const int tid = otid(), w = __builtin_amdgcn_readfirstlane(tid >> 6), lane = tid & 63, fr = lane & 15, fq = lane >> 4;
    float* sBU = (float*)(smem + w * 12800);
    bf16_t* sH = (bf16_t*)(smem + w * 12800 + 8448);
    float* sC = (float*)(smem + 8 * 12800);
    const bf16_t* Z = (const bf16_t*)(P.ws + R_Z) - (size_t)g0 * DIN; bf16_t* ZS = (bf16_t*)(P.ws + R_ZS5) - (size_t)g0 * 768;
    int g, b0;
    if (grp) { const int unit = jid * 8 + w; g = unit % 48; b0 = (unit / 48) * 16; } else { b0 = jid / 48; g = jid - b0 * 48; b0 += pb0; }
    const float dt = __expf(INP(I_LS)[l * 48 + g]);
    float abr = 0.f, abi = 0.f;
    bf16x8 Bf[8];
#pragma unroll
    for (int k = 0; k < 4; ++k) {
        const int p = 16 * k + fr;
        const float lr = INP(I_AR)[((size_t)l * 48 + g) * 64 + p], li = INP(I_AI)[((size_t)l * 48 + g) * 64 + p];
        const float mag = expf(lr * dt), ar_ = mag * cosf(li * dt), ai_ = mag * sinf(li * dt);
        if (k == fq) { abr = ar_; abi = ai_; }
        const float den = lr * lr + li * li, nr = ar_ - 1.0f;
        const float cr = (nr * lr + ai_ * li) / den, ci = (ai_ * lr - nr * li) / den;
        bf16x8 fre, fim;
#pragma unroll
        for (int j = 0; j < 8; ++j) { fre[j] = 0; fim[j] = 0; }
        if (fq < 2) {
            gfp_t bre = INP(I_BR) + (((size_t)l * 48 + g) * 64 + p) * 16 + 8 * fq; gfp_t bim = INP(I_BI) + (((size_t)l * 48 + g) * 64 + p) * 16 + 8 * fq;
#pragma unroll
            for (int j = 0; j < 8; ++j) { const float br_ = bre[j], bi_ = bim[j]; fre[j] = (short)f2bf(cr * br_ - ci * bi_); fim[j] = (short)f2bf(cr * bi_ + ci * br_); }
        }
        Bf[k] = fre; Bf[4 + k] = fim;
    }
    bf16x8 Cf[4];
#pragma unroll
    for (int ks = 0; ks < 4; ++ks) {
        gfp_t cp = (ks < 2 ? INP(I_CR) : INP(I_CI)) + (((size_t)l * 48 + g) * 16 + fr) * 64 + 32 * (ks & 1) + 8 * fq;
        const float sg = ks < 2 ? 1.0f : -1.0f;
#pragma unroll
        for (int j = 0; j < 8; ++j) Cf[ks][j] = (short)f2bf(sg * cp[j]);
    }
    const float dsk = INP(I_D)[l * 768 + g * 16 + fr];
    __syncthreads();
    if (grp) {
        for (int s = 0; s < 16; ++s) {
            const int b = b0 + s; const int rowb = TPR + b * 4;
            float hr = INP(I_S5RE)[(((size_t)l * DEC_B + b) * 48 + g) * 64 + lane], hi = INP(I_S5IM)[(((size_t)l * DEC_B + b) * 48 + g) * 64 + lane];
            s5_run<true>(Z, ZS, sBU, sH, Bf, Cf, abr, abi, dsk, rowb, g, 4, 0, 1, hr, hi, lane, fr, fq);
            P.out[O_S_S5RE + (((size_t)l * DEC_B + b) * 48 + g) * 64 + lane] = hr;
            P.out[O_S_S5IM + (((size_t)l * DEC_B + b) * 48 + g) * 64 + lane] = hi;
        }
    } else {
        const int b = b0, rowb = b * LP;
        const int it0 = w == 0 ? 0 : 17 + 16 * (w - 1), it1 = 17 + 16 * w;
        float hr = 0.f, hi = 0.f;
        s5_run<false>(Z, ZS, sBU, sH, Bf, Cf, abr, abi, dsk, rowb, g, LP, it0, it1, hr, hi, lane, fr, fq);
        sC[(w * 64 + lane) * 2] = hr; sC[(w * 64 + lane) * 2 + 1] = hi;
        float pr = abr, pi = abi, p16r = 0.f, p16i = 0.f;
#pragma unroll
        for (int q = 0; q < 8; ++q) { cmul(pr, pi, pr, pi); if (q == 3) { p16r = pr; p16i = pi; } }
        float qr = pr, qi = pi; cmul(qr, qi, p16r, p16i);
        __syncthreads();
        float cr_ = 0.f, ci_ = 0.f;
        for (int ww = 0; ww < w; ++ww) {
            const float ar2 = ww == 0 ? qr : pr, ai2 = ww == 0 ? qi : pi;
            cmul(cr_, ci_, ar2, ai2);
            cr_ += sC[(ww * 64 + lane) * 2]; ci_ += sC[(ww * 64 + lane) * 2 + 1];
        }
        hr = cr_; hi = ci_;
        s5_run<true>(Z, ZS, sBU, sH, Bf, Cf, abr, abi, dsk, rowb, g, LP, it0, it1, hr, hi, lane, fr, fq);
        if (w == 7) {
            P.out[O_P_S5RE + (((size_t)l * NB + b) * 48 + g) * 64 + lane] = hr;
            P.out[O_P_S5IM + (((size_t)l * NB + b) * 48 + g) * 64 + lane] = hi;
        }
    }
    asm volatile("s_waitcnt vmcnt(0)" ::: "memory");
    __syncthreads();
    if (threadIdx.x == 0) { __threadfence(); asm volatile("s_waitcnt vmcnt(0)" ::: "memory"); atomicAdd(s5done, 1u); }
}

__device__ __forceinline__ void mixers_phase(const Params& P, int l, int rg, unsigned char* smem, int rep) {
    const Grp G = get_grp(rg);
    const int j1 = G.npb * 8, j2 = j1 + G.npb * 12, j3 = j2 + G.npb * 48, j4 = j3 + (G.hasS ? 1024 : 0), j5 = j4 + (G.hasS ? 48 : 0), j6 = j5 + (G.hasS ? 192 : 0), j7 = j6 + G.npan * 12, NJ = j7 + G.npan * 3;
    unsigned* s5done = (unsigned*)(P.ws + A_CTR) + 32 + (l * NGRP + rg) + rep * 16;
    const unsigned s5total = (unsigned)(G.npb * 48 + (G.hasS ? 48 : 0));
    unsigned* ctr = (unsigned*)(P.ws + A_CTR) + (l * NGRP + rg) + rep * 16;
    int* slot = (int*)(smem + LDS_BYTES - 16);
#ifndef STATIC_JOBS
#define STATIC_JOBS 0
#endif
    for (int jj = blockIdx.x;; jj += gridDim.x) {
        __syncthreads();
#if STATIC_JOBS
        const int j = jj; (void)ctr; (void)slot;
#else
        if (threadIdx.x == 0) *slot = (int)atomicAdd(ctr, 1u);
        __syncthreads();
        const int j = *slot;
#endif
        if (j >= NJ) break;
        int type, sg, idx;
        if (j < j1) { type = 0; sg = 0; idx = j; }
        else if (j < j2) { type = 1; sg = 0; idx = j - j1; }
        else if (j < j3) { type = 2; sg = 0; idx = j - j2; }
        else if (j < j4) { type = 0; sg = 1; idx = j - j3; }
        else if (j < j5) { type = 2; sg = 1; idx = j - j4; }
        else if (j < j6) { type = 1; sg = 1; idx = j - j5; }
        else if (j < j7) { type = 4; sg = 0; idx = j - j6; }
        else { type = 3; sg = 0; idx = j - j7; }
        if (type == 4) {
            using namespace pg8;
            Gemm gg{(const bf16_t*)(P.ws + R_H), (const bf16_t*)(P.ws + W_IN) + (size_t)l * DIN * DM, DM, DM, G.npan, DIN / 256, DM / 64, nullptr};
            SchedOne S1{idx / 12, 21 + idx % 12, DM / 64};
            EpiSigBf E{(bf16_t*)(P.ws + R_Z), DIN};
            gemm_run((LAS unsigned char*)smem, gg, S1, E);
            continue;
        }
        if (type == 3) {
            if (threadIdx.x == 0) {
                unsigned sp = 0;
                while (__hip_atomic_load(s5done, __ATOMIC_RELAXED, __HIP_MEMORY_SCOPE_AGENT) < s5total) { __builtin_amdgcn_s_sleep(8); if (++sp > (1u << 22)) break; }
                __threadfence();
                asm volatile("s_waitcnt vmcnt(0)" ::: "memory");
            }
            __syncthreads();
            using namespace pg8;
            Gemm gg{(const bf16_t*)(P.ws + R_ZS5), (const bf16_t*)(P.ws + W_GLU) + (size_t)l * 768 * 768, 768, 768, G.npan, 3, 12, nullptr};
            SchedOne S1{idx / 3, idx % 3, 12};
            EpiGlu E{(bf16_t*)(P.ws + R_Y), (const bf16_t*)(P.ws + R_ZS5), INP(I_BGLU) + l * 768};
            gemm_run((LAS unsigned char*)smem, gg, S1, E);
            continue;
        }
        if (type == 0) ret_job(P, l, sg, (idx >> 3) + (sg ? 0 : G.pb0), idx & 7, G.g0, smem);
        else if (type == 1) lru_job(P, l, sg, idx, G.g0, G.pb0, smem);
        else s5_job(P, l, sg, idx, G.g0, G.pb0, s5done, smem);
    }
}

__device__ __forceinline__ void run_phase(const Params& P, int ph, unsigned char* smem, int rep) {
#ifndef PHSEL
#define PHSEL -1
#endif
#define PSEL(x) (PHSEL < 0 || PHSEL == (x))
    if (ph == 0) { if (PSEL(10)) phase0(P, smem); return; }
    const int l = (ph - 1) / (10 * NGRP), rg = ((ph - 1) / 10) % NGRP, s = (ph - 1) % 10;
    LAS unsigned char* lds = (LAS unsigned char*)smem;
    unsigned char* ws = P.ws;
    using namespace pg8;
    const int G = gridDim.x, c = blockIdx.x;
    const int npan = rg < 2 ? 25 : 19;
    switch (s) {
    case 0: if (PSEL(0)) { Gemm g{(const bf16_t*)(ws + R_H), (const bf16_t*)(ws + W_IN) + (size_t)l * DIN * DM, DM, DM, npan, 21, DM / 64, nullptr};
              Sched<1> S; S.init(g.nM, g.nN, G, c, g.nt); EpiBf E{(bf16_t*)(ws + R_Z), DIN, (bf16_t*)(ws + R_Z)}; gemm_run(lds, g, S, E); } break;
    case 1: if (PSEL(1)) mixers_phase(P, l, rg, smem, rep); break;
    case 2: if (PSEL(2)) { Gemm g{(const bf16_t*)(ws + R_ZS5), (const bf16_t*)(ws + W_GLU) + (size_t)l * 768 * 768, 768, 768, npan, 3, 12, nullptr};
              Sched<1> S; S.init(g.nM, g.nN, G, c, g.nt); EpiGlu E{(bf16_t*)(ws + R_Y), (const bf16_t*)(ws + R_ZS5), INP(I_BGLU) + l * 768}; gemm_run(lds, g, S, E); } break;
    case 3: if (PSEL(3)) { Gemm g{(const bf16_t*)(ws + R_Y), (const bf16_t*)(ws + W_BR) + (size_t)l * DM * LDY, LDY, LDY, npan, 4, 0, nullptr};
              SchedBr2 S; S.init(g.nM, g.nN, G, c); EpiBranch E{(const bf16_t*)(ws + R_Z) + ZO_GATE, (bf16_t*)(ws + R_M), (bf16_t*)(ws + R_M2)}; gemm_run(lds, g, S, E); } break;
    case 4: if (PSEL(4)) { Gemm g{(const bf16_t*)(ws + R_M), (const bf16_t*)(ws + W_OUT) + (size_t)l * DM * DM, DM, DM, npan, 4, 16, (const bf16_t*)(ws + R_M2)};
              Sched<2> S; S.init(g.nM, g.nN, G, c, g.nt); S.fullk = 1;     EpiBf E{(bf16_t*)(ws + R_F), DM, (bf16_t*)(ws + R_UP)}; gemm_run(lds, g, S, E); } break;
    case 5: if (PSEL(5) && rep == 0) norm_rows(P, 1, l, rg, smem); break;
    case 6: if (PSEL(6)) { Gemm g{(const bf16_t*)(ws + R_H), (const bf16_t*)(ws + W_UP) + (size_t)l * 2 * DFF * DM, DM, DM, npan, 22, 16, nullptr};
              Sched<1> S; S.init(g.nM, g.nN, G, c, g.nt); EpiBf E{(bf16_t*)(ws + R_UP), 2 * DFF, (bf16_t*)(ws + R_UP)}; gemm_run(lds, g, S, E); } break;
    case 7: if (PSEL(7)) ffn_conv_phase(P, l, rg, smem); break;
    case 8: if (PSEL(8)) { Gemm g{(const bf16_t*)(ws + R_FIN), (const bf16_t*)(ws + W_DOWN) + (size_t)l * DM * DFF, DFF, DFF, npan, 4, 44, nullptr};
              Sched<2> S; S.init(g.nM, g.nN, G, c, g.nt); EpiBf E{(bf16_t*)(ws + R_F), DM, (bf16_t*)(ws + R_UP)}; gemm_run(lds, g, S, E);
              const int nun = 2 * npan * 4;
              if (c >= nun) next_h_rows(P, l, rg, (c - nun) * 8 + (int)(threadIdx.x >> 6), (G - nun) * 8, smem);
              else if (G <= nun) next_h_rows(P, l, rg, c * 8 + (int)(threadIdx.x >> 6), G * 8, smem); } break;
    default: if (PSEL(9) && rep == 0) norm_rows(P, 2, l, rg, smem); break;
    }
}

#define XB_TMO      128
#define XB_XCNT(j)  (256  + 64 * (j))
#define XB_XSUB(j)  (1280 + 64 * (j))
#define XB_XGEN(j)  (2304 + 64 * (j))
#define XB_TOP      3328
#define XB_TOPGEN   3392
#define XCD_BAR_WORDS 3456
#define XB_SPIN_CAP (1u << 18)

__device__ __forceinline__ unsigned xb_ld(unsigned* p)              { return __hip_atomic_load(p, __ATOMIC_RELAXED, __HIP_MEMORY_SCOPE_AGENT); }
__device__ __forceinline__ unsigned xb_add(unsigned* p, unsigned v) { return __hip_atomic_fetch_add(p, v, __ATOMIC_RELAXED, __HIP_MEMORY_SCOPE_AGENT); }
__device__ __forceinline__ unsigned xb_xcc_id() { return (unsigned)__builtin_amdgcn_s_getreg((3 << 11) | 20) & 0xFu; }
#define XB_SPIN(cond, bar) do { unsigned _sp = 0; while (cond) { __builtin_amdgcn_s_sleep(1); \
    if ((++_sp & 255u) == 0u) { if (xb_ld(&(bar)[XB_TMO])) break; if (_sp > XB_SPIN_CAP) { atomicAdd(&(bar)[XB_TMO], 1u); break; } } } } while (0)

struct XcdBarrier {
    unsigned* bar; unsigned x;
    volatile LAS unsigned* st;
};

__device__ __forceinline__ XcdBarrier xcd_barrier_post(unsigned* bar, volatile LAS unsigned* st) {
    XcdBarrier b; b.bar = bar; b.x = xb_xcc_id(); b.st = st;
    if (threadIdx.x == 0) (void)xb_add(&bar[XB_XCNT(b.x)], 1u);
    return b;
}
__device__ __forceinline__ void xcd_barrier_complete(unsigned* bar, unsigned x, unsigned& nloc, unsigned& nx) {
    const unsigned G = gridDim.x * gridDim.y * gridDim.z;
    unsigned sum, cnt, mine, sp = 0u;
    for (;;) {
        sum = 0u; cnt = 0u; mine = 0u;
#pragma unroll
        for (unsigned j = 0; j < 16; ++j) { const unsigned c = xb_ld(&bar[XB_XCNT(j)]); sum += c; cnt += (c > 0u) ? 1u : 0u; mine = (j == x) ? c : mine; }
        if (sum == G) break;
        __builtin_amdgcn_s_sleep(1);
        if ((++sp & 255u) == 0u) { if (xb_ld(&bar[XB_TMO])) break; if (sp > XB_SPIN_CAP) { atomicAdd(&bar[XB_TMO], 1u); break; } }
    }
    nloc = mine > 0u ? mine : 1u; nx = cnt > 0u ? cnt : 1u;
}

__device__ __forceinline__ void xcd_barrier(const XcdBarrier& b) {
    asm volatile("s_waitcnt vmcnt(0)" ::: "memory");
    __syncthreads();
    if (threadIdx.x == 0) {
        unsigned* bar = b.bar;
        __builtin_amdgcn_s_waitcnt(0);
        unsigned nloc = b.st[0], nx = b.st[1];
        if (nloc == 0u) { xcd_barrier_complete(bar, b.x, nloc, nx); b.st[0] = nloc; b.st[1] = nx; }
        const unsigned old = xb_add(&bar[XB_XSUB(b.x)], 1u);
        const unsigned gen = old / nloc;
        if (old + 1u == (gen + 1u) * nloc) {
            __builtin_amdgcn_fence(__ATOMIC_RELEASE, "agent");
            asm volatile("s_waitcnt vmcnt(0)" ::: "memory");
            const unsigned og = xb_add(&bar[XB_TOP], 1u);
            const unsigned tg = og / nx;
            if (og + 1u == (tg + 1u) * nx) xb_add(&bar[XB_TOPGEN], 1u);
            else XB_SPIN(xb_ld(&bar[XB_TOPGEN]) == tg, bar);
            __builtin_amdgcn_fence(__ATOMIC_ACQUIRE, "agent");
            xb_add(&bar[XB_XGEN(b.x)], 1u);
            asm volatile("s_waitcnt vmcnt(0)" ::: "memory");
        } else {
            XB_SPIN(xb_ld(&bar[XB_XGEN(b.x)]) == gen, bar);
            __builtin_amdgcn_fence(__ATOMIC_ACQUIRE, "agent");
            asm volatile("s_waitcnt vmcnt(0)" ::: "memory");
        }
    }
    __syncthreads();
}


__global__ void __launch_bounds__(512, 2) mega(Params P, int ph_lo, int ph_hi) {
    extern __shared__ __attribute__((aligned(16))) unsigned char smem[];
    unsigned* xst = (unsigned*)(smem + LDS_BYTES - 32);
    if (threadIdx.x == 0) {
        const float** tab = (const float**)(smem + PTAB_OFF);
#pragma unroll
        for (int i = 0; i < N_IN; ++i) tab[i] = P.in[i];
        xst[0] = 0u; xst[1] = 0u;
    }
    __syncthreads();
    XcdBarrier xb = xcd_barrier_post((unsigned*)(P.ws + A_BAR), (volatile LAS unsigned*)xst);
#ifndef DUP_MASK
#define DUP_MASK 0x400
#endif
    for (int ph = ph_lo; ph < ph_hi; ++ph) {
        if (ph > 0 && (ph - 1) % 10 == 2) continue;
        int nrep = 1;
        if (DUP_MASK) { const int sidx = ph == 0 ? 10 : (ph - 1) % 10; if ((DUP_MASK >> sidx) & 1) nrep = 2; }
        for (int rep = 0; rep < nrep; ++rep) {
            run_phase(P, ph, smem, rep);
            if (ph + 1 < ph_hi || rep + 1 < nrep) xcd_barrier(xb);
        }
    }
}


#ifndef DBG_STOP
#define DBG_STOP 0
#endif
#ifndef DBG_OFF
#define DBG_OFF R_Z
#endif
__global__ void dbg_dump(const unsigned char* ws, float* out, size_t n) {
    const bf16_t* src = (const bf16_t*)(ws + DBG_OFF);
    for (size_t i = (size_t)blockIdx.x * blockDim.x + threadIdx.x; i < n; i += (size_t)gridDim.x * blockDim.x) out[i] = bf2f(src[i]);
}

extern "C" void kernel_launch(void* const* d_in, const int* in_sizes, int n_in, void* d_out, int out_size, void* d_ws, size_t ws_size, hipStream_t stream) {
    (void)in_sizes; (void)n_in; (void)out_size;
    if (ws_size < WS_TOTAL) { fprintf(stderr, "workspace too small: %zu < %zu\n", ws_size, (size_t)WS_TOTAL); return; }
    Params p{};
    for (int i = 0; i < N_IN; ++i) p.in[i] = (const float*)d_in[i];
    p.out = (float*)d_out; p.ws = (unsigned char*)d_ws;
    hipFuncSetAttribute((const void*)mega, hipFuncAttributeMaxDynamicSharedMemorySize, LDS_BYTES);
    int dev = 0, cus = 256, per_cu = 1;
    hipGetDevice(&dev);
    hipDeviceGetAttribute(&cus, hipDeviceAttributeMultiprocessorCount, dev);
    hipOccupancyMaxActiveBlocksPerMultiprocessor(&per_cu, mega, 512, LDS_BYTES);
    if (per_cu < 1) per_cu = 1;
    const int grid = cus * 1;
#if COOP
#ifndef PH_HI
#define PH_HI NPHASE
#endif
    hipMemsetAsync((unsigned char*)d_ws + A_BAR, 0, 16384, stream);
    int lo = 0, hi = PH_HI;
    void* args[] = {&p, &lo, &hi};
    hipError_t e = hipLaunchCooperativeKernel((void*)mega, dim3(grid), dim3(512), args, LDS_BYTES, stream);
    if (e != hipSuccess) fprintf(stderr, "cooperative launch failed: %s (grid %d)\n", hipGetErrorString(e), grid);
#else
#if DBG_STOP
    for (int ph = 0; ph < DBG_STOP; ++ph) hipLaunchKernelGGL(mega, dim3(grid), dim3(512), LDS_BYTES, stream, p, ph, ph + 1);
#ifdef DBG_EXTRA
    hipLaunchKernelGGL(mega, dim3(grid), dim3(512), LDS_BYTES, stream, p, DBG_EXTRA, DBG_EXTRA + 1);
#endif
    hipLaunchKernelGGL(dbg_dump, dim3(2048), dim3(256), 0, stream, (const unsigned char*)d_ws, (float*)d_out, (size_t)34873344);
#else
    for (int ph = 0; ph < NPHASE; ++ph) hipLaunchKernelGGL(mega, dim3(grid), dim3(512), LDS_BYTES, stream, p, ph, ph + 1);
#endif
#endif
}
```

```cpp
#include <hip/hip_runtime.h>
#include <hip/hip_cooperative_groups.h>
#include <cstdio>
namespace cg = cooperative_groups;

#define DUP_MASK 0
#ifndef COOP
#define COOP 1
#endif
#ifndef OUTMASK
#define OUTMASK 0x3FFF
#endif
#ifndef OUT_BMAX
#define OUT_BMAX 1000
#endif
#ifndef OUT_L
#define OUT_L 3
#endif
#define OUT_ON(k) (((OUTMASK >> (k)) & 1) && ((OUT_L >> l) & 1))
#ifndef DMA_AUX
#define DMA_AUX 0
#endif

#define LAS __attribute__((address_space(3)))
typedef unsigned short bf16_t;
typedef short bf16x8 __attribute__((ext_vector_type(8)));
typedef float f32x4 __attribute__((ext_vector_type(4)));
typedef unsigned u32x4 __attribute__((ext_vector_type(4)));
typedef unsigned u32x2 __attribute__((ext_vector_type(2)));

constexpr int DM = 1024, NB = 8, SEQ = 2048, LP = 2064, DEC_B = 128, DEC_S = 4;
constexpr int TPR = NB * LP;
constexpr int TT = TPR + DEC_B * DEC_S;
constexpr int TPAD = 17152;
constexpr int DIN = 8448, DFF = 2816;
constexpr int ZO_UA = 0, ZO_XB = 768, ZO_GB = 1536, ZO_Q = 2304, ZO_K = 2816, ZO_V = 3328, ZO_GC = 4352, ZO_GATE = 5376;
constexpr int LDY = 2560;
constexpr float EPS = 1e-6f;
constexpr int LDS_BYTES = 143360;

enum { I_XP = 0, I_XS, I_S5RE, I_S5IM, I_LRUH, I_LRUC, I_RET, I_FFNC, I_META, I_GPREMIX, I_GPOSTMIX, I_GPREFFN, I_GPOSTFFN, I_WIN,
       I_AR, I_AI, I_LS, I_BR, I_BI, I_CR, I_CI, I_D, I_WGLU, I_BGLU, I_LCW, I_LCB, I_LWA, I_LBA, I_LWX, I_LBX, I_LAM, I_RNG,
       I_WBA, I_WBB, I_WBC, I_WOUT, I_WUP, I_FCW, I_FCB, I_WDOWN, N_IN };

constexpr size_t O_YP = 0;
constexpr size_t O_YS = O_YP + (size_t)NB * SEQ * DM;
constexpr size_t O_P_S5RE = O_YS + (size_t)DEC_B * DEC_S * DM;
constexpr size_t O_P_S5IM = O_P_S5RE + 2 * NB * 48 * 64;
constexpr size_t O_P_LRUH = O_P_S5IM + 2 * NB * 48 * 64;
constexpr size_t O_P_LRUC = O_P_LRUH + 2 * NB * 768;
constexpr size_t O_P_RET = O_P_LRUC + 2 * NB * 3 * 768;
constexpr size_t O_P_FFNC = O_P_RET + (size_t)2 * NB * 8 * 64 * 128;
constexpr size_t O_S_S5RE = O_P_FFNC + 2 * NB * 2 * DFF;
constexpr size_t O_S_S5IM = O_S_S5RE + 2 * DEC_B * 48 * 64;
constexpr size_t O_S_LRUH = O_S_S5IM + 2 * DEC_B * 48 * 64;
constexpr size_t O_S_LRUC = O_S_LRUH + 2 * DEC_B * 768;
constexpr size_t O_S_RET = O_S_LRUC + 2 * DEC_B * 3 * 768;
constexpr size_t O_S_FFNC = O_S_RET + (size_t)2 * DEC_B * 8 * 64 * 128;

constexpr size_t al256(size_t x) { return (x + 255) & ~(size_t)255; }
constexpr size_t W_IN = 0;
constexpr size_t W_GLU = W_IN + (size_t)2 * DIN * DM * 2;
constexpr size_t W_BR = W_GLU + (size_t)2 * 768 * 768 * 2;
constexpr size_t W_OUT = W_BR + (size_t)2 * DM * LDY * 2;
constexpr size_t W_UP = W_OUT + (size_t)2 * DM * DM * 2;
constexpr size_t W_DOWN = W_UP + (size_t)2 * 2 * DFF * DM * 2;
constexpr size_t A_X = W_DOWN + (size_t)2 * DM * DFF * 2;
constexpr int GR = 6400;
constexpr size_t R_Z = A_X + (size_t)TPAD * DM * 4;
constexpr size_t R_ZS5 = R_Z + (size_t)GR * DIN * 2;
constexpr size_t R_Y = R_ZS5 + (size_t)GR * 768 * 2;
constexpr size_t R_M = R_Y + (size_t)GR * LDY * 2;
constexpr size_t R_END = R_M + (size_t)GR * DM * 2;
constexpr size_t R_H = R_M;
constexpr size_t R_F = R_Z;
constexpr size_t R_UP = R_Z + (size_t)GR * DM * 4;
constexpr size_t R_FIN = R_ZS5;
static_assert(R_UP + (size_t)GR * 2 * DFF * 2 <= R_ZS5, "UP inside Z");
static_assert(R_FIN + (size_t)GR * DFF * 2 <= R_M, "FIN inside ZS5|Y");
constexpr size_t A_ROPE = R_END;
constexpr size_t A_CTR = al256(A_ROPE + (size_t)2068 * 64 * 4);
constexpr size_t A_BAR = A_CTR + 4096;
constexpr size_t WS_TOTAL = A_BAR + 16384;
constexpr size_t R_M2 = A_X + (size_t)40 * 1024 * 1024;
static_assert(A_X + (size_t)TPAD * DM * 2 <= R_M2 && R_M2 + (size_t)GR * DM * 2 <= R_Z, "M2 inside the freed half of the X reservation");
constexpr int NGRP = 3;
constexpr int NPHASE = 1 + 2 * NGRP * 10;

struct Grp { int g0, nrows, npan, pb0, npb, hasS; };
__device__ __forceinline__ Grp get_grp(int g) {
    Grp r; r.g0 = g * 6192; r.nrows = g < 2 ? 6192 : 4640; r.npan = g < 2 ? 25 : 19; r.pb0 = g * 3; r.npb = g < 2 ? 3 : 2; r.hasS = g == 2; return r;
}

struct Params {
    const float* in[N_IN];
    float* out;
    unsigned char* ws;
};


constexpr int PTAB_OFF = 142336;
typedef const __attribute__((address_space(1))) float* gfp_t;
typedef const __attribute__((address_space(1))) f32x4* gf4p_t;
__device__ __forceinline__ gfp_t ldin(const unsigned char* smem, int i) {
    const unsigned long long v = ((const unsigned long long*)(smem + PTAB_OFF))[i];
    const unsigned lo = __builtin_amdgcn_readfirstlane((unsigned)v), hi = __builtin_amdgcn_readfirstlane((unsigned)(v >> 32));
    return (gfp_t)(((unsigned long long)hi << 32) | lo);
}
#define INP(i) ldin(smem, (i))
__device__ __forceinline__ int otid() { int t = threadIdx.x; asm volatile("" : "+v"(t)); return t; }

__device__ __forceinline__ float bf2f(bf16_t b) { return __uint_as_float(((unsigned)b) << 16); }
__device__ __forceinline__ bf16_t f2bf(float f) { unsigned u = __float_as_uint(f); u += 0x7FFFu + ((u >> 16) & 1u); return (bf16_t)(u >> 16); }
__device__ __forceinline__ unsigned pk2(float lo, float hi) { return (unsigned)f2bf(lo) | ((unsigned)f2bf(hi) << 16); }
__device__ __forceinline__ float sigm(float x) { return __builtin_amdgcn_rcpf(1.0f + __expf(-x)); }
__device__ __forceinline__ float gelu_t(float x) { const float v = 1.5957691216f * (x + 0.044715f * x * x * x); return x * __builtin_amdgcn_rcpf(1.0f + __expf(-v)); }
__device__ __forceinline__ void lds_wait() { asm volatile("s_waitcnt lgkmcnt(0)" ::: "memory"); __builtin_amdgcn_wave_barrier(); }
__device__ __forceinline__ f32x4 mfma16(bf16x8 a, bf16x8 b, f32x4 c) { return __builtin_amdgcn_mfma_f32_16x16x32_bf16(a, b, c, 0, 0, 0); }

namespace pg8 {
constexpr int BM = 256, BK = 64, HALF = 128, HTB = HALF * BK * 2, STAGE_BYTES = 8 * HTB, NXCD = 8, WGM = 8;
__device__ __forceinline__ int lds_byte(int r, int c) { const int st = (r >> 4) * 2 + (c >> 5), rr = r & 15, cc = c & 31, ob = rr * 64 + cc * 2; return st * 1024 + (ob ^ (((ob >> 9) & 1) << 5)); }
__device__ __forceinline__ void stage_rc(int b, int& R, int& C) { const int st = b / 1024, sb = b % 1024, swz = sb ^ (((sb >> 9) & 1) << 5); R = (st >> 1) * 16 + swz / 64; C = (st & 1) * 32 + (swz % 64) / 2; }

struct Unit { int pm, pn, br; };
struct Gemm { const bf16_t* A; const bf16_t* Bt; int lda, ldb, nM, nN, nt; const bf16_t* A2; };

struct SchedOne {
    int pm, pn, nt0;
    __device__ bool next(int i, Unit& u) const { if (i != 0) return false; u.pm = pm; u.pn = pn; u.br = 0; return true; }
    __device__ __forceinline__ void kr(const Unit&, size_t& koffB, int& nt) const { koffB = 0; nt = nt0; }
};
template <int NBR> struct Sched {
    int nM, nN, nwg, G, c, nt0, fullk;
    __device__ void init(int nM_, int nN_, int G_, int c_, int nt_) { nM = nM_; nN = nN_; nwg = nM * nN; G = G_; c = c_; nt0 = nt_; fullk = 0; }
    __device__ bool next(int i, Unit& u) const {
        int wgid;
        if (NBR == 2) {
            const long L = (long)i * G + c; if (L >= 2 * (long)nwg) return false;
            u.br = (int)(L / nwg); wgid = (int)(L - (long)u.br * nwg);
        } else {
            const int ti = i / NBR; u.br = i - ti * NBR;
            const long L = (long)ti * G + c; if (L >= nwg) return false;
            wgid = (int)L;
        } { const int q = nwg / NXCD, r = nwg % NXCD, xcd = wgid % NXCD, off = wgid / NXCD; wgid = (xcd < r ? xcd * (q + 1) : r * (q + 1) + (xcd - r) * q) + off; }
        const int nig = WGM * nN, gid = wgid / nig, fm = gid * WGM, gsz = (nM - fm) < WGM ? (nM - fm) : WGM;
        u.pm = fm + ((wgid % nig) % gsz); u.pn = (wgid % nig) / gsz; return true;
    }
    __device__ __forceinline__ void kr(const Unit& u, size_t& koffB, int& nt) const {
        if (NBR == 1) { koffB = 0; nt = nt0; }
        else if (NBR == 2) { if (fullk) { nt = nt0; koffB = 0; } else { nt = nt0 >> 1; koffB = (size_t)u.br * (size_t)nt * 128; } }
        else { koffB = (size_t)u.br * 1536; nt = (u.br == 2) ? 16 : 12; }
    }
};

struct SchedBr2 {
    int nM, nN, nwg, G, c;
    __device__ void init(int nM_, int nN_, int G_, int c_) { nM = nM_; nN = nN_; nwg = nM * nN; G = G_; c = c_; }
    __device__ bool next(int i, Unit& u) const {
        const int ti = i / 3, b = i - ti * 3;
        const long L = (long)ti * G + c; if (L >= 2 * (long)nwg) return false;
        const int half = (int)(L / nwg); int wgid = (int)(L - (long)half * nwg);
        { const int q = nwg / NXCD, r = nwg % NXCD, xcd = wgid % NXCD, off = wgid / NXCD; wgid = (xcd < r ? xcd * (q + 1) : r * (q + 1) + (xcd - r) * q) + off; }
        const int nig = WGM * nN, gid = wgid / nig, fm = gid * WGM, gsz = (nM - fm) < WGM ? (nM - fm) : WGM;
        u.pm = fm + ((wgid % nig) % gsz); u.pn = (wgid % nig) / gsz; u.br = b + 4 * half; return true;
    }
    __device__ __forceinline__ void kr(const Unit& u, size_t& koffB, int& nt) const {
        const int b = u.br & 3, half = u.br >> 2; nt = (b == 2) ? 8 : 6; koffB = (size_t)b * 1536 + (size_t)half * nt * 128;
    }
};
__device__ __forceinline__ unsigned cvt_pk_bf16(float lo, float hi) { unsigned r; asm volatile("s_nop 1\n\tv_cvt_pk_bf16_f32 %0, %1, %2" : "=v"(r) : "v"(lo), "v"(hi)); return r; }

template <class Epi, class SchedT>
__device__ __forceinline__ void gemm_phase(LAS unsigned char* lds, const Gemm g, const SchedT& S, const Epi& E) {
    const int tid = otid(), wid = __builtin_amdgcn_readfirstlane(tid >> 6), lane = tid & 63, wr = wid >> 2, wc = wid & 3, fr = lane & 15, fq = lane >> 4;
    unsigned voffA[2], voffB[2];
#pragma unroll
    for (int i = 0; i < 2; ++i) { int R, C; stage_rc(tid * 16 + i * 8192, R, C);
        voffA[i] = (unsigned)(R * g.lda + C) * 2u; voffB[i] = (unsigned)(R * g.ldb + C) * 2u; }
    const size_t kstep = (size_t)(BK * 2);
    const size_t hstepA = (size_t)HALF * g.lda * 2, hstepB = (size_t)HALF * g.ldb * 2;
    const size_t tstepA = 2 * hstepA, tstepB = 2 * hstepB;
    const unsigned ldsw = (unsigned)wid * 1024u;
    const int aoff = lds_byte(wr * 64 + fr, fq * 8), boff = lds_byte(wc * 32 + fr, fq * 8);
#define PG8_SA(b, h) (((b) * 2 + (h)) * HTB)
#define PG8_SB(b, h) ((4 + (b) * 2 + (h)) * HTB)
#define PG8_STAGE(bufoff, gbase, voff) do { _Pragma("unroll") for (int _i = 0; _i < 2; ++_i) \
        __builtin_amdgcn_global_load_lds((const unsigned*)((const char*)(gbase) + (voff)[_i]), (LAS unsigned*)(lds + (bufoff) + ldsw + _i * 8192), 16, 0, DMA_AUX); } while (0)
#define PG8_LDA(dst, b, h) do { _Pragma("unroll") for (int m = 0; m < 4; ++m) _Pragma("unroll") for (int k = 0; k < 2; ++k) dst[m][k] = *(const LAS bf16x8*)(lds + PG8_SA(b, h) + aoff + m * 2048 + k * 1024); } while (0)
#define PG8_LDB(dst, b, h) do { _Pragma("unroll") for (int n = 0; n < 2; ++n) _Pragma("unroll") for (int k = 0; k < 2; ++k) dst[n][k] = *(const LAS bf16x8*)(lds + PG8_SB(b, h) + boff + n * 2048 + k * 1024); } while (0)
#define PG8_MMA(ai, bj, At, Bt) do { __builtin_amdgcn_s_setprio(1); _Pragma("unroll") for (int m = 0; m < 4; ++m) _Pragma("unroll") for (int n = 0; n < 2; ++n) _Pragma("unroll") for (int k = 0; k < 2; ++k) \
        acc[ai][bj][m][n] = __builtin_amdgcn_mfma_f32_16x16x32_bf16(Bt[n][k], At[m][k], acc[ai][bj][m][n], 0, 0, 0); __builtin_amdgcn_s_setprio(0); } while (0)
#define PG8_WAIT_V(n) asm volatile("s_waitcnt vmcnt(" #n ")" ::: "memory")
#define PG8_WAIT_L(n) asm volatile("s_waitcnt lgkmcnt(" #n ")" ::: "memory")
#define PG8_BAR __builtin_amdgcn_s_barrier()
#define PG8_SCHED __builtin_amdgcn_sched_barrier(0)
    Unit cur, nxt; int ui = 0;
    if (!S.next(0, cur)) return;
    f32x4 acc[2][2][4][2];
#pragma unroll
    for (int a = 0; a < 2; ++a)
#pragma unroll
        for (int b = 0; b < 2; ++b)
#pragma unroll
            for (int m = 0; m < 4; ++m)
#pragma unroll
                for (int n = 0; n < 2; ++n) acc[a][b][m][n] = (f32x4){0.f, 0.f, 0.f, 0.f};
    bf16x8 At[4][2], B0[2][2], B1[2][2];
    size_t koc; int ntc; S.kr(cur, koc, ntc);
    const char* cA = (const char*)((g.A2 && cur.br) ? g.A2 : g.A) + (size_t)cur.pm * tstepA + koc; const char* cB = (const char*)g.Bt + (size_t)cur.pn * tstepB + koc;
    PG8_STAGE(PG8_SB(0, 0), cB, voffB); PG8_STAGE(PG8_SA(0, 0), cA, voffA); PG8_STAGE(PG8_SB(0, 1), cB + hstepB, voffB); PG8_STAGE(PG8_SA(0, 1), cA + hstepA, voffA);
    if (wr == 1) PG8_BAR;
    PG8_WAIT_V(4); PG8_BAR;
    PG8_STAGE(PG8_SB(1, 0), cB + kstep, voffB); PG8_STAGE(PG8_SA(1, 0), cA + kstep, voffA); PG8_STAGE(PG8_SB(1, 1), cB + hstepB + kstep, voffB);
    PG8_WAIT_V(6); PG8_BAR;
    for (;;) {
        const bool has_next = S.next(ui + 1, nxt);
        size_t kon = 0; int ntn = ntc; if (has_next) S.kr(nxt, kon, ntn);
        const char* nA = has_next ? (const char*)((g.A2 && nxt.br) ? g.A2 : g.A) + (size_t)nxt.pm * tstepA + kon : cA; const char* nB = has_next ? (const char*)g.Bt + (size_t)nxt.pn * tstepB + kon : cB;
        for (int t = 0; t < ntc; t += 2) {
            const bool last = (t == ntc - 2);
            const char* a1 = cA + (size_t)(t + 1) * kstep;
            const char* a2 = last ? nA : cA + (size_t)(t + 2) * kstep; const char* b2 = last ? nB : cB + (size_t)(t + 2) * kstep;
            const char* a3 = a2 + kstep; const char* b3 = b2 + kstep;
            PG8_LDB(B0, 0, 0); PG8_SCHED; PG8_LDA(At, 0, 0); PG8_STAGE(PG8_SA(1, 1), a1 + hstepA, voffA);
            PG8_WAIT_L(8); PG8_BAR; PG8_WAIT_L(0); PG8_MMA(0, 0, At, B0); PG8_BAR; PG8_SCHED;
            PG8_LDB(B1, 0, 1); PG8_STAGE(PG8_SB(0, 0), b2, voffB);
            PG8_BAR; PG8_WAIT_L(0); PG8_MMA(0, 1, At, B1); PG8_BAR;
            PG8_LDA(At, 0, 1); PG8_STAGE(PG8_SA(0, 0), a2, voffA);
            PG8_BAR; PG8_WAIT_L(0); PG8_MMA(1, 0, At, B0); PG8_BAR; PG8_SCHED;
            PG8_STAGE(PG8_SB(0, 1), b2 + hstepB, voffB);
            PG8_WAIT_V(6); PG8_BAR; PG8_MMA(1, 1, At, B1); PG8_BAR;
            PG8_LDB(B0, 1, 0); PG8_SCHED; PG8_LDA(At, 1, 0); PG8_STAGE(PG8_SA(0, 1), a2 + hstepA, voffA);
            PG8_WAIT_L(8); PG8_BAR; PG8_WAIT_L(0); PG8_MMA(0, 0, At, B0); PG8_BAR; PG8_SCHED;
            PG8_LDB(B1, 1, 1); PG8_STAGE(PG8_SB(1, 0), b3, voffB);
            PG8_BAR; PG8_WAIT_L(0); PG8_MMA(0, 1, At, B1); PG8_BAR;
            PG8_LDA(At, 1, 1); PG8_STAGE(PG8_SA(1, 0), a3, voffA);
            PG8_BAR; PG8_WAIT_L(0); PG8_MMA(1, 0, At, B0); PG8_BAR; PG8_SCHED;
            PG8_STAGE(PG8_SB(1, 1), b3 + hstepB, voffB);
            PG8_WAIT_V(6); PG8_BAR; PG8_MMA(1, 1, At, B1); PG8_BAR;
        }
        E(acc, cur, wr, wc, fr, fq);
        if (!has_next) break;
#pragma unroll
        for (int a = 0; a < 2; ++a)
#pragma unroll
            for (int b = 0; b < 2; ++b)
#pragma unroll
                for (int m = 0; m < 4; ++m)
#pragma unroll
                    for (int n = 0; n < 2; ++n) acc[a][b][m][n] = (f32x4){0.f, 0.f, 0.f, 0.f};
        cur = nxt; cA = nA; cB = nB; ntc = ntn; ++ui;
    }
    PG8_WAIT_V(0);
    if (wr == 0) PG8_BAR;
    PG8_BAR;
#undef PG8_SA
#undef PG8_SB
#undef PG8_STAGE
#undef PG8_LDA
#undef PG8_LDB
#undef PG8_MMA
#undef PG8_WAIT_V
#undef PG8_WAIT_L
#undef PG8_BAR
#undef PG8_SCHED
}

struct EpiBf {
    bf16_t* O; int ldc; bf16_t* O2;
    __device__ __forceinline__ void operator()(const f32x4 (&acc)[2][2][4][2], const Unit& u, int wr, int wc, int fr, int fq) const {
        const int row0 = u.pm * BM + wr * 64 + fr, col0 = u.pn * BM + wc * 32 + 4 * fq;
        bf16_t* O = u.br ? this->O2 : this->O;
#pragma unroll
        for (int ai = 0; ai < 2; ++ai)
#pragma unroll
            for (int m = 0; m < 4; ++m) { bf16_t* rowp = O + (size_t)(row0 + ai * HALF + m * 16) * ldc + col0;
#pragma unroll
                for (int bj = 0; bj < 2; ++bj)
#pragma unroll
                    for (int n = 0; n < 2; ++n) { const f32x4 v = acc[ai][bj][m][n]; u32x2 o; o.x = cvt_pk_bf16(v[0], v[1]); o.y = cvt_pk_bf16(v[2], v[3]); *(u32x2*)(rowp + bj * HALF + n * 16) = o; } }
    }
};
struct EpiSigBf {
    bf16_t* O; int ldc;
    __device__ __forceinline__ void operator()(const f32x4 (&acc)[2][2][4][2], const Unit& u, int wr, int wc, int fr, int fq) const {
        const int row0 = u.pm * BM + wr * 64 + fr, col0 = u.pn * BM + wc * 32 + 4 * fq;
#pragma unroll
        for (int ai = 0; ai < 2; ++ai)
#pragma unroll
            for (int m = 0; m < 4; ++m) { bf16_t* rowp = O + (size_t)(row0 + ai * HALF + m * 16) * ldc + col0;
#pragma unroll
                for (int bj = 0; bj < 2; ++bj)
#pragma unroll
                    for (int n = 0; n < 2; ++n) { const f32x4 v = acc[ai][bj][m][n]; u32x2 o; o.x = cvt_pk_bf16(sigm(v[0]), sigm(v[1])); o.y = cvt_pk_bf16(sigm(v[2]), sigm(v[3])); *(u32x2*)(rowp + bj * HALF + n * 16) = o; } }
    }
};
struct EpiF32 {
    float* C; int ldc; float* C2;
    __device__ __forceinline__ void operator()(const f32x4 (&acc)[2][2][4][2], const Unit& u, int wr, int wc, int fr, int fq) const {
        const int row0 = u.pm * BM + wr * 64 + fr, col0 = u.pn * BM + wc * 32 + 4 * fq;
        float* C = u.br ? this->C2 : this->C;
#pragma unroll
        for (int ai = 0; ai < 2; ++ai)
#pragma unroll
            for (int m = 0; m < 4; ++m) { float* rowp = C + (size_t)(row0 + ai * HALF + m * 16) * ldc + col0;
#pragma unroll
                for (int bj = 0; bj < 2; ++bj)
#pragma unroll
                    for (int n = 0; n < 2; ++n) *(f32x4*)(rowp + bj * HALF + n * 16) = acc[ai][bj][m][n]; }
    }
};
struct EpiGlu {
    bf16_t* Y; const bf16_t* Z; gfp_t bias;
    __device__ __forceinline__ void operator()(const f32x4 (&acc)[2][2][4][2], const Unit& u, int wr, int wc, int fr, int fq) const {
        const int row0 = u.pm * BM + wr * 64 + fr, col0 = u.pn * BM + wc * 32 + 4 * fq;
#pragma unroll
        for (int ai = 0; ai < 2; ++ai)
#pragma unroll
            for (int m = 0; m < 4; ++m) { const size_t r = (size_t)(row0 + ai * HALF + m * 16);
#pragma unroll
                for (int bj = 0; bj < 2; ++bj)
#pragma unroll
                    for (int n = 0; n < 2; ++n) { const int c = col0 + bj * HALF + n * 16; const f32x4 v = acc[ai][bj][m][n];
                        const u32x2 zz = *(const u32x2*)(Z + r * 768 + c); const f32x4 bb = *(const f32x4*)(bias + c);
                        const float z0 = __uint_as_float(zz.x << 16), z1 = __uint_as_float(zz.x & 0xffff0000u), z2 = __uint_as_float(zz.y << 16), z3 = __uint_as_float(zz.y & 0xffff0000u);
                        u32x2 o; o.x = cvt_pk_bf16(z0 * sigm(v[0] + bb[0]), z1 * sigm(v[1] + bb[1])); o.y = cvt_pk_bf16(z2 * sigm(v[2] + bb[2]), z3 * sigm(v[3] + bb[3]));
                        *(u32x2*)(Y + r * LDY + c) = o; } }
    }
};
struct EpiBranch {
    const bf16_t* Zg; bf16_t* Mo; bf16_t* Mo2;
    __device__ __forceinline__ void operator()(const f32x4 (&acc)[2][2][4][2], const Unit& u, int wr, int wc, int fr, int fq) const {
        const int row0 = u.pm * BM + wr * 64 + fr, col0 = u.pn * BM + wc * 32 + 4 * fq; const int br = u.br & 3; bf16_t* Mo = (u.br >> 2) ? this->Mo2 : this->Mo;
#pragma unroll
        for (int ai = 0; ai < 2; ++ai)
#pragma unroll
            for (int m = 0; m < 4; ++m) { const size_t r = (size_t)(row0 + ai * HALF + m * 16);
#pragma unroll
                for (int bj = 0; bj < 2; ++bj)
#pragma unroll
                    for (int n = 0; n < 2; ++n) { const int c = col0 + bj * HALF + n * 16; const f32x4 v = acc[ai][bj][m][n];
                        const u32x2 gg = *(const u32x2*)(Zg + r * DIN + br * 1024 + c);
                        f32x4 t; t[0] = v[0] * __uint_as_float(gg.x << 16); t[1] = v[1] * __uint_as_float(gg.x & 0xffff0000u);
                        t[2] = v[2] * __uint_as_float(gg.y << 16); t[3] = v[3] * __uint_as_float(gg.y & 0xffff0000u);
                        bf16_t* mp = Mo + r * DM + c;
                        if (br != 0) { const u32x2 p = *(const u32x2*)mp; t[0] += __uint_as_float(p.x << 16); t[1] += __uint_as_float(p.x & 0xffff0000u); t[2] += __uint_as_float(p.y << 16); t[3] += __uint_as_float(p.y & 0xffff0000u); }
                        u32x2 o; o.x = cvt_pk_bf16(t[0], t[1]); o.y = cvt_pk_bf16(t[2], t[3]); *(u32x2*)mp = o; } }
    }
};

#ifndef GEMM_SIMPLE
#define GEMM_SIMPLE 0
#endif
template <class Epi, class SchedT>
__device__ __forceinline__ void gemm_simple(LAS unsigned char* lds, const Gemm g, const SchedT& S, const Epi& E) {
    const int tid = otid(), wid = __builtin_amdgcn_readfirstlane(tid >> 6), lane = tid & 63, wr = wid >> 2, wc = wid & 3, fr = lane & 15, fq = lane >> 4;
    unsigned voffA[2], voffB[2];
#pragma unroll
    for (int i = 0; i < 2; ++i) { int R, C; stage_rc(tid * 16 + i * 8192, R, C);
        voffA[i] = (unsigned)(R * g.lda + C) * 2u; voffB[i] = (unsigned)(R * g.ldb + C) * 2u; }
    const size_t hstepA = (size_t)HALF * g.lda * 2, hstepB = (size_t)HALF * g.ldb * 2;
    const int aoff = lds_byte(wr * 64 + fr, fq * 8), boff = lds_byte(wc * 32 + fr, fq * 8);
    Unit cur;
    for (int ui = 0; S.next(ui, cur); ++ui) {
        size_t koc; int ntc; S.kr(cur, koc, ntc);
        const char* cA = (const char*)((g.A2 && cur.br) ? g.A2 : g.A) + (size_t)cur.pm * 2 * hstepA + koc; const char* cB = (const char*)g.Bt + (size_t)cur.pn * 2 * hstepB + koc;
        f32x4 acc[2][2][4][2];
#pragma unroll
        for (int a = 0; a < 2; ++a)
#pragma unroll
            for (int b = 0; b < 2; ++b)
#pragma unroll
                for (int m = 0; m < 4; ++m)
#pragma unroll
                    for (int n = 0; n < 2; ++n) acc[a][b][m][n] = (f32x4){0.f, 0.f, 0.f, 0.f};
        for (int t = 0; t < ntc; ++t) {
            u32x4 ra[2][2], rb[2][2];
#pragma unroll
            for (int h = 0; h < 2; ++h)
#pragma unroll
                for (int i = 0; i < 2; ++i) { ra[h][i] = *(const u32x4*)(cA + (size_t)t * 128 + h * hstepA + voffA[i]); rb[h][i] = *(const u32x4*)(cB + (size_t)t * 128 + h * hstepB + voffB[i]); }
            __syncthreads();
#pragma unroll
            for (int h = 0; h < 2; ++h)
#pragma unroll
                for (int i = 0; i < 2; ++i) { *(LAS u32x4*)(lds + h * HTB + tid * 16 + i * 8192) = ra[h][i]; *(LAS u32x4*)(lds + (4 + h) * HTB + tid * 16 + i * 8192) = rb[h][i]; }
            __syncthreads();
#pragma unroll
            for (int ai = 0; ai < 2; ++ai) {
                bf16x8 At[4][2];
#pragma unroll
                for (int m = 0; m < 4; ++m)
#pragma unroll
                    for (int k = 0; k < 2; ++k) At[m][k] = *(const LAS bf16x8*)(lds + ai * HTB + aoff + m * 2048 + k * 1024);
#pragma unroll
                for (int bj = 0; bj < 2; ++bj) {
                    bf16x8 Bf[2][2];
#pragma unroll
                    for (int n = 0; n < 2; ++n)
#pragma unroll
                        for (int k = 0; k < 2; ++k) Bf[n][k] = *(const LAS bf16x8*)(lds + (4 + bj) * HTB + boff + n * 2048 + k * 1024);
#pragma unroll
                    for (int m = 0; m < 4; ++m)
#pragma unroll
                        for (int n = 0; n < 2; ++n)
#pragma unroll
                            for (int k = 0; k < 2; ++k) acc[ai][bj][m][n] = __builtin_amdgcn_mfma_f32_16x16x32_bf16(Bf[n][k], At[m][k], acc[ai][bj][m][n], 0, 0, 0);
                }
            }
        }
        E(acc, cur, wr, wc, fr, fq);
    }
    __syncthreads();
}
template <class Epi, class SchedT>
__device__ __forceinline__ void gemm_run(LAS unsigned char* lds, const Gemm g, const SchedT& S, const Epi& E) {
#if GEMM_SIMPLE
    gemm_simple(lds, g, S, E);
#else
    gemm_phase(lds, g, S, E);
#endif
}
}

__device__ __forceinline__ void transpose_tile(gfp_t W, int N, bf16_t* __restrict__ dst, int ldd, int koff, int tk, int tn, float* tile) {
    const int tid = otid(), a = tid >> 6, bq = tid & 63;
    __syncthreads();
#pragma unroll
    for (int i = 0; i < 8; ++i) { const int k = a + 8 * i; tile[k * 65 + bq] = W[(size_t)(tk * 64 + k) * N + tn * 64 + bq]; }
    __syncthreads();
#pragma unroll
    for (int i = 0; i < 8; ++i) { const int n = a + 8 * i; dst[(size_t)(tn * 64 + n) * ldd + koff + tk * 64 + bq] = f2bf(tile[bq * 65 + n]); }
}

__device__ __forceinline__ f32x4 ldx4(const bf16_t* p) { const u32x2 v = *(const u32x2*)p; f32x4 r; r[0] = __uint_as_float(v.x << 16); r[1] = __uint_as_float(v.x & 0xffff0000u); r[2] = __uint_as_float(v.y << 16); r[3] = __uint_as_float(v.y & 0xffff0000u); return r; }
__device__ __forceinline__ void stx4(bf16_t* p, const f32x4 v) { u32x2 o; o.x = pk2(v[0], v[1]); o.y = pk2(v[2], v[3]); *(u32x2*)p = o; }
__device__ __forceinline__ float row16_sum(float v) {
    v += __builtin_bit_cast(float, __builtin_amdgcn_update_dpp(0, __builtin_bit_cast(int, v), 0xB1, 0xF, 0xF, true));
    v += __builtin_bit_cast(float, __builtin_amdgcn_update_dpp(0, __builtin_bit_cast(int, v), 0x4E, 0xF, 0xF, true));
    v += __builtin_bit_cast(float, __builtin_amdgcn_update_dpp(0, __builtin_bit_cast(int, v), 0x141, 0xF, 0xF, true));
    v += __builtin_bit_cast(float, __builtin_amdgcn_update_dpp(0, __builtin_bit_cast(int, v), 0x140, 0xF, 0xF, true));
    return v;
}
__device__ __forceinline__ float wave_sum(float v) {
    v = row16_sum(v);
    const int iv = __builtin_bit_cast(int, v);
    const float a = __builtin_bit_cast(float, __builtin_amdgcn_readlane(iv, 0)), b = __builtin_bit_cast(float, __builtin_amdgcn_readlane(iv, 16));
    const float c = __builtin_bit_cast(float, __builtin_amdgcn_readlane(iv, 32)), d = __builtin_bit_cast(float, __builtin_amdgcn_readlane(iv, 48));
    return (a + b) + (c + d);
}
__device__ __forceinline__ void rms_store_r(const f32x4 (&xv)[4], const f32x4 (&gr)[4], bf16_t* dst, int lane) {
    float ss = 0.f;
#pragma unroll
    for (int i = 0; i < 4; ++i) ss += xv[i][0] * xv[i][0] + xv[i][1] * xv[i][1] + xv[i][2] * xv[i][2] + xv[i][3] * xv[i][3];
    ss = wave_sum(ss);
    const float rs = rsqrtf(ss * (1.0f / DM) + EPS);
#pragma unroll
    for (int i = 0; i < 4; ++i) { const int c = lane * 4 + 256 * i; const f32x4 hv = xv[i] * gr[i] * rs;
        u32x2 o; o.x = pk2(hv[0], hv[1]); o.y = pk2(hv[2], hv[3]); *(u32x2*)(dst + c) = o; }
}
__device__ __forceinline__ void rms_store(const f32x4 (&xv)[4], gfp_t g, bf16_t* dst, int lane) {
    float ss = 0.f;
#pragma unroll
    for (int i = 0; i < 4; ++i) ss += xv[i][0] * xv[i][0] + xv[i][1] * xv[i][1] + xv[i][2] * xv[i][2] + xv[i][3] * xv[i][3];
    ss = wave_sum(ss);
    const float rs = rsqrtf(ss * (1.0f / DM) + EPS);
#pragma unroll
    for (int i = 0; i < 4; ++i) { const int c = lane * 4 + 256 * i; const f32x4 gn = *(const f32x4*)(g + c); const f32x4 hv = xv[i] * gn * rs;
        u32x2 o; o.x = pk2(hv[0], hv[1]); o.y = pk2(hv[2], hv[3]); *(u32x2*)(dst + c) = o; }
}
__device__ __forceinline__ void norm_rows(const Params& P, int mode, int l, int grp, const unsigned char* smem) {
    const int tid_ = otid(); const int wid = tid_ >> 6, lane = tid_ & 63;
    bf16_t* __restrict__ X = (bf16_t*)(P.ws + A_X);
    const int gw = blockIdx.x * 8 + wid, nw = gridDim.x * 8;
    if (mode == 0) {
        gfp_t g0p = INP(I_GPREMIX); bf16_t* H = (bf16_t*)(P.ws + R_H);
        for (int row = gw; row < TPAD; row += nw) {
            f32x4 xv[4];
            if (row >= TT) {
#pragma unroll
                for (int i = 0; i < 4; ++i) xv[i] = (f32x4){0.f, 0.f, 0.f, 0.f};
            } else {
                const bool isP = row < TPR; int b = 0, t = 0; if (isP) { b = row / LP; t = row - b * LP; }
                gfp_t src = isP ? (t < 16 ? INP(I_META) + (size_t)t * DM : INP(I_XP) + ((size_t)b * SEQ + (t - 16)) * DM) : INP(I_XS) + (size_t)(row - TPR) * DM;
#pragma unroll
                for (int i = 0; i < 4; ++i) xv[i] = *(const f32x4*)(src + lane * 4 + 256 * i);
            }
#pragma unroll
            for (int i = 0; i < 4; ++i) stx4(X + (size_t)row * DM + lane * 4 + 256 * i, xv[i]);
            if (row < 6192) rms_store(xv, g0p, H + (size_t)row * DM, lane);
        }
        return;
    }
    const Grp G = get_grp(grp);
    const bf16_t* __restrict__ F = (const bf16_t*)(P.ws + R_F) - (size_t)G.g0 * DM;
    const bf16_t* __restrict__ F2 = (const bf16_t*)(P.ws + R_UP) - (size_t)G.g0 * DM;
    bf16_t* __restrict__ H = (bf16_t*)(P.ws + R_H) - (size_t)G.g0 * DM;
    const bool fin = (mode == 2 && l == 1);
    gfp_t gpost = (mode == 1 ? INP(I_GPOSTMIX) : INP(I_GPOSTFFN)) + l * DM;
    gfp_t gffn = INP(I_GPREFFN) + l * DM;
    f32x4 gpr[4], gfr[4];
#pragma unroll
    for (int i = 0; i < 4; ++i) { gpr[i] = *(const f32x4*)(gpost + lane * 4 + 256 * i); gfr[i] = *(const f32x4*)(gffn + lane * 4 + 256 * i); }
#pragma unroll 4
    for (int row = G.g0 + gw; row < G.g0 + G.nrows; row += nw) {
        f32x4 xv[4], fv[4]; float ss = 0.f;
#pragma unroll
        for (int i = 0; i < 4; ++i) { const int c = lane * 4 + 256 * i; xv[i] = ldx4(X + (size_t)row * DM + c);
            { const u32x2 fa = *(const u32x2*)(F + (size_t)row * DM + c), fb = *(const u32x2*)(F2 + (size_t)row * DM + c);
              fv[i][0] = __uint_as_float(fa.x << 16) + __uint_as_float(fb.x << 16); fv[i][1] = __uint_as_float(fa.x & 0xffff0000u) + __uint_as_float(fb.x & 0xffff0000u);
              fv[i][2] = __uint_as_float(fa.y << 16) + __uint_as_float(fb.y << 16); fv[i][3] = __uint_as_float(fa.y & 0xffff0000u) + __uint_as_float(fb.y & 0xffff0000u); }
            ss += fv[i][0] * fv[i][0] + fv[i][1] * fv[i][1] + fv[i][2] * fv[i][2] + fv[i][3] * fv[i][3]; }
        ss = wave_sum(ss);
        const float rs = rsqrtf(ss * (1.0f / DM) + EPS);
#pragma unroll
        for (int i = 0; i < 4; ++i) xv[i] = xv[i] + fv[i] * gpr[i] * rs;
        if (fin) {
            float* dst = nullptr;
            if (row < TPR) { const int b = row / LP, t = row - b * LP; if (t >= 16 && ((OUTMASK >> 0) & 1)) dst = P.out + O_YP + ((size_t)b * SEQ + (t - 16)) * DM; }
            else if ((OUTMASK >> 1) & 1) dst = P.out + O_YS + (size_t)(row - TPR) * DM;
            if (dst) {
#pragma unroll
                for (int i = 0; i < 4; ++i) *(f32x4*)(dst + lane * 4 + 256 * i) = xv[i];
            }
        } else {
#pragma unroll
            for (int i = 0; i < 4; ++i) stx4(X + (size_t)row * DM + lane * 4 + 256 * i, xv[i]);
        }
        if (mode == 1) rms_store_r(xv, gfr, H + (size_t)row * DM, lane);
    }
}

__device__ __forceinline__ void next_h_rows(const Params& P, int l, int grp, int gw, int nw, const unsigned char* smem) {
    int nl = l, ng = grp + 1; if (ng == NGRP) { ng = 0; nl = l + 1; }
    if (nl >= 2) return;
    const int tid_ = otid(); const int lane = tid_ & 63;
    const bf16_t* __restrict__ X = (const bf16_t*)(P.ws + A_X);
    const Grp N = get_grp(ng); gfp_t gn = INP(I_GPREMIX) + nl * DM; bf16_t* __restrict__ Hn = (bf16_t*)(P.ws + R_H) - (size_t)N.g0 * DM;
    f32x4 gnr[4];
#pragma unroll
    for (int i = 0; i < 4; ++i) gnr[i] = *(const f32x4*)(gn + lane * 4 + 256 * i);
#pragma unroll 4
    for (int row = N.g0 + gw; row < N.g0 + N.nrows; row += nw) {
        f32x4 xv[4];
#pragma unroll
        for (int i = 0; i < 4; ++i) xv[i] = ldx4(X + (size_t)row * DM + lane * 4 + 256 * i);
        rms_store_r(xv, gnr, Hn + (size_t)row * DM, lane);
    }
}

__device__ __forceinline__ void phase0(const Params& P, unsigned char* smem) {
    float* tile = (float*)smem;
    constexpr int C0 = 2112, C1 = C0 + 144, C2 = C1 + 192, C3 = C2 + 192, C4 = C3 + 256, C5 = C4 + 256, C6 = C5 + 1408, C7 = C6 + 704;
    for (int id = blockIdx.x; id < 2 * C7; id += gridDim.x) {
        const int l = id / C7; int j = id - l * C7;
        gfp_t W; int N, ldd, koff = 0; bf16_t* dst;
        if (j < C0) { W = INP(I_WIN) + (size_t)l * DM * DIN; N = DIN; dst = (bf16_t*)(P.ws + W_IN) + (size_t)l * DIN * DM; ldd = DM; }
        else if (j < C1) { j -= C0; W = INP(I_WGLU) + (size_t)l * 768 * 768; N = 768; dst = (bf16_t*)(P.ws + W_GLU) + (size_t)l * 768 * 768; ldd = 768; }
        else if (j < C2) { j -= C1; W = INP(I_WBA) + (size_t)l * 768 * DM; N = DM; dst = (bf16_t*)(P.ws + W_BR) + (size_t)l * DM * LDY; ldd = LDY; }
        else if (j < C3) { j -= C2; W = INP(I_WBB) + (size_t)l * 768 * DM; N = DM; dst = (bf16_t*)(P.ws + W_BR) + (size_t)l * DM * LDY; ldd = LDY; koff = 768; }
        else if (j < C4) { j -= C3; W = INP(I_WBC) + (size_t)l * DM * DM; N = DM; dst = (bf16_t*)(P.ws + W_BR) + (size_t)l * DM * LDY; ldd = LDY; koff = 1536; }
        else if (j < C5) { j -= C4; W = INP(I_WOUT) + (size_t)l * DM * DM; N = DM; dst = (bf16_t*)(P.ws + W_OUT) + (size_t)l * DM * DM; ldd = DM; }
        else if (j < C6) { j -= C5; W = INP(I_WUP) + (size_t)l * DM * 2 * DFF; N = 2 * DFF; dst = (bf16_t*)(P.ws + W_UP) + (size_t)l * 2 * DFF * DM; ldd = DM; }
        else { j -= C6; W = INP(I_WDOWN) + (size_t)l * DFF * DM; N = DM; dst = (bf16_t*)(P.ws + W_DOWN) + (size_t)l * DM * DFF; ldd = DFF; }
        const int ntn = N / 64; const int tk = j / ntn, tn = j - tk * ntn;
        transpose_tile(W, N, dst, ldd, koff, tk, tn, tile);
    }
    norm_rows(P, 0, 0, 0, smem);
    float* rt = (float*)(P.ws + A_ROPE);
    for (int i = blockIdx.x * 512 + threadIdx.x; i < 2068 * 32; i += gridDim.x * 512) {
        const int pi = i >> 5, fi = i & 31; const double pos = pi < LP ? (double)pi : (double)(16384 + pi - LP);
        const double inv = exp(-(double)fi * (9.210340371976184 / 32.0));
        double ang = pos * inv; const double k = rint(ang * 0.15915494309189535); ang = ang - k * 6.283185307179586;
        const float af = (float)ang; rt[2 * i] = cosf(af); rt[2 * i + 1] = sinf(af);
    }
    if (blockIdx.x == 0 && threadIdx.x < 64) ((unsigned*)(P.ws + A_CTR))[threadIdx.x] = 0u;
}

__device__ __forceinline__ void ld8(const bf16_t* p, float (&d)[8]) {
    const u32x4 v = *(const u32x4*)p;
#pragma unroll
    for (int i = 0; i < 4; ++i) { d[2 * i] = __uint_as_float(v[i] << 16); d[2 * i + 1] = __uint_as_float(v[i] & 0xffff0000u); }
}
__device__ __forceinline__ void ffn_conv_phase(const Params& P, int l, int grp, const unsigned char* smem) {
    const Grp G = get_grp(grp);
    const bf16_t* __restrict__ UP = (const bf16_t*)(P.ws + R_UP) - (size_t)G.g0 * (2 * DFF); bf16_t* __restrict__ FIN = (bf16_t*)(P.ws + R_FIN) - (size_t)G.g0 * DFF;
    gfp_t cw = INP(I_FCW) + (size_t)l * 3 * DFF; gfp_t cb = INP(I_FCB) + (size_t)l * DFF;
    gfp_t cache = INP(I_FFNC) + (size_t)l * DEC_B * 2 * DFF;
    constexpr int NCG = DFF / 8;
    const int RL = grp < 2 ? 6 : 8;
    const int nrun = G.nrows / RL;
    for (int it = blockIdx.x * 512 + threadIdx.x; it < nrun * NCG; it += gridDim.x * 512) {
        const int ck = it / NCG, c = (it - ck * NCG) * 8, row0 = G.g0 + ck * RL;
        float w0[8], w1[8], w2[8], bs[8];
#pragma unroll
        for (int i = 0; i < 8; ++i) { bs[i] = cb[c + i]; w0[i] = cw[c + i]; w1[i] = cw[DFF + c + i]; w2[i] = cw[2 * DFF + c + i]; }
        float g1[8], g2[8];
#pragma unroll
        for (int r = 0; r < 8; ++r) {
            if (r >= RL) break;
            const int row = row0 + r;
            int b, t, L; const bool isP = row < TPR;
            if (isP) { b = row / LP; t = row - b * LP; L = LP; } else { b = (row - TPR) >> 2; t = (row - TPR) & 3; L = 4; }
            float g0[8], uf[8];
            ld8(UP + (size_t)row * (2 * DFF) + c, g0); ld8(UP + (size_t)row * (2 * DFF) + DFF + c, uf);
            if (r == 0) {
                if (t >= 1) ld8(UP + (size_t)(row - 1) * (2 * DFF) + c, g1);
                else {
#pragma unroll
                    for (int i = 0; i < 8; ++i) g1[i] = isP ? 0.f : cache[((size_t)b * 2 + 1) * DFF + c + i]; }
                if (t >= 2) ld8(UP + (size_t)(row - 2) * (2 * DFF) + c, g2);
                else {
#pragma unroll
                    for (int i = 0; i < 8; ++i) g2[i] = isP ? 0.f : cache[((size_t)b * 2 + t) * DFF + c + i]; }
            } else if (t == 0) {
#pragma unroll
                for (int i = 0; i < 8; ++i) { g1[i] = isP ? 0.f : cache[((size_t)b * 2 + 1) * DFF + c + i]; g2[i] = isP ? 0.f : cache[((size_t)b * 2) * DFF + c + i]; }
            } else if (t == 1) {
#pragma unroll
                for (int i = 0; i < 8; ++i) g2[i] = isP ? 0.f : cache[((size_t)b * 2 + 1) * DFF + c + i];
            }
            float o[8];
#pragma unroll
            for (int i = 0; i < 8; ++i) { const float gc = bs[i] + w0[i] * g2[i] + w1[i] * g1[i] + w2[i] * g0[i]; o[i] = gelu_t(gc) * uf[i]; }
            u32x4 ov; ov[0] = pk2(o[0], o[1]); ov[1] = pk2(o[2], o[3]); ov[2] = pk2(o[4], o[5]); ov[3] = pk2(o[6], o[7]);
            *(u32x4*)(FIN + (size_t)row * DFF + c) = ov;
            if (t >= L - 2) {
                float* dst = isP ? P.out + O_P_FFNC + (((size_t)l * NB + b) * 2 + (t - (L - 2))) * DFF + c : P.out + O_S_FFNC + (((size_t)l * DEC_B + b) * 2 + (t - (L - 2))) * DFF + c;
#pragma unroll
                for (int i = 0; i < 8; ++i) dst[i] = g0[i];
            }
#pragma unroll
            for (int i = 0; i < 8; ++i) { g2[i] = g1[i]; g1[i] = g0[i]; }
        }
    }
}

__device__ __forceinline__ void ret_job(const Params& P, int l, int grp, int b, int h, int g0, unsigned char* smem) {
    const int tid = otid(), w = __builtin_amdgcn_readfirstlane(tid >> 6), lane = tid & 63, fr = lane & 15, fq = lane >> 4;
    bf16_t* sQ = (bf16_t*)smem;
    bf16_t* sK = sQ + 128 * 72;
    bf16_t* sKdT = sK + 128 * 72;
    bf16_t* sVT = sKdT + 64 * 136;
    bf16_t* sST = sVT + 128 * 136;
    bf16_t* sP = sST + 128 * 72 + w * 16 * 136;
    const bf16_t* Z = (const bf16_t*)(P.ws + R_Z) - (size_t)g0 * DIN; bf16_t* Y = (bf16_t*)(P.ws + R_Y) - (size_t)g0 * LDY;
    const float* rope = (const float*)(P.ws + A_ROPE);
    const int L = grp ? 4 : LP, rowb = grp ? TPR + b * 4 : b * LP, tabb = grp ? LP : 0;
    const float lg = log1pf(-exp2f(-5.0f - (float)h));
    gfp_t ng = INP(I_RNG) + (size_t)l * 1024 + h * 128;
    float ngv[8];
#pragma unroll
    for (int et = 0; et < 8; ++et) ngv[et] = ng[16 * et + fr];
    f32x4 accS[4];
    float* Sout = P.out + (grp ? O_S_RET + (((size_t)l * DEC_B + b) * 8 + h) * 8192 : O_P_RET + (((size_t)l * NB + b) * 8 + h) * 8192);
    if (grp) { gfp_t S0 = INP(I_RET) + (((size_t)l * DEC_B + b) * 8 + h) * 8192;
#pragma unroll
        for (int dt = 0; dt < 4; ++dt)
#pragma unroll
            for (int j = 0; j < 4; ++j) accS[dt][j] = S0[(16 * dt + 4 * fq + j) * 128 + 16 * w + fr];
    } else {
#pragma unroll
        for (int dt = 0; dt < 4; ++dt) accS[dt] = (f32x4){0.f, 0.f, 0.f, 0.f};
    }
    __syncthreads();
#pragma unroll
    for (int dt = 0; dt < 4; ++dt) { u32x2 o; o.x = pk2(accS[dt][0], accS[dt][1]); o.y = pk2(accS[dt][2], accS[dt][3]); *(u32x2*)(sST + (16 * w + fr) * 72 + 16 * dt + 4 * fq) = o; }
    const int nch = grp ? 1 : 17;
    u32x4 q1 = {0u, 0u, 0u, 0u}, q2 = q1, k1 = q1, k2 = q1, vv[4];
#define RET_LOAD(ckx) do { const int _t0 = grp ? 0 : ((ckx) == 0 ? 0 : 16 + ((ckx) - 1) * 128), _C = grp ? 4 : ((ckx) == 0 ? 16 : 128); \
        const int _m = tid >> 2, _i0 = (tid & 3) * 8, _m2 = tid & 127, _e0 = (tid >> 7) * 32; \
        q1 = (u32x4){0u, 0u, 0u, 0u}; q2 = q1; k1 = q1; k2 = q1; \
        if (_m < _C) { const size_t _zr = (size_t)(rowb + _t0 + _m) * DIN; \
            q1 = *(const u32x4*)(Z + _zr + ZO_Q + h * 64 + _i0); q2 = *(const u32x4*)(Z + _zr + ZO_Q + h * 64 + 32 + _i0); \
            k1 = *(const u32x4*)(Z + _zr + ZO_K + h * 64 + _i0); k2 = *(const u32x4*)(Z + _zr + ZO_K + h * 64 + 32 + _i0); } \
        _Pragma("unroll") for (int _i = 0; _i < 4; ++_i) vv[_i] = (u32x4){0u, 0u, 0u, 0u}; \
        if (_m2 < _C) { const bf16_t* _vp = Z + (size_t)(rowb + _t0 + _m2) * DIN + ZO_V + h * 128 + _e0; \
            _Pragma("unroll") for (int _i = 0; _i < 4; ++_i) vv[_i] = *(const u32x4*)(_vp + 8 * _i); } } while (0)
    RET_LOAD(0);
    for (int ck = 0; ck < nch; ++ck) {
        const int t0 = grp ? 0 : (ck == 0 ? 0 : 16 + (ck - 1) * 128), C = grp ? 4 : (ck == 0 ? 16 : 128);
        {
            const int m = tid >> 2, i0 = (tid & 3) * 8;
            u32x4 q1w = {0u, 0u, 0u, 0u}, q2w = q1w, k1w = q1w, k2w = q1w;
            float kd1[8], kd2[8];
#pragma unroll
            for (int e = 0; e < 8; ++e) { kd1[e] = 0.f; kd2[e] = 0.f; }
            if (m < C) {
                const float* rp = rope + ((size_t)(tabb + t0 + m) * 32 + i0) * 2;
                const float kdec = __expf(lg * (float)(C - 1 - m));
                float qo1[8], qo2[8], ko1[8], ko2[8];
#pragma unroll
                for (int e = 0; e < 8; ++e) {
                    const float cs = rp[2 * e], sn = rp[2 * e + 1];
                    const unsigned qa = q1[e >> 1], qb = q2[e >> 1], ka = k1[e >> 1], kb = k2[e >> 1];
                    const float x1 = (e & 1) ? __uint_as_float(qa & 0xffff0000u) : __uint_as_float(qa << 16);
                    const float x2 = (e & 1) ? __uint_as_float(qb & 0xffff0000u) : __uint_as_float(qb << 16);
                    const float y1 = ((e & 1) ? __uint_as_float(ka & 0xffff0000u) : __uint_as_float(ka << 16)) * 0.125f;
                    const float y2 = ((e & 1) ? __uint_as_float(kb & 0xffff0000u) : __uint_as_float(kb << 16)) * 0.125f;
                    qo1[e] = x1 * cs - x2 * sn; qo2[e] = x2 * cs + x1 * sn;
                    ko1[e] = y1 * cs - y2 * sn; ko2[e] = y2 * cs + y1 * sn;
                    kd1[e] = ko1[e] * kdec; kd2[e] = ko2[e] * kdec;
                }
#pragma unroll
                for (int e = 0; e < 4; ++e) { q1w[e] = pk2(qo1[2 * e], qo1[2 * e + 1]); q2w[e] = pk2(qo2[2 * e], qo2[2 * e + 1]); k1w[e] = pk2(ko1[2 * e], ko1[2 * e + 1]); k2w[e] = pk2(ko2[2 * e], ko2[2 * e + 1]); }
            }
            *(u32x4*)(sQ + m * 72 + i0) = q1w; *(u32x4*)(sQ + m * 72 + 32 + i0) = q2w;
            *(u32x4*)(sK + m * 72 + i0) = k1w; *(u32x4*)(sK + m * 72 + 32 + i0) = k2w;
#pragma unroll
            for (int e = 0; e < 8; ++e) { sKdT[(i0 + e) * 136 + m] = f2bf(kd1[e]); sKdT[(32 + i0 + e) * 136 + m] = f2bf(kd2[e]); }
            const int m2 = tid & 127, e0 = (tid >> 7) * 32;
#pragma unroll
            for (int i = 0; i < 4; ++i)
#pragma unroll
                for (int e = 0; e < 4; ++e) { sVT[(e0 + 8 * i + 2 * e) * 136 + m2] = (bf16_t)(vv[i][e] & 0xffffu); sVT[(e0 + 8 * i + 2 * e + 1) * 136 + m2] = (bf16_t)(vv[i][e] >> 16); }
        }
        __syncthreads();
        if (ck + 1 < nch) RET_LOAD(ck + 1);
        f32x4 o[8];
        const bool act = (16 * w < C);
        unsigned gcp[4][4];
        if (act) {
#pragma unroll
            for (int j = 0; j < 4; ++j) { const int n = 16 * w + 4 * fq + j; const size_t row = (size_t)(rowb + t0 + (n < C ? n : 0));
#pragma unroll
                for (int e2 = 0; e2 < 4; ++e2) { const bf16_t lo = Z[row * DIN + ZO_GC + h * 128 + 32 * e2 + fr], hi = Z[row * DIN + ZO_GC + h * 128 + 32 * e2 + 16 + fr]; gcp[e2][j] = (unsigned)lo | ((unsigned)hi << 16); } }
        }
        if (act) {
            bf16x8 qf[2];
#pragma unroll
            for (int ks = 0; ks < 2; ++ks) qf[ks] = *(const bf16x8*)(sQ + (16 * w + fr) * 72 + 32 * ks + 8 * fq);
            const int mtN = (w | 1) + 1;
            for (int mt = 0; mt < mtN; ++mt) {
                f32x4 a = {0.f, 0.f, 0.f, 0.f};
#pragma unroll
                for (int ks = 0; ks < 2; ++ks) { const bf16x8 kf = *(const bf16x8*)(sK + (16 * mt + fr) * 72 + 32 * ks + 8 * fq); a = mfma16(qf[ks], kf, a); }
                { const int d0 = (16 * w + 4 * fq) - (16 * mt + fr); float e = __expf(lg * (float)d0); const float g1 = __expf(lg);
#pragma unroll
                  for (int j = 0; j < 4; ++j) { const float v = (d0 + j) >= 0 ? a[j] * e : 0.f; sP[(4 * fq + j) * 136 + 16 * mt + fr] = f2bf(v); e *= g1; } }
            }
            lds_wait();
#pragma unroll
            for (int et = 0; et < 8; ++et) o[et] = (f32x4){0.f, 0.f, 0.f, 0.f};
            const int ksN = mtN >> 1;
            for (int ks = 0; ks < ksN; ++ks) {
                const bf16x8 pf = *(const bf16x8*)(sP + fr * 136 + 32 * ks + 8 * fq);
#pragma unroll
                for (int et = 0; et < 8; ++et) { const bf16x8 vf = *(const bf16x8*)(sVT + (16 * et + fr) * 136 + 32 * ks + 8 * fq); o[et] = mfma16(pf, vf, o[et]); }
            }
            f32x4 o2[8];
#pragma unroll
            for (int et = 0; et < 8; ++et) o2[et] = (f32x4){0.f, 0.f, 0.f, 0.f};
#pragma unroll
            for (int ks = 0; ks < 2; ++ks)
#pragma unroll
                for (int et = 0; et < 8; ++et) { const bf16x8 sf = *(const bf16x8*)(sST + (16 * et + fr) * 72 + 32 * ks + 8 * fq); o2[et] = mfma16(qf[ks], sf, o2[et]); }
#pragma unroll
            for (int j = 0; j < 4; ++j) { const float sc = __expf(lg * (float)(16 * w + 4 * fq + j + 1));
#pragma unroll
                for (int et = 0; et < 8; ++et) o[et][j] += o2[et][j] * sc; }
        }
        {
            const float gC = __expf(lg * (float)C);
#pragma unroll
            for (int dt = 0; dt < 4; ++dt) accS[dt] = accS[dt] * gC;
            const int ksN = (C + 31) >> 5;
            for (int ks = 0; ks < ksN; ++ks) {
                const bf16x8 vf = *(const bf16x8*)(sVT + (16 * w + fr) * 136 + 32 * ks + 8 * fq);
#pragma unroll
                for (int dt = 0; dt < 4; ++dt) { const bf16x8 kf = *(const bf16x8*)(sKdT + (16 * dt + fr) * 136 + 32 * ks + 8 * fq); accS[dt] = mfma16(kf, vf, accS[dt]); }
            }
        }
        __syncthreads();
#pragma unroll
        for (int dt = 0; dt < 4; ++dt) { u32x2 ow; ow.x = pk2(accS[dt][0], accS[dt][1]); ow.y = pk2(accS[dt][2], accS[dt][3]); *(u32x2*)(sST + (16 * w + fr) * 72 + 16 * dt + 4 * fq) = ow; }
        if (act) {
#pragma unroll
            for (int j = 0; j < 4; ++j) {
                float s = 0.f;
#pragma unroll
                for (int et = 0; et < 8; ++et) s += o[et][j];
                s = row16_sum(s);
                const float mu = s * (1.0f / 128.0f);
                float s2 = 0.f;
#pragma unroll
                for (int et = 0; et < 8; ++et) { const float d = o[et][j] - mu; s2 += d * d; }
                s2 = row16_sum(s2);
                const float rstd = rsqrtf(s2 * (1.0f / 128.0f) + EPS);
                const int n = 16 * w + 4 * fq + j;
                if (n < C) {
                    const size_t row = (size_t)(rowb + t0 + n);
#pragma unroll
                    for (int et = 0; et < 8; ++et) { const int e = 16 * et + fr; const unsigned gw_ = gcp[et >> 1][j]; const float gcv = (et & 1) ? __uint_as_float(gw_ & 0xffff0000u) : __uint_as_float(gw_ << 16);
                        const float yv = gcv * sigm(gcv) * (o[et][j] - mu) * rstd * ngv[et]; Y[row * LDY + 1536 + h * 128 + e] = f2bf(yv); }
                }
            }
        }
    }
    if (grp ? OUT_ON(12) : OUT_ON(6)) {
#pragma unroll
    for (int dt = 0; dt < 4; ++dt)
#pragma unroll
        for (int j = 0; j < 4; ++j) Sout[(16 * dt + 4 * fq + j) * 128 + 16 * w + fr] = accS[dt][j];
    }
}

__device__ __forceinline__ void lru_job(const Params& P, int l, int grp, int jid, int g0, int pb0, unsigned char* smem) {
    const int tid = otid(), w = __builtin_amdgcn_readfirstlane(tid >> 6), lane = tid & 63, fr = lane & 15, fq = lane >> 4;
    bf16_t* sA = (bf16_t*)(smem + w * 10752);
    float* sRI = (float*)(smem + w * 10752 + 2304);
    float* sComb = (float*)(smem + 8 * 10752);
    const bf16_t* Z = (const bf16_t*)(P.ws + R_Z) - (size_t)g0 * DIN; bf16_t* Y = (bf16_t*)(P.ws + R_Y) - (size_t)g0 * LDY;
    const int unit = grp ? jid * 8 + w : jid;
    const int bl = unit / 12, hb = unit - bl * 12, ch = hb * 64 + lane; const int b = grp ? bl : pb0 + bl;
    const int L = grp ? 4 : LP, rowb = grp ? TPR + b * 4 : b * LP;
    float cw[4];
#pragma unroll
    for (int j = 0; j < 4; ++j) cw[j] = INP(I_LCW)[((size_t)l * 4 + j) * 768 + ch];
    const float cb = INP(I_LCB)[l * 768 + ch], ba = INP(I_LBA)[l * 768 + ch], bx = INP(I_LBX)[l * 768 + ch];
    const float lam = INP(I_LAM)[l * 768 + ch];
    const float sp8 = 8.0f * (fmaxf(-lam, 0.f) + log1pf(__expf(-fabsf(lam))));
    bf16x8 Wa[4][2], Wx[4][2];
    { gfp_t wa = INP(I_LWA) + ((size_t)l * 12 + hb) * 4096; gfp_t wx = INP(I_LWX) + ((size_t)l * 12 + hb) * 4096;
#pragma unroll
      for (int nt = 0; nt < 4; ++nt)
#pragma unroll
          for (int ks = 0; ks < 2; ++ks)
#pragma unroll
              for (int j = 0; j < 8; ++j) { const int k = 32 * ks + 8 * fq + j, n = 16 * nt + fr; Wa[nt][ks][j] = (short)f2bf(wa[k * 64 + n]); Wx[nt][ks][j] = (short)f2bf(wx[k * 64 + n]); } }
    float carry = grp ? INP(I_LRUH)[((size_t)l * DEC_B + b) * 768 + ch] : 0.f;
    gfp_t cache = INP(I_LRUC) + ((size_t)l * DEC_B + b) * 3 * 768;
    const int nIter = grp ? 1 : 17;
    __syncthreads();
#ifndef LRU_REP
#define LRU_REP 1
#endif
    bf16_t xn[19];
    { const int tw0 = grp ? 0 : 16 * w;
#pragma unroll
      for (int i = 0; i < 19; ++i) { int t = tw0 - 3 + i; t = t < 0 ? 0 : (t > L - 1 ? L - 1 : t); xn[i] = Z[(size_t)(rowb + t) * DIN + ZO_XB + ch]; } }
    for (int it_ = 0; it_ < nIter * (grp ? 1 : LRU_REP); ++it_) {
        const int it = it_ % nIter; if (LRU_REP > 1 && it_ == nIter) carry = 0.f;
        const int tw = grp ? 0 : it * 128 + 16 * w;
        float xv[19];
#pragma unroll
        for (int i = 0; i < 19; ++i) { const int t = tw - 3 + i; xv[i] = (t >= 0 && t < L) ? bf2f(xn[i]) : 0.f; }
        if (grp) {
#pragma unroll
            for (int i = 0; i < 3; ++i) xv[i] = cache[i * 768 + ch];
        }
        if (it_ + 1 < nIter * (grp ? 1 : LRU_REP)) {
            const int twn = tw + 128;
#pragma unroll
            for (int i = 0; i < 19; ++i) { int t = twn - 3 + i; t = t < 0 ? 0 : (t > L - 1 ? L - 1 : t); xn[i] = Z[(size_t)(rowb + t) * DIN + ZO_XB + ch]; }
        }
        unsigned gtp[8];
#pragma unroll
        for (int i = 0; i < 8; ++i) { const int ta = tw + 2 * i, tb = ta + 1;
            const bf16_t lo = Z[(size_t)(rowb + (ta < L ? ta : L - 1)) * DIN + ZO_GB + ch], hi = Z[(size_t)(rowb + (tb < L ? tb : L - 1)) * DIN + ZO_GB + ch];
            gtp[i] = (unsigned)lo | ((unsigned)hi << 16); }
        float xc[16];
#pragma unroll
        for (int i = 0; i < 16; ++i) { xc[i] = cb + cw[0] * xv[i] + cw[1] * xv[i + 1] + cw[2] * xv[i + 2] + cw[3] * xv[i + 3]; sA[i * 72 + lane] = f2bf(xc[i]); }
        lds_wait();
        bf16x8 af[2];
#pragma unroll
        for (int ks = 0; ks < 2; ++ks) af[ks] = *(const bf16x8*)(sA + fr * 72 + 32 * ks + 8 * fq);
#pragma unroll
        for (int nt = 0; nt < 4; ++nt) {
            f32x4 ra = {0.f, 0.f, 0.f, 0.f}, rx = ra;
            ra = mfma16(af[0], Wa[nt][0], ra); ra = mfma16(af[1], Wa[nt][1], ra);
            rx = mfma16(af[0], Wx[nt][0], rx); rx = mfma16(af[1], Wx[nt][1], rx);
#pragma unroll
            for (int j = 0; j < 4; ++j) { sRI[(4 * fq + j) * 132 + 16 * nt + fr] = ra[j]; sRI[(4 * fq + j) * 132 + 64 + 16 * nt + fr] = rx[j]; }
        }
        lds_wait();
        float hloc[16], ca[16]; float hl = 0.f, cacc = 1.f;
#pragma unroll
        for (int i = 0; i < 16; ++i) {
            const float rp = sRI[i * 132 + lane], ip = sRI[i * 132 + 64 + lane];
            const float r = sigm(rp + ba), ii = sigm(ip + bx);
            const float la = -sp8 * r; float a = __expf(la);
            const float x2 = 2.0f * la;
            const float ser = -x2 * (1.0f + x2 * (0.5f + x2 * (0.16666667f + x2 * (0.041666668f + x2 * 0.0083333338f))));
            const float om = x2 > -0.25f ? ser : 1.0f - __expf(x2);
            float bv = __builtin_amdgcn_sqrtf(om) * ii * xc[i];
            if (tw + i >= L) { a = 1.f; bv = 0.f; }
            hl = a * hl + bv; cacc *= a; hloc[i] = hl; ca[i] = cacc;
        }
        float hin = carry;
        if (!grp) {
            float* sCb = sComb + (it_ & 1) * 1024;
            sCb[(w * 64 + lane) * 2] = cacc; sCb[(w * 64 + lane) * 2 + 1] = hl;
            __syncthreads();
            float run = carry;
#pragma unroll
            for (int ww = 0; ww < 8; ++ww) { if (ww == w) hin = run; run = sCb[(ww * 64 + lane) * 2] * run + sCb[(ww * 64 + lane) * 2 + 1]; }
            carry = run;
        } else carry = hloc[15] + ca[15] * hin;
#pragma unroll
        for (int i = 0; i < 16; ++i) { const int t = tw + i;
            if (t < L) { const size_t row = (size_t)(rowb + t); const float hh = hloc[i] + ca[i] * hin; const unsigned gw_ = gtp[i >> 1]; const float gt = (i & 1) ? __uint_as_float(gw_ & 0xffff0000u) : __uint_as_float(gw_ << 16); Y[row * LDY + 768 + ch] = f2bf(hh * gelu_t(gt)); } }
    }
    if (grp || w == 0) {
        float* ho = grp ? P.out + O_S_LRUH + ((size_t)l * DEC_B + b) * 768 + ch : P.out + O_P_LRUH + ((size_t)l * NB + b) * 768 + ch;
        if (grp ? OUT_ON(10) : OUT_ON(4)) *ho = carry;
        float* co = grp ? P.out + O_S_LRUC + ((size_t)l * DEC_B + b) * 3 * 768 + ch : P.out + O_P_LRUC + ((size_t)l * NB + b) * 3 * 768 + ch;
#pragma unroll
        for (int j = 0; j < 3; ++j) if (grp ? OUT_ON(11) : OUT_ON(5)) co[j * 768] = bf2f(Z[(size_t)(rowb + L - 3 + j) * DIN + ZO_XB + ch]);
    }
}

template <bool FULL>
__device__ __forceinline__ void s5_run(const bf16_t* Z, bf16_t* ZS, float* sBU, bf16_t* sH, const bf16x8 (&Bf)[8], const bf16x8 (&Cf)[4], float abr, float abi, float dsk,
                                       int rowb, int g, int L, int it0, int it1, float& hr, float& hi, int lane, int fr, int fq) {
    u32x4 ufn = {0u, 0u, 0u, 0u}; bf16_t udn[4] = {0, 0, 0, 0};
    { const int t1 = it0 * 16; const int v1 = (L - t1) < 16 ? (L - t1) : 16;
      if (fq < 2 && fr < v1) ufn = *(const u32x4*)(Z + (size_t)(rowb + t1 + fr) * DIN + ZO_UA + g * 16 + 8 * fq);
      if (FULL) {
#pragma unroll
          for (int j = 0; j < 4; ++j) if (4 * fq + j < v1) udn[j] = Z[(size_t)(rowb + t1 + 4 * fq + j) * DIN + ZO_UA + g * 16 + fr]; } }
    for (int it = it0; it < it1; ++it) {
        const int t0 = it * 16; const int valid = (L - t0) < 16 ? (L - t0) : 16;
        const bf16x8 uf = __builtin_bit_cast(bf16x8, ufn);
        bf16_t ud[4];
#pragma unroll
        for (int j = 0; j < 4; ++j) ud[j] = udn[j];
        if (it + 1 < it1) { const int t1 = t0 + 16; const int v1 = (L - t1) < 16 ? (L - t1) : 16;
            ufn = (u32x4){0u, 0u, 0u, 0u};
            if (fq < 2 && fr < v1) ufn = *(const u32x4*)(Z + (size_t)(rowb + t1 + fr) * DIN + ZO_UA + g * 16 + 8 * fq);
            if (FULL) {
#pragma unroll
                for (int j = 0; j < 4; ++j) { udn[j] = 0; if (4 * fq + j < v1) udn[j] = Z[(size_t)(rowb + t1 + 4 * fq + j) * DIN + ZO_UA + g * 16 + fr]; } } }
#pragma unroll
        for (int nt = 0; nt < 8; ++nt) { f32x4 a = {0.f, 0.f, 0.f, 0.f}; a = mfma16(uf, Bf[nt], a);
#pragma unroll
            for (int j = 0; j < 4; ++j) sBU[(4 * fq + j) * 132 + 16 * nt + fr] = a[j]; }
        lds_wait();
#pragma unroll
        for (int i = 0; i < 16; ++i) {
            float bur = sBU[i * 132 + lane], bui = sBU[i * 132 + 64 + lane];
            asm volatile("" : "+v"(bur), "+v"(bui));
            const float msk = (i < valid) ? 1.0f : 0.0f;
            float nr = __builtin_fmaf(abr, hr, bur); asm volatile("" : "+v"(nr));
            nr = __builtin_fmaf(-abi, hi, nr); asm volatile("" : "+v"(nr));
            float ni = __builtin_fmaf(abr, hi, bui); asm volatile("" : "+v"(ni));
            ni = __builtin_fmaf(abi, hr, ni); asm volatile("" : "+v"(ni));
            hr = __builtin_fmaf(msk, nr - hr, hr); hi = __builtin_fmaf(msk, ni - hi, hi);
            asm volatile("" : "+v"(hr), "+v"(hi));
            if (FULL) { sH[i * 136 + lane] = f2bf(hr); sH[i * 136 + 64 + lane] = f2bf(hi); }
        }
        lds_wait();
        if (FULL) {
            f32x4 y = {0.f, 0.f, 0.f, 0.f};
#pragma unroll
            for (int ks = 0; ks < 4; ++ks) { const bf16x8 hf = *(const bf16x8*)(sH + fr * 136 + 32 * ks + 8 * fq); y = mfma16(hf, Cf[ks], y); }
#pragma unroll
            for (int j = 0; j < 4; ++j) { const int t = 4 * fq + j;
                if (t < valid) { const size_t row = (size_t)(rowb + t0 + t); const float u = bf2f(ud[j]); ZS[row * 768 + g * 16 + fr] = f2bf(gelu_t(y[j] + dsk * u)); } }
            lds_wait();
        }
    }
}
__device__ __forceinline__ void cmul(float& ar, float& ai, float br, float bi) { const float r = ar * br - ai * bi, i = ar * bi + ai * br; ar = r; ai = i; }

__device__ __forceinline__ void s5_job(const Params& P, int l, int grp, int jid, int g0, int pb0, unsigned* s5done, unsigned char* smem) {
    const int tid = otid(), w = __builtin_amdgcn_readfirstlane(tid >> 6), lane = tid & 63, fr = lane & 15, fq = lane >> 4;
    float* sBU = (float*)(smem + w * 12800);
    bf16_t* sH = (bf16_t*)(smem + w * 12800 + 8448);
    float* sC = (float*)(smem + 8 * 12800);
    const bf16_t* Z = (const bf16_t*)(P.ws + R_Z) - (size_t)g0 * DIN; bf16_t* ZS = (bf16_t*)(P.ws + R_ZS5) - (size_t)g0 * 768;
    int g, b0;
    if (grp) { const int unit = jid * 8 + w; g = unit % 48; b0 = (unit / 48) * 16; } else { b0 = jid / 48; g = jid - b0 * 48; b0 += pb0; }
    const float dt = __expf(INP(I_LS)[l * 48 + g]);
    float abr = 0.f, abi = 0.f;
    bf16x8 Bf[8];
#pragma unroll
    for (int k = 0; k < 4; ++k) {
        const int p = 16 * k + fr;
        const float lr = INP(I_AR)[((size_t)l * 48 + g) * 64 + p], li = INP(I_AI)[((size_t)l * 48 + g) * 64 + p];
        const float mag = expf(lr * dt), ar_ = mag * cosf(li * dt), ai_ = mag * sinf(li * dt);
        if (k == fq) { abr = ar_; abi = ai_; }
        const float den = lr * lr + li * li, nr = ar_ - 1.0f;
        const float cr = (nr * lr + ai_ * li) / den, ci = (ai_ * lr - nr * li) / den;
        bf16x8 fre, fim;
#pragma unroll
        for (int j = 0; j < 8; ++j) { fre[j] = 0; fim[j] = 0; }
        if (fq < 2) {
            gfp_t bre = INP(I_BR) + (((size_t)l * 48 + g) * 64 + p) * 16 + 8 * fq; gfp_t bim = INP(I_BI) + (((size_t)l * 48 + g) * 64 + p) * 16 + 8 * fq;
#pragma unroll
            for (int j = 0; j < 8; ++j) { const float br_ = bre[j], bi_ = bim[j]; fre[j] = (short)f2bf(cr * br_ - ci * bi_); fim[j] = (short)f2bf(cr * bi_ + ci * br_); }
        }
        Bf[k] = fre; Bf[4 + k] = fim;
    }
    bf16x8 Cf[4];
#pragma unroll
    for (int ks = 0; ks < 4; ++ks) {
        gfp_t cp = (ks < 2 ? INP(I_CR) : INP(I_CI)) + (((size_t)l * 48 + g) * 16 + fr) * 64 + 32 * (ks & 1) + 8 * fq;
        const float sg = ks < 2 ? 1.0f : -1.0f;
#pragma unroll
        for (int j = 0; j < 8; ++j) Cf[ks][j] = (short)f2bf(sg * cp[j]);
    }
    const float dsk = INP(I_D)[l * 768 + g * 16 + fr];
    __syncthreads();
    if (grp) {
        for (int s = 0; s < 16; ++s) {
            const int b = b0 + s; const int rowb = TPR + b * 4;
            float hr = INP(I_S5RE)[(((size_t)l * DEC_B + b) * 48 + g) * 64 + lane], hi = INP(I_S5IM)[(((size_t)l * DEC_B + b) * 48 + g) * 64 + lane];
            s5_run<true>(Z, ZS, sBU, sH, Bf, Cf, abr, abi, dsk, rowb, g, 4, 0, 1, hr, hi, lane, fr, fq);
            P.out[O_S_S5RE + (((size_t)l * DEC_B + b) * 48 + g) * 64 + lane] = hr;
            P.out[O_S_S5IM + (((size_t)l * DEC_B + b) * 48 + g) * 64 + lane] = hi;
        }
    } else {
        const int b = b0, rowb = b * LP;
        const int it0 = w == 0 ? 0 : 17 + 16 * (w - 1), it1 = 17 + 16 * w;
        float hr = 0.f, hi = 0.f;
        s5_run<false>(Z, ZS, sBU, sH, Bf, Cf, abr, abi, dsk, rowb, g, LP, it0, it1, hr, hi, lane, fr, fq);
        sC[(w * 64 + lane) * 2] = hr; sC[(w * 64 + lane) * 2 + 1] = hi;
        float pr = abr, pi = abi, p16r = 0.f, p16i = 0.f;
#pragma unroll
        for (int q = 0; q < 8; ++q) { cmul(pr, pi, pr, pi); if (q == 3) { p16r = pr; p16i = pi; } }
        float qr = pr, qi = pi; cmul(qr, qi, p16r, p16i);
        __syncthreads();
        float cr_ = 0.f, ci_ = 0.f;
        for (int ww = 0; ww < w; ++ww) {
            const float ar2 = ww == 0 ? qr : pr, ai2 = ww == 0 ? qi : pi;
            cmul(cr_, ci_, ar2, ai2);
            cr_ += sC[(ww * 64 + lane) * 2]; ci_ += sC[(ww * 64 + lane) * 2 + 1];
        }
        hr = cr_; hi = ci_;
        s5_run<true>(Z, ZS, sBU, sH, Bf, Cf, abr, abi, dsk, rowb, g, LP, it0, it1, hr, hi, lane, fr, fq);
        if (w == 7) {
            P.out[O_P_S5RE + (((size_t)l * NB + b) * 48 + g) * 64 + lane] = hr;
            P.out[O_P_S5IM + (((size_t)l * NB + b) * 48 + g) * 64 + lane] = hi;
        }
    }
    asm volatile("s_waitcnt vmcnt(0)" ::: "memory");
    __syncthreads();
    if (threadIdx.x == 0) { __threadfence(); asm volatile("s_waitcnt vmcnt(0)" ::: "memory"); atomicAdd(s5done, 1u); }
}

__device__ __forceinline__ void mixers_phase(const Params& P, int l, int rg, unsigned char* smem, int rep) {
    const Grp G = get_grp(rg);
    const int j1 = G.npb * 8, j2 = j1 + G.npb * 12, j3 = j2 + G.npb * 48, j4 = j3 + (G.hasS ? 1024 : 0), j5 = j4 + (G.hasS ? 48 : 0), j6 = j5 + (G.hasS ? 192 : 0), j7 = j6 + G.npan * 12, NJ = j7 + G.npan * 3;
    unsigned* s5done = (unsigned*)(P.ws + A_CTR) + 32 + (l * NGRP + rg) + rep * 16;
    const unsigned s5total = (unsigned)(G.npb * 48 + (G.hasS ? 48 : 0));
    unsigned* ctr = (unsigned*)(P.ws + A_CTR) + (l * NGRP + rg) + rep * 16;
    int* slot = (int*)(smem + LDS_BYTES - 16);
#ifndef STATIC_JOBS
#define STATIC_JOBS 0
#endif
    for (int jj = blockIdx.x;; jj += gridDim.x) {
        __syncthreads();
#if STATIC_JOBS
        const int j = jj; (void)ctr; (void)slot;
#else
        if (threadIdx.x == 0) *slot = (int)atomicAdd(ctr, 1u);
        __syncthreads();
        const int j = *slot;
#endif
        if (j >= NJ) break;
        int type, sg, idx;
        if (j < j1) { type = 0; sg = 0; idx = j; }
        else if (j < j2) { type = 1; sg = 0; idx = j - j1; }
        else if (j < j3) { type = 2; sg = 0; idx = j - j2; }
        else if (j < j4) { type = 0; sg = 1; idx = j - j3; }
        else if (j < j5) { type = 2; sg = 1; idx = j - j4; }
        else if (j < j6) { type = 1; sg = 1; idx = j - j5; }
        else if (j < j7) { type = 4; sg = 0; idx = j - j6; }
        else { type = 3; sg = 0; idx = j - j7; }
        if (type == 4) {
            using namespace pg8;
            Gemm gg{(const bf16_t*)(P.ws + R_H), (const bf16_t*)(P.ws + W_IN) + (size_t)l * DIN * DM, DM, DM, G.npan, DIN / 256, DM / 64, nullptr};
            SchedOne S1{idx / 12, 21 + idx % 12, DM / 64};
            EpiSigBf E{(bf16_t*)(P.ws + R_Z), DIN};
            gemm_run((LAS unsigned char*)smem, gg, S1, E);
            continue;
        }
        if (type == 3) {
            if (threadIdx.x == 0) {
                unsigned sp = 0;
                while (__hip_atomic_load(s5done, __ATOMIC_RELAXED, __HIP_MEMORY_SCOPE_AGENT) < s5total) { __builtin_amdgcn_s_sleep(8); if (++sp > (1u << 22)) break; }
                __threadfence();
                asm volatile("s_waitcnt vmcnt(0)" ::: "memory");
            }
            __syncthreads();
            using namespace pg8;
            Gemm gg{(const bf16_t*)(P.ws + R_ZS5), (const bf16_t*)(P.ws + W_GLU) + (size_t)l * 768 * 768, 768, 768, G.npan, 3, 12, nullptr};
            SchedOne S1{idx / 3, idx % 3, 12};
            EpiGlu E{(bf16_t*)(P.ws + R_Y), (const bf16_t*)(P.ws + R_ZS5), INP(I_BGLU) + l * 768};
            gemm_run((LAS unsigned char*)smem, gg, S1, E);
            continue;
        }
        if (type == 0) ret_job(P, l, sg, (idx >> 3) + (sg ? 0 : G.pb0), idx & 7, G.g0, smem);
        else if (type == 1) lru_job(P, l, sg, idx, G.g0, G.pb0, smem);
        else s5_job(P, l, sg, idx, G.g0, G.pb0, s5done, smem);
    }
}

__device__ __forceinline__ void run_phase(const Params& P, int ph, unsigned char* smem, int rep) {
#ifndef PHSEL
#define PHSEL -1
#endif
#define PSEL(x) (PHSEL < 0 || PHSEL == (x))
    if (ph == 0) { if (PSEL(10)) phase0(P, smem); return; }
    const int l = (ph - 1) / (10 * NGRP), rg = ((ph - 1) / 10) % NGRP, s = (ph - 1) % 10;
    LAS unsigned char* lds = (LAS unsigned char*)smem;
    unsigned char* ws = P.ws;
    using namespace pg8;
    const int G = gridDim.x, c = blockIdx.x;
    const int npan = rg < 2 ? 25 : 19;
    switch (s) {
    case 0: if (PSEL(0)) { Gemm g{(const bf16_t*)(ws + R_H), (const bf16_t*)(ws + W_IN) + (size_t)l * DIN * DM, DM, DM, npan, 21, DM / 64, nullptr};
              Sched<1> S; S.init(g.nM, g.nN, G, c, g.nt); EpiBf E{(bf16_t*)(ws + R_Z), DIN, (bf16_t*)(ws + R_Z)}; gemm_run(lds, g, S, E); } break;
    case 1: if (PSEL(1)) mixers_phase(P, l, rg, smem, rep); break;
    case 2: if (PSEL(2)) { Gemm g{(const bf16_t*)(ws + R_ZS5), (const bf16_t*)(ws + W_GLU) + (size_t)l * 768 * 768, 768, 768, npan, 3, 12, nullptr};
              Sched<1> S; S.init(g.nM, g.nN, G, c, g.nt); EpiGlu E{(bf16_t*)(ws + R_Y), (const bf16_t*)(ws + R_ZS5), INP(I_BGLU) + l * 768}; gemm_run(lds, g, S, E); } break;
    case 3: if (PSEL(3)) { Gemm g{(const bf16_t*)(ws + R_Y), (const bf16_t*)(ws + W_BR) + (size_t)l * DM * LDY, LDY, LDY, npan, 4, 0, nullptr};
              SchedBr2 S; S.init(g.nM, g.nN, G, c); EpiBranch E{(const bf16_t*)(ws + R_Z) + ZO_GATE, (bf16_t*)(ws + R_M), (bf16_t*)(ws + R_M2)}; gemm_run(lds, g, S, E); } break;
    case 4: if (PSEL(4)) { Gemm g{(const bf16_t*)(ws + R_M), (const bf16_t*)(ws + W_OUT) + (size_t)l * DM * DM, DM, DM, npan, 4, 16, (const bf16_t*)(ws + R_M2)};
              Sched<2> S; S.init(g.nM, g.nN, G, c, g.nt); S.fullk = 1;     EpiBf E{(bf16_t*)(ws + R_F), DM, (bf16_t*)(ws + R_UP)}; gemm_run(lds, g, S, E); } break;
    case 5: if (PSEL(5) && rep == 0) norm_rows(P, 1, l, rg, smem); break;
    case 6: if (PSEL(6)) { Gemm g{(const bf16_t*)(ws + R_H), (const bf16_t*)(ws + W_UP) + (size_t)l * 2 * DFF * DM, DM, DM, npan, 22, 16, nullptr};
              Sched<1> S; S.init(g.nM, g.nN, G, c, g.nt); EpiBf E{(bf16_t*)(ws + R_UP), 2 * DFF, (bf16_t*)(ws + R_UP)}; gemm_run(lds, g, S, E); } break;
    case 7: if (PSEL(7)) ffn_conv_phase(P, l, rg, smem); break;
    case 8: if (PSEL(8)) { Gemm g{(const bf16_t*)(ws + R_FIN), (const bf16_t*)(ws + W_DOWN) + (size_t)l * DM * DFF, DFF, DFF, npan, 4, 44, nullptr};
              Sched<2> S; S.init(g.nM, g.nN, G, c, g.nt); EpiBf E{(bf16_t*)(ws + R_F), DM, (bf16_t*)(ws + R_UP)}; gemm_run(lds, g, S, E);
              const int nun = 2 * npan * 4;
              if (c >= nun) next_h_rows(P, l, rg, (c - nun) * 8 + (int)(threadIdx.x >> 6), (G - nun) * 8, smem);
              else if (G <= nun) next_h_rows(P, l, rg, c * 8 + (int)(threadIdx.x >> 6), G * 8, smem); } break;
    default: if (PSEL(9) && rep == 0) norm_rows(P, 2, l, rg, smem); break;
    }
}

#define XB_TMO      128
#define XB_XCNT(j)  (256  + 64 * (j))
#define XB_XSUB(j)  (1280 + 64 * (j))
#define XB_XGEN(j)  (2304 + 64 * (j))
#define XB_TOP      3328
#define XB_TOPGEN   3392
#define XCD_BAR_WORDS 3456
#define XB_SPIN_CAP (1u << 18)

__device__ __forceinline__ unsigned xb_ld(unsigned* p)              { return __hip_atomic_load(p, __ATOMIC_RELAXED, __HIP_MEMORY_SCOPE_AGENT); }
__device__ __forceinline__ unsigned xb_add(unsigned* p, unsigned v) { return __hip_atomic_fetch_add(p, v, __ATOMIC_RELAXED, __HIP_MEMORY_SCOPE_AGENT); }
__device__ __forceinline__ unsigned xb_xcc_id() { return (unsigned)__builtin_amdgcn_s_getreg((3 << 11) | 20) & 0xFu; }
#define XB_SPIN(cond, bar) do { unsigned _sp = 0; while (cond) { __builtin_amdgcn_s_sleep(1); \
    if ((++_sp & 255u) == 0u) { if (xb_ld(&(bar)[XB_TMO])) break; if (_sp > XB_SPIN_CAP) { atomicAdd(&(bar)[XB_TMO], 1u); break; } } } } while (0)

struct XcdBarrier {
    unsigned* bar; unsigned x;
    volatile LAS unsigned* st;
};

__device__ __forceinline__ XcdBarrier xcd_barrier_post(unsigned* bar, volatile LAS unsigned* st) {
    XcdBarrier b; b.bar = bar; b.x = xb_xcc_id(); b.st = st;
    if (threadIdx.x == 0) (void)xb_add(&bar[XB_XCNT(b.x)], 1u);
    return b;
}
__device__ __forceinline__ void xcd_barrier_complete(unsigned* bar, unsigned x, unsigned& nloc, unsigned& nx) {
    const unsigned G = gridDim.x * gridDim.y * gridDim.z;
    unsigned sum, cnt, mine, sp = 0u;
    for (;;) {
        sum = 0u; cnt = 0u; mine = 0u;
#pragma unroll
        for (unsigned j = 0; j < 16; ++j) { const unsigned c = xb_ld(&bar[XB_XCNT(j)]); sum += c; cnt += (c > 0u) ? 1u : 0u; mine = (j == x) ? c : mine; }
        if (sum == G) break;
        __builtin_amdgcn_s_sleep(1);
        if ((++sp & 255u) == 0u) { if (xb_ld(&bar[XB_TMO])) break; if (sp > XB_SPIN_CAP) { atomicAdd(&bar[XB_TMO], 1u); break; } }
    }
    nloc = mine > 0u ? mine : 1u; nx = cnt > 0u ? cnt : 1u;
}

__device__ __forceinline__ void xcd_barrier(const XcdBarrier& b) {
    asm volatile("s_waitcnt vmcnt(0)" ::: "memory");
    __syncthreads();
    if (threadIdx.x == 0) {
        unsigned* bar = b.bar;
        __builtin_amdgcn_s_waitcnt(0);
        unsigned nloc = b.st[0], nx = b.st[1];
        if (nloc == 0u) { xcd_barrier_complete(bar, b.x, nloc, nx); b.st[0] = nloc; b.st[1] = nx; }
        const unsigned old = xb_add(&bar[XB_XSUB(b.x)], 1u);
        const unsigned gen = old / nloc;
        if (old + 1u == (gen + 1u) * nloc) {
            __builtin_amdgcn_fence(__ATOMIC_RELEASE, "agent");
            asm volatile("s_waitcnt vmcnt(0)" ::: "memory");
            const unsigned og = xb_add(&bar[XB_TOP], 1u);
            const unsigned tg = og / nx;
            if (og + 1u == (tg + 1u) * nx) xb_add(&bar[XB_TOPGEN], 1u);
            else XB_SPIN(xb_ld(&bar[XB_TOPGEN]) == tg, bar);
            __builtin_amdgcn_fence(__ATOMIC_ACQUIRE, "agent");
            xb_add(&bar[XB_XGEN(b.x)], 1u);
            asm volatile("s_waitcnt vmcnt(0)" ::: "memory");
        } else {
            XB_SPIN(xb_ld(&bar[XB_XGEN(b.x)]) == gen, bar);
            __builtin_amdgcn_fence(__ATOMIC_ACQUIRE, "agent");
            asm volatile("s_waitcnt vmcnt(0)" ::: "memory");
        }
    }
    __syncthreads();
}


__global__ void __launch_bounds__(512, 2) mega(Params P, int ph_lo, int ph_hi) {
    extern __shared__ __attribute__((aligned(16))) unsigned char smem[];
    unsigned* xst = (unsigned*)(smem + LDS_BYTES - 32);
    if (threadIdx.x == 0) {
        const float** tab = (const float**)(smem + PTAB_OFF);
#pragma unroll
        for (int i = 0; i < N_IN; ++i) tab[i] = P.in[i];
        xst[0] = 0u; xst[1] = 0u;
    }
    __syncthreads();
    XcdBarrier xb = xcd_barrier_post((unsigned*)(P.ws + A_BAR), (volatile LAS unsigned*)xst);
#ifndef DUP_MASK
#define DUP_MASK 0x400
#endif
    for (int ph = ph_lo; ph < ph_hi; ++ph) {
        if (ph > 0 && (ph - 1) % 10 == 2) continue;
        int nrep = 1;
        if (DUP_MASK) { const int sidx = ph == 0 ? 10 : (ph - 1) % 10; if ((DUP_MASK >> sidx) & 1) nrep = 2; }
        for (int rep = 0; rep < nrep; ++rep) {
            run_phase(P, ph, smem, rep);
            if (ph + 1 < ph_hi || rep + 1 < nrep) xcd_barrier(xb);
        }
    }
}


#ifndef DBG_STOP
#define DBG_STOP 0
#endif
#ifndef DBG_OFF
#define DBG_OFF R_Z
#endif
__global__ void dbg_dump(const unsigned char* ws, float* out, size_t n) {
    const bf16_t* src = (const bf16_t*)(ws + DBG_OFF);
    for (size_t i = (size_t)blockIdx.x * blockDim.x + threadIdx.x; i < n; i += (size_t)gridDim.x * blockDim.x) out[i] = bf2f(src[i]);
}

extern "C" void kernel_launch(void* const* d_in, const int* in_sizes, int n_in, void* d_out, int out_size, void* d_ws, size_t ws_size, hipStream_t stream) {
    (void)in_sizes; (void)n_in; (void)out_size;
    if (ws_size < WS_TOTAL) { fprintf(stderr, "workspace too small: %zu < %zu\n", ws_size, (size_t)WS_TOTAL); return; }
    Params p{};
    for (int i = 0; i < N_IN; ++i) p.in[i] = (const float*)d_in[i];
    p.out = (float*)d_out; p.ws = (unsigned char*)d_ws;
    hipFuncSetAttribute((const void*)mega, hipFuncAttributeMaxDynamicSharedMemorySize, LDS_BYTES);
    int dev = 0, cus = 256, per_cu = 1;
    hipGetDevice(&dev);
    hipDeviceGetAttribute(&cus, hipDeviceAttributeMultiprocessorCount, dev);
    hipOccupancyMaxActiveBlocksPerMultiprocessor(&per_cu, mega, 512, LDS_BYTES);
    if (per_cu < 1) per_cu = 1;
    const int grid = cus * 1;
#if COOP
#ifndef PH_HI
#define PH_HI NPHASE
#endif
    hipMemsetAsync((unsigned char*)d_ws + A_BAR, 0, 16384, stream);
    int lo = 0, hi = PH_HI;
    void* args[] = {&p, &lo, &hi};
    hipError_t e = hipLaunchCooperativeKernel((void*)mega, dim3(grid), dim3(512), args, LDS_BYTES, stream);
    if (e != hipSuccess) fprintf(stderr, "cooperative launch failed: %s (grid %d)\n", hipGetErrorString(e), grid);
#else
#if DBG_STOP
    for (int ph = 0; ph < DBG_STOP; ++ph) hipLaunchKernelGGL(mega, dim3(grid), dim3(512), LDS_BYTES, stream, p, ph, ph + 1);
#ifdef DBG_EXTRA
    hipLaunchKernelGGL(mega, dim3(grid), dim3(512), LDS_BYTES, stream, p, DBG_EXTRA, DBG_EXTRA + 1);
#endif
    hipLaunchKernelGGL(dbg_dump, dim3(2048), dim3(256), 0, stream, (const unsigned char*)d_ws, (float*)d_out, (size_t)34873344);
#else
    for (int ph = 0; ph < NPHASE; ++ph) hipLaunchKernelGGL(mega, dim3(grid), dim3(512), LDS_BYTES, stream, p, ph, ph + 1);
#endif
#endif
}
```
